# Optimizing an MI355X kernel written in HIP

```python
import jax, jax.numpy as jnp
from jax import lax
import numpy as np

D_MODEL = 2048
BATCH = 8
SEQ = 4096
DEPTH = 4

N_MIXERS = 2
N_A = (DEPTH + 1) // 2
N_B = DEPTH // 2
HEAD_DIM = 128
N_HEADS = D_MODEL // HEAD_DIM
Q_BLOCK = 128
CHUNK = 128
D_GM = D_MODEL
GM_GROUP = 128
N_GM_GROUPS = D_GM // GM_GROUP
D_FF = 5504
CONV_W = 3
EPS = 1e-6

kernel_name = "hybrid_fox_gmlp_convffn_adaln"


def rms_norm(x, g):
    xf = x.astype(jnp.float32)
    y = xf * lax.rsqrt(jnp.mean(xf * xf, axis=-1, keepdims=True) + EPS)
    return (y * g.astype(jnp.float32)).astype(x.dtype)


def modulate(h, shift, scale):
    return h * (1 + scale[:, None, :]) + shift[:, None, :]


def fox_attention(h, w_in, b_f, w_o):
    B, S, D = h.shape
    proj = h @ w_in
    q = proj[..., :D].reshape(B, S, N_HEADS, HEAD_DIM).transpose(0, 2, 1, 3)
    k = proj[..., D:2 * D].reshape(B, S, N_HEADS, HEAD_DIM).transpose(0, 2, 1, 3)
    v = proj[..., 2 * D:3 * D].reshape(B, S, N_HEADS, HEAD_DIM).transpose(0, 2, 1, 3)
    f_logit = (proj[..., 3 * D:] + b_f).astype(jnp.float32)
    log_f = jax.nn.log_sigmoid(f_logit)
    F = jnp.cumsum(log_f, axis=1).transpose(0, 2, 1)
    scale = HEAD_DIM ** -0.5
    outs = []
    for i in range(S // Q_BLOCK):
        lo, hi = i * Q_BLOCK, (i + 1) * Q_BLOCK
        qb = q[:, :, lo:hi]
        kb = k[:, :, :hi]
        vb = v[:, :, :hi]
        s = jnp.einsum('bhqd,bhkd->bhqk', qb, kb).astype(jnp.float32) * scale
        s = s + F[:, :, lo:hi, None] - F[:, :, None, :hi]
        q_pos = lo + jnp.arange(Q_BLOCK)
        k_pos = jnp.arange(hi)
        mask = k_pos[None, :] <= q_pos[:, None]
        s = jnp.where(mask, s, -jnp.inf)
        p = jax.nn.softmax(s, axis=-1).astype(v.dtype)
        outs.append(jnp.einsum('bhqk,bhkd->bhqd', p, vb))
    o = jnp.concatenate(outs, axis=2)
    o = o.transpose(0, 2, 1, 3).reshape(B, S, D)
    return o @ w_o


def chunked_gmlp(h, w_in, v_g, w_s, b_s, w_o):
    B, S, _ = h.shape
    z = jax.nn.gelu(h @ w_in)
    u, v = z[..., :D_GM], z[..., D_GM:]
    v = rms_norm(v, v_g)
    vc = v.reshape(B, S // CHUNK, CHUNK, N_GM_GROUPS, GM_GROUP)
    causal = jnp.tril(jnp.ones((CHUNK, CHUNK), dtype=w_s.dtype))
    w = w_s * causal[None]
    sv = jnp.einsum('gts,bnsgd->bntgd', w, vc)
    sv = sv + b_s.T[None, None, :, :, None]
    gated = u * sv.reshape(B, S, D_GM)
    return gated @ w_o


def conv_ffn(h, w_in, conv_w, conv_b, w_out):
    a = h @ w_in
    S = a.shape[1]
    ap = jnp.pad(a, ((0, 0), (CONV_W - 1, 0), (0, 0)))
    a = (conv_w[0] * ap[:, 0:S] + conv_w[1] * ap[:, 1:S + 1]
         + conv_w[2] * ap[:, 2:S + 2] + conv_b)
    gate, up = a[..., :D_FF], a[..., D_FF:]
    return (jax.nn.silu(gate) * up) @ w_out


def setup_inputs(seed: int = 0) -> dict:
    key = jax.random.key(seed)
    ks = jax.random.split(key, 24)
    f32 = jnp.float32
    nrm = lambda k, shape, s: jax.random.normal(k, shape, f32) * s
    D = D_MODEL
    return {
        "x": nrm(ks[0], (BATCH, SEQ, D), 1.0),
        "c": nrm(ks[1], (BATCH, D), 1.0),
        "mod_w": nrm(ks[2], (DEPTH, D, 6 * D), 0.5 * D ** -0.5),
        "mod_b": nrm(ks[3], (DEPTH, 6 * D), 0.02),
        "mix_norm_g": 1.0 + nrm(ks[4], (DEPTH, D), 0.02),
        "ffn_norm_g": 1.0 + nrm(ks[5], (DEPTH, D), 0.02),
        "attn_w_in": nrm(ks[6], (N_A, D, 3 * D + N_HEADS), D ** -0.5),
        "attn_b_f": jax.random.uniform(ks[7], (N_A, N_HEADS), f32, 1.0, 6.0),
        "attn_w_o": nrm(ks[8], (N_A, D, D), D ** -0.5),
        "gm_w_in": nrm(ks[9], (N_B, D, 2 * D_GM), D ** -0.5),
        "gm_v_g": 1.0 + nrm(ks[10], (N_B, D_GM), 0.02),
        "gm_w_s": nrm(ks[11], (N_B, N_GM_GROUPS, CHUNK, CHUNK), CHUNK ** -0.5),
        "gm_b_s": 1.0 + nrm(ks[12], (N_B, N_GM_GROUPS, CHUNK), 0.1),
        "gm_w_o": nrm(ks[13], (N_B, D_GM, D), D_GM ** -0.5),
        "ffn_w_in": nrm(ks[14], (DEPTH, D, 2 * D_FF), D ** -0.5),
        "ffn_conv_w": nrm(ks[15], (DEPTH, CONV_W, 2 * D_FF), CONV_W ** -0.5),
        "ffn_conv_b": nrm(ks[16], (DEPTH, 2 * D_FF), 0.02),
        "ffn_w_out": nrm(ks[17], (DEPTH, D_FF, D), D_FF ** -0.5),
        "final_g": 1.0 + nrm(ks[18], (D,), 0.02),
    }


def reference(x, c, mod_w, mod_b, mix_norm_g, ffn_norm_g, attn_w_in, attn_b_f, attn_w_o,
              gm_w_in, gm_v_g, gm_w_s, gm_b_s, gm_w_o, ffn_w_in, ffn_conv_w, ffn_conv_b,
              ffn_w_out, final_g):
    c_act = jax.nn.silu(c)
    for i in range(DEPTH):
        mod = c_act @ mod_w[i] + mod_b[i]
        sh1, sc1, g1, sh2, sc2, g2 = jnp.split(mod, 6, axis=-1)
        h = modulate(rms_norm(x, mix_norm_g[i]), sh1, sc1)
        j = i // N_MIXERS
        if i % N_MIXERS == 0:
            y = fox_attention(h, attn_w_in[j], attn_b_f[j], attn_w_o[j])
        else:
            y = chunked_gmlp(h, gm_w_in[j], gm_v_g[j], gm_w_s[j], gm_b_s[j], gm_w_o[j])
        x = x + g1[:, None, :] * y
        h = modulate(rms_norm(x, ffn_norm_g[i]), sh2, sc2)
        x = x + g2[:, None, :] * conv_ffn(h, ffn_w_in[i], ffn_conv_w[i], ffn_conv_b[i], ffn_w_out[i])
    return rms_norm(x, final_g)
```

```cpp
#include <hip/hip_runtime.h>
#include <hip/hip_bf16.h>
#include <cstdio>
#include <cstdint>
__device__ __forceinline__ int ltid() { int t = (int)threadIdx.x; asm volatile("" : "+v"(t)); return t; }
namespace pg8 {
#define PG8_LAS __attribute__((address_space(3)))
typedef unsigned short bf16_t;
typedef short bf16x8 __attribute__((ext_vector_type(8)));
typedef float f32x4 __attribute__((ext_vector_type(4)));
typedef unsigned u32x4 __attribute__((ext_vector_type(4)));
constexpr int BM = 256, BK = 64, HALF = 128, HTB = HALF * BK * 2  , STAGE_BYTES = 8 * HTB, NXCD = 8, WGM = 8;

__host__ __device__ __forceinline__ int lds_byte(int r, int c) { const int st = (r >> 4) * 2 + (c >> 5), rr = r & 15, cc = c & 31, ob = rr * 64 + cc * 2; return st * 1024 + (ob ^ (((ob >> 9) & 1) << 5)); }
__host__ __device__ __forceinline__ void stage_rc(int b, int& R, int& C) { const int st = b / 1024, sb = b % 1024, swz = sb ^ (((sb >> 9) & 1) << 5); R = (st >> 1) * 16 + swz / 64; C = (st & 1) * 32 + (swz % 64) / 2; }
__host__ __device__ __forceinline__ int perm32(int rho) { const int n = rho >> 4, i = rho & 15; return 8 * (i >> 2) + 4 * n + (i & 3); }

struct Unit { int pm, pn; };
struct Gemm { const bf16_t* A; const bf16_t* Bt; int M, N, K; };

struct StaticOrder {
    int nM, nN, nwg, G, c;
    __host__ __device__ void init(int M, int N, int G_, int c_) { nM = M / BM; nN = N / BM; nwg = nM * nN; G = G_; c = c_; }
    __host__ __device__ bool next(int i, Unit& u) const {
        const long L = (long)i * G + c; if (L >= nwg) return false;
        int wgid = (int)L; { const int q = nwg / NXCD, r = nwg % NXCD, xcd = wgid % NXCD, off = wgid / NXCD; wgid = (xcd < r ? xcd * (q + 1) : r * (q + 1) + (xcd - r) * q) + off; }
        const int nig = WGM * nN, gid = wgid / nig, fm = gid * WGM, gsz = (nM - fm) < WGM ? (nM - fm) : WGM;
        u.pm = fm + ((wgid % nig) % gsz); u.pn = (wgid % nig) / gsz; return true;
    }
    __device__ __forceinline__ void a_ready(const Unit&) const {}
    __device__ __forceinline__ void done(const Unit&) const {}
};
__device__ __forceinline__ unsigned cvt_pk_bf16(float lo, float hi) { unsigned r; asm volatile("v_cvt_pk_bf16_f32 %0, %1, %2" : "=v"(r) : "v"(lo), "v"(hi)); return r; }
typedef float f32x2 __attribute__((ext_vector_type(2)));
__device__ __forceinline__ f32x2 gelu_pk(f32x2 v) {
    const f32x2 av = __builtin_elementwise_abs(v), d = av * 0.2316418882f + 1.0f;
    f32x2 t; t.x = __builtin_amdgcn_rcpf(d.x); t.y = __builtin_amdgcn_rcpf(d.y);
    f32x2 q = t * 0.5307027145f + (-0.7265760135f); q = q * t + 0.7107068705f; q = q * t + (-0.142248368f); q = q * t + 0.127414796f; q = q * t;
    const f32x2 s = (v * v) * (-0.72134752044f);
    f32x2 e; e.x = __builtin_amdgcn_exp2f(s.x); e.y = __builtin_amdgcn_exp2f(s.y);
    const f32x2 m = v * (q * e), r = v - m;
    f32x2 o; o.x = v.x < 0.f ? m.x : r.x; o.y = v.y < 0.f ? m.y : r.y; return o;
}

__device__ __forceinline__ float gelu_tanh1(float v) {
    const float u = v * (0.7978845608f + 0.0356774081f * v * v);
    const float e = __builtin_amdgcn_exp2f(u * -2.8853900818f);
    return v * __builtin_amdgcn_rcpf(1.0f + e);
}
template <int ACT  > struct EpiStore {
    static constexpr bool PERM = true, AFTER_DRAIN = false;
    bf16_t* O; int ldc;
    __device__ __forceinline__ void operator()(const f32x4 (&acc)[2][2][4][2], const Unit& u, int wr, int wc, int fr, int fq) const {
        const int row0 = u.pm * BM + wr * 64 + fr, col0 = u.pn * BM + wc * 32 + 8 * fq;
#pragma unroll
        for (int ai = 0; ai < 2; ++ai)
#pragma unroll
            for (int m = 0; m < 4; ++m) { bf16_t* rowp = O + (size_t)(row0 + ai * HALF + m * 16) * ldc + col0;
#pragma unroll
                for (int bj = 0; bj < 2; ++bj) { f32x4 v0 = acc[ai][bj][m][0], v1 = acc[ai][bj][m][1];
                    if (ACT == 1) {
#pragma unroll
                        for (int j = 0; j < 4; ++j) { v0[j] = gelu_tanh1(v0[j]); v1[j] = gelu_tanh1(v1[j]); } }
                    u32x4 w; w.x = cvt_pk_bf16(v0[0], v0[1]); w.y = cvt_pk_bf16(v0[2], v0[3]); w.z = cvt_pk_bf16(v1[0], v1[1]); w.w = cvt_pk_bf16(v1[2], v1[3]);
                    *(u32x4*)(rowp + bj * HALF) = w; } }
    }
};
struct EpiQKV {
    static constexpr bool PERM = true, AFTER_DRAIN = false;
    bf16_t* QKV; size_t tstride; float qscale;
    __device__ __forceinline__ void operator()(const f32x4 (&acc)[2][2][4][2], const Unit& u, int wr, int wc, int fr, int fq) const {
        const int tok0 = u.pm * BM, b = tok0 >> 12, s0 = (tok0 & 4095) + wr * 64 + fr;
        const int colt = u.pn * BM, t = colt >> 11, hd0 = (colt & 2047) >> 7;
        bf16_t* base = QKV + (size_t)t * tstride; const float sc = t == 0 ? qscale : 1.0f;
#pragma unroll
        for (int bj = 0; bj < 2; ++bj) { bf16_t* hb = base + ((size_t)(b * 16 + hd0 + bj) * 4096 + s0) * 128 + wc * 32 + 8 * fq;
#pragma unroll
            for (int ai = 0; ai < 2; ++ai)
#pragma unroll
                for (int m = 0; m < 4; ++m) { const f32x4 v0 = acc[ai][bj][m][0] * sc, v1 = acc[ai][bj][m][1] * sc;
                    u32x4 w; w.x = cvt_pk_bf16(v0[0], v0[1]); w.y = cvt_pk_bf16(v0[2], v0[3]); w.z = cvt_pk_bf16(v1[0], v1[1]); w.w = cvt_pk_bf16(v1[2], v1[3]);
                    *(u32x4*)(hb + (size_t)(ai * HALF + m * 16) * 128) = w; } }
    }
};
struct EpiRes {
    static constexpr bool PERM = false, AFTER_DRAIN = false;
    const float* xin; float* xout; const float* gate; int gpitch;
    __device__ __forceinline__ void operator()(const f32x4 (&acc)[2][2][4][2], const Unit& u, int wr, int wc, int fr, int fq) const {
        const int row0 = u.pm * BM + wr * 64 + fr, col0 = u.pn * BM + wc * 32 + 4 * fq, b = (u.pm * BM) >> 12;
        f32x4 gv[2][2];
#pragma unroll
        for (int bj = 0; bj < 2; ++bj)
#pragma unroll
            for (int n = 0; n < 2; ++n) gv[bj][n] = *(const f32x4*)(gate + (size_t)b * gpitch + col0 + bj * HALF + n * 16);
#pragma unroll
        for (int ai = 0; ai < 2; ++ai)
#pragma unroll
            for (int m = 0; m < 4; ++m) { const size_t off = (size_t)(row0 + ai * HALF + m * 16) * 2048 + col0;
#pragma unroll
                for (int bj = 0; bj < 2; ++bj)
#pragma unroll
                    for (int n = 0; n < 2; ++n) { const f32x4 xo = *(const f32x4*)(xin + off + bj * HALF + n * 16);
                        *(f32x4*)(xout + off + bj * HALF + n * 16) = xo + gv[bj][n] * acc[ai][bj][m][n]; }
                asm volatile("" ::: "memory"); }
    }
};
template <class Epi, class Sched, bool ALIGN_EPI = false, bool SP2 = false>
__device__ __forceinline__ void gemm_phase(PG8_LAS unsigned char* lds, const Gemm g, const Sched& S, const Epi& E) {
    const int tid = ltid(), wid = __builtin_amdgcn_readfirstlane(tid >> 6), lane = tid & 63, wr = wid >> 2, wc = wid & 3, fr = lane & 15, fq = lane >> 4;
    const int K = g.K, nt = K / BK;
    unsigned voffA[2], voffB[2];
#pragma unroll
    for (int i = 0; i < 2; ++i) { int R, C; stage_rc(tid * 16 + i * 8192, R, C); const int Rb = Epi::PERM ? ((R & ~31) + perm32(R & 31)) : R;
        voffA[i] = (unsigned)(R * K + C) * 2u; voffB[i] = (unsigned)(Rb * K + C) * 2u; }
    const size_t kstep = (size_t)(BK * 2);
    const size_t hstep = (size_t)HALF * K * 2;
    const size_t tstep = 2 * hstep;
    const unsigned ldsw = (unsigned)wid * 1024u;
    const int aoff = lds_byte(wr * 64 + fr, fq * 8), boff = lds_byte(wc * 32 + fr, fq * 8);
#define PG8_SA(b, h) (((b) * 2 + (h)) * HTB)
#define PG8_SB(b, h) ((4 + (b) * 2 + (h)) * HTB)
#define PG8_STAGE(bufoff, gbase, voff) do { _Pragma("unroll") for (int _i = 0; _i < 2; ++_i) \
        __builtin_amdgcn_global_load_lds((const unsigned*)((const char*)(gbase) + (voff)[_i]), (PG8_LAS unsigned*)(lds + (bufoff) + ldsw + _i * 8192), 16, 0, 0); } while (0)
#define PG8_LDA(dst, b, h) do { _Pragma("unroll") for (int m = 0; m < 4; ++m) _Pragma("unroll") for (int k = 0; k < 2; ++k) dst[m][k] = *(const PG8_LAS bf16x8*)(lds + PG8_SA(b, h) + aoff + m * 2048 + k * 1024); } while (0)
#define PG8_LDB(dst, b, h) do { _Pragma("unroll") for (int n = 0; n < 2; ++n) _Pragma("unroll") for (int k = 0; k < 2; ++k) dst[n][k] = *(const PG8_LAS bf16x8*)(lds + PG8_SB(b, h) + boff + n * 2048 + k * 1024); } while (0)
#define PG8_MMA(ai, bj, At, Bt) do { __builtin_amdgcn_s_setprio(1); _Pragma("unroll") for (int m = 0; m < 4; ++m) _Pragma("unroll") for (int n = 0; n < 2; ++n) _Pragma("unroll") for (int k = 0; k < 2; ++k) \
        acc[ai][bj][m][n] = __builtin_amdgcn_mfma_f32_16x16x32_bf16(Bt[n][k], At[m][k], acc[ai][bj][m][n], 0, 0, 0); __builtin_amdgcn_s_setprio(0); } while (0)
#define PG8_WAIT_V(n) asm volatile("s_waitcnt vmcnt(" #n ")" ::: "memory")
#define PG8_WAIT_L(n) asm volatile("s_waitcnt lgkmcnt(" #n ")" ::: "memory")
#define PG8_BAR __builtin_amdgcn_s_barrier()
#define PG8_SCHED __builtin_amdgcn_sched_barrier(0)
    Unit cur, nxt; int ui = 0;
    if (!S.next(0, cur)) return;
    f32x4 acc[2][2][4][2];
#pragma unroll
    for (int a = 0; a < 2; ++a)
#pragma unroll
        for (int b = 0; b < 2; ++b)
#pragma unroll
            for (int m = 0; m < 4; ++m)
#pragma unroll
                for (int n = 0; n < 2; ++n) acc[a][b][m][n] = (f32x4){0.f, 0.f, 0.f, 0.f};
    bf16x8 At[4][2], B0[2][2], B1[2][2];
    const char* cA = (const char*)g.A + (size_t)cur.pm * tstep; const char* cB = (const char*)g.Bt + (size_t)cur.pn * tstep;
    S.a_ready(cur);
    if constexpr (SP2) {
        PG8_STAGE(PG8_SB(0, 0), cB, voffB); PG8_STAGE(PG8_SB(0, 1), cB + hstep, voffB); PG8_STAGE(PG8_SA(0, 0), cA, voffA); PG8_STAGE(PG8_SA(0, 1), cA + hstep, voffA);
        if (wr == 1) PG8_BAR;
        PG8_WAIT_V(2); PG8_BAR;
        PG8_STAGE(PG8_SB(1, 0), cB + kstep, voffB); PG8_STAGE(PG8_SA(1, 0), cA + kstep, voffA); PG8_STAGE(PG8_SB(1, 1), cB + hstep + kstep, voffB);
        PG8_WAIT_V(6); PG8_BAR;
    } else {
        PG8_STAGE(PG8_SB(0, 0), cB, voffB); PG8_STAGE(PG8_SA(0, 0), cA, voffA); PG8_STAGE(PG8_SB(0, 1), cB + hstep, voffB); PG8_STAGE(PG8_SA(0, 1), cA + hstep, voffA);
        if (wr == 1) PG8_BAR;
        PG8_WAIT_V(4); PG8_BAR;
        PG8_STAGE(PG8_SB(1, 0), cB + kstep, voffB); PG8_STAGE(PG8_SA(1, 0), cA + kstep, voffA); PG8_STAGE(PG8_SB(1, 1), cB + hstep + kstep, voffB);
        PG8_WAIT_V(6); PG8_BAR;
    }
    for (;;) {
        const bool has_next = S.next(ui + 1, nxt);
        const char* nA = has_next ? (const char*)g.A + (size_t)nxt.pm * tstep : cA; const char* nB = has_next ? (const char*)g.Bt + (size_t)nxt.pn * tstep : cB;
        for (int t = 0; t < nt; t += 2) {
            const bool last = (t == nt - 2);
            const char* a1 = cA + (size_t)(t + 1) * kstep;
            const char* a2 = last ? nA : cA + (size_t)(t + 2) * kstep; const char* b2 = last ? nB : cB + (size_t)(t + 2) * kstep;
            const char* a3 = a2 + kstep; const char* b3 = b2 + kstep;
            if (last && has_next) S.a_ready(nxt);
            if constexpr (SP2) {
            PG8_LDB(B0, 0, 0); PG8_LDB(B1, 0, 1); PG8_SCHED; PG8_LDA(At, 0, 0); PG8_STAGE(PG8_SA(1, 1), a1 + hstep, voffA);
            PG8_WAIT_V(8); PG8_WAIT_L(0); PG8_BAR; PG8_MMA(0, 0, At, B0); PG8_MMA(0, 1, At, B1); PG8_BAR; PG8_SCHED;
            PG8_LDA(At, 0, 1); PG8_STAGE(PG8_SB(0, 0), b2, voffB); PG8_STAGE(PG8_SB(0, 1), b2 + hstep, voffB); PG8_STAGE(PG8_SA(0, 0), a2, voffA);
            PG8_WAIT_V(8); PG8_WAIT_L(0); PG8_BAR; PG8_MMA(1, 0, At, B0); PG8_MMA(1, 1, At, B1); PG8_BAR; PG8_SCHED;
            PG8_LDB(B0, 1, 0); PG8_LDB(B1, 1, 1); PG8_SCHED; PG8_LDA(At, 1, 0); PG8_STAGE(PG8_SA(0, 1), a2 + hstep, voffA);
            PG8_WAIT_V(8); PG8_WAIT_L(0); PG8_BAR; PG8_MMA(0, 0, At, B0); PG8_MMA(0, 1, At, B1); PG8_BAR; PG8_SCHED;
            PG8_LDA(At, 1, 1); PG8_STAGE(PG8_SB(1, 0), b3, voffB); PG8_STAGE(PG8_SB(1, 1), b3 + hstep, voffB); PG8_STAGE(PG8_SA(1, 0), a3, voffA);
            PG8_WAIT_V(8); PG8_WAIT_L(0); PG8_BAR; PG8_MMA(1, 0, At, B0); PG8_MMA(1, 1, At, B1); PG8_BAR; PG8_SCHED;
            } else {
            PG8_LDB(B0, 0, 0); PG8_SCHED; PG8_LDA(At, 0, 0); PG8_STAGE(PG8_SA(1, 1), a1 + hstep, voffA);
            PG8_WAIT_L(8); PG8_BAR; PG8_WAIT_L(0); PG8_MMA(0, 0, At, B0); PG8_BAR; PG8_SCHED;
            PG8_LDB(B1, 0, 1); PG8_STAGE(PG8_SB(0, 0), b2, voffB);
            PG8_BAR; PG8_WAIT_L(0); PG8_MMA(0, 1, At, B1); PG8_BAR;
            PG8_LDA(At, 0, 1); PG8_STAGE(PG8_SA(0, 0), a2, voffA);
            PG8_BAR; PG8_WAIT_L(0); PG8_MMA(1, 0, At, B0); PG8_BAR; PG8_SCHED;
            PG8_STAGE(PG8_SB(0, 1), b2 + hstep, voffB);
            PG8_WAIT_V(6); PG8_BAR; PG8_MMA(1, 1, At, B1); PG8_BAR;
            PG8_LDB(B0, 1, 0); PG8_SCHED; PG8_LDA(At, 1, 0); PG8_STAGE(PG8_SA(0, 1), a2 + hstep, voffA);
            PG8_WAIT_L(8); PG8_BAR; PG8_WAIT_L(0); PG8_MMA(0, 0, At, B0); PG8_BAR; PG8_SCHED;
            PG8_LDB(B1, 1, 1); PG8_STAGE(PG8_SB(1, 0), b3, voffB);
            PG8_BAR; PG8_WAIT_L(0); PG8_MMA(0, 1, At, B1); PG8_BAR;
            PG8_LDA(At, 1, 1); PG8_STAGE(PG8_SA(1, 0), a3, voffA);
            PG8_BAR; PG8_WAIT_L(0); PG8_MMA(1, 0, At, B0); PG8_BAR; PG8_SCHED;
            PG8_STAGE(PG8_SB(1, 1), b3 + hstep, voffB);
            PG8_WAIT_V(6); PG8_BAR; PG8_MMA(1, 1, At, B1); PG8_BAR;
            }
        }
        if constexpr (ALIGN_EPI) { if (wr == 0) PG8_BAR; }
        if constexpr (!Epi::AFTER_DRAIN) { E(acc, cur, wr, wc, fr, fq); S.done(cur); }
        if (!has_next) break;
#pragma unroll
        for (int a = 0; a < 2; ++a)
#pragma unroll
            for (int b = 0; b < 2; ++b)
#pragma unroll
                for (int m = 0; m < 4; ++m)
#pragma unroll
                    for (int n = 0; n < 2; ++n) acc[a][b][m][n] = (f32x4){0.f, 0.f, 0.f, 0.f};
        cur = nxt; cA = nA; cB = nB; ++ui;
        if constexpr (ALIGN_EPI) { if (wr == 1) PG8_BAR; }
    }
    PG8_WAIT_V(0);
    if constexpr (!ALIGN_EPI) { if (wr == 0) PG8_BAR; }
    PG8_BAR;
    if constexpr (Epi::AFTER_DRAIN) { E.fused(acc, cur, wr, wc, fr, fq, lds, wid, lane); S.done(cur); }
#undef PG8_SA
#undef PG8_SB
#undef PG8_STAGE
#undef PG8_LDA
#undef PG8_LDB
#undef PG8_MMA
#undef PG8_WAIT_V
#undef PG8_WAIT_L
#undef PG8_BAR
#undef PG8_SCHED
}
}
namespace fox {
enum { ORDER_NATURAL = 0, ORDER_REVERSED = 1, ORDER_PAIRED = 2, ORDER_XCD = 4 };
constexpr int B = 8, H = 16, HKV = 16, SQ = 4096, SKV = 4096, D = 128;
constexpr int QOFF = 0;
constexpr int WINDOW = SKV;
constexpr float THR = 8.f;
constexpr bool WSKIP = false;
constexpr float SCALE = 0.08838834764831845f;
constexpr float QSCALE = SCALE * 1.4426950408889634f;
constexpr int NW = 8, QBLK = 32, KVBLK = 64, QB = NW * QBLK;
constexpr int SHM_V = KVBLK * D * 2, SHM_K = KVBLK * D * 2;
constexpr int LDS_FB = 2 * SHM_V + 2 * SHM_K + NW * 64 * 4;
constexpr int LDS_BYTES = LDS_FB + SKV * 4;
constexpr int OPITCH = H * D;
using bf16 = __hip_bfloat16;
typedef short bf16x8 __attribute__((ext_vector_type(8)));
typedef short s16x4 __attribute__((ext_vector_type(4)));
typedef float f32x16 __attribute__((ext_vector_type(16)));
typedef float f32x4 __attribute__((ext_vector_type(4)));
typedef unsigned u32x4 __attribute__((ext_vector_type(4)));
template <class A, class Bt> struct same_t { static constexpr bool v = false; };
template <class A> struct same_t<A, A> { static constexpr bool v = true; };

#define KSWZ(row, colB) ((row) * 256 + ((colB) ^ (((row) & 7) << 4)))
#define SBAR() __builtin_amdgcn_sched_barrier(0)
__device__ __forceinline__ int v_st(int k, int c) { const int kk = (k & ~0xC) | ((k & 4) << 1) | ((k & 8) >> 1); return ((kk >> 3) * 4 + (c >> 5)) * 512 + ((kk & 7) * 32 + (c & 31)) * 2; }
__device__ __forceinline__ int v_rd_base(int lane) { return ((lane & 3) << 3) | (((lane >> 2) & 3) << 6) | (((lane >> 4) & 1) << 5) | (((lane >> 5) & 1) << 8); }
constexpr int v_rd_off(int d0, int ks, int half) { return d0 * 512 + ks * 4096 + half * 2048; }
__device__ __forceinline__ int crow(int r, int hi) { return (r & 3) + 8 * (r >> 2) + 4 * hi; }
__device__ __forceinline__ unsigned cvtpk(float lo, float hi) {
    unsigned r; asm volatile("v_cvt_pk_bf16_f32 %0, %1, %2" : "=v"(r) : "v"(lo), "v"(hi)); return r;
}
__device__ __forceinline__ bf16x8 pack8(f32x4 a, f32x4 b) {
    u32x4 w = {cvtpk(a[0], a[1]), cvtpk(a[2], a[3]), cvtpk(b[0], b[1]), cvtpk(b[2], b[3])};
    return *reinterpret_cast<bf16x8*>(&w);
}
template <class T> __device__ __forceinline__ bf16x8 load8(const T* p) {
    if constexpr (same_t<T, float>::v) { return pack8(*(const f32x4*)p, *(const f32x4*)(p + 4)); }
    else { return *reinterpret_cast<const bf16x8*>(p); }
}
__device__ __forceinline__ void mask_tile(f32x16& p0, f32x16& p1, int dq, unsigned W) {
    const float NEG = -__builtin_inff();
#pragma unroll
    for (int r = 0; r < 16; ++r) {
        const int c = (r & 3) + 8 * (r >> 2);
        if ((unsigned)(dq - c) >= W) p0[r] = NEG;
        if ((unsigned)(dq - c - 32) >= W) p1[r] = NEG;
    }
}
__device__ __forceinline__ void partialSM(f32x16& p0, f32x16& p1, float& m_reg, float& mn, float& alpha) {
    float pmax = p0[0]; for (int r = 1; r < 16; ++r) pmax = fmaxf(pmax, p0[r]); for (int r = 0; r < 16; ++r) pmax = fmaxf(pmax, p1[r]);
    { auto rr = __builtin_amdgcn_permlane32_swap(__float_as_uint(pmax), __float_as_uint(pmax), false, false);
      pmax = fmaxf(__uint_as_float(rr[0]), __uint_as_float(rr[1])); }
    constexpr float THR2 = THR * 1.4426950408889634f;
    if (__builtin_expect(__all((pmax - m_reg) <= THR2), 1)) { mn = m_reg; alpha = 1.f; }
    else { mn = fmaxf(m_reg, pmax); alpha = __builtin_amdgcn_exp2f(m_reg - mn); m_reg = mn; }
    for (int r = 0; r < 16; ++r) p0[r] = p0[r] - mn; for (int r = 0; r < 16; ++r) p1[r] = p1[r] - mn;
    for (int r = 0; r < 16; ++r) p0[r] = __builtin_amdgcn_exp2f(p0[r]);
}
__device__ __forceinline__ void finishSM(f32x16& p0, f32x16& p1, float alpha, float& l_reg, bf16x8& pa0, bf16x8& pa1, bf16x8& pa2, bf16x8& pa3) {
    for (int r = 0; r < 16; ++r) p1[r] = __builtin_amdgcn_exp2f(p1[r]);
    float ps = 0; for (int r = 0; r < 16; ++r) ps += p0[r]; for (int r = 0; r < 16; ++r) ps += p1[r];
    { auto rr = __builtin_amdgcn_permlane32_swap(__float_as_uint(ps), __float_as_uint(ps), false, false);
      ps = __uint_as_float(rr[0]) + __uint_as_float(rr[1]); }
    l_reg = l_reg * alpha + ps;
#define PK4(P, B_, OUT) do { unsigned a0 = cvtpk(P[B_+0], P[B_+1]), a1 = cvtpk(P[B_+2], P[B_+3]);                          \
        unsigned b0 = cvtpk(P[B_+4], P[B_+5]), b1 = cvtpk(P[B_+6], P[B_+7]);                                             \
        auto r0 = __builtin_amdgcn_permlane32_swap(a0, b0, false, false); auto r1 = __builtin_amdgcn_permlane32_swap(a1, b1, false, false); \
        u32x4 w = {r0[0], r1[0], r0[1], r1[1]}; OUT = *reinterpret_cast<bf16x8*>(&w); } while (0)
    PK4(p0, 0, pa0); PK4(p0, 8, pa1); PK4(p1, 0, pa2); PK4(p1, 8, pa3);
#undef PK4
}
template <int KB, bool SK>
__device__ __forceinline__ void qkt(f32x16& p0, f32x16& p1, const char* K_lds, int r32, int hi, const bf16x8* qr, bool act, const char* fb) {
    if (SK && !act) { const float NEG = -__builtin_inff();
#pragma unroll
        for (int r = 0; r < 16; ++r) { p0[r] = NEG; p1[r] = NEG; } return; }
#pragma unroll
    for (int q = 0; q < 4; ++q) { const f32x4 b0 = *reinterpret_cast<const f32x4*>(fb + q * 32), b1 = *reinterpret_cast<const f32x4*>(fb + 128 + q * 32);
#pragma unroll
        for (int i = 0; i < 4; ++i) { p0[4 * q + i] = b0[i]; p1[4 * q + i] = b1[i]; } }
    const char* kb[4];
#pragma unroll
    for (int dd = 0; dd < 4; ++dd) kb[dd] = K_lds + KB * SHM_K + KSWZ(r32, (dd * 16 + hi * 8) * 2);
#pragma unroll
    for (int d0 = 0; d0 < 8; ++d0) { const char* a = kb[d0 & 3] + (d0 >> 2) * 128;
        bf16x8 b0 = *reinterpret_cast<const bf16x8*>(a);
        bf16x8 b1 = *reinterpret_cast<const bf16x8*>(a + 32 * 256);
        p0 = __builtin_amdgcn_mfma_f32_32x32x16_bf16(b0, qr[d0], p0, 0, 0, 0);
        p1 = __builtin_amdgcn_mfma_f32_32x32x16_bf16(b1, qr[d0], p1, 0, 0, 0); }
}
template <int VB, bool SK>
__device__ __forceinline__ void pv_tile(f32x16* o, int vb0, bf16x8 pa0, bf16x8 pa1, bf16x8 pa2, bf16x8 pa3, bool act) {
    if (SK && !act) return;
#define TRRD(dst, off) asm volatile("ds_read_b64_tr_b16 %0, %1 offset:%2" : "=&v"(dst) : "v"(vb0), "i"(off) : "memory")
#define PV_D0(d0) do { s16x4 l0, l1, l2, l3, h0, h1, h2, h3; constexpr int b_ = VB * SHM_V + v_rd_off(d0, 0, 0);     \
        TRRD(l0, b_); TRRD(h0, b_ + 2048); TRRD(l1, b_ + 4096); TRRD(h1, b_ + 6144); TRRD(l2, b_ + 8192); TRRD(h2, b_ + 10240); TRRD(l3, b_ + 12288); TRRD(h3, b_ + 14336); \
        asm volatile("s_waitcnt lgkmcnt(0)" ::: "memory"); SBAR();                 \
        o[d0] = __builtin_amdgcn_mfma_f32_32x32x16_bf16(pa0, (bf16x8){l0[0], l0[1], l0[2], l0[3], h0[0], h0[1], h0[2], h0[3]}, o[d0], 0, 0, 0);   \
        o[d0] = __builtin_amdgcn_mfma_f32_32x32x16_bf16(pa1, (bf16x8){l1[0], l1[1], l1[2], l1[3], h1[0], h1[1], h1[2], h1[3]}, o[d0], 0, 0, 0);   \
        o[d0] = __builtin_amdgcn_mfma_f32_32x32x16_bf16(pa2, (bf16x8){l2[0], l2[1], l2[2], l2[3], h2[0], h2[1], h2[2], h2[3]}, o[d0], 0, 0, 0);   \
        o[d0] = __builtin_amdgcn_mfma_f32_32x32x16_bf16(pa3, (bf16x8){l3[0], l3[1], l3[2], l3[3], h3[0], h3[1], h3[2], h3[3]}, o[d0], 0, 0, 0); } while (0)
    PV_D0(0); PV_D0(1); PV_D0(2); PV_D0(3);
#undef PV_D0
#undef TRRD
}
template <class TIn, class TOut> struct BlockRef { const TIn* Q; const TIn* K; const TIn* V; TOut* O; const float* FB; int P0; };
template <class TIn> struct Seam {
    bf16x8 qr[8];
    bf16x8 st_v0, st_v1, st_k0, st_k1; f32x4 sf0, sf1, sf2, sf3;
    f32x4 tq[16];
};
__device__ __forceinline__ int swa_jlo(int P0, int W) { const int lowk = P0 - W + 1; return lowk > 0 ? lowk / KVBLK : 0; }
#define ROW(p, k0, rr) ((p) + (size_t)((k0) + (rr)) * D + sc)
#define VMW() asm volatile("s_waitcnt vmcnt(0)" ::: "memory")
#define VMWN(n) asm volatile("s_waitcnt vmcnt(%0)" :: "i"(n) : "memory")
#define SLOAD_H(Kp, Vp, k0) do { S.st_v0 = load8<TIn>(ROW(Vp, k0, sr)); S.st_v1 = load8<TIn>(ROW(Vp, k0, 32 + sr));              \
                         S.st_k0 = load8<TIn>(ROW(Kp, k0, sr)); S.st_k1 = load8<TIn>(ROW(Kp, k0, 32 + sr)); } while (0)
#define SWRITE_HK(bf) do { *(bf16x8*)(K_lds + (bf) * SHM_K + kws) = S.st_k0; *(bf16x8*)(K_lds + (bf) * SHM_K + kws + 32 * 256) = S.st_k1; } while (0)
#define SWRITE_HV(bf) do { *(bf16x8*)(V_lds + (bf) * SHM_V + vst0) = S.st_v0; *(bf16x8*)(V_lds + (bf) * SHM_V + vst1) = S.st_v1; } while (0)
#define SWRITE_H(bf) do { SWRITE_HV(bf); SWRITE_HK(bf); } while (0)
#define SLOAD_F(p, k0) do { S.sf0 = *(const f32x4*)ROW(p, k0, sr); S.sf1 = *(const f32x4*)(ROW(p, k0, sr) + 4);                \
                            S.sf2 = *(const f32x4*)ROW(p, k0, 32 + sr); S.sf3 = *(const f32x4*)(ROW(p, k0, 32 + sr) + 4); } while (0)
#define SWRITE_KF(bf) do { *(bf16x8*)(K_lds + (bf) * SHM_K + kws) = pack8(S.sf0, S.sf1); *(bf16x8*)(K_lds + (bf) * SHM_K + kws + 32 * 256) = pack8(S.sf2, S.sf3); } while (0)
#define SWRITE_VF(bf) do { *(bf16x8*)(V_lds + (bf) * SHM_V + vst0) = pack8(S.sf0, S.sf1); *(bf16x8*)(V_lds + (bf) * SHM_V + vst1) = pack8(S.sf2, S.sf3); } while (0)
template <class TIn, class TOut>
__device__ __forceinline__ void causal_swa_prime(const BlockRef<TIn, TOut>& cur, int W, char* lds, Seam<TIn>& S) {
    constexpr bool F32 = same_t<TIn, float>::v;
    const int tid = ltid(), wid = __builtin_amdgcn_readfirstlane(tid >> 6), lane = tid & 63, r32 = lane & 31, hi = lane >> 5;
    const int sr = tid >> 4, sc = (tid & 15) * 8, kws = KSWZ(sr, sc * 2); char* K_lds = lds + 2 * SHM_V;
    const int kb0 = swa_jlo(cur.P0, W) * KVBLK;
    for (int d0 = 0; d0 < 8; ++d0) S.qr[d0] = load8<TIn>(cur.Q + (size_t)(wid * QBLK + r32) * D + d0 * 16 + hi * 8);
    if constexpr (F32) { SLOAD_F((const float*)cur.K, kb0); VMW(); SWRITE_KF(0); SBAR(); SLOAD_F((const float*)cur.V, kb0); }
    else { SLOAD_H(cur.K, cur.V, kb0); VMW(); SWRITE_HK(0); }
    __syncthreads();
}
template <class TIn, class TOut>
__device__ __forceinline__ void causal_swa_block(const BlockRef<TIn, TOut>& cur, const BlockRef<TIn, TOut>& nxt, int skv, int W, char* lds, Seam<TIn>& S) {
    constexpr bool F32 = same_t<TIn, float>::v;
    const int tid = ltid(), wid = __builtin_amdgcn_readfirstlane(tid >> 6), lane = tid & 63, r32 = lane & 31, hi = lane >> 5;
    const int j_lo = swa_jlo(cur.P0, W);
    int j_hi = (cur.P0 + QB - 1) / KVBLK + 1; if (j_hi > skv / KVBLK) j_hi = skv / KVBLK;
    const int NT = j_hi - j_lo;
    const int kbn = swa_jlo(nxt.P0, W) * KVBLK;
    const int qlo = cur.P0 + wid * QBLK, qm = qlo + r32 - 4 * hi;
    char* V_lds = lds; char* K_lds = lds + 2 * SHM_V;
    float* ws = (float*)(lds + 2 * SHM_V + 2 * SHM_K) + wid * 64; float* li_l = ws, * al_l = ws + 32;
    float m_reg = -1e30f, l_reg = 0; f32x16 o[4] = {};
    float* fbuf = (float*)(lds + LDS_FB);
    { const int nk = cur.P0 + QB;
      for (int i4 = tid * 4; i4 < nk; i4 += 64 * NW * 4) *(f32x4*)(fbuf + i4) = *(const f32x4*)(cur.FB + i4);
      __syncthreads(); }
    const char* fbl = (const char*)fbuf + hi * 16;
    const int sr = tid >> 4, sc = (tid & 15) * 8, vst0 = v_st(sr, sc), vst1 = v_st(32 + sr, sc), kws = KSWZ(sr, sc * 2);
    const int vb0 = (int)(uintptr_t)V_lds + v_rd_base(lane);
    const TIn* Kh = cur.K; const TIn* Vh = cur.V;
#define RESC(a) do { if (__any((a) < 1.f)) { if (hi == 0) al_l[r32] = (a); asm volatile("s_waitcnt lgkmcnt(0)" ::: "memory");              \
                     for (int d_ = 0; d_ < 4; ++d_) for (int r = 0; r < 16; ++r) o[d_][r] *= al_l[crow(r, hi)]; } } while (0)
#define KBASE(t) ((j_lo + (t)) * KVBLK)
#define ACT(t) (KBASE(t) <= qlo + QBLK - 1 && KBASE(t) + KVBLK - 1 >= qlo - W + 1)
#define MASKT(P0_, P1_, t) do { const int kb_ = KBASE(t); if ((!SK || ACT(t)) && (kb_ + KVBLK - 1 > qlo || kb_ <= qlo + QBLK - 1 - W)) mask_tile(P0_, P1_, qm - kb_, (unsigned)W); } while (0)
    constexpr int NQL = F32 ? 16 : 8;
    constexpr bool SK = WSKIP && !F32;
#define SEAM_K0() do { VMWN(NQL); if constexpr (F32) { SWRITE_KF(0); SBAR(); SLOAD_F((const float*)nxt.V, kbn); } else { SWRITE_HK(0); } SBAR(); } while (0)
    f32x16 pA0, pA1, pB0, pB1; float mnA, mnB, alA, alB; bf16x8 pa0, pa1, pa2, pa3;
    if constexpr (F32) { VMW(); SWRITE_VF(0); SBAR(); } else { SWRITE_HV(0); SBAR(); }
    if (NT > 1) { if constexpr (F32) SLOAD_F((const float*)Kh, KBASE(1)); else SLOAD_H(Kh, Vh, KBASE(1)); }
    SBAR(); qkt<0, SK>(pA0, pA1, K_lds, r32, hi, S.qr, ACT(0), fbl + KBASE(0) * 4);
    if constexpr (F32) { if (NT > 1) { VMW(); SWRITE_KF(1); SBAR(); SLOAD_F((const float*)Vh, KBASE(1)); } }
    MASKT(pA0, pA1, 0); partialSM(pA0, pA1, m_reg, mnA, alA);
    if (NT > 1) { VMW(); if constexpr (F32) { SWRITE_VF(1); SBAR(); if (NT > 2) SLOAD_F((const float*)Kh, KBASE(2)); } else SWRITE_H(1); }
    __syncthreads();
#define HALF_STEP(PX0, PX1, mnX, alX, PY0, PY1, alY, t, KB, VB, SB) do {                                                      \
        SBAR(); qkt<KB, SK>(PX0, PX1, K_lds, r32, hi, S.qr, ACT(t), fbl + KBASE(t) * 4);                                             \
        finishSM(PY0, PY1, alY, l_reg, pa0, pa1, pa2, pa3); SBAR();                                                           \
        if ((t) + 1 < NT) { if constexpr (F32) { VMW(); SWRITE_KF(SB); SBAR(); SLOAD_F((const float*)Vh, KBASE((t) + 1)); }  \
                            else { SLOAD_H(Kh, Vh, KBASE((t) + 1)); } SBAR(); }                                               \
        pv_tile<VB, SK>(o, vb0, pa0, pa1, pa2, pa3, ACT((t) - 1)); MASKT(PX0, PX1, (t)); partialSM(PX0, PX1, m_reg, mnX, alX);                                        \
        __syncthreads();                                                                                                      \
        if ((t) + 1 < NT) { VMW(); if constexpr (F32) { SWRITE_VF(SB); SBAR(); if ((t) + 2 < NT) SLOAD_F((const float*)Kh, KBASE((t) + 2)); } \
                            else { SWRITE_H(SB); } }                                                                          \
        RESC(alX); __syncthreads(); } while (0)
    for (int t = 1; t + 1 < NT; t += 2) {
        HALF_STEP(pB0, pB1, mnB, alB, pA0, pA1, alA, t, 1, 0, 0);
        HALF_STEP(pA0, pA1, mnA, alA, pB0, pB1, alB, t + 1, 0, 1, 1);
    }
    const bool even = (NT & 1) == 0;
    if (even) { SBAR(); qkt<1, SK>(pB0, pB1, K_lds, r32, hi, S.qr, ACT(NT - 1), fbl + KBASE(NT - 1) * 4); SBAR(); }
#define QROW(e) (nxt.Q + (size_t)(wid * QBLK + r32) * D + ((e) >> 1) * 16 + hi * 8 + ((e) & 1) * 4)
    if constexpr (F32) { SLOAD_F((const float*)nxt.K, kbn); SBAR();
#pragma unroll
        for (int e = 0; e < 8; ++e) S.tq[e] = *(const f32x4*)QROW(e); }
    else { SLOAD_H(nxt.K, nxt.V, kbn); SBAR();
#pragma unroll
        for (int d0 = 0; d0 < 8; ++d0) S.qr[d0] = load8<TIn>(nxt.Q + (size_t)(wid * QBLK + r32) * D + d0 * 16 + hi * 8); }
    SBAR();
    finishSM(pA0, pA1, alA, l_reg, pa0, pa1, pa2, pa3); SBAR();
    if constexpr (F32) {
#pragma unroll
        for (int e = 8; e < 16; ++e) S.tq[e] = *(const f32x4*)QROW(e); SBAR(); }
#undef QROW
    pv_tile<0, SK>(o, vb0, pa0, pa1, pa2, pa3, ACT(even ? NT - 2 : NT - 1));
    if (even) { MASKT(pB0, pB1, NT - 1); partialSM(pB0, pB1, m_reg, mnB, alB); __syncthreads(); RESC(alB);
        finishSM(pB0, pB1, alB, l_reg, pa0, pa1, pa2, pa3); SBAR(); pv_tile<1, SK>(o, vb0, pa0, pa1, pa2, pa3, ACT(NT - 1)); }
    SBAR(); SEAM_K0();
    if (hi == 0) li_l[r32] = l_reg; asm volatile("s_waitcnt lgkmcnt(0)" ::: "memory");
    float rli[16];
#pragma unroll
    for (int r = 0; r < 16; ++r) rli[r] = __builtin_amdgcn_rcpf(li_l[crow(r, hi)]);
    TOut* Ow = cur.O + (size_t)(wid * QBLK) * OPITCH;
#pragma unroll
    for (int r = 0; r < 16; ++r) { const int orow = crow(r, hi);
#pragma unroll
        for (int d0 = 0; d0 < 4; ++d0) { const float v = o[d0][r] * rli[r];
            if constexpr (same_t<TOut, float>::v) { Ow[(size_t)orow * OPITCH + d0 * 32 + r32] = v; }
            else { const float vn = __shfl_xor(v, 1);
                   if ((r32 & 1) == 0) *(unsigned*)(Ow + (size_t)orow * OPITCH + d0 * 32 + r32) = cvtpk(v, vn); } } }
    if constexpr (F32) {
#pragma unroll
        for (int d0 = 0; d0 < 8; ++d0) S.qr[d0] = pack8(S.tq[2 * d0], S.tq[2 * d0 + 1]); }
    __syncthreads();
#undef RESC
#undef KBASE
#undef ACT
#undef MASKT
#undef SEAM_K0
#undef HALF_STEP
}
#undef ROW
#undef VMW
#undef VMWN
#undef SLOAD_H
#undef SWRITE_HK
#undef SWRITE_HV
#undef SWRITE_H
#undef SLOAD_F
#undef SWRITE_KF
#undef SWRITE_VF
constexpr int NQB = SQ / QB, NXI = NQB / 2, NITEMS = NXI * B * H;
struct SwaItem { int bh, qb0, qb1; };
__device__ __forceinline__ SwaItem swa_decode(int L) { SwaItem it; it.bh = L / NXI; const int x = L - it.bh * NXI; it.qb0 = x; it.qb1 = NQB - 1 - x; return it; }
template <class TIn, class TOut>
__device__ __forceinline__ BlockRef<TIn, TOut> swa_ref(const SwaItem& it, int pass, const TIn* Q, const TIn* K, const TIn* V, TOut* O, const float* FB) {
    const int qb = pass ? it.qb1 : it.qb0;
    BlockRef<TIn, TOut> r;
    r.Q = Q + ((size_t)it.bh * SQ + (size_t)qb * QB) * D;
    r.O = O + ((size_t)(it.bh / H) * SQ + (size_t)qb * QB) * OPITCH + (it.bh % H) * D;
    r.K = K + (size_t)it.bh * SKV * D; r.V = V + (size_t)it.bh * SKV * D; r.FB = FB + (size_t)it.bh * SKV; r.P0 = qb * QB;
    return r;
}
__device__ __forceinline__ void att_phase(char* lds, const bf16* Q, const bf16* K, const bf16* V, bf16* O, const float* FB, int wg, int nwg) {
    int L = wg; if (L >= NITEMS) return;
    SwaItem it = swa_decode(L); int pass = 0;
    BlockRef<bf16, bf16> cur = swa_ref<bf16, bf16>(it, 0, Q, K, V, O, FB);
    Seam<bf16> S;
    causal_swa_prime<bf16, bf16>(cur, WINDOW, lds, S);
    for (;;) {
        const bool more_pass = pass == 0 && it.qb1 != it.qb0, more_item = L + nwg < NITEMS, last = !more_pass && !more_item;
        SwaItem itn = it; int passn = pass + 1, Ln = L;
        if (!more_pass) { passn = 0; Ln = more_item ? L + nwg : L; itn = swa_decode(Ln); }
        const BlockRef<bf16, bf16> nxt = last ? cur : swa_ref<bf16, bf16>(itn, passn, Q, K, V, O, FB);
        causal_swa_block<bf16, bf16>(cur, nxt, SKV, WINDOW, lds, S);
        if (last) break;
        cur = nxt; it = itn; pass = passn; L = Ln;
    }
}
}
constexpr int DM = 2048, NBATCH = 8, SEQ = 4096, DEPTH = 4, NHEAD = 16, HDIM = 128, DFF = 5504, NFF2 = 2 * DFF, MTOK = NBATCH * SEQ;
constexpr int NQKVF = 3 * DM + NHEAD;
constexpr float EPS = 1e-6f;
constexpr int NWAVES = 8;
#ifndef MK_PER_PHASE
#define MK_PER_PHASE 1
#endif
constexpr size_t MiB = 1u << 20;
constexpr size_t WS_CTL = 0, CTL_ZERO_BYTES = 1 * MiB;
constexpr size_t WS_MOD = 1 * MiB;
constexpr size_t WS_LOGF = 3 * MiB;
constexpr size_t WS_FB = 5 * MiB;
constexpr size_t WS_VRSTD = 7 * MiB;
constexpr size_t WS_WF = 7 * MiB + 512 * 1024;
constexpr size_t WS_WQKV = 8 * MiB;
constexpr size_t WS_WO = 56 * MiB;
constexpr size_t WS_WGI = 72 * MiB;
constexpr size_t WS_WGO = 104 * MiB;
constexpr size_t WS_WF1 = 120 * MiB;
constexpr size_t WS_WF2 = 292 * MiB;
constexpr size_t WS_H = 378 * MiB;
constexpr size_t WS_R = 506 * MiB;
constexpr size_t WS_END = WS_R + 688 * MiB;
constexpr int CW_TMO = 0, CW_BAR = 4096;

constexpr int RING_OFF = 0, RING_BYTES = 131072;
constexpr int LDSCTL_OFF = 143360, MISC_OFF = LDSCTL_OFF + 320;
constexpr int LDS_BYTES = 147456;

#define GAS __attribute__((address_space(1)))
#define LAS __attribute__((address_space(3)))
typedef unsigned short bf16;
typedef unsigned v4u __attribute__((ext_vector_type(4)));
typedef unsigned v2u __attribute__((ext_vector_type(2)));
typedef float f32x4 __attribute__((ext_vector_type(4)));
typedef short bf16x8 __attribute__((ext_vector_type(8)));
typedef GAS unsigned gu32;
#define RLX_AGENT __ATOMIC_RELAXED, __HIP_MEMORY_SCOPE_AGENT
#define LDS_WAIT() asm volatile("s_waitcnt lgkmcnt(0)" ::: "memory")
#define VM_WAIT() asm volatile("s_waitcnt vmcnt(0)" ::: "memory")
__device__ __forceinline__ unsigned f2bf(float f) { unsigned u = __builtin_bit_cast(unsigned, f); return (u + 0x7fffu + ((u >> 16) & 1u)) >> 16; }
__device__ __forceinline__ unsigned pk2(float lo, float hi) { return f2bf(lo) | (f2bf(hi) << 16); }
__device__ __forceinline__ float bf2f(unsigned short b) { return __builtin_bit_cast(float, (unsigned)b << 16); }
__device__ __forceinline__ float bflo(unsigned w) { return __builtin_bit_cast(float, w << 16); }
__device__ __forceinline__ float bfhi(unsigned w) { return __builtin_bit_cast(float, w & 0xffff0000u); }
#define XB_TMO      128
#define XB_XCNT(j)  (256  + 64 * (j))
#define XB_XSUB(j)  (1280 + 64 * (j))
#define XB_XGEN(j)  (2304 + 64 * (j))
#define XB_TOP      3328
#define XB_TOPGEN   3392
#define XCD_BAR_WORDS 3456
#define XB_SPIN_CAP (1u << 18)

__device__ __forceinline__ unsigned xb_ld(unsigned* p)              { return __hip_atomic_load(p, __ATOMIC_RELAXED, __HIP_MEMORY_SCOPE_AGENT); }
__device__ __forceinline__ unsigned xb_add(unsigned* p, unsigned v) { return __hip_atomic_fetch_add(p, v, __ATOMIC_RELAXED, __HIP_MEMORY_SCOPE_AGENT); }
__device__ __forceinline__ unsigned xb_xcc_id() { return (unsigned)__builtin_amdgcn_s_getreg((3 << 11) | 20) & 0xFu; }
#define XB_SPIN(cond, bar) do { unsigned _sp = 0; while (cond) { __builtin_amdgcn_s_sleep(1); \
    if ((++_sp & 255u) == 0u) { if (xb_ld(&(bar)[XB_TMO])) break; if (_sp > XB_SPIN_CAP) { atomicAdd(&(bar)[XB_TMO], 1u); break; } } } } while (0)

struct XcdBarrier {
    unsigned* bar; unsigned x;
    volatile LAS unsigned* st;
};

__device__ __forceinline__ XcdBarrier xcd_barrier_post(unsigned* bar, volatile LAS unsigned* st) {
    XcdBarrier b; b.bar = bar; b.x = xb_xcc_id(); b.st = st;
    if (threadIdx.x == 0) (void)xb_add(&bar[XB_XCNT(b.x)], 1u);
    return b;
}
__device__ __forceinline__ void xcd_barrier_complete(unsigned* bar, unsigned x, unsigned& nloc, unsigned& nx) {
    const unsigned G = gridDim.x * gridDim.y * gridDim.z;
    unsigned sum, cnt, mine, sp = 0u;
    for (;;) {
        sum = 0u; cnt = 0u; mine = 0u;
#pragma unroll
        for (unsigned j = 0; j < 16; ++j) { const unsigned c = xb_ld(&bar[XB_XCNT(j)]); sum += c; cnt += (c > 0u) ? 1u : 0u; mine = (j == x) ? c : mine; }
        if (sum == G) break;
        __builtin_amdgcn_s_sleep(1);
        if ((++sp & 255u) == 0u) { if (xb_ld(&bar[XB_TMO])) break; if (sp > XB_SPIN_CAP) { atomicAdd(&bar[XB_TMO], 1u); break; } }
    }
    nloc = mine > 0u ? mine : 1u; nx = cnt > 0u ? cnt : 1u;
}

__device__ __forceinline__ void xcd_barrier(const XcdBarrier& b) {
    asm volatile("s_waitcnt vmcnt(0)" ::: "memory");
    __syncthreads();
    if (threadIdx.x == 0) {
        unsigned* bar = b.bar;
        __builtin_amdgcn_s_waitcnt(0);
        unsigned nloc = b.st[0], nx = b.st[1];
        if (nloc == 0u) { xcd_barrier_complete(bar, b.x, nloc, nx); b.st[0] = nloc; b.st[1] = nx; }
        const unsigned old = xb_add(&bar[XB_XSUB(b.x)], 1u);
        const unsigned gen = old / nloc;
        if (old + 1u == (gen + 1u) * nloc) {
            __builtin_amdgcn_fence(__ATOMIC_RELEASE, "agent");
            asm volatile("s_waitcnt vmcnt(0)" ::: "memory");
            const unsigned og = xb_add(&bar[XB_TOP], 1u);
            const unsigned tg = og / nx;
            if (og + 1u == (tg + 1u) * nx) xb_add(&bar[XB_TOPGEN], 1u);
            else XB_SPIN(xb_ld(&bar[XB_TOPGEN]) == tg, bar);
            __builtin_amdgcn_fence(__ATOMIC_ACQUIRE, "agent");
            xb_add(&bar[XB_XGEN(b.x)], 1u);
            asm volatile("s_waitcnt vmcnt(0)" ::: "memory");
        } else {
            XB_SPIN(xb_ld(&bar[XB_XGEN(b.x)]) == gen, bar);
            __builtin_amdgcn_fence(__ATOMIC_ACQUIRE, "agent");
            asm volatile("s_waitcnt vmcnt(0)" ::: "memory");
        }
    }
    __syncthreads();
}
struct Frame {
    LAS unsigned char* lds; char* ldsg;
    volatile LAS unsigned* MISC;
    gu32* ctl;
    int tid, lane, wave, vcu, G, bid;
    const GAS float* const __attribute__((address_space(4)))* inp;
    GAS float* outg; GAS unsigned char* wsg;
    __device__ __forceinline__ const float* in(int i) const { return (const float*)inp[i]; }
};
enum { IN_X = 0, IN_C, IN_MODW, IN_MODB, IN_MIXG, IN_FFNG, IN_AWIN, IN_ABF, IN_AWO, IN_GWIN, IN_GVG, IN_GWS, IN_GBS, IN_GWO, IN_FWIN, IN_FCW, IN_FCB, IN_FWOUT, IN_FING };
__device__ __forceinline__ bool relaunder(Frame& F) { int t = F.tid; asm volatile("" : "+v"(t)); F.tid = t; F.lane = t & 63;
    asm volatile("" : "+s"(F.bid), "+s"(F.G), "+s"(F.vcu), "+s"(F.wave)); asm volatile("" : "+s"(F.inp), "+s"(F.wsg), "+s"(F.outg)); return true; }
__device__ __forceinline__ float wave_sum(float v) {
#pragma unroll
    for (int o = 1; o < 64; o <<= 1) v += __shfl_xor(v, o);
    return v;
}
__device__ __forceinline__ void transpose_item(const float* W, int ldw, int K, bf16* WT, int k0, int n0, int dst_row0, int ncols, LAS float* scr, int lane) {
    const int nl = lane & 31;
#pragma unroll 8
    for (int i = 0; i < 32; ++i) { const int kk = 2 * i + (lane >> 5); if (nl < ncols) scr[kk * 33 + nl] = W[(size_t)(k0 + kk) * ldw + n0 + nl]; }
    LDS_WAIT(); asm volatile("" ::: "memory");
    const int c = lane & 7;
#pragma unroll
    for (int j = 0; j < 4; ++j) { const int n = (lane >> 3) + 8 * j; const LAS float* s = scr + (8 * c) * 33 + n;
        if (n < ncols) { v4u o; o.x = pk2(s[0 * 33], s[1 * 33]); o.y = pk2(s[2 * 33], s[3 * 33]); o.z = pk2(s[4 * 33], s[5 * 33]); o.w = pk2(s[6 * 33], s[7 * 33]);
            *(GAS v4u*)(WT + (size_t)(dst_row0 + n) * K + k0 + 8 * c) = o; } }
    LDS_WAIT(); asm volatile("" ::: "memory");
}
__device__ __forceinline__ void pro_phase(Frame& F) {
    {
        LAS float* cact = (LAS float*)(F.lds + RING_OFF);
        LAS float* red = (LAS float*)(F.lds + RING_OFF + 65536);
        float* mod = (float*)((unsigned char*)F.wsg + WS_MOD);
        for (int item = F.bid; item < 192; item += F.G) {
            for (int idx = F.tid; idx < NBATCH * DM; idx += NWAVES * 64) { const int b = idx >> 11, k = idx & 2047; const float v = F.in(IN_C)[idx]; cact[k * 8 + b] = v / (1.0f + __expf(-v)); }
            __syncthreads();
            const int i = item / 48, nbase = (item % 48) * 256;
            const float* wp = F.in(IN_MODW) + ((size_t)i * DM + F.wave * 256) * 12288 + nbase + F.lane * 4;
            f32x4 acc[8];
#pragma unroll
            for (int b = 0; b < 8; ++b) acc[b] = (f32x4){0.f, 0.f, 0.f, 0.f};
#pragma unroll 8
            for (int kk = 0; kk < 256; ++kk) {
                const f32x4 w = *(const GAS f32x4*)(wp + (size_t)kk * 12288);
                const LAS f32x4* cp = (const LAS f32x4*)(cact + (F.wave * 256 + kk) * 8);
                const f32x4 c0 = cp[0], c1 = cp[1];
                acc[0] += w * c0.x; acc[1] += w * c0.y; acc[2] += w * c0.z; acc[3] += w * c0.w;
                acc[4] += w * c1.x; acc[5] += w * c1.y; acc[6] += w * c1.z; acc[7] += w * c1.w;
            }
#pragma unroll
            for (int b = 0; b < 8; ++b) *(LAS f32x4*)(red + (F.wave * 8 + b) * 256 + F.lane * 4) = acc[b];
            __syncthreads();
            for (int o = F.tid; o < 2048; o += NWAVES * 64) { const int b = o >> 8, col = o & 255; float s = 0.f;
#pragma unroll
                for (int w = 0; w < 8; ++w) s += red[(w * 8 + b) * 256 + col];
                mod[((size_t)i * 8 + b) * 12288 + nbase + col] = s + F.in(IN_MODB)[i * 12288 + nbase + col]; }
            __syncthreads();
        }
    }
    LAS float* scr = (LAS float*)(F.lds + RING_OFF + F.wave * 16384);
    const int gw = F.vcu * NWAVES + F.wave, NGW = F.G * NWAVES;
    constexpr int I_QKV = 32 * 192, I_F = 32, I_O = 32 * 64, I_GI = 32 * 128, I_GO = 32 * 64, I_F1 = 32 * 344, I_F2 = 86 * 64;
    constexpr int NITEMS = 2 * (I_QKV + I_F + I_O + I_GI + I_GO) + 4 * (I_F1 + I_F2);
    bf16* Wqkv = (bf16*)((unsigned char*)F.wsg + WS_WQKV); bf16* Wf = (bf16*)((unsigned char*)F.wsg + WS_WF); bf16* Wo = (bf16*)((unsigned char*)F.wsg + WS_WO); bf16* Wgi = (bf16*)((unsigned char*)F.wsg + WS_WGI);
    bf16* Wgo = (bf16*)((unsigned char*)F.wsg + WS_WGO); bf16* Wf1 = (bf16*)((unsigned char*)F.wsg + WS_WF1); bf16* Wf2 = (bf16*)((unsigned char*)F.wsg + WS_WF2);
    for (int it = gw; it < NITEMS; it += NGW) {
        int r = it;
        if (r < 2 * I_QKV) { const int j = r / I_QKV, q = r % I_QKV, kb = q / 192, nb = q % 192;
            transpose_item(F.in(IN_AWIN) + (size_t)j * DM * NQKVF, NQKVF, DM, Wqkv + (size_t)j * 6144 * DM, 64 * kb, 32 * nb, 32 * nb, 32, scr, F.lane); continue; } r -= 2 * I_QKV;
        if (r < 2 * I_F) { const int j = r / I_F, kb = r % I_F;
            transpose_item(F.in(IN_AWIN) + (size_t)j * DM * NQKVF, NQKVF, DM, Wf + (size_t)j * 16 * DM, 64 * kb, 6144, 0, 16, scr, F.lane); continue; } r -= 2 * I_F;
        if (r < 2 * I_O) { const int j = r / I_O, q = r % I_O, kb = q / 64, nb = q % 64;
            transpose_item(F.in(IN_AWO) + (size_t)j * DM * DM, DM, DM, Wo + (size_t)j * DM * DM, 64 * kb, 32 * nb, 32 * nb, 32, scr, F.lane); continue; } r -= 2 * I_O;
        if (r < 2 * I_GI) { const int j = r / I_GI, q = r % I_GI, kb = q / 128, nb = q % 128;
            transpose_item(F.in(IN_GWIN) + (size_t)j * DM * 4096, 4096, DM, Wgi + (size_t)j * 4096 * DM, 64 * kb, 32 * nb, 32 * nb, 32, scr, F.lane); continue; } r -= 2 * I_GI;
        if (r < 2 * I_GO) { const int j = r / I_GO, q = r % I_GO, kb = q / 64, nb = q % 64;
            transpose_item(F.in(IN_GWO) + (size_t)j * DM * DM, DM, DM, Wgo + (size_t)j * DM * DM, 64 * kb, 32 * nb, 32 * nb, 32, scr, F.lane); continue; } r -= 2 * I_GO;
        if (r < 4 * I_F1) { const int j = r / I_F1, q = r % I_F1, kb = q / 344, nb = q % 344;
            transpose_item(F.in(IN_FWIN) + (size_t)j * DM * NFF2, NFF2, DM, Wf1 + (size_t)j * NFF2 * DM, 64 * kb, 32 * nb, 32 * nb, 32, scr, F.lane); continue; } r -= 4 * I_F1;
        { const int j = r / I_F2, q = r % I_F2, kb = q / 64, nb = q % 64;
            transpose_item(F.in(IN_FWOUT) + (size_t)j * DFF * DM, DM, DFF, Wf2 + (size_t)j * DM * DFF, 64 * kb, 32 * nb, 32 * nb, 32, scr, F.lane); }
    }
}
__device__ __forceinline__ void norm_phase(Frame& F, const float* xin, const float* g, const float* shift, const float* scale, bf16* H) {
    const int gw = F.vcu * NWAVES + F.wave, NGW = F.G * NWAVES;
    for (int rb = gw; rb < MTOK / 16; rb += NGW) {
        const int b = (rb * 16) >> 12;
        f32x4 gs[8], sh[8];
#pragma unroll
        for (int j = 0; j < 8; ++j) { const int c4 = F.lane + 64 * j;
            gs[j] = ((const GAS f32x4*)g)[c4] * (((const GAS f32x4*)(scale + (size_t)b * 12288))[c4] + 1.0f); sh[j] = ((const GAS f32x4*)(shift + (size_t)b * 12288))[c4]; }
        for (int r = 0; r < 16; ++r) { const size_t row = (size_t)rb * 16 + r;
            const GAS f32x4* xr = (const GAS f32x4*)(xin + row * DM) + F.lane;
            f32x4 v[8]; float ss = 0.f;
#pragma unroll
            for (int j = 0; j < 8; ++j) { v[j] = xr[64 * j]; ss += (v[j].x * v[j].x + v[j].y * v[j].y) + (v[j].z * v[j].z + v[j].w * v[j].w); }
            const float rstd = 1.0f / sqrtf(wave_sum(ss) * (1.0f / DM) + EPS);
            GAS v2u* o8 = (GAS v2u*)(H + row * DM) + F.lane;
#pragma unroll
            for (int j = 0; j < 8; ++j) { const f32x4 o = v[j] * rstd * gs[j] + sh[j]; v2u w; w.x = pk2(o.x, o.y); w.y = pk2(o.z, o.w); o8[64 * j] = w; } }
    }
}
__device__ __forceinline__ void normf_phase(Frame& F, float* x, const float* g) {
    const int gw = F.vcu * NWAVES + F.wave, NGW = F.G * NWAVES;
    for (int rb = gw; rb < MTOK / 16; rb += NGW) {
        f32x4 gs[8];
#pragma unroll
        for (int j = 0; j < 8; ++j) gs[j] = ((const GAS f32x4*)g)[F.lane + 64 * j];
        for (int r = 0; r < 16; ++r) { const size_t row = (size_t)rb * 16 + r;
            GAS f32x4* xr = (GAS f32x4*)(x + row * DM) + F.lane;
            f32x4 v[8]; float ss = 0.f;
#pragma unroll
            for (int j = 0; j < 8; ++j) { v[j] = xr[64 * j]; ss += (v[j].x * v[j].x + v[j].y * v[j].y) + (v[j].z * v[j].z + v[j].w * v[j].w); }
            const float rstd = 1.0f / sqrtf(wave_sum(ss) * (1.0f / DM) + EPS);
#pragma unroll
            for (int j = 0; j < 8; ++j) xr[64 * j] = v[j] * rstd * gs[j]; }
    }
}
__device__ __forceinline__ void fg_phase(Frame& F, const bf16* H, const bf16* Wf, const float* bfv, float* LOGF) {
    const int gw = F.vcu * NWAVES + F.wave, NGW = F.G * NWAVES, fr = F.lane & 15, fq = F.lane >> 4;
    for (int rb = gw; rb < MTOK / 16; rb += NGW) {
        const GAS bf16x8* ap = (const GAS bf16x8*)(H + ((size_t)rb * 16 + fr) * DM + fq * 8);
        const GAS bf16x8* bp = (const GAS bf16x8*)(Wf + (size_t)fr * DM + fq * 8);
        f32x4 acc = (f32x4){0.f, 0.f, 0.f, 0.f};
#pragma unroll 8
        for (int ks = 0; ks < 64; ++ks) acc = __builtin_amdgcn_mfma_f32_16x16x32_bf16(bp[ks * 4], ap[ks * 4], acc, 0, 0, 0);
        const f32x4 bb = *(const GAS f32x4*)(bfv + 4 * fq); f32x4 o;
#pragma unroll
        for (int i = 0; i < 4; ++i) { const float z = acc[i] + bb[i]; o[i] = fminf(z, 0.f) - log1pf(__expf(-fabsf(z))); }
        *(GAS f32x4*)(LOGF + ((size_t)rb * 16 + fr) * 16 + 4 * fq) = o;
    }
}
__device__ __forceinline__ void cum_phase(Frame& F, const float* LOGF, float* FB) {
    const int gw = F.vcu * NWAVES + F.wave, NGW = F.G * NWAVES;
    for (int bh = gw; bh < NBATCH * NHEAD; bh += NGW) { const int b = bh >> 4, h = bh & 15;
        const float* p = LOGF + ((size_t)b * SEQ + F.lane * 64) * 16 + h;
        float v[64]; float s = 0.f;
#pragma unroll
        for (int i = 0; i < 64; ++i) { s += p[i * 16]; v[i] = s; }
        float incl = s;
#pragma unroll
        for (int o = 1; o < 64; o <<= 1) { const float t = __shfl_up(incl, o); if (F.lane >= o) incl += t; }
        const float excl = incl - s;
        GAS f32x4* q = (GAS f32x4*)(FB + (size_t)bh * SEQ + F.lane * 64);
#pragma unroll
        for (int i = 0; i < 16; ++i) q[i] = (f32x4){-(excl + v[4 * i]) * 1.4426950408889634f, -(excl + v[4 * i + 1]) * 1.4426950408889634f, -(excl + v[4 * i + 2]) * 1.4426950408889634f, -(excl + v[4 * i + 3]) * 1.4426950408889634f};
    }
}
__device__ __forceinline__ void vstat_phase(Frame& F, const bf16* Z, float* VRSTD) {
    const int gw = F.vcu * NWAVES + F.wave, NGW = F.G * NWAVES;
    for (int rb = gw; rb < MTOK / 16; rb += NGW)
        for (int r = 0; r < 16; ++r) { const size_t row = (size_t)rb * 16 + r;
            const GAS v4u* vp = (const GAS v4u*)(Z + row * 4096 + 2048) + F.lane; float ss = 0.f;
#pragma unroll
            for (int j = 0; j < 4; ++j) { const v4u w = vp[64 * j];
#pragma unroll
                for (int e = 0; e < 4; ++e) { const float a = bflo(w[e]), c = bfhi(w[e]); ss += a * a + c * c; } }
            const float rstd = 1.0f / sqrtf(wave_sum(ss) * (1.0f / DM) + EPS);
            if (F.lane == 0) VRSTD[row] = rstd; }
}
__device__ __forceinline__ void gate_phase(Frame& F, const bf16* Z, const float* VRSTD, const float* vg, const float* Ws, const float* bs, bf16* GT) {
    LAS float* Wl = (LAS float*)(F.lds + RING_OFF);
    LAS float* vn = (LAS float*)(F.lds + RING_OFF + 66048);
    const int t = 64 * (F.wave & 1) + F.lane, dg = F.wave >> 1;
    for (int item = F.bid; item < (MTOK / 128) * 16; item += F.G) {
        const int ch = item >> 4, g = item & 15; const size_t row0 = (size_t)ch * 128;
        for (int idx = F.tid; idx < 128 * 128; idx += NWAVES * 64) { const int tt = idx >> 7, s = idx & 127; const float w = Ws[((size_t)g * 128 + tt) * 128 + s]; Wl[tt * 129 + s] = (s <= tt) ? w : 0.f; }
        for (int idx = F.tid; idx < 128 * 16; idx += NWAVES * 64) { const int s = idx >> 4, d8 = (idx & 15) * 8;
            const v4u w = *(const GAS v4u*)(Z + (row0 + s) * 4096 + 2048 + g * 128 + d8); const float rs = VRSTD[row0 + s];
            const f32x4 g0 = *(const GAS f32x4*)(vg + g * 128 + d8), g1 = *(const GAS f32x4*)(vg + g * 128 + d8 + 4);
            *(LAS f32x4*)(vn + s * 128 + d8) = (f32x4){bflo(w.x) * rs * g0.x, bfhi(w.x) * rs * g0.y, bflo(w.y) * rs * g0.z, bfhi(w.y) * rs * g0.w};
            *(LAS f32x4*)(vn + s * 128 + d8 + 4) = (f32x4){bflo(w.z) * rs * g1.x, bfhi(w.z) * rs * g1.y, bflo(w.w) * rs * g1.z, bfhi(w.w) * rs * g1.w}; }
        __syncthreads();
        f32x4 acc[8];
#pragma unroll
        for (int i = 0; i < 8; ++i) acc[i] = (f32x4){0.f, 0.f, 0.f, 0.f};
        const int smax = 64 * (F.wave & 1) + 63;
        for (int s = 0; s <= smax; ++s) { const float w = Wl[t * 129 + s]; const LAS f32x4* vr = (const LAS f32x4*)(vn + s * 128 + dg * 32);
#pragma unroll
            for (int i = 0; i < 8; ++i) acc[i] += vr[i] * w; }
        const float bias = bs[g * 128 + t];
        const GAS v4u* up = (const GAS v4u*)(Z + (row0 + t) * 4096 + g * 128 + dg * 32);
        GAS v4u* op = (GAS v4u*)(GT + (row0 + t) * DM + g * 128 + dg * 32);
#pragma unroll
        for (int i = 0; i < 4; ++i) { const v4u uw = up[i]; const f32x4 a0 = acc[2 * i] + bias, a1 = acc[2 * i + 1] + bias; v4u o;
            o.x = pk2(bflo(uw.x) * a0.x, bfhi(uw.x) * a0.y); o.y = pk2(bflo(uw.y) * a0.z, bfhi(uw.y) * a0.w);
            o.z = pk2(bflo(uw.z) * a1.x, bfhi(uw.z) * a1.y); o.w = pk2(bflo(uw.w) * a1.z, bfhi(uw.w) * a1.w); op[i] = o; }
        __syncthreads();
    }
}
__device__ __forceinline__ void conv_phase(Frame& F, const bf16* A, int tok0, int rows, const float* cw, const float* cb, bf16* ACT) {
    const int nitems = (rows / 16) * (DFF / 8);
    for (int item = F.bid * (NWAVES * 64) + F.tid; item < nitems; item += F.G * NWAVES * 64) {
        const int run = item / (DFF / 8), c8 = (item % (DFF / 8)) * 8, r0 = run * 16, t0 = (tok0 + r0) & (SEQ - 1);
        float wg[3][8], wu[3][8], bg[8], bu[8];
#pragma unroll
        for (int j = 0; j < 3; ++j)
#pragma unroll
            for (int e = 0; e < 8; ++e) { wg[j][e] = cw[j * NFF2 + c8 + e]; wu[j][e] = cw[j * NFF2 + DFF + c8 + e]; }
#pragma unroll
        for (int e = 0; e < 8; ++e) { bg[e] = cb[c8 + e]; bu[e] = cb[DFF + c8 + e]; }
        float g2[8], g1[8], u2[8], u1[8];
        if (t0 >= 2) { const v4u a = *(const GAS v4u*)(A + (size_t)(r0 - 2) * NFF2 + c8), bq = *(const GAS v4u*)(A + (size_t)(r0 - 1) * NFF2 + c8);
                       const v4u c = *(const GAS v4u*)(A + (size_t)(r0 - 2) * NFF2 + DFF + c8), d = *(const GAS v4u*)(A + (size_t)(r0 - 1) * NFF2 + DFF + c8);
#pragma unroll
            for (int e = 0; e < 4; ++e) { g2[2 * e] = bflo(a[e]); g2[2 * e + 1] = bfhi(a[e]); g1[2 * e] = bflo(bq[e]); g1[2 * e + 1] = bfhi(bq[e]);
                                          u2[2 * e] = bflo(c[e]); u2[2 * e + 1] = bfhi(c[e]); u1[2 * e] = bflo(d[e]); u1[2 * e + 1] = bfhi(d[e]); } }
        else {
#pragma unroll
            for (int e = 0; e < 8; ++e) { g2[e] = 0.f; g1[e] = 0.f; u2[e] = 0.f; u1[e] = 0.f; } }
        for (int r = 0; r < 16; ++r) {
            const v4u a = *(const GAS v4u*)(A + (size_t)(r0 + r) * NFF2 + c8), c = *(const GAS v4u*)(A + (size_t)(r0 + r) * NFF2 + DFF + c8);
            float g0[8], u0[8], o[8];
#pragma unroll
            for (int e = 0; e < 4; ++e) { g0[2 * e] = bflo(a[e]); g0[2 * e + 1] = bfhi(a[e]); u0[2 * e] = bflo(c[e]); u0[2 * e + 1] = bfhi(c[e]); }
#pragma unroll
            for (int e = 0; e < 8; ++e) { const float cg = wg[0][e] * g2[e] + wg[1][e] * g1[e] + wg[2][e] * g0[e] + bg[e], cu = wu[0][e] * u2[e] + wu[1][e] * u1[e] + wu[2][e] * u0[e] + bu[e];
                o[e] = cg / (1.0f + __expf(-cg)) * cu; g2[e] = g1[e]; g1[e] = g0[e]; u2[e] = u1[e]; u1[e] = u0[e]; }
            v4u w; w.x = pk2(o[0], o[1]); w.y = pk2(o[2], o[3]); w.z = pk2(o[4], o[5]); w.w = pk2(o[6], o[7]);
            *(GAS v4u*)(ACT + (size_t)(tok0 + r0 + r) * DFF + c8) = w; }
    }
}
constexpr int NPHASE = 1 + DEPTH * 11 + 1;
struct Args { const float* in[19]; float* out; unsigned char* ws; int ph_lo, ph_hi; };
static_assert(sizeof(Args) == 19 * 8 + 8 + 8 + 8, "Args has no padding bytes");
#ifndef MK_EN
#define MK_EN 0xffffffffu
#endif
#define EN(k) (((MK_EN) >> (k)) & 1u)
#define W_MOD   ((float*)((unsigned char*)F.wsg + WS_MOD))
#define W_H     ((bf16*)((unsigned char*)F.wsg + WS_H))
#define W_Q     ((bf16*)((unsigned char*)F.wsg + WS_R))
#define W_K     ((bf16*)((unsigned char*)F.wsg + WS_R + 128 * MiB))
#define W_V     ((bf16*)((unsigned char*)F.wsg + WS_R + 256 * MiB))
#define W_Z     ((bf16*)((unsigned char*)F.wsg + WS_R))
#define W_A     ((bf16*)((unsigned char*)F.wsg + WS_R))
#define W_ACT   ((bf16*)((unsigned char*)F.wsg + WS_R + 344 * MiB))
#define W_LOGF  ((float*)((unsigned char*)F.wsg + WS_LOGF))
#define W_FB    ((float*)((unsigned char*)F.wsg + WS_FB))
#define W_VRSTD ((float*)((unsigned char*)F.wsg + WS_VRSTD))
#define W_MODI  (W_MOD + (size_t)i * 8 * 12288)
#define X_IN    ((i == 0) ? F.in(IN_X) : (const float*)(float*)F.outg)
__global__ void __launch_bounds__(NWAVES * 64, 2) mega_fwd(Args args) {
    extern __shared__ __attribute__((aligned(16))) unsigned char lds[];
    Frame F;
    F.lds = (LAS unsigned char*)lds; F.ldsg = (char*)lds;
    F.MISC = (volatile LAS unsigned*)(F.lds + MISC_OFF);
    F.tid = threadIdx.x; F.lane = F.tid & 63; F.wave = __builtin_amdgcn_readfirstlane(F.tid >> 6);
    F.G = gridDim.x; F.bid = blockIdx.x; { const int bx = blockIdx.x; F.vcu = (F.G % 8 == 0) ? (bx % 8) * (F.G / 8) + bx / 8 : bx; }
    F.inp = (const GAS float* const __attribute__((address_space(4)))*)__builtin_amdgcn_kernarg_segment_ptr();
    F.wsg = (GAS unsigned char*)args.ws; F.ctl = (gu32*)(args.ws + WS_CTL); F.outg = (GAS float*)args.out;
    for (int u = F.tid; u < (LDS_BYTES - LDSCTL_OFF) / 4; u += NWAVES * 64) ((LAS unsigned*)(F.lds + LDSCTL_OFF))[u] = 0u;
    __syncthreads();
    XcdBarrier bar; bar.bar = (unsigned*)(F.ctl + CW_BAR); bar.x = 0; bar.st = nullptr;
    if (!MK_PER_PHASE) bar = xcd_barrier_post((unsigned*)(F.ctl + CW_BAR), F.MISC + 8);
    const int lo = args.ph_lo, hi = args.ph_hi;
    int ph = 0;
#define RUN() (lo <= ph && ph < hi && relaunder(F))
#define SEAM() do { if (!MK_PER_PHASE) { if (lo <= ph && ph + 1 < hi) xcd_barrier(bar); } ++ph; } while (0)

    if (EN(0) && RUN()) pro_phase(F);
    SEAM();
    for (int i = 0; i < DEPTH; ++i) {
        const int j = i >> 1;
        if (EN(1) && RUN()) norm_phase(F, X_IN, F.in(IN_MIXG) + i * DM, W_MODI, W_MODI + DM, W_H);
        SEAM();
        if ((i & 1) == 0) {
            if (EN(2) && RUN()) {
                fg_phase(F, W_H, (const bf16*)((unsigned char*)F.wsg + WS_WF) + (size_t)j * 16 * DM, F.in(IN_ABF) + j * 16, W_LOGF);
                pg8::Gemm g{W_H, (const bf16*)((unsigned char*)F.wsg + WS_WQKV) + (size_t)j * 6144 * DM, MTOK, 6144, DM}; pg8::StaticOrder S; S.init(MTOK, 6144, F.G, F.bid);
                pg8::EpiQKV E{W_Q, (size_t)(64 * MiB), fox::QSCALE};
                pg8::gemm_phase<pg8::EpiQKV, pg8::StaticOrder, true, true>(F.lds + RING_OFF, g, S, E);
            }
            SEAM();
            if (EN(3) && RUN()) cum_phase(F, W_LOGF, W_FB);
            SEAM();
            if (EN(4) && RUN()) fox::att_phase(F.ldsg + RING_OFF, (const fox::bf16*)W_Q, (const fox::bf16*)W_K, (const fox::bf16*)W_V, (fox::bf16*)W_H, W_FB, F.bid, F.G);
            SEAM();
            if (EN(5) && RUN()) {
                pg8::Gemm g{W_H, (const bf16*)((unsigned char*)F.wsg + WS_WO) + (size_t)j * DM * DM, MTOK, DM, DM}; pg8::StaticOrder S; S.init(MTOK, DM, F.G, F.bid);
                pg8::EpiRes E{X_IN, (float*)F.outg, W_MODI + 2 * DM, 12288};
                pg8::gemm_phase<pg8::EpiRes, pg8::StaticOrder, true, true>(F.lds + RING_OFF, g, S, E);
            }
            SEAM();
        } else {
            if (EN(6) && RUN()) {
                pg8::Gemm g{W_H, (const bf16*)((unsigned char*)F.wsg + WS_WGI) + (size_t)j * 4096 * DM, MTOK, 4096, DM}; pg8::StaticOrder S; S.init(MTOK, 4096, F.G, F.bid);
                pg8::EpiStore<1> E{W_Z, 4096};
                pg8::gemm_phase<pg8::EpiStore<1>, pg8::StaticOrder, true, true>(F.lds + RING_OFF, g, S, E);
            }
            SEAM();
            if (EN(7) && RUN()) vstat_phase(F, W_Z, W_VRSTD);
            SEAM();
            if (EN(8) && RUN()) gate_phase(F, W_Z, W_VRSTD, F.in(IN_GVG) + j * DM, F.in(IN_GWS) + (size_t)j * 16 * 128 * 128, F.in(IN_GBS) + j * 16 * 128, W_H);
            SEAM();
            if (EN(9) && RUN()) {
                pg8::Gemm g{W_H, (const bf16*)((unsigned char*)F.wsg + WS_WGO) + (size_t)j * DM * DM, MTOK, DM, DM}; pg8::StaticOrder S; S.init(MTOK, DM, F.G, F.bid);
                pg8::EpiRes E{X_IN, (float*)F.outg, W_MODI + 2 * DM, 12288};
                pg8::gemm_phase<pg8::EpiRes, pg8::StaticOrder, true, true>(F.lds + RING_OFF, g, S, E);
            }
            SEAM();
        }
        if (EN(10) && RUN()) norm_phase(F, (float*)F.outg, F.in(IN_FFNG) + i * DM, W_MODI + 3 * DM, W_MODI + 4 * DM, W_H);
        SEAM();
        for (int half = 0; half < 2; ++half) {
            if (EN(11) && RUN()) {
                pg8::Gemm g{W_H + (size_t)half * (MTOK / 2) * DM, (const bf16*)((unsigned char*)F.wsg + WS_WF1) + (size_t)i * NFF2 * DM, MTOK / 2, NFF2, DM}; pg8::StaticOrder S; S.init(MTOK / 2, NFF2, F.G, F.bid);
                pg8::EpiStore<0> E{W_A, NFF2};
                pg8::gemm_phase<pg8::EpiStore<0>, pg8::StaticOrder, true, true>(F.lds + RING_OFF, g, S, E);
            }
            SEAM();
            if (EN(12) && RUN()) conv_phase(F, W_A, half * (MTOK / 2), MTOK / 2, F.in(IN_FCW) + (size_t)i * 3 * NFF2, F.in(IN_FCB) + (size_t)i * NFF2, W_ACT);
            SEAM();
        }
        if (EN(13) && RUN()) {
            pg8::Gemm g{W_ACT, (const bf16*)((unsigned char*)F.wsg + WS_WF2) + (size_t)i * DM * DFF, MTOK, DM, DFF}; pg8::StaticOrder S; S.init(MTOK, DM, F.G, F.bid);
            pg8::EpiRes E{(float*)F.outg, (float*)F.outg, W_MODI + 5 * DM, 12288};
            pg8::gemm_phase<pg8::EpiRes, pg8::StaticOrder, true, true>(F.lds + RING_OFF, g, S, E);
        }
        SEAM();
    }
    if (EN(14) && RUN()) normf_phase(F, (float*)F.outg, F.in(IN_FING));
#undef RUN
#undef SEAM
}

extern "C" void kernel_launch(void* const* d_in, const int* in_sizes, int n_in, void* d_out, int out_size, void* d_ws, size_t ws_size, hipStream_t stream) {
    static int grid = 0;
    if (grid == 0) {
        if (n_in != 19 || out_size != MTOK * DM || ws_size < WS_END) { fprintf(stderr, "kernel_launch: unexpected shapes (n_in %d, out %d, ws %zu < %zu)\n", n_in, out_size, ws_size, (size_t)WS_END); grid = -1; return; }
        int dev = 0, cus = 0, per_cu = 0;
        if (hipGetDevice(&dev) != hipSuccess || hipDeviceGetAttribute(&cus, hipDeviceAttributeMultiprocessorCount, dev) != hipSuccess) { grid = -1; return; }
        if (hipFuncSetAttribute((const void*)mega_fwd, hipFuncAttributeMaxDynamicSharedMemorySize, LDS_BYTES) != hipSuccess) { fprintf(stderr, "kernel_launch: hipFuncSetAttribute failed\n"); grid = -1; return; }
        if (hipOccupancyMaxActiveBlocksPerMultiprocessor(&per_cu, (const void*)mega_fwd, NWAVES * 64, LDS_BYTES) != hipSuccess || per_cu < 1) { fprintf(stderr, "kernel_launch: occupancy query says %d\n", per_cu); }
        (void)hipGetLastError();
        grid = cus;
    }
    if (grid < 0) return;
    if (hipMemsetAsync((char*)d_ws + WS_CTL, 0, CTL_ZERO_BYTES, stream) != hipSuccess) return;
    Args a{};
    for (int i = 0; i < 19; ++i) a.in[i] = (const float*)d_in[i];
    a.out = (float*)d_out; a.ws = (unsigned char*)d_ws;
#if MK_PER_PHASE
    for (int p = 0; p < NPHASE; ++p) { a.ph_lo = p; a.ph_hi = p + 1; hipLaunchKernelGGL(mega_fwd, dim3(grid), dim3(NWAVES * 64), LDS_BYTES, stream, a); }
#else
    a.ph_lo = 0; a.ph_hi = NPHASE; hipLaunchKernelGGL(mega_fwd, dim3(grid), dim3(NWAVES * 64), LDS_BYTES, stream, a);
#endif
}
```

```cpp
#include <hip/hip_runtime.h>
#include <hip/hip_bf16.h>
#include <cstdio>
#include <cstdint>
__device__ __forceinline__ int ltid() { int t = (int)threadIdx.x; asm volatile("" : "+v"(t)); return t; }
namespace pg8 {
#define PG8_LAS __attribute__((address_space(3)))
typedef unsigned short bf16_t;
typedef short bf16x8 __attribute__((ext_vector_type(8)));
typedef float f32x4 __attribute__((ext_vector_type(4)));
typedef unsigned u32x4 __attribute__((ext_vector_type(4)));
constexpr int BM = 256, BK = 64, HALF = 128, HTB = HALF * BK * 2  , STAGE_BYTES = 8 * HTB, NXCD = 8, WGM = 8;

__host__ __device__ __forceinline__ int lds_byte(int r, int c) { const int st = (r >> 4) * 2 + (c >> 5), rr = r & 15, cc = c & 31, ob = rr * 64 + cc * 2; return st * 1024 + (ob ^ (((ob >> 9) & 1) << 5)); }
__host__ __device__ __forceinline__ void stage_rc(int b, int& R, int& C) { const int st = b / 1024, sb = b % 1024, swz = sb ^ (((sb >> 9) & 1) << 5); R = (st >> 1) * 16 + swz / 64; C = (st & 1) * 32 + (swz % 64) / 2; }
__host__ __device__ __forceinline__ int perm32(int rho) { const int n = rho >> 4, i = rho & 15; return 8 * (i >> 2) + 4 * n + (i & 3); }

struct Unit { int pm, pn; };
struct Gemm { const bf16_t* A; const bf16_t* Bt; int M, N, K; };

struct StaticOrder {
    int nM, nN, nwg, G, c;
    __host__ __device__ void init(int M, int N, int G_, int c_) { nM = M / BM; nN = N / BM; nwg = nM * nN; G = G_; c = c_; }
    __host__ __device__ bool next(int i, Unit& u) const {
        const long L = (long)i * G + c; if (L >= nwg) return false;
        int wgid = (int)L; { const int q = nwg / NXCD, r = nwg % NXCD, xcd = wgid % NXCD, off = wgid / NXCD; wgid = (xcd < r ? xcd * (q + 1) : r * (q + 1) + (xcd - r) * q) + off; }
        const int nig = WGM * nN, gid = wgid / nig, fm = gid * WGM, gsz = (nM - fm) < WGM ? (nM - fm) : WGM;
        u.pm = fm + ((wgid % nig) % gsz); u.pn = (wgid % nig) / gsz; return true;
    }
    __device__ __forceinline__ void a_ready(const Unit&) const {}
    __device__ __forceinline__ void done(const Unit&) const {}
};
__device__ __forceinline__ unsigned cvt_pk_bf16(float lo, float hi) { unsigned r; asm volatile("v_cvt_pk_bf16_f32 %0, %1, %2" : "=v"(r) : "v"(lo), "v"(hi)); return r; }
typedef float f32x2 __attribute__((ext_vector_type(2)));
__device__ __forceinline__ f32x2 gelu_pk(f32x2 v) {
    const f32x2 av = __builtin_elementwise_abs(v), d = av * 0.2316418882f + 1.0f;
    f32x2 t; t.x = __builtin_amdgcn_rcpf(d.x); t.y = __builtin_amdgcn_rcpf(d.y);
    f32x2 q = t * 0.5307027145f + (-0.7265760135f); q = q * t + 0.7107068705f; q = q * t + (-0.142248368f); q = q * t + 0.127414796f; q = q * t;
    const f32x2 s = (v * v) * (-0.72134752044f);
    f32x2 e; e.x = __builtin_amdgcn_exp2f(s.x); e.y = __builtin_amdgcn_exp2f(s.y);
    const f32x2 m = v * (q * e), r = v - m;
    f32x2 o; o.x = v.x < 0.f ? m.x : r.x; o.y = v.y < 0.f ? m.y : r.y; return o;
}

__device__ __forceinline__ float gelu_tanh1(float v) {
    const float u = v * (0.7978845608f + 0.0356774081f * v * v);
    const float e = __builtin_amdgcn_exp2f(u * -2.8853900818f);
    return v * __builtin_amdgcn_rcpf(1.0f + e);
}
template <int ACT  > struct EpiStore {
    static constexpr bool PERM = true, AFTER_DRAIN = false;
    bf16_t* O; int ldc;
    __device__ __forceinline__ void operator()(const f32x4 (&acc)[2][2][4][2], const Unit& u, int wr, int wc, int fr, int fq) const {
        const int row0 = u.pm * BM + wr * 64 + fr, col0 = u.pn * BM + wc * 32 + 8 * fq;
#pragma unroll
        for (int ai = 0; ai < 2; ++ai)
#pragma unroll
            for (int m = 0; m < 4; ++m) { bf16_t* rowp = O + (size_t)(row0 + ai * HALF + m * 16) * ldc + col0;
#pragma unroll
                for (int bj = 0; bj < 2; ++bj) { f32x4 v0 = acc[ai][bj][m][0], v1 = acc[ai][bj][m][1];
                    if (ACT == 1) {
#pragma unroll
                        for (int j = 0; j < 4; ++j) { v0[j] = gelu_tanh1(v0[j]); v1[j] = gelu_tanh1(v1[j]); } }
                    u32x4 w; w.x = cvt_pk_bf16(v0[0], v0[1]); w.y = cvt_pk_bf16(v0[2], v0[3]); w.z = cvt_pk_bf16(v1[0], v1[1]); w.w = cvt_pk_bf16(v1[2], v1[3]);
                    *(u32x4*)(rowp + bj * HALF) = w; } }
    }
};
struct EpiQKV {
    static constexpr bool PERM = true, AFTER_DRAIN = false;
    bf16_t* QKV; size_t tstride; float qscale;
    __device__ __forceinline__ void operator()(const f32x4 (&acc)[2][2][4][2], const Unit& u, int wr, int wc, int fr, int fq) const {
        const int tok0 = u.pm * BM, b = tok0 >> 12, s0 = (tok0 & 4095) + wr * 64 + fr;
        const int colt = u.pn * BM, t = colt >> 11, hd0 = (colt & 2047) >> 7;
        bf16_t* base = QKV + (size_t)t * tstride; const float sc = t == 0 ? qscale : 1.0f;
#pragma unroll
        for (int bj = 0; bj < 2; ++bj) { bf16_t* hb = base + ((size_t)(b * 16 + hd0 + bj) * 4096 + s0) * 128 + wc * 32 + 8 * fq;
#pragma unroll
            for (int ai = 0; ai < 2; ++ai)
#pragma unroll
                for (int m = 0; m < 4; ++m) { const f32x4 v0 = acc[ai][bj][m][0] * sc, v1 = acc[ai][bj][m][1] * sc;
                    u32x4 w; w.x = cvt_pk_bf16(v0[0], v0[1]); w.y = cvt_pk_bf16(v0[2], v0[3]); w.z = cvt_pk_bf16(v1[0], v1[1]); w.w = cvt_pk_bf16(v1[2], v1[3]);
                    *(u32x4*)(hb + (size_t)(ai * HALF + m * 16) * 128) = w; } }
    }
};
struct EpiRes {
    static constexpr bool PERM = false, AFTER_DRAIN = false;
    const float* xin; float* xout; const float* gate; int gpitch;
    __device__ __forceinline__ void operator()(const f32x4 (&acc)[2][2][4][2], const Unit& u, int wr, int wc, int fr, int fq) const {
        const int row0 = u.pm * BM + wr * 64 + fr, col0 = u.pn * BM + wc * 32 + 4 * fq, b = (u.pm * BM) >> 12;
        f32x4 gv[2][2];
#pragma unroll
        for (int bj = 0; bj < 2; ++bj)
#pragma unroll
            for (int n = 0; n < 2; ++n) gv[bj][n] = *(const f32x4*)(gate + (size_t)b * gpitch + col0 + bj * HALF + n * 16);
#pragma unroll
        for (int ai = 0; ai < 2; ++ai)
#pragma unroll
            for (int m = 0; m < 4; ++m) { const size_t off = (size_t)(row0 + ai * HALF + m * 16) * 2048 + col0;
#pragma unroll
                for (int bj = 0; bj < 2; ++bj)
#pragma unroll
                    for (int n = 0; n < 2; ++n) { const f32x4 xo = *(const f32x4*)(xin + off + bj * HALF + n * 16);
                        *(f32x4*)(xout + off + bj * HALF + n * 16) = xo + gv[bj][n] * acc[ai][bj][m][n]; }
                asm volatile("" ::: "memory"); }
    }
};
template <class Epi, class Sched, bool ALIGN_EPI = false, bool SP2 = false>
__device__ __forceinline__ void gemm_phase(PG8_LAS unsigned char* lds, const Gemm g, const Sched& S, const Epi& E) {
    const int tid = ltid(), wid = __builtin_amdgcn_readfirstlane(tid >> 6), lane = tid & 63, wr = wid >> 2, wc = wid & 3, fr = lane & 15, fq = lane >> 4;
    const int K = g.K, nt = K / BK;
    unsigned voffA[2], voffB[2];
#pragma unroll
    for (int i = 0; i < 2; ++i) { int R, C; stage_rc(tid * 16 + i * 8192, R, C); const int Rb = Epi::PERM ? ((R & ~31) + perm32(R & 31)) : R;
        voffA[i] = (unsigned)(R * K + C) * 2u; voffB[i] = (unsigned)(Rb * K + C) * 2u; }
    const size_t kstep = (size_t)(BK * 2);
    const size_t hstep = (size_t)HALF * K * 2;
    const size_t tstep = 2 * hstep;
    const unsigned ldsw = (unsigned)wid * 1024u;
    const int aoff = lds_byte(wr * 64 + fr, fq * 8), boff = lds_byte(wc * 32 + fr, fq * 8);
#define PG8_SA(b, h) (((b) * 2 + (h)) * HTB)
#define PG8_SB(b, h) ((4 + (b) * 2 + (h)) * HTB)
#define PG8_STAGE(bufoff, gbase, voff) do { _Pragma("unroll") for (int _i = 0; _i < 2; ++_i) \
        __builtin_amdgcn_global_load_lds((const unsigned*)((const char*)(gbase) + (voff)[_i]), (PG8_LAS unsigned*)(lds + (bufoff) + ldsw + _i * 8192), 16, 0, 0); } while (0)
#define PG8_LDA(dst, b, h) do { _Pragma("unroll") for (int m = 0; m < 4; ++m) _Pragma("unroll") for (int k = 0; k < 2; ++k) dst[m][k] = *(const PG8_LAS bf16x8*)(lds + PG8_SA(b, h) + aoff + m * 2048 + k * 1024); } while (0)
#define PG8_LDB(dst, b, h) do { _Pragma("unroll") for (int n = 0; n < 2; ++n) _Pragma("unroll") for (int k = 0; k < 2; ++k) dst[n][k] = *(const PG8_LAS bf16x8*)(lds + PG8_SB(b, h) + boff + n * 2048 + k * 1024); } while (0)
#define PG8_MMA(ai, bj, At, Bt) do { __builtin_amdgcn_s_setprio(1); _Pragma("unroll") for (int m = 0; m < 4; ++m) _Pragma("unroll") for (int n = 0; n < 2; ++n) _Pragma("unroll") for (int k = 0; k < 2; ++k) \
        acc[ai][bj][m][n] = __builtin_amdgcn_mfma_f32_16x16x32_bf16(Bt[n][k], At[m][k], acc[ai][bj][m][n], 0, 0, 0); __builtin_amdgcn_s_setprio(0); } while (0)
#define PG8_WAIT_V(n) asm volatile("s_waitcnt vmcnt(" #n ")" ::: "memory")
#define PG8_WAIT_L(n) asm volatile("s_waitcnt lgkmcnt(" #n ")" ::: "memory")
#define PG8_BAR __builtin_amdgcn_s_barrier()
#define PG8_SCHED __builtin_amdgcn_sched_barrier(0)
    Unit cur, nxt; int ui = 0;
    if (!S.next(0, cur)) return;
    f32x4 acc[2][2][4][2];
#pragma unroll
    for (int a = 0; a < 2; ++a)
#pragma unroll
        for (int b = 0; b < 2; ++b)
#pragma unroll
            for (int m = 0; m < 4; ++m)
#pragma unroll
                for (int n = 0; n < 2; ++n) acc[a][b][m][n] = (f32x4){0.f, 0.f, 0.f, 0.f};
    bf16x8 At[4][2], B0[2][2], B1[2][2];
    const char* cA = (const char*)g.A + (size_t)cur.pm * tstep; const char* cB = (const char*)g.Bt + (size_t)cur.pn * tstep;
    S.a_ready(cur);
    if constexpr (SP2) {
        PG8_STAGE(PG8_SB(0, 0), cB, voffB); PG8_STAGE(PG8_SB(0, 1), cB + hstep, voffB); PG8_STAGE(PG8_SA(0, 0), cA, voffA); PG8_STAGE(PG8_SA(0, 1), cA + hstep, voffA);
        if (wr == 1) PG8_BAR;
        PG8_WAIT_V(2); PG8_BAR;
        PG8_STAGE(PG8_SB(1, 0), cB + kstep, voffB); PG8_STAGE(PG8_SA(1, 0), cA + kstep, voffA); PG8_STAGE(PG8_SB(1, 1), cB + hstep + kstep, voffB);
        PG8_WAIT_V(6); PG8_BAR;
    } else {
        PG8_STAGE(PG8_SB(0, 0), cB, voffB); PG8_STAGE(PG8_SA(0, 0), cA, voffA); PG8_STAGE(PG8_SB(0, 1), cB + hstep, voffB); PG8_STAGE(PG8_SA(0, 1), cA + hstep, voffA);
        if (wr == 1) PG8_BAR;
        PG8_WAIT_V(4); PG8_BAR;
        PG8_STAGE(PG8_SB(1, 0), cB + kstep, voffB); PG8_STAGE(PG8_SA(1, 0), cA + kstep, voffA); PG8_STAGE(PG8_SB(1, 1), cB + hstep + kstep, voffB);
        PG8_WAIT_V(6); PG8_BAR;
    }
    for (;;) {
        const bool has_next = S.next(ui + 1, nxt);
        const char* nA = has_next ? (const char*)g.A + (size_t)nxt.pm * tstep : cA; const char* nB = has_next ? (const char*)g.Bt + (size_t)nxt.pn * tstep : cB;
        for (int t = 0; t < nt; t += 2) {
            const bool last = (t == nt - 2);
            const char* a1 = cA + (size_t)(t + 1) * kstep;
            const char* a2 = last ? nA : cA + (size_t)(t + 2) * kstep; const char* b2 = last ? nB : cB + (size_t)(t + 2) * kstep;
            const char* a3 = a2 + kstep; const char* b3 = b2 + kstep;
            if (last && has_next) S.a_ready(nxt);
            if constexpr (SP2) {
            PG8_LDB(B0, 0, 0); PG8_LDB(B1, 0, 1); PG8_SCHED; PG8_LDA(At, 0, 0); PG8_STAGE(PG8_SA(1, 1), a1 + hstep, voffA);
            PG8_WAIT_V(8); PG8_WAIT_L(0); PG8_BAR; PG8_MMA(0, 0, At, B0); PG8_MMA(0, 1, At, B1); PG8_BAR; PG8_SCHED;
            PG8_LDA(At, 0, 1); PG8_STAGE(PG8_SB(0, 0), b2, voffB); PG8_STAGE(PG8_SB(0, 1), b2 + hstep, voffB); PG8_STAGE(PG8_SA(0, 0), a2, voffA);
            PG8_WAIT_V(8); PG8_WAIT_L(0); PG8_BAR; PG8_MMA(1, 0, At, B0); PG8_MMA(1, 1, At, B1); PG8_BAR; PG8_SCHED;
            PG8_LDB(B0, 1, 0); PG8_LDB(B1, 1, 1); PG8_SCHED; PG8_LDA(At, 1, 0); PG8_STAGE(PG8_SA(0, 1), a2 + hstep, voffA);
            PG8_WAIT_V(8); PG8_WAIT_L(0); PG8_BAR; PG8_MMA(0, 0, At, B0); PG8_MMA(0, 1, At, B1); PG8_BAR; PG8_SCHED;
            PG8_LDA(At, 1, 1); PG8_STAGE(PG8_SB(1, 0), b3, voffB); PG8_STAGE(PG8_SB(1, 1), b3 + hstep, voffB); PG8_STAGE(PG8_SA(1, 0), a3, voffA);
            PG8_WAIT_V(8); PG8_WAIT_L(0); PG8_BAR; PG8_MMA(1, 0, At, B0); PG8_MMA(1, 1, At, B1); PG8_BAR; PG8_SCHED;
            } else {
            PG8_LDB(B0, 0, 0); PG8_SCHED; PG8_LDA(At, 0, 0); PG8_STAGE(PG8_SA(1, 1), a1 + hstep, voffA);
            PG8_WAIT_L(8); PG8_BAR; PG8_WAIT_L(0); PG8_MMA(0, 0, At, B0); PG8_BAR; PG8_SCHED;
            PG8_LDB(B1, 0, 1); PG8_STAGE(PG8_SB(0, 0), b2, voffB);
            PG8_BAR; PG8_WAIT_L(0); PG8_MMA(0, 1, At, B1); PG8_BAR;
            PG8_LDA(At, 0, 1); PG8_STAGE(PG8_SA(0, 0), a2, voffA);
            PG8_BAR; PG8_WAIT_L(0); PG8_MMA(1, 0, At, B0); PG8_BAR; PG8_SCHED;
            PG8_STAGE(PG8_SB(0, 1), b2 + hstep, voffB);
            PG8_WAIT_V(6); PG8_BAR; PG8_MMA(1, 1, At, B1); PG8_BAR;
            PG8_LDB(B0, 1, 0); PG8_SCHED; PG8_LDA(At, 1, 0); PG8_STAGE(PG8_SA(0, 1), a2 + hstep, voffA);
            PG8_WAIT_L(8); PG8_BAR; PG8_WAIT_L(0); PG8_MMA(0, 0, At, B0); PG8_BAR; PG8_SCHED;
            PG8_LDB(B1, 1, 1); PG8_STAGE(PG8_SB(1, 0), b3, voffB);
            PG8_BAR; PG8_WAIT_L(0); PG8_MMA(0, 1, At, B1); PG8_BAR;
            PG8_LDA(At, 1, 1); PG8_STAGE(PG8_SA(1, 0), a3, voffA);
            PG8_BAR; PG8_WAIT_L(0); PG8_MMA(1, 0, At, B0); PG8_BAR; PG8_SCHED;
            PG8_STAGE(PG8_SB(1, 1), b3 + hstep, voffB);
            PG8_WAIT_V(6); PG8_BAR; PG8_MMA(1, 1, At, B1); PG8_BAR;
            }
        }
        if constexpr (ALIGN_EPI) { if (wr == 0) PG8_BAR; }
        if constexpr (!Epi::AFTER_DRAIN) { E(acc, cur, wr, wc, fr, fq); S.done(cur); }
        if (!has_next) break;
#pragma unroll
        for (int a = 0; a < 2; ++a)
#pragma unroll
            for (int b = 0; b < 2; ++b)
#pragma unroll
                for (int m = 0; m < 4; ++m)
#pragma unroll
                    for (int n = 0; n < 2; ++n) acc[a][b][m][n] = (f32x4){0.f, 0.f, 0.f, 0.f};
        cur = nxt; cA = nA; cB = nB; ++ui;
        if constexpr (ALIGN_EPI) { if (wr == 1) PG8_BAR; }
    }
    PG8_WAIT_V(0);
    if constexpr (!ALIGN_EPI) { if (wr == 0) PG8_BAR; }
    PG8_BAR;
    if constexpr (Epi::AFTER_DRAIN) { E.fused(acc, cur, wr, wc, fr, fq, lds, wid, lane); S.done(cur); }
#undef PG8_SA
#undef PG8_SB
#undef PG8_STAGE
#undef PG8_LDA
#undef PG8_LDB
#undef PG8_MMA
#undef PG8_WAIT_V
#undef PG8_WAIT_L
#undef PG8_BAR
#undef PG8_SCHED
}
}
namespace fox {
enum { ORDER_NATURAL = 0, ORDER_REVERSED = 1, ORDER_PAIRED = 2, ORDER_XCD = 4 };
constexpr int B = 8, H = 16, HKV = 16, SQ = 4096, SKV = 4096, D = 128;
constexpr int QOFF = 0;
constexpr int WINDOW = SKV;
constexpr float THR = 8.f;
constexpr bool WSKIP = false;
constexpr float SCALE = 0.08838834764831845f;
constexpr float QSCALE = SCALE * 1.4426950408889634f;
constexpr int NW = 8, QBLK = 32, KVBLK = 64, QB = NW * QBLK;
constexpr int SHM_V = KVBLK * D * 2, SHM_K = KVBLK * D * 2;
constexpr int LDS_FB = 2 * SHM_V + 2 * SHM_K + NW * 64 * 4;
constexpr int LDS_BYTES = LDS_FB + SKV * 4;
constexpr int OPITCH = H * D;
using bf16 = __hip_bfloat16;
typedef short bf16x8 __attribute__((ext_vector_type(8)));
typedef short s16x4 __attribute__((ext_vector_type(4)));
typedef float f32x16 __attribute__((ext_vector_type(16)));
typedef float f32x4 __attribute__((ext_vector_type(4)));
typedef unsigned u32x4 __attribute__((ext_vector_type(4)));
template <class A, class Bt> struct same_t { static constexpr bool v = false; };
template <class A> struct same_t<A, A> { static constexpr bool v = true; };

#define KSWZ(row, colB) ((row) * 256 + ((colB) ^ (((row) & 7) << 4)))
#define SBAR() __builtin_amdgcn_sched_barrier(0)
__device__ __forceinline__ int v_st(int k, int c) { const int kk = (k & ~0xC) | ((k & 4) << 1) | ((k & 8) >> 1); return ((kk >> 3) * 4 + (c >> 5)) * 512 + ((kk & 7) * 32 + (c & 31)) * 2; }
__device__ __forceinline__ int v_rd_base(int lane) { return ((lane & 3) << 3) | (((lane >> 2) & 3) << 6) | (((lane >> 4) & 1) << 5) | (((lane >> 5) & 1) << 8); }
constexpr int v_rd_off(int d0, int ks, int half) { return d0 * 512 + ks * 4096 + half * 2048; }
__device__ __forceinline__ int crow(int r, int hi) { return (r & 3) + 8 * (r >> 2) + 4 * hi; }
__device__ __forceinline__ unsigned cvtpk(float lo, float hi) {
    unsigned r; asm volatile("v_cvt_pk_bf16_f32 %0, %1, %2" : "=v"(r) : "v"(lo), "v"(hi)); return r;
}
__device__ __forceinline__ bf16x8 pack8(f32x4 a, f32x4 b) {
    u32x4 w = {cvtpk(a[0], a[1]), cvtpk(a[2], a[3]), cvtpk(b[0], b[1]), cvtpk(b[2], b[3])};
    return *reinterpret_cast<bf16x8*>(&w);
}
template <class T> __device__ __forceinline__ bf16x8 load8(const T* p) {
    if constexpr (same_t<T, float>::v) { return pack8(*(const f32x4*)p, *(const f32x4*)(p + 4)); }
    else { return *reinterpret_cast<const bf16x8*>(p); }
}
__device__ __forceinline__ void mask_tile(f32x16& p0, f32x16& p1, int dq, unsigned W) {
    const float NEG = -__builtin_inff();
#pragma unroll
    for (int r = 0; r < 16; ++r) {
        const int c = (r & 3) + 8 * (r >> 2);
        if ((unsigned)(dq - c) >= W) p0[r] = NEG;
        if ((unsigned)(dq - c - 32) >= W) p1[r] = NEG;
    }
}
__device__ __forceinline__ void partialSM(f32x16& p0, f32x16& p1, float& m_reg, float& mn, float& alpha) {
    float pmax = p0[0]; for (int r = 1; r < 16; ++r) pmax = fmaxf(pmax, p0[r]); for (int r = 0; r < 16; ++r) pmax = fmaxf(pmax, p1[r]);
    { auto rr = __builtin_amdgcn_permlane32_swap(__float_as_uint(pmax), __float_as_uint(pmax), false, false);
      pmax = fmaxf(__uint_as_float(rr[0]), __uint_as_float(rr[1])); }
    constexpr float THR2 = THR * 1.4426950408889634f;
    if (__builtin_expect(__all((pmax - m_reg) <= THR2), 1)) { mn = m_reg; alpha = 1.f; }
    else { mn = fmaxf(m_reg, pmax); alpha = __builtin_amdgcn_exp2f(m_reg - mn); m_reg = mn; }
    for (int r = 0; r < 16; ++r) p0[r] = p0[r] - mn; for (int r = 0; r < 16; ++r) p1[r] = p1[r] - mn;
    for (int r = 0; r < 16; ++r) p0[r] = __builtin_amdgcn_exp2f(p0[r]);
}
__device__ __forceinline__ void finishSM(f32x16& p0, f32x16& p1, float alpha, float& l_reg, bf16x8& pa0, bf16x8& pa1, bf16x8& pa2, bf16x8& pa3) {
    for (int r = 0; r < 16; ++r) p1[r] = __builtin_amdgcn_exp2f(p1[r]);
    float ps = 0; for (int r = 0; r < 16; ++r) ps += p0[r]; for (int r = 0; r < 16; ++r) ps += p1[r];
    { auto rr = __builtin_amdgcn_permlane32_swap(__float_as_uint(ps), __float_as_uint(ps), false, false);
      ps = __uint_as_float(rr[0]) + __uint_as_float(rr[1]); }
    l_reg = l_reg * alpha + ps;
#define PK4(P, B_, OUT) do { unsigned a0 = cvtpk(P[B_+0], P[B_+1]), a1 = cvtpk(P[B_+2], P[B_+3]);                          \
        unsigned b0 = cvtpk(P[B_+4], P[B_+5]), b1 = cvtpk(P[B_+6], P[B_+7]);                                             \
        auto r0 = __builtin_amdgcn_permlane32_swap(a0, b0, false, false); auto r1 = __builtin_amdgcn_permlane32_swap(a1, b1, false, false); \
        u32x4 w = {r0[0], r1[0], r0[1], r1[1]}; OUT = *reinterpret_cast<bf16x8*>(&w); } while (0)
    PK4(p0, 0, pa0); PK4(p0, 8, pa1); PK4(p1, 0, pa2); PK4(p1, 8, pa3);
#undef PK4
}
template <int KB, bool SK>
__device__ __forceinline__ void qkt(f32x16& p0, f32x16& p1, const char* K_lds, int r32, int hi, const bf16x8* qr, bool act, const char* fb) {
    if (SK && !act) { const float NEG = -__builtin_inff();
#pragma unroll
        for (int r = 0; r < 16; ++r) { p0[r] = NEG; p1[r] = NEG; } return; }
#pragma unroll
    for (int q = 0; q < 4; ++q) { const f32x4 b0 = *reinterpret_cast<const f32x4*>(fb + q * 32), b1 = *reinterpret_cast<const f32x4*>(fb + 128 + q * 32);
#pragma unroll
        for (int i = 0; i < 4; ++i) { p0[4 * q + i] = b0[i]; p1[4 * q + i] = b1[i]; } }
    const char* kb[4];
#pragma unroll
    for (int dd = 0; dd < 4; ++dd) kb[dd] = K_lds + KB * SHM_K + KSWZ(r32, (dd * 16 + hi * 8) * 2);
#pragma unroll
    for (int d0 = 0; d0 < 8; ++d0) { const char* a = kb[d0 & 3] + (d0 >> 2) * 128;
        bf16x8 b0 = *reinterpret_cast<const bf16x8*>(a);
        bf16x8 b1 = *reinterpret_cast<const bf16x8*>(a + 32 * 256);
        p0 = __builtin_amdgcn_mfma_f32_32x32x16_bf16(b0, qr[d0], p0, 0, 0, 0);
        p1 = __builtin_amdgcn_mfma_f32_32x32x16_bf16(b1, qr[d0], p1, 0, 0, 0); }
}
template <int VB, bool SK>
__device__ __forceinline__ void pv_tile(f32x16* o, int vb0, bf16x8 pa0, bf16x8 pa1, bf16x8 pa2, bf16x8 pa3, bool act) {
    if (SK && !act) return;
#define TRRD(dst, off) asm volatile("ds_read_b64_tr_b16 %0, %1 offset:%2" : "=&v"(dst) : "v"(vb0), "i"(off) : "memory")
#define PV_D0(d0) do { s16x4 l0, l1, l2, l3, h0, h1, h2, h3; constexpr int b_ = VB * SHM_V + v_rd_off(d0, 0, 0);     \
        TRRD(l0, b_); TRRD(h0, b_ + 2048); TRRD(l1, b_ + 4096); TRRD(h1, b_ + 6144); TRRD(l2, b_ + 8192); TRRD(h2, b_ + 10240); TRRD(l3, b_ + 12288); TRRD(h3, b_ + 14336); \
        asm volatile("s_waitcnt lgkmcnt(0)" ::: "memory"); SBAR();                 \
        o[d0] = __builtin_amdgcn_mfma_f32_32x32x16_bf16(pa0, (bf16x8){l0[0], l0[1], l0[2], l0[3], h0[0], h0[1], h0[2], h0[3]}, o[d0], 0, 0, 0);   \
        o[d0] = __builtin_amdgcn_mfma_f32_32x32x16_bf16(pa1, (bf16x8){l1[0], l1[1], l1[2], l1[3], h1[0], h1[1], h1[2], h1[3]}, o[d0], 0, 0, 0);   \
        o[d0] = __builtin_amdgcn_mfma_f32_32x32x16_bf16(pa2, (bf16x8){l2[0], l2[1], l2[2], l2[3], h2[0], h2[1], h2[2], h2[3]}, o[d0], 0, 0, 0);   \
        o[d0] = __builtin_amdgcn_mfma_f32_32x32x16_bf16(pa3, (bf16x8){l3[0], l3[1], l3[2], l3[3], h3[0], h3[1], h3[2], h3[3]}, o[d0], 0, 0, 0); } while (0)
    PV_D0(0); PV_D0(1); PV_D0(2); PV_D0(3);
#undef PV_D0
#undef TRRD
}
template <class TIn, class TOut> struct BlockRef { const TIn* Q; const TIn* K; const TIn* V; TOut* O; const float* FB; int P0; };
template <class TIn> struct Seam {
    bf16x8 qr[8];
    bf16x8 st_v0, st_v1, st_k0, st_k1; f32x4 sf0, sf1, sf2, sf3;
    f32x4 tq[16];
};
__device__ __forceinline__ int swa_jlo(int P0, int W) { const int lowk = P0 - W + 1; return lowk > 0 ? lowk / KVBLK : 0; }
#define ROW(p, k0, rr) ((p) + (size_t)((k0) + (rr)) * D + sc)
#define VMW() asm volatile("s_waitcnt vmcnt(0)" ::: "memory")
#define VMWN(n) asm volatile("s_waitcnt vmcnt(%0)" :: "i"(n) : "memory")
#define SLOAD_H(Kp, Vp, k0) do { S.st_v0 = load8<TIn>(ROW(Vp, k0, sr)); S.st_v1 = load8<TIn>(ROW(Vp, k0, 32 + sr));              \
                         S.st_k0 = load8<TIn>(ROW(Kp, k0, sr)); S.st_k1 = load8<TIn>(ROW(Kp, k0, 32 + sr)); } while (0)
#define SWRITE_HK(bf) do { *(bf16x8*)(K_lds + (bf) * SHM_K + kws) = S.st_k0; *(bf16x8*)(K_lds + (bf) * SHM_K + kws + 32 * 256) = S.st_k1; } while (0)
#define SWRITE_HV(bf) do { *(bf16x8*)(V_lds + (bf) * SHM_V + vst0) = S.st_v0; *(bf16x8*)(V_lds + (bf) * SHM_V + vst1) = S.st_v1; } while (0)
#define SWRITE_H(bf) do { SWRITE_HV(bf); SWRITE_HK(bf); } while (0)
#define SLOAD_F(p, k0) do { S.sf0 = *(const f32x4*)ROW(p, k0, sr); S.sf1 = *(const f32x4*)(ROW(p, k0, sr) + 4);                \
                            S.sf2 = *(const f32x4*)ROW(p, k0, 32 + sr); S.sf3 = *(const f32x4*)(ROW(p, k0, 32 + sr) + 4); } while (0)
#define SWRITE_KF(bf) do { *(bf16x8*)(K_lds + (bf) * SHM_K + kws) = pack8(S.sf0, S.sf1); *(bf16x8*)(K_lds + (bf) * SHM_K + kws + 32 * 256) = pack8(S.sf2, S.sf3); } while (0)
#define SWRITE_VF(bf) do { *(bf16x8*)(V_lds + (bf) * SHM_V + vst0) = pack8(S.sf0, S.sf1); *(bf16x8*)(V_lds + (bf) * SHM_V + vst1) = pack8(S.sf2, S.sf3); } while (0)
template <class TIn, class TOut>
__device__ __forceinline__ void causal_swa_prime(const BlockRef<TIn, TOut>& cur, int W, char* lds, Seam<TIn>& S) {
    constexpr bool F32 = same_t<TIn, float>::v;
    const int tid = ltid(), wid = __builtin_amdgcn_readfirstlane(tid >> 6), lane = tid & 63, r32 = lane & 31, hi = lane >> 5;
    const int sr = tid >> 4, sc = (tid & 15) * 8, kws = KSWZ(sr, sc * 2); char* K_lds = lds + 2 * SHM_V;
    const int kb0 = swa_jlo(cur.P0, W) * KVBLK;
    for (int d0 = 0; d0 < 8; ++d0) S.qr[d0] = load8<TIn>(cur.Q + (size_t)(wid * QBLK + r32) * D + d0 * 16 + hi * 8);
    if constexpr (F32) { SLOAD_F((const float*)cur.K, kb0); VMW(); SWRITE_KF(0); SBAR(); SLOAD_F((const float*)cur.V, kb0); }
    else { SLOAD_H(cur.K, cur.V, kb0); VMW(); SWRITE_HK(0); }
    __syncthreads();
}
template <class TIn, class TOut>
__device__ __forceinline__ void causal_swa_block(const BlockRef<TIn, TOut>& cur, const BlockRef<TIn, TOut>& nxt, int skv, int W, char* lds, Seam<TIn>& S) {
    constexpr bool F32 = same_t<TIn, float>::v;
    const int tid = ltid(), wid = __builtin_amdgcn_readfirstlane(tid >> 6), lane = tid & 63, r32 = lane & 31, hi = lane >> 5;
    const int j_lo = swa_jlo(cur.P0, W);
    int j_hi = (cur.P0 + QB - 1) / KVBLK + 1; if (j_hi > skv / KVBLK) j_hi = skv / KVBLK;
    const int NT = j_hi - j_lo;
    const int kbn = swa_jlo(nxt.P0, W) * KVBLK;
    const int qlo = cur.P0 + wid * QBLK, qm = qlo + r32 - 4 * hi;
    char* V_lds = lds; char* K_lds = lds + 2 * SHM_V;
    float* ws = (float*)(lds + 2 * SHM_V + 2 * SHM_K) + wid * 64; float* li_l = ws, * al_l = ws + 32;
    float m_reg = -1e30f, l_reg = 0; f32x16 o[4] = {};
    float* fbuf = (float*)(lds + LDS_FB);
    { const int nk = cur.P0 + QB;
      for (int i4 = tid * 4; i4 < nk; i4 += 64 * NW * 4) *(f32x4*)(fbuf + i4) = *(const f32x4*)(cur.FB + i4);
      __syncthreads(); }
    const char* fbl = (const char*)fbuf + hi * 16;
    const int sr = tid >> 4, sc = (tid & 15) * 8, vst0 = v_st(sr, sc), vst1 = v_st(32 + sr, sc), kws = KSWZ(sr, sc * 2);
    const int vb0 = (int)(uintptr_t)V_lds + v_rd_base(lane);
    const TIn* Kh = cur.K; const TIn* Vh = cur.V;
#define RESC(a) do { if (__any((a) < 1.f)) { if (hi == 0) al_l[r32] = (a); asm volatile("s_waitcnt lgkmcnt(0)" ::: "memory");              \
                     for (int d_ = 0; d_ < 4; ++d_) for (int r = 0; r < 16; ++r) o[d_][r] *= al_l[crow(r, hi)]; } } while (0)
#define KBASE(t) ((j_lo + (t)) * KVBLK)
#define ACT(t) (KBASE(t) <= qlo + QBLK - 1 && KBASE(t) + KVBLK - 1 >= qlo - W + 1)
#define MASKT(P0_, P1_, t) do { const int kb_ = KBASE(t); if ((!SK || ACT(t)) && (kb_ + KVBLK - 1 > qlo || kb_ <= qlo + QBLK - 1 - W)) mask_tile(P0_, P1_, qm - kb_, (unsigned)W); } while (0)
    constexpr int NQL = F32 ? 16 : 8;
    constexpr bool SK = WSKIP && !F32;
#define SEAM_K0() do { VMWN(NQL); if constexpr (F32) { SWRITE_KF(0); SBAR(); SLOAD_F((const float*)nxt.V, kbn); } else { SWRITE_HK(0); } SBAR(); } while (0)
    f32x16 pA0, pA1, pB0, pB1; float mnA, mnB, alA, alB; bf16x8 pa0, pa1, pa2, pa3;
    if constexpr (F32) { VMW(); SWRITE_VF(0); SBAR(); } else { SWRITE_HV(0); SBAR(); }
    if (NT > 1) { if constexpr (F32) SLOAD_F((const float*)Kh, KBASE(1)); else SLOAD_H(Kh, Vh, KBASE(1)); }
    SBAR(); qkt<0, SK>(pA0, pA1, K_lds, r32, hi, S.qr, ACT(0), fbl + KBASE(0) * 4);
    if constexpr (F32) { if (NT > 1) { VMW(); SWRITE_KF(1); SBAR(); SLOAD_F((const float*)Vh, KBASE(1)); } }
    MASKT(pA0, pA1, 0); partialSM(pA0, pA1, m_reg, mnA, alA);
    if (NT > 1) { VMW(); if constexpr (F32) { SWRITE_VF(1); SBAR(); if (NT > 2) SLOAD_F((const float*)Kh, KBASE(2)); } else SWRITE_H(1); }
    __syncthreads();
#define HALF_STEP(PX0, PX1, mnX, alX, PY0, PY1, alY, t, KB, VB, SB) do {                                                      \
        SBAR(); qkt<KB, SK>(PX0, PX1, K_lds, r32, hi, S.qr, ACT(t), fbl + KBASE(t) * 4);                                             \
        finishSM(PY0, PY1, alY, l_reg, pa0, pa1, pa2, pa3); SBAR();                                                           \
        if ((t) + 1 < NT) { if constexpr (F32) { VMW(); SWRITE_KF(SB); SBAR(); SLOAD_F((const float*)Vh, KBASE((t) + 1)); }  \
                            else { SLOAD_H(Kh, Vh, KBASE((t) + 1)); } SBAR(); }                                               \
        pv_tile<VB, SK>(o, vb0, pa0, pa1, pa2, pa3, ACT((t) - 1)); MASKT(PX0, PX1, (t)); partialSM(PX0, PX1, m_reg, mnX, alX);                                        \
        __syncthreads();                                                                                                      \
        if ((t) + 1 < NT) { VMW(); if constexpr (F32) { SWRITE_VF(SB); SBAR(); if ((t) + 2 < NT) SLOAD_F((const float*)Kh, KBASE((t) + 2)); } \
                            else { SWRITE_H(SB); } }                                                                          \
        RESC(alX); __syncthreads(); } while (0)
    for (int t = 1; t + 1 < NT; t += 2) {
        HALF_STEP(pB0, pB1, mnB, alB, pA0, pA1, alA, t, 1, 0, 0);
        HALF_STEP(pA0, pA1, mnA, alA, pB0, pB1, alB, t + 1, 0, 1, 1);
    }
    const bool even = (NT & 1) == 0;
    if (even) { SBAR(); qkt<1, SK>(pB0, pB1, K_lds, r32, hi, S.qr, ACT(NT - 1), fbl + KBASE(NT - 1) * 4); SBAR(); }
#define QROW(e) (nxt.Q + (size_t)(wid * QBLK + r32) * D + ((e) >> 1) * 16 + hi * 8 + ((e) & 1) * 4)
    if constexpr (F32) { SLOAD_F((const float*)nxt.K, kbn); SBAR();
#pragma unroll
        for (int e = 0; e < 8; ++e) S.tq[e] = *(const f32x4*)QROW(e); }
    else { SLOAD_H(nxt.K, nxt.V, kbn); SBAR();
#pragma unroll
        for (int d0 = 0; d0 < 8; ++d0) S.qr[d0] = load8<TIn>(nxt.Q + (size_t)(wid * QBLK + r32) * D + d0 * 16 + hi * 8); }
    SBAR();
    finishSM(pA0, pA1, alA, l_reg, pa0, pa1, pa2, pa3); SBAR();
    if constexpr (F32) {
#pragma unroll
        for (int e = 8; e < 16; ++e) S.tq[e] = *(const f32x4*)QROW(e); SBAR(); }
#undef QROW
    pv_tile<0, SK>(o, vb0, pa0, pa1, pa2, pa3, ACT(even ? NT - 2 : NT - 1));
    if (even) { MASKT(pB0, pB1, NT - 1); partialSM(pB0, pB1, m_reg, mnB, alB); __syncthreads(); RESC(alB);
        finishSM(pB0, pB1, alB, l_reg, pa0, pa1, pa2, pa3); SBAR(); pv_tile<1, SK>(o, vb0, pa0, pa1, pa2, pa3, ACT(NT - 1)); }
    SBAR(); SEAM_K0();
    if (hi == 0) li_l[r32] = l_reg; asm volatile("s_waitcnt lgkmcnt(0)" ::: "memory");
    float rli[16];
#pragma unroll
    for (int r = 0; r < 16; ++r) rli[r] = __builtin_amdgcn_rcpf(li_l[crow(r, hi)]);
    TOut* Ow = cur.O + (size_t)(wid * QBLK) * OPITCH;
#pragma unroll
    for (int r = 0; r < 16; ++r) { const int orow = crow(r, hi);
#pragma unroll
        for (int d0 = 0; d0 < 4; ++d0) { const float v = o[d0][r] * rli[r];
            if constexpr (same_t<TOut, float>::v) { Ow[(size_t)orow * OPITCH + d0 * 32 + r32] = v; }
            else { const float vn = __shfl_xor(v, 1);
                   if ((r32 & 1) == 0) *(unsigned*)(Ow + (size_t)orow * OPITCH + d0 * 32 + r32) = cvtpk(v, vn); } } }
    if constexpr (F32) {
#pragma unroll
        for (int d0 = 0; d0 < 8; ++d0) S.qr[d0] = pack8(S.tq[2 * d0], S.tq[2 * d0 + 1]); }
    __syncthreads();
#undef RESC
#undef KBASE
#undef ACT
#undef MASKT
#undef SEAM_K0
#undef HALF_STEP
}
#undef ROW
#undef VMW
#undef VMWN
#undef SLOAD_H
#undef SWRITE_HK
#undef SWRITE_HV
#undef SWRITE_H
#undef SLOAD_F
#undef SWRITE_KF
#undef SWRITE_VF
constexpr int NQB = SQ / QB, NXI = NQB / 2, NITEMS = NXI * B * H;
struct SwaItem { int bh, qb0, qb1; };
__device__ __forceinline__ SwaItem swa_decode(int L) { SwaItem it; it.bh = L / NXI; const int x = L - it.bh * NXI; it.qb0 = x; it.qb1 = NQB - 1 - x; return it; }
template <class TIn, class TOut>
__device__ __forceinline__ BlockRef<TIn, TOut> swa_ref(const SwaItem& it, int pass, const TIn* Q, const TIn* K, const TIn* V, TOut* O, const float* FB) {
    const int qb = pass ? it.qb1 : it.qb0;
    BlockRef<TIn, TOut> r;
    r.Q = Q + ((size_t)it.bh * SQ + (size_t)qb * QB) * D;
    r.O = O + ((size_t)(it.bh / H) * SQ + (size_t)qb * QB) * OPITCH + (it.bh % H) * D;
    r.K = K + (size_t)it.bh * SKV * D; r.V = V + (size_t)it.bh * SKV * D; r.FB = FB + (size_t)it.bh * SKV; r.P0 = qb * QB;
    return r;
}
__device__ __forceinline__ void att_phase(char* lds, const bf16* Q, const bf16* K, const bf16* V, bf16* O, const float* FB, int wg, int nwg) {
    int L = wg; if (L >= NITEMS) return;
    SwaItem it = swa_decode(L); int pass = 0;
    BlockRef<bf16, bf16> cur = swa_ref<bf16, bf16>(it, 0, Q, K, V, O, FB);
    Seam<bf16> S;
    causal_swa_prime<bf16, bf16>(cur, WINDOW, lds, S);
    for (;;) {
        const bool more_pass = pass == 0 && it.qb1 != it.qb0, more_item = L + nwg < NITEMS, last = !more_pass && !more_item;
        SwaItem itn = it; int passn = pass + 1, Ln = L;
        if (!more_pass) { passn = 0; Ln = more_item ? L + nwg : L; itn = swa_decode(Ln); }
        const BlockRef<bf16, bf16> nxt = last ? cur : swa_ref<bf16, bf16>(itn, passn, Q, K, V, O, FB);
        causal_swa_block<bf16, bf16>(cur, nxt, SKV, WINDOW, lds, S);
        if (last) break;
        cur = nxt; it = itn; pass = passn; L = Ln;
    }
}
}
constexpr int DM = 2048, NBATCH = 8, SEQ = 4096, DEPTH = 4, NHEAD = 16, HDIM = 128, DFF = 5504, NFF2 = 2 * DFF, MTOK = NBATCH * SEQ;
constexpr int NQKVF = 3 * DM + NHEAD;
constexpr float EPS = 1e-6f;
constexpr int NWAVES = 8;
#ifndef MK_PER_PHASE
#define MK_PER_PHASE 0
#endif
constexpr size_t MiB = 1u << 20;
constexpr size_t WS_CTL = 0, CTL_ZERO_BYTES = 1 * MiB;
constexpr size_t WS_MOD = 1 * MiB;
constexpr size_t WS_LOGF = 3 * MiB;
constexpr size_t WS_FB = 5 * MiB;
constexpr size_t WS_VRSTD = 7 * MiB;
constexpr size_t WS_WF = 7 * MiB + 512 * 1024;
constexpr size_t WS_WQKV = 8 * MiB;
constexpr size_t WS_WO = 56 * MiB;
constexpr size_t WS_WGI = 72 * MiB;
constexpr size_t WS_WGO = 104 * MiB;
constexpr size_t WS_WF1 = 120 * MiB;
constexpr size_t WS_WF2 = 292 * MiB;
constexpr size_t WS_H = 378 * MiB;
constexpr size_t WS_R = 506 * MiB;
constexpr size_t WS_END = WS_R + 688 * MiB;
constexpr int CW_TMO = 0, CW_BAR = 4096;

constexpr int RING_OFF = 0, RING_BYTES = 131072;
constexpr int LDSCTL_OFF = 143360, MISC_OFF = LDSCTL_OFF + 320;
constexpr int LDS_BYTES = 147456;

#define GAS __attribute__((address_space(1)))
#define LAS __attribute__((address_space(3)))
typedef unsigned short bf16;
typedef unsigned v4u __attribute__((ext_vector_type(4)));
typedef unsigned v2u __attribute__((ext_vector_type(2)));
typedef float f32x4 __attribute__((ext_vector_type(4)));
typedef short bf16x8 __attribute__((ext_vector_type(8)));
typedef GAS unsigned gu32;
#define RLX_AGENT __ATOMIC_RELAXED, __HIP_MEMORY_SCOPE_AGENT
#define LDS_WAIT() asm volatile("s_waitcnt lgkmcnt(0)" ::: "memory")
#define VM_WAIT() asm volatile("s_waitcnt vmcnt(0)" ::: "memory")
__device__ __forceinline__ unsigned f2bf(float f) { unsigned u = __builtin_bit_cast(unsigned, f); return (u + 0x7fffu + ((u >> 16) & 1u)) >> 16; }
__device__ __forceinline__ unsigned pk2(float lo, float hi) { return f2bf(lo) | (f2bf(hi) << 16); }
__device__ __forceinline__ float bf2f(unsigned short b) { return __builtin_bit_cast(float, (unsigned)b << 16); }
__device__ __forceinline__ float bflo(unsigned w) { return __builtin_bit_cast(float, w << 16); }
__device__ __forceinline__ float bfhi(unsigned w) { return __builtin_bit_cast(float, w & 0xffff0000u); }
#define XB_TMO      128
#define XB_XCNT(j)  (256  + 64 * (j))
#define XB_XSUB(j)  (1280 + 64 * (j))
#define XB_XGEN(j)  (2304 + 64 * (j))
#define XB_TOP      3328
#define XB_TOPGEN   3392
#define XCD_BAR_WORDS 3456
#define XB_SPIN_CAP (1u << 18)

__device__ __forceinline__ unsigned xb_ld(unsigned* p)              { return __hip_atomic_load((GAS unsigned*)p, __ATOMIC_RELAXED, __HIP_MEMORY_SCOPE_AGENT); }
__device__ __forceinline__ unsigned xb_add(unsigned* p, unsigned v) { return __hip_atomic_fetch_add((GAS unsigned*)p, v, __ATOMIC_RELAXED, __HIP_MEMORY_SCOPE_AGENT); }
__device__ __forceinline__ unsigned xb_xcc_id() { return (unsigned)__builtin_amdgcn_s_getreg((3 << 11) | 20) & 0xFu; }
#define XB_SPIN(cond, bar) do { unsigned _sp = 0; while (cond) { __builtin_amdgcn_s_sleep(1); \
    if ((++_sp & 255u) == 0u) { if (xb_ld(&(bar)[XB_TMO])) break; if (_sp > XB_SPIN_CAP) { xb_add(&(bar)[XB_TMO], 1u); break; } } } } while (0)

struct XcdBarrier {
    unsigned* bar; unsigned x;
    volatile LAS unsigned* st;
};

__device__ __forceinline__ XcdBarrier xcd_barrier_post(unsigned* bar, volatile LAS unsigned* st) {
    XcdBarrier b; b.bar = bar; b.x = xb_xcc_id(); b.st = st;
    if (threadIdx.x == 0) (void)xb_add(&bar[XB_XCNT(b.x)], 1u);
    return b;
}
__device__ __forceinline__ void xcd_barrier_complete(unsigned* bar, unsigned x, unsigned& nloc, unsigned& nx) {
    const unsigned G = gridDim.x * gridDim.y * gridDim.z;
    unsigned sum, cnt, mine, sp = 0u;
    for (;;) {
        sum = 0u; cnt = 0u; mine = 0u;
#pragma unroll
        for (unsigned j = 0; j < 16; ++j) { const unsigned c = xb_ld(&bar[XB_XCNT(j)]); sum += c; cnt += (c > 0u) ? 1u : 0u; mine = (j == x) ? c : mine; }
        if (sum == G) break;
        __builtin_amdgcn_s_sleep(1);
        if ((++sp & 255u) == 0u) { if (xb_ld(&bar[XB_TMO])) break; if (sp > XB_SPIN_CAP) { xb_add(&bar[XB_TMO], 1u); break; } }
    }
    nloc = mine > 0u ? mine : 1u; nx = cnt > 0u ? cnt : 1u;
}

__device__ __forceinline__ void xcd_barrier(const XcdBarrier& b) {
    asm volatile("s_waitcnt vmcnt(0)" ::: "memory");
    __syncthreads();
    if (threadIdx.x == 0) {
        unsigned* bar = b.bar;
        __builtin_amdgcn_s_waitcnt(0);
        unsigned nloc = b.st[0], nx = b.st[1];
        if (nloc == 0u) { xcd_barrier_complete(bar, b.x, nloc, nx); b.st[0] = nloc; b.st[1] = nx; }
        const unsigned old = xb_add(&bar[XB_XSUB(b.x)], 1u);
        const unsigned gen = old / nloc;
        if (old + 1u == (gen + 1u) * nloc) {
            __builtin_amdgcn_fence(__ATOMIC_RELEASE, "agent");
            asm volatile("s_waitcnt vmcnt(0)" ::: "memory");
            const unsigned og = xb_add(&bar[XB_TOP], 1u);
            const unsigned tg = og / nx;
            if (og + 1u == (tg + 1u) * nx) xb_add(&bar[XB_TOPGEN], 1u);
            else XB_SPIN(xb_ld(&bar[XB_TOPGEN]) == tg, bar);
            __builtin_amdgcn_fence(__ATOMIC_ACQUIRE, "agent");
            xb_add(&bar[XB_XGEN(b.x)], 1u);
            asm volatile("s_waitcnt vmcnt(0)" ::: "memory");
        } else {
            XB_SPIN(xb_ld(&bar[XB_XGEN(b.x)]) == gen, bar);
            __builtin_amdgcn_fence(__ATOMIC_ACQUIRE, "agent");
            asm volatile("s_waitcnt vmcnt(0)" ::: "memory");
        }
    }
    __syncthreads();
}
struct Frame {
    LAS unsigned char* lds; char* ldsg;
    volatile LAS unsigned* MISC;
    int tid, lane, wave, vcu, G, bid;
    const GAS float* const __attribute__((address_space(4)))* inp;
    GAS float* outg; GAS unsigned char* wsg;
    __device__ __forceinline__ const float* in(int i) const { return (const float*)inp[i]; }
};
enum { IN_X = 0, IN_C, IN_MODW, IN_MODB, IN_MIXG, IN_FFNG, IN_AWIN, IN_ABF, IN_AWO, IN_GWIN, IN_GVG, IN_GWS, IN_GBS, IN_GWO, IN_FWIN, IN_FCW, IN_FCB, IN_FWOUT, IN_FING };
enum { MW_BID = 16, MW_G, MW_VCU, MW_INP, MW_INP_HI, MW_WS, MW_WS_HI, MW_OUT, MW_OUT_HI };
__device__ __forceinline__ unsigned misc_rd(const Frame& F, int k) { return (unsigned)__builtin_amdgcn_readfirstlane((int)F.MISC[k]); }
__device__ __forceinline__ bool relaunder(Frame& F) {
    int t = (int)threadIdx.x; asm volatile("" : "+v"(t)); F.tid = t; F.lane = t & 63; F.wave = __builtin_amdgcn_readfirstlane(t >> 6);
    F.bid = (int)misc_rd(F, MW_BID); F.G = (int)misc_rd(F, MW_G); F.vcu = (int)misc_rd(F, MW_VCU);
    F.inp = (const GAS float* const __attribute__((address_space(4)))*)(((unsigned long long)misc_rd(F, MW_INP_HI) << 32) | misc_rd(F, MW_INP));
    F.wsg = (GAS unsigned char*)(((unsigned long long)misc_rd(F, MW_WS_HI) << 32) | misc_rd(F, MW_WS));
    F.outg = (GAS float*)(((unsigned long long)misc_rd(F, MW_OUT_HI) << 32) | misc_rd(F, MW_OUT));
    return true; }
__device__ __forceinline__ float wave_sum(float v) {
#pragma unroll
    for (int o = 1; o < 64; o <<= 1) v += __shfl_xor(v, o);
    return v;
}
__device__ __forceinline__ void transpose_item(const float* W, int ldw, int K, bf16* WT, int k0, int n0, int dst_row0, int ncols, LAS float* scr, int lane) {
    const int nl = lane & 31;
#pragma unroll 8
    for (int i = 0; i < 32; ++i) { const int kk = 2 * i + (lane >> 5); if (nl < ncols) scr[kk * 33 + nl] = W[(size_t)(k0 + kk) * ldw + n0 + nl]; }
    LDS_WAIT(); asm volatile("" ::: "memory");
    const int c = lane & 7;
#pragma unroll
    for (int j = 0; j < 4; ++j) { const int n = (lane >> 3) + 8 * j; const LAS float* s = scr + (8 * c) * 33 + n;
        if (n < ncols) { v4u o; o.x = pk2(s[0 * 33], s[1 * 33]); o.y = pk2(s[2 * 33], s[3 * 33]); o.z = pk2(s[4 * 33], s[5 * 33]); o.w = pk2(s[6 * 33], s[7 * 33]);
            *(GAS v4u*)(WT + (size_t)(dst_row0 + n) * K + k0 + 8 * c) = o; } }
    LDS_WAIT(); asm volatile("" ::: "memory");
}
__device__ __forceinline__ void pro_phase(Frame& F) {
    {
        LAS float* cact = (LAS float*)(F.lds + RING_OFF);
        LAS float* red = (LAS float*)(F.lds + RING_OFF + 65536);
        float* mod = (float*)((unsigned char*)F.wsg + WS_MOD);
        for (int item = F.bid; item < 192; item += F.G) {
            for (int idx = F.tid; idx < NBATCH * DM; idx += NWAVES * 64) { const int b = idx >> 11, k = idx & 2047; const float v = F.in(IN_C)[idx]; cact[k * 8 + b] = v / (1.0f + __expf(-v)); }
            __syncthreads();
            const int i = item / 48, nbase = (item % 48) * 256;
            const float* wp = F.in(IN_MODW) + ((size_t)i * DM + F.wave * 256) * 12288 + nbase + F.lane * 4;
            f32x4 acc[8];
#pragma unroll
            for (int b = 0; b < 8; ++b) acc[b] = (f32x4){0.f, 0.f, 0.f, 0.f};
#pragma unroll 8
            for (int kk = 0; kk < 256; ++kk) {
                const f32x4 w = *(const GAS f32x4*)(wp + (size_t)kk * 12288);
                const LAS f32x4* cp = (const LAS f32x4*)(cact + (F.wave * 256 + kk) * 8);
                const f32x4 c0 = cp[0], c1 = cp[1];
                acc[0] += w * c0.x; acc[1] += w * c0.y; acc[2] += w * c0.z; acc[3] += w * c0.w;
                acc[4] += w * c1.x; acc[5] += w * c1.y; acc[6] += w * c1.z; acc[7] += w * c1.w;
            }
#pragma unroll
            for (int b = 0; b < 8; ++b) *(LAS f32x4*)(red + (F.wave * 8 + b) * 256 + F.lane * 4) = acc[b];
            __syncthreads();
            for (int o = F.tid; o < 2048; o += NWAVES * 64) { const int b = o >> 8, col = o & 255; float s = 0.f;
#pragma unroll
                for (int w = 0; w < 8; ++w) s += red[(w * 8 + b) * 256 + col];
                mod[((size_t)i * 8 + b) * 12288 + nbase + col] = s + F.in(IN_MODB)[i * 12288 + nbase + col]; }
            __syncthreads();
        }
    }
    LAS float* scr = (LAS float*)(F.lds + RING_OFF + F.wave * 16384);
    const int gw = F.vcu * NWAVES + F.wave, NGW = F.G * NWAVES;
    constexpr int I_QKV = 32 * 192, I_F = 32, I_O = 32 * 64, I_GI = 32 * 128, I_GO = 32 * 64, I_F1 = 32 * 344, I_F2 = 86 * 64;
    constexpr int NITEMS = 2 * (I_QKV + I_F + I_O + I_GI + I_GO) + 4 * (I_F1 + I_F2);
    bf16* Wqkv = (bf16*)((unsigned char*)F.wsg + WS_WQKV); bf16* Wf = (bf16*)((unsigned char*)F.wsg + WS_WF); bf16* Wo = (bf16*)((unsigned char*)F.wsg + WS_WO); bf16* Wgi = (bf16*)((unsigned char*)F.wsg + WS_WGI);
    bf16* Wgo = (bf16*)((unsigned char*)F.wsg + WS_WGO); bf16* Wf1 = (bf16*)((unsigned char*)F.wsg + WS_WF1); bf16* Wf2 = (bf16*)((unsigned char*)F.wsg + WS_WF2);
    for (int it = gw; it < NITEMS; it += NGW) {
        int r = it;
        if (r < 2 * I_QKV) { const int j = r / I_QKV, q = r % I_QKV, kb = q / 192, nb = q % 192;
            transpose_item(F.in(IN_AWIN) + (size_t)j * DM * NQKVF, NQKVF, DM, Wqkv + (size_t)j * 6144 * DM, 64 * kb, 32 * nb, 32 * nb, 32, scr, F.lane); continue; } r -= 2 * I_QKV;
        if (r < 2 * I_F) { const int j = r / I_F, kb = r % I_F;
            transpose_item(F.in(IN_AWIN) + (size_t)j * DM * NQKVF, NQKVF, DM, Wf + (size_t)j * 16 * DM, 64 * kb, 6144, 0, 16, scr, F.lane); continue; } r -= 2 * I_F;
        if (r < 2 * I_O) { const int j = r / I_O, q = r % I_O, kb = q / 64, nb = q % 64;
            transpose_item(F.in(IN_AWO) + (size_t)j * DM * DM, DM, DM, Wo + (size_t)j * DM * DM, 64 * kb, 32 * nb, 32 * nb, 32, scr, F.lane); continue; } r -= 2 * I_O;
        if (r < 2 * I_GI) { const int j = r / I_GI, q = r % I_GI, kb = q / 128, nb = q % 128;
            transpose_item(F.in(IN_GWIN) + (size_t)j * DM * 4096, 4096, DM, Wgi + (size_t)j * 4096 * DM, 64 * kb, 32 * nb, 32 * nb, 32, scr, F.lane); continue; } r -= 2 * I_GI;
        if (r < 2 * I_GO) { const int j = r / I_GO, q = r % I_GO, kb = q / 64, nb = q % 64;
            transpose_item(F.in(IN_GWO) + (size_t)j * DM * DM, DM, DM, Wgo + (size_t)j * DM * DM, 64 * kb, 32 * nb, 32 * nb, 32, scr, F.lane); continue; } r -= 2 * I_GO;
        if (r < 4 * I_F1) { const int j = r / I_F1, q = r % I_F1, kb = q / 344, nb = q % 344;
            transpose_item(F.in(IN_FWIN) + (size_t)j * DM * NFF2, NFF2, DM, Wf1 + (size_t)j * NFF2 * DM, 64 * kb, 32 * nb, 32 * nb, 32, scr, F.lane); continue; } r -= 4 * I_F1;
        { const int j = r / I_F2, q = r % I_F2, kb = q / 64, nb = q % 64;
            transpose_item(F.in(IN_FWOUT) + (size_t)j * DFF * DM, DM, DFF, Wf2 + (size_t)j * DM * DFF, 64 * kb, 32 * nb, 32 * nb, 32, scr, F.lane); }
    }
}
__device__ __forceinline__ void norm_phase(Frame& F, const float* xin, const float* g, const float* shift, const float* scale, bf16* H) {
    const int gw = F.vcu * NWAVES + F.wave, NGW = F.G * NWAVES;
    for (int rb = gw; rb < MTOK / 16; rb += NGW) {
        const int b = (rb * 16) >> 12;
        f32x4 gs[8], sh[8];
#pragma unroll
        for (int j = 0; j < 8; ++j) { const int c4 = F.lane + 64 * j;
            gs[j] = ((const GAS f32x4*)g)[c4] * (((const GAS f32x4*)(scale + (size_t)b * 12288))[c4] + 1.0f); sh[j] = ((const GAS f32x4*)(shift + (size_t)b * 12288))[c4]; }
        for (int r = 0; r < 16; ++r) { const size_t row = (size_t)rb * 16 + r;
            const GAS f32x4* xr = (const GAS f32x4*)(xin + row * DM) + F.lane;
            f32x4 v[8]; float ss = 0.f;
#pragma unroll
            for (int j = 0; j < 8; ++j) { v[j] = xr[64 * j]; ss += (v[j].x * v[j].x + v[j].y * v[j].y) + (v[j].z * v[j].z + v[j].w * v[j].w); }
            const float rstd = 1.0f / sqrtf(wave_sum(ss) * (1.0f / DM) + EPS);
            GAS v2u* o8 = (GAS v2u*)(H + row * DM) + F.lane;
#pragma unroll
            for (int j = 0; j < 8; ++j) { const f32x4 o = v[j] * rstd * gs[j] + sh[j]; v2u w; w.x = pk2(o.x, o.y); w.y = pk2(o.z, o.w); o8[64 * j] = w; } }
    }
}
__device__ __forceinline__ void normf_phase(Frame& F, float* x, const float* g) {
    const int gw = F.vcu * NWAVES + F.wave, NGW = F.G * NWAVES;
    for (int rb = gw; rb < MTOK / 16; rb += NGW) {
        f32x4 gs[8];
#pragma unroll
        for (int j = 0; j < 8; ++j) gs[j] = ((const GAS f32x4*)g)[F.lane + 64 * j];
        for (int r = 0; r < 16; ++r) { const size_t row = (size_t)rb * 16 + r;
            GAS f32x4* xr = (GAS f32x4*)(x + row * DM) + F.lane;
            f32x4 v[8]; float ss = 0.f;
#pragma unroll
            for (int j = 0; j < 8; ++j) { v[j] = xr[64 * j]; ss += (v[j].x * v[j].x + v[j].y * v[j].y) + (v[j].z * v[j].z + v[j].w * v[j].w); }
            const float rstd = 1.0f / sqrtf(wave_sum(ss) * (1.0f / DM) + EPS);
#pragma unroll
            for (int j = 0; j < 8; ++j) xr[64 * j] = v[j] * rstd * gs[j]; }
    }
}
__device__ __forceinline__ void fg_phase(Frame& F, const bf16* H, const bf16* Wf, const float* bfv, float* LOGF) {
    const int gw = F.vcu * NWAVES + F.wave, NGW = F.G * NWAVES, fr = F.lane & 15, fq = F.lane >> 4;
    for (int rb = gw; rb < MTOK / 16; rb += NGW) {
        const GAS bf16x8* ap = (const GAS bf16x8*)(H + ((size_t)rb * 16 + fr) * DM + fq * 8);
        const GAS bf16x8* bp = (const GAS bf16x8*)(Wf + (size_t)fr * DM + fq * 8);
        f32x4 acc = (f32x4){0.f, 0.f, 0.f, 0.f};
#pragma unroll 8
        for (int ks = 0; ks < 64; ++ks) acc = __builtin_amdgcn_mfma_f32_16x16x32_bf16(bp[ks * 4], ap[ks * 4], acc, 0, 0, 0);
        const f32x4 bb = *(const GAS f32x4*)(bfv + 4 * fq); f32x4 o;
#pragma unroll
        for (int i = 0; i < 4; ++i) { const float z = acc[i] + bb[i]; o[i] = fminf(z, 0.f) - log1pf(__expf(-fabsf(z))); }
        *(GAS f32x4*)(LOGF + ((size_t)rb * 16 + fr) * 16 + 4 * fq) = o;
    }
}
__device__ __forceinline__ void cum_phase(Frame& F, const float* LOGF, float* FB) {
    const int gw = F.vcu * NWAVES + F.wave, NGW = F.G * NWAVES;
    for (int bh = gw; bh < NBATCH * NHEAD; bh += NGW) { const int b = bh >> 4, h = bh & 15;
        const float* p = LOGF + ((size_t)b * SEQ + F.lane * 64) * 16 + h;
        float v[64]; float s = 0.f;
#pragma unroll
        for (int i = 0; i < 64; ++i) { s += p[i * 16]; v[i] = s; }
        float incl = s;
#pragma unroll
        for (int o = 1; o < 64; o <<= 1) { const float t = __shfl_up(incl, o); if (F.lane >= o) incl += t; }
        const float excl = incl - s;
        GAS f32x4* q = (GAS f32x4*)(FB + (size_t)bh * SEQ + F.lane * 64);
#pragma unroll
        for (int i = 0; i < 16; ++i) q[i] = (f32x4){-(excl + v[4 * i]) * 1.4426950408889634f, -(excl + v[4 * i + 1]) * 1.4426950408889634f, -(excl + v[4 * i + 2]) * 1.4426950408889634f, -(excl + v[4 * i + 3]) * 1.4426950408889634f};
    }
}
__device__ __forceinline__ void vstat_phase(Frame& F, const bf16* Z, float* VRSTD) {
    const int gw = F.vcu * NWAVES + F.wave, NGW = F.G * NWAVES;
    for (int rb = gw; rb < MTOK / 16; rb += NGW)
        for (int r = 0; r < 16; ++r) { const size_t row = (size_t)rb * 16 + r;
            const GAS v4u* vp = (const GAS v4u*)(Z + row * 4096 + 2048) + F.lane; float ss = 0.f;
#pragma unroll
            for (int j = 0; j < 4; ++j) { const v4u w = vp[64 * j];
#pragma unroll
                for (int e = 0; e < 4; ++e) { const float a = bflo(w[e]), c = bfhi(w[e]); ss += a * a + c * c; } }
            const float rstd = 1.0f / sqrtf(wave_sum(ss) * (1.0f / DM) + EPS);
            if (F.lane == 0) VRSTD[row] = rstd; }
}
__device__ __forceinline__ void gate_phase(Frame& F, const bf16* Z, const float* VRSTD, const float* vg, const float* Ws, const float* bs, bf16* GT) {
    LAS float* Wl = (LAS float*)(F.lds + RING_OFF);
    LAS float* vn = (LAS float*)(F.lds + RING_OFF + 66048);
    const int t = 64 * (F.wave & 1) + F.lane, dg = F.wave >> 1;
    for (int item = F.bid; item < (MTOK / 128) * 16; item += F.G) {
        const int ch = item >> 4, g = item & 15; const size_t row0 = (size_t)ch * 128;
        for (int idx = F.tid; idx < 128 * 128; idx += NWAVES * 64) { const int tt = idx >> 7, s = idx & 127; const float w = Ws[((size_t)g * 128 + tt) * 128 + s]; Wl[tt * 129 + s] = (s <= tt) ? w : 0.f; }
        for (int idx = F.tid; idx < 128 * 16; idx += NWAVES * 64) { const int s = idx >> 4, d8 = (idx & 15) * 8;
            const v4u w = *(const GAS v4u*)(Z + (row0 + s) * 4096 + 2048 + g * 128 + d8); const float rs = VRSTD[row0 + s];
            const f32x4 g0 = *(const GAS f32x4*)(vg + g * 128 + d8), g1 = *(const GAS f32x4*)(vg + g * 128 + d8 + 4);
            *(LAS f32x4*)(vn + s * 128 + d8) = (f32x4){bflo(w.x) * rs * g0.x, bfhi(w.x) * rs * g0.y, bflo(w.y) * rs * g0.z, bfhi(w.y) * rs * g0.w};
            *(LAS f32x4*)(vn + s * 128 + d8 + 4) = (f32x4){bflo(w.z) * rs * g1.x, bfhi(w.z) * rs * g1.y, bflo(w.w) * rs * g1.z, bfhi(w.w) * rs * g1.w}; }
        __syncthreads();
        f32x4 acc[8];
#pragma unroll
        for (int i = 0; i < 8; ++i) acc[i] = (f32x4){0.f, 0.f, 0.f, 0.f};
        const int smax = 64 * (F.wave & 1) + 63;
        for (int s = 0; s <= smax; ++s) { const float w = Wl[t * 129 + s]; const LAS f32x4* vr = (const LAS f32x4*)(vn + s * 128 + dg * 32);
#pragma unroll
            for (int i = 0; i < 8; ++i) acc[i] += vr[i] * w; }
        const float bias = bs[g * 128 + t];
        const GAS v4u* up = (const GAS v4u*)(Z + (row0 + t) * 4096 + g * 128 + dg * 32);
        GAS v4u* op = (GAS v4u*)(GT + (row0 + t) * DM + g * 128 + dg * 32);
#pragma unroll
        for (int i = 0; i < 4; ++i) { const v4u uw = up[i]; const f32x4 a0 = acc[2 * i] + bias, a1 = acc[2 * i + 1] + bias; v4u o;
            o.x = pk2(bflo(uw.x) * a0.x, bfhi(uw.x) * a0.y); o.y = pk2(bflo(uw.y) * a0.z, bfhi(uw.y) * a0.w);
            o.z = pk2(bflo(uw.z) * a1.x, bfhi(uw.z) * a1.y); o.w = pk2(bflo(uw.w) * a1.z, bfhi(uw.w) * a1.w); op[i] = o; }
        __syncthreads();
    }
}
__device__ __forceinline__ void conv_phase(Frame& F, const bf16* A, int tok0, int rows, const float* cw, const float* cb, bf16* ACT) {
    const int nitems = (rows / 16) * (DFF / 8);
    for (int item = F.bid * (NWAVES * 64) + F.tid; item < nitems; item += F.G * NWAVES * 64) {
        const int run = item / (DFF / 8), c8 = (item % (DFF / 8)) * 8, r0 = run * 16, t0 = (tok0 + r0) & (SEQ - 1);
        float wg[3][8], wu[3][8], bg[8], bu[8];
#pragma unroll
        for (int j = 0; j < 3; ++j)
#pragma unroll
            for (int e = 0; e < 8; ++e) { wg[j][e] = cw[j * NFF2 + c8 + e]; wu[j][e] = cw[j * NFF2 + DFF + c8 + e]; }
#pragma unroll
        for (int e = 0; e < 8; ++e) { bg[e] = cb[c8 + e]; bu[e] = cb[DFF + c8 + e]; }
        float g2[8], g1[8], u2[8], u1[8];
        if (t0 >= 2) { const v4u a = *(const GAS v4u*)(A + (size_t)(r0 - 2) * NFF2 + c8), bq = *(const GAS v4u*)(A + (size_t)(r0 - 1) * NFF2 + c8);
                       const v4u c = *(const GAS v4u*)(A + (size_t)(r0 - 2) * NFF2 + DFF + c8), d = *(const GAS v4u*)(A + (size_t)(r0 - 1) * NFF2 + DFF + c8);
#pragma unroll
            for (int e = 0; e < 4; ++e) { g2[2 * e] = bflo(a[e]); g2[2 * e + 1] = bfhi(a[e]); g1[2 * e] = bflo(bq[e]); g1[2 * e + 1] = bfhi(bq[e]);
                                          u2[2 * e] = bflo(c[e]); u2[2 * e + 1] = bfhi(c[e]); u1[2 * e] = bflo(d[e]); u1[2 * e + 1] = bfhi(d[e]); } }
        else {
#pragma unroll
            for (int e = 0; e < 8; ++e) { g2[e] = 0.f; g1[e] = 0.f; u2[e] = 0.f; u1[e] = 0.f; } }
        for (int r = 0; r < 16; ++r) {
            const v4u a = *(const GAS v4u*)(A + (size_t)(r0 + r) * NFF2 + c8), c = *(const GAS v4u*)(A + (size_t)(r0 + r) * NFF2 + DFF + c8);
            float g0[8], u0[8], o[8];
#pragma unroll
            for (int e = 0; e < 4; ++e) { g0[2 * e] = bflo(a[e]); g0[2 * e + 1] = bfhi(a[e]); u0[2 * e] = bflo(c[e]); u0[2 * e + 1] = bfhi(c[e]); }
#pragma unroll
            for (int e = 0; e < 8; ++e) { const float cg = wg[0][e] * g2[e] + wg[1][e] * g1[e] + wg[2][e] * g0[e] + bg[e], cu = wu[0][e] * u2[e] + wu[1][e] * u1[e] + wu[2][e] * u0[e] + bu[e];
                o[e] = cg / (1.0f + __expf(-cg)) * cu; g2[e] = g1[e]; g1[e] = g0[e]; u2[e] = u1[e]; u1[e] = u0[e]; }
            v4u w; w.x = pk2(o[0], o[1]); w.y = pk2(o[2], o[3]); w.z = pk2(o[4], o[5]); w.w = pk2(o[6], o[7]);
            *(GAS v4u*)(ACT + (size_t)(tok0 + r0 + r) * DFF + c8) = w; }
    }
}
constexpr int NPHASE = 1 + DEPTH * 11 + 1;
struct Args { const float* in[19]; float* out; unsigned char* ws; int ph_lo, ph_hi; };
static_assert(sizeof(Args) == 19 * 8 + 8 + 8 + 8, "Args has no padding bytes");
#ifndef MK_EN
#define MK_EN 0xffffffffu
#endif
#define EN(k) (((MK_EN) >> (k)) & 1u)
#define W_MOD   ((float*)((unsigned char*)F.wsg + WS_MOD))
#define W_H     ((bf16*)((unsigned char*)F.wsg + WS_H))
#define W_Q     ((bf16*)((unsigned char*)F.wsg + WS_R))
#define W_K     ((bf16*)((unsigned char*)F.wsg + WS_R + 128 * MiB))
#define W_V     ((bf16*)((unsigned char*)F.wsg + WS_R + 256 * MiB))
#define W_Z     ((bf16*)((unsigned char*)F.wsg + WS_R))
#define W_A     ((bf16*)((unsigned char*)F.wsg + WS_R))
#define W_ACT   ((bf16*)((unsigned char*)F.wsg + WS_R + 344 * MiB))
#define W_LOGF  ((float*)((unsigned char*)F.wsg + WS_LOGF))
#define W_FB    ((float*)((unsigned char*)F.wsg + WS_FB))
#define W_VRSTD ((float*)((unsigned char*)F.wsg + WS_VRSTD))
#define W_MODI  (W_MOD + (size_t)i * 8 * 12288)
#define X_IN    ((i == 0) ? F.in(IN_X) : (const float*)(float*)F.outg)
__global__ void __launch_bounds__(NWAVES * 64, 2) mega_fwd(Args args) {
    extern __shared__ __attribute__((aligned(16))) unsigned char lds[];
    Frame F;
    F.lds = (LAS unsigned char*)lds; F.ldsg = (char*)lds;
    F.MISC = (volatile LAS unsigned*)(F.lds + MISC_OFF);
    for (int u = threadIdx.x; u < (LDS_BYTES - LDSCTL_OFF) / 4; u += NWAVES * 64) ((LAS unsigned*)(F.lds + LDSCTL_OFF))[u] = 0u;
    __syncthreads();
    if (threadIdx.x == 0) {
        const int G = gridDim.x, bx = blockIdx.x; const unsigned long long kp = (unsigned long long)__builtin_amdgcn_kernarg_segment_ptr(), wp = (unsigned long long)args.ws, op = (unsigned long long)args.out;
        F.MISC[MW_BID] = (unsigned)bx; F.MISC[MW_G] = (unsigned)G; F.MISC[MW_VCU] = (unsigned)((G % 8 == 0) ? (bx % 8) * (G / 8) + bx / 8 : bx);
        F.MISC[MW_INP] = (unsigned)kp; F.MISC[MW_INP_HI] = (unsigned)(kp >> 32); F.MISC[MW_WS] = (unsigned)wp; F.MISC[MW_WS_HI] = (unsigned)(wp >> 32); F.MISC[MW_OUT] = (unsigned)op; F.MISC[MW_OUT_HI] = (unsigned)(op >> 32);
    }
    __syncthreads();
    XcdBarrier bar; bar.bar = (unsigned*)(args.ws + WS_CTL) + CW_BAR; bar.x = 0; bar.st = nullptr;
    if (!MK_PER_PHASE) bar = xcd_barrier_post((unsigned*)(args.ws + WS_CTL) + CW_BAR, F.MISC + 8);
    const int lo = args.ph_lo, hi = args.ph_hi;
    int ph = 0;
#define RUN() (lo <= ph && ph < hi && relaunder(F))
#define SEAM() do { if (!MK_PER_PHASE) { if (lo <= ph && ph + 1 < hi) { relaunder(F); bar.bar = (unsigned*)((unsigned char*)F.wsg + WS_CTL) + CW_BAR; asm volatile("" : "+s"(bar.x)); xcd_barrier(bar); } } ++ph; } while (0)

    if (EN(0) && RUN()) pro_phase(F);
    SEAM();
    for (int i = 0; i < DEPTH; ++i) {
        const int j = i >> 1;
        if (EN(1) && RUN()) norm_phase(F, X_IN, F.in(IN_MIXG) + i * DM, W_MODI, W_MODI + DM, W_H);
        SEAM();
        if ((i & 1) == 0) {
            if (EN(2) && RUN()) {
                fg_phase(F, W_H, (const bf16*)((unsigned char*)F.wsg + WS_WF) + (size_t)j * 16 * DM, F.in(IN_ABF) + j * 16, W_LOGF);
                pg8::Gemm g{W_H, (const bf16*)((unsigned char*)F.wsg + WS_WQKV) + (size_t)j * 6144 * DM, MTOK, 6144, DM}; pg8::StaticOrder S; S.init(MTOK, 6144, F.G, F.bid);
                pg8::EpiQKV E{W_Q, (size_t)(64 * MiB), fox::QSCALE};
                pg8::gemm_phase<pg8::EpiQKV, pg8::StaticOrder, true, true>(F.lds + RING_OFF, g, S, E);
            }
            SEAM();
            if (EN(3) && RUN()) cum_phase(F, W_LOGF, W_FB);
            SEAM();
            if (EN(4) && RUN()) fox::att_phase(F.ldsg + RING_OFF, (const fox::bf16*)W_Q, (const fox::bf16*)W_K, (const fox::bf16*)W_V, (fox::bf16*)W_H, W_FB, F.bid, F.G);
            SEAM();
            if (EN(5) && RUN()) {
                pg8::Gemm g{W_H, (const bf16*)((unsigned char*)F.wsg + WS_WO) + (size_t)j * DM * DM, MTOK, DM, DM}; pg8::StaticOrder S; S.init(MTOK, DM, F.G, F.bid);
                pg8::EpiRes E{X_IN, (float*)F.outg, W_MODI + 2 * DM, 12288};
                pg8::gemm_phase<pg8::EpiRes, pg8::StaticOrder, true, true>(F.lds + RING_OFF, g, S, E);
            }
            SEAM();
        } else {
            if (EN(6) && RUN()) {
                pg8::Gemm g{W_H, (const bf16*)((unsigned char*)F.wsg + WS_WGI) + (size_t)j * 4096 * DM, MTOK, 4096, DM}; pg8::StaticOrder S; S.init(MTOK, 4096, F.G, F.bid);
                pg8::EpiStore<1> E{W_Z, 4096};
                pg8::gemm_phase<pg8::EpiStore<1>, pg8::StaticOrder, true, true>(F.lds + RING_OFF, g, S, E);
            }
            SEAM();
            if (EN(7) && RUN()) vstat_phase(F, W_Z, W_VRSTD);
            SEAM();
            if (EN(8) && RUN()) gate_phase(F, W_Z, W_VRSTD, F.in(IN_GVG) + j * DM, F.in(IN_GWS) + (size_t)j * 16 * 128 * 128, F.in(IN_GBS) + j * 16 * 128, W_H);
            SEAM();
            if (EN(9) && RUN()) {
                pg8::Gemm g{W_H, (const bf16*)((unsigned char*)F.wsg + WS_WGO) + (size_t)j * DM * DM, MTOK, DM, DM}; pg8::StaticOrder S; S.init(MTOK, DM, F.G, F.bid);
                pg8::EpiRes E{X_IN, (float*)F.outg, W_MODI + 2 * DM, 12288};
                pg8::gemm_phase<pg8::EpiRes, pg8::StaticOrder, true, true>(F.lds + RING_OFF, g, S, E);
            }
            SEAM();
        }
        if (EN(10) && RUN()) norm_phase(F, (float*)F.outg, F.in(IN_FFNG) + i * DM, W_MODI + 3 * DM, W_MODI + 4 * DM, W_H);
        SEAM();
        for (int half = 0; half < 2; ++half) {
            if (EN(11) && RUN()) {
                pg8::Gemm g{W_H + (size_t)half * (MTOK / 2) * DM, (const bf16*)((unsigned char*)F.wsg + WS_WF1) + (size_t)i * NFF2 * DM, MTOK / 2, NFF2, DM}; pg8::StaticOrder S; S.init(MTOK / 2, NFF2, F.G, F.bid);
                pg8::EpiStore<0> E{W_A, NFF2};
                pg8::gemm_phase<pg8::EpiStore<0>, pg8::StaticOrder, true, true>(F.lds + RING_OFF, g, S, E);
            }
            SEAM();
            if (EN(12) && RUN()) conv_phase(F, W_A, half * (MTOK / 2), MTOK / 2, F.in(IN_FCW) + (size_t)i * 3 * NFF2, F.in(IN_FCB) + (size_t)i * NFF2, W_ACT);
            SEAM();
        }
        if (EN(13) && RUN()) {
            pg8::Gemm g{W_ACT, (const bf16*)((unsigned char*)F.wsg + WS_WF2) + (size_t)i * DM * DFF, MTOK, DM, DFF}; pg8::StaticOrder S; S.init(MTOK, DM, F.G, F.bid);
            pg8::EpiRes E{(float*)F.outg, (float*)F.outg, W_MODI + 5 * DM, 12288};
            pg8::gemm_phase<pg8::EpiRes, pg8::StaticOrder, true, true>(F.lds + RING_OFF, g, S, E);
        }
        SEAM();
    }
    if (EN(14) && RUN()) normf_phase(F, (float*)F.outg, F.in(IN_FING));
#undef RUN
#undef SEAM
}

extern "C" void kernel_launch(void* const* d_in, const int* in_sizes, int n_in, void* d_out, int out_size, void* d_ws, size_t ws_size, hipStream_t stream) {
    static int grid = 0;
    if (grid == 0) {
        if (n_in != 19 || out_size != MTOK * DM || ws_size < WS_END) { fprintf(stderr, "kernel_launch: unexpected shapes (n_in %d, out %d, ws %zu < %zu)\n", n_in, out_size, ws_size, (size_t)WS_END); grid = -1; return; }
        int dev = 0, cus = 0, per_cu = 0;
        if (hipGetDevice(&dev) != hipSuccess || hipDeviceGetAttribute(&cus, hipDeviceAttributeMultiprocessorCount, dev) != hipSuccess) { grid = -1; return; }
        if (hipFuncSetAttribute((const void*)mega_fwd, hipFuncAttributeMaxDynamicSharedMemorySize, LDS_BYTES) != hipSuccess) { fprintf(stderr, "kernel_launch: hipFuncSetAttribute failed\n"); grid = -1; return; }
        if (hipOccupancyMaxActiveBlocksPerMultiprocessor(&per_cu, (const void*)mega_fwd, NWAVES * 64, LDS_BYTES) != hipSuccess || per_cu < 1) { fprintf(stderr, "kernel_launch: occupancy query says %d\n", per_cu); }
        (void)hipGetLastError();
        grid = cus;
    }
    if (grid < 0) return;
    if (hipMemsetAsync((char*)d_ws + WS_CTL, 0, CTL_ZERO_BYTES, stream) != hipSuccess) return;
    Args a{};
    for (int i = 0; i < 19; ++i) a.in[i] = (const float*)d_in[i];
    a.out = (float*)d_out; a.ws = (unsigned char*)d_ws;
#if MK_PER_PHASE
    for (int p = 0; p < NPHASE; ++p) { a.ph_lo = p; a.ph_hi = p + 1; hipLaunchKernelGGL(mega_fwd, dim3(grid), dim3(NWAVES * 64), LDS_BYTES, stream, a); }
#else
    a.ph_lo = 0; a.ph_hi = NPHASE; hipLaunchKernelGGL(mega_fwd, dim3(grid), dim3(NWAVES * 64), LDS_BYTES, stream, a);
#endif
}
```

```cpp
#include <hip/hip_runtime.h>
#include <hip/hip_bf16.h>
#include <cstdio>
#include <cstdint>
__device__ __forceinline__ int ltid() { int t = (int)threadIdx.x; asm volatile("" : "+v"(t)); return t; }
namespace pg8 {
#define PG8_LAS __attribute__((address_space(3)))
typedef unsigned short bf16_t;
typedef short bf16x8 __attribute__((ext_vector_type(8)));
typedef float f32x4 __attribute__((ext_vector_type(4)));
typedef unsigned u32x4 __attribute__((ext_vector_type(4)));
constexpr int BM = 256, BK = 64, HALF = 128, HTB = HALF * BK * 2  , STAGE_BYTES = 8 * HTB, NXCD = 8, WGM = 8;

__host__ __device__ __forceinline__ int lds_byte(int r, int c) { const int st = (r >> 4) * 2 + (c >> 5), rr = r & 15, cc = c & 31, ob = rr * 64 + cc * 2; return st * 1024 + (ob ^ (((ob >> 9) & 1) << 5)); }
__host__ __device__ __forceinline__ void stage_rc(int b, int& R, int& C) { const int st = b / 1024, sb = b % 1024, swz = sb ^ (((sb >> 9) & 1) << 5); R = (st >> 1) * 16 + swz / 64; C = (st & 1) * 32 + (swz % 64) / 2; }
__host__ __device__ __forceinline__ int perm32(int rho) { const int n = rho >> 4, i = rho & 15; return 8 * (i >> 2) + 4 * n + (i & 3); }

struct Unit { int pm, pn; };
struct Gemm { const bf16_t* A; const bf16_t* Bt; int M, N, K; };

struct StaticOrder {
    int nM, nN, nwg, G, c;
    __host__ __device__ void init(int M, int N, int G_, int c_) { nM = M / BM; nN = N / BM; nwg = nM * nN; G = G_; c = c_; }
    __host__ __device__ bool next(int i, Unit& u) const {
        const long L = (long)i * G + c; if (L >= nwg) return false;
        int wgid = (int)L; { const int q = nwg / NXCD, r = nwg % NXCD, xcd = wgid % NXCD, off = wgid / NXCD; wgid = (xcd < r ? xcd * (q + 1) : r * (q + 1) + (xcd - r) * q) + off; }
        const int nig = WGM * nN, gid = wgid / nig, fm = gid * WGM, gsz = (nM - fm) < WGM ? (nM - fm) : WGM;
        u.pm = fm + ((wgid % nig) % gsz); u.pn = (wgid % nig) / gsz; return true;
    }
    __device__ __forceinline__ void a_ready(const Unit&) const {}
    __device__ __forceinline__ void done(const Unit&) const {}
};
__device__ __forceinline__ unsigned cvt_pk_bf16(float lo, float hi) { unsigned r; asm volatile("v_cvt_pk_bf16_f32 %0, %1, %2" : "=v"(r) : "v"(lo), "v"(hi)); return r; }
typedef float f32x2 __attribute__((ext_vector_type(2)));
__device__ __forceinline__ f32x2 gelu_pk(f32x2 v) {
    const f32x2 av = __builtin_elementwise_abs(v), d = av * 0.2316418882f + 1.0f;
    f32x2 t; t.x = __builtin_amdgcn_rcpf(d.x); t.y = __builtin_amdgcn_rcpf(d.y);
    f32x2 q = t * 0.5307027145f + (-0.7265760135f); q = q * t + 0.7107068705f; q = q * t + (-0.142248368f); q = q * t + 0.127414796f; q = q * t;
    const f32x2 s = (v * v) * (-0.72134752044f);
    f32x2 e; e.x = __builtin_amdgcn_exp2f(s.x); e.y = __builtin_amdgcn_exp2f(s.y);
    const f32x2 m = v * (q * e), r = v - m;
    f32x2 o; o.x = v.x < 0.f ? m.x : r.x; o.y = v.y < 0.f ? m.y : r.y; return o;
}

__device__ __forceinline__ float gelu_tanh1(float v) {
    const float u = v * (0.7978845608f + 0.0356774081f * v * v);
    const float e = __builtin_amdgcn_exp2f(u * -2.8853900818f);
    return v * __builtin_amdgcn_rcpf(1.0f + e);
}
template <int ACT  > struct EpiStore {
    static constexpr bool PERM = true, AFTER_DRAIN = false;
    bf16_t* O; int ldc;
    __device__ __forceinline__ void operator()(const f32x4 (&acc)[2][2][4][2], const Unit& u, int wr, int wc, int fr, int fq) const {
        const int row0 = u.pm * BM + wr * 64 + fr, col0 = u.pn * BM + wc * 32 + 8 * fq;
#pragma unroll
        for (int ai = 0; ai < 2; ++ai)
#pragma unroll
            for (int m = 0; m < 4; ++m) { bf16_t* rowp = O + (size_t)(row0 + ai * HALF + m * 16) * ldc + col0;
#pragma unroll
                for (int bj = 0; bj < 2; ++bj) { f32x4 v0 = acc[ai][bj][m][0], v1 = acc[ai][bj][m][1];
                    if (ACT == 1) {
#pragma unroll
                        for (int j = 0; j < 4; ++j) { v0[j] = gelu_tanh1(v0[j]); v1[j] = gelu_tanh1(v1[j]); } }
                    u32x4 w; w.x = cvt_pk_bf16(v0[0], v0[1]); w.y = cvt_pk_bf16(v0[2], v0[3]); w.z = cvt_pk_bf16(v1[0], v1[1]); w.w = cvt_pk_bf16(v1[2], v1[3]);
                    *(u32x4*)(rowp + bj * HALF) = w; } }
    }
};
struct EpiQKV {
    static constexpr bool PERM = true, AFTER_DRAIN = false;
    bf16_t* QKV; size_t tstride; float qscale;
    __device__ __forceinline__ void operator()(const f32x4 (&acc)[2][2][4][2], const Unit& u, int wr, int wc, int fr, int fq) const {
        const int tok0 = u.pm * BM, b = tok0 >> 12, s0 = (tok0 & 4095) + wr * 64 + fr;
        const int colt = u.pn * BM, t = colt >> 11, hd0 = (colt & 2047) >> 7;
        bf16_t* base = QKV + (size_t)t * tstride; const float sc = t == 0 ? qscale : 1.0f;
#pragma unroll
        for (int bj = 0; bj < 2; ++bj) { bf16_t* hb = base + ((size_t)(b * 16 + hd0 + bj) * 4096 + s0) * 128 + wc * 32 + 8 * fq;
#pragma unroll
            for (int ai = 0; ai < 2; ++ai)
#pragma unroll
                for (int m = 0; m < 4; ++m) { const f32x4 v0 = acc[ai][bj][m][0] * sc, v1 = acc[ai][bj][m][1] * sc;
                    u32x4 w; w.x = cvt_pk_bf16(v0[0], v0[1]); w.y = cvt_pk_bf16(v0[2], v0[3]); w.z = cvt_pk_bf16(v1[0], v1[1]); w.w = cvt_pk_bf16(v1[2], v1[3]);
                    *(u32x4*)(hb + (size_t)(ai * HALF + m * 16) * 128) = w; } }
    }
};
struct EpiRes {
    static constexpr bool PERM = false, AFTER_DRAIN = false;
    const float* xin; float* xout; const float* gate; int gpitch;
    __device__ __forceinline__ void operator()(const f32x4 (&acc)[2][2][4][2], const Unit& u, int wr, int wc, int fr, int fq) const {
        const int row0 = u.pm * BM + wr * 64 + fr, col0 = u.pn * BM + wc * 32 + 4 * fq, b = (u.pm * BM) >> 12;
        f32x4 gv[2][2];
#pragma unroll
        for (int bj = 0; bj < 2; ++bj)
#pragma unroll
            for (int n = 0; n < 2; ++n) gv[bj][n] = *(const f32x4*)(gate + (size_t)b * gpitch + col0 + bj * HALF + n * 16);
#pragma unroll
        for (int ai = 0; ai < 2; ++ai)
#pragma unroll
            for (int m = 0; m < 4; ++m) { const size_t off = (size_t)(row0 + ai * HALF + m * 16) * 2048 + col0;
#pragma unroll
                for (int bj = 0; bj < 2; ++bj)
#pragma unroll
                    for (int n = 0; n < 2; ++n) { const f32x4 xo = *(const f32x4*)(xin + off + bj * HALF + n * 16);
                        *(f32x4*)(xout + off + bj * HALF + n * 16) = xo + gv[bj][n] * acc[ai][bj][m][n]; }
                asm volatile("" ::: "memory"); }
    }
};
template <class Epi, class Sched, bool ALIGN_EPI = false, bool SP2 = false>
__device__ __forceinline__ void gemm_phase(PG8_LAS unsigned char* lds, const Gemm g, const Sched& S, const Epi& E) {
    const int tid = ltid(), wid = __builtin_amdgcn_readfirstlane(tid >> 6), lane = tid & 63, wr = wid >> 2, wc = wid & 3, fr = lane & 15, fq = lane >> 4;
    const int K = g.K, nt = K / BK;
    unsigned voffA[2], voffB[2];
#pragma unroll
    for (int i = 0; i < 2; ++i) { int R, C; stage_rc(tid * 16 + i * 8192, R, C); const int Rb = Epi::PERM ? ((R & ~31) + perm32(R & 31)) : R;
        voffA[i] = (unsigned)(R * K + C) * 2u; voffB[i] = (unsigned)(Rb * K + C) * 2u; }
    const size_t kstep = (size_t)(BK * 2);
    const size_t hstep = (size_t)HALF * K * 2;
    const size_t tstep = 2 * hstep;
    const unsigned ldsw = (unsigned)wid * 1024u;
    const int aoff = lds_byte(wr * 64 + fr, fq * 8), boff = lds_byte(wc * 32 + fr, fq * 8);
#define PG8_SA(b, h) (((b) * 2 + (h)) * HTB)
#define PG8_SB(b, h) ((4 + (b) * 2 + (h)) * HTB)
#define PG8_STAGE(bufoff, gbase, voff) do { _Pragma("unroll") for (int _i = 0; _i < 2; ++_i) \
        __builtin_amdgcn_global_load_lds((const unsigned*)((const char*)(gbase) + (voff)[_i]), (PG8_LAS unsigned*)(lds + (bufoff) + ldsw + _i * 8192), 16, 0, 0); } while (0)
#define PG8_LDA(dst, b, h) do { _Pragma("unroll") for (int m = 0; m < 4; ++m) _Pragma("unroll") for (int k = 0; k < 2; ++k) dst[m][k] = *(const PG8_LAS bf16x8*)(lds + PG8_SA(b, h) + aoff + m * 2048 + k * 1024); } while (0)
#define PG8_LDB(dst, b, h) do { _Pragma("unroll") for (int n = 0; n < 2; ++n) _Pragma("unroll") for (int k = 0; k < 2; ++k) dst[n][k] = *(const PG8_LAS bf16x8*)(lds + PG8_SB(b, h) + boff + n * 2048 + k * 1024); } while (0)
#define PG8_MMA(ai, bj, At, Bt) do { __builtin_amdgcn_s_setprio(1); _Pragma("unroll") for (int m = 0; m < 4; ++m) _Pragma("unroll") for (int n = 0; n < 2; ++n) _Pragma("unroll") for (int k = 0; k < 2; ++k) \
        acc[ai][bj][m][n] = __builtin_amdgcn_mfma_f32_16x16x32_bf16(Bt[n][k], At[m][k], acc[ai][bj][m][n], 0, 0, 0); __builtin_amdgcn_s_setprio(0); } while (0)
#define PG8_WAIT_V(n) asm volatile("s_waitcnt vmcnt(" #n ")" ::: "memory")
#define PG8_WAIT_L(n) asm volatile("s_waitcnt lgkmcnt(" #n ")" ::: "memory")
#define PG8_BAR __builtin_amdgcn_s_barrier()
#define PG8_SCHED __builtin_amdgcn_sched_barrier(0)
    Unit cur, nxt; int ui = 0;
    if (!S.next(0, cur)) return;
    f32x4 acc[2][2][4][2];
#pragma unroll
    for (int a = 0; a < 2; ++a)
#pragma unroll
        for (int b = 0; b < 2; ++b)
#pragma unroll
            for (int m = 0; m < 4; ++m)
#pragma unroll
                for (int n = 0; n < 2; ++n) acc[a][b][m][n] = (f32x4){0.f, 0.f, 0.f, 0.f};
    bf16x8 At[4][2], B0[2][2], B1[2][2];
    const char* cA = (const char*)g.A + (size_t)cur.pm * tstep; const char* cB = (const char*)g.Bt + (size_t)cur.pn * tstep;
    S.a_ready(cur);
    if constexpr (SP2) {
        PG8_STAGE(PG8_SB(0, 0), cB, voffB); PG8_STAGE(PG8_SB(0, 1), cB + hstep, voffB); PG8_STAGE(PG8_SA(0, 0), cA, voffA); PG8_STAGE(PG8_SA(0, 1), cA + hstep, voffA);
        if (wr == 1) PG8_BAR;
        PG8_WAIT_V(2); PG8_BAR;
        PG8_STAGE(PG8_SB(1, 0), cB + kstep, voffB); PG8_STAGE(PG8_SA(1, 0), cA + kstep, voffA); PG8_STAGE(PG8_SB(1, 1), cB + hstep + kstep, voffB);
        PG8_WAIT_V(6); PG8_BAR;
    } else {
        PG8_STAGE(PG8_SB(0, 0), cB, voffB); PG8_STAGE(PG8_SA(0, 0), cA, voffA); PG8_STAGE(PG8_SB(0, 1), cB + hstep, voffB); PG8_STAGE(PG8_SA(0, 1), cA + hstep, voffA);
        if (wr == 1) PG8_BAR;
        PG8_WAIT_V(4); PG8_BAR;
        PG8_STAGE(PG8_SB(1, 0), cB + kstep, voffB); PG8_STAGE(PG8_SA(1, 0), cA + kstep, voffA); PG8_STAGE(PG8_SB(1, 1), cB + hstep + kstep, voffB);
        PG8_WAIT_V(6); PG8_BAR;
    }
    for (;;) {
        const bool has_next = S.next(ui + 1, nxt);
        const char* nA = has_next ? (const char*)g.A + (size_t)nxt.pm * tstep : cA; const char* nB = has_next ? (const char*)g.Bt + (size_t)nxt.pn * tstep : cB;
        for (int t = 0; t < nt; t += 2) {
            const bool last = (t == nt - 2);
            const char* a1 = cA + (size_t)(t + 1) * kstep;
            const char* a2 = last ? nA : cA + (size_t)(t + 2) * kstep; const char* b2 = last ? nB : cB + (size_t)(t + 2) * kstep;
            const char* a3 = a2 + kstep; const char* b3 = b2 + kstep;
            if (last && has_next) S.a_ready(nxt);
            if constexpr (SP2) {
            PG8_LDB(B0, 0, 0); PG8_LDB(B1, 0, 1); PG8_SCHED; PG8_LDA(At, 0, 0); PG8_STAGE(PG8_SA(1, 1), a1 + hstep, voffA);
            PG8_WAIT_V(8); PG8_WAIT_L(0); PG8_BAR; PG8_MMA(0, 0, At, B0); PG8_MMA(0, 1, At, B1); PG8_BAR; PG8_SCHED;
            PG8_LDA(At, 0, 1); PG8_STAGE(PG8_SB(0, 0), b2, voffB); PG8_STAGE(PG8_SB(0, 1), b2 + hstep, voffB); PG8_STAGE(PG8_SA(0, 0), a2, voffA);
            PG8_WAIT_V(8); PG8_WAIT_L(0); PG8_BAR; PG8_MMA(1, 0, At, B0); PG8_MMA(1, 1, At, B1); PG8_BAR; PG8_SCHED;
            PG8_LDB(B0, 1, 0); PG8_LDB(B1, 1, 1); PG8_SCHED; PG8_LDA(At, 1, 0); PG8_STAGE(PG8_SA(0, 1), a2 + hstep, voffA);
            PG8_WAIT_V(8); PG8_WAIT_L(0); PG8_BAR; PG8_MMA(0, 0, At, B0); PG8_MMA(0, 1, At, B1); PG8_BAR; PG8_SCHED;
            PG8_LDA(At, 1, 1); PG8_STAGE(PG8_SB(1, 0), b3, voffB); PG8_STAGE(PG8_SB(1, 1), b3 + hstep, voffB); PG8_STAGE(PG8_SA(1, 0), a3, voffA);
            PG8_WAIT_V(8); PG8_WAIT_L(0); PG8_BAR; PG8_MMA(1, 0, At, B0); PG8_MMA(1, 1, At, B1); PG8_BAR; PG8_SCHED;
            } else {
            PG8_LDB(B0, 0, 0); PG8_SCHED; PG8_LDA(At, 0, 0); PG8_STAGE(PG8_SA(1, 1), a1 + hstep, voffA);
            PG8_WAIT_L(8); PG8_BAR; PG8_WAIT_L(0); PG8_MMA(0, 0, At, B0); PG8_BAR; PG8_SCHED;
            PG8_LDB(B1, 0, 1); PG8_STAGE(PG8_SB(0, 0), b2, voffB);
            PG8_BAR; PG8_WAIT_L(0); PG8_MMA(0, 1, At, B1); PG8_BAR;
            PG8_LDA(At, 0, 1); PG8_STAGE(PG8_SA(0, 0), a2, voffA);
            PG8_BAR; PG8_WAIT_L(0); PG8_MMA(1, 0, At, B0); PG8_BAR; PG8_SCHED;
            PG8_STAGE(PG8_SB(0, 1), b2 + hstep, voffB);
            PG8_WAIT_V(6); PG8_BAR; PG8_MMA(1, 1, At, B1); PG8_BAR;
            PG8_LDB(B0, 1, 0); PG8_SCHED; PG8_LDA(At, 1, 0); PG8_STAGE(PG8_SA(0, 1), a2 + hstep, voffA);
            PG8_WAIT_L(8); PG8_BAR; PG8_WAIT_L(0); PG8_MMA(0, 0, At, B0); PG8_BAR; PG8_SCHED;
            PG8_LDB(B1, 1, 1); PG8_STAGE(PG8_SB(1, 0), b3, voffB);
            PG8_BAR; PG8_WAIT_L(0); PG8_MMA(0, 1, At, B1); PG8_BAR;
            PG8_LDA(At, 1, 1); PG8_STAGE(PG8_SA(1, 0), a3, voffA);
            PG8_BAR; PG8_WAIT_L(0); PG8_MMA(1, 0, At, B0); PG8_BAR; PG8_SCHED;
            PG8_STAGE(PG8_SB(1, 1), b3 + hstep, voffB);
            PG8_WAIT_V(6); PG8_BAR; PG8_MMA(1, 1, At, B1); PG8_BAR;
            }
        }
        if constexpr (ALIGN_EPI) { if (wr == 0) PG8_BAR; }
        if constexpr (!Epi::AFTER_DRAIN) { E(acc, cur, wr, wc, fr, fq); S.done(cur); }
        if (!has_next) break;
#pragma unroll
        for (int a = 0; a < 2; ++a)
#pragma unroll
            for (int b = 0; b < 2; ++b)
#pragma unroll
                for (int m = 0; m < 4; ++m)
#pragma unroll
                    for (int n = 0; n < 2; ++n) acc[a][b][m][n] = (f32x4){0.f, 0.f, 0.f, 0.f};
        cur = nxt; cA = nA; cB = nB; ++ui;
        if constexpr (ALIGN_EPI) { if (wr == 1) PG8_BAR; }
    }
    PG8_WAIT_V(0);
    if constexpr (!ALIGN_EPI) { if (wr == 0) PG8_BAR; }
    PG8_BAR;
    if constexpr (Epi::AFTER_DRAIN) { E.fused(acc, cur, wr, wc, fr, fq, lds, wid, lane); S.done(cur); }
#undef PG8_SA
#undef PG8_SB
#undef PG8_STAGE
#undef PG8_LDA
#undef PG8_LDB
#undef PG8_MMA
#undef PG8_WAIT_V
#undef PG8_WAIT_L
#undef PG8_BAR
#undef PG8_SCHED
}
}
namespace fox {
enum { ORDER_NATURAL = 0, ORDER_REVERSED = 1, ORDER_PAIRED = 2, ORDER_XCD = 4 };
constexpr int B = 8, H = 16, HKV = 16, SQ = 4096, SKV = 4096, D = 128;
constexpr int QOFF = 0;
constexpr int WINDOW = SKV;
constexpr float THR = 8.f;
constexpr bool WSKIP = false;
constexpr float SCALE = 0.08838834764831845f;
constexpr float QSCALE = SCALE * 1.4426950408889634f;
constexpr int NW = 8, QBLK = 32, KVBLK = 64, QB = NW * QBLK;
constexpr int SHM_V = KVBLK * D * 2, SHM_K = KVBLK * D * 2;
constexpr int LDS_FB = 2 * SHM_V + 2 * SHM_K + NW * 64 * 4;
constexpr int LDS_BYTES = LDS_FB + SKV * 4;
constexpr int OPITCH = H * D;
using bf16 = __hip_bfloat16;
typedef short bf16x8 __attribute__((ext_vector_type(8)));
typedef short s16x4 __attribute__((ext_vector_type(4)));
typedef float f32x16 __attribute__((ext_vector_type(16)));
typedef float f32x4 __attribute__((ext_vector_type(4)));
typedef unsigned u32x4 __attribute__((ext_vector_type(4)));
template <class A, class Bt> struct same_t { static constexpr bool v = false; };
template <class A> struct same_t<A, A> { static constexpr bool v = true; };

#define KSWZ(row, colB) ((row) * 256 + ((colB) ^ (((row) & 7) << 4)))
#define SBAR() __builtin_amdgcn_sched_barrier(0)
__device__ __forceinline__ int v_st(int k, int c) { const int kk = (k & ~0xC) | ((k & 4) << 1) | ((k & 8) >> 1); return ((kk >> 3) * 4 + (c >> 5)) * 512 + ((kk & 7) * 32 + (c & 31)) * 2; }
__device__ __forceinline__ int v_rd_base(int lane) { return ((lane & 3) << 3) | (((lane >> 2) & 3) << 6) | (((lane >> 4) & 1) << 5) | (((lane >> 5) & 1) << 8); }
constexpr int v_rd_off(int d0, int ks, int half) { return d0 * 512 + ks * 4096 + half * 2048; }
__device__ __forceinline__ int crow(int r, int hi) { return (r & 3) + 8 * (r >> 2) + 4 * hi; }
__device__ __forceinline__ unsigned cvtpk(float lo, float hi) {
    unsigned r; asm volatile("v_cvt_pk_bf16_f32 %0, %1, %2" : "=v"(r) : "v"(lo), "v"(hi)); return r;
}
__device__ __forceinline__ bf16x8 pack8(f32x4 a, f32x4 b) {
    u32x4 w = {cvtpk(a[0], a[1]), cvtpk(a[2], a[3]), cvtpk(b[0], b[1]), cvtpk(b[2], b[3])};
    return *reinterpret_cast<bf16x8*>(&w);
}
template <class T> __device__ __forceinline__ bf16x8 load8(const T* p) {
    if constexpr (same_t<T, float>::v) { return pack8(*(const f32x4*)p, *(const f32x4*)(p + 4)); }
    else { return *reinterpret_cast<const bf16x8*>(p); }
}
__device__ __forceinline__ void mask_tile(f32x16& p0, f32x16& p1, int dq, unsigned W) {
    const float NEG = -__builtin_inff();
#pragma unroll
    for (int r = 0; r < 16; ++r) {
        const int c = (r & 3) + 8 * (r >> 2);
        if ((unsigned)(dq - c) >= W) p0[r] = NEG;
        if ((unsigned)(dq - c - 32) >= W) p1[r] = NEG;
    }
}
__device__ __forceinline__ void partialSM(f32x16& p0, f32x16& p1, float& m_reg, float& mn, float& alpha) {
    float pmax = p0[0]; for (int r = 1; r < 16; ++r) pmax = fmaxf(pmax, p0[r]); for (int r = 0; r < 16; ++r) pmax = fmaxf(pmax, p1[r]);
    { auto rr = __builtin_amdgcn_permlane32_swap(__float_as_uint(pmax), __float_as_uint(pmax), false, false);
      pmax = fmaxf(__uint_as_float(rr[0]), __uint_as_float(rr[1])); }
    constexpr float THR2 = THR * 1.4426950408889634f;
    if (__builtin_expect(__all((pmax - m_reg) <= THR2), 1)) { mn = m_reg; alpha = 1.f; }
    else { mn = fmaxf(m_reg, pmax); alpha = __builtin_amdgcn_exp2f(m_reg - mn); m_reg = mn; }
    for (int r = 0; r < 16; ++r) p0[r] = p0[r] - mn; for (int r = 0; r < 16; ++r) p1[r] = p1[r] - mn;
    for (int r = 0; r < 16; ++r) p0[r] = __builtin_amdgcn_exp2f(p0[r]);
}
__device__ __forceinline__ void finishSM(f32x16& p0, f32x16& p1, float alpha, float& l_reg, bf16x8& pa0, bf16x8& pa1, bf16x8& pa2, bf16x8& pa3) {
    for (int r = 0; r < 16; ++r) p1[r] = __builtin_amdgcn_exp2f(p1[r]);
    float ps = 0; for (int r = 0; r < 16; ++r) ps += p0[r]; for (int r = 0; r < 16; ++r) ps += p1[r];
    { auto rr = __builtin_amdgcn_permlane32_swap(__float_as_uint(ps), __float_as_uint(ps), false, false);
      ps = __uint_as_float(rr[0]) + __uint_as_float(rr[1]); }
    l_reg = l_reg * alpha + ps;
#define PK4(P, B_, OUT) do { unsigned a0 = cvtpk(P[B_+0], P[B_+1]), a1 = cvtpk(P[B_+2], P[B_+3]);                          \
        unsigned b0 = cvtpk(P[B_+4], P[B_+5]), b1 = cvtpk(P[B_+6], P[B_+7]);                                             \
        auto r0 = __builtin_amdgcn_permlane32_swap(a0, b0, false, false); auto r1 = __builtin_amdgcn_permlane32_swap(a1, b1, false, false); \
        u32x4 w = {r0[0], r1[0], r0[1], r1[1]}; OUT = *reinterpret_cast<bf16x8*>(&w); } while (0)
    PK4(p0, 0, pa0); PK4(p0, 8, pa1); PK4(p1, 0, pa2); PK4(p1, 8, pa3);
#undef PK4
}
template <int KB, bool SK>
__device__ __forceinline__ void qkt(f32x16& p0, f32x16& p1, const char* K_lds, int r32, int hi, const bf16x8* qr, bool act, const char* fb) {
    if (SK && !act) { const float NEG = -__builtin_inff();
#pragma unroll
        for (int r = 0; r < 16; ++r) { p0[r] = NEG; p1[r] = NEG; } return; }
#pragma unroll
    for (int q = 0; q < 4; ++q) { const f32x4 b0 = *reinterpret_cast<const f32x4*>(fb + q * 32), b1 = *reinterpret_cast<const f32x4*>(fb + 128 + q * 32);
#pragma unroll
        for (int i = 0; i < 4; ++i) { p0[4 * q + i] = b0[i]; p1[4 * q + i] = b1[i]; } }
    const char* kb[4];
#pragma unroll
    for (int dd = 0; dd < 4; ++dd) kb[dd] = K_lds + KB * SHM_K + KSWZ(r32, (dd * 16 + hi * 8) * 2);
#pragma unroll
    for (int d0 = 0; d0 < 8; ++d0) { const char* a = kb[d0 & 3] + (d0 >> 2) * 128;
        bf16x8 b0 = *reinterpret_cast<const bf16x8*>(a);
        bf16x8 b1 = *reinterpret_cast<const bf16x8*>(a + 32 * 256);
        p0 = __builtin_amdgcn_mfma_f32_32x32x16_bf16(b0, qr[d0], p0, 0, 0, 0);
        p1 = __builtin_amdgcn_mfma_f32_32x32x16_bf16(b1, qr[d0], p1, 0, 0, 0); }
}
template <int VB, bool SK>
__device__ __forceinline__ void pv_tile(f32x16* o, int vb0, bf16x8 pa0, bf16x8 pa1, bf16x8 pa2, bf16x8 pa3, bool act) {
    if (SK && !act) return;
#define TRRD(dst, off) asm volatile("ds_read_b64_tr_b16 %0, %1 offset:%2" : "=&v"(dst) : "v"(vb0), "i"(off) : "memory")
#define PV_D0(d0) do { s16x4 l0, l1, l2, l3, h0, h1, h2, h3; constexpr int b_ = VB * SHM_V + v_rd_off(d0, 0, 0);     \
        TRRD(l0, b_); TRRD(h0, b_ + 2048); TRRD(l1, b_ + 4096); TRRD(h1, b_ + 6144); TRRD(l2, b_ + 8192); TRRD(h2, b_ + 10240); TRRD(l3, b_ + 12288); TRRD(h3, b_ + 14336); \
        asm volatile("s_waitcnt lgkmcnt(0)" ::: "memory"); SBAR();                 \
        o[d0] = __builtin_amdgcn_mfma_f32_32x32x16_bf16(pa0, (bf16x8){l0[0], l0[1], l0[2], l0[3], h0[0], h0[1], h0[2], h0[3]}, o[d0], 0, 0, 0);   \
        o[d0] = __builtin_amdgcn_mfma_f32_32x32x16_bf16(pa1, (bf16x8){l1[0], l1[1], l1[2], l1[3], h1[0], h1[1], h1[2], h1[3]}, o[d0], 0, 0, 0);   \
        o[d0] = __builtin_amdgcn_mfma_f32_32x32x16_bf16(pa2, (bf16x8){l2[0], l2[1], l2[2], l2[3], h2[0], h2[1], h2[2], h2[3]}, o[d0], 0, 0, 0);   \
        o[d0] = __builtin_amdgcn_mfma_f32_32x32x16_bf16(pa3, (bf16x8){l3[0], l3[1], l3[2], l3[3], h3[0], h3[1], h3[2], h3[3]}, o[d0], 0, 0, 0); } while (0)
    PV_D0(0); PV_D0(1); PV_D0(2); PV_D0(3);
#undef PV_D0
#undef TRRD
}
template <class TIn, class TOut> struct BlockRef { const TIn* Q; const TIn* K; const TIn* V; TOut* O; const float* FB; int P0; };
template <class TIn> struct Seam {
    bf16x8 qr[8];
    bf16x8 st_v0, st_v1, st_k0, st_k1; f32x4 sf0, sf1, sf2, sf3;
    f32x4 tq[16];
};
__device__ __forceinline__ int swa_jlo(int P0, int W) { const int lowk = P0 - W + 1; return lowk > 0 ? lowk / KVBLK : 0; }
#define ROW(p, k0, rr) ((p) + (size_t)((k0) + (rr)) * D + sc)
#define VMW() asm volatile("s_waitcnt vmcnt(0)" ::: "memory")
#define VMWN(n) asm volatile("s_waitcnt vmcnt(%0)" :: "i"(n) : "memory")
#define SLOAD_H(Kp, Vp, k0) do { S.st_v0 = load8<TIn>(ROW(Vp, k0, sr)); S.st_v1 = load8<TIn>(ROW(Vp, k0, 32 + sr));              \
                         S.st_k0 = load8<TIn>(ROW(Kp, k0, sr)); S.st_k1 = load8<TIn>(ROW(Kp, k0, 32 + sr)); } while (0)
#define SWRITE_HK(bf) do { *(bf16x8*)(K_lds + (bf) * SHM_K + kws) = S.st_k0; *(bf16x8*)(K_lds + (bf) * SHM_K + kws + 32 * 256) = S.st_k1; } while (0)
#define SWRITE_HV(bf) do { *(bf16x8*)(V_lds + (bf) * SHM_V + vst0) = S.st_v0; *(bf16x8*)(V_lds + (bf) * SHM_V + vst1) = S.st_v1; } while (0)
#define SWRITE_H(bf) do { SWRITE_HV(bf); SWRITE_HK(bf); } while (0)
#define SLOAD_F(p, k0) do { S.sf0 = *(const f32x4*)ROW(p, k0, sr); S.sf1 = *(const f32x4*)(ROW(p, k0, sr) + 4);                \
                            S.sf2 = *(const f32x4*)ROW(p, k0, 32 + sr); S.sf3 = *(const f32x4*)(ROW(p, k0, 32 + sr) + 4); } while (0)
#define SWRITE_KF(bf) do { *(bf16x8*)(K_lds + (bf) * SHM_K + kws) = pack8(S.sf0, S.sf1); *(bf16x8*)(K_lds + (bf) * SHM_K + kws + 32 * 256) = pack8(S.sf2, S.sf3); } while (0)
#define SWRITE_VF(bf) do { *(bf16x8*)(V_lds + (bf) * SHM_V + vst0) = pack8(S.sf0, S.sf1); *(bf16x8*)(V_lds + (bf) * SHM_V + vst1) = pack8(S.sf2, S.sf3); } while (0)
template <class TIn, class TOut>
__device__ __forceinline__ void causal_swa_prime(const BlockRef<TIn, TOut>& cur, int W, char* lds, Seam<TIn>& S) {
    constexpr bool F32 = same_t<TIn, float>::v;
    const int tid = ltid(), wid = __builtin_amdgcn_readfirstlane(tid >> 6), lane = tid & 63, r32 = lane & 31, hi = lane >> 5;
    const int sr = tid >> 4, sc = (tid & 15) * 8, kws = KSWZ(sr, sc * 2); char* K_lds = lds + 2 * SHM_V;
    const int kb0 = swa_jlo(cur.P0, W) * KVBLK;
    for (int d0 = 0; d0 < 8; ++d0) S.qr[d0] = load8<TIn>(cur.Q + (size_t)(wid * QBLK + r32) * D + d0 * 16 + hi * 8);
    if constexpr (F32) { SLOAD_F((const float*)cur.K, kb0); VMW(); SWRITE_KF(0); SBAR(); SLOAD_F((const float*)cur.V, kb0); }
    else { SLOAD_H(cur.K, cur.V, kb0); VMW(); SWRITE_HK(0); }
    __syncthreads();
}
template <class TIn, class TOut>
__device__ __forceinline__ void causal_swa_block(const BlockRef<TIn, TOut>& cur, const BlockRef<TIn, TOut>& nxt, int skv, int W, char* lds, Seam<TIn>& S) {
    constexpr bool F32 = same_t<TIn, float>::v;
    const int tid = ltid(), wid = __builtin_amdgcn_readfirstlane(tid >> 6), lane = tid & 63, r32 = lane & 31, hi = lane >> 5;
    const int j_lo = swa_jlo(cur.P0, W);
    int j_hi = (cur.P0 + QB - 1) / KVBLK + 1; if (j_hi > skv / KVBLK) j_hi = skv / KVBLK;
    const int NT = j_hi - j_lo;
    const int kbn = swa_jlo(nxt.P0, W) * KVBLK;
    const int qlo = cur.P0 + wid * QBLK, qm = qlo + r32 - 4 * hi;
    char* V_lds = lds; char* K_lds = lds + 2 * SHM_V;
    float* ws = (float*)(lds + 2 * SHM_V + 2 * SHM_K) + wid * 64; float* li_l = ws, * al_l = ws + 32;
    float m_reg = -1e30f, l_reg = 0; f32x16 o[4] = {};
    float* fbuf = (float*)(lds + LDS_FB);
    { const int nk = cur.P0 + QB;
      for (int i4 = tid * 4; i4 < nk; i4 += 64 * NW * 4) *(f32x4*)(fbuf + i4) = *(const f32x4*)(cur.FB + i4);
      __syncthreads(); }
    const char* fbl = (const char*)fbuf + hi * 16;
    const int sr = tid >> 4, sc = (tid & 15) * 8, vst0 = v_st(sr, sc), vst1 = v_st(32 + sr, sc), kws = KSWZ(sr, sc * 2);
    const int vb0 = (int)(uintptr_t)V_lds + v_rd_base(lane);
    const TIn* Kh = cur.K; const TIn* Vh = cur.V;
#define RESC(a) do { if (__any((a) < 1.f)) { if (hi == 0) al_l[r32] = (a); asm volatile("s_waitcnt lgkmcnt(0)" ::: "memory");              \
                     for (int d_ = 0; d_ < 4; ++d_) for (int r = 0; r < 16; ++r) o[d_][r] *= al_l[crow(r, hi)]; } } while (0)
#define KBASE(t) ((j_lo + (t)) * KVBLK)
#define ACT(t) (KBASE(t) <= qlo + QBLK - 1 && KBASE(t) + KVBLK - 1 >= qlo - W + 1)
#define MASKT(P0_, P1_, t) do { const int kb_ = KBASE(t); if ((!SK || ACT(t)) && (kb_ + KVBLK - 1 > qlo || kb_ <= qlo + QBLK - 1 - W)) mask_tile(P0_, P1_, qm - kb_, (unsigned)W); } while (0)
    constexpr int NQL = F32 ? 16 : 8;
    constexpr bool SK = WSKIP && !F32;
#define SEAM_K0() do { VMWN(NQL); if constexpr (F32) { SWRITE_KF(0); SBAR(); SLOAD_F((const float*)nxt.V, kbn); } else { SWRITE_HK(0); } SBAR(); } while (0)
    f32x16 pA0, pA1, pB0, pB1; float mnA, mnB, alA, alB; bf16x8 pa0, pa1, pa2, pa3;
    if constexpr (F32) { VMW(); SWRITE_VF(0); SBAR(); } else { SWRITE_HV(0); SBAR(); }
    if (NT > 1) { if constexpr (F32) SLOAD_F((const float*)Kh, KBASE(1)); else SLOAD_H(Kh, Vh, KBASE(1)); }
    SBAR(); qkt<0, SK>(pA0, pA1, K_lds, r32, hi, S.qr, ACT(0), fbl + KBASE(0) * 4);
    if constexpr (F32) { if (NT > 1) { VMW(); SWRITE_KF(1); SBAR(); SLOAD_F((const float*)Vh, KBASE(1)); } }
    MASKT(pA0, pA1, 0); partialSM(pA0, pA1, m_reg, mnA, alA);
    if (NT > 1) { VMW(); if constexpr (F32) { SWRITE_VF(1); SBAR(); if (NT > 2) SLOAD_F((const float*)Kh, KBASE(2)); } else SWRITE_H(1); }
    __syncthreads();
#define HALF_STEP(PX0, PX1, mnX, alX, PY0, PY1, alY, t, KB, VB, SB) do {                                                      \
        SBAR(); qkt<KB, SK>(PX0, PX1, K_lds, r32, hi, S.qr, ACT(t), fbl + KBASE(t) * 4);                                             \
        finishSM(PY0, PY1, alY, l_reg, pa0, pa1, pa2, pa3); SBAR();                                                           \
        if ((t) + 1 < NT) { if constexpr (F32) { VMW(); SWRITE_KF(SB); SBAR(); SLOAD_F((const float*)Vh, KBASE((t) + 1)); }  \
                            else { SLOAD_H(Kh, Vh, KBASE((t) + 1)); } SBAR(); }                                               \
        pv_tile<VB, SK>(o, vb0, pa0, pa1, pa2, pa3, ACT((t) - 1)); MASKT(PX0, PX1, (t)); partialSM(PX0, PX1, m_reg, mnX, alX);                                        \
        __syncthreads();                                                                                                      \
        if ((t) + 1 < NT) { VMW(); if constexpr (F32) { SWRITE_VF(SB); SBAR(); if ((t) + 2 < NT) SLOAD_F((const float*)Kh, KBASE((t) + 2)); } \
                            else { SWRITE_H(SB); } }                                                                          \
        RESC(alX); __syncthreads(); } while (0)
    for (int t = 1; t + 1 < NT; t += 2) {
        HALF_STEP(pB0, pB1, mnB, alB, pA0, pA1, alA, t, 1, 0, 0);
        HALF_STEP(pA0, pA1, mnA, alA, pB0, pB1, alB, t + 1, 0, 1, 1);
    }
    const bool even = (NT & 1) == 0;
    if (even) { SBAR(); qkt<1, SK>(pB0, pB1, K_lds, r32, hi, S.qr, ACT(NT - 1), fbl + KBASE(NT - 1) * 4); SBAR(); }
#define QROW(e) (nxt.Q + (size_t)(wid * QBLK + r32) * D + ((e) >> 1) * 16 + hi * 8 + ((e) & 1) * 4)
    if constexpr (F32) { SLOAD_F((const float*)nxt.K, kbn); SBAR();
#pragma unroll
        for (int e = 0; e < 8; ++e) S.tq[e] = *(const f32x4*)QROW(e); }
    else { SLOAD_H(nxt.K, nxt.V, kbn); SBAR();
#pragma unroll
        for (int d0 = 0; d0 < 8; ++d0) S.qr[d0] = load8<TIn>(nxt.Q + (size_t)(wid * QBLK + r32) * D + d0 * 16 + hi * 8); }
    SBAR();
    finishSM(pA0, pA1, alA, l_reg, pa0, pa1, pa2, pa3); SBAR();
    if constexpr (F32) {
#pragma unroll
        for (int e = 8; e < 16; ++e) S.tq[e] = *(const f32x4*)QROW(e); SBAR(); }
#undef QROW
    pv_tile<0, SK>(o, vb0, pa0, pa1, pa2, pa3, ACT(even ? NT - 2 : NT - 1));
    if (even) { MASKT(pB0, pB1, NT - 1); partialSM(pB0, pB1, m_reg, mnB, alB); __syncthreads(); RESC(alB);
        finishSM(pB0, pB1, alB, l_reg, pa0, pa1, pa2, pa3); SBAR(); pv_tile<1, SK>(o, vb0, pa0, pa1, pa2, pa3, ACT(NT - 1)); }
    SBAR(); SEAM_K0();
    if (hi == 0) li_l[r32] = l_reg; asm volatile("s_waitcnt lgkmcnt(0)" ::: "memory");
    float rli[16];
#pragma unroll
    for (int r = 0; r < 16; ++r) rli[r] = __builtin_amdgcn_rcpf(li_l[crow(r, hi)]);
    TOut* Ow = cur.O + (size_t)(wid * QBLK) * OPITCH;
#pragma unroll
    for (int r = 0; r < 16; ++r) { const int orow = crow(r, hi);
#pragma unroll
        for (int d0 = 0; d0 < 4; ++d0) { const float v = o[d0][r] * rli[r];
            if constexpr (same_t<TOut, float>::v) { Ow[(size_t)orow * OPITCH + d0 * 32 + r32] = v; }
            else { const float vn = __shfl_xor(v, 1);
                   if ((r32 & 1) == 0) *(unsigned*)(Ow + (size_t)orow * OPITCH + d0 * 32 + r32) = cvtpk(v, vn); } } }
    if constexpr (F32) {
#pragma unroll
        for (int d0 = 0; d0 < 8; ++d0) S.qr[d0] = pack8(S.tq[2 * d0], S.tq[2 * d0 + 1]); }
    __syncthreads();
#undef RESC
#undef KBASE
#undef ACT
#undef MASKT
#undef SEAM_K0
#undef HALF_STEP
}
#undef ROW
#undef VMW
#undef VMWN
#undef SLOAD_H
#undef SWRITE_HK
#undef SWRITE_HV
#undef SWRITE_H
#undef SLOAD_F
#undef SWRITE_KF
#undef SWRITE_VF
constexpr int NQB = SQ / QB, NXI = NQB / 2, NITEMS = NXI * B * H;
struct SwaItem { int bh, qb0, qb1; };
__device__ __forceinline__ SwaItem swa_decode(int L) { SwaItem it; it.bh = L / NXI; const int x = L - it.bh * NXI; it.qb0 = x; it.qb1 = NQB - 1 - x; return it; }
template <class TIn, class TOut>
__device__ __forceinline__ BlockRef<TIn, TOut> swa_ref(const SwaItem& it, int pass, const TIn* Q, const TIn* K, const TIn* V, TOut* O, const float* FB) {
    const int qb = pass ? it.qb1 : it.qb0;
    BlockRef<TIn, TOut> r;
    r.Q = Q + ((size_t)it.bh * SQ + (size_t)qb * QB) * D;
    r.O = O + ((size_t)(it.bh / H) * SQ + (size_t)qb * QB) * OPITCH + (it.bh % H) * D;
    r.K = K + (size_t)it.bh * SKV * D; r.V = V + (size_t)it.bh * SKV * D; r.FB = FB + (size_t)it.bh * SKV; r.P0 = qb * QB;
    return r;
}
__device__ __forceinline__ void att_phase(char* lds, const bf16* Q, const bf16* K, const bf16* V, bf16* O, const float* FB, int wg, int nwg) {
    int L = wg; if (L >= NITEMS) return;
    SwaItem it = swa_decode(L); int pass = 0;
    BlockRef<bf16, bf16> cur = swa_ref<bf16, bf16>(it, 0, Q, K, V, O, FB);
    Seam<bf16> S;
    causal_swa_prime<bf16, bf16>(cur, WINDOW, lds, S);
    for (;;) {
        const bool more_pass = pass == 0 && it.qb1 != it.qb0, more_item = L + nwg < NITEMS, last = !more_pass && !more_item;
        SwaItem itn = it; int passn = pass + 1, Ln = L;
        if (!more_pass) { passn = 0; Ln = more_item ? L + nwg : L; itn = swa_decode(Ln); }
        const BlockRef<bf16, bf16> nxt = last ? cur : swa_ref<bf16, bf16>(itn, passn, Q, K, V, O, FB);
        causal_swa_block<bf16, bf16>(cur, nxt, SKV, WINDOW, lds, S);
        if (last) break;
        cur = nxt; it = itn; pass = passn; L = Ln;
    }
}
}
constexpr int DM = 2048, NBATCH = 8, SEQ = 4096, DEPTH = 4, NHEAD = 16, HDIM = 128, DFF = 5504, NFF2 = 2 * DFF, MTOK = NBATCH * SEQ;
constexpr int NQKVF = 3 * DM + NHEAD;
constexpr float EPS = 1e-6f;
constexpr int NWAVES = 8;
#ifndef MK_PER_PHASE
#define MK_PER_PHASE 0
#endif
constexpr size_t MiB = 1u << 20;
constexpr size_t WS_CTL = 0, CTL_ZERO_BYTES = 1 * MiB;
constexpr size_t WS_MOD = 1 * MiB;
constexpr size_t WS_LOGF = 3 * MiB;
constexpr size_t WS_FB = 5 * MiB;
constexpr size_t WS_VRSTD = 7 * MiB;
constexpr size_t WS_WF = 7 * MiB + 512 * 1024;
constexpr size_t WS_WQKV = 8 * MiB;
constexpr size_t WS_WO = 56 * MiB;
constexpr size_t WS_WGI = 72 * MiB;
constexpr size_t WS_WGO = 104 * MiB;
constexpr size_t WS_WF1 = 120 * MiB;
constexpr size_t WS_WF2 = 292 * MiB;
constexpr size_t WS_H = 378 * MiB;
constexpr size_t WS_R = 506 * MiB;
constexpr size_t WS_END = WS_R + 688 * MiB;
constexpr int CW_TMO = 0, CW_BAR = 4096;

constexpr int RING_OFF = 0, RING_BYTES = 131072;
constexpr int LDSCTL_OFF = 143360, MISC_OFF = LDSCTL_OFF + 320;
constexpr int LDS_BYTES = 147456;

#define GAS __attribute__((address_space(1)))
#define LAS __attribute__((address_space(3)))
typedef unsigned short bf16;
typedef unsigned v4u __attribute__((ext_vector_type(4)));
typedef unsigned v2u __attribute__((ext_vector_type(2)));
typedef float f32x4 __attribute__((ext_vector_type(4)));
typedef short bf16x8 __attribute__((ext_vector_type(8)));
typedef GAS unsigned gu32;
#define RLX_AGENT __ATOMIC_RELAXED, __HIP_MEMORY_SCOPE_AGENT
#define LDS_WAIT() asm volatile("s_waitcnt lgkmcnt(0)" ::: "memory")
#define VM_WAIT() asm volatile("s_waitcnt vmcnt(0)" ::: "memory")
__device__ __forceinline__ unsigned f2bf(float f) { unsigned u = __builtin_bit_cast(unsigned, f); return (u + 0x7fffu + ((u >> 16) & 1u)) >> 16; }
__device__ __forceinline__ unsigned pk2(float lo, float hi) { return f2bf(lo) | (f2bf(hi) << 16); }
__device__ __forceinline__ float bf2f(unsigned short b) { return __builtin_bit_cast(float, (unsigned)b << 16); }
__device__ __forceinline__ float bflo(unsigned w) { return __builtin_bit_cast(float, w << 16); }
__device__ __forceinline__ float bfhi(unsigned w) { return __builtin_bit_cast(float, w & 0xffff0000u); }
#define XB_TMO      128
#define XB_XCNT(j)  (256  + 64 * (j))
#define XB_XSUB(j)  (1280 + 64 * (j))
#define XB_XGEN(j)  (2304 + 64 * (j))
#define XB_TOP      3328
#define XB_TOPGEN   3392
#define XCD_BAR_WORDS 3456
#define XB_SPIN_CAP (1u << 18)

__device__ __forceinline__ unsigned xb_ld(unsigned* p)              { return __hip_atomic_load((GAS unsigned*)p, __ATOMIC_RELAXED, __HIP_MEMORY_SCOPE_AGENT); }
__device__ __forceinline__ unsigned xb_add(unsigned* p, unsigned v) { return __hip_atomic_fetch_add((GAS unsigned*)p, v, __ATOMIC_RELAXED, __HIP_MEMORY_SCOPE_AGENT); }
__device__ __forceinline__ unsigned xb_xcc_id() { return (unsigned)__builtin_amdgcn_s_getreg((3 << 11) | 20) & 0xFu; }
#define XB_SPIN(cond, bar) do { unsigned _sp = 0; while (cond) { __builtin_amdgcn_s_sleep(1); \
    if ((++_sp & 255u) == 0u) { if (xb_ld(&(bar)[XB_TMO])) break; if (_sp > XB_SPIN_CAP) { xb_add(&(bar)[XB_TMO], 1u); break; } } } } while (0)

struct XcdBarrier {
    unsigned* bar; unsigned x;
    volatile LAS unsigned* st;
};

__device__ __forceinline__ XcdBarrier xcd_barrier_post(unsigned* bar, volatile LAS unsigned* st) {
    XcdBarrier b; b.bar = bar; b.x = xb_xcc_id(); b.st = st;
    if (threadIdx.x == 0) (void)xb_add(&bar[XB_XCNT(b.x)], 1u);
    return b;
}
__device__ __forceinline__ void xcd_barrier_complete(unsigned* bar, unsigned x, unsigned& nloc, unsigned& nx) {
    const unsigned G = gridDim.x * gridDim.y * gridDim.z;
    unsigned sum, cnt, mine, sp = 0u;
    for (;;) {
        sum = 0u; cnt = 0u; mine = 0u;
#pragma unroll
        for (unsigned j = 0; j < 16; ++j) { const unsigned c = xb_ld(&bar[XB_XCNT(j)]); sum += c; cnt += (c > 0u) ? 1u : 0u; mine = (j == x) ? c : mine; }
        if (sum == G) break;
        __builtin_amdgcn_s_sleep(1);
        if ((++sp & 255u) == 0u) { if (xb_ld(&bar[XB_TMO])) break; if (sp > XB_SPIN_CAP) { xb_add(&bar[XB_TMO], 1u); break; } }
    }
    nloc = mine > 0u ? mine : 1u; nx = cnt > 0u ? cnt : 1u;
}

__device__ __forceinline__ void xcd_barrier(const XcdBarrier& b) {
    asm volatile("s_waitcnt vmcnt(0)" ::: "memory");
    __syncthreads();
    if (threadIdx.x == 0) {
        unsigned* bar = b.bar;
        __builtin_amdgcn_s_waitcnt(0);
        unsigned nloc = b.st[0], nx = b.st[1];
        if (nloc == 0u) { xcd_barrier_complete(bar, b.x, nloc, nx); b.st[0] = nloc; b.st[1] = nx; }
        const unsigned old = xb_add(&bar[XB_XSUB(b.x)], 1u);
        const unsigned gen = old / nloc;
        if (old + 1u == (gen + 1u) * nloc) {
            __builtin_amdgcn_fence(__ATOMIC_RELEASE, "agent");
            asm volatile("s_waitcnt vmcnt(0)" ::: "memory");
            const unsigned og = xb_add(&bar[XB_TOP], 1u);
            const unsigned tg = og / nx;
            if (og + 1u == (tg + 1u) * nx) xb_add(&bar[XB_TOPGEN], 1u);
            else XB_SPIN(xb_ld(&bar[XB_TOPGEN]) == tg, bar);
            __builtin_amdgcn_fence(__ATOMIC_ACQUIRE, "agent");
            xb_add(&bar[XB_XGEN(b.x)], 1u);
            asm volatile("s_waitcnt vmcnt(0)" ::: "memory");
        } else {
            XB_SPIN(xb_ld(&bar[XB_XGEN(b.x)]) == gen, bar);
            __builtin_amdgcn_fence(__ATOMIC_ACQUIRE, "agent");
            asm volatile("s_waitcnt vmcnt(0)" ::: "memory");
        }
    }
    __syncthreads();
}
struct Frame {
    LAS unsigned char* lds; char* ldsg;
    volatile LAS unsigned* MISC;
    int tid, lane, wave, vcu, G, bid;
    const GAS float* const __attribute__((address_space(4)))* inp;
    GAS float* outg; GAS unsigned char* wsg;
    __device__ __forceinline__ const float* in(int i) const { return (const float*)inp[i]; }
};
enum { IN_X = 0, IN_C, IN_MODW, IN_MODB, IN_MIXG, IN_FFNG, IN_AWIN, IN_ABF, IN_AWO, IN_GWIN, IN_GVG, IN_GWS, IN_GBS, IN_GWO, IN_FWIN, IN_FCW, IN_FCB, IN_FWOUT, IN_FING };
enum { MW_BID = 16, MW_G, MW_VCU, MW_INP, MW_INP_HI, MW_WS, MW_WS_HI, MW_OUT, MW_OUT_HI };
__device__ __forceinline__ unsigned misc_rd(const Frame& F, int k) { return (unsigned)__builtin_amdgcn_readfirstlane((int)F.MISC[k]); }
__device__ __forceinline__ bool relaunder(Frame& F) {
    int t = (int)threadIdx.x; asm volatile("" : "+v"(t)); F.tid = t; F.lane = t & 63; F.wave = __builtin_amdgcn_readfirstlane(t >> 6);
    F.bid = (int)misc_rd(F, MW_BID); F.G = (int)misc_rd(F, MW_G); F.vcu = (int)misc_rd(F, MW_VCU);
    F.inp = (const GAS float* const __attribute__((address_space(4)))*)(((unsigned long long)misc_rd(F, MW_INP_HI) << 32) | misc_rd(F, MW_INP));
    F.wsg = (GAS unsigned char*)(((unsigned long long)misc_rd(F, MW_WS_HI) << 32) | misc_rd(F, MW_WS));
    F.outg = (GAS float*)(((unsigned long long)misc_rd(F, MW_OUT_HI) << 32) | misc_rd(F, MW_OUT));
    return true; }
__device__ __forceinline__ float wave_sum(float v) {
#pragma unroll
    for (int o = 1; o < 64; o <<= 1) v += __shfl_xor(v, o);
    return v;
}
__device__ __forceinline__ void transpose_item(const float* W, int ldw, int K, bf16* WT, int k0, int n0, int dst_row0, int ncols, LAS float* scr, int lane) {
    const int nl = lane & 31;
#pragma unroll 8
    for (int i = 0; i < 32; ++i) { const int kk = 2 * i + (lane >> 5); if (nl < ncols) scr[kk * 33 + nl] = W[(size_t)(k0 + kk) * ldw + n0 + nl]; }
    LDS_WAIT(); asm volatile("" ::: "memory");
    const int c = lane & 7;
#pragma unroll
    for (int j = 0; j < 4; ++j) { const int n = (lane >> 3) + 8 * j; const LAS float* s = scr + (8 * c) * 33 + n;
        if (n < ncols) { v4u o; o.x = pk2(s[0 * 33], s[1 * 33]); o.y = pk2(s[2 * 33], s[3 * 33]); o.z = pk2(s[4 * 33], s[5 * 33]); o.w = pk2(s[6 * 33], s[7 * 33]);
            *(GAS v4u*)(WT + (size_t)(dst_row0 + n) * K + k0 + 8 * c) = o; } }
    LDS_WAIT(); asm volatile("" ::: "memory");
}
__device__ __forceinline__ void pro_phase(Frame& F) {
    __syncthreads();
    {
        LAS float* cact = (LAS float*)(F.lds + RING_OFF);
        LAS float* red = (LAS float*)(F.lds + RING_OFF + 65536);
        float* mod = (float*)((unsigned char*)F.wsg + WS_MOD);
        for (int item = F.bid; item < 192; item += F.G) {
            for (int idx = F.tid; idx < NBATCH * DM; idx += NWAVES * 64) { const int b = idx >> 11, k = idx & 2047; const float v = F.in(IN_C)[idx]; cact[k * 8 + b] = v / (1.0f + __expf(-v)); }
            __syncthreads();
            const int i = item / 48, nbase = (item % 48) * 256;
            const float* wp = F.in(IN_MODW) + ((size_t)i * DM + F.wave * 256) * 12288 + nbase + F.lane * 4;
            f32x4 acc[8];
#pragma unroll
            for (int b = 0; b < 8; ++b) acc[b] = (f32x4){0.f, 0.f, 0.f, 0.f};
#pragma unroll 8
            for (int kk = 0; kk < 256; ++kk) {
                const f32x4 w = *(const GAS f32x4*)(wp + (size_t)kk * 12288);
                const LAS f32x4* cp = (const LAS f32x4*)(cact + (F.wave * 256 + kk) * 8);
                const f32x4 c0 = cp[0], c1 = cp[1];
                acc[0] += w * c0.x; acc[1] += w * c0.y; acc[2] += w * c0.z; acc[3] += w * c0.w;
                acc[4] += w * c1.x; acc[5] += w * c1.y; acc[6] += w * c1.z; acc[7] += w * c1.w;
            }
#pragma unroll
            for (int b = 0; b < 8; ++b) *(LAS f32x4*)(red + (F.wave * 8 + b) * 256 + F.lane * 4) = acc[b];
            __syncthreads();
            for (int o = F.tid; o < 2048; o += NWAVES * 64) { const int b = o >> 8, col = o & 255; float s = 0.f;
#pragma unroll
                for (int w = 0; w < 8; ++w) s += red[(w * 8 + b) * 256 + col];
                mod[((size_t)i * 8 + b) * 12288 + nbase + col] = s + F.in(IN_MODB)[i * 12288 + nbase + col]; }
            __syncthreads();
        }
    }
    LAS float* scr = (LAS float*)(F.lds + RING_OFF + F.wave * 16384);
    const int gw = F.vcu * NWAVES + F.wave, NGW = F.G * NWAVES;
    constexpr int I_QKV = 32 * 192, I_F = 32, I_O = 32 * 64, I_GI = 32 * 128, I_GO = 32 * 64, I_F1 = 32 * 344, I_F2 = 86 * 64;
    constexpr int NITEMS = 2 * (I_QKV + I_F + I_O + I_GI + I_GO) + 4 * (I_F1 + I_F2);
    bf16* Wqkv = (bf16*)((unsigned char*)F.wsg + WS_WQKV); bf16* Wf = (bf16*)((unsigned char*)F.wsg + WS_WF); bf16* Wo = (bf16*)((unsigned char*)F.wsg + WS_WO); bf16* Wgi = (bf16*)((unsigned char*)F.wsg + WS_WGI);
    bf16* Wgo = (bf16*)((unsigned char*)F.wsg + WS_WGO); bf16* Wf1 = (bf16*)((unsigned char*)F.wsg + WS_WF1); bf16* Wf2 = (bf16*)((unsigned char*)F.wsg + WS_WF2);
    for (int it = gw; it < NITEMS; it += NGW) {
        int r = it;
        if (r < 2 * I_QKV) { const int j = r / I_QKV, q = r % I_QKV, kb = q / 192, nb = q % 192;
            transpose_item(F.in(IN_AWIN) + (size_t)j * DM * NQKVF, NQKVF, DM, Wqkv + (size_t)j * 6144 * DM, 64 * kb, 32 * nb, 32 * nb, 32, scr, F.lane); continue; } r -= 2 * I_QKV;
        if (r < 2 * I_F) { const int j = r / I_F, kb = r % I_F;
            transpose_item(F.in(IN_AWIN) + (size_t)j * DM * NQKVF, NQKVF, DM, Wf + (size_t)j * 16 * DM, 64 * kb, 6144, 0, 16, scr, F.lane); continue; } r -= 2 * I_F;
        if (r < 2 * I_O) { const int j = r / I_O, q = r % I_O, kb = q / 64, nb = q % 64;
            transpose_item(F.in(IN_AWO) + (size_t)j * DM * DM, DM, DM, Wo + (size_t)j * DM * DM, 64 * kb, 32 * nb, 32 * nb, 32, scr, F.lane); continue; } r -= 2 * I_O;
        if (r < 2 * I_GI) { const int j = r / I_GI, q = r % I_GI, kb = q / 128, nb = q % 128;
            transpose_item(F.in(IN_GWIN) + (size_t)j * DM * 4096, 4096, DM, Wgi + (size_t)j * 4096 * DM, 64 * kb, 32 * nb, 32 * nb, 32, scr, F.lane); continue; } r -= 2 * I_GI;
        if (r < 2 * I_GO) { const int j = r / I_GO, q = r % I_GO, kb = q / 64, nb = q % 64;
            transpose_item(F.in(IN_GWO) + (size_t)j * DM * DM, DM, DM, Wgo + (size_t)j * DM * DM, 64 * kb, 32 * nb, 32 * nb, 32, scr, F.lane); continue; } r -= 2 * I_GO;
        if (r < 4 * I_F1) { const int j = r / I_F1, q = r % I_F1, kb = q / 344, nb = q % 344;
            transpose_item(F.in(IN_FWIN) + (size_t)j * DM * NFF2, NFF2, DM, Wf1 + (size_t)j * NFF2 * DM, 64 * kb, 32 * nb, 32 * nb, 32, scr, F.lane); continue; } r -= 4 * I_F1;
        { const int j = r / I_F2, q = r % I_F2, kb = q / 64, nb = q % 64;
            transpose_item(F.in(IN_FWOUT) + (size_t)j * DFF * DM, DM, DFF, Wf2 + (size_t)j * DM * DFF, 64 * kb, 32 * nb, 32 * nb, 32, scr, F.lane); }
    }
}
__device__ __forceinline__ void norm_phase(Frame& F, const float* xin, const float* g, const float* shift, const float* scale, bf16* H) {
    const int gw = F.vcu * NWAVES + F.wave, NGW = F.G * NWAVES;
    for (int rb = gw; rb < MTOK / 16; rb += NGW) {
        const int b = (rb * 16) >> 12;
        f32x4 gs[8], sh[8];
#pragma unroll
        for (int j = 0; j < 8; ++j) { const int c4 = F.lane + 64 * j;
            gs[j] = ((const GAS f32x4*)g)[c4] * (((const GAS f32x4*)(scale + (size_t)b * 12288))[c4] + 1.0f); sh[j] = ((const GAS f32x4*)(shift + (size_t)b * 12288))[c4]; }
        for (int r = 0; r < 16; ++r) { const size_t row = (size_t)rb * 16 + r;
            const GAS f32x4* xr = (const GAS f32x4*)(xin + row * DM) + F.lane;
            f32x4 v[8]; float ss = 0.f;
#pragma unroll
            for (int j = 0; j < 8; ++j) { v[j] = xr[64 * j]; ss += (v[j].x * v[j].x + v[j].y * v[j].y) + (v[j].z * v[j].z + v[j].w * v[j].w); }
            const float rstd = 1.0f / sqrtf(wave_sum(ss) * (1.0f / DM) + EPS);
            GAS v2u* o8 = (GAS v2u*)(H + row * DM) + F.lane;
#pragma unroll
            for (int j = 0; j < 8; ++j) { const f32x4 o = v[j] * rstd * gs[j] + sh[j]; v2u w; w.x = pk2(o.x, o.y); w.y = pk2(o.z, o.w); o8[64 * j] = w; } }
    }
}
__device__ __forceinline__ void normf_phase(Frame& F, float* x, const float* g) {
    const int gw = F.vcu * NWAVES + F.wave, NGW = F.G * NWAVES;
    for (int rb = gw; rb < MTOK / 16; rb += NGW) {
        f32x4 gs[8];
#pragma unroll
        for (int j = 0; j < 8; ++j) gs[j] = ((const GAS f32x4*)g)[F.lane + 64 * j];
        for (int r = 0; r < 16; ++r) { const size_t row = (size_t)rb * 16 + r;
            GAS f32x4* xr = (GAS f32x4*)(x + row * DM) + F.lane;
            f32x4 v[8]; float ss = 0.f;
#pragma unroll
            for (int j = 0; j < 8; ++j) { v[j] = xr[64 * j]; ss += (v[j].x * v[j].x + v[j].y * v[j].y) + (v[j].z * v[j].z + v[j].w * v[j].w); }
            const float rstd = 1.0f / sqrtf(wave_sum(ss) * (1.0f / DM) + EPS);
#pragma unroll
            for (int j = 0; j < 8; ++j) xr[64 * j] = v[j] * rstd * gs[j]; }
    }
}
__device__ __forceinline__ void fg_phase(Frame& F, const bf16* H, const bf16* Wf, const float* bfv, float* LOGF) {
    const int gw = F.vcu * NWAVES + F.wave, NGW = F.G * NWAVES, fr = F.lane & 15, fq = F.lane >> 4;
    for (int rb = gw; rb < MTOK / 16; rb += NGW) {
        const GAS bf16x8* ap = (const GAS bf16x8*)(H + ((size_t)rb * 16 + fr) * DM + fq * 8);
        const GAS bf16x8* bp = (const GAS bf16x8*)(Wf + (size_t)fr * DM + fq * 8);
        f32x4 acc = (f32x4){0.f, 0.f, 0.f, 0.f};
#pragma unroll 8
        for (int ks = 0; ks < 64; ++ks) acc = __builtin_amdgcn_mfma_f32_16x16x32_bf16(bp[ks * 4], ap[ks * 4], acc, 0, 0, 0);
        const f32x4 bb = *(const GAS f32x4*)(bfv + 4 * fq); f32x4 o;
#pragma unroll
        for (int i = 0; i < 4; ++i) { const float z = acc[i] + bb[i]; o[i] = fminf(z, 0.f) - log1pf(__expf(-fabsf(z))); }
        *(GAS f32x4*)(LOGF + ((size_t)rb * 16 + fr) * 16 + 4 * fq) = o;
    }
}
__device__ __forceinline__ void cum_phase(Frame& F, const float* LOGF, float* FB) {
    const int gw = F.vcu * NWAVES + F.wave, NGW = F.G * NWAVES;
    for (int bh = gw; bh < NBATCH * NHEAD; bh += NGW) { const int b = bh >> 4, h = bh & 15;
        const float* p = LOGF + ((size_t)b * SEQ + F.lane * 64) * 16 + h;
        float v[64]; float s = 0.f;
#pragma unroll
        for (int i = 0; i < 64; ++i) { s += p[i * 16]; v[i] = s; }
        float incl = s;
#pragma unroll
        for (int o = 1; o < 64; o <<= 1) { const float t = __shfl_up(incl, o); if (F.lane >= o) incl += t; }
        const float excl = incl - s;
        GAS f32x4* q = (GAS f32x4*)(FB + (size_t)bh * SEQ + F.lane * 64);
#pragma unroll
        for (int i = 0; i < 16; ++i) q[i] = (f32x4){-(excl + v[4 * i]) * 1.4426950408889634f, -(excl + v[4 * i + 1]) * 1.4426950408889634f, -(excl + v[4 * i + 2]) * 1.4426950408889634f, -(excl + v[4 * i + 3]) * 1.4426950408889634f};
    }
}
__device__ __forceinline__ void vstat_phase(Frame& F, const bf16* Z, float* VRSTD) {
    const int gw = F.vcu * NWAVES + F.wave, NGW = F.G * NWAVES;
    for (int rb = gw; rb < MTOK / 16; rb += NGW)
        for (int r = 0; r < 16; ++r) { const size_t row = (size_t)rb * 16 + r;
            const GAS v4u* vp = (const GAS v4u*)(Z + row * 4096 + 2048) + F.lane; float ss = 0.f;
#pragma unroll
            for (int j = 0; j < 4; ++j) { const v4u w = vp[64 * j];
#pragma unroll
                for (int e = 0; e < 4; ++e) { const float a = bflo(w[e]), c = bfhi(w[e]); ss += a * a + c * c; } }
            const float rstd = 1.0f / sqrtf(wave_sum(ss) * (1.0f / DM) + EPS);
            if (F.lane == 0) VRSTD[row] = rstd; }
}
__device__ __forceinline__ void gate_phase(Frame& F, const bf16* Z, const float* VRSTD, const float* vg, const float* Ws, const float* bs, bf16* GT) {
    using fox::bf16x8; using fox::f32x16;
    const int r32 = F.lane & 31, hi = F.lane >> 5, c = F.wave >> 2, t0 = 32 * (F.wave & 3);
    const int vb0 = (int)(uintptr_t)(F.ldsg + RING_OFF) + c * 32768 + fox::v_rd_base(F.lane);
    bf16x8 aw[8]; int gcur = -1;
    for (int item = F.bid; item < (MTOK / 256) * 16; item += F.G) {
        const int g = item & 15, pnl = item >> 4; const size_t row0 = (size_t)pnl * 256;
        if (g != gcur) { gcur = g;
            const float* wr_ = Ws + ((size_t)g * 128 + t0 + r32) * 128 + 8 * hi;
#pragma unroll
            for (int ks = 0; ks < 8; ++ks) { const f32x4 a = *(const GAS f32x4*)(wr_ + 16 * ks), b = *(const GAS f32x4*)(wr_ + 16 * ks + 4); const int s0 = 16 * ks + 8 * hi; int t = t0 + r32; asm volatile("" : "+v"(t));
                v4u w; w.x = pk2(s0 + 0 <= t ? a.x : 0.f, s0 + 1 <= t ? a.y : 0.f); w.y = pk2(s0 + 2 <= t ? a.z : 0.f, s0 + 3 <= t ? a.w : 0.f);
                       w.z = pk2(s0 + 4 <= t ? b.x : 0.f, s0 + 5 <= t ? b.y : 0.f); w.w = pk2(s0 + 6 <= t ? b.z : 0.f, s0 + 7 <= t ? b.w : 0.f);
                aw[ks] = __builtin_bit_cast(bf16x8, w); } }
#pragma unroll 2
        for (int ps = 0; ps < 8; ++ps) { const int idx = ps * (NWAVES * 64) + F.tid, row = idx >> 4, c8 = (idx & 15) * 8, s = row & 127;
            const v4u w = *(const GAS v4u*)(Z + (row0 + row) * 4096 + 2048 + g * 128 + c8); const float rs = VRSTD[row0 + row];
            const f32x4 g0 = *(const GAS f32x4*)(vg + g * 128 + c8), g1 = *(const GAS f32x4*)(vg + g * 128 + c8 + 4);
            v4u o; o.x = pk2(bflo(w.x) * rs * g0.x, bfhi(w.x) * rs * g0.y); o.y = pk2(bflo(w.y) * rs * g0.z, bfhi(w.y) * rs * g0.w);
                   o.z = pk2(bflo(w.z) * rs * g1.x, bfhi(w.z) * rs * g1.y); o.w = pk2(bflo(w.w) * rs * g1.z, bfhi(w.w) * rs * g1.w);
            *(LAS v4u*)(F.lds + RING_OFF + ((row >> 7) * 2 + (s >> 6)) * 16384 + fox::v_st(s & 63, c8)) = o; }
        __syncthreads();
        f32x16 o[4] = {};
        fox::pv_tile<0, false>(o, vb0, aw[0], aw[1], aw[2], aw[3], true);
        if (t0 >= 64) fox::pv_tile<1, false>(o, vb0, aw[4], aw[5], aw[6], aw[7], true);
        { const size_t lrow = row0 + c * 128 + t0 + 4 * hi;
          const bf16* ub = Z + lrow * 4096 + g * 128 + r32; bf16* ob = GT + lrow * DM + g * 128 + r32; const float* bb = bs + g * 128 + t0 + 4 * hi;
#pragma unroll
          for (int r = 0; r < 16; ++r) { const int ro = (r & 3) + 8 * (r >> 2); const bf16* up = ub + (size_t)ro * 4096; bf16* op = ob + (size_t)ro * DM; asm volatile("" : "+v"(up), "+v"(op));
            const float bias = bb[ro];
#pragma unroll
            for (int d0 = 0; d0 < 4; ++d0) { const float u = bf2f(*(const GAS bf16*)(up + d0 * 32)); const float v = u * (o[d0][r] + bias);
                const float vn = __shfl_xor(v, 1);
                if ((r32 & 1) == 0) *(GAS unsigned*)(op + d0 * 32) = pk2(v, vn); } } }
        __syncthreads();
    }
}
__device__ __forceinline__ void conv_phase(Frame& F, const bf16* A, int tok0, int rows, const float* cw, const float* cb, bf16* ACT) {
    const int nitems = (rows / 16) * (DFF / 8);
    for (int item = F.bid * (NWAVES * 64) + F.tid; item < nitems; item += F.G * NWAVES * 64) {
        const int run = item / (DFF / 8), c8 = (item % (DFF / 8)) * 8, r0 = run * 16, t0 = (tok0 + r0) & (SEQ - 1);
        float wg[3][8], wu[3][8], bg[8], bu[8];
#pragma unroll
        for (int j = 0; j < 3; ++j)
#pragma unroll
            for (int e = 0; e < 8; ++e) { wg[j][e] = cw[j * NFF2 + c8 + e]; wu[j][e] = cw[j * NFF2 + DFF + c8 + e]; }
#pragma unroll
        for (int e = 0; e < 8; ++e) { bg[e] = cb[c8 + e]; bu[e] = cb[DFF + c8 + e]; }
        float g2[8], g1[8], u2[8], u1[8];
        if (t0 >= 2) { const v4u a = *(const GAS v4u*)(A + (size_t)(r0 - 2) * NFF2 + c8), bq = *(const GAS v4u*)(A + (size_t)(r0 - 1) * NFF2 + c8);
                       const v4u c = *(const GAS v4u*)(A + (size_t)(r0 - 2) * NFF2 + DFF + c8), d = *(const GAS v4u*)(A + (size_t)(r0 - 1) * NFF2 + DFF + c8);
#pragma unroll
            for (int e = 0; e < 4; ++e) { g2[2 * e] = bflo(a[e]); g2[2 * e + 1] = bfhi(a[e]); g1[2 * e] = bflo(bq[e]); g1[2 * e + 1] = bfhi(bq[e]);
                                          u2[2 * e] = bflo(c[e]); u2[2 * e + 1] = bfhi(c[e]); u1[2 * e] = bflo(d[e]); u1[2 * e + 1] = bfhi(d[e]); } }
        else {
#pragma unroll
            for (int e = 0; e < 8; ++e) { g2[e] = 0.f; g1[e] = 0.f; u2[e] = 0.f; u1[e] = 0.f; } }
        for (int r = 0; r < 16; ++r) {
            const v4u a = *(const GAS v4u*)(A + (size_t)(r0 + r) * NFF2 + c8), c = *(const GAS v4u*)(A + (size_t)(r0 + r) * NFF2 + DFF + c8);
            float g0[8], u0[8], o[8];
#pragma unroll
            for (int e = 0; e < 4; ++e) { g0[2 * e] = bflo(a[e]); g0[2 * e + 1] = bfhi(a[e]); u0[2 * e] = bflo(c[e]); u0[2 * e + 1] = bfhi(c[e]); }
#pragma unroll
            for (int e = 0; e < 8; ++e) { const float cg = wg[0][e] * g2[e] + wg[1][e] * g1[e] + wg[2][e] * g0[e] + bg[e], cu = wu[0][e] * u2[e] + wu[1][e] * u1[e] + wu[2][e] * u0[e] + bu[e];
                o[e] = cg / (1.0f + __expf(-cg)) * cu; g2[e] = g1[e]; g1[e] = g0[e]; u2[e] = u1[e]; u1[e] = u0[e]; }
            v4u w; w.x = pk2(o[0], o[1]); w.y = pk2(o[2], o[3]); w.z = pk2(o[4], o[5]); w.w = pk2(o[6], o[7]);
            *(GAS v4u*)(ACT + (size_t)(tok0 + r0 + r) * DFF + c8) = w; }
    }
}
constexpr int NPHASE = 1 + DEPTH * 11 + 1;
struct Args { const float* in[19]; float* out; unsigned char* ws; int ph_lo, ph_hi; };
static_assert(sizeof(Args) == 19 * 8 + 8 + 8 + 8, "Args has no padding bytes");
#ifndef MK_EN
#define MK_EN 0xffffffffu
#endif
#define EN(k) (((MK_EN) >> (k)) & 1u)
#ifndef MK_REP
#define MK_REP 0u
#endif
#define REPN(k) ((((MK_REP) >> (k)) & 1u) ? 2 : 1)
#define W_MOD   ((float*)((unsigned char*)F.wsg + WS_MOD))
#define W_H     ((bf16*)((unsigned char*)F.wsg + WS_H))
#define W_Q     ((bf16*)((unsigned char*)F.wsg + WS_R))
#define W_K     ((bf16*)((unsigned char*)F.wsg + WS_R + 128 * MiB))
#define W_V     ((bf16*)((unsigned char*)F.wsg + WS_R + 256 * MiB))
#define W_Z     ((bf16*)((unsigned char*)F.wsg + WS_R))
#define W_A     ((bf16*)((unsigned char*)F.wsg + WS_R))
#define W_ACT   ((bf16*)((unsigned char*)F.wsg + WS_R + 344 * MiB))
#define W_LOGF  ((float*)((unsigned char*)F.wsg + WS_LOGF))
#define W_FB    ((float*)((unsigned char*)F.wsg + WS_FB))
#define W_VRSTD ((float*)((unsigned char*)F.wsg + WS_VRSTD))
#define W_MODI  (W_MOD + (size_t)i * 8 * 12288)
#define X_IN    ((i == 0) ? F.in(IN_X) : (const float*)(float*)F.outg)
__global__ void __launch_bounds__(NWAVES * 64, 2) mega_fwd(Args args) {
    extern __shared__ __attribute__((aligned(16))) unsigned char lds[];
    Frame F;
    F.lds = (LAS unsigned char*)lds; F.ldsg = (char*)lds;
    F.MISC = (volatile LAS unsigned*)(F.lds + MISC_OFF);
    for (int u = threadIdx.x; u < (LDS_BYTES - LDSCTL_OFF) / 4; u += NWAVES * 64) ((LAS unsigned*)(F.lds + LDSCTL_OFF))[u] = 0u;
    __syncthreads();
    if (threadIdx.x == 0) {
        const int G = gridDim.x, bx = blockIdx.x; const unsigned long long kp = (unsigned long long)__builtin_amdgcn_kernarg_segment_ptr(), wp = (unsigned long long)args.ws, op = (unsigned long long)args.out;
        F.MISC[MW_BID] = (unsigned)bx; F.MISC[MW_G] = (unsigned)G; F.MISC[MW_VCU] = (unsigned)((G % 8 == 0) ? (bx % 8) * (G / 8) + bx / 8 : bx);
        F.MISC[MW_INP] = (unsigned)kp; F.MISC[MW_INP_HI] = (unsigned)(kp >> 32); F.MISC[MW_WS] = (unsigned)wp; F.MISC[MW_WS_HI] = (unsigned)(wp >> 32); F.MISC[MW_OUT] = (unsigned)op; F.MISC[MW_OUT_HI] = (unsigned)(op >> 32);
    }
    __syncthreads();
    XcdBarrier bar; bar.bar = (unsigned*)(args.ws + WS_CTL) + CW_BAR; bar.x = 0; bar.st = nullptr;
    if (!MK_PER_PHASE) bar = xcd_barrier_post((unsigned*)(args.ws + WS_CTL) + CW_BAR, F.MISC + 8);
    const int lo = args.ph_lo, hi = args.ph_hi;
    int ph = 0;
#define RUN() (lo <= ph && ph < hi && relaunder(F))
#define SEAM() do { if (!MK_PER_PHASE) { if (lo <= ph && ph + 1 < hi) { relaunder(F); bar.bar = (unsigned*)((unsigned char*)F.wsg + WS_CTL) + CW_BAR; asm volatile("" : "+s"(bar.x)); xcd_barrier(bar); } } ++ph; } while (0)

    if (EN(0) && RUN()) for (int rep_ = 0; rep_ < REPN(0); ++rep_) pro_phase(F);
    SEAM();
    for (int i = 0; i < DEPTH; ++i) {
        const int j = i >> 1;
        if (EN(1) && RUN()) for (int rep_ = 0; rep_ < REPN(1); ++rep_) norm_phase(F, X_IN, F.in(IN_MIXG) + i * DM, W_MODI, W_MODI + DM, W_H);
        SEAM();
        if ((i & 1) == 0) {
            if (EN(2) && RUN()) for (int rep_ = 0; rep_ < REPN(2); ++rep_) {
                fg_phase(F, W_H, (const bf16*)((unsigned char*)F.wsg + WS_WF) + (size_t)j * 16 * DM, F.in(IN_ABF) + j * 16, W_LOGF);
                pg8::Gemm g{W_H, (const bf16*)((unsigned char*)F.wsg + WS_WQKV) + (size_t)j * 6144 * DM, MTOK, 6144, DM}; pg8::StaticOrder S; S.init(MTOK, 6144, F.G, F.bid);
                pg8::EpiQKV E{W_Q, (size_t)(64 * MiB), fox::QSCALE};
                pg8::gemm_phase<pg8::EpiQKV, pg8::StaticOrder, true, true>(F.lds + RING_OFF, g, S, E);
            }
            SEAM();
            if (EN(3) && RUN()) for (int rep_ = 0; rep_ < REPN(3); ++rep_) cum_phase(F, W_LOGF, W_FB);
            SEAM();
            if (EN(4) && RUN()) for (int rep_ = 0; rep_ < REPN(4); ++rep_) fox::att_phase(F.ldsg + RING_OFF, (const fox::bf16*)W_Q, (const fox::bf16*)W_K, (const fox::bf16*)W_V, (fox::bf16*)W_H, W_FB, F.bid, F.G);
            SEAM();
            if (EN(5) && RUN()) for (int rep_ = 0; rep_ < REPN(5); ++rep_) {
                pg8::Gemm g{W_H, (const bf16*)((unsigned char*)F.wsg + WS_WO) + (size_t)j * DM * DM, MTOK, DM, DM}; pg8::StaticOrder S; S.init(MTOK, DM, F.G, F.bid);
                pg8::EpiRes E{X_IN, (float*)F.outg, W_MODI + 2 * DM, 12288};
                pg8::gemm_phase<pg8::EpiRes, pg8::StaticOrder, true, true>(F.lds + RING_OFF, g, S, E);
            }
            SEAM();
        } else {
            if (EN(6) && RUN()) for (int rep_ = 0; rep_ < REPN(6); ++rep_) {
                pg8::Gemm g{W_H, (const bf16*)((unsigned char*)F.wsg + WS_WGI) + (size_t)j * 4096 * DM, MTOK, 4096, DM}; pg8::StaticOrder S; S.init(MTOK, 4096, F.G, F.bid);
                pg8::EpiStore<1> E{W_Z, 4096};
                pg8::gemm_phase<pg8::EpiStore<1>, pg8::StaticOrder, true, true>(F.lds + RING_OFF, g, S, E);
            }
            SEAM();
            if (EN(7) && RUN()) for (int rep_ = 0; rep_ < REPN(7); ++rep_) vstat_phase(F, W_Z, W_VRSTD);
            SEAM();
            if (EN(8) && RUN()) for (int rep_ = 0; rep_ < REPN(8); ++rep_) gate_phase(F, W_Z, W_VRSTD, F.in(IN_GVG) + j * DM, F.in(IN_GWS) + (size_t)j * 16 * 128 * 128, F.in(IN_GBS) + j * 16 * 128, W_H);
            SEAM();
            if (EN(9) && RUN()) for (int rep_ = 0; rep_ < REPN(9); ++rep_) {
                pg8::Gemm g{W_H, (const bf16*)((unsigned char*)F.wsg + WS_WGO) + (size_t)j * DM * DM, MTOK, DM, DM}; pg8::StaticOrder S; S.init(MTOK, DM, F.G, F.bid);
                pg8::EpiRes E{X_IN, (float*)F.outg, W_MODI + 2 * DM, 12288};
                pg8::gemm_phase<pg8::EpiRes, pg8::StaticOrder, true, true>(F.lds + RING_OFF, g, S, E);
            }
            SEAM();
        }
        if (EN(10) && RUN()) for (int rep_ = 0; rep_ < REPN(10); ++rep_) norm_phase(F, (float*)F.outg, F.in(IN_FFNG) + i * DM, W_MODI + 3 * DM, W_MODI + 4 * DM, W_H);
        SEAM();
        for (int half = 0; half < 2; ++half) {
            if (EN(11) && RUN()) for (int rep_ = 0; rep_ < REPN(11); ++rep_) {
                pg8::Gemm g{W_H + (size_t)half * (MTOK / 2) * DM, (const bf16*)((unsigned char*)F.wsg + WS_WF1) + (size_t)i * NFF2 * DM, MTOK / 2, NFF2, DM}; pg8::StaticOrder S; S.init(MTOK / 2, NFF2, F.G, F.bid);
                pg8::EpiStore<0> E{W_A, NFF2};
                pg8::gemm_phase<pg8::EpiStore<0>, pg8::StaticOrder, true, true>(F.lds + RING_OFF, g, S, E);
            }
            SEAM();
            if (EN(12) && RUN()) for (int rep_ = 0; rep_ < REPN(12); ++rep_) conv_phase(F, W_A, half * (MTOK / 2), MTOK / 2, F.in(IN_FCW) + (size_t)i * 3 * NFF2, F.in(IN_FCB) + (size_t)i * NFF2, W_ACT);
            SEAM();
        }
        if (EN(13) && RUN()) for (int rep_ = 0; rep_ < REPN(13); ++rep_) {
            pg8::Gemm g{W_ACT, (const bf16*)((unsigned char*)F.wsg + WS_WF2) + (size_t)i * DM * DFF, MTOK, DM, DFF}; pg8::StaticOrder S; S.init(MTOK, DM, F.G, F.bid);
            pg8::EpiRes E{(float*)F.outg, (float*)F.outg, W_MODI + 5 * DM, 12288};
            pg8::gemm_phase<pg8::EpiRes, pg8::StaticOrder, true, true>(F.lds + RING_OFF, g, S, E);
        }
        SEAM();
    }
    if (EN(14) && RUN()) for (int rep_ = 0; rep_ < REPN(14); ++rep_) normf_phase(F, (float*)F.outg, F.in(IN_FING));
#undef RUN
#undef SEAM
}

extern "C" void kernel_launch(void* const* d_in, const int* in_sizes, int n_in, void* d_out, int out_size, void* d_ws, size_t ws_size, hipStream_t stream) {
    static int grid = 0;
    if (grid == 0) {
        if (n_in != 19 || out_size != MTOK * DM || ws_size < WS_END) { fprintf(stderr, "kernel_launch: unexpected shapes (n_in %d, out %d, ws %zu < %zu)\n", n_in, out_size, ws_size, (size_t)WS_END); grid = -1; return; }
        int dev = 0, cus = 0, per_cu = 0;
        if (hipGetDevice(&dev) != hipSuccess || hipDeviceGetAttribute(&cus, hipDeviceAttributeMultiprocessorCount, dev) != hipSuccess) { grid = -1; return; }
        if (hipFuncSetAttribute((const void*)mega_fwd, hipFuncAttributeMaxDynamicSharedMemorySize, LDS_BYTES) != hipSuccess) { fprintf(stderr, "kernel_launch: hipFuncSetAttribute failed\n"); grid = -1; return; }
        if (hipOccupancyMaxActiveBlocksPerMultiprocessor(&per_cu, (const void*)mega_fwd, NWAVES * 64, LDS_BYTES) != hipSuccess || per_cu < 1) { fprintf(stderr, "kernel_launch: occupancy query says %d\n", per_cu); }
        (void)hipGetLastError();
        grid = cus;
    }
    if (grid < 0) return;
    if (hipMemsetAsync((char*)d_ws + WS_CTL, 0, CTL_ZERO_BYTES, stream) != hipSuccess) return;
    Args a{};
    for (int i = 0; i < 19; ++i) a.in[i] = (const float*)d_in[i];
    a.out = (float*)d_out; a.ws = (unsigned char*)d_ws;
#if MK_PER_PHASE
    for (int p = 0; p < NPHASE; ++p) { a.ph_lo = p; a.ph_hi = p + 1; hipLaunchKernelGGL(mega_fwd, dim3(grid), dim3(NWAVES * 64), LDS_BYTES, stream, a); }
#else
    a.ph_lo = 0; a.ph_hi = NPHASE; hipLaunchKernelGGL(mega_fwd, dim3(grid), dim3(NWAVES * 64), LDS_BYTES, stream, a);
#endif
}
```

```cpp
#include <hip/hip_runtime.h>
#include <hip/hip_bf16.h>
#include <cstdio>
#include <cstdint>
__device__ __forceinline__ int ltid() { int t = (int)threadIdx.x; asm volatile("" : "+v"(t)); return t; }
namespace pg8 {
#define PG8_LAS __attribute__((address_space(3)))
typedef unsigned short bf16_t;
typedef short bf16x8 __attribute__((ext_vector_type(8)));
typedef float f32x4 __attribute__((ext_vector_type(4)));
typedef unsigned u32x4 __attribute__((ext_vector_type(4)));
constexpr int BM = 256, BK = 64, HALF = 128, HTB = HALF * BK * 2  , STAGE_BYTES = 8 * HTB, NXCD = 8, WGM = 8;

__host__ __device__ __forceinline__ int lds_byte(int r, int c) { const int st = (r >> 4) * 2 + (c >> 5), rr = r & 15, cc = c & 31, ob = rr * 64 + cc * 2; return st * 1024 + (ob ^ (((ob >> 9) & 1) << 5)); }
__host__ __device__ __forceinline__ void stage_rc(int b, int& R, int& C) { const int st = b / 1024, sb = b % 1024, swz = sb ^ (((sb >> 9) & 1) << 5); R = (st >> 1) * 16 + swz / 64; C = (st & 1) * 32 + (swz % 64) / 2; }
__host__ __device__ __forceinline__ int perm32(int rho) { const int n = rho >> 4, i = rho & 15; return 8 * (i >> 2) + 4 * n + (i & 3); }

struct Unit { int pm, pn; };
struct Gemm { const bf16_t* A; const bf16_t* Bt; int M, N, K; };

struct StaticOrder {
    int nM, nN, nwg, G, c;
    __host__ __device__ void init(int M, int N, int G_, int c_) { nM = M / BM; nN = N / BM; nwg = nM * nN; G = G_; c = c_; }
    __host__ __device__ bool next(int i, Unit& u) const {
        const long L = (long)i * G + c; if (L >= nwg) return false;
        int wgid = (int)L; { const int q = nwg / NXCD, r = nwg % NXCD, xcd = wgid % NXCD, off = wgid / NXCD; wgid = (xcd < r ? xcd * (q + 1) : r * (q + 1) + (xcd - r) * q) + off; }
        const int nig = WGM * nN, gid = wgid / nig, fm = gid * WGM, gsz = (nM - fm) < WGM ? (nM - fm) : WGM;
        u.pm = fm + ((wgid % nig) % gsz); u.pn = (wgid % nig) / gsz; return true;
    }
    __device__ __forceinline__ void a_ready(const Unit&) const {}
    __device__ __forceinline__ void done(const Unit&) const {}
};
__device__ __forceinline__ unsigned cvt_pk_bf16(float lo, float hi) { unsigned r; asm volatile("v_cvt_pk_bf16_f32 %0, %1, %2" : "=v"(r) : "v"(lo), "v"(hi)); return r; }
typedef float f32x2 __attribute__((ext_vector_type(2)));
__device__ __forceinline__ f32x2 gelu_pk(f32x2 v) {
    const f32x2 av = __builtin_elementwise_abs(v), d = av * 0.2316418882f + 1.0f;
    f32x2 t; t.x = __builtin_amdgcn_rcpf(d.x); t.y = __builtin_amdgcn_rcpf(d.y);
    f32x2 q = t * 0.5307027145f + (-0.7265760135f); q = q * t + 0.7107068705f; q = q * t + (-0.142248368f); q = q * t + 0.127414796f; q = q * t;
    const f32x2 s = (v * v) * (-0.72134752044f);
    f32x2 e; e.x = __builtin_amdgcn_exp2f(s.x); e.y = __builtin_amdgcn_exp2f(s.y);
    const f32x2 m = v * (q * e), r = v - m;
    f32x2 o; o.x = v.x < 0.f ? m.x : r.x; o.y = v.y < 0.f ? m.y : r.y; return o;
}

__device__ __forceinline__ float gelu_tanh1(float v) {
    const float u = v * (0.7978845608f + 0.0356774081f * v * v);
    const float e = __builtin_amdgcn_exp2f(u * -2.8853900818f);
    return v * __builtin_amdgcn_rcpf(1.0f + e);
}
template <int ACT  > struct EpiStore {
    static constexpr bool PERM = true, AFTER_DRAIN = false;
    bf16_t* O; int ldc;
    __device__ __forceinline__ void operator()(const f32x4 (&acc)[2][2][4][2], const Unit& u, int wr, int wc, int fr, int fq) const {
        const int row0 = u.pm * BM + wr * 64 + fr, col0 = u.pn * BM + wc * 32 + 8 * fq;
#pragma unroll
        for (int ai = 0; ai < 2; ++ai)
#pragma unroll
            for (int m = 0; m < 4; ++m) { bf16_t* rowp = O + (size_t)(row0 + ai * HALF + m * 16) * ldc + col0;
#pragma unroll
                for (int bj = 0; bj < 2; ++bj) { f32x4 v0 = acc[ai][bj][m][0], v1 = acc[ai][bj][m][1];
                    if (ACT == 1) {
#pragma unroll
                        for (int j = 0; j < 4; ++j) { v0[j] = gelu_tanh1(v0[j]); v1[j] = gelu_tanh1(v1[j]); } }
                    u32x4 w; w.x = cvt_pk_bf16(v0[0], v0[1]); w.y = cvt_pk_bf16(v0[2], v0[3]); w.z = cvt_pk_bf16(v1[0], v1[1]); w.w = cvt_pk_bf16(v1[2], v1[3]);
                    *(u32x4*)(rowp + bj * HALF) = w; } }
    }
};
struct EpiQKV {
    static constexpr bool PERM = true, AFTER_DRAIN = false;
    bf16_t* QKV; size_t tstride; float qscale;
    __device__ __forceinline__ void operator()(const f32x4 (&acc)[2][2][4][2], const Unit& u, int wr, int wc, int fr, int fq) const {
        const int tok0 = u.pm * BM, b = tok0 >> 12, s0 = (tok0 & 4095) + wr * 64 + fr;
        const int colt = u.pn * BM, t = colt >> 11, hd0 = (colt & 2047) >> 7;
        bf16_t* base = QKV + (size_t)t * tstride; const float sc = t == 0 ? qscale : 1.0f;
#pragma unroll
        for (int bj = 0; bj < 2; ++bj) { bf16_t* hb = base + ((size_t)(b * 16 + hd0 + bj) * 4096 + s0) * 128 + wc * 32 + 8 * fq;
#pragma unroll
            for (int ai = 0; ai < 2; ++ai)
#pragma unroll
                for (int m = 0; m < 4; ++m) { const f32x4 v0 = acc[ai][bj][m][0] * sc, v1 = acc[ai][bj][m][1] * sc;
                    u32x4 w; w.x = cvt_pk_bf16(v0[0], v0[1]); w.y = cvt_pk_bf16(v0[2], v0[3]); w.z = cvt_pk_bf16(v1[0], v1[1]); w.w = cvt_pk_bf16(v1[2], v1[3]);
                    *(u32x4*)(hb + (size_t)(ai * HALF + m * 16) * 128) = w; } }
    }
};
struct EpiRes {
    static constexpr bool PERM = false, AFTER_DRAIN = false;
    const float* xin; float* xout; const float* gate; int gpitch;
    __device__ __forceinline__ void operator()(const f32x4 (&acc)[2][2][4][2], const Unit& u, int wr, int wc, int fr, int fq) const {
        const int row0 = u.pm * BM + wr * 64 + fr, col0 = u.pn * BM + wc * 32 + 4 * fq, b = (u.pm * BM) >> 12;
        f32x4 gv[2][2];
#pragma unroll
        for (int bj = 0; bj < 2; ++bj)
#pragma unroll
            for (int n = 0; n < 2; ++n) gv[bj][n] = *(const f32x4*)(gate + (size_t)b * gpitch + col0 + bj * HALF + n * 16);
#pragma unroll
        for (int ai = 0; ai < 2; ++ai)
#pragma unroll
            for (int m = 0; m < 4; ++m) { const size_t off = (size_t)(row0 + ai * HALF + m * 16) * 2048 + col0;
#pragma unroll
                for (int bj = 0; bj < 2; ++bj)
#pragma unroll
                    for (int n = 0; n < 2; ++n) { const f32x4 xo = *(const f32x4*)(xin + off + bj * HALF + n * 16);
                        *(f32x4*)(xout + off + bj * HALF + n * 16) = xo + gv[bj][n] * acc[ai][bj][m][n]; }
                asm volatile("" ::: "memory"); }
    }
};
__device__ __forceinline__ int f2i(float v) { return __builtin_bit_cast(int, v); }
__device__ __forceinline__ float i2f(int v) { return __builtin_bit_cast(float, v); }
template <int SH> __device__ __forceinline__ float dpp_ror(float v) { return i2f(__builtin_amdgcn_update_dpp(0, f2i(v), 0x120 + SH, 0xf, 0xf, true)); }
template <int SH> __device__ __forceinline__ float dpp_shr_fill(float fill, float cur) { return i2f(__builtin_amdgcn_update_dpp(f2i(fill), f2i(cur), 0x110 + SH, 0xf, 0xf, false)); }
struct EpiConv {
    static constexpr bool PERM = true, AFTER_DRAIN = false;
    bf16_t* ACT; const float* cw; const float* cb; float* HALO; PG8_LAS float* X;
    __device__ __forceinline__ void operator()(f32x4 (&acc)[2][2][4][2], const Unit& u, int wr, int wc, int fr, int fq) const {
        const int tcol = wc * 32 + 8 * fq, ch0 = u.pn * 128 + tcol;
        if (fr >= 14) {
#pragma unroll
            for (int ai = 0; ai < 2; ++ai)
#pragma unroll
                for (int bj = 0; bj < 2; ++bj)
#pragma unroll
                    for (int n = 0; n < 2; ++n) *(PG8_LAS f32x4*)(X + (((ai * 2 + wr) * 2 + (fr - 14)) * 256) + bj * 128 + tcol + 4 * n) = acc[ai][bj][3][n];
            if (wr == 1) {
#pragma unroll
                for (int bj = 0; bj < 2; ++bj)
#pragma unroll
                    for (int n = 0; n < 2; ++n) *(f32x4*)(HALO + ((size_t)u.pm * 4 + 2 + (fr - 14)) * 11008 + bj * 5504 + ch0 + 4 * n) = acc[1][bj][3][n]; }
        }
        if (fr < 2 && wr == 0) {
#pragma unroll
            for (int bj = 0; bj < 2; ++bj)
#pragma unroll
                for (int n = 0; n < 2; ++n) *(f32x4*)(HALO + ((size_t)u.pm * 4 + fr) * 11008 + bj * 5504 + ch0 + 4 * n) = acc[0][bj][0][n]; }
        asm volatile("s_waitcnt lgkmcnt(0)" ::: "memory"); __builtin_amdgcn_s_barrier(); asm volatile("" ::: "memory");
#pragma unroll
        for (int bj = 0; bj < 2; ++bj) {
            f32x4 w0[2], w1[2], w2[2], bb[2];
#pragma unroll
            for (int n = 0; n < 2; ++n) { const float* p = cw + bj * 5504 + ch0 + 4 * n; w0[n] = *(const f32x4*)p; w1[n] = *(const f32x4*)(p + 11008); w2[n] = *(const f32x4*)(p + 2 * 11008); bb[n] = *(const f32x4*)(cb + bj * 5504 + ch0 + 4 * n); }
            __builtin_amdgcn_sched_barrier(0);
#pragma unroll
            for (int ai = 0; ai < 2; ++ai) { const int g = ai * 2 + wr;
#pragma unroll
                for (int n = 0; n < 2; ++n) {
                    f32x4 h1 = (f32x4){0.f, 0.f, 0.f, 0.f}, h2 = h1;
                    if (g > 0) { h1 = *(const PG8_LAS f32x4*)(X + (((g - 1) * 2 + 1) * 256) + bj * 128 + tcol + 4 * n); h2 = *(const PG8_LAS f32x4*)(X + (((g - 1) * 2 + (fr & 1)) * 256) + bj * 128 + tcol + 4 * n); }
#pragma unroll
                    for (int m = 3; m >= 0; --m) { const f32x4 x = acc[ai][bj][m][n]; f32x4 r;
#pragma unroll
                        for (int e = 0; e < 4; ++e) { float f1, f2;
                            if (m > 0) { const float xp = acc[ai][bj][m - 1][n][e]; f1 = dpp_ror<1>(xp); f2 = dpp_ror<2>(xp); } else { f1 = h1[e]; f2 = h2[e]; }
                            const float p1 = dpp_shr_fill<1>(f1, x[e]), p2 = dpp_shr_fill<2>(f2, x[e]);
                            r[e] = bb[n][e] + w2[n][e] * x[e] + w1[n][e] * p1 + w0[n][e] * p2; }
                        asm volatile("" : "+v"(r));
                        acc[ai][bj][m][n] = r; }
                    __builtin_amdgcn_sched_barrier(0); } }
        }
        const int row0 = u.pm * BM + wr * 64 + fr;
#pragma unroll
        for (int ai = 0; ai < 2; ++ai)
#pragma unroll
            for (int m = 0; m < 4; ++m) { f32x4 o[2];
#pragma unroll
                for (int n = 0; n < 2; ++n)
#pragma unroll
                    for (int e = 0; e < 4; ++e) { const float gt = acc[ai][0][m][n][e]; o[n][e] = gt * __builtin_amdgcn_rcpf(1.0f + __builtin_amdgcn_exp2f(gt * -1.4426950408889634f)) * acc[ai][1][m][n][e]; }
                u32x4 w; w.x = cvt_pk_bf16(o[0][0], o[0][1]); w.y = cvt_pk_bf16(o[0][2], o[0][3]); w.z = cvt_pk_bf16(o[1][0], o[1][1]); w.w = cvt_pk_bf16(o[1][2], o[1][3]);
                *(u32x4*)(ACT + (size_t)(row0 + ai * HALF + m * 16) * 5504 + ch0) = w; }
    }
};
template <class Epi, class Sched, bool ALIGN_EPI = false, bool SP2 = false>
__device__ __forceinline__ void gemm_phase(PG8_LAS unsigned char* lds, const Gemm g, const Sched& S, const Epi& E) {
    const int tid = ltid(), wid = __builtin_amdgcn_readfirstlane(tid >> 6), lane = tid & 63, wr = wid >> 2, wc = wid & 3, fr = lane & 15, fq = lane >> 4;
    const int K = g.K, nt = K / BK;
    unsigned voffA[2], voffB[2];
#pragma unroll
    for (int i = 0; i < 2; ++i) { int R, C; stage_rc(tid * 16 + i * 8192, R, C); const int Rb = Epi::PERM ? ((R & ~31) + perm32(R & 31)) : R;
        voffA[i] = (unsigned)(R * K + C) * 2u; voffB[i] = (unsigned)(Rb * K + C) * 2u; }
    const size_t kstep = (size_t)(BK * 2);
    const size_t hstep = (size_t)HALF * K * 2;
    const size_t tstep = 2 * hstep;
    const unsigned ldsw = (unsigned)wid * 1024u;
    const int aoff = lds_byte(wr * 64 + fr, fq * 8), boff = lds_byte(wc * 32 + fr, fq * 8);
#define PG8_SA(b, h) (((b) * 2 + (h)) * HTB)
#define PG8_SB(b, h) ((4 + (b) * 2 + (h)) * HTB)
#define PG8_STAGE(bufoff, gbase, voff) do { _Pragma("unroll") for (int _i = 0; _i < 2; ++_i) \
        __builtin_amdgcn_global_load_lds((const unsigned*)((const char*)(gbase) + (voff)[_i]), (PG8_LAS unsigned*)(lds + (bufoff) + ldsw + _i * 8192), 16, 0, 0); } while (0)
#define PG8_LDA(dst, b, h) do { _Pragma("unroll") for (int m = 0; m < 4; ++m) _Pragma("unroll") for (int k = 0; k < 2; ++k) dst[m][k] = *(const PG8_LAS bf16x8*)(lds + PG8_SA(b, h) + aoff + m * 2048 + k * 1024); } while (0)
#define PG8_LDB(dst, b, h) do { _Pragma("unroll") for (int n = 0; n < 2; ++n) _Pragma("unroll") for (int k = 0; k < 2; ++k) dst[n][k] = *(const PG8_LAS bf16x8*)(lds + PG8_SB(b, h) + boff + n * 2048 + k * 1024); } while (0)
#define PG8_MMA(ai, bj, At, Bt) do { __builtin_amdgcn_s_setprio(1); _Pragma("unroll") for (int m = 0; m < 4; ++m) _Pragma("unroll") for (int n = 0; n < 2; ++n) _Pragma("unroll") for (int k = 0; k < 2; ++k) \
        acc[ai][bj][m][n] = __builtin_amdgcn_mfma_f32_16x16x32_bf16(Bt[n][k], At[m][k], acc[ai][bj][m][n], 0, 0, 0); __builtin_amdgcn_s_setprio(0); } while (0)
#define PG8_WAIT_V(n) asm volatile("s_waitcnt vmcnt(" #n ")" ::: "memory")
#define PG8_WAIT_L(n) asm volatile("s_waitcnt lgkmcnt(" #n ")" ::: "memory")
#define PG8_BAR __builtin_amdgcn_s_barrier()
#define PG8_SCHED __builtin_amdgcn_sched_barrier(0)
    Unit cur, nxt; int ui = 0;
    if (!S.next(0, cur)) return;
    f32x4 acc[2][2][4][2];
#pragma unroll
    for (int a = 0; a < 2; ++a)
#pragma unroll
        for (int b = 0; b < 2; ++b)
#pragma unroll
            for (int m = 0; m < 4; ++m)
#pragma unroll
                for (int n = 0; n < 2; ++n) acc[a][b][m][n] = (f32x4){0.f, 0.f, 0.f, 0.f};
    bf16x8 At[4][2], B0[2][2], B1[2][2];
    const char* cA = (const char*)g.A + (size_t)cur.pm * tstep; const char* cB = (const char*)g.Bt + (size_t)cur.pn * tstep;
    S.a_ready(cur);
    if constexpr (SP2) {
        PG8_STAGE(PG8_SB(0, 0), cB, voffB); PG8_STAGE(PG8_SB(0, 1), cB + hstep, voffB); PG8_STAGE(PG8_SA(0, 0), cA, voffA); PG8_STAGE(PG8_SA(0, 1), cA + hstep, voffA);
        if (wr == 1) PG8_BAR;
        PG8_WAIT_V(2); PG8_BAR;
        PG8_STAGE(PG8_SB(1, 0), cB + kstep, voffB); PG8_STAGE(PG8_SA(1, 0), cA + kstep, voffA); PG8_STAGE(PG8_SB(1, 1), cB + hstep + kstep, voffB);
        PG8_WAIT_V(6); PG8_BAR;
    } else {
        PG8_STAGE(PG8_SB(0, 0), cB, voffB); PG8_STAGE(PG8_SA(0, 0), cA, voffA); PG8_STAGE(PG8_SB(0, 1), cB + hstep, voffB); PG8_STAGE(PG8_SA(0, 1), cA + hstep, voffA);
        if (wr == 1) PG8_BAR;
        PG8_WAIT_V(4); PG8_BAR;
        PG8_STAGE(PG8_SB(1, 0), cB + kstep, voffB); PG8_STAGE(PG8_SA(1, 0), cA + kstep, voffA); PG8_STAGE(PG8_SB(1, 1), cB + hstep + kstep, voffB);
        PG8_WAIT_V(6); PG8_BAR;
    }
    for (;;) {
        const bool has_next = S.next(ui + 1, nxt);
        const char* nA = has_next ? (const char*)g.A + (size_t)nxt.pm * tstep : cA; const char* nB = has_next ? (const char*)g.Bt + (size_t)nxt.pn * tstep : cB;
        for (int t = 0; t < nt; t += 2) {
            const bool last = (t == nt - 2);
            const char* a1 = cA + (size_t)(t + 1) * kstep;
            const char* a2 = last ? nA : cA + (size_t)(t + 2) * kstep; const char* b2 = last ? nB : cB + (size_t)(t + 2) * kstep;
            const char* a3 = a2 + kstep; const char* b3 = b2 + kstep;
            if (last && has_next) S.a_ready(nxt);
            if constexpr (SP2) {
            PG8_LDB(B0, 0, 0); PG8_LDB(B1, 0, 1); PG8_SCHED; PG8_LDA(At, 0, 0); PG8_STAGE(PG8_SA(1, 1), a1 + hstep, voffA);
            PG8_WAIT_V(8); PG8_WAIT_L(0); PG8_BAR; PG8_MMA(0, 0, At, B0); PG8_MMA(0, 1, At, B1); PG8_BAR; PG8_SCHED;
            PG8_LDA(At, 0, 1); PG8_STAGE(PG8_SB(0, 0), b2, voffB); PG8_STAGE(PG8_SB(0, 1), b2 + hstep, voffB); PG8_STAGE(PG8_SA(0, 0), a2, voffA);
            PG8_WAIT_V(8); PG8_WAIT_L(0); PG8_BAR; PG8_MMA(1, 0, At, B0); PG8_MMA(1, 1, At, B1); PG8_BAR; PG8_SCHED;
            PG8_LDB(B0, 1, 0); PG8_LDB(B1, 1, 1); PG8_SCHED; PG8_LDA(At, 1, 0); PG8_STAGE(PG8_SA(0, 1), a2 + hstep, voffA);
            PG8_WAIT_V(8); PG8_WAIT_L(0); PG8_BAR; PG8_MMA(0, 0, At, B0); PG8_MMA(0, 1, At, B1); PG8_BAR; PG8_SCHED;
            PG8_LDA(At, 1, 1); PG8_STAGE(PG8_SB(1, 0), b3, voffB); PG8_STAGE(PG8_SB(1, 1), b3 + hstep, voffB); PG8_STAGE(PG8_SA(1, 0), a3, voffA);
            PG8_WAIT_V(8); PG8_WAIT_L(0); PG8_BAR; PG8_MMA(1, 0, At, B0); PG8_MMA(1, 1, At, B1); PG8_BAR; PG8_SCHED;
            } else {
            PG8_LDB(B0, 0, 0); PG8_SCHED; PG8_LDA(At, 0, 0); PG8_STAGE(PG8_SA(1, 1), a1 + hstep, voffA);
            PG8_WAIT_L(8); PG8_BAR; PG8_WAIT_L(0); PG8_MMA(0, 0, At, B0); PG8_BAR; PG8_SCHED;
            PG8_LDB(B1, 0, 1); PG8_STAGE(PG8_SB(0, 0), b2, voffB);
            PG8_BAR; PG8_WAIT_L(0); PG8_MMA(0, 1, At, B1); PG8_BAR;
            PG8_LDA(At, 0, 1); PG8_STAGE(PG8_SA(0, 0), a2, voffA);
            PG8_BAR; PG8_WAIT_L(0); PG8_MMA(1, 0, At, B0); PG8_BAR; PG8_SCHED;
            PG8_STAGE(PG8_SB(0, 1), b2 + hstep, voffB);
            PG8_WAIT_V(6); PG8_BAR; PG8_MMA(1, 1, At, B1); PG8_BAR;
            PG8_LDB(B0, 1, 0); PG8_SCHED; PG8_LDA(At, 1, 0); PG8_STAGE(PG8_SA(0, 1), a2 + hstep, voffA);
            PG8_WAIT_L(8); PG8_BAR; PG8_WAIT_L(0); PG8_MMA(0, 0, At, B0); PG8_BAR; PG8_SCHED;
            PG8_LDB(B1, 1, 1); PG8_STAGE(PG8_SB(1, 0), b3, voffB);
            PG8_BAR; PG8_WAIT_L(0); PG8_MMA(0, 1, At, B1); PG8_BAR;
            PG8_LDA(At, 1, 1); PG8_STAGE(PG8_SA(1, 0), a3, voffA);
            PG8_BAR; PG8_WAIT_L(0); PG8_MMA(1, 0, At, B0); PG8_BAR; PG8_SCHED;
            PG8_STAGE(PG8_SB(1, 1), b3 + hstep, voffB);
            PG8_WAIT_V(6); PG8_BAR; PG8_MMA(1, 1, At, B1); PG8_BAR;
            }
        }
        if constexpr (ALIGN_EPI) { if (wr == 0) PG8_BAR; }
        if constexpr (!Epi::AFTER_DRAIN) { E(acc, cur, wr, wc, fr, fq); S.done(cur); }
        if (!has_next) break;
#pragma unroll
        for (int a = 0; a < 2; ++a)
#pragma unroll
            for (int b = 0; b < 2; ++b)
#pragma unroll
                for (int m = 0; m < 4; ++m)
#pragma unroll
                    for (int n = 0; n < 2; ++n) acc[a][b][m][n] = (f32x4){0.f, 0.f, 0.f, 0.f};
        cur = nxt; cA = nA; cB = nB; ++ui;
        if constexpr (ALIGN_EPI) { if (wr == 1) PG8_BAR; }
    }
    PG8_WAIT_V(0);
    if constexpr (!ALIGN_EPI) { if (wr == 0) PG8_BAR; }
    PG8_BAR;
    if constexpr (Epi::AFTER_DRAIN) { E.fused(acc, cur, wr, wc, fr, fq, lds, wid, lane); S.done(cur); }
#undef PG8_SA
#undef PG8_SB
#undef PG8_STAGE
#undef PG8_LDA
#undef PG8_LDB
#undef PG8_MMA
#undef PG8_WAIT_V
#undef PG8_WAIT_L
#undef PG8_BAR
#undef PG8_SCHED
}
}
namespace fox {
enum { ORDER_NATURAL = 0, ORDER_REVERSED = 1, ORDER_PAIRED = 2, ORDER_XCD = 4 };
constexpr int B = 8, H = 16, HKV = 16, SQ = 4096, SKV = 4096, D = 128;
constexpr int QOFF = 0;
constexpr int WINDOW = SKV;
constexpr float THR = 8.f;
constexpr bool WSKIP = false;
constexpr float SCALE = 0.08838834764831845f;
constexpr float QSCALE = SCALE * 1.4426950408889634f;
constexpr int NW = 8, QBLK = 32, KVBLK = 64, QB = NW * QBLK;
constexpr int SHM_V = KVBLK * D * 2, SHM_K = KVBLK * D * 2;
constexpr int LDS_FB = 2 * SHM_V + 2 * SHM_K + NW * 64 * 4;
constexpr int LDS_BYTES = LDS_FB + SKV * 4;
constexpr int OPITCH = H * D;
using bf16 = __hip_bfloat16;
typedef short bf16x8 __attribute__((ext_vector_type(8)));
typedef short s16x4 __attribute__((ext_vector_type(4)));
typedef float f32x16 __attribute__((ext_vector_type(16)));
typedef float f32x4 __attribute__((ext_vector_type(4)));
typedef unsigned u32x4 __attribute__((ext_vector_type(4)));
template <class A, class Bt> struct same_t { static constexpr bool v = false; };
template <class A> struct same_t<A, A> { static constexpr bool v = true; };

#define KSWZ(row, colB) ((row) * 256 + ((colB) ^ (((row) & 7) << 4)))
#define SBAR() __builtin_amdgcn_sched_barrier(0)
__device__ __forceinline__ int v_st(int k, int c) { const int kk = (k & ~0xC) | ((k & 4) << 1) | ((k & 8) >> 1); return ((kk >> 3) * 4 + (c >> 5)) * 512 + ((kk & 7) * 32 + (c & 31)) * 2; }
__device__ __forceinline__ int v_rd_base(int lane) { return ((lane & 3) << 3) | (((lane >> 2) & 3) << 6) | (((lane >> 4) & 1) << 5) | (((lane >> 5) & 1) << 8); }
constexpr int v_rd_off(int d0, int ks, int half) { return d0 * 512 + ks * 4096 + half * 2048; }
__device__ __forceinline__ int crow(int r, int hi) { return (r & 3) + 8 * (r >> 2) + 4 * hi; }
__device__ __forceinline__ unsigned cvtpk(float lo, float hi) {
    unsigned r; asm volatile("v_cvt_pk_bf16_f32 %0, %1, %2" : "=v"(r) : "v"(lo), "v"(hi)); return r;
}
__device__ __forceinline__ bf16x8 pack8(f32x4 a, f32x4 b) {
    u32x4 w = {cvtpk(a[0], a[1]), cvtpk(a[2], a[3]), cvtpk(b[0], b[1]), cvtpk(b[2], b[3])};
    return *reinterpret_cast<bf16x8*>(&w);
}
template <class T> __device__ __forceinline__ bf16x8 load8(const T* p) {
    if constexpr (same_t<T, float>::v) { return pack8(*(const f32x4*)p, *(const f32x4*)(p + 4)); }
    else { return *reinterpret_cast<const bf16x8*>(p); }
}
__device__ __forceinline__ void mask_tile(f32x16& p0, f32x16& p1, int dq, unsigned W) {
    const float NEG = -__builtin_inff();
#pragma unroll
    for (int r = 0; r < 16; ++r) {
        const int c = (r & 3) + 8 * (r >> 2);
        if ((unsigned)(dq - c) >= W) p0[r] = NEG;
        if ((unsigned)(dq - c - 32) >= W) p1[r] = NEG;
    }
}
__device__ __forceinline__ void partialSM(f32x16& p0, f32x16& p1, float& m_reg, float& mn, float& alpha) {
    float pmax = p0[0]; for (int r = 1; r < 16; ++r) pmax = fmaxf(pmax, p0[r]); for (int r = 0; r < 16; ++r) pmax = fmaxf(pmax, p1[r]);
    { auto rr = __builtin_amdgcn_permlane32_swap(__float_as_uint(pmax), __float_as_uint(pmax), false, false);
      pmax = fmaxf(__uint_as_float(rr[0]), __uint_as_float(rr[1])); }
    constexpr float THR2 = THR * 1.4426950408889634f;
    if (__builtin_expect(__all((pmax - m_reg) <= THR2), 1)) { mn = m_reg; alpha = 1.f; }
    else { mn = fmaxf(m_reg, pmax); alpha = __builtin_amdgcn_exp2f(m_reg - mn); m_reg = mn; }
    for (int r = 0; r < 16; ++r) p0[r] = p0[r] - mn; for (int r = 0; r < 16; ++r) p1[r] = p1[r] - mn;
    for (int r = 0; r < 16; ++r) p0[r] = __builtin_amdgcn_exp2f(p0[r]);
}
__device__ __forceinline__ void finishSM(f32x16& p0, f32x16& p1, float alpha, float& l_reg, bf16x8& pa0, bf16x8& pa1, bf16x8& pa2, bf16x8& pa3) {
    for (int r = 0; r < 16; ++r) p1[r] = __builtin_amdgcn_exp2f(p1[r]);
    float ps = 0; for (int r = 0; r < 16; ++r) ps += p0[r]; for (int r = 0; r < 16; ++r) ps += p1[r];
    { auto rr = __builtin_amdgcn_permlane32_swap(__float_as_uint(ps), __float_as_uint(ps), false, false);
      ps = __uint_as_float(rr[0]) + __uint_as_float(rr[1]); }
    l_reg = l_reg * alpha + ps;
#define PK4(P, B_, OUT) do { unsigned a0 = cvtpk(P[B_+0], P[B_+1]), a1 = cvtpk(P[B_+2], P[B_+3]);                          \
        unsigned b0 = cvtpk(P[B_+4], P[B_+5]), b1 = cvtpk(P[B_+6], P[B_+7]);                                             \
        auto r0 = __builtin_amdgcn_permlane32_swap(a0, b0, false, false); auto r1 = __builtin_amdgcn_permlane32_swap(a1, b1, false, false); \
        u32x4 w = {r0[0], r1[0], r0[1], r1[1]}; OUT = *reinterpret_cast<bf16x8*>(&w); } while (0)
    PK4(p0, 0, pa0); PK4(p0, 8, pa1); PK4(p1, 0, pa2); PK4(p1, 8, pa3);
#undef PK4
}
template <int KB, bool SK>
__device__ __forceinline__ void qkt(f32x16& p0, f32x16& p1, const char* K_lds, int r32, int hi, const bf16x8* qr, bool act, const char* fb) {
    if (SK && !act) { const float NEG = -__builtin_inff();
#pragma unroll
        for (int r = 0; r < 16; ++r) { p0[r] = NEG; p1[r] = NEG; } return; }
#pragma unroll
    for (int q = 0; q < 4; ++q) { const f32x4 b0 = *reinterpret_cast<const f32x4*>(fb + q * 32), b1 = *reinterpret_cast<const f32x4*>(fb + 128 + q * 32);
#pragma unroll
        for (int i = 0; i < 4; ++i) { p0[4 * q + i] = b0[i]; p1[4 * q + i] = b1[i]; } }
    const char* kb[4];
#pragma unroll
    for (int dd = 0; dd < 4; ++dd) kb[dd] = K_lds + KB * SHM_K + KSWZ(r32, (dd * 16 + hi * 8) * 2);
#pragma unroll
    for (int d0 = 0; d0 < 8; ++d0) { const char* a = kb[d0 & 3] + (d0 >> 2) * 128;
        bf16x8 b0 = *reinterpret_cast<const bf16x8*>(a);
        bf16x8 b1 = *reinterpret_cast<const bf16x8*>(a + 32 * 256);
        p0 = __builtin_amdgcn_mfma_f32_32x32x16_bf16(b0, qr[d0], p0, 0, 0, 0);
        p1 = __builtin_amdgcn_mfma_f32_32x32x16_bf16(b1, qr[d0], p1, 0, 0, 0); }
}
template <int VB, bool SK>
__device__ __forceinline__ void pv_tile(f32x16* o, int vb0, bf16x8 pa0, bf16x8 pa1, bf16x8 pa2, bf16x8 pa3, bool act) {
    if (SK && !act) return;
#define TRRD(dst, off) asm volatile("ds_read_b64_tr_b16 %0, %1 offset:%2" : "=&v"(dst) : "v"(vb0), "i"(off) : "memory")
#define PV_D0(d0) do { s16x4 l0, l1, l2, l3, h0, h1, h2, h3; constexpr int b_ = VB * SHM_V + v_rd_off(d0, 0, 0);     \
        TRRD(l0, b_); TRRD(h0, b_ + 2048); TRRD(l1, b_ + 4096); TRRD(h1, b_ + 6144); TRRD(l2, b_ + 8192); TRRD(h2, b_ + 10240); TRRD(l3, b_ + 12288); TRRD(h3, b_ + 14336); \
        asm volatile("s_waitcnt lgkmcnt(0)" ::: "memory"); SBAR();                 \
        o[d0] = __builtin_amdgcn_mfma_f32_32x32x16_bf16(pa0, (bf16x8){l0[0], l0[1], l0[2], l0[3], h0[0], h0[1], h0[2], h0[3]}, o[d0], 0, 0, 0);   \
        o[d0] = __builtin_amdgcn_mfma_f32_32x32x16_bf16(pa1, (bf16x8){l1[0], l1[1], l1[2], l1[3], h1[0], h1[1], h1[2], h1[3]}, o[d0], 0, 0, 0);   \
        o[d0] = __builtin_amdgcn_mfma_f32_32x32x16_bf16(pa2, (bf16x8){l2[0], l2[1], l2[2], l2[3], h2[0], h2[1], h2[2], h2[3]}, o[d0], 0, 0, 0);   \
        o[d0] = __builtin_amdgcn_mfma_f32_32x32x16_bf16(pa3, (bf16x8){l3[0], l3[1], l3[2], l3[3], h3[0], h3[1], h3[2], h3[3]}, o[d0], 0, 0, 0); } while (0)
    PV_D0(0); PV_D0(1); PV_D0(2); PV_D0(3);
#undef PV_D0
#undef TRRD
}
template <class TIn, class TOut> struct BlockRef { const TIn* Q; const TIn* K; const TIn* V; TOut* O; const float* FB; int P0; };
template <class TIn> struct Seam {
    bf16x8 qr[8];
    bf16x8 st_v0, st_v1, st_k0, st_k1; f32x4 sf0, sf1, sf2, sf3;
    f32x4 tq[16];
};
__device__ __forceinline__ int swa_jlo(int P0, int W) { const int lowk = P0 - W + 1; return lowk > 0 ? lowk / KVBLK : 0; }
#define ROW(p, k0, rr) ((p) + (size_t)((k0) + (rr)) * D + sc)
#define VMW() asm volatile("s_waitcnt vmcnt(0)" ::: "memory")
#define VMWN(n) asm volatile("s_waitcnt vmcnt(%0)" :: "i"(n) : "memory")
#define SLOAD_H(Kp, Vp, k0) do { S.st_v0 = load8<TIn>(ROW(Vp, k0, sr)); S.st_v1 = load8<TIn>(ROW(Vp, k0, 32 + sr));              \
                         S.st_k0 = load8<TIn>(ROW(Kp, k0, sr)); S.st_k1 = load8<TIn>(ROW(Kp, k0, 32 + sr)); } while (0)
#define SWRITE_HK(bf) do { *(bf16x8*)(K_lds + (bf) * SHM_K + kws) = S.st_k0; *(bf16x8*)(K_lds + (bf) * SHM_K + kws + 32 * 256) = S.st_k1; } while (0)
#define SWRITE_HV(bf) do { *(bf16x8*)(V_lds + (bf) * SHM_V + vst0) = S.st_v0; *(bf16x8*)(V_lds + (bf) * SHM_V + vst1) = S.st_v1; } while (0)
#define SWRITE_H(bf) do { SWRITE_HV(bf); SWRITE_HK(bf); } while (0)
#define SLOAD_F(p, k0) do { S.sf0 = *(const f32x4*)ROW(p, k0, sr); S.sf1 = *(const f32x4*)(ROW(p, k0, sr) + 4);                \
                            S.sf2 = *(const f32x4*)ROW(p, k0, 32 + sr); S.sf3 = *(const f32x4*)(ROW(p, k0, 32 + sr) + 4); } while (0)
#define SWRITE_KF(bf) do { *(bf16x8*)(K_lds + (bf) * SHM_K + kws) = pack8(S.sf0, S.sf1); *(bf16x8*)(K_lds + (bf) * SHM_K + kws + 32 * 256) = pack8(S.sf2, S.sf3); } while (0)
#define SWRITE_VF(bf) do { *(bf16x8*)(V_lds + (bf) * SHM_V + vst0) = pack8(S.sf0, S.sf1); *(bf16x8*)(V_lds + (bf) * SHM_V + vst1) = pack8(S.sf2, S.sf3); } while (0)
template <class TIn, class TOut>
__device__ __forceinline__ void causal_swa_prime(const BlockRef<TIn, TOut>& cur, int W, char* lds, Seam<TIn>& S) {
    constexpr bool F32 = same_t<TIn, float>::v;
    const int tid = ltid(), wid = __builtin_amdgcn_readfirstlane(tid >> 6), lane = tid & 63, r32 = lane & 31, hi = lane >> 5;
    const int sr = tid >> 4, sc = (tid & 15) * 8, kws = KSWZ(sr, sc * 2); char* K_lds = lds + 2 * SHM_V;
    const int kb0 = swa_jlo(cur.P0, W) * KVBLK;
    for (int d0 = 0; d0 < 8; ++d0) S.qr[d0] = load8<TIn>(cur.Q + (size_t)(wid * QBLK + r32) * D + d0 * 16 + hi * 8);
    if constexpr (F32) { SLOAD_F((const float*)cur.K, kb0); VMW(); SWRITE_KF(0); SBAR(); SLOAD_F((const float*)cur.V, kb0); }
    else { SLOAD_H(cur.K, cur.V, kb0); VMW(); SWRITE_HK(0); }
    __syncthreads();
}
template <class TIn, class TOut>
__device__ __forceinline__ void causal_swa_block(const BlockRef<TIn, TOut>& cur, const BlockRef<TIn, TOut>& nxt, int skv, int W, char* lds, Seam<TIn>& S) {
    constexpr bool F32 = same_t<TIn, float>::v;
    const int tid = ltid(), wid = __builtin_amdgcn_readfirstlane(tid >> 6), lane = tid & 63, r32 = lane & 31, hi = lane >> 5;
    const int j_lo = swa_jlo(cur.P0, W);
    int j_hi = (cur.P0 + QB - 1) / KVBLK + 1; if (j_hi > skv / KVBLK) j_hi = skv / KVBLK;
    const int NT = j_hi - j_lo;
    const int kbn = swa_jlo(nxt.P0, W) * KVBLK;
    const int qlo = cur.P0 + wid * QBLK, qm = qlo + r32 - 4 * hi;
    char* V_lds = lds; char* K_lds = lds + 2 * SHM_V;
    float* ws = (float*)(lds + 2 * SHM_V + 2 * SHM_K) + wid * 64; float* li_l = ws, * al_l = ws + 32;
    float m_reg = -1e30f, l_reg = 0; f32x16 o[4] = {};
    float* fbuf = (float*)(lds + LDS_FB);
    { const int nk = cur.P0 + QB;
      for (int i4 = tid * 4; i4 < nk; i4 += 64 * NW * 4) *(f32x4*)(fbuf + i4) = *(const f32x4*)(cur.FB + i4);
      __syncthreads(); }
    const char* fbl = (const char*)fbuf + hi * 16;
    const int sr = tid >> 4, sc = (tid & 15) * 8, vst0 = v_st(sr, sc), vst1 = v_st(32 + sr, sc), kws = KSWZ(sr, sc * 2);
    const int vb0 = (int)(uintptr_t)V_lds + v_rd_base(lane);
    const TIn* Kh = cur.K; const TIn* Vh = cur.V;
#define RESC(a) do { if (__any((a) < 1.f)) { if (hi == 0) al_l[r32] = (a); asm volatile("s_waitcnt lgkmcnt(0)" ::: "memory");              \
                     for (int d_ = 0; d_ < 4; ++d_) for (int r = 0; r < 16; ++r) o[d_][r] *= al_l[crow(r, hi)]; } } while (0)
#define KBASE(t) ((j_lo + (t)) * KVBLK)
#define ACT(t) (KBASE(t) <= qlo + QBLK - 1 && KBASE(t) + KVBLK - 1 >= qlo - W + 1)
#define MASKT(P0_, P1_, t) do { const int kb_ = KBASE(t); if ((!SK || ACT(t)) && (kb_ + KVBLK - 1 > qlo || kb_ <= qlo + QBLK - 1 - W)) mask_tile(P0_, P1_, qm - kb_, (unsigned)W); } while (0)
    constexpr int NQL = F32 ? 16 : 8;
    constexpr bool SK = WSKIP && !F32;
#define SEAM_K0() do { VMWN(NQL); if constexpr (F32) { SWRITE_KF(0); SBAR(); SLOAD_F((const float*)nxt.V, kbn); } else { SWRITE_HK(0); } SBAR(); } while (0)
    f32x16 pA0, pA1, pB0, pB1; float mnA, mnB, alA, alB; bf16x8 pa0, pa1, pa2, pa3;
    if constexpr (F32) { VMW(); SWRITE_VF(0); SBAR(); } else { SWRITE_HV(0); SBAR(); }
    if (NT > 1) { if constexpr (F32) SLOAD_F((const float*)Kh, KBASE(1)); else SLOAD_H(Kh, Vh, KBASE(1)); }
    SBAR(); qkt<0, SK>(pA0, pA1, K_lds, r32, hi, S.qr, ACT(0), fbl + KBASE(0) * 4);
    if constexpr (F32) { if (NT > 1) { VMW(); SWRITE_KF(1); SBAR(); SLOAD_F((const float*)Vh, KBASE(1)); } }
    MASKT(pA0, pA1, 0); partialSM(pA0, pA1, m_reg, mnA, alA);
    if (NT > 1) { VMW(); if constexpr (F32) { SWRITE_VF(1); SBAR(); if (NT > 2) SLOAD_F((const float*)Kh, KBASE(2)); } else SWRITE_H(1); }
    __syncthreads();
#define HALF_STEP(PX0, PX1, mnX, alX, PY0, PY1, alY, t, KB, VB, SB) do {                                                      \
        SBAR(); qkt<KB, SK>(PX0, PX1, K_lds, r32, hi, S.qr, ACT(t), fbl + KBASE(t) * 4);                                             \
        finishSM(PY0, PY1, alY, l_reg, pa0, pa1, pa2, pa3); SBAR();                                                           \
        if ((t) + 1 < NT) { if constexpr (F32) { VMW(); SWRITE_KF(SB); SBAR(); SLOAD_F((const float*)Vh, KBASE((t) + 1)); }  \
                            else { SLOAD_H(Kh, Vh, KBASE((t) + 1)); } SBAR(); }                                               \
        pv_tile<VB, SK>(o, vb0, pa0, pa1, pa2, pa3, ACT((t) - 1)); MASKT(PX0, PX1, (t)); partialSM(PX0, PX1, m_reg, mnX, alX);                                        \
        __syncthreads();                                                                                                      \
        if ((t) + 1 < NT) { VMW(); if constexpr (F32) { SWRITE_VF(SB); SBAR(); if ((t) + 2 < NT) SLOAD_F((const float*)Kh, KBASE((t) + 2)); } \
                            else { SWRITE_H(SB); } }                                                                          \
        RESC(alX); __syncthreads(); } while (0)
    for (int t = 1; t + 1 < NT; t += 2) {
        HALF_STEP(pB0, pB1, mnB, alB, pA0, pA1, alA, t, 1, 0, 0);
        HALF_STEP(pA0, pA1, mnA, alA, pB0, pB1, alB, t + 1, 0, 1, 1);
    }
    const bool even = (NT & 1) == 0;
    if (even) { SBAR(); qkt<1, SK>(pB0, pB1, K_lds, r32, hi, S.qr, ACT(NT - 1), fbl + KBASE(NT - 1) * 4); SBAR(); }
#define QROW(e) (nxt.Q + (size_t)(wid * QBLK + r32) * D + ((e) >> 1) * 16 + hi * 8 + ((e) & 1) * 4)
    if constexpr (F32) { SLOAD_F((const float*)nxt.K, kbn); SBAR();
#pragma unroll
        for (int e = 0; e < 8; ++e) S.tq[e] = *(const f32x4*)QROW(e); }
    else { SLOAD_H(nxt.K, nxt.V, kbn); SBAR();
#pragma unroll
        for (int d0 = 0; d0 < 8; ++d0) S.qr[d0] = load8<TIn>(nxt.Q + (size_t)(wid * QBLK + r32) * D + d0 * 16 + hi * 8); }
    SBAR();
    finishSM(pA0, pA1, alA, l_reg, pa0, pa1, pa2, pa3); SBAR();
    if constexpr (F32) {
#pragma unroll
        for (int e = 8; e < 16; ++e) S.tq[e] = *(const f32x4*)QROW(e); SBAR(); }
#undef QROW
    pv_tile<0, SK>(o, vb0, pa0, pa1, pa2, pa3, ACT(even ? NT - 2 : NT - 1));
    if (even) { MASKT(pB0, pB1, NT - 1); partialSM(pB0, pB1, m_reg, mnB, alB); __syncthreads(); RESC(alB);
        finishSM(pB0, pB1, alB, l_reg, pa0, pa1, pa2, pa3); SBAR(); pv_tile<1, SK>(o, vb0, pa0, pa1, pa2, pa3, ACT(NT - 1)); }
    SBAR(); SEAM_K0();
    if (hi == 0) li_l[r32] = l_reg; asm volatile("s_waitcnt lgkmcnt(0)" ::: "memory");
    float rli[16];
#pragma unroll
    for (int r = 0; r < 16; ++r) rli[r] = __builtin_amdgcn_rcpf(li_l[crow(r, hi)]);
    TOut* Ow = cur.O + (size_t)(wid * QBLK) * OPITCH;
#pragma unroll
    for (int r = 0; r < 16; ++r) { const int orow = crow(r, hi);
#pragma unroll
        for (int d0 = 0; d0 < 4; ++d0) { const float v = o[d0][r] * rli[r];
            if constexpr (same_t<TOut, float>::v) { Ow[(size_t)orow * OPITCH + d0 * 32 + r32] = v; }
            else { const float vn = __shfl_xor(v, 1);
                   if ((r32 & 1) == 0) *(unsigned*)(Ow + (size_t)orow * OPITCH + d0 * 32 + r32) = cvtpk(v, vn); } } }
    if constexpr (F32) {
#pragma unroll
        for (int d0 = 0; d0 < 8; ++d0) S.qr[d0] = pack8(S.tq[2 * d0], S.tq[2 * d0 + 1]); }
    __syncthreads();
#undef RESC
#undef KBASE
#undef ACT
#undef MASKT
#undef SEAM_K0
#undef HALF_STEP
}
#undef ROW
#undef VMW
#undef VMWN
#undef SLOAD_H
#undef SWRITE_HK
#undef SWRITE_HV
#undef SWRITE_H
#undef SLOAD_F
#undef SWRITE_KF
#undef SWRITE_VF
constexpr int NQB = SQ / QB, NXI = NQB / 2, NITEMS = NXI * B * H;
struct SwaItem { int bh, qb0, qb1; };
__device__ __forceinline__ SwaItem swa_decode(int L) { SwaItem it; it.bh = L / NXI; const int x = L - it.bh * NXI; it.qb0 = x; it.qb1 = NQB - 1 - x; return it; }
template <class TIn, class TOut>
__device__ __forceinline__ BlockRef<TIn, TOut> swa_ref(const SwaItem& it, int pass, const TIn* Q, const TIn* K, const TIn* V, TOut* O, const float* FB) {
    const int qb = pass ? it.qb1 : it.qb0;
    BlockRef<TIn, TOut> r;
    r.Q = Q + ((size_t)it.bh * SQ + (size_t)qb * QB) * D;
    r.O = O + ((size_t)(it.bh / H) * SQ + (size_t)qb * QB) * OPITCH + (it.bh % H) * D;
    r.K = K + (size_t)it.bh * SKV * D; r.V = V + (size_t)it.bh * SKV * D; r.FB = FB + (size_t)it.bh * SKV; r.P0 = qb * QB;
    return r;
}
__device__ __forceinline__ void att_phase(char* lds, const bf16* Q, const bf16* K, const bf16* V, bf16* O, const float* FB, int wg, int nwg) {
    int L = wg; if (L >= NITEMS) return;
    SwaItem it = swa_decode(L); int pass = 0;
    BlockRef<bf16, bf16> cur = swa_ref<bf16, bf16>(it, 0, Q, K, V, O, FB);
    Seam<bf16> S;
    causal_swa_prime<bf16, bf16>(cur, WINDOW, lds, S);
    for (;;) {
        const bool more_pass = pass == 0 && it.qb1 != it.qb0, more_item = L + nwg < NITEMS, last = !more_pass && !more_item;
        SwaItem itn = it; int passn = pass + 1, Ln = L;
        if (!more_pass) { passn = 0; Ln = more_item ? L + nwg : L; itn = swa_decode(Ln); }
        const BlockRef<bf16, bf16> nxt = last ? cur : swa_ref<bf16, bf16>(itn, passn, Q, K, V, O, FB);
        causal_swa_block<bf16, bf16>(cur, nxt, SKV, WINDOW, lds, S);
        if (last) break;
        cur = nxt; it = itn; pass = passn; L = Ln;
    }
}
}
constexpr int DM = 2048, NBATCH = 8, SEQ = 4096, DEPTH = 4, NHEAD = 16, HDIM = 128, DFF = 5504, NFF2 = 2 * DFF, MTOK = NBATCH * SEQ;
constexpr int NQKVF = 3 * DM + NHEAD;
constexpr float EPS = 1e-6f;
constexpr int NWAVES = 8;
#ifndef MK_PER_PHASE
#define MK_PER_PHASE 0
#endif
constexpr size_t MiB = 1u << 20;
constexpr size_t WS_CTL = 0, CTL_ZERO_BYTES = 1 * MiB;
constexpr size_t WS_MOD = 1 * MiB;
constexpr size_t WS_LOGF = 3 * MiB;
constexpr size_t WS_FB = 5 * MiB;
constexpr size_t WS_VRSTD = 7 * MiB;
constexpr size_t WS_WF = 7 * MiB + 512 * 1024;
constexpr size_t WS_WQKV = 8 * MiB;
constexpr size_t WS_WO = 56 * MiB;
constexpr size_t WS_WGI = 72 * MiB;
constexpr size_t WS_WGO = 104 * MiB;
constexpr size_t WS_WF1 = 120 * MiB;
constexpr size_t WS_WF2 = 292 * MiB;
constexpr size_t WS_H = 378 * MiB;
constexpr size_t WS_R = 506 * MiB;
constexpr size_t WS_END = WS_R + 384 * MiB;
constexpr int CW_TMO = 0, CW_BAR = 4096;

constexpr int RING_OFF = 0, RING_BYTES = 131072, XCH_OFF = 131072;
constexpr int LDSCTL_OFF = 143360, MISC_OFF = LDSCTL_OFF + 320;
constexpr int LDS_BYTES = 147456;

#define GAS __attribute__((address_space(1)))
#define LAS __attribute__((address_space(3)))
typedef unsigned short bf16;
typedef unsigned v4u __attribute__((ext_vector_type(4)));
typedef unsigned v2u __attribute__((ext_vector_type(2)));
typedef float f32x4 __attribute__((ext_vector_type(4)));
typedef short bf16x8 __attribute__((ext_vector_type(8)));
typedef GAS unsigned gu32;
#define RLX_AGENT __ATOMIC_RELAXED, __HIP_MEMORY_SCOPE_AGENT
#define LDS_WAIT() asm volatile("s_waitcnt lgkmcnt(0)" ::: "memory")
#define VM_WAIT() asm volatile("s_waitcnt vmcnt(0)" ::: "memory")
__device__ __forceinline__ unsigned f2bf(float f) { unsigned u = __builtin_bit_cast(unsigned, f); return (u + 0x7fffu + ((u >> 16) & 1u)) >> 16; }
__device__ __forceinline__ unsigned pk2(float lo, float hi) { return f2bf(lo) | (f2bf(hi) << 16); }
__device__ __forceinline__ float bf2f(unsigned short b) { return __builtin_bit_cast(float, (unsigned)b << 16); }
__device__ __forceinline__ float bflo(unsigned w) { return __builtin_bit_cast(float, w << 16); }
__device__ __forceinline__ float bfhi(unsigned w) { return __builtin_bit_cast(float, w & 0xffff0000u); }
#define XB_TMO      128
#define XB_XCNT(j)  (256  + 64 * (j))
#define XB_XSUB(j)  (1280 + 64 * (j))
#define XB_XGEN(j)  (2304 + 64 * (j))
#define XB_TOP      3328
#define XB_TOPGEN   3392
#define XCD_BAR_WORDS 3456
#define XB_SPIN_CAP (1u << 18)

__device__ __forceinline__ unsigned xb_ld(unsigned* p)              { return __hip_atomic_load((GAS unsigned*)p, __ATOMIC_RELAXED, __HIP_MEMORY_SCOPE_AGENT); }
__device__ __forceinline__ unsigned xb_add(unsigned* p, unsigned v) { return __hip_atomic_fetch_add((GAS unsigned*)p, v, __ATOMIC_RELAXED, __HIP_MEMORY_SCOPE_AGENT); }
__device__ __forceinline__ unsigned xb_xcc_id() { return (unsigned)__builtin_amdgcn_s_getreg((3 << 11) | 20) & 0xFu; }
#define XB_SPIN(cond, bar) do { unsigned _sp = 0; while (cond) { __builtin_amdgcn_s_sleep(1); \
    if ((++_sp & 255u) == 0u) { if (xb_ld(&(bar)[XB_TMO])) break; if (_sp > XB_SPIN_CAP) { xb_add(&(bar)[XB_TMO], 1u); break; } } } } while (0)

struct XcdBarrier {
    unsigned* bar; unsigned x;
    volatile LAS unsigned* st;
};

__device__ __forceinline__ XcdBarrier xcd_barrier_post(unsigned* bar, volatile LAS unsigned* st) {
    XcdBarrier b; b.bar = bar; b.x = xb_xcc_id(); b.st = st;
    if (threadIdx.x == 0) (void)xb_add(&bar[XB_XCNT(b.x)], 1u);
    return b;
}
__device__ __forceinline__ void xcd_barrier_complete(unsigned* bar, unsigned x, unsigned& nloc, unsigned& nx) {
    const unsigned G = gridDim.x * gridDim.y * gridDim.z;
    unsigned sum, cnt, mine, sp = 0u;
    for (;;) {
        sum = 0u; cnt = 0u; mine = 0u;
#pragma unroll
        for (unsigned j = 0; j < 16; ++j) { const unsigned c = xb_ld(&bar[XB_XCNT(j)]); sum += c; cnt += (c > 0u) ? 1u : 0u; mine = (j == x) ? c : mine; }
        if (sum == G) break;
        __builtin_amdgcn_s_sleep(1);
        if ((++sp & 255u) == 0u) { if (xb_ld(&bar[XB_TMO])) break; if (sp > XB_SPIN_CAP) { xb_add(&bar[XB_TMO], 1u); break; } }
    }
    nloc = mine > 0u ? mine : 1u; nx = cnt > 0u ? cnt : 1u;
}

__device__ __forceinline__ void xcd_barrier(const XcdBarrier& b) {
    asm volatile("s_waitcnt vmcnt(0)" ::: "memory");
    __syncthreads();
    if (threadIdx.x == 0) {
        unsigned* bar = b.bar;
        __builtin_amdgcn_s_waitcnt(0);
        unsigned nloc = b.st[0], nx = b.st[1];
        if (nloc == 0u) { xcd_barrier_complete(bar, b.x, nloc, nx); b.st[0] = nloc; b.st[1] = nx; }
        const unsigned old = xb_add(&bar[XB_XSUB(b.x)], 1u);
        const unsigned gen = old / nloc;
        if (old + 1u == (gen + 1u) * nloc) {
            __builtin_amdgcn_fence(__ATOMIC_RELEASE, "agent");
            asm volatile("s_waitcnt vmcnt(0)" ::: "memory");
            const unsigned og = xb_add(&bar[XB_TOP], 1u);
            const unsigned tg = og / nx;
            if (og + 1u == (tg + 1u) * nx) xb_add(&bar[XB_TOPGEN], 1u);
            else XB_SPIN(xb_ld(&bar[XB_TOPGEN]) == tg, bar);
            __builtin_amdgcn_fence(__ATOMIC_ACQUIRE, "agent");
            xb_add(&bar[XB_XGEN(b.x)], 1u);
            asm volatile("s_waitcnt vmcnt(0)" ::: "memory");
        } else {
            XB_SPIN(xb_ld(&bar[XB_XGEN(b.x)]) == gen, bar);
            __builtin_amdgcn_fence(__ATOMIC_ACQUIRE, "agent");
            asm volatile("s_waitcnt vmcnt(0)" ::: "memory");
        }
    }
    __syncthreads();
}
struct Frame {
    LAS unsigned char* lds; char* ldsg;
    volatile LAS unsigned* MISC;
    int tid, lane, wave, vcu, G, bid;
    const GAS float* const __attribute__((address_space(4)))* inp;
    GAS float* outg; GAS unsigned char* wsg;
    __device__ __forceinline__ const float* in(int i) const { return (const float*)inp[i]; }
};
enum { IN_X = 0, IN_C, IN_MODW, IN_MODB, IN_MIXG, IN_FFNG, IN_AWIN, IN_ABF, IN_AWO, IN_GWIN, IN_GVG, IN_GWS, IN_GBS, IN_GWO, IN_FWIN, IN_FCW, IN_FCB, IN_FWOUT, IN_FING };
enum { MW_BID = 16, MW_G, MW_VCU, MW_INP, MW_INP_HI, MW_WS, MW_WS_HI, MW_OUT, MW_OUT_HI };
__device__ __forceinline__ unsigned misc_rd(const Frame& F, int k) { return (unsigned)__builtin_amdgcn_readfirstlane((int)F.MISC[k]); }
__device__ __forceinline__ bool relaunder(Frame& F) {
    int t = (int)threadIdx.x; asm volatile("" : "+v"(t)); F.tid = t; F.lane = t & 63; F.wave = __builtin_amdgcn_readfirstlane(t >> 6);
    F.bid = (int)misc_rd(F, MW_BID); F.G = (int)misc_rd(F, MW_G); F.vcu = (int)misc_rd(F, MW_VCU);
    F.inp = (const GAS float* const __attribute__((address_space(4)))*)(((unsigned long long)misc_rd(F, MW_INP_HI) << 32) | misc_rd(F, MW_INP));
    F.wsg = (GAS unsigned char*)(((unsigned long long)misc_rd(F, MW_WS_HI) << 32) | misc_rd(F, MW_WS));
    F.outg = (GAS float*)(((unsigned long long)misc_rd(F, MW_OUT_HI) << 32) | misc_rd(F, MW_OUT));
    return true; }
__device__ __forceinline__ float wave_sum(float v) {
#pragma unroll
    for (int o = 1; o < 64; o <<= 1) v += __shfl_xor(v, o);
    return v;
}
__device__ __forceinline__ void transpose_item(const float* W, int ldw, int K, bf16* WT, int k0, int n0, int dst_row0, int ncols, LAS float* scr, int lane) {
    const int nl = lane & 31;
#pragma unroll 8
    for (int i = 0; i < 32; ++i) { const int kk = 2 * i + (lane >> 5); if (nl < ncols) scr[kk * 33 + nl] = W[(size_t)(k0 + kk) * ldw + n0 + nl]; }
    LDS_WAIT(); asm volatile("" ::: "memory");
    const int c = lane & 7;
#pragma unroll
    for (int j = 0; j < 4; ++j) { const int n = (lane >> 3) + 8 * j; const LAS float* s = scr + (8 * c) * 33 + n;
        if (n < ncols) { v4u o; o.x = pk2(s[0 * 33], s[1 * 33]); o.y = pk2(s[2 * 33], s[3 * 33]); o.z = pk2(s[4 * 33], s[5 * 33]); o.w = pk2(s[6 * 33], s[7 * 33]);
            *(GAS v4u*)(WT + (size_t)(dst_row0 + n) * K + k0 + 8 * c) = o; } }
    LDS_WAIT(); asm volatile("" ::: "memory");
}
__device__ __forceinline__ void pro_phase(Frame& F) {
    __syncthreads();
    {
        LAS float* cact = (LAS float*)(F.lds + RING_OFF);
        LAS float* red = (LAS float*)(F.lds + RING_OFF + 65536);
        float* mod = (float*)((unsigned char*)F.wsg + WS_MOD);
        for (int item = F.bid; item < 192; item += F.G) {
            for (int idx = F.tid; idx < NBATCH * DM; idx += NWAVES * 64) { const int b = idx >> 11, k = idx & 2047; const float v = F.in(IN_C)[idx]; cact[k * 8 + b] = v / (1.0f + __expf(-v)); }
            __syncthreads();
            const int i = item / 48, nbase = (item % 48) * 256;
            const float* wp = F.in(IN_MODW) + ((size_t)i * DM + F.wave * 256) * 12288 + nbase + F.lane * 4;
            f32x4 acc[8];
#pragma unroll
            for (int b = 0; b < 8; ++b) acc[b] = (f32x4){0.f, 0.f, 0.f, 0.f};
#pragma unroll 8
            for (int kk = 0; kk < 256; ++kk) {
                const f32x4 w = *(const GAS f32x4*)(wp + (size_t)kk * 12288);
                const LAS f32x4* cp = (const LAS f32x4*)(cact + (F.wave * 256 + kk) * 8);
                const f32x4 c0 = cp[0], c1 = cp[1];
                acc[0] += w * c0.x; acc[1] += w * c0.y; acc[2] += w * c0.z; acc[3] += w * c0.w;
                acc[4] += w * c1.x; acc[5] += w * c1.y; acc[6] += w * c1.z; acc[7] += w * c1.w;
            }
#pragma unroll
            for (int b = 0; b < 8; ++b) *(LAS f32x4*)(red + (F.wave * 8 + b) * 256 + F.lane * 4) = acc[b];
            __syncthreads();
            for (int o = F.tid; o < 2048; o += NWAVES * 64) { const int b = o >> 8, col = o & 255; float s = 0.f;
#pragma unroll
                for (int w = 0; w < 8; ++w) s += red[(w * 8 + b) * 256 + col];
                mod[((size_t)i * 8 + b) * 12288 + nbase + col] = s + F.in(IN_MODB)[i * 12288 + nbase + col]; }
            __syncthreads();
        }
    }
    LAS float* scr = (LAS float*)(F.lds + RING_OFF + F.wave * 16384);
    const int gw = F.vcu * NWAVES + F.wave, NGW = F.G * NWAVES;
    constexpr int I_QKV = 32 * 192, I_F = 32, I_O = 32 * 64, I_GI = 32 * 128, I_GO = 32 * 64, I_F1 = 32 * 344, I_F2 = 86 * 64;
    constexpr int NITEMS = 2 * (I_QKV + I_F + I_O + I_GI + I_GO) + 4 * (I_F1 + I_F2);
    bf16* Wqkv = (bf16*)((unsigned char*)F.wsg + WS_WQKV); bf16* Wf = (bf16*)((unsigned char*)F.wsg + WS_WF); bf16* Wo = (bf16*)((unsigned char*)F.wsg + WS_WO); bf16* Wgi = (bf16*)((unsigned char*)F.wsg + WS_WGI);
    bf16* Wgo = (bf16*)((unsigned char*)F.wsg + WS_WGO); bf16* Wf1 = (bf16*)((unsigned char*)F.wsg + WS_WF1); bf16* Wf2 = (bf16*)((unsigned char*)F.wsg + WS_WF2);
    for (int it = gw; it < NITEMS; it += NGW) {
        int r = it;
        if (r < 2 * I_QKV) { const int j = r / I_QKV, q = r % I_QKV, kb = q / 192, nb = q % 192;
            transpose_item(F.in(IN_AWIN) + (size_t)j * DM * NQKVF, NQKVF, DM, Wqkv + (size_t)j * 6144 * DM, 64 * kb, 32 * nb, 32 * nb, 32, scr, F.lane); continue; } r -= 2 * I_QKV;
        if (r < 2 * I_F) { const int j = r / I_F, kb = r % I_F;
            transpose_item(F.in(IN_AWIN) + (size_t)j * DM * NQKVF, NQKVF, DM, Wf + (size_t)j * 16 * DM, 64 * kb, 6144, 0, 16, scr, F.lane); continue; } r -= 2 * I_F;
        if (r < 2 * I_O) { const int j = r / I_O, q = r % I_O, kb = q / 64, nb = q % 64;
            transpose_item(F.in(IN_AWO) + (size_t)j * DM * DM, DM, DM, Wo + (size_t)j * DM * DM, 64 * kb, 32 * nb, 32 * nb, 32, scr, F.lane); continue; } r -= 2 * I_O;
        if (r < 2 * I_GI) { const int j = r / I_GI, q = r % I_GI, kb = q / 128, nb = q % 128;
            transpose_item(F.in(IN_GWIN) + (size_t)j * DM * 4096, 4096, DM, Wgi + (size_t)j * 4096 * DM, 64 * kb, 32 * nb, 32 * nb, 32, scr, F.lane); continue; } r -= 2 * I_GI;
        if (r < 2 * I_GO) { const int j = r / I_GO, q = r % I_GO, kb = q / 64, nb = q % 64;
            transpose_item(F.in(IN_GWO) + (size_t)j * DM * DM, DM, DM, Wgo + (size_t)j * DM * DM, 64 * kb, 32 * nb, 32 * nb, 32, scr, F.lane); continue; } r -= 2 * I_GO;
        if (r < 4 * I_F1) { const int j = r / I_F1, q = r % I_F1, kb = q / 344, nb = q % 344;
            const int n0 = 32 * nb, isup = n0 >= DFF, cch = n0 - isup * DFF;
            transpose_item(F.in(IN_FWIN) + (size_t)j * DM * NFF2, NFF2, DM, Wf1 + (size_t)j * NFF2 * DM, 64 * kb, n0, 256 * (cch >> 7) + 128 * isup + (cch & 127), 32, scr, F.lane); continue; } r -= 4 * I_F1;
        { const int j = r / I_F2, q = r % I_F2, kb = q / 64, nb = q % 64;
            transpose_item(F.in(IN_FWOUT) + (size_t)j * DFF * DM, DM, DFF, Wf2 + (size_t)j * DM * DFF, 64 * kb, 32 * nb, 32 * nb, 32, scr, F.lane); }
    }
}
__device__ __forceinline__ void norm_phase(Frame& F, const float* xin, const float* g, const float* shift, const float* scale, bf16* H) {
    const int gw = F.vcu * NWAVES + F.wave, NGW = F.G * NWAVES;
    for (int rb = gw; rb < MTOK / 16; rb += NGW) {
        const int b = (rb * 16) >> 12;
        f32x4 gs[8], sh[8];
#pragma unroll
        for (int j = 0; j < 8; ++j) { const int c4 = F.lane + 64 * j;
            gs[j] = ((const GAS f32x4*)g)[c4] * (((const GAS f32x4*)(scale + (size_t)b * 12288))[c4] + 1.0f); sh[j] = ((const GAS f32x4*)(shift + (size_t)b * 12288))[c4]; }
        for (int r = 0; r < 16; ++r) { const size_t row = (size_t)rb * 16 + r;
            const GAS f32x4* xr = (const GAS f32x4*)(xin + row * DM) + F.lane;
            f32x4 v[8]; float ss = 0.f;
#pragma unroll
            for (int j = 0; j < 8; ++j) { v[j] = xr[64 * j]; ss += (v[j].x * v[j].x + v[j].y * v[j].y) + (v[j].z * v[j].z + v[j].w * v[j].w); }
            const float rstd = 1.0f / sqrtf(wave_sum(ss) * (1.0f / DM) + EPS);
            GAS v2u* o8 = (GAS v2u*)(H + row * DM) + F.lane;
#pragma unroll
            for (int j = 0; j < 8; ++j) { const f32x4 o = v[j] * rstd * gs[j] + sh[j]; v2u w; w.x = pk2(o.x, o.y); w.y = pk2(o.z, o.w); o8[64 * j] = w; } }
    }
}
__device__ __forceinline__ void normf_phase(Frame& F, float* x, const float* g) {
    const int gw = F.vcu * NWAVES + F.wave, NGW = F.G * NWAVES;
    for (int rb = gw; rb < MTOK / 16; rb += NGW) {
        f32x4 gs[8];
#pragma unroll
        for (int j = 0; j < 8; ++j) gs[j] = ((const GAS f32x4*)g)[F.lane + 64 * j];
        for (int r = 0; r < 16; ++r) { const size_t row = (size_t)rb * 16 + r;
            GAS f32x4* xr = (GAS f32x4*)(x + row * DM) + F.lane;
            f32x4 v[8]; float ss = 0.f;
#pragma unroll
            for (int j = 0; j < 8; ++j) { v[j] = xr[64 * j]; ss += (v[j].x * v[j].x + v[j].y * v[j].y) + (v[j].z * v[j].z + v[j].w * v[j].w); }
            const float rstd = 1.0f / sqrtf(wave_sum(ss) * (1.0f / DM) + EPS);
#pragma unroll
            for (int j = 0; j < 8; ++j) xr[64 * j] = v[j] * rstd * gs[j]; }
    }
}
__device__ __forceinline__ void fg_phase(Frame& F, const bf16* H, const bf16* Wf, const float* bfv, float* LOGF) {
    const int gw = F.vcu * NWAVES + F.wave, NGW = F.G * NWAVES, fr = F.lane & 15, fq = F.lane >> 4;
    for (int rb = gw; rb < MTOK / 16; rb += NGW) {
        const GAS bf16x8* ap = (const GAS bf16x8*)(H + ((size_t)rb * 16 + fr) * DM + fq * 8);
        const GAS bf16x8* bp = (const GAS bf16x8*)(Wf + (size_t)fr * DM + fq * 8);
        f32x4 acc = (f32x4){0.f, 0.f, 0.f, 0.f};
#pragma unroll 8
        for (int ks = 0; ks < 64; ++ks) acc = __builtin_amdgcn_mfma_f32_16x16x32_bf16(bp[ks * 4], ap[ks * 4], acc, 0, 0, 0);
        const f32x4 bb = *(const GAS f32x4*)(bfv + 4 * fq); f32x4 o;
#pragma unroll
        for (int i = 0; i < 4; ++i) { const float z = acc[i] + bb[i]; o[i] = fminf(z, 0.f) - log1pf(__expf(-fabsf(z))); }
        *(GAS f32x4*)(LOGF + ((size_t)rb * 16 + fr) * 16 + 4 * fq) = o;
    }
}
__device__ __forceinline__ void cum_phase(Frame& F, const float* LOGF, float* FB) {
    const int gw = F.vcu * NWAVES + F.wave, NGW = F.G * NWAVES;
    for (int bh = gw; bh < NBATCH * NHEAD; bh += NGW) { const int b = bh >> 4, h = bh & 15;
        const float* p = LOGF + ((size_t)b * SEQ + F.lane * 64) * 16 + h;
        float v[64]; float s = 0.f;
#pragma unroll
        for (int i = 0; i < 64; ++i) { s += p[i * 16]; v[i] = s; }
        float incl = s;
#pragma unroll
        for (int o = 1; o < 64; o <<= 1) { const float t = __shfl_up(incl, o); if (F.lane >= o) incl += t; }
        const float excl = incl - s;
        GAS f32x4* q = (GAS f32x4*)(FB + (size_t)bh * SEQ + F.lane * 64);
#pragma unroll
        for (int i = 0; i < 16; ++i) q[i] = (f32x4){-(excl + v[4 * i]) * 1.4426950408889634f, -(excl + v[4 * i + 1]) * 1.4426950408889634f, -(excl + v[4 * i + 2]) * 1.4426950408889634f, -(excl + v[4 * i + 3]) * 1.4426950408889634f};
    }
}
__device__ __forceinline__ void vstat_phase(Frame& F, const bf16* Z, float* VRSTD) {
    const int gw = F.vcu * NWAVES + F.wave, NGW = F.G * NWAVES;
    for (int rb = gw; rb < MTOK / 16; rb += NGW)
        for (int r = 0; r < 16; ++r) { const size_t row = (size_t)rb * 16 + r;
            const GAS v4u* vp = (const GAS v4u*)(Z + row * 4096 + 2048) + F.lane; float ss = 0.f;
#pragma unroll
            for (int j = 0; j < 4; ++j) { const v4u w = vp[64 * j];
#pragma unroll
                for (int e = 0; e < 4; ++e) { const float a = bflo(w[e]), c = bfhi(w[e]); ss += a * a + c * c; } }
            const float rstd = 1.0f / sqrtf(wave_sum(ss) * (1.0f / DM) + EPS);
            if (F.lane == 0) VRSTD[row] = rstd; }
}
__device__ __forceinline__ void gate_phase(Frame& F, const bf16* Z, const float* VRSTD, const float* vg, const float* Ws, const float* bs, bf16* GT) {
    using fox::bf16x8; using fox::f32x16;
    const int r32 = F.lane & 31, hi = F.lane >> 5, c = F.wave >> 2, t0 = 32 * (F.wave & 3);
    const int vb0 = (int)(uintptr_t)(F.ldsg + RING_OFF) + c * 32768 + fox::v_rd_base(F.lane);
    bf16x8 aw[8]; int gcur = -1;
    for (int item = F.bid; item < (MTOK / 256) * 16; item += F.G) {
        const int g = item & 15, pnl = item >> 4; const size_t row0 = (size_t)pnl * 256;
        if (g != gcur) { gcur = g;
            const float* wr_ = Ws + ((size_t)g * 128 + t0 + r32) * 128 + 8 * hi;
#pragma unroll
            for (int ks = 0; ks < 8; ++ks) { const f32x4 a = *(const GAS f32x4*)(wr_ + 16 * ks), b = *(const GAS f32x4*)(wr_ + 16 * ks + 4); const int s0 = 16 * ks + 8 * hi; int t = t0 + r32; asm volatile("" : "+v"(t));
                v4u w; w.x = pk2(s0 + 0 <= t ? a.x : 0.f, s0 + 1 <= t ? a.y : 0.f); w.y = pk2(s0 + 2 <= t ? a.z : 0.f, s0 + 3 <= t ? a.w : 0.f);
                       w.z = pk2(s0 + 4 <= t ? b.x : 0.f, s0 + 5 <= t ? b.y : 0.f); w.w = pk2(s0 + 6 <= t ? b.z : 0.f, s0 + 7 <= t ? b.w : 0.f);
                aw[ks] = __builtin_bit_cast(bf16x8, w); } }
#pragma unroll 2
        for (int ps = 0; ps < 8; ++ps) { const int idx = ps * (NWAVES * 64) + F.tid, row = idx >> 4, c8 = (idx & 15) * 8, s = row & 127;
            const v4u w = *(const GAS v4u*)(Z + (row0 + row) * 4096 + 2048 + g * 128 + c8); const float rs = VRSTD[row0 + row];
            const f32x4 g0 = *(const GAS f32x4*)(vg + g * 128 + c8), g1 = *(const GAS f32x4*)(vg + g * 128 + c8 + 4);
            v4u o; o.x = pk2(bflo(w.x) * rs * g0.x, bfhi(w.x) * rs * g0.y); o.y = pk2(bflo(w.y) * rs * g0.z, bfhi(w.y) * rs * g0.w);
                   o.z = pk2(bflo(w.z) * rs * g1.x, bfhi(w.z) * rs * g1.y); o.w = pk2(bflo(w.w) * rs * g1.z, bfhi(w.w) * rs * g1.w);
            *(LAS v4u*)(F.lds + RING_OFF + ((row >> 7) * 2 + (s >> 6)) * 16384 + fox::v_st(s & 63, c8)) = o; }
        __syncthreads();
        f32x16 o[4] = {};
        fox::pv_tile<0, false>(o, vb0, aw[0], aw[1], aw[2], aw[3], true);
        if (t0 >= 64) fox::pv_tile<1, false>(o, vb0, aw[4], aw[5], aw[6], aw[7], true);
        { const size_t lrow = row0 + c * 128 + t0 + 4 * hi;
          const bf16* ub = Z + lrow * 4096 + g * 128 + r32; bf16* ob = GT + lrow * DM + g * 128 + r32; const float* bb = bs + g * 128 + t0 + 4 * hi;
#pragma unroll
          for (int r = 0; r < 16; ++r) { const int ro = (r & 3) + 8 * (r >> 2); const bf16* up = ub + (size_t)ro * 4096; bf16* op = ob + (size_t)ro * DM; asm volatile("" : "+v"(up), "+v"(op));
            const float bias = bb[ro];
#pragma unroll
            for (int d0 = 0; d0 < 4; ++d0) { const float u = bf2f(*(const GAS bf16*)(up + d0 * 32)); const float v = u * (o[d0][r] + bias);
                const float vn = __shfl_xor(v, 1);
                if ((r32 & 1) == 0) *(GAS unsigned*)(op + d0 * 32) = pk2(v, vn); } } }
        __syncthreads();
    }
}
__device__ __forceinline__ float silu1(float v) { return v * __builtin_amdgcn_rcpf(1.0f + __builtin_amdgcn_exp2f(v * -1.4426950408889634f)); }
__device__ __forceinline__ void fix_phase(Frame& F, const float* HALO, const float* cw, const float* cb, bf16* ACT) {
    constexpr int C4 = DFF / 4;
    for (int item = F.bid * (NWAVES * 64) + F.tid; item < (MTOK / 256) * C4; item += F.G * NWAVES * 64) {
        const int pm = item / C4, c4 = (item % C4) * 4; if ((pm & 15) == 0) continue;
        f32x4 r0[2], r1[2];
#pragma unroll
        for (int part = 0; part < 2; ++part) { const int col = part * DFF + c4;
            const f32x4 am2 = *(const GAS f32x4*)(HALO + ((size_t)(pm - 1) * 4 + 2) * NFF2 + col), am1 = *(const GAS f32x4*)(HALO + ((size_t)(pm - 1) * 4 + 3) * NFF2 + col);
            const f32x4 a0 = *(const GAS f32x4*)(HALO + ((size_t)pm * 4 + 0) * NFF2 + col), a1 = *(const GAS f32x4*)(HALO + ((size_t)pm * 4 + 1) * NFF2 + col);
            const f32x4 w0 = *(const GAS f32x4*)(cw + col), w1 = *(const GAS f32x4*)(cw + NFF2 + col), w2 = *(const GAS f32x4*)(cw + 2 * NFF2 + col), b = *(const GAS f32x4*)(cb + col);
            r0[part] = b + w0 * am2 + w1 * am1 + w2 * a0; r1[part] = b + w0 * am1 + w1 * a0 + w2 * a1; }
        v2u o0, o1;
        o0.x = pk2(silu1(r0[0].x) * r0[1].x, silu1(r0[0].y) * r0[1].y); o0.y = pk2(silu1(r0[0].z) * r0[1].z, silu1(r0[0].w) * r0[1].w);
        o1.x = pk2(silu1(r1[0].x) * r1[1].x, silu1(r1[0].y) * r1[1].y); o1.y = pk2(silu1(r1[0].z) * r1[1].z, silu1(r1[0].w) * r1[1].w);
        *(GAS v2u*)(ACT + ((size_t)pm * 256) * DFF + c4) = o0; *(GAS v2u*)(ACT + ((size_t)pm * 256 + 1) * DFF + c4) = o1;
    }
}
constexpr int NPHASE = 1 + DEPTH * 9 + 1;
struct Args { const float* in[19]; float* out; unsigned char* ws; int ph_lo, ph_hi; };
static_assert(sizeof(Args) == 19 * 8 + 8 + 8 + 8, "Args has no padding bytes");
#ifndef MK_EN
#define MK_EN 0xffffffffu
#endif
#define EN(k) (((MK_EN) >> (k)) & 1u)
#ifndef MK_REP
#define MK_REP 0u
#endif
#define REPN(k) ((((MK_REP) >> (k)) & 1u) ? 2 : 1)
#define W_MOD   ((float*)((unsigned char*)F.wsg + WS_MOD))
#define W_H     ((bf16*)((unsigned char*)F.wsg + WS_H))
#define W_Q     ((bf16*)((unsigned char*)F.wsg + WS_R))
#define W_K     ((bf16*)((unsigned char*)F.wsg + WS_R + 128 * MiB))
#define W_V     ((bf16*)((unsigned char*)F.wsg + WS_R + 256 * MiB))
#define W_Z     ((bf16*)((unsigned char*)F.wsg + WS_R))
#define W_ACT   ((bf16*)((unsigned char*)F.wsg + WS_R))
#define W_HALO  ((float*)((unsigned char*)F.wsg + WS_R + 344 * MiB))
#define W_LOGF  ((float*)((unsigned char*)F.wsg + WS_LOGF))
#define W_FB    ((float*)((unsigned char*)F.wsg + WS_FB))
#define W_VRSTD ((float*)((unsigned char*)F.wsg + WS_VRSTD))
#define W_MODI  (W_MOD + (size_t)i * 8 * 12288)
#define X_IN    ((i == 0) ? F.in(IN_X) : (const float*)(float*)F.outg)
__global__ void __launch_bounds__(NWAVES * 64, 2) mega_fwd(Args args) {
    extern __shared__ __attribute__((aligned(16))) unsigned char lds[];
    Frame F;
    F.lds = (LAS unsigned char*)lds; F.ldsg = (char*)lds;
    F.MISC = (volatile LAS unsigned*)(F.lds + MISC_OFF);
    for (int u = threadIdx.x; u < (LDS_BYTES - LDSCTL_OFF) / 4; u += NWAVES * 64) ((LAS unsigned*)(F.lds + LDSCTL_OFF))[u] = 0u;
    __syncthreads();
    if (threadIdx.x == 0) {
        const int G = gridDim.x, bx = blockIdx.x; const unsigned long long kp = (unsigned long long)__builtin_amdgcn_kernarg_segment_ptr(), wp = (unsigned long long)args.ws, op = (unsigned long long)args.out;
        F.MISC[MW_BID] = (unsigned)bx; F.MISC[MW_G] = (unsigned)G; F.MISC[MW_VCU] = (unsigned)((G % 8 == 0) ? (bx % 8) * (G / 8) + bx / 8 : bx);
        F.MISC[MW_INP] = (unsigned)kp; F.MISC[MW_INP_HI] = (unsigned)(kp >> 32); F.MISC[MW_WS] = (unsigned)wp; F.MISC[MW_WS_HI] = (unsigned)(wp >> 32); F.MISC[MW_OUT] = (unsigned)op; F.MISC[MW_OUT_HI] = (unsigned)(op >> 32);
    }
    __syncthreads();
    XcdBarrier bar; bar.bar = (unsigned*)(args.ws + WS_CTL) + CW_BAR; bar.x = 0; bar.st = nullptr;
    if (!MK_PER_PHASE) bar = xcd_barrier_post((unsigned*)(args.ws + WS_CTL) + CW_BAR, F.MISC + 8);
    const int lo = args.ph_lo, hi = args.ph_hi;
    int ph = 0;
#define RUN() (lo <= ph && ph < hi && relaunder(F))
#define SEAM() do { if (!MK_PER_PHASE) { if (lo <= ph && ph + 1 < hi) { relaunder(F); bar.bar = (unsigned*)((unsigned char*)F.wsg + WS_CTL) + CW_BAR; asm volatile("" : "+s"(bar.x)); xcd_barrier(bar); } } ++ph; } while (0)

    if (EN(0) && RUN()) for (int rep_ = 0; rep_ < REPN(0); ++rep_) pro_phase(F);
    SEAM();
    for (int i = 0; i < DEPTH; ++i) {
        const int j = i >> 1;
        if (EN(1) && RUN()) for (int rep_ = 0; rep_ < REPN(1); ++rep_) norm_phase(F, X_IN, F.in(IN_MIXG) + i * DM, W_MODI, W_MODI + DM, W_H);
        SEAM();
        if ((i & 1) == 0) {
            if (EN(2) && RUN()) for (int rep_ = 0; rep_ < REPN(2); ++rep_) {
                fg_phase(F, W_H, (const bf16*)((unsigned char*)F.wsg + WS_WF) + (size_t)j * 16 * DM, F.in(IN_ABF) + j * 16, W_LOGF);
                pg8::Gemm g{W_H, (const bf16*)((unsigned char*)F.wsg + WS_WQKV) + (size_t)j * 6144 * DM, MTOK, 6144, DM}; pg8::StaticOrder S; S.init(MTOK, 6144, F.G, F.bid);
                pg8::EpiQKV E{W_Q, (size_t)(64 * MiB), fox::QSCALE};
                pg8::gemm_phase<pg8::EpiQKV, pg8::StaticOrder, true, true>(F.lds + RING_OFF, g, S, E);
            }
            SEAM();
            if (EN(3) && RUN()) for (int rep_ = 0; rep_ < REPN(3); ++rep_) cum_phase(F, W_LOGF, W_FB);
            SEAM();
            if (EN(4) && RUN()) for (int rep_ = 0; rep_ < REPN(4); ++rep_) fox::att_phase(F.ldsg + RING_OFF, (const fox::bf16*)W_Q, (const fox::bf16*)W_K, (const fox::bf16*)W_V, (fox::bf16*)W_H, W_FB, F.bid, F.G);
            SEAM();
            if (EN(5) && RUN()) for (int rep_ = 0; rep_ < REPN(5); ++rep_) {
                pg8::Gemm g{W_H, (const bf16*)((unsigned char*)F.wsg + WS_WO) + (size_t)j * DM * DM, MTOK, DM, DM}; pg8::StaticOrder S; S.init(MTOK, DM, F.G, F.bid);
                pg8::EpiRes E{X_IN, (float*)F.outg, W_MODI + 2 * DM, 12288};
                pg8::gemm_phase<pg8::EpiRes, pg8::StaticOrder, true, true>(F.lds + RING_OFF, g, S, E);
            }
            SEAM();
        } else {
            if (EN(6) && RUN()) for (int rep_ = 0; rep_ < REPN(6); ++rep_) {
                pg8::Gemm g{W_H, (const bf16*)((unsigned char*)F.wsg + WS_WGI) + (size_t)j * 4096 * DM, MTOK, 4096, DM}; pg8::StaticOrder S; S.init(MTOK, 4096, F.G, F.bid);
                pg8::EpiStore<1> E{W_Z, 4096};
                pg8::gemm_phase<pg8::EpiStore<1>, pg8::StaticOrder, true, true>(F.lds + RING_OFF, g, S, E);
            }
            SEAM();
            if (EN(7) && RUN()) for (int rep_ = 0; rep_ < REPN(7); ++rep_) vstat_phase(F, W_Z, W_VRSTD);
            SEAM();
            if (EN(8) && RUN()) for (int rep_ = 0; rep_ < REPN(8); ++rep_) gate_phase(F, W_Z, W_VRSTD, F.in(IN_GVG) + j * DM, F.in(IN_GWS) + (size_t)j * 16 * 128 * 128, F.in(IN_GBS) + j * 16 * 128, W_H);
            SEAM();
            if (EN(9) && RUN()) for (int rep_ = 0; rep_ < REPN(9); ++rep_) {
                pg8::Gemm g{W_H, (const bf16*)((unsigned char*)F.wsg + WS_WGO) + (size_t)j * DM * DM, MTOK, DM, DM}; pg8::StaticOrder S; S.init(MTOK, DM, F.G, F.bid);
                pg8::EpiRes E{X_IN, (float*)F.outg, W_MODI + 2 * DM, 12288};
                pg8::gemm_phase<pg8::EpiRes, pg8::StaticOrder, true, true>(F.lds + RING_OFF, g, S, E);
            }
            SEAM();
        }
        if (EN(10) && RUN()) for (int rep_ = 0; rep_ < REPN(10); ++rep_) norm_phase(F, (float*)F.outg, F.in(IN_FFNG) + i * DM, W_MODI + 3 * DM, W_MODI + 4 * DM, W_H);
        SEAM();
        if (EN(11) && RUN()) for (int rep_ = 0; rep_ < REPN(11); ++rep_) {
            pg8::Gemm g{W_H, (const bf16*)((unsigned char*)F.wsg + WS_WF1) + (size_t)i * NFF2 * DM, MTOK, NFF2, DM}; pg8::StaticOrder S; S.init(MTOK, NFF2, F.G, F.bid);
            pg8::EpiConv E{W_ACT, F.in(IN_FCW) + (size_t)i * 3 * NFF2, F.in(IN_FCB) + (size_t)i * NFF2, W_HALO, (LAS float*)(F.lds + XCH_OFF)};
            pg8::gemm_phase<pg8::EpiConv, pg8::StaticOrder, true, true>(F.lds + RING_OFF, g, S, E);
        }
        SEAM();
        if (EN(12) && RUN()) for (int rep_ = 0; rep_ < REPN(12); ++rep_) fix_phase(F, W_HALO, F.in(IN_FCW) + (size_t)i * 3 * NFF2, F.in(IN_FCB) + (size_t)i * NFF2, W_ACT);
        SEAM();
        if (EN(13) && RUN()) for (int rep_ = 0; rep_ < REPN(13); ++rep_) {
            pg8::Gemm g{W_ACT, (const bf16*)((unsigned char*)F.wsg + WS_WF2) + (size_t)i * DM * DFF, MTOK, DM, DFF}; pg8::StaticOrder S; S.init(MTOK, DM, F.G, F.bid);
            pg8::EpiRes E{(float*)F.outg, (float*)F.outg, W_MODI + 5 * DM, 12288};
            pg8::gemm_phase<pg8::EpiRes, pg8::StaticOrder, true, true>(F.lds + RING_OFF, g, S, E);
        }
        SEAM();
    }
    if (EN(14) && RUN()) for (int rep_ = 0; rep_ < REPN(14); ++rep_) normf_phase(F, (float*)F.outg, F.in(IN_FING));
#undef RUN
#undef SEAM
}

extern "C" void kernel_launch(void* const* d_in, const int* in_sizes, int n_in, void* d_out, int out_size, void* d_ws, size_t ws_size, hipStream_t stream) {
    static int grid = 0;
    if (grid == 0) {
        if (n_in != 19 || out_size != MTOK * DM || ws_size < WS_END) { fprintf(stderr, "kernel_launch: unexpected shapes (n_in %d, out %d, ws %zu < %zu)\n", n_in, out_size, ws_size, (size_t)WS_END); grid = -1; return; }
        int dev = 0, cus = 0, per_cu = 0;
        if (hipGetDevice(&dev) != hipSuccess || hipDeviceGetAttribute(&cus, hipDeviceAttributeMultiprocessorCount, dev) != hipSuccess) { grid = -1; return; }
        if (hipFuncSetAttribute((const void*)mega_fwd, hipFuncAttributeMaxDynamicSharedMemorySize, LDS_BYTES) != hipSuccess) { fprintf(stderr, "kernel_launch: hipFuncSetAttribute failed\n"); grid = -1; return; }
        if (hipOccupancyMaxActiveBlocksPerMultiprocessor(&per_cu, (const void*)mega_fwd, NWAVES * 64, LDS_BYTES) != hipSuccess || per_cu < 1) { fprintf(stderr, "kernel_launch: occupancy query says %d\n", per_cu); }
        (void)hipGetLastError();
        grid = cus;
    }
    if (grid < 0) return;
    if (hipMemsetAsync((char*)d_ws + WS_CTL, 0, CTL_ZERO_BYTES, stream) != hipSuccess) return;
    Args a{};
    for (int i = 0; i < 19; ++i) a.in[i] = (const float*)d_in[i];
    a.out = (float*)d_out; a.ws = (unsigned char*)d_ws;
#if MK_PER_PHASE
    for (int p = 0; p < NPHASE; ++p) { a.ph_lo = p; a.ph_hi = p + 1; hipLaunchKernelGGL(mega_fwd, dim3(grid), dim3(NWAVES * 64), LDS_BYTES, stream, a); }
#else
    a.ph_lo = 0; a.ph_hi = NPHASE; hipLaunchKernelGGL(mega_fwd, dim3(grid), dim3(NWAVES * 64), LDS_BYTES, stream, a);
#endif
}
```

```cpp
#include <hip/hip_runtime.h>
#include <hip/hip_bf16.h>
#include <cstdio>
#include <cstdint>
__device__ __forceinline__ int ltid() { int t = (int)threadIdx.x; asm volatile("" : "+v"(t)); return t; }
namespace pg8 {
#define PG8_LAS __attribute__((address_space(3)))
typedef unsigned short bf16_t;
typedef short bf16x8 __attribute__((ext_vector_type(8)));
typedef float f32x4 __attribute__((ext_vector_type(4)));
typedef unsigned u32x4 __attribute__((ext_vector_type(4)));
constexpr int BM = 256, BK = 64, HALF = 128, HTB = HALF * BK * 2  , STAGE_BYTES = 8 * HTB, NXCD = 8, WGM = 8;

__host__ __device__ __forceinline__ int lds_byte(int r, int c) { const int st = (r >> 4) * 2 + (c >> 5), rr = r & 15, cc = c & 31, ob = rr * 64 + cc * 2; return st * 1024 + (ob ^ (((ob >> 9) & 1) << 5)); }
__host__ __device__ __forceinline__ void stage_rc(int b, int& R, int& C) { const int st = b / 1024, sb = b % 1024, swz = sb ^ (((sb >> 9) & 1) << 5); R = (st >> 1) * 16 + swz / 64; C = (st & 1) * 32 + (swz % 64) / 2; }
__host__ __device__ __forceinline__ int perm32(int rho) { const int n = rho >> 4, i = rho & 15; return 8 * (i >> 2) + 4 * n + (i & 3); }

struct Unit { int pm, pn; };
struct Gemm { const bf16_t* A; const bf16_t* Bt; int M, N, K; };

struct StaticOrder {
    int nM, nN, nwg, G, c;
    __host__ __device__ void init(int M, int N, int G_, int c_) { nM = M / BM; nN = N / BM; nwg = nM * nN; G = G_; c = c_; }
    __host__ __device__ bool next(int i, Unit& u) const {
        const long L = (long)i * G + c; if (L >= nwg) return false;
        int wgid = (int)L; { const int q = nwg / NXCD, r = nwg % NXCD, xcd = wgid % NXCD, off = wgid / NXCD; wgid = (xcd < r ? xcd * (q + 1) : r * (q + 1) + (xcd - r) * q) + off; }
        const int nig = WGM * nN, gid = wgid / nig, fm = gid * WGM, gsz = (nM - fm) < WGM ? (nM - fm) : WGM;
        u.pm = fm + ((wgid % nig) % gsz); u.pn = (wgid % nig) / gsz; return true;
    }
    __device__ __forceinline__ void a_ready(const Unit&) const {}
    __device__ __forceinline__ void done(const Unit&) const {}
};
__device__ __forceinline__ unsigned cvt_pk_bf16(float lo, float hi) { unsigned r; asm volatile("v_cvt_pk_bf16_f32 %0, %1, %2" : "=v"(r) : "v"(lo), "v"(hi)); return r; }
typedef float f32x2 __attribute__((ext_vector_type(2)));
__device__ __forceinline__ f32x2 gelu_pk(f32x2 v) {
    const f32x2 av = __builtin_elementwise_abs(v), d = av * 0.2316418882f + 1.0f;
    f32x2 t; t.x = __builtin_amdgcn_rcpf(d.x); t.y = __builtin_amdgcn_rcpf(d.y);
    f32x2 q = t * 0.5307027145f + (-0.7265760135f); q = q * t + 0.7107068705f; q = q * t + (-0.142248368f); q = q * t + 0.127414796f; q = q * t;
    const f32x2 s = (v * v) * (-0.72134752044f);
    f32x2 e; e.x = __builtin_amdgcn_exp2f(s.x); e.y = __builtin_amdgcn_exp2f(s.y);
    const f32x2 m = v * (q * e), r = v - m;
    f32x2 o; o.x = v.x < 0.f ? m.x : r.x; o.y = v.y < 0.f ? m.y : r.y; return o;
}

__device__ __forceinline__ float gelu_tanh1(float v) {
    const float u = v * (0.7978845608f + 0.0356774081f * v * v);
    const float e = __builtin_amdgcn_exp2f(u * -2.8853900818f);
    return v * __builtin_amdgcn_rcpf(1.0f + e);
}
template <int ACT  > struct EpiStore {
    static constexpr bool PERM = true, AFTER_DRAIN = false;
    bf16_t* O; int ldc;
    __device__ __forceinline__ void operator()(const f32x4 (&acc)[2][2][4][2], const Unit& u, int wr, int wc, int fr, int fq) const {
        const int row0 = u.pm * BM + wr * 64 + fr, col0 = u.pn * BM + wc * 32 + 8 * fq;
#pragma unroll
        for (int ai = 0; ai < 2; ++ai)
#pragma unroll
            for (int m = 0; m < 4; ++m) { bf16_t* rowp = O + (size_t)(row0 + ai * HALF + m * 16) * ldc + col0;
#pragma unroll
                for (int bj = 0; bj < 2; ++bj) { f32x4 v0 = acc[ai][bj][m][0], v1 = acc[ai][bj][m][1];
                    if (ACT == 1) {
#pragma unroll
                        for (int j = 0; j < 4; ++j) { v0[j] = gelu_tanh1(v0[j]); v1[j] = gelu_tanh1(v1[j]); } }
                    u32x4 w; w.x = cvt_pk_bf16(v0[0], v0[1]); w.y = cvt_pk_bf16(v0[2], v0[3]); w.z = cvt_pk_bf16(v1[0], v1[1]); w.w = cvt_pk_bf16(v1[2], v1[3]);
                    *(u32x4*)(rowp + bj * HALF) = w; } }
    }
};
struct EpiQKV {
    static constexpr bool PERM = true, AFTER_DRAIN = false;
    bf16_t* QKV; size_t tstride; float qscale;
    __device__ __forceinline__ void operator()(const f32x4 (&acc)[2][2][4][2], const Unit& u, int wr, int wc, int fr, int fq) const {
        const int tok0 = u.pm * BM, b = tok0 >> 12, s0 = (tok0 & 4095) + wr * 64 + fr;
        const int colt = u.pn * BM, t = colt >> 11, hd0 = (colt & 2047) >> 7;
        bf16_t* base = QKV + (size_t)t * tstride; const float sc = t == 0 ? qscale : 1.0f;
#pragma unroll
        for (int bj = 0; bj < 2; ++bj) { bf16_t* hb = base + ((size_t)(b * 16 + hd0 + bj) * 4096 + s0) * 128 + wc * 32 + 8 * fq;
#pragma unroll
            for (int ai = 0; ai < 2; ++ai)
#pragma unroll
                for (int m = 0; m < 4; ++m) { const f32x4 v0 = acc[ai][bj][m][0] * sc, v1 = acc[ai][bj][m][1] * sc;
                    u32x4 w; w.x = cvt_pk_bf16(v0[0], v0[1]); w.y = cvt_pk_bf16(v0[2], v0[3]); w.z = cvt_pk_bf16(v1[0], v1[1]); w.w = cvt_pk_bf16(v1[2], v1[3]);
                    *(u32x4*)(hb + (size_t)(ai * HALF + m * 16) * 128) = w; } }
    }
};
struct EpiRes {
    static constexpr bool PERM = false, AFTER_DRAIN = false;
    const float* xin; float* xout; const float* gate; int gpitch;
    __device__ __forceinline__ void operator()(const f32x4 (&acc)[2][2][4][2], const Unit& u, int wr, int wc, int fr, int fq) const {
        const int row0 = u.pm * BM + wr * 64 + fr, col0 = u.pn * BM + wc * 32 + 4 * fq, b = (u.pm * BM) >> 12;
        f32x4 gv[2][2];
#pragma unroll
        for (int bj = 0; bj < 2; ++bj)
#pragma unroll
            for (int n = 0; n < 2; ++n) gv[bj][n] = *(const f32x4*)(gate + (size_t)b * gpitch + col0 + bj * HALF + n * 16);
#pragma unroll
        for (int ai = 0; ai < 2; ++ai)
#pragma unroll
            for (int m = 0; m < 4; ++m) { const size_t off = (size_t)(row0 + ai * HALF + m * 16) * 2048 + col0;
#pragma unroll
                for (int bj = 0; bj < 2; ++bj)
#pragma unroll
                    for (int n = 0; n < 2; ++n) { const f32x4 xo = *(const f32x4*)(xin + off + bj * HALF + n * 16);
                        *(f32x4*)(xout + off + bj * HALF + n * 16) = xo + gv[bj][n] * acc[ai][bj][m][n]; }
                asm volatile("" ::: "memory"); }
    }
};
__device__ __forceinline__ int f2i(float v) { return __builtin_bit_cast(int, v); }
__device__ __forceinline__ float i2f(int v) { return __builtin_bit_cast(float, v); }
template <int SH> __device__ __forceinline__ float dpp_ror(float v) { return i2f(__builtin_amdgcn_update_dpp(0, f2i(v), 0x120 + SH, 0xf, 0xf, true)); }
template <int SH> __device__ __forceinline__ float dpp_shr_fill(float fill, float cur) { return i2f(__builtin_amdgcn_update_dpp(f2i(fill), f2i(cur), 0x110 + SH, 0xf, 0xf, false)); }
struct EpiConv {
    static constexpr bool PERM = true, AFTER_DRAIN = false;
    bf16_t* ACT; const float* cw; const float* cb; float* HALO; PG8_LAS float* X;
    __device__ __forceinline__ void operator()(f32x4 (&acc)[2][2][4][2], const Unit& u, int wr, int wc, int fr, int fq) const {
        const int tcol = wc * 32 + 8 * fq, ch0 = u.pn * 128 + tcol;
#if defined(MK_KREP) && MK_KREP > 1
#pragma unroll
        for (int ai = 0; ai < 2; ++ai)
#pragma unroll
            for (int bj = 0; bj < 2; ++bj)
#pragma unroll
                for (int m = 0; m < 4; ++m)
#pragma unroll
                    for (int n = 0; n < 2; ++n) acc[ai][bj][m][n] *= (1.0f / MK_KREP);
#endif
        if (fr >= 14) {
#pragma unroll
            for (int ai = 0; ai < 2; ++ai)
#pragma unroll
                for (int bj = 0; bj < 2; ++bj)
#pragma unroll
                    for (int n = 0; n < 2; ++n) *(PG8_LAS f32x4*)(X + (((ai * 2 + wr) * 2 + (fr - 14)) * 256) + bj * 128 + tcol + 4 * n) = acc[ai][bj][3][n];
            if (wr == 1) {
#pragma unroll
                for (int bj = 0; bj < 2; ++bj)
#pragma unroll
                    for (int n = 0; n < 2; ++n) *(f32x4*)(HALO + ((size_t)u.pm * 4 + 2 + (fr - 14)) * 11008 + bj * 5504 + ch0 + 4 * n) = acc[1][bj][3][n]; }
        }
        if (fr < 2 && wr == 0) {
#pragma unroll
            for (int bj = 0; bj < 2; ++bj)
#pragma unroll
                for (int n = 0; n < 2; ++n) *(f32x4*)(HALO + ((size_t)u.pm * 4 + fr) * 11008 + bj * 5504 + ch0 + 4 * n) = acc[0][bj][0][n]; }
        asm volatile("s_waitcnt lgkmcnt(0)" ::: "memory"); __builtin_amdgcn_s_barrier(); asm volatile("" ::: "memory");
#pragma unroll
        for (int bj = 0; bj < 2; ++bj) {
            f32x4 w0[2], w1[2], w2[2], bb[2];
#pragma unroll
            for (int n = 0; n < 2; ++n) { const float* p = cw + bj * 5504 + ch0 + 4 * n; w0[n] = *(const f32x4*)p; w1[n] = *(const f32x4*)(p + 11008); w2[n] = *(const f32x4*)(p + 2 * 11008); bb[n] = *(const f32x4*)(cb + bj * 5504 + ch0 + 4 * n); }
            __builtin_amdgcn_sched_barrier(0);
#pragma unroll
            for (int ai = 0; ai < 2; ++ai) { const int g = ai * 2 + wr;
#pragma unroll
                for (int n = 0; n < 2; ++n) {
                    f32x4 h1 = (f32x4){0.f, 0.f, 0.f, 0.f}, h2 = h1;
                    if (g > 0) { h1 = *(const PG8_LAS f32x4*)(X + (((g - 1) * 2 + 1) * 256) + bj * 128 + tcol + 4 * n); h2 = *(const PG8_LAS f32x4*)(X + (((g - 1) * 2 + (fr & 1)) * 256) + bj * 128 + tcol + 4 * n); }
#pragma unroll
                    for (int m = 3; m >= 0; --m) { const f32x4 x = acc[ai][bj][m][n]; f32x4 r;
#pragma unroll
                        for (int e = 0; e < 4; ++e) { float f1, f2;
                            if (m > 0) { const float xp = acc[ai][bj][m - 1][n][e]; f1 = dpp_ror<1>(xp); f2 = dpp_ror<2>(xp); } else { f1 = h1[e]; f2 = h2[e]; }
                            const float p1 = dpp_shr_fill<1>(f1, x[e]), p2 = dpp_shr_fill<2>(f2, x[e]);
                            r[e] = bb[n][e] + w2[n][e] * x[e] + w1[n][e] * p1 + w0[n][e] * p2; }
                        asm volatile("" : "+v"(r));
                        acc[ai][bj][m][n] = r; }
                    __builtin_amdgcn_sched_barrier(0); } }
        }
        const int row0 = u.pm * BM + wr * 64 + fr;
#pragma unroll
        for (int ai = 0; ai < 2; ++ai)
#pragma unroll
            for (int m = 0; m < 4; ++m) { f32x4 o[2];
#pragma unroll
                for (int n = 0; n < 2; ++n)
#pragma unroll
                    for (int e = 0; e < 4; ++e) { const float gt = acc[ai][0][m][n][e]; o[n][e] = gt * __builtin_amdgcn_rcpf(1.0f + __builtin_amdgcn_exp2f(gt * -1.4426950408889634f)) * acc[ai][1][m][n][e]; }
                u32x4 w; w.x = cvt_pk_bf16(o[0][0], o[0][1]); w.y = cvt_pk_bf16(o[0][2], o[0][3]); w.z = cvt_pk_bf16(o[1][0], o[1][1]); w.w = cvt_pk_bf16(o[1][2], o[1][3]);
                *(u32x4*)(ACT + (size_t)(row0 + ai * HALF + m * 16) * 5504 + ch0) = w; }
    }
};
template <class Epi, class Sched, bool ALIGN_EPI = false, bool SP2 = false, int KREP = 1>
__device__ __forceinline__ void gemm_phase(PG8_LAS unsigned char* lds, const Gemm g, const Sched& S, const Epi& E) {
    const int tid = ltid(), wid = __builtin_amdgcn_readfirstlane(tid >> 6), lane = tid & 63, wr = wid >> 2, wc = wid & 3, fr = lane & 15, fq = lane >> 4;
    const int K = g.K, nt = K / BK;
    unsigned voffA[2], voffB[2];
#pragma unroll
    for (int i = 0; i < 2; ++i) { int R, C; stage_rc(tid * 16 + i * 8192, R, C); const int Rb = Epi::PERM ? ((R & ~31) + perm32(R & 31)) : R;
        voffA[i] = (unsigned)(R * K + C) * 2u; voffB[i] = (unsigned)(Rb * K + C) * 2u; }
    const size_t kstep = (size_t)(BK * 2);
    const size_t hstep = (size_t)HALF * K * 2;
    const size_t tstep = 2 * hstep;
    const unsigned ldsw = (unsigned)wid * 1024u;
    const int aoff = lds_byte(wr * 64 + fr, fq * 8), boff = lds_byte(wc * 32 + fr, fq * 8);
#define PG8_SA(b, h) (((b) * 2 + (h)) * HTB)
#define PG8_SB(b, h) ((4 + (b) * 2 + (h)) * HTB)
#define PG8_STAGE(bufoff, gbase, voff) do { _Pragma("unroll") for (int _i = 0; _i < 2; ++_i) \
        __builtin_amdgcn_global_load_lds((const unsigned*)((const char*)(gbase) + (voff)[_i]), (PG8_LAS unsigned*)(lds + (bufoff) + ldsw + _i * 8192), 16, 0, 0); } while (0)
#define PG8_LDA(dst, b, h) do { _Pragma("unroll") for (int m = 0; m < 4; ++m) _Pragma("unroll") for (int k = 0; k < 2; ++k) dst[m][k] = *(const PG8_LAS bf16x8*)(lds + PG8_SA(b, h) + aoff + m * 2048 + k * 1024); } while (0)
#define PG8_LDB(dst, b, h) do { _Pragma("unroll") for (int n = 0; n < 2; ++n) _Pragma("unroll") for (int k = 0; k < 2; ++k) dst[n][k] = *(const PG8_LAS bf16x8*)(lds + PG8_SB(b, h) + boff + n * 2048 + k * 1024); } while (0)
#define PG8_MMA(ai, bj, At, Bt) do { __builtin_amdgcn_s_setprio(1); _Pragma("unroll") for (int m = 0; m < 4; ++m) _Pragma("unroll") for (int n = 0; n < 2; ++n) _Pragma("unroll") for (int k = 0; k < 2; ++k) \
        acc[ai][bj][m][n] = __builtin_amdgcn_mfma_f32_16x16x32_bf16(Bt[n][k], At[m][k], acc[ai][bj][m][n], 0, 0, 0); __builtin_amdgcn_s_setprio(0); } while (0)
#define PG8_WAIT_V(n) asm volatile("s_waitcnt vmcnt(" #n ")" ::: "memory")
#define PG8_WAIT_L(n) asm volatile("s_waitcnt lgkmcnt(" #n ")" ::: "memory")
#define PG8_BAR __builtin_amdgcn_s_barrier()
#define PG8_SCHED __builtin_amdgcn_sched_barrier(0)
    Unit cur, nxt; int ui = 0;
    if (!S.next(0, cur)) return;
    f32x4 acc[2][2][4][2];
#pragma unroll
    for (int a = 0; a < 2; ++a)
#pragma unroll
        for (int b = 0; b < 2; ++b)
#pragma unroll
            for (int m = 0; m < 4; ++m)
#pragma unroll
                for (int n = 0; n < 2; ++n) acc[a][b][m][n] = (f32x4){0.f, 0.f, 0.f, 0.f};
    bf16x8 At[4][2], B0[2][2], B1[2][2];
    const char* cA = (const char*)g.A + (size_t)cur.pm * tstep; const char* cB = (const char*)g.Bt + (size_t)cur.pn * tstep;
    S.a_ready(cur);
    if constexpr (SP2) {
        PG8_STAGE(PG8_SB(0, 0), cB, voffB); PG8_STAGE(PG8_SB(0, 1), cB + hstep, voffB); PG8_STAGE(PG8_SA(0, 0), cA, voffA); PG8_STAGE(PG8_SA(0, 1), cA + hstep, voffA);
        if (wr == 1) PG8_BAR;
        PG8_WAIT_V(2); PG8_BAR;
        PG8_STAGE(PG8_SB(1, 0), cB + kstep, voffB); PG8_STAGE(PG8_SA(1, 0), cA + kstep, voffA); PG8_STAGE(PG8_SB(1, 1), cB + hstep + kstep, voffB);
        PG8_WAIT_V(6); PG8_BAR;
    } else {
        PG8_STAGE(PG8_SB(0, 0), cB, voffB); PG8_STAGE(PG8_SA(0, 0), cA, voffA); PG8_STAGE(PG8_SB(0, 1), cB + hstep, voffB); PG8_STAGE(PG8_SA(0, 1), cA + hstep, voffA);
        if (wr == 1) PG8_BAR;
        PG8_WAIT_V(4); PG8_BAR;
        PG8_STAGE(PG8_SB(1, 0), cB + kstep, voffB); PG8_STAGE(PG8_SA(1, 0), cA + kstep, voffA); PG8_STAGE(PG8_SB(1, 1), cB + hstep + kstep, voffB);
        PG8_WAIT_V(6); PG8_BAR;
    }
    for (;;) {
        const bool has_next = S.next(ui + 1, nxt);
        const char* nA = has_next ? (const char*)g.A + (size_t)nxt.pm * tstep : cA; const char* nB = has_next ? (const char*)g.Bt + (size_t)nxt.pn * tstep : cB;
        for (int t = 0; t < nt * KREP; t += 2) {
            const bool last = (t == nt * KREP - 2);
            const int t1w = KREP > 1 ? ((t + 1) & (nt - 1)) : t + 1, t2w = KREP > 1 ? ((t + 2) & (nt - 1)) : t + 2;
            const char* a1 = cA + (size_t)t1w * kstep;
            const char* a2 = last ? nA : cA + (size_t)t2w * kstep; const char* b2 = last ? nB : cB + (size_t)t2w * kstep;
            const char* a3 = a2 + kstep; const char* b3 = b2 + kstep;
            if (last && has_next) S.a_ready(nxt);
            if constexpr (SP2) {
            PG8_LDB(B0, 0, 0); PG8_LDB(B1, 0, 1); PG8_SCHED; PG8_LDA(At, 0, 0); PG8_STAGE(PG8_SA(1, 1), a1 + hstep, voffA);
            PG8_WAIT_V(8); PG8_WAIT_L(0); PG8_BAR; PG8_MMA(0, 0, At, B0); PG8_MMA(0, 1, At, B1); PG8_BAR; PG8_SCHED;
            PG8_LDA(At, 0, 1); PG8_STAGE(PG8_SB(0, 0), b2, voffB); PG8_STAGE(PG8_SB(0, 1), b2 + hstep, voffB); PG8_STAGE(PG8_SA(0, 0), a2, voffA);
            PG8_WAIT_V(8); PG8_WAIT_L(0); PG8_BAR; PG8_MMA(1, 0, At, B0); PG8_MMA(1, 1, At, B1); PG8_BAR; PG8_SCHED;
            PG8_LDB(B0, 1, 0); PG8_LDB(B1, 1, 1); PG8_SCHED; PG8_LDA(At, 1, 0); PG8_STAGE(PG8_SA(0, 1), a2 + hstep, voffA);
            PG8_WAIT_V(8); PG8_WAIT_L(0); PG8_BAR; PG8_MMA(0, 0, At, B0); PG8_MMA(0, 1, At, B1); PG8_BAR; PG8_SCHED;
            PG8_LDA(At, 1, 1); PG8_STAGE(PG8_SB(1, 0), b3, voffB); PG8_STAGE(PG8_SB(1, 1), b3 + hstep, voffB); PG8_STAGE(PG8_SA(1, 0), a3, voffA);
            PG8_WAIT_V(8); PG8_WAIT_L(0); PG8_BAR; PG8_MMA(1, 0, At, B0); PG8_MMA(1, 1, At, B1); PG8_BAR; PG8_SCHED;
            } else {
            PG8_LDB(B0, 0, 0); PG8_SCHED; PG8_LDA(At, 0, 0); PG8_STAGE(PG8_SA(1, 1), a1 + hstep, voffA);
            PG8_WAIT_L(8); PG8_BAR; PG8_WAIT_L(0); PG8_MMA(0, 0, At, B0); PG8_BAR; PG8_SCHED;
            PG8_LDB(B1, 0, 1); PG8_STAGE(PG8_SB(0, 0), b2, voffB);
            PG8_BAR; PG8_WAIT_L(0); PG8_MMA(0, 1, At, B1); PG8_BAR;
            PG8_LDA(At, 0, 1); PG8_STAGE(PG8_SA(0, 0), a2, voffA);
            PG8_BAR; PG8_WAIT_L(0); PG8_MMA(1, 0, At, B0); PG8_BAR; PG8_SCHED;
            PG8_STAGE(PG8_SB(0, 1), b2 + hstep, voffB);
            PG8_WAIT_V(6); PG8_BAR; PG8_MMA(1, 1, At, B1); PG8_BAR;
            PG8_LDB(B0, 1, 0); PG8_SCHED; PG8_LDA(At, 1, 0); PG8_STAGE(PG8_SA(0, 1), a2 + hstep, voffA);
            PG8_WAIT_L(8); PG8_BAR; PG8_WAIT_L(0); PG8_MMA(0, 0, At, B0); PG8_BAR; PG8_SCHED;
            PG8_LDB(B1, 1, 1); PG8_STAGE(PG8_SB(1, 0), b3, voffB);
            PG8_BAR; PG8_WAIT_L(0); PG8_MMA(0, 1, At, B1); PG8_BAR;
            PG8_LDA(At, 1, 1); PG8_STAGE(PG8_SA(1, 0), a3, voffA);
            PG8_BAR; PG8_WAIT_L(0); PG8_MMA(1, 0, At, B0); PG8_BAR; PG8_SCHED;
            PG8_STAGE(PG8_SB(1, 1), b3 + hstep, voffB);
            PG8_WAIT_V(6); PG8_BAR; PG8_MMA(1, 1, At, B1); PG8_BAR;
            }
        }
        if constexpr (ALIGN_EPI) { if (wr == 0) PG8_BAR; }
        if constexpr (!Epi::AFTER_DRAIN) { E(acc, cur, wr, wc, fr, fq); S.done(cur); }
        if (!has_next) break;
#pragma unroll
        for (int a = 0; a < 2; ++a)
#pragma unroll
            for (int b = 0; b < 2; ++b)
#pragma unroll
                for (int m = 0; m < 4; ++m)
#pragma unroll
                    for (int n = 0; n < 2; ++n) acc[a][b][m][n] = (f32x4){0.f, 0.f, 0.f, 0.f};
        cur = nxt; cA = nA; cB = nB; ++ui;
        if constexpr (ALIGN_EPI) { if (wr == 1) PG8_BAR; }
    }
    PG8_WAIT_V(0);
    if constexpr (!ALIGN_EPI) { if (wr == 0) PG8_BAR; }
    PG8_BAR;
    if constexpr (Epi::AFTER_DRAIN) { E.fused(acc, cur, wr, wc, fr, fq, lds, wid, lane); S.done(cur); }
#undef PG8_SA
#undef PG8_SB
#undef PG8_STAGE
#undef PG8_LDA
#undef PG8_LDB
#undef PG8_MMA
#undef PG8_WAIT_V
#undef PG8_WAIT_L
#undef PG8_BAR
#undef PG8_SCHED
}
}
namespace fox {
enum { ORDER_NATURAL = 0, ORDER_REVERSED = 1, ORDER_PAIRED = 2, ORDER_XCD = 4 };
constexpr int B = 8, H = 16, HKV = 16, SQ = 4096, SKV = 4096, D = 128;
constexpr int QOFF = 0;
constexpr int WINDOW = SKV;
constexpr float THR = 8.f;
constexpr bool WSKIP = false;
constexpr float SCALE = 0.08838834764831845f;
constexpr float QSCALE = SCALE * 1.4426950408889634f;
constexpr int NW = 8, QBLK = 32, KVBLK = 64, QB = NW * QBLK;
constexpr int SHM_V = KVBLK * D * 2, SHM_K = KVBLK * D * 2;
constexpr int LDS_FB = 2 * SHM_V + 2 * SHM_K + NW * 64 * 4;
constexpr int LDS_BYTES = LDS_FB + SKV * 4;
constexpr int OPITCH = H * D;
using bf16 = __hip_bfloat16;
typedef short bf16x8 __attribute__((ext_vector_type(8)));
typedef short s16x4 __attribute__((ext_vector_type(4)));
typedef float f32x16 __attribute__((ext_vector_type(16)));
typedef float f32x4 __attribute__((ext_vector_type(4)));
typedef unsigned u32x4 __attribute__((ext_vector_type(4)));
template <class A, class Bt> struct same_t { static constexpr bool v = false; };
template <class A> struct same_t<A, A> { static constexpr bool v = true; };

#define KSWZ(row, colB) ((row) * 256 + ((colB) ^ (((row) & 7) << 4)))
#define SBAR() __builtin_amdgcn_sched_barrier(0)
__device__ __forceinline__ int v_st(int k, int c) { const int kk = (k & ~0xC) | ((k & 4) << 1) | ((k & 8) >> 1); return ((kk >> 3) * 4 + (c >> 5)) * 512 + ((kk & 7) * 32 + (c & 31)) * 2; }
__device__ __forceinline__ int v_rd_base(int lane) { return ((lane & 3) << 3) | (((lane >> 2) & 3) << 6) | (((lane >> 4) & 1) << 5) | (((lane >> 5) & 1) << 8); }
constexpr int v_rd_off(int d0, int ks, int half) { return d0 * 512 + ks * 4096 + half * 2048; }
__device__ __forceinline__ int crow(int r, int hi) { return (r & 3) + 8 * (r >> 2) + 4 * hi; }
__device__ __forceinline__ unsigned cvtpk(float lo, float hi) {
    unsigned r; asm volatile("v_cvt_pk_bf16_f32 %0, %1, %2" : "=v"(r) : "v"(lo), "v"(hi)); return r;
}
__device__ __forceinline__ bf16x8 pack8(f32x4 a, f32x4 b) {
    u32x4 w = {cvtpk(a[0], a[1]), cvtpk(a[2], a[3]), cvtpk(b[0], b[1]), cvtpk(b[2], b[3])};
    return *reinterpret_cast<bf16x8*>(&w);
}
template <class T> __device__ __forceinline__ bf16x8 load8(const T* p) {
    if constexpr (same_t<T, float>::v) { return pack8(*(const f32x4*)p, *(const f32x4*)(p + 4)); }
    else { return *reinterpret_cast<const bf16x8*>(p); }
}
__device__ __forceinline__ void mask_tile(f32x16& p0, f32x16& p1, int dq, unsigned W) {
    const float NEG = -__builtin_inff();
#pragma unroll
    for (int r = 0; r < 16; ++r) {
        const int c = (r & 3) + 8 * (r >> 2);
        if ((unsigned)(dq - c) >= W) p0[r] = NEG;
        if ((unsigned)(dq - c - 32) >= W) p1[r] = NEG;
    }
}
__device__ __forceinline__ void partialSM(f32x16& p0, f32x16& p1, float& m_reg, float& mn, float& alpha) {
    float pmax = p0[0]; for (int r = 1; r < 16; ++r) pmax = fmaxf(pmax, p0[r]); for (int r = 0; r < 16; ++r) pmax = fmaxf(pmax, p1[r]);
    { auto rr = __builtin_amdgcn_permlane32_swap(__float_as_uint(pmax), __float_as_uint(pmax), false, false);
      pmax = fmaxf(__uint_as_float(rr[0]), __uint_as_float(rr[1])); }
    constexpr float THR2 = THR * 1.4426950408889634f;
    if (__builtin_expect(__all((pmax - m_reg) <= THR2), 1)) { mn = m_reg; alpha = 1.f; }
    else { mn = fmaxf(m_reg, pmax); alpha = __builtin_amdgcn_exp2f(m_reg - mn); m_reg = mn; }
    for (int r = 0; r < 16; ++r) p0[r] = p0[r] - mn; for (int r = 0; r < 16; ++r) p1[r] = p1[r] - mn;
    for (int r = 0; r < 16; ++r) p0[r] = __builtin_amdgcn_exp2f(p0[r]);
}
__device__ __forceinline__ void finishSM(f32x16& p0, f32x16& p1, float alpha, float& l_reg, bf16x8& pa0, bf16x8& pa1, bf16x8& pa2, bf16x8& pa3) {
    for (int r = 0; r < 16; ++r) p1[r] = __builtin_amdgcn_exp2f(p1[r]);
    float ps = 0; for (int r = 0; r < 16; ++r) ps += p0[r]; for (int r = 0; r < 16; ++r) ps += p1[r];
    { auto rr = __builtin_amdgcn_permlane32_swap(__float_as_uint(ps), __float_as_uint(ps), false, false);
      ps = __uint_as_float(rr[0]) + __uint_as_float(rr[1]); }
    l_reg = l_reg * alpha + ps;
#define PK4(P, B_, OUT) do { unsigned a0 = cvtpk(P[B_+0], P[B_+1]), a1 = cvtpk(P[B_+2], P[B_+3]);                          \
        unsigned b0 = cvtpk(P[B_+4], P[B_+5]), b1 = cvtpk(P[B_+6], P[B_+7]);                                             \
        auto r0 = __builtin_amdgcn_permlane32_swap(a0, b0, false, false); auto r1 = __builtin_amdgcn_permlane32_swap(a1, b1, false, false); \
        u32x4 w = {r0[0], r1[0], r0[1], r1[1]}; OUT = *reinterpret_cast<bf16x8*>(&w); } while (0)
    PK4(p0, 0, pa0); PK4(p0, 8, pa1); PK4(p1, 0, pa2); PK4(p1, 8, pa3);
#undef PK4
}
template <int KB, bool SK>
__device__ __forceinline__ void qkt(f32x16& p0, f32x16& p1, const char* K_lds, int r32, int hi, const bf16x8* qr, bool act, const char* fb) {
    if (SK && !act) { const float NEG = -__builtin_inff();
#pragma unroll
        for (int r = 0; r < 16; ++r) { p0[r] = NEG; p1[r] = NEG; } return; }
#pragma unroll
    for (int q = 0; q < 4; ++q) { const f32x4 b0 = *reinterpret_cast<const f32x4*>(fb + q * 32), b1 = *reinterpret_cast<const f32x4*>(fb + 128 + q * 32);
#pragma unroll
        for (int i = 0; i < 4; ++i) { p0[4 * q + i] = b0[i]; p1[4 * q + i] = b1[i]; } }
    const char* kb[4];
#pragma unroll
    for (int dd = 0; dd < 4; ++dd) kb[dd] = K_lds + KB * SHM_K + KSWZ(r32, (dd * 16 + hi * 8) * 2);
#pragma unroll
    for (int d0 = 0; d0 < 8; ++d0) { const char* a = kb[d0 & 3] + (d0 >> 2) * 128;
        bf16x8 b0 = *reinterpret_cast<const bf16x8*>(a);
        bf16x8 b1 = *reinterpret_cast<const bf16x8*>(a + 32 * 256);
        p0 = __builtin_amdgcn_mfma_f32_32x32x16_bf16(b0, qr[d0], p0, 0, 0, 0);
        p1 = __builtin_amdgcn_mfma_f32_32x32x16_bf16(b1, qr[d0], p1, 0, 0, 0); }
}
template <int VB, bool SK>
__device__ __forceinline__ void pv_tile(f32x16* o, int vb0, bf16x8 pa0, bf16x8 pa1, bf16x8 pa2, bf16x8 pa3, bool act) {
    if (SK && !act) return;
#define TRRD(dst, off) asm volatile("ds_read_b64_tr_b16 %0, %1 offset:%2" : "=&v"(dst) : "v"(vb0), "i"(off) : "memory")
#define PV_D0(d0) do { s16x4 l0, l1, l2, l3, h0, h1, h2, h3; constexpr int b_ = VB * SHM_V + v_rd_off(d0, 0, 0);     \
        TRRD(l0, b_); TRRD(h0, b_ + 2048); TRRD(l1, b_ + 4096); TRRD(h1, b_ + 6144); TRRD(l2, b_ + 8192); TRRD(h2, b_ + 10240); TRRD(l3, b_ + 12288); TRRD(h3, b_ + 14336); \
        asm volatile("s_waitcnt lgkmcnt(0)" ::: "memory"); SBAR();                 \
        o[d0] = __builtin_amdgcn_mfma_f32_32x32x16_bf16(pa0, (bf16x8){l0[0], l0[1], l0[2], l0[3], h0[0], h0[1], h0[2], h0[3]}, o[d0], 0, 0, 0);   \
        o[d0] = __builtin_amdgcn_mfma_f32_32x32x16_bf16(pa1, (bf16x8){l1[0], l1[1], l1[2], l1[3], h1[0], h1[1], h1[2], h1[3]}, o[d0], 0, 0, 0);   \
        o[d0] = __builtin_amdgcn_mfma_f32_32x32x16_bf16(pa2, (bf16x8){l2[0], l2[1], l2[2], l2[3], h2[0], h2[1], h2[2], h2[3]}, o[d0], 0, 0, 0);   \
        o[d0] = __builtin_amdgcn_mfma_f32_32x32x16_bf16(pa3, (bf16x8){l3[0], l3[1], l3[2], l3[3], h3[0], h3[1], h3[2], h3[3]}, o[d0], 0, 0, 0); } while (0)
    PV_D0(0); PV_D0(1); PV_D0(2); PV_D0(3);
#undef PV_D0
#undef TRRD
}
template <class TIn, class TOut> struct BlockRef { const TIn* Q; const TIn* K; const TIn* V; TOut* O; const float* FB; int P0; };
template <class TIn> struct Seam {
    bf16x8 qr[8];
    bf16x8 st_v0, st_v1, st_k0, st_k1; f32x4 sf0, sf1, sf2, sf3;
    f32x4 tq[16];
};
__device__ __forceinline__ int swa_jlo(int P0, int W) { const int lowk = P0 - W + 1; return lowk > 0 ? lowk / KVBLK : 0; }
#define ROW(p, k0, rr) ((p) + (size_t)((k0) + (rr)) * D + sc)
#define VMW() asm volatile("s_waitcnt vmcnt(0)" ::: "memory")
#define VMWN(n) asm volatile("s_waitcnt vmcnt(%0)" :: "i"(n) : "memory")
#define SLOAD_H(Kp, Vp, k0) do { S.st_v0 = load8<TIn>(ROW(Vp, k0, sr)); S.st_v1 = load8<TIn>(ROW(Vp, k0, 32 + sr));              \
                         S.st_k0 = load8<TIn>(ROW(Kp, k0, sr)); S.st_k1 = load8<TIn>(ROW(Kp, k0, 32 + sr)); } while (0)
#define SWRITE_HK(bf) do { *(bf16x8*)(K_lds + (bf) * SHM_K + kws) = S.st_k0; *(bf16x8*)(K_lds + (bf) * SHM_K + kws + 32 * 256) = S.st_k1; } while (0)
#define SWRITE_HV(bf) do { *(bf16x8*)(V_lds + (bf) * SHM_V + vst0) = S.st_v0; *(bf16x8*)(V_lds + (bf) * SHM_V + vst1) = S.st_v1; } while (0)
#define SWRITE_H(bf) do { SWRITE_HV(bf); SWRITE_HK(bf); } while (0)
#define SLOAD_F(p, k0) do { S.sf0 = *(const f32x4*)ROW(p, k0, sr); S.sf1 = *(const f32x4*)(ROW(p, k0, sr) + 4);                \
                            S.sf2 = *(const f32x4*)ROW(p, k0, 32 + sr); S.sf3 = *(const f32x4*)(ROW(p, k0, 32 + sr) + 4); } while (0)
#define SWRITE_KF(bf) do { *(bf16x8*)(K_lds + (bf) * SHM_K + kws) = pack8(S.sf0, S.sf1); *(bf16x8*)(K_lds + (bf) * SHM_K + kws + 32 * 256) = pack8(S.sf2, S.sf3); } while (0)
#define SWRITE_VF(bf) do { *(bf16x8*)(V_lds + (bf) * SHM_V + vst0) = pack8(S.sf0, S.sf1); *(bf16x8*)(V_lds + (bf) * SHM_V + vst1) = pack8(S.sf2, S.sf3); } while (0)
template <class TIn, class TOut>
__device__ __forceinline__ void causal_swa_prime(const BlockRef<TIn, TOut>& cur, int W, char* lds, Seam<TIn>& S) {
    constexpr bool F32 = same_t<TIn, float>::v;
    const int tid = ltid(), wid = __builtin_amdgcn_readfirstlane(tid >> 6), lane = tid & 63, r32 = lane & 31, hi = lane >> 5;
    const int sr = tid >> 4, sc = (tid & 15) * 8, kws = KSWZ(sr, sc * 2); char* K_lds = lds + 2 * SHM_V;
    const int kb0 = swa_jlo(cur.P0, W) * KVBLK;
    for (int d0 = 0; d0 < 8; ++d0) S.qr[d0] = load8<TIn>(cur.Q + (size_t)(wid * QBLK + r32) * D + d0 * 16 + hi * 8);
    if constexpr (F32) { SLOAD_F((const float*)cur.K, kb0); VMW(); SWRITE_KF(0); SBAR(); SLOAD_F((const float*)cur.V, kb0); }
    else { SLOAD_H(cur.K, cur.V, kb0); VMW(); SWRITE_HK(0); }
    __syncthreads();
}
template <class TIn, class TOut>
__device__ __forceinline__ void causal_swa_block(const BlockRef<TIn, TOut>& cur, const BlockRef<TIn, TOut>& nxt, int skv, int W, char* lds, Seam<TIn>& S) {
    constexpr bool F32 = same_t<TIn, float>::v;
    const int tid = ltid(), wid = __builtin_amdgcn_readfirstlane(tid >> 6), lane = tid & 63, r32 = lane & 31, hi = lane >> 5;
    const int j_lo = swa_jlo(cur.P0, W);
    int j_hi = (cur.P0 + QB - 1) / KVBLK + 1; if (j_hi > skv / KVBLK) j_hi = skv / KVBLK;
    const int NT = j_hi - j_lo;
    const int kbn = swa_jlo(nxt.P0, W) * KVBLK;
    const int qlo = cur.P0 + wid * QBLK, qm = qlo + r32 - 4 * hi;
    char* V_lds = lds; char* K_lds = lds + 2 * SHM_V;
    float* ws = (float*)(lds + 2 * SHM_V + 2 * SHM_K) + wid * 64; float* li_l = ws, * al_l = ws + 32;
    float m_reg = -1e30f, l_reg = 0; f32x16 o[4] = {};
    float* fbuf = (float*)(lds + LDS_FB);
    { const int nk = cur.P0 + QB;
      for (int i4 = tid * 4; i4 < nk; i4 += 64 * NW * 4) *(f32x4*)(fbuf + i4) = *(const f32x4*)(cur.FB + i4);
      __syncthreads(); }
    const char* fbl = (const char*)fbuf + hi * 16;
    const int sr = tid >> 4, sc = (tid & 15) * 8, vst0 = v_st(sr, sc), vst1 = v_st(32 + sr, sc), kws = KSWZ(sr, sc * 2);
    const int vb0 = (int)(uintptr_t)V_lds + v_rd_base(lane);
    const TIn* Kh = cur.K; const TIn* Vh = cur.V;
#define RESC(a) do { if (__any((a) < 1.f)) { if (hi == 0) al_l[r32] = (a); asm volatile("s_waitcnt lgkmcnt(0)" ::: "memory");              \
                     for (int d_ = 0; d_ < 4; ++d_) for (int r = 0; r < 16; ++r) o[d_][r] *= al_l[crow(r, hi)]; } } while (0)
#define KBASE(t) ((j_lo + (t)) * KVBLK)
#define ACT(t) (KBASE(t) <= qlo + QBLK - 1 && KBASE(t) + KVBLK - 1 >= qlo - W + 1)
#define MASKT(P0_, P1_, t) do { const int kb_ = KBASE(t); if ((!SK || ACT(t)) && (kb_ + KVBLK - 1 > qlo || kb_ <= qlo + QBLK - 1 - W)) mask_tile(P0_, P1_, qm - kb_, (unsigned)W); } while (0)
    constexpr int NQL = F32 ? 16 : 8;
    constexpr bool SK = WSKIP && !F32;
#define SEAM_K0() do { VMWN(NQL); if constexpr (F32) { SWRITE_KF(0); SBAR(); SLOAD_F((const float*)nxt.V, kbn); } else { SWRITE_HK(0); } SBAR(); } while (0)
    f32x16 pA0, pA1, pB0, pB1; float mnA, mnB, alA, alB; bf16x8 pa0, pa1, pa2, pa3;
    if constexpr (F32) { VMW(); SWRITE_VF(0); SBAR(); } else { SWRITE_HV(0); SBAR(); }
    if (NT > 1) { if constexpr (F32) SLOAD_F((const float*)Kh, KBASE(1)); else SLOAD_H(Kh, Vh, KBASE(1)); }
    SBAR(); qkt<0, SK>(pA0, pA1, K_lds, r32, hi, S.qr, ACT(0), fbl + KBASE(0) * 4);
    if constexpr (F32) { if (NT > 1) { VMW(); SWRITE_KF(1); SBAR(); SLOAD_F((const float*)Vh, KBASE(1)); } }
    MASKT(pA0, pA1, 0); partialSM(pA0, pA1, m_reg, mnA, alA);
    if (NT > 1) { VMW(); if constexpr (F32) { SWRITE_VF(1); SBAR(); if (NT > 2) SLOAD_F((const float*)Kh, KBASE(2)); } else SWRITE_H(1); }
    __syncthreads();
#define HALF_STEP(PX0, PX1, mnX, alX, PY0, PY1, alY, t, KB, VB, SB) do {                                                      \
        SBAR(); qkt<KB, SK>(PX0, PX1, K_lds, r32, hi, S.qr, ACT(t), fbl + KBASE(t) * 4);                                             \
        finishSM(PY0, PY1, alY, l_reg, pa0, pa1, pa2, pa3); SBAR();                                                           \
        if ((t) + 1 < NT) { if constexpr (F32) { VMW(); SWRITE_KF(SB); SBAR(); SLOAD_F((const float*)Vh, KBASE((t) + 1)); }  \
                            else { SLOAD_H(Kh, Vh, KBASE((t) + 1)); } SBAR(); }                                               \
        pv_tile<VB, SK>(o, vb0, pa0, pa1, pa2, pa3, ACT((t) - 1)); MASKT(PX0, PX1, (t)); partialSM(PX0, PX1, m_reg, mnX, alX);                                        \
        __syncthreads();                                                                                                      \
        if ((t) + 1 < NT) { VMW(); if constexpr (F32) { SWRITE_VF(SB); SBAR(); if ((t) + 2 < NT) SLOAD_F((const float*)Kh, KBASE((t) + 2)); } \
                            else { SWRITE_H(SB); } }                                                                          \
        RESC(alX); __syncthreads(); } while (0)
    for (int t = 1; t + 1 < NT; t += 2) {
        HALF_STEP(pB0, pB1, mnB, alB, pA0, pA1, alA, t, 1, 0, 0);
        HALF_STEP(pA0, pA1, mnA, alA, pB0, pB1, alB, t + 1, 0, 1, 1);
    }
    const bool even = (NT & 1) == 0;
    if (even) { SBAR(); qkt<1, SK>(pB0, pB1, K_lds, r32, hi, S.qr, ACT(NT - 1), fbl + KBASE(NT - 1) * 4); SBAR(); }
#define QROW(e) (nxt.Q + (size_t)(wid * QBLK + r32) * D + ((e) >> 1) * 16 + hi * 8 + ((e) & 1) * 4)
    if constexpr (F32) { SLOAD_F((const float*)nxt.K, kbn); SBAR();
#pragma unroll
        for (int e = 0; e < 8; ++e) S.tq[e] = *(const f32x4*)QROW(e); }
    else { SLOAD_H(nxt.K, nxt.V, kbn); SBAR();
#pragma unroll
        for (int d0 = 0; d0 < 8; ++d0) S.qr[d0] = load8<TIn>(nxt.Q + (size_t)(wid * QBLK + r32) * D + d0 * 16 + hi * 8); }
    SBAR();
    finishSM(pA0, pA1, alA, l_reg, pa0, pa1, pa2, pa3); SBAR();
    if constexpr (F32) {
#pragma unroll
        for (int e = 8; e < 16; ++e) S.tq[e] = *(const f32x4*)QROW(e); SBAR(); }
#undef QROW
    pv_tile<0, SK>(o, vb0, pa0, pa1, pa2, pa3, ACT(even ? NT - 2 : NT - 1));
    if (even) { MASKT(pB0, pB1, NT - 1); partialSM(pB0, pB1, m_reg, mnB, alB); __syncthreads(); RESC(alB);
        finishSM(pB0, pB1, alB, l_reg, pa0, pa1, pa2, pa3); SBAR(); pv_tile<1, SK>(o, vb0, pa0, pa1, pa2, pa3, ACT(NT - 1)); }
    SBAR(); SEAM_K0();
    if (hi == 0) li_l[r32] = l_reg; asm volatile("s_waitcnt lgkmcnt(0)" ::: "memory");
    float rli[16];
#pragma unroll
    for (int r = 0; r < 16; ++r) rli[r] = __builtin_amdgcn_rcpf(li_l[crow(r, hi)]);
    TOut* Ow = cur.O + (size_t)(wid * QBLK) * OPITCH;
#pragma unroll
    for (int r = 0; r < 16; ++r) { const int orow = crow(r, hi);
#pragma unroll
        for (int d0 = 0; d0 < 4; ++d0) { const float v = o[d0][r] * rli[r];
            if constexpr (same_t<TOut, float>::v) { Ow[(size_t)orow * OPITCH + d0 * 32 + r32] = v; }
            else { const float vn = __shfl_xor(v, 1);
                   if ((r32 & 1) == 0) *(unsigned*)(Ow + (size_t)orow * OPITCH + d0 * 32 + r32) = cvtpk(v, vn); } } }
    if constexpr (F32) {
#pragma unroll
        for (int d0 = 0; d0 < 8; ++d0) S.qr[d0] = pack8(S.tq[2 * d0], S.tq[2 * d0 + 1]); }
    __syncthreads();
#undef RESC
#undef KBASE
#undef ACT
#undef MASKT
#undef SEAM_K0
#undef HALF_STEP
}
#undef ROW
#undef VMW
#undef VMWN
#undef SLOAD_H
#undef SWRITE_HK
#undef SWRITE_HV
#undef SWRITE_H
#undef SLOAD_F
#undef SWRITE_KF
#undef SWRITE_VF
constexpr int NQB = SQ / QB, NXI = NQB / 2, NITEMS = NXI * B * H;
struct SwaItem { int bh, qb0, qb1; };
__device__ __forceinline__ SwaItem swa_decode(int L) { SwaItem it; it.bh = L / NXI; const int x = L - it.bh * NXI; it.qb0 = x; it.qb1 = NQB - 1 - x; return it; }
template <class TIn, class TOut>
__device__ __forceinline__ BlockRef<TIn, TOut> swa_ref(const SwaItem& it, int pass, const TIn* Q, const TIn* K, const TIn* V, TOut* O, const float* FB) {
    const int qb = pass ? it.qb1 : it.qb0;
    BlockRef<TIn, TOut> r;
    r.Q = Q + ((size_t)it.bh * SQ + (size_t)qb * QB) * D;
    r.O = O + ((size_t)(it.bh / H) * SQ + (size_t)qb * QB) * OPITCH + (it.bh % H) * D;
    r.K = K + (size_t)it.bh * SKV * D; r.V = V + (size_t)it.bh * SKV * D; r.FB = FB + (size_t)it.bh * SKV; r.P0 = qb * QB;
    return r;
}
__device__ __forceinline__ void att_phase(char* lds, const bf16* Q, const bf16* K, const bf16* V, bf16* O, const float* FB, int wg, int nwg) {
    int L = wg; if (L >= NITEMS) return;
    SwaItem it = swa_decode(L); int pass = 0;
    BlockRef<bf16, bf16> cur = swa_ref<bf16, bf16>(it, 0, Q, K, V, O, FB);
    Seam<bf16> S;
    causal_swa_prime<bf16, bf16>(cur, WINDOW, lds, S);
    for (;;) {
        const bool more_pass = pass == 0 && it.qb1 != it.qb0, more_item = L + nwg < NITEMS, last = !more_pass && !more_item;
        SwaItem itn = it; int passn = pass + 1, Ln = L;
        if (!more_pass) { passn = 0; Ln = more_item ? L + nwg : L; itn = swa_decode(Ln); }
        const BlockRef<bf16, bf16> nxt = last ? cur : swa_ref<bf16, bf16>(itn, passn, Q, K, V, O, FB);
        causal_swa_block<bf16, bf16>(cur, nxt, SKV, WINDOW, lds, S);
        if (last) break;
        cur = nxt; it = itn; pass = passn; L = Ln;
    }
}
}
constexpr int DM = 2048, NBATCH = 8, SEQ = 4096, DEPTH = 4, NHEAD = 16, HDIM = 128, DFF = 5504, NFF2 = 2 * DFF, MTOK = NBATCH * SEQ;
constexpr int NQKVF = 3 * DM + NHEAD;
constexpr float EPS = 1e-6f;
constexpr int NWAVES = 8;
#ifndef MK_PER_PHASE
#define MK_PER_PHASE 0
#endif
constexpr size_t MiB = 1u << 20;
constexpr size_t WS_CTL = 0, CTL_ZERO_BYTES = 1 * MiB;
constexpr size_t WS_MOD = 1 * MiB;
constexpr size_t WS_LOGF = 3 * MiB;
constexpr size_t WS_FB = 5 * MiB;
constexpr size_t WS_VRSTD = 7 * MiB;
constexpr size_t WS_WF = 7 * MiB + 512 * 1024;
constexpr size_t WS_WQKV = 8 * MiB;
constexpr size_t WS_WO = 56 * MiB;
constexpr size_t WS_WGI = 72 * MiB;
constexpr size_t WS_WGO = 104 * MiB;
constexpr size_t WS_WF1 = 120 * MiB;
constexpr size_t WS_WF2 = 292 * MiB;
constexpr size_t WS_H = 378 * MiB;
constexpr size_t WS_R = 506 * MiB;
constexpr size_t WS_END = WS_R + 384 * MiB;
constexpr int CW_TMO = 0, CW_BAR = 4096;

constexpr int RING_OFF = 0, RING_BYTES = 131072, XCH_OFF = 131072;
constexpr int LDSCTL_OFF = 143360, MISC_OFF = LDSCTL_OFF + 320;
constexpr int LDS_BYTES = 147456;

#define GAS __attribute__((address_space(1)))
#define LAS __attribute__((address_space(3)))
typedef unsigned short bf16;
typedef unsigned v4u __attribute__((ext_vector_type(4)));
typedef unsigned v2u __attribute__((ext_vector_type(2)));
typedef float f32x4 __attribute__((ext_vector_type(4)));
typedef short bf16x8 __attribute__((ext_vector_type(8)));
typedef GAS unsigned gu32;
#define RLX_AGENT __ATOMIC_RELAXED, __HIP_MEMORY_SCOPE_AGENT
#define LDS_WAIT() asm volatile("s_waitcnt lgkmcnt(0)" ::: "memory")
#define VM_WAIT() asm volatile("s_waitcnt vmcnt(0)" ::: "memory")
__device__ __forceinline__ unsigned f2bf(float f) { unsigned u = __builtin_bit_cast(unsigned, f); return (u + 0x7fffu + ((u >> 16) & 1u)) >> 16; }
__device__ __forceinline__ unsigned pk2(float lo, float hi) { return f2bf(lo) | (f2bf(hi) << 16); }
__device__ __forceinline__ float bf2f(unsigned short b) { return __builtin_bit_cast(float, (unsigned)b << 16); }
__device__ __forceinline__ float bflo(unsigned w) { return __builtin_bit_cast(float, w << 16); }
__device__ __forceinline__ float bfhi(unsigned w) { return __builtin_bit_cast(float, w & 0xffff0000u); }
#define XB_TMO      128
#define XB_XCNT(j)  (256  + 64 * (j))
#define XB_XSUB(j)  (1280 + 64 * (j))
#define XB_XGEN(j)  (2304 + 64 * (j))
#define XB_TOP      3328
#define XB_TOPGEN   3392
#define XCD_BAR_WORDS 3456
#define XB_SPIN_CAP (1u << 18)

__device__ __forceinline__ unsigned xb_ld(unsigned* p)              { return __hip_atomic_load((GAS unsigned*)p, __ATOMIC_RELAXED, __HIP_MEMORY_SCOPE_AGENT); }
__device__ __forceinline__ unsigned xb_add(unsigned* p, unsigned v) { return __hip_atomic_fetch_add((GAS unsigned*)p, v, __ATOMIC_RELAXED, __HIP_MEMORY_SCOPE_AGENT); }
__device__ __forceinline__ unsigned xb_xcc_id() { return (unsigned)__builtin_amdgcn_s_getreg((3 << 11) | 20) & 0xFu; }
#define XB_SPIN(cond, bar) do { unsigned _sp = 0; while (cond) { __builtin_amdgcn_s_sleep(1); \
    if ((++_sp & 255u) == 0u) { if (xb_ld(&(bar)[XB_TMO])) break; if (_sp > XB_SPIN_CAP) { xb_add(&(bar)[XB_TMO], 1u); break; } } } } while (0)

struct XcdBarrier {
    unsigned* bar; unsigned x;
    volatile LAS unsigned* st;
};

__device__ __forceinline__ XcdBarrier xcd_barrier_post(unsigned* bar, volatile LAS unsigned* st) {
    XcdBarrier b; b.bar = bar; b.x = xb_xcc_id(); b.st = st;
    if (threadIdx.x == 0) (void)xb_add(&bar[XB_XCNT(b.x)], 1u);
    return b;
}
__device__ __forceinline__ void xcd_barrier_complete(unsigned* bar, unsigned x, unsigned& nloc, unsigned& nx) {
    const unsigned G = gridDim.x * gridDim.y * gridDim.z;
    unsigned sum, cnt, mine, sp = 0u;
    for (;;) {
        sum = 0u; cnt = 0u; mine = 0u;
#pragma unroll
        for (unsigned j = 0; j < 16; ++j) { const unsigned c = xb_ld(&bar[XB_XCNT(j)]); sum += c; cnt += (c > 0u) ? 1u : 0u; mine = (j == x) ? c : mine; }
        if (sum == G) break;
        __builtin_amdgcn_s_sleep(1);
        if ((++sp & 255u) == 0u) { if (xb_ld(&bar[XB_TMO])) break; if (sp > XB_SPIN_CAP) { xb_add(&bar[XB_TMO], 1u); break; } }
    }
    nloc = mine > 0u ? mine : 1u; nx = cnt > 0u ? cnt : 1u;
}

__device__ __forceinline__ void xcd_barrier(const XcdBarrier& b) {
    asm volatile("s_waitcnt vmcnt(0)" ::: "memory");
    __syncthreads();
    if (threadIdx.x == 0) {
        unsigned* bar = b.bar;
        __builtin_amdgcn_s_waitcnt(0);
        unsigned nloc = b.st[0], nx = b.st[1];
        if (nloc == 0u) { xcd_barrier_complete(bar, b.x, nloc, nx); b.st[0] = nloc; b.st[1] = nx; }
        const unsigned old = xb_add(&bar[XB_XSUB(b.x)], 1u);
        const unsigned gen = old / nloc;
        if (old + 1u == (gen + 1u) * nloc) {
            __builtin_amdgcn_fence(__ATOMIC_RELEASE, "agent");
            asm volatile("s_waitcnt vmcnt(0)" ::: "memory");
            const unsigned og = xb_add(&bar[XB_TOP], 1u);
            const unsigned tg = og / nx;
            if (og + 1u == (tg + 1u) * nx) xb_add(&bar[XB_TOPGEN], 1u);
            else XB_SPIN(xb_ld(&bar[XB_TOPGEN]) == tg, bar);
            __builtin_amdgcn_fence(__ATOMIC_ACQUIRE, "agent");
            xb_add(&bar[XB_XGEN(b.x)], 1u);
            asm volatile("s_waitcnt vmcnt(0)" ::: "memory");
        } else {
            XB_SPIN(xb_ld(&bar[XB_XGEN(b.x)]) == gen, bar);
            __builtin_amdgcn_fence(__ATOMIC_ACQUIRE, "agent");
            asm volatile("s_waitcnt vmcnt(0)" ::: "memory");
        }
    }
    __syncthreads();
}
struct Frame {
    LAS unsigned char* lds; char* ldsg;
    volatile LAS unsigned* MISC;
    int tid, lane, wave, vcu, G, bid;
    const GAS float* const __attribute__((address_space(4)))* inp;
    GAS float* outg; GAS unsigned char* wsg;
    __device__ __forceinline__ const float* in(int i) const { return (const float*)inp[i]; }
};
enum { IN_X = 0, IN_C, IN_MODW, IN_MODB, IN_MIXG, IN_FFNG, IN_AWIN, IN_ABF, IN_AWO, IN_GWIN, IN_GVG, IN_GWS, IN_GBS, IN_GWO, IN_FWIN, IN_FCW, IN_FCB, IN_FWOUT, IN_FING };
enum { MW_BID = 16, MW_G, MW_VCU, MW_INP, MW_INP_HI, MW_WS, MW_WS_HI, MW_OUT, MW_OUT_HI };
__device__ __forceinline__ unsigned misc_rd(const Frame& F, int k) { return (unsigned)__builtin_amdgcn_readfirstlane((int)F.MISC[k]); }
__device__ __forceinline__ bool relaunder(Frame& F) {
    int t = (int)threadIdx.x; asm volatile("" : "+v"(t)); F.tid = t; F.lane = t & 63; F.wave = __builtin_amdgcn_readfirstlane(t >> 6);
    F.bid = (int)misc_rd(F, MW_BID); F.G = (int)misc_rd(F, MW_G); F.vcu = (int)misc_rd(F, MW_VCU);
    F.inp = (const GAS float* const __attribute__((address_space(4)))*)(((unsigned long long)misc_rd(F, MW_INP_HI) << 32) | misc_rd(F, MW_INP));
    F.wsg = (GAS unsigned char*)(((unsigned long long)misc_rd(F, MW_WS_HI) << 32) | misc_rd(F, MW_WS));
    F.outg = (GAS float*)(((unsigned long long)misc_rd(F, MW_OUT_HI) << 32) | misc_rd(F, MW_OUT));
    return true; }
__device__ __forceinline__ float wave_sum(float v) {
#pragma unroll
    for (int o = 1; o < 64; o <<= 1) v += __shfl_xor(v, o);
    return v;
}
__device__ __forceinline__ void transpose_item(const float* W, int ldw, int K, bf16* WT, int k0, int n0, int dst_row0, int ncols, LAS float* scr, int lane) {
    const int nl = lane & 31;
#pragma unroll 8
    for (int i = 0; i < 32; ++i) { const int kk = 2 * i + (lane >> 5); if (nl < ncols) scr[kk * 33 + nl] = W[(size_t)(k0 + kk) * ldw + n0 + nl]; }
    LDS_WAIT(); asm volatile("" ::: "memory");
    const int c = lane & 7;
#pragma unroll
    for (int j = 0; j < 4; ++j) { const int n = (lane >> 3) + 8 * j; const LAS float* s = scr + (8 * c) * 33 + n;
        if (n < ncols) { v4u o; o.x = pk2(s[0 * 33], s[1 * 33]); o.y = pk2(s[2 * 33], s[3 * 33]); o.z = pk2(s[4 * 33], s[5 * 33]); o.w = pk2(s[6 * 33], s[7 * 33]);
            *(GAS v4u*)(WT + (size_t)(dst_row0 + n) * K + k0 + 8 * c) = o; } }
    LDS_WAIT(); asm volatile("" ::: "memory");
}
__device__ __forceinline__ void pro_phase(Frame& F) {
    __syncthreads();
    {
        LAS float* cact = (LAS float*)(F.lds + RING_OFF);
        LAS float* red = (LAS float*)(F.lds + RING_OFF + 65536);
        float* mod = (float*)((unsigned char*)F.wsg + WS_MOD);
        for (int item = F.bid; item < 192; item += F.G) {
            for (int idx = F.tid; idx < NBATCH * DM; idx += NWAVES * 64) { const int b = idx >> 11, k = idx & 2047; const float v = F.in(IN_C)[idx]; cact[k * 8 + b] = v / (1.0f + __expf(-v)); }
            __syncthreads();
            const int i = item / 48, nbase = (item % 48) * 256;
            const float* wp = F.in(IN_MODW) + ((size_t)i * DM + F.wave * 256) * 12288 + nbase + F.lane * 4;
            f32x4 acc[8];
#pragma unroll
            for (int b = 0; b < 8; ++b) acc[b] = (f32x4){0.f, 0.f, 0.f, 0.f};
#pragma unroll 8
            for (int kk = 0; kk < 256; ++kk) {
                const f32x4 w = *(const GAS f32x4*)(wp + (size_t)kk * 12288);
                const LAS f32x4* cp = (const LAS f32x4*)(cact + (F.wave * 256 + kk) * 8);
                const f32x4 c0 = cp[0], c1 = cp[1];
                acc[0] += w * c0.x; acc[1] += w * c0.y; acc[2] += w * c0.z; acc[3] += w * c0.w;
                acc[4] += w * c1.x; acc[5] += w * c1.y; acc[6] += w * c1.z; acc[7] += w * c1.w;
            }
#pragma unroll
            for (int b = 0; b < 8; ++b) *(LAS f32x4*)(red + (F.wave * 8 + b) * 256 + F.lane * 4) = acc[b];
            __syncthreads();
            for (int o = F.tid; o < 2048; o += NWAVES * 64) { const int b = o >> 8, col = o & 255; float s = 0.f;
#pragma unroll
                for (int w = 0; w < 8; ++w) s += red[(w * 8 + b) * 256 + col];
                mod[((size_t)i * 8 + b) * 12288 + nbase + col] = s + F.in(IN_MODB)[i * 12288 + nbase + col]; }
            __syncthreads();
        }
    }
    LAS float* scr = (LAS float*)(F.lds + RING_OFF + F.wave * 16384);
    const int gw = F.vcu * NWAVES + F.wave, NGW = F.G * NWAVES;
    constexpr int I_QKV = 32 * 192, I_F = 32, I_O = 32 * 64, I_GI = 32 * 128, I_GO = 32 * 64, I_F1 = 32 * 344, I_F2 = 86 * 64;
    constexpr int NITEMS = 2 * (I_QKV + I_F + I_O + I_GI + I_GO) + 4 * (I_F1 + I_F2);
    bf16* Wqkv = (bf16*)((unsigned char*)F.wsg + WS_WQKV); bf16* Wf = (bf16*)((unsigned char*)F.wsg + WS_WF); bf16* Wo = (bf16*)((unsigned char*)F.wsg + WS_WO); bf16* Wgi = (bf16*)((unsigned char*)F.wsg + WS_WGI);
    bf16* Wgo = (bf16*)((unsigned char*)F.wsg + WS_WGO); bf16* Wf1 = (bf16*)((unsigned char*)F.wsg + WS_WF1); bf16* Wf2 = (bf16*)((unsigned char*)F.wsg + WS_WF2);
    for (int it = gw; it < NITEMS; it += NGW) {
        int r = it;
        if (r < 2 * I_QKV) { const int j = r / I_QKV, q = r % I_QKV, kb = q / 192, nb = q % 192;
            transpose_item(F.in(IN_AWIN) + (size_t)j * DM * NQKVF, NQKVF, DM, Wqkv + (size_t)j * 6144 * DM, 64 * kb, 32 * nb, 32 * nb, 32, scr, F.lane); continue; } r -= 2 * I_QKV;
        if (r < 2 * I_F) { const int j = r / I_F, kb = r % I_F;
            transpose_item(F.in(IN_AWIN) + (size_t)j * DM * NQKVF, NQKVF, DM, Wf + (size_t)j * 16 * DM, 64 * kb, 6144, 0, 16, scr, F.lane); continue; } r -= 2 * I_F;
        if (r < 2 * I_O) { const int j = r / I_O, q = r % I_O, kb = q / 64, nb = q % 64;
            transpose_item(F.in(IN_AWO) + (size_t)j * DM * DM, DM, DM, Wo + (size_t)j * DM * DM, 64 * kb, 32 * nb, 32 * nb, 32, scr, F.lane); continue; } r -= 2 * I_O;
        if (r < 2 * I_GI) { const int j = r / I_GI, q = r % I_GI, kb = q / 128, nb = q % 128;
            transpose_item(F.in(IN_GWIN) + (size_t)j * DM * 4096, 4096, DM, Wgi + (size_t)j * 4096 * DM, 64 * kb, 32 * nb, 32 * nb, 32, scr, F.lane); continue; } r -= 2 * I_GI;
        if (r < 2 * I_GO) { const int j = r / I_GO, q = r % I_GO, kb = q / 64, nb = q % 64;
            transpose_item(F.in(IN_GWO) + (size_t)j * DM * DM, DM, DM, Wgo + (size_t)j * DM * DM, 64 * kb, 32 * nb, 32 * nb, 32, scr, F.lane); continue; } r -= 2 * I_GO;
        if (r < 4 * I_F1) { const int j = r / I_F1, q = r % I_F1, kb = q / 344, nb = q % 344;
            const int n0 = 32 * nb, isup = n0 >= DFF, cch = n0 - isup * DFF;
            transpose_item(F.in(IN_FWIN) + (size_t)j * DM * NFF2, NFF2, DM, Wf1 + (size_t)j * NFF2 * DM, 64 * kb, n0, 256 * (cch >> 7) + 128 * isup + (cch & 127), 32, scr, F.lane); continue; } r -= 4 * I_F1;
        { const int j = r / I_F2, q = r % I_F2, kb = q / 64, nb = q % 64;
            transpose_item(F.in(IN_FWOUT) + (size_t)j * DFF * DM, DM, DFF, Wf2 + (size_t)j * DM * DFF, 64 * kb, 32 * nb, 32 * nb, 32, scr, F.lane); }
    }
}
__device__ __forceinline__ void norm_phase(Frame& F, const float* xin, const float* g, const float* shift, const float* scale, bf16* H) {
    const int gw = F.vcu * NWAVES + F.wave, NGW = F.G * NWAVES;
    for (int rb = gw; rb < MTOK / 16; rb += NGW) {
        const int b = (rb * 16) >> 12;
        f32x4 gs[8], sh[8];
#pragma unroll
        for (int j = 0; j < 8; ++j) { const int c4 = F.lane + 64 * j;
            gs[j] = ((const GAS f32x4*)g)[c4] * (((const GAS f32x4*)(scale + (size_t)b * 12288))[c4] + 1.0f); sh[j] = ((const GAS f32x4*)(shift + (size_t)b * 12288))[c4]; }
        for (int r = 0; r < 16; ++r) { const size_t row = (size_t)rb * 16 + r;
            const GAS f32x4* xr = (const GAS f32x4*)(xin + row * DM) + F.lane;
            f32x4 v[8]; float ss = 0.f;
#pragma unroll
            for (int j = 0; j < 8; ++j) { v[j] = xr[64 * j]; ss += (v[j].x * v[j].x + v[j].y * v[j].y) + (v[j].z * v[j].z + v[j].w * v[j].w); }
            const float rstd = 1.0f / sqrtf(wave_sum(ss) * (1.0f / DM) + EPS);
            GAS v2u* o8 = (GAS v2u*)(H + row * DM) + F.lane;
#pragma unroll
            for (int j = 0; j < 8; ++j) { const f32x4 o = v[j] * rstd * gs[j] + sh[j]; v2u w; w.x = pk2(o.x, o.y); w.y = pk2(o.z, o.w); o8[64 * j] = w; } }
    }
}
__device__ __forceinline__ void normf_phase(Frame& F, float* x, const float* g) {
    const int gw = F.vcu * NWAVES + F.wave, NGW = F.G * NWAVES;
    for (int rb = gw; rb < MTOK / 16; rb += NGW) {
        f32x4 gs[8];
#pragma unroll
        for (int j = 0; j < 8; ++j) gs[j] = ((const GAS f32x4*)g)[F.lane + 64 * j];
        for (int r = 0; r < 16; ++r) { const size_t row = (size_t)rb * 16 + r;
            GAS f32x4* xr = (GAS f32x4*)(x + row * DM) + F.lane;
            f32x4 v[8]; float ss = 0.f;
#pragma unroll
            for (int j = 0; j < 8; ++j) { v[j] = xr[64 * j]; ss += (v[j].x * v[j].x + v[j].y * v[j].y) + (v[j].z * v[j].z + v[j].w * v[j].w); }
            const float rstd = 1.0f / sqrtf(wave_sum(ss) * (1.0f / DM) + EPS);
#pragma unroll
            for (int j = 0; j < 8; ++j) xr[64 * j] = v[j] * rstd * gs[j]; }
    }
}
__device__ __forceinline__ void fg_phase(Frame& F, const bf16* H, const bf16* Wf, const float* bfv, float* LOGF) {
    const int gw = F.vcu * NWAVES + F.wave, NGW = F.G * NWAVES, fr = F.lane & 15, fq = F.lane >> 4;
    for (int rb = gw; rb < MTOK / 16; rb += NGW) {
        const GAS bf16x8* ap = (const GAS bf16x8*)(H + ((size_t)rb * 16 + fr) * DM + fq * 8);
        const GAS bf16x8* bp = (const GAS bf16x8*)(Wf + (size_t)fr * DM + fq * 8);
        f32x4 acc = (f32x4){0.f, 0.f, 0.f, 0.f};
#pragma unroll 8
        for (int ks = 0; ks < 64; ++ks) acc = __builtin_amdgcn_mfma_f32_16x16x32_bf16(bp[ks * 4], ap[ks * 4], acc, 0, 0, 0);
        const f32x4 bb = *(const GAS f32x4*)(bfv + 4 * fq); f32x4 o;
#pragma unroll
        for (int i = 0; i < 4; ++i) { const float z = acc[i] + bb[i]; o[i] = fminf(z, 0.f) - log1pf(__expf(-fabsf(z))); }
        *(GAS f32x4*)(LOGF + ((size_t)rb * 16 + fr) * 16 + 4 * fq) = o;
    }
}
__device__ __forceinline__ void cum_phase(Frame& F, const float* LOGF, float* FB) {
    const int gw = F.vcu * NWAVES + F.wave, NGW = F.G * NWAVES;
    for (int bh = gw; bh < NBATCH * NHEAD; bh += NGW) { const int b = bh >> 4, h = bh & 15;
        const float* p = LOGF + ((size_t)b * SEQ + F.lane * 64) * 16 + h;
        float v[64]; float s = 0.f;
#pragma unroll
        for (int i = 0; i < 64; ++i) { s += p[i * 16]; v[i] = s; }
        float incl = s;
#pragma unroll
        for (int o = 1; o < 64; o <<= 1) { const float t = __shfl_up(incl, o); if (F.lane >= o) incl += t; }
        const float excl = incl - s;
        GAS f32x4* q = (GAS f32x4*)(FB + (size_t)bh * SEQ + F.lane * 64);
#pragma unroll
        for (int i = 0; i < 16; ++i) q[i] = (f32x4){-(excl + v[4 * i]) * 1.4426950408889634f, -(excl + v[4 * i + 1]) * 1.4426950408889634f, -(excl + v[4 * i + 2]) * 1.4426950408889634f, -(excl + v[4 * i + 3]) * 1.4426950408889634f};
    }
}
__device__ __forceinline__ void vstat_phase(Frame& F, const bf16* Z, float* VRSTD) {
    const int gw = F.vcu * NWAVES + F.wave, NGW = F.G * NWAVES;
    for (int rb = gw; rb < MTOK / 16; rb += NGW)
        for (int r = 0; r < 16; ++r) { const size_t row = (size_t)rb * 16 + r;
            const GAS v4u* vp = (const GAS v4u*)(Z + row * 4096 + 2048) + F.lane; float ss = 0.f;
#pragma unroll
            for (int j = 0; j < 4; ++j) { const v4u w = vp[64 * j];
#pragma unroll
                for (int e = 0; e < 4; ++e) { const float a = bflo(w[e]), c = bfhi(w[e]); ss += a * a + c * c; } }
            const float rstd = 1.0f / sqrtf(wave_sum(ss) * (1.0f / DM) + EPS);
            if (F.lane == 0) VRSTD[row] = rstd; }
}
template <int VB>
__device__ __forceinline__ void gate_pv(fox::f32x16* o, int vb0, fox::bf16x8 pa0, fox::bf16x8 pa1, fox::bf16x8 pa2, fox::bf16x8 pa3) {
    using fox::s16x4; using fox::bf16x8;
#define TRRD(dst, off) asm volatile("ds_read_b64_tr_b16 %0, %1 offset:%2" : "=&v"(dst) : "v"(vb0), "i"(off) : "memory")
#define PV_D0(d0) do { s16x4 l0, l1, l2, l3, h0, h1, h2, h3; constexpr int b_ = VB * fox::SHM_V + fox::v_rd_off(d0, 0, 0); \
        TRRD(l0, b_); TRRD(h0, b_ + 2048); TRRD(l1, b_ + 4096); TRRD(h1, b_ + 6144); TRRD(l2, b_ + 8192); TRRD(h2, b_ + 10240); TRRD(l3, b_ + 12288); TRRD(h3, b_ + 14336); \
        asm volatile("s_waitcnt lgkmcnt(0)" ::: "memory"); __builtin_amdgcn_sched_barrier(0); \
        o[d0] = __builtin_amdgcn_mfma_f32_32x32x16_bf16((bf16x8){l0[0], l0[1], l0[2], l0[3], h0[0], h0[1], h0[2], h0[3]}, pa0, o[d0], 0, 0, 0);   \
        o[d0] = __builtin_amdgcn_mfma_f32_32x32x16_bf16((bf16x8){l1[0], l1[1], l1[2], l1[3], h1[0], h1[1], h1[2], h1[3]}, pa1, o[d0], 0, 0, 0);   \
        o[d0] = __builtin_amdgcn_mfma_f32_32x32x16_bf16((bf16x8){l2[0], l2[1], l2[2], l2[3], h2[0], h2[1], h2[2], h2[3]}, pa2, o[d0], 0, 0, 0);   \
        o[d0] = __builtin_amdgcn_mfma_f32_32x32x16_bf16((bf16x8){l3[0], l3[1], l3[2], l3[3], h3[0], h3[1], h3[2], h3[3]}, pa3, o[d0], 0, 0, 0); } while (0)
    PV_D0(0); PV_D0(1); PV_D0(2); PV_D0(3);
#undef PV_D0
#undef TRRD
}
__device__ __forceinline__ void gate_phase(Frame& F, const bf16* Z, const float* VRSTD, const float* vg, const float* Ws, const float* bs, bf16* GT) {
    using fox::bf16x8; using fox::f32x16;
    const int r32 = F.lane & 31, hi = F.lane >> 5, c = F.wave >> 2, t0 = 32 * (F.wave & 3);
    const int vb0 = (int)(uintptr_t)(F.ldsg + RING_OFF) + c * 32768 + fox::v_rd_base(F.lane);
    bf16x8 aw[8]; int gcur = -1;
    for (int item = F.bid; item < (MTOK / 256) * 16; item += F.G) {
        const int g = item & 15, pnl = item >> 4; const size_t row0 = (size_t)pnl * 256;
        if (g != gcur) { gcur = g;
            const float* wr_ = Ws + ((size_t)g * 128 + t0 + r32) * 128 + 8 * hi;
#pragma unroll
            for (int ks = 0; ks < 8; ++ks) { const f32x4 a = *(const GAS f32x4*)(wr_ + 16 * ks), b = *(const GAS f32x4*)(wr_ + 16 * ks + 4); const int s0 = 16 * ks + 8 * hi; int t = t0 + r32; asm volatile("" : "+v"(t));
                v4u w; w.x = pk2(s0 + 0 <= t ? a.x : 0.f, s0 + 1 <= t ? a.y : 0.f); w.y = pk2(s0 + 2 <= t ? a.z : 0.f, s0 + 3 <= t ? a.w : 0.f);
                       w.z = pk2(s0 + 4 <= t ? b.x : 0.f, s0 + 5 <= t ? b.y : 0.f); w.w = pk2(s0 + 6 <= t ? b.z : 0.f, s0 + 7 <= t ? b.w : 0.f);
                aw[ks] = __builtin_bit_cast(bf16x8, w); } }
#pragma unroll 2
        for (int ps = 0; ps < 8; ++ps) { const int idx = ps * (NWAVES * 64) + F.tid, row = idx >> 4, c8 = (idx & 15) * 8, s = row & 127;
            const v4u w = *(const GAS v4u*)(Z + (row0 + row) * 4096 + 2048 + g * 128 + c8); const float rs = VRSTD[row0 + row];
            const f32x4 g0 = *(const GAS f32x4*)(vg + g * 128 + c8), g1 = *(const GAS f32x4*)(vg + g * 128 + c8 + 4);
            v4u o; o.x = pk2(bflo(w.x) * rs * g0.x, bfhi(w.x) * rs * g0.y); o.y = pk2(bflo(w.y) * rs * g0.z, bfhi(w.y) * rs * g0.w);
                   o.z = pk2(bflo(w.z) * rs * g1.x, bfhi(w.z) * rs * g1.y); o.w = pk2(bflo(w.w) * rs * g1.z, bfhi(w.w) * rs * g1.w);
            *(LAS v4u*)(F.lds + RING_OFF + ((row >> 7) * 2 + (s >> 6)) * 16384 + fox::v_st(s & 63, c8)) = o; }
        __syncthreads();
        f32x16 o[4] = {};
        gate_pv<0>(o, vb0, aw[0], aw[1], aw[2], aw[3]);
        if (t0 >= 64) gate_pv<1>(o, vb0, aw[4], aw[5], aw[6], aw[7]);
        { const size_t grow = row0 + c * 128 + t0 + r32; const float bias = bs[g * 128 + t0 + r32];
          const GAS v2u* up = (const GAS v2u*)(Z + grow * 4096 + g * 128 + 4 * hi); GAS v4u* op = (GAS v4u*)(GT + grow * DM + g * 128 + 8 * hi);
#pragma unroll
          for (int d0 = 0; d0 < 4; ++d0) { float v[16];
#pragma unroll
            for (int q = 0; q < 4; ++q) { const v2u uw = up[d0 * 8 + q * 2];
                v[4 * q + 0] = bflo(uw.x) * (o[d0][4 * q + 0] + bias); v[4 * q + 1] = bfhi(uw.x) * (o[d0][4 * q + 1] + bias);
                v[4 * q + 2] = bflo(uw.y) * (o[d0][4 * q + 2] + bias); v[4 * q + 3] = bfhi(uw.y) * (o[d0][4 * q + 3] + bias); }
#pragma unroll
            for (int hf = 0; hf < 2; ++hf) { const unsigned a0 = fox::cvtpk(v[8 * hf + 0], v[8 * hf + 1]), a1 = fox::cvtpk(v[8 * hf + 2], v[8 * hf + 3]), b0 = fox::cvtpk(v[8 * hf + 4], v[8 * hf + 5]), b1 = fox::cvtpk(v[8 * hf + 6], v[8 * hf + 7]);
                auto r0 = __builtin_amdgcn_permlane32_swap(a0, b0, false, false); auto r1 = __builtin_amdgcn_permlane32_swap(a1, b1, false, false);
                v4u w; w.x = r0[0]; w.y = r1[0]; w.z = r0[1]; w.w = r1[1];
                op[d0 * 4 + hf * 2] = w; } } }
        __syncthreads();
    }
}
__device__ __forceinline__ float silu1(float v) { return v * __builtin_amdgcn_rcpf(1.0f + __builtin_amdgcn_exp2f(v * -1.4426950408889634f)); }
__device__ __forceinline__ void fix_phase(Frame& F, const float* HALO, const float* cw, const float* cb, bf16* ACT) {
    constexpr int C4 = DFF / 4;
    for (int item = F.bid * (NWAVES * 64) + F.tid; item < (MTOK / 256) * C4; item += F.G * NWAVES * 64) {
        const int pm = item / C4, c4 = (item % C4) * 4; if ((pm & 15) == 0) continue;
        f32x4 r0[2], r1[2];
#pragma unroll
        for (int part = 0; part < 2; ++part) { const int col = part * DFF + c4;
            const f32x4 am2 = *(const GAS f32x4*)(HALO + ((size_t)(pm - 1) * 4 + 2) * NFF2 + col), am1 = *(const GAS f32x4*)(HALO + ((size_t)(pm - 1) * 4 + 3) * NFF2 + col);
            const f32x4 a0 = *(const GAS f32x4*)(HALO + ((size_t)pm * 4 + 0) * NFF2 + col), a1 = *(const GAS f32x4*)(HALO + ((size_t)pm * 4 + 1) * NFF2 + col);
            const f32x4 w0 = *(const GAS f32x4*)(cw + col), w1 = *(const GAS f32x4*)(cw + NFF2 + col), w2 = *(const GAS f32x4*)(cw + 2 * NFF2 + col), b = *(const GAS f32x4*)(cb + col);
            r0[part] = b + w0 * am2 + w1 * am1 + w2 * a0; r1[part] = b + w0 * am1 + w1 * a0 + w2 * a1; }
        v2u o0, o1;
        o0.x = pk2(silu1(r0[0].x) * r0[1].x, silu1(r0[0].y) * r0[1].y); o0.y = pk2(silu1(r0[0].z) * r0[1].z, silu1(r0[0].w) * r0[1].w);
        o1.x = pk2(silu1(r1[0].x) * r1[1].x, silu1(r1[0].y) * r1[1].y); o1.y = pk2(silu1(r1[0].z) * r1[1].z, silu1(r1[0].w) * r1[1].w);
        *(GAS v2u*)(ACT + ((size_t)pm * 256) * DFF + c4) = o0; *(GAS v2u*)(ACT + ((size_t)pm * 256 + 1) * DFF + c4) = o1;
    }
}
constexpr int NPHASE = 1 + DEPTH * 9 + 1;
struct Args { const float* in[19]; float* out; unsigned char* ws; int ph_lo, ph_hi; };
static_assert(sizeof(Args) == 19 * 8 + 8 + 8 + 8, "Args has no padding bytes");
#ifndef MK_EN
#define MK_EN 0xffffffffu
#endif
#define EN(k) (((MK_EN) >> (k)) & 1u)
#ifndef MK_KREP
#define MK_KREP 1
#endif
#ifndef MK_REP
#define MK_REP 0u
#endif
#define REPN(k) ((((MK_REP) >> (k)) & 1u) ? 2 : 1)
#define W_MOD   ((float*)((unsigned char*)F.wsg + WS_MOD))
#define W_H     ((bf16*)((unsigned char*)F.wsg + WS_H))
#define W_Q     ((bf16*)((unsigned char*)F.wsg + WS_R))
#define W_K     ((bf16*)((unsigned char*)F.wsg + WS_R + 128 * MiB))
#define W_V     ((bf16*)((unsigned char*)F.wsg + WS_R + 256 * MiB))
#define W_Z     ((bf16*)((unsigned char*)F.wsg + WS_R))
#define W_ACT   ((bf16*)((unsigned char*)F.wsg + WS_R))
#define W_HALO  ((float*)((unsigned char*)F.wsg + WS_R + 344 * MiB))
#define W_LOGF  ((float*)((unsigned char*)F.wsg + WS_LOGF))
#define W_FB    ((float*)((unsigned char*)F.wsg + WS_FB))
#define W_VRSTD ((float*)((unsigned char*)F.wsg + WS_VRSTD))
#define W_MODI  (W_MOD + (size_t)i * 8 * 12288)
#define X_IN    ((i == 0) ? F.in(IN_X) : (const float*)(float*)F.outg)
__global__ void __launch_bounds__(NWAVES * 64, 2) mega_fwd(Args args) {
    extern __shared__ __attribute__((aligned(16))) unsigned char lds[];
    Frame F;
    F.lds = (LAS unsigned char*)lds; F.ldsg = (char*)lds;
    F.MISC = (volatile LAS unsigned*)(F.lds + MISC_OFF);
    for (int u = threadIdx.x; u < (LDS_BYTES - LDSCTL_OFF) / 4; u += NWAVES * 64) ((LAS unsigned*)(F.lds + LDSCTL_OFF))[u] = 0u;
    __syncthreads();
    if (threadIdx.x == 0) {
        const int G = gridDim.x, bx = blockIdx.x; const unsigned long long kp = (unsigned long long)__builtin_amdgcn_kernarg_segment_ptr(), wp = (unsigned long long)args.ws, op = (unsigned long long)args.out;
        F.MISC[MW_BID] = (unsigned)bx; F.MISC[MW_G] = (unsigned)G; F.MISC[MW_VCU] = (unsigned)((G % 8 == 0) ? (bx % 8) * (G / 8) + bx / 8 : bx);
        F.MISC[MW_INP] = (unsigned)kp; F.MISC[MW_INP_HI] = (unsigned)(kp >> 32); F.MISC[MW_WS] = (unsigned)wp; F.MISC[MW_WS_HI] = (unsigned)(wp >> 32); F.MISC[MW_OUT] = (unsigned)op; F.MISC[MW_OUT_HI] = (unsigned)(op >> 32);
    }
    __syncthreads();
    XcdBarrier bar; bar.bar = (unsigned*)(args.ws + WS_CTL) + CW_BAR; bar.x = 0; bar.st = nullptr;
    if (!MK_PER_PHASE) bar = xcd_barrier_post((unsigned*)(args.ws + WS_CTL) + CW_BAR, F.MISC + 8);
    const int lo = args.ph_lo, hi = args.ph_hi;
    int ph = 0;
#define RUN() (lo <= ph && ph < hi && relaunder(F))
#define SEAM() do { if (!MK_PER_PHASE) { if (lo <= ph && ph + 1 < hi) { relaunder(F); bar.bar = (unsigned*)((unsigned char*)F.wsg + WS_CTL) + CW_BAR; asm volatile("" : "+s"(bar.x)); xcd_barrier(bar); } } ++ph; } while (0)

    if (EN(0) && RUN()) for (int rep_ = 0; rep_ < REPN(0); ++rep_) pro_phase(F);
    SEAM();
    for (int i = 0; i < DEPTH; ++i) {
        const int j = i >> 1;
        if (EN(1) && RUN()) for (int rep_ = 0; rep_ < REPN(1); ++rep_) norm_phase(F, X_IN, F.in(IN_MIXG) + i * DM, W_MODI, W_MODI + DM, W_H);
        SEAM();
        if ((i & 1) == 0) {
            if (EN(2) && RUN()) for (int rep_ = 0; rep_ < REPN(2); ++rep_) {
                fg_phase(F, W_H, (const bf16*)((unsigned char*)F.wsg + WS_WF) + (size_t)j * 16 * DM, F.in(IN_ABF) + j * 16, W_LOGF);
                pg8::Gemm g{W_H, (const bf16*)((unsigned char*)F.wsg + WS_WQKV) + (size_t)j * 6144 * DM, MTOK, 6144, DM}; pg8::StaticOrder S; S.init(MTOK, 6144, F.G, F.bid);
                pg8::EpiQKV E{W_Q, (size_t)(64 * MiB), fox::QSCALE};
                pg8::gemm_phase<pg8::EpiQKV, pg8::StaticOrder, true, true>(F.lds + RING_OFF, g, S, E);
            }
            SEAM();
            if (EN(3) && RUN()) for (int rep_ = 0; rep_ < REPN(3); ++rep_) cum_phase(F, W_LOGF, W_FB);
            SEAM();
            if (EN(4) && RUN()) for (int rep_ = 0; rep_ < REPN(4); ++rep_) fox::att_phase(F.ldsg + RING_OFF, (const fox::bf16*)W_Q, (const fox::bf16*)W_K, (const fox::bf16*)W_V, (fox::bf16*)W_H, W_FB, F.bid, F.G);
            SEAM();
            if (EN(5) && RUN()) for (int rep_ = 0; rep_ < REPN(5); ++rep_) {
                pg8::Gemm g{W_H, (const bf16*)((unsigned char*)F.wsg + WS_WO) + (size_t)j * DM * DM, MTOK, DM, DM}; pg8::StaticOrder S; S.init(MTOK, DM, F.G, F.bid);
                pg8::EpiRes E{X_IN, (float*)F.outg, W_MODI + 2 * DM, 12288};
                pg8::gemm_phase<pg8::EpiRes, pg8::StaticOrder, true, true>(F.lds + RING_OFF, g, S, E);
            }
            SEAM();
        } else {
            if (EN(6) && RUN()) for (int rep_ = 0; rep_ < REPN(6); ++rep_) {
                pg8::Gemm g{W_H, (const bf16*)((unsigned char*)F.wsg + WS_WGI) + (size_t)j * 4096 * DM, MTOK, 4096, DM}; pg8::StaticOrder S; S.init(MTOK, 4096, F.G, F.bid);
                pg8::EpiStore<1> E{W_Z, 4096};
                pg8::gemm_phase<pg8::EpiStore<1>, pg8::StaticOrder, true, true>(F.lds + RING_OFF, g, S, E);
            }
            SEAM();
            if (EN(7) && RUN()) for (int rep_ = 0; rep_ < REPN(7); ++rep_) vstat_phase(F, W_Z, W_VRSTD);
            SEAM();
            if (EN(8) && RUN()) for (int rep_ = 0; rep_ < REPN(8); ++rep_) gate_phase(F, W_Z, W_VRSTD, F.in(IN_GVG) + j * DM, F.in(IN_GWS) + (size_t)j * 16 * 128 * 128, F.in(IN_GBS) + j * 16 * 128, W_H);
            SEAM();
            if (EN(9) && RUN()) for (int rep_ = 0; rep_ < REPN(9); ++rep_) {
                pg8::Gemm g{W_H, (const bf16*)((unsigned char*)F.wsg + WS_WGO) + (size_t)j * DM * DM, MTOK, DM, DM}; pg8::StaticOrder S; S.init(MTOK, DM, F.G, F.bid);
                pg8::EpiRes E{X_IN, (float*)F.outg, W_MODI + 2 * DM, 12288};
                pg8::gemm_phase<pg8::EpiRes, pg8::StaticOrder, true, true>(F.lds + RING_OFF, g, S, E);
            }
            SEAM();
        }
        if (EN(10) && RUN()) for (int rep_ = 0; rep_ < REPN(10); ++rep_) norm_phase(F, (float*)F.outg, F.in(IN_FFNG) + i * DM, W_MODI + 3 * DM, W_MODI + 4 * DM, W_H);
        SEAM();
        if (EN(11) && RUN()) for (int rep_ = 0; rep_ < REPN(11); ++rep_) {
            pg8::Gemm g{W_H, (const bf16*)((unsigned char*)F.wsg + WS_WF1) + (size_t)i * NFF2 * DM, MTOK, NFF2, DM}; pg8::StaticOrder S; S.init(MTOK, NFF2, F.G, F.bid);
            pg8::EpiConv E{W_ACT, F.in(IN_FCW) + (size_t)i * 3 * NFF2, F.in(IN_FCB) + (size_t)i * NFF2, W_HALO, (LAS float*)(F.lds + XCH_OFF)};
            pg8::gemm_phase<pg8::EpiConv, pg8::StaticOrder, true, true, MK_KREP>(F.lds + RING_OFF, g, S, E);
        }
        SEAM();
        if (EN(12) && RUN()) for (int rep_ = 0; rep_ < REPN(12); ++rep_) fix_phase(F, W_HALO, F.in(IN_FCW) + (size_t)i * 3 * NFF2, F.in(IN_FCB) + (size_t)i * NFF2, W_ACT);
        SEAM();
        if (EN(13) && RUN()) for (int rep_ = 0; rep_ < REPN(13); ++rep_) {
            pg8::Gemm g{W_ACT, (const bf16*)((unsigned char*)F.wsg + WS_WF2) + (size_t)i * DM * DFF, MTOK, DM, DFF}; pg8::StaticOrder S; S.init(MTOK, DM, F.G, F.bid);
            pg8::EpiRes E{(float*)F.outg, (float*)F.outg, W_MODI + 5 * DM, 12288};
            pg8::gemm_phase<pg8::EpiRes, pg8::StaticOrder, true, true>(F.lds + RING_OFF, g, S, E);
        }
        SEAM();
    }
    if (EN(14) && RUN()) for (int rep_ = 0; rep_ < REPN(14); ++rep_) normf_phase(F, (float*)F.outg, F.in(IN_FING));
#undef RUN
#undef SEAM
}

extern "C" void kernel_launch(void* const* d_in, const int* in_sizes, int n_in, void* d_out, int out_size, void* d_ws, size_t ws_size, hipStream_t stream) {
    static int grid = 0;
    if (grid == 0) {
        if (n_in != 19 || out_size != MTOK * DM || ws_size < WS_END) { fprintf(stderr, "kernel_launch: unexpected shapes (n_in %d, out %d, ws %zu < %zu)\n", n_in, out_size, ws_size, (size_t)WS_END); grid = -1; return; }
        int dev = 0, cus = 0, per_cu = 0;
        if (hipGetDevice(&dev) != hipSuccess || hipDeviceGetAttribute(&cus, hipDeviceAttributeMultiprocessorCount, dev) != hipSuccess) { grid = -1; return; }
        if (hipFuncSetAttribute((const void*)mega_fwd, hipFuncAttributeMaxDynamicSharedMemorySize, LDS_BYTES) != hipSuccess) { fprintf(stderr, "kernel_launch: hipFuncSetAttribute failed\n"); grid = -1; return; }
        if (hipOccupancyMaxActiveBlocksPerMultiprocessor(&per_cu, (const void*)mega_fwd, NWAVES * 64, LDS_BYTES) != hipSuccess || per_cu < 1) { fprintf(stderr, "kernel_launch: occupancy query says %d\n", per_cu); }
        (void)hipGetLastError();
        grid = cus;
    }
    if (grid < 0) return;
    if (hipMemsetAsync((char*)d_ws + WS_CTL, 0, CTL_ZERO_BYTES, stream) != hipSuccess) return;
    Args a{};
    for (int i = 0; i < 19; ++i) a.in[i] = (const float*)d_in[i];
    a.out = (float*)d_out; a.ws = (unsigned char*)d_ws;
#if MK_PER_PHASE
    for (int p = 0; p < NPHASE; ++p) { a.ph_lo = p; a.ph_hi = p + 1; hipLaunchKernelGGL(mega_fwd, dim3(grid), dim3(NWAVES * 64), LDS_BYTES, stream, a); }
#else
    a.ph_lo = 0; a.ph_hi = NPHASE; hipLaunchKernelGGL(mega_fwd, dim3(grid), dim3(NWAVES * 64), LDS_BYTES, stream, a);
#endif
}
```

```cpp
#include <hip/hip_runtime.h>
#include <hip/hip_bf16.h>
#include <cstdio>
#include <cstdint>
__device__ __forceinline__ int ltid() { int t = (int)threadIdx.x; asm volatile("" : "+v"(t)); return t; }
namespace pg8 {
#define PG8_LAS __attribute__((address_space(3)))
typedef unsigned short bf16_t;
typedef short bf16x8 __attribute__((ext_vector_type(8)));
typedef float f32x4 __attribute__((ext_vector_type(4)));
typedef unsigned u32x4 __attribute__((ext_vector_type(4)));
constexpr int BM = 256, BK = 64, HALF = 128, HTB = HALF * BK * 2  , STAGE_BYTES = 8 * HTB, NXCD = 8, WGM = 8;

__host__ __device__ __forceinline__ int lds_byte(int r, int c) { const int st = (r >> 4) * 2 + (c >> 5), rr = r & 15, cc = c & 31, ob = rr * 64 + cc * 2; return st * 1024 + (ob ^ (((ob >> 9) & 1) << 5)); }
__host__ __device__ __forceinline__ void stage_rc(int b, int& R, int& C) { const int st = b / 1024, sb = b % 1024, swz = sb ^ (((sb >> 9) & 1) << 5); R = (st >> 1) * 16 + swz / 64; C = (st & 1) * 32 + (swz % 64) / 2; }
__host__ __device__ __forceinline__ int perm32(int rho) { const int n = rho >> 4, i = rho & 15; return 8 * (i >> 2) + 4 * n + (i & 3); }

struct Unit { int pm, pn; };
struct Gemm { const bf16_t* A; const bf16_t* Bt; int M, N, K; };

struct StaticOrder {
    int nM, nN, nwg, G, c;
    __host__ __device__ void init(int M, int N, int G_, int c_) { nM = M / BM; nN = N / BM; nwg = nM * nN; G = G_; c = c_; }
    __host__ __device__ bool next(int i, Unit& u) const {
        const long L = (long)i * G + c; if (L >= nwg) return false;
        int wgid = (int)L; { const int q = nwg / NXCD, r = nwg % NXCD, xcd = wgid % NXCD, off = wgid / NXCD; wgid = (xcd < r ? xcd * (q + 1) : r * (q + 1) + (xcd - r) * q) + off; }
        const int nig = WGM * nN, gid = wgid / nig, fm = gid * WGM, gsz = (nM - fm) < WGM ? (nM - fm) : WGM;
        u.pm = fm + ((wgid % nig) % gsz); u.pn = (wgid % nig) / gsz; return true;
    }
    __device__ __forceinline__ void a_ready(const Unit&) const {}
    __device__ __forceinline__ void done(const Unit&) const {}
};
__device__ __forceinline__ unsigned cvt_pk_bf16(float lo, float hi) { unsigned r; asm volatile("v_cvt_pk_bf16_f32 %0, %1, %2" : "=v"(r) : "v"(lo), "v"(hi)); return r; }
typedef float f32x2 __attribute__((ext_vector_type(2)));
__device__ __forceinline__ f32x2 gelu_pk(f32x2 v) {
    const f32x2 av = __builtin_elementwise_abs(v), d = av * 0.2316418882f + 1.0f;
    f32x2 t; t.x = __builtin_amdgcn_rcpf(d.x); t.y = __builtin_amdgcn_rcpf(d.y);
    f32x2 q = t * 0.5307027145f + (-0.7265760135f); q = q * t + 0.7107068705f; q = q * t + (-0.142248368f); q = q * t + 0.127414796f; q = q * t;
    const f32x2 s = (v * v) * (-0.72134752044f);
    f32x2 e; e.x = __builtin_amdgcn_exp2f(s.x); e.y = __builtin_amdgcn_exp2f(s.y);
    const f32x2 m = v * (q * e), r = v - m;
    f32x2 o; o.x = v.x < 0.f ? m.x : r.x; o.y = v.y < 0.f ? m.y : r.y; return o;
}

struct RowAffine {
    const unsigned long long* rss; const float* biasb;
    int bpitch; PG8_LAS float* T;
    template <bool UPGATE> __device__ __forceinline__ void stage(const Unit& u, int p, int wid, int lane) const {
        if (wid == 0 || wid == 2) __builtin_amdgcn_global_load_lds((const unsigned*)(rss + (size_t)u.pm * BM + wid * 64 + lane * 2), (PG8_LAS unsigned*)(T + p * 768 + wid * 128), 16, 0, 0);
        if (wid == 1) { const int b = (u.pm * BM) >> 12;
            const int col = UPGATE ? ((lane < 32) ? (u.pn * 128 + lane * 4) : (5504 + u.pn * 128 + (lane - 32) * 4)) : (u.pn * BM + lane * 4);
            __builtin_amdgcn_global_load_lds((const unsigned*)(biasb + (size_t)b * bpitch + col), (PG8_LAS unsigned*)(T + p * 768 + 512), 16, 0, 0); }
    }
    __device__ __forceinline__ void apply(f32x4 (&acc)[2][2][4][2], int p, int wr, int wc, int fr, int fq) const {
        const PG8_LAS unsigned long long* Tr = (const PG8_LAS unsigned long long*)(T + p * 768) + wr * 64 + fr; const PG8_LAS float* Tb = T + p * 768 + 512 + wc * 32 + 8 * fq;
        float rs[2][4];
#pragma unroll
        for (int ai = 0; ai < 2; ++ai)
#pragma unroll
            for (int m = 0; m < 4; ++m) rs[ai][m] = __builtin_amdgcn_rsqf((float)Tr[ai * HALF + m * 16] * (1.0f / (1048576.0f * 2048.0f)) + 1e-6f);
#pragma unroll
        for (int bj = 0; bj < 2; ++bj)
#pragma unroll
            for (int n = 0; n < 2; ++n) { const f32x4 bv = *(const PG8_LAS f32x4*)(Tb + bj * HALF + 4 * n);
#pragma unroll
                for (int ai = 0; ai < 2; ++ai)
#pragma unroll
                    for (int m = 0; m < 4; ++m) acc[ai][bj][m][n] = acc[ai][bj][m][n] * rs[ai][m] + bv; }
    }
};
__device__ __forceinline__ float gelu_tanh1(float v) {
    const float u = v * (0.7978845608f + 0.0356774081f * v * v);
    const float e = __builtin_amdgcn_exp2f(u * -2.8853900818f);
    return v * __builtin_amdgcn_rcpf(1.0f + e);
}
template <int ACT  > struct EpiStore {
    static constexpr bool PERM = true, AFTER_DRAIN = false;
    bf16_t* O; int ldc; RowAffine ra; unsigned long long* vss;
    __device__ __forceinline__ void stage(const Unit& u, int p, int wid, int lane) const { ra.stage<false>(u, p, wid, lane); }
    __device__ __forceinline__ void operator()(f32x4 (&acc)[2][2][4][2], const Unit& u, int p, int wr, int wc, int fr, int fq) const {
        ra.apply(acc, p, wr, wc, fr, fq);
        const int row0 = u.pm * BM + wr * 64 + fr, col0 = u.pn * BM + wc * 32 + 8 * fq; float ssq[8];
#pragma unroll
        for (int ai = 0; ai < 2; ++ai)
#pragma unroll
            for (int m = 0; m < 4; ++m) { bf16_t* rowp = O + (size_t)(row0 + ai * HALF + m * 16) * ldc + col0; float s = 0.f;
#pragma unroll
                for (int bj = 0; bj < 2; ++bj) { f32x4 v0 = acc[ai][bj][m][0], v1 = acc[ai][bj][m][1];
                    if (ACT == 1) {
#pragma unroll
                        for (int j = 0; j < 4; ++j) { v0[j] = gelu_tanh1(v0[j]); v1[j] = gelu_tanh1(v1[j]); } }
                    s += (v0[0] * v0[0] + v0[1] * v0[1]) + (v0[2] * v0[2] + v0[3] * v0[3]) + (v1[0] * v1[0] + v1[1] * v1[1]) + (v1[2] * v1[2] + v1[3] * v1[3]);
                    u32x4 w; w.x = cvt_pk_bf16(v0[0], v0[1]); w.y = cvt_pk_bf16(v0[2], v0[3]); w.z = cvt_pk_bf16(v1[0], v1[1]); w.w = cvt_pk_bf16(v1[2], v1[3]);
                    *(u32x4*)(rowp + bj * HALF) = w; }
                ssq[ai * 4 + m] = s; }
        if (vss && u.pn >= 8) {
#pragma unroll
            for (int k = 0; k < 8; ++k) ssq[k] += __shfl_xor(ssq[k], 16);
#pragma unroll
            for (int k = 0; k < 8; ++k) ssq[k] += __shfl_xor(ssq[k], 32);
            if (fq == 0) {
#pragma unroll
                for (int k = 0; k < 8; ++k) __hip_atomic_fetch_add(vss + row0 + (k >> 2) * HALF + (k & 3) * 16, (unsigned long long)(ssq[k] * 1048576.0f), __ATOMIC_RELAXED, __HIP_MEMORY_SCOPE_AGENT); } }
    }
};
struct EpiQKV {
    static constexpr bool PERM = true, AFTER_DRAIN = false;
    bf16_t* QKV; size_t tstride; float qscale; RowAffine ra;
    __device__ __forceinline__ void stage(const Unit& u, int p, int wid, int lane) const { ra.stage<false>(u, p, wid, lane); }
    __device__ __forceinline__ void operator()(f32x4 (&acc)[2][2][4][2], const Unit& u, int p, int wr, int wc, int fr, int fq) const {
        ra.apply(acc, p, wr, wc, fr, fq);
        const int tok0 = u.pm * BM, b = tok0 >> 12, s0 = (tok0 & 4095) + wr * 64 + fr;
        const int colt = u.pn * BM, t = colt >> 11, hd0 = (colt & 2047) >> 7;
        bf16_t* base = QKV + (size_t)t * tstride; const float sc = t == 0 ? qscale : 1.0f;
#pragma unroll
        for (int bj = 0; bj < 2; ++bj) { bf16_t* hb = base + ((size_t)(b * 16 + hd0 + bj) * 4096 + s0) * 128 + wc * 32 + 8 * fq;
#pragma unroll
            for (int ai = 0; ai < 2; ++ai)
#pragma unroll
                for (int m = 0; m < 4; ++m) { const f32x4 v0 = acc[ai][bj][m][0] * sc, v1 = acc[ai][bj][m][1] * sc;
                    u32x4 w; w.x = cvt_pk_bf16(v0[0], v0[1]); w.y = cvt_pk_bf16(v0[2], v0[3]); w.z = cvt_pk_bf16(v1[0], v1[1]); w.w = cvt_pk_bf16(v1[2], v1[3]);
                    *(u32x4*)(hb + (size_t)(ai * HALF + m * 16) * 128) = w; } }
    }
};
struct EpiRes {
    static constexpr bool PERM = true, AFTER_DRAIN = false;
    bf16_t* xb; const float* gate; int gpitch; bf16_t* xg; const float* gn; const float* scn; unsigned long long* rss; PG8_LAS float* T;
    __device__ __forceinline__ void stage(const Unit& u, int p, int wid, int lane) const { const int b = (u.pm * BM) >> 12, c = u.pn * BM + lane * 4;
        if (wid == 0) __builtin_amdgcn_global_load_lds((const unsigned*)(gate + (size_t)b * gpitch + c), (PG8_LAS unsigned*)(T + p * 768), 16, 0, 0);
        if (wid == 1 && xg) __builtin_amdgcn_global_load_lds((const unsigned*)(gn + c), (PG8_LAS unsigned*)(T + p * 768 + 256), 16, 0, 0);
        if (wid == 2 && xg) __builtin_amdgcn_global_load_lds((const unsigned*)(scn + (size_t)b * gpitch + c), (PG8_LAS unsigned*)(T + p * 768 + 512), 16, 0, 0); }
    __device__ __forceinline__ void operator()(const f32x4 (&acc)[2][2][4][2], const Unit& u, int p, int wr, int wc, int fr, int fq) const {
        const int row0 = u.pm * BM + wr * 64 + fr, col0 = u.pn * BM + wc * 32 + 8 * fq; const PG8_LAS float* Tc = T + p * 768 + wc * 32 + 8 * fq;
        u32x4 xbuf[3][2];
#define ER_LOAD(k) do { const size_t off_ = (size_t)(row0 + ((k) >> 2) * HALF + ((k) & 3) * 16) * 2048 + col0; _Pragma("unroll") for (int bj = 0; bj < 2; ++bj) xbuf[(k) % 3][bj] = *(const u32x4*)(xb + off_ + bj * HALF); } while (0)
        ER_LOAD(0); ER_LOAD(1);
        f32x4 gv[2][2], gs[2][2];
#pragma unroll
        for (int bj = 0; bj < 2; ++bj)
#pragma unroll
            for (int n = 0; n < 2; ++n) { gv[bj][n] = *(const PG8_LAS f32x4*)(Tc + bj * HALF + n * 4);
                gs[bj][n] = xg ? *(const PG8_LAS f32x4*)(Tc + 256 + bj * HALF + n * 4) * (*(const PG8_LAS f32x4*)(Tc + 512 + bj * HALF + n * 4) + 1.0f) : (f32x4){0.f, 0.f, 0.f, 0.f}; }
        float ss[8];
#pragma unroll
        for (int k = 0; k < 8; ++k) { const int ai = k >> 2, m = k & 3, row = row0 + ai * HALF + m * 16; const size_t off = (size_t)row * 2048 + col0; float s = 0.f;
            if (k + 2 < 8) ER_LOAD(k + 2);
            __builtin_amdgcn_sched_barrier(0);
#pragma unroll
            for (int bj = 0; bj < 2; ++bj) { const u32x4 xw = xbuf[k % 3][bj];
                const f32x4 x0 = (f32x4){__builtin_bit_cast(float, xw.x << 16), __builtin_bit_cast(float, xw.x & 0xffff0000u), __builtin_bit_cast(float, xw.y << 16), __builtin_bit_cast(float, xw.y & 0xffff0000u)};
                const f32x4 x1 = (f32x4){__builtin_bit_cast(float, xw.z << 16), __builtin_bit_cast(float, xw.z & 0xffff0000u), __builtin_bit_cast(float, xw.w << 16), __builtin_bit_cast(float, xw.w & 0xffff0000u)};
                const f32x4 o0 = x0 + gv[bj][0] * acc[ai][bj][m][0], o1 = x1 + gv[bj][1] * acc[ai][bj][m][1];
                u32x4 w; w.x = cvt_pk_bf16(o0[0], o0[1]); w.y = cvt_pk_bf16(o0[2], o0[3]); w.z = cvt_pk_bf16(o1[0], o1[1]); w.w = cvt_pk_bf16(o1[2], o1[3]);
                *(u32x4*)(xb + off + bj * HALF) = w;
                if (xg) { const f32x4 y0 = o0 * gs[bj][0], y1 = o1 * gs[bj][1]; u32x4 g; g.x = cvt_pk_bf16(y0[0], y0[1]); g.y = cvt_pk_bf16(y0[2], y0[3]); g.z = cvt_pk_bf16(y1[0], y1[1]); g.w = cvt_pk_bf16(y1[2], y1[3]);
                    *(u32x4*)(xg + off + bj * HALF) = g;
                    s += (o0[0] * o0[0] + o0[1] * o0[1]) + (o0[2] * o0[2] + o0[3] * o0[3]) + (o1[0] * o1[0] + o1[1] * o1[1]) + (o1[2] * o1[2] + o1[3] * o1[3]); } }
            ss[k] = s;
            __builtin_amdgcn_sched_barrier(0); }
#undef ER_LOAD
        if (xg) {
#pragma unroll
            for (int k = 0; k < 8; ++k) ss[k] += __shfl_xor(ss[k], 16);
#pragma unroll
            for (int k = 0; k < 8; ++k) ss[k] += __shfl_xor(ss[k], 32);
            if (fq == 0) {
#pragma unroll
                for (int k = 0; k < 8; ++k) __hip_atomic_fetch_add(rss + row0 + (k >> 2) * HALF + (k & 3) * 16, (unsigned long long)(ss[k] * 1048576.0f), __ATOMIC_RELAXED, __HIP_MEMORY_SCOPE_AGENT); } }
    }
};
__device__ __forceinline__ int f2i(float v) { return __builtin_bit_cast(int, v); }
__device__ __forceinline__ float i2f(int v) { return __builtin_bit_cast(float, v); }
template <int SH> __device__ __forceinline__ float dpp_ror(float v) { return i2f(__builtin_amdgcn_update_dpp(0, f2i(v), 0x120 + SH, 0xf, 0xf, true)); }
template <int SH> __device__ __forceinline__ float dpp_shr_fill(float fill, float cur) { return i2f(__builtin_amdgcn_update_dpp(f2i(fill), f2i(cur), 0x110 + SH, 0xf, 0xf, false)); }
struct EpiConv {
    static constexpr bool PERM = true, AFTER_DRAIN = false;
    bf16_t* ACT; const float* cw; const float* cb; float* HALO; PG8_LAS float* X; RowAffine ra;
    __device__ __forceinline__ void stage(const Unit& u, int p, int wid, int lane) const { ra.stage<true>(u, p, wid, lane); }
    __device__ __forceinline__ void operator()(f32x4 (&acc)[2][2][4][2], const Unit& u, int p, int wr, int wc, int fr, int fq) const {
        const int tcol = wc * 32 + 8 * fq, ch0 = u.pn * 128 + tcol;
        ra.apply(acc, p, wr, wc, fr, fq);
#if defined(MK_KREP) && MK_KREP > 1
#pragma unroll
        for (int ai = 0; ai < 2; ++ai)
#pragma unroll
            for (int bj = 0; bj < 2; ++bj)
#pragma unroll
                for (int m = 0; m < 4; ++m)
#pragma unroll
                    for (int n = 0; n < 2; ++n) acc[ai][bj][m][n] *= (1.0f / MK_KREP);
#endif
        if (fr >= 14) {
#pragma unroll
            for (int ai = 0; ai < 2; ++ai)
#pragma unroll
                for (int bj = 0; bj < 2; ++bj)
#pragma unroll
                    for (int n = 0; n < 2; ++n) *(PG8_LAS f32x4*)(X + (((ai * 2 + wr) * 2 + (fr - 14)) * 256) + bj * 128 + tcol + 4 * n) = acc[ai][bj][3][n];
            if (wr == 1) {
#pragma unroll
                for (int bj = 0; bj < 2; ++bj)
#pragma unroll
                    for (int n = 0; n < 2; ++n) *(f32x4*)(HALO + ((size_t)u.pm * 4 + 2 + (fr - 14)) * 11008 + bj * 5504 + ch0 + 4 * n) = acc[1][bj][3][n]; }
        }
        if (fr < 2 && wr == 0) {
#pragma unroll
            for (int bj = 0; bj < 2; ++bj)
#pragma unroll
                for (int n = 0; n < 2; ++n) *(f32x4*)(HALO + ((size_t)u.pm * 4 + fr) * 11008 + bj * 5504 + ch0 + 4 * n) = acc[0][bj][0][n]; }
        asm volatile("s_waitcnt lgkmcnt(0)" ::: "memory"); __builtin_amdgcn_s_barrier(); asm volatile("" ::: "memory");
#pragma unroll
        for (int bj = 0; bj < 2; ++bj) {
            f32x4 w0[2], w1[2], w2[2], bb[2];
#pragma unroll
            for (int n = 0; n < 2; ++n) { const float* p = cw + bj * 5504 + ch0 + 4 * n; w0[n] = *(const f32x4*)p; w1[n] = *(const f32x4*)(p + 11008); w2[n] = *(const f32x4*)(p + 2 * 11008); bb[n] = *(const f32x4*)(cb + bj * 5504 + ch0 + 4 * n); }
            __builtin_amdgcn_sched_barrier(0);
#pragma unroll
            for (int ai = 0; ai < 2; ++ai) { const int g = ai * 2 + wr;
#pragma unroll
                for (int n = 0; n < 2; ++n) {
                    f32x4 h1 = (f32x4){0.f, 0.f, 0.f, 0.f}, h2 = h1;
                    if (g > 0) { h1 = *(const PG8_LAS f32x4*)(X + (((g - 1) * 2 + 1) * 256) + bj * 128 + tcol + 4 * n); h2 = *(const PG8_LAS f32x4*)(X + (((g - 1) * 2 + (fr & 1)) * 256) + bj * 128 + tcol + 4 * n); }
#pragma unroll
                    for (int m = 3; m >= 0; --m) { const f32x4 x = acc[ai][bj][m][n]; f32x4 r;
#pragma unroll
                        for (int e = 0; e < 4; ++e) { float f1, f2;
                            if (m > 0) { const float xp = acc[ai][bj][m - 1][n][e]; f1 = dpp_ror<1>(xp); f2 = dpp_ror<2>(xp); } else { f1 = h1[e]; f2 = h2[e]; }
                            const float p1 = dpp_shr_fill<1>(f1, x[e]), p2 = dpp_shr_fill<2>(f2, x[e]);
                            r[e] = bb[n][e] + w2[n][e] * x[e] + w1[n][e] * p1 + w0[n][e] * p2; }
                        asm volatile("" : "+v"(r));
                        acc[ai][bj][m][n] = r; }
                    __builtin_amdgcn_sched_barrier(0); } }
        }
        const int row0 = u.pm * BM + wr * 64 + fr;
#pragma unroll
        for (int ai = 0; ai < 2; ++ai)
#pragma unroll
            for (int m = 0; m < 4; ++m) { f32x4 o[2];
#pragma unroll
                for (int n = 0; n < 2; ++n)
#pragma unroll
                    for (int e = 0; e < 4; ++e) { const float gt = acc[ai][0][m][n][e]; o[n][e] = gt * __builtin_amdgcn_rcpf(1.0f + __builtin_amdgcn_exp2f(gt * -1.4426950408889634f)) * acc[ai][1][m][n][e]; }
                u32x4 w; w.x = cvt_pk_bf16(o[0][0], o[0][1]); w.y = cvt_pk_bf16(o[0][2], o[0][3]); w.z = cvt_pk_bf16(o[1][0], o[1][1]); w.w = cvt_pk_bf16(o[1][2], o[1][3]);
                *(u32x4*)(ACT + (size_t)(row0 + ai * HALF + m * 16) * 5504 + ch0) = w; }
    }
};
template <class Epi, class Sched, bool ALIGN_EPI = false, bool SP2 = false, int KREP = 1>
__device__ __forceinline__ void gemm_phase(PG8_LAS unsigned char* lds, const Gemm g, const Sched& S, const Epi& E) {
    const int tid = ltid(), wid = __builtin_amdgcn_readfirstlane(tid >> 6), lane = tid & 63, wr = wid >> 2, wc = wid & 3, fr = lane & 15, fq = lane >> 4;
    const int K = g.K, nt = K / BK;
    unsigned voffA[2], voffB[2];
#pragma unroll
    for (int i = 0; i < 2; ++i) { int R, C; stage_rc(tid * 16 + i * 8192, R, C); const int Rb = Epi::PERM ? ((R & ~31) + perm32(R & 31)) : R;
        voffA[i] = (unsigned)(R * K + C) * 2u; voffB[i] = (unsigned)(Rb * K + C) * 2u; }
    const size_t kstep = (size_t)(BK * 2);
    const size_t hstep = (size_t)HALF * K * 2;
    const size_t tstep = 2 * hstep;
    const unsigned ldsw = (unsigned)wid * 1024u;
    const int aoff = lds_byte(wr * 64 + fr, fq * 8), boff = lds_byte(wc * 32 + fr, fq * 8);
#define PG8_SA(b, h) (((b) * 2 + (h)) * HTB)
#define PG8_SB(b, h) ((4 + (b) * 2 + (h)) * HTB)
#define PG8_STAGE(bufoff, gbase, voff) do { _Pragma("unroll") for (int _i = 0; _i < 2; ++_i) \
        __builtin_amdgcn_global_load_lds((const unsigned*)((const char*)(gbase) + (voff)[_i]), (PG8_LAS unsigned*)(lds + (bufoff) + ldsw + _i * 8192), 16, 0, 0); } while (0)
#define PG8_LDA(dst, b, h) do { _Pragma("unroll") for (int m = 0; m < 4; ++m) _Pragma("unroll") for (int k = 0; k < 2; ++k) dst[m][k] = *(const PG8_LAS bf16x8*)(lds + PG8_SA(b, h) + aoff + m * 2048 + k * 1024); } while (0)
#define PG8_LDB(dst, b, h) do { _Pragma("unroll") for (int n = 0; n < 2; ++n) _Pragma("unroll") for (int k = 0; k < 2; ++k) dst[n][k] = *(const PG8_LAS bf16x8*)(lds + PG8_SB(b, h) + boff + n * 2048 + k * 1024); } while (0)
#define PG8_MMA(ai, bj, At, Bt) do { __builtin_amdgcn_s_setprio(1); _Pragma("unroll") for (int m = 0; m < 4; ++m) _Pragma("unroll") for (int n = 0; n < 2; ++n) _Pragma("unroll") for (int k = 0; k < 2; ++k) \
        acc[ai][bj][m][n] = __builtin_amdgcn_mfma_f32_16x16x32_bf16(Bt[n][k], At[m][k], acc[ai][bj][m][n], 0, 0, 0); __builtin_amdgcn_s_setprio(0); } while (0)
#define PG8_WAIT_V(n) asm volatile("s_waitcnt vmcnt(" #n ")" ::: "memory")
#define PG8_WAIT_L(n) asm volatile("s_waitcnt lgkmcnt(" #n ")" ::: "memory")
#define PG8_BAR __builtin_amdgcn_s_barrier()
#define PG8_SCHED __builtin_amdgcn_sched_barrier(0)
    Unit cur, nxt; int ui = 0;
    if (!S.next(0, cur)) return;
    E.stage(cur, 0, wid, lane);
    f32x4 acc[2][2][4][2];
#pragma unroll
    for (int a = 0; a < 2; ++a)
#pragma unroll
        for (int b = 0; b < 2; ++b)
#pragma unroll
            for (int m = 0; m < 4; ++m)
#pragma unroll
                for (int n = 0; n < 2; ++n) acc[a][b][m][n] = (f32x4){0.f, 0.f, 0.f, 0.f};
    bf16x8 At[4][2], B0[2][2], B1[2][2];
    const char* cA = (const char*)g.A + (size_t)cur.pm * tstep; const char* cB = (const char*)g.Bt + (size_t)cur.pn * tstep;
    S.a_ready(cur);
    if constexpr (SP2) {
        PG8_STAGE(PG8_SB(0, 0), cB, voffB); PG8_STAGE(PG8_SB(0, 1), cB + hstep, voffB); PG8_STAGE(PG8_SA(0, 0), cA, voffA); PG8_STAGE(PG8_SA(0, 1), cA + hstep, voffA);
        if (wr == 1) PG8_BAR;
        PG8_WAIT_V(2); PG8_BAR;
        PG8_STAGE(PG8_SB(1, 0), cB + kstep, voffB); PG8_STAGE(PG8_SA(1, 0), cA + kstep, voffA); PG8_STAGE(PG8_SB(1, 1), cB + hstep + kstep, voffB);
        PG8_WAIT_V(6); PG8_BAR;
    } else {
        PG8_STAGE(PG8_SB(0, 0), cB, voffB); PG8_STAGE(PG8_SA(0, 0), cA, voffA); PG8_STAGE(PG8_SB(0, 1), cB + hstep, voffB); PG8_STAGE(PG8_SA(0, 1), cA + hstep, voffA);
        if (wr == 1) PG8_BAR;
        PG8_WAIT_V(4); PG8_BAR;
        PG8_STAGE(PG8_SB(1, 0), cB + kstep, voffB); PG8_STAGE(PG8_SA(1, 0), cA + kstep, voffA); PG8_STAGE(PG8_SB(1, 1), cB + hstep + kstep, voffB);
        PG8_WAIT_V(6); PG8_BAR;
    }
    for (;;) {
        const bool has_next = S.next(ui + 1, nxt);
        const char* nA = has_next ? (const char*)g.A + (size_t)nxt.pm * tstep : cA; const char* nB = has_next ? (const char*)g.Bt + (size_t)nxt.pn * tstep : cB;
        for (int t = 0; t < nt * KREP; t += 2) {
            const bool last = (t == nt * KREP - 2);
            const int t1w = KREP > 1 ? ((t + 1) & (nt - 1)) : t + 1, t2w = KREP > 1 ? ((t + 2) & (nt - 1)) : t + 2;
            const char* a1 = cA + (size_t)t1w * kstep;
            const char* a2 = last ? nA : cA + (size_t)t2w * kstep; const char* b2 = last ? nB : cB + (size_t)t2w * kstep;
            const char* a3 = a2 + kstep; const char* b3 = b2 + kstep;
            if (last && has_next) S.a_ready(nxt);
            if constexpr (SP2) {
            PG8_LDB(B0, 0, 0); PG8_LDB(B1, 0, 1); PG8_SCHED; PG8_LDA(At, 0, 0); PG8_STAGE(PG8_SA(1, 1), a1 + hstep, voffA);
            PG8_WAIT_V(8); PG8_WAIT_L(0); PG8_BAR; PG8_MMA(0, 0, At, B0); PG8_MMA(0, 1, At, B1); PG8_BAR; PG8_SCHED;
            PG8_LDA(At, 0, 1); PG8_STAGE(PG8_SB(0, 0), b2, voffB); PG8_STAGE(PG8_SB(0, 1), b2 + hstep, voffB); PG8_STAGE(PG8_SA(0, 0), a2, voffA);
            PG8_WAIT_V(8); PG8_WAIT_L(0); PG8_BAR; PG8_MMA(1, 0, At, B0); PG8_MMA(1, 1, At, B1); PG8_BAR; PG8_SCHED;
            PG8_LDB(B0, 1, 0); PG8_LDB(B1, 1, 1); PG8_SCHED; PG8_LDA(At, 1, 0); PG8_STAGE(PG8_SA(0, 1), a2 + hstep, voffA);
            PG8_WAIT_V(8); PG8_WAIT_L(0); PG8_BAR; PG8_MMA(0, 0, At, B0); PG8_MMA(0, 1, At, B1); PG8_BAR; PG8_SCHED;
            PG8_LDA(At, 1, 1); PG8_STAGE(PG8_SB(1, 0), b3, voffB); PG8_STAGE(PG8_SB(1, 1), b3 + hstep, voffB); PG8_STAGE(PG8_SA(1, 0), a3, voffA);
            PG8_WAIT_V(8); PG8_WAIT_L(0); PG8_BAR; PG8_MMA(1, 0, At, B0); PG8_MMA(1, 1, At, B1); PG8_BAR; PG8_SCHED;
            } else {
            PG8_LDB(B0, 0, 0); PG8_SCHED; PG8_LDA(At, 0, 0); PG8_STAGE(PG8_SA(1, 1), a1 + hstep, voffA);
            PG8_WAIT_L(8); PG8_BAR; PG8_WAIT_L(0); PG8_MMA(0, 0, At, B0); PG8_BAR; PG8_SCHED;
            PG8_LDB(B1, 0, 1); PG8_STAGE(PG8_SB(0, 0), b2, voffB);
            PG8_BAR; PG8_WAIT_L(0); PG8_MMA(0, 1, At, B1); PG8_BAR;
            PG8_LDA(At, 0, 1); PG8_STAGE(PG8_SA(0, 0), a2, voffA);
            PG8_BAR; PG8_WAIT_L(0); PG8_MMA(1, 0, At, B0); PG8_BAR; PG8_SCHED;
            PG8_STAGE(PG8_SB(0, 1), b2 + hstep, voffB);
            PG8_WAIT_V(6); PG8_BAR; PG8_MMA(1, 1, At, B1); PG8_BAR;
            PG8_LDB(B0, 1, 0); PG8_SCHED; PG8_LDA(At, 1, 0); PG8_STAGE(PG8_SA(0, 1), a2 + hstep, voffA);
            PG8_WAIT_L(8); PG8_BAR; PG8_WAIT_L(0); PG8_MMA(0, 0, At, B0); PG8_BAR; PG8_SCHED;
            PG8_LDB(B1, 1, 1); PG8_STAGE(PG8_SB(1, 0), b3, voffB);
            PG8_BAR; PG8_WAIT_L(0); PG8_MMA(0, 1, At, B1); PG8_BAR;
            PG8_LDA(At, 1, 1); PG8_STAGE(PG8_SA(1, 0), a3, voffA);
            PG8_BAR; PG8_WAIT_L(0); PG8_MMA(1, 0, At, B0); PG8_BAR; PG8_SCHED;
            PG8_STAGE(PG8_SB(1, 1), b3 + hstep, voffB);
            PG8_WAIT_V(6); PG8_BAR; PG8_MMA(1, 1, At, B1); PG8_BAR;
            }
        }
        if constexpr (ALIGN_EPI) { if (wr == 0) PG8_BAR; }
        if constexpr (!Epi::AFTER_DRAIN) { E(acc, cur, ui & 1, wr, wc, fr, fq); S.done(cur); }
        if (!has_next) break;
        E.stage(nxt, (ui + 1) & 1, wid, lane);
#pragma unroll
        for (int a = 0; a < 2; ++a)
#pragma unroll
            for (int b = 0; b < 2; ++b)
#pragma unroll
                for (int m = 0; m < 4; ++m)
#pragma unroll
                    for (int n = 0; n < 2; ++n) acc[a][b][m][n] = (f32x4){0.f, 0.f, 0.f, 0.f};
        cur = nxt; cA = nA; cB = nB; ++ui;
        if constexpr (ALIGN_EPI) { if (wr == 1) PG8_BAR; }
    }
    PG8_WAIT_V(0);
    if constexpr (!ALIGN_EPI) { if (wr == 0) PG8_BAR; }
    PG8_BAR;
    if constexpr (Epi::AFTER_DRAIN) { E.fused(acc, cur, wr, wc, fr, fq, lds, wid, lane); S.done(cur); }
#undef PG8_SA
#undef PG8_SB
#undef PG8_STAGE
#undef PG8_LDA
#undef PG8_LDB
#undef PG8_MMA
#undef PG8_WAIT_V
#undef PG8_WAIT_L
#undef PG8_BAR
#undef PG8_SCHED
}
}
namespace fox {
enum { ORDER_NATURAL = 0, ORDER_REVERSED = 1, ORDER_PAIRED = 2, ORDER_XCD = 4 };
constexpr int B = 8, H = 16, HKV = 16, SQ = 4096, SKV = 4096, D = 128;
constexpr int QOFF = 0;
constexpr int WINDOW = SKV;
constexpr float THR = 8.f;
constexpr bool WSKIP = false;
constexpr float SCALE = 0.08838834764831845f;
constexpr float QSCALE = SCALE * 1.4426950408889634f;
constexpr int NW = 8, QBLK = 32, KVBLK = 64, QB = NW * QBLK;
constexpr int SHM_V = KVBLK * D * 2, SHM_K = KVBLK * D * 2;
constexpr int LDS_FB = 2 * SHM_V + 2 * SHM_K + NW * 64 * 4;
constexpr int LDS_BYTES = LDS_FB + SKV * 4;
constexpr int OPITCH = H * D;
using bf16 = __hip_bfloat16;
typedef short bf16x8 __attribute__((ext_vector_type(8)));
typedef short s16x4 __attribute__((ext_vector_type(4)));
typedef float f32x16 __attribute__((ext_vector_type(16)));
typedef float f32x4 __attribute__((ext_vector_type(4)));
typedef unsigned u32x4 __attribute__((ext_vector_type(4)));
template <class A, class Bt> struct same_t { static constexpr bool v = false; };
template <class A> struct same_t<A, A> { static constexpr bool v = true; };

#define KSWZ(row, colB) ((row) * 256 + ((colB) ^ (((row) & 7) << 4)))
#define SBAR() __builtin_amdgcn_sched_barrier(0)
__device__ __forceinline__ int v_st(int k, int c) { const int kk = (k & ~0xC) | ((k & 4) << 1) | ((k & 8) >> 1); return ((kk >> 3) * 4 + (c >> 5)) * 512 + ((kk & 7) * 32 + (c & 31)) * 2; }
__device__ __forceinline__ int v_rd_base(int lane) { return ((lane & 3) << 3) | (((lane >> 2) & 3) << 6) | (((lane >> 4) & 1) << 5) | (((lane >> 5) & 1) << 8); }
constexpr int v_rd_off(int d0, int ks, int half) { return d0 * 512 + ks * 4096 + half * 2048; }
__device__ __forceinline__ int crow(int r, int hi) { return (r & 3) + 8 * (r >> 2) + 4 * hi; }
__device__ __forceinline__ unsigned cvtpk(float lo, float hi) {
    unsigned r; asm volatile("v_cvt_pk_bf16_f32 %0, %1, %2" : "=v"(r) : "v"(lo), "v"(hi)); return r;
}
__device__ __forceinline__ bf16x8 pack8(f32x4 a, f32x4 b) {
    u32x4 w = {cvtpk(a[0], a[1]), cvtpk(a[2], a[3]), cvtpk(b[0], b[1]), cvtpk(b[2], b[3])};
    return *reinterpret_cast<bf16x8*>(&w);
}
template <class T> __device__ __forceinline__ bf16x8 load8(const T* p) {
    if constexpr (same_t<T, float>::v) { return pack8(*(const f32x4*)p, *(const f32x4*)(p + 4)); }
    else { return *reinterpret_cast<const bf16x8*>(p); }
}
__device__ __forceinline__ void mask_tile(f32x16& p0, f32x16& p1, int dq, unsigned W) {
    const float NEG = -__builtin_inff();
#pragma unroll
    for (int r = 0; r < 16; ++r) {
        const int c = (r & 3) + 8 * (r >> 2);
        if ((unsigned)(dq - c) >= W) p0[r] = NEG;
        if ((unsigned)(dq - c - 32) >= W) p1[r] = NEG;
    }
}
__device__ __forceinline__ void partialSM(f32x16& p0, f32x16& p1, float& m_reg, float& mn, float& alpha) {
    float pmax = p0[0]; for (int r = 1; r < 16; ++r) pmax = fmaxf(pmax, p0[r]); for (int r = 0; r < 16; ++r) pmax = fmaxf(pmax, p1[r]);
    { auto rr = __builtin_amdgcn_permlane32_swap(__float_as_uint(pmax), __float_as_uint(pmax), false, false);
      pmax = fmaxf(__uint_as_float(rr[0]), __uint_as_float(rr[1])); }
    constexpr float THR2 = THR * 1.4426950408889634f;
    if (__builtin_expect(__all((pmax - m_reg) <= THR2), 1)) { mn = m_reg; alpha = 1.f; }
    else { mn = fmaxf(m_reg, pmax); alpha = __builtin_amdgcn_exp2f(m_reg - mn); m_reg = mn; }
    for (int r = 0; r < 16; ++r) p0[r] = p0[r] - mn; for (int r = 0; r < 16; ++r) p1[r] = p1[r] - mn;
    for (int r = 0; r < 16; ++r) p0[r] = __builtin_amdgcn_exp2f(p0[r]);
}
__device__ __forceinline__ void finishSM(f32x16& p0, f32x16& p1, float alpha, float& l_reg, bf16x8& pa0, bf16x8& pa1, bf16x8& pa2, bf16x8& pa3) {
    for (int r = 0; r < 16; ++r) p1[r] = __builtin_amdgcn_exp2f(p1[r]);
    float ps = 0; for (int r = 0; r < 16; ++r) ps += p0[r]; for (int r = 0; r < 16; ++r) ps += p1[r];
    { auto rr = __builtin_amdgcn_permlane32_swap(__float_as_uint(ps), __float_as_uint(ps), false, false);
      ps = __uint_as_float(rr[0]) + __uint_as_float(rr[1]); }
    l_reg = l_reg * alpha + ps;
#define PK4(P, B_, OUT) do { unsigned a0 = cvtpk(P[B_+0], P[B_+1]), a1 = cvtpk(P[B_+2], P[B_+3]);                          \
        unsigned b0 = cvtpk(P[B_+4], P[B_+5]), b1 = cvtpk(P[B_+6], P[B_+7]);                                             \
        auto r0 = __builtin_amdgcn_permlane32_swap(a0, b0, false, false); auto r1 = __builtin_amdgcn_permlane32_swap(a1, b1, false, false); \
        u32x4 w = {r0[0], r1[0], r0[1], r1[1]}; OUT = *reinterpret_cast<bf16x8*>(&w); } while (0)
    PK4(p0, 0, pa0); PK4(p0, 8, pa1); PK4(p1, 0, pa2); PK4(p1, 8, pa3);
#undef PK4
}
template <int KB, bool SK>
__device__ __forceinline__ void qkt(f32x16& p0, f32x16& p1, const char* K_lds, int r32, int hi, const bf16x8* qr, bool act, const char* fb) {
    if (SK && !act) { const float NEG = -__builtin_inff();
#pragma unroll
        for (int r = 0; r < 16; ++r) { p0[r] = NEG; p1[r] = NEG; } return; }
#pragma unroll
    for (int q = 0; q < 4; ++q) { const f32x4 b0 = *reinterpret_cast<const f32x4*>(fb + q * 32), b1 = *reinterpret_cast<const f32x4*>(fb + 128 + q * 32);
#pragma unroll
        for (int i = 0; i < 4; ++i) { p0[4 * q + i] = b0[i]; p1[4 * q + i] = b1[i]; } }
    const char* kb[4];
#pragma unroll
    for (int dd = 0; dd < 4; ++dd) kb[dd] = K_lds + KB * SHM_K + KSWZ(r32, (dd * 16 + hi * 8) * 2);
#pragma unroll
    for (int d0 = 0; d0 < 8; ++d0) { const char* a = kb[d0 & 3] + (d0 >> 2) * 128;
        bf16x8 b0 = *reinterpret_cast<const bf16x8*>(a);
        bf16x8 b1 = *reinterpret_cast<const bf16x8*>(a + 32 * 256);
        p0 = __builtin_amdgcn_mfma_f32_32x32x16_bf16(b0, qr[d0], p0, 0, 0, 0);
        p1 = __builtin_amdgcn_mfma_f32_32x32x16_bf16(b1, qr[d0], p1, 0, 0, 0); }
}
template <int VB, bool SK>
__device__ __forceinline__ void pv_tile(f32x16* o, int vb0, bf16x8 pa0, bf16x8 pa1, bf16x8 pa2, bf16x8 pa3, bool act) {
    if (SK && !act) return;
#define TRRD(dst, off) asm volatile("ds_read_b64_tr_b16 %0, %1 offset:%2" : "=&v"(dst) : "v"(vb0), "i"(off) : "memory")
#define PV_D0(d0) do { s16x4 l0, l1, l2, l3, h0, h1, h2, h3; constexpr int b_ = VB * SHM_V + v_rd_off(d0, 0, 0);     \
        TRRD(l0, b_); TRRD(h0, b_ + 2048); TRRD(l1, b_ + 4096); TRRD(h1, b_ + 6144); TRRD(l2, b_ + 8192); TRRD(h2, b_ + 10240); TRRD(l3, b_ + 12288); TRRD(h3, b_ + 14336); \
        asm volatile("s_waitcnt lgkmcnt(0)" ::: "memory"); SBAR();                 \
        o[d0] = __builtin_amdgcn_mfma_f32_32x32x16_bf16(pa0, (bf16x8){l0[0], l0[1], l0[2], l0[3], h0[0], h0[1], h0[2], h0[3]}, o[d0], 0, 0, 0);   \
        o[d0] = __builtin_amdgcn_mfma_f32_32x32x16_bf16(pa1, (bf16x8){l1[0], l1[1], l1[2], l1[3], h1[0], h1[1], h1[2], h1[3]}, o[d0], 0, 0, 0);   \
        o[d0] = __builtin_amdgcn_mfma_f32_32x32x16_bf16(pa2, (bf16x8){l2[0], l2[1], l2[2], l2[3], h2[0], h2[1], h2[2], h2[3]}, o[d0], 0, 0, 0);   \
        o[d0] = __builtin_amdgcn_mfma_f32_32x32x16_bf16(pa3, (bf16x8){l3[0], l3[1], l3[2], l3[3], h3[0], h3[1], h3[2], h3[3]}, o[d0], 0, 0, 0); } while (0)
    PV_D0(0); PV_D0(1); PV_D0(2); PV_D0(3);
#undef PV_D0
#undef TRRD
}
template <class TIn, class TOut> struct BlockRef { const TIn* Q; const TIn* K; const TIn* V; TOut* O; const float* FB; int P0; };
template <class TIn> struct Seam {
    bf16x8 qr[8];
    bf16x8 st_v0, st_v1, st_k0, st_k1; f32x4 sf0, sf1, sf2, sf3;
    f32x4 tq[16];
};
__device__ __forceinline__ int swa_jlo(int P0, int W) { const int lowk = P0 - W + 1; return lowk > 0 ? lowk / KVBLK : 0; }
#define ROW(p, k0, rr) ((p) + (size_t)((k0) + (rr)) * D + sc)
#define VMW() asm volatile("s_waitcnt vmcnt(0)" ::: "memory")
#define VMWN(n) asm volatile("s_waitcnt vmcnt(%0)" :: "i"(n) : "memory")
#define SLOAD_H(Kp, Vp, k0) do { S.st_v0 = load8<TIn>(ROW(Vp, k0, sr)); S.st_v1 = load8<TIn>(ROW(Vp, k0, 32 + sr));              \
                         S.st_k0 = load8<TIn>(ROW(Kp, k0, sr)); S.st_k1 = load8<TIn>(ROW(Kp, k0, 32 + sr)); } while (0)
#define SWRITE_HK(bf) do { *(bf16x8*)(K_lds + (bf) * SHM_K + kws) = S.st_k0; *(bf16x8*)(K_lds + (bf) * SHM_K + kws + 32 * 256) = S.st_k1; } while (0)
#define SWRITE_HV(bf) do { *(bf16x8*)(V_lds + (bf) * SHM_V + vst0) = S.st_v0; *(bf16x8*)(V_lds + (bf) * SHM_V + vst1) = S.st_v1; } while (0)
#define SWRITE_H(bf) do { SWRITE_HV(bf); SWRITE_HK(bf); } while (0)
#define SLOAD_F(p, k0) do { S.sf0 = *(const f32x4*)ROW(p, k0, sr); S.sf1 = *(const f32x4*)(ROW(p, k0, sr) + 4);                \
                            S.sf2 = *(const f32x4*)ROW(p, k0, 32 + sr); S.sf3 = *(const f32x4*)(ROW(p, k0, 32 + sr) + 4); } while (0)
#define SWRITE_KF(bf) do { *(bf16x8*)(K_lds + (bf) * SHM_K + kws) = pack8(S.sf0, S.sf1); *(bf16x8*)(K_lds + (bf) * SHM_K + kws + 32 * 256) = pack8(S.sf2, S.sf3); } while (0)
#define SWRITE_VF(bf) do { *(bf16x8*)(V_lds + (bf) * SHM_V + vst0) = pack8(S.sf0, S.sf1); *(bf16x8*)(V_lds + (bf) * SHM_V + vst1) = pack8(S.sf2, S.sf3); } while (0)
template <class TIn, class TOut>
__device__ __forceinline__ void causal_swa_prime(const BlockRef<TIn, TOut>& cur, int W, char* lds, Seam<TIn>& S) {
    constexpr bool F32 = same_t<TIn, float>::v;
    const int tid = ltid(), wid = __builtin_amdgcn_readfirstlane(tid >> 6), lane = tid & 63, r32 = lane & 31, hi = lane >> 5;
    const int sr = tid >> 4, sc = (tid & 15) * 8, kws = KSWZ(sr, sc * 2); char* K_lds = lds + 2 * SHM_V;
    const int kb0 = swa_jlo(cur.P0, W) * KVBLK;
    for (int d0 = 0; d0 < 8; ++d0) S.qr[d0] = load8<TIn>(cur.Q + (size_t)(wid * QBLK + r32) * D + d0 * 16 + hi * 8);
    if constexpr (F32) { SLOAD_F((const float*)cur.K, kb0); VMW(); SWRITE_KF(0); SBAR(); SLOAD_F((const float*)cur.V, kb0); }
    else { SLOAD_H(cur.K, cur.V, kb0); VMW(); SWRITE_HK(0); }
    __syncthreads();
}
template <class TIn, class TOut>
__device__ __forceinline__ void causal_swa_block(const BlockRef<TIn, TOut>& cur, const BlockRef<TIn, TOut>& nxt, int skv, int W, char* lds, Seam<TIn>& S) {
    constexpr bool F32 = same_t<TIn, float>::v;
    const int tid = ltid(), wid = __builtin_amdgcn_readfirstlane(tid >> 6), lane = tid & 63, r32 = lane & 31, hi = lane >> 5;
    const int j_lo = swa_jlo(cur.P0, W);
    int j_hi = (cur.P0 + QB - 1) / KVBLK + 1; if (j_hi > skv / KVBLK) j_hi = skv / KVBLK;
    const int NT = j_hi - j_lo;
    const int kbn = swa_jlo(nxt.P0, W) * KVBLK;
    const int qlo = cur.P0 + wid * QBLK, qm = qlo + r32 - 4 * hi;
    char* V_lds = lds; char* K_lds = lds + 2 * SHM_V;
    float* ws = (float*)(lds + 2 * SHM_V + 2 * SHM_K) + wid * 64; float* li_l = ws, * al_l = ws + 32;
    float m_reg = -1e30f, l_reg = 0; f32x16 o[4] = {};
    float* fbuf = (float*)(lds + LDS_FB);
    { const int nk = cur.P0 + QB;
      for (int i4 = tid * 4; i4 < nk; i4 += 64 * NW * 4) *(f32x4*)(fbuf + i4) = *(const f32x4*)(cur.FB + i4);
      __syncthreads(); }
    const char* fbl = (const char*)fbuf + hi * 16;
    const int sr = tid >> 4, sc = (tid & 15) * 8, vst0 = v_st(sr, sc), vst1 = v_st(32 + sr, sc), kws = KSWZ(sr, sc * 2);
    const int vb0 = (int)(uintptr_t)V_lds + v_rd_base(lane);
    const TIn* Kh = cur.K; const TIn* Vh = cur.V;
#define RESC(a) do { if (__any((a) < 1.f)) { if (hi == 0) al_l[r32] = (a); asm volatile("s_waitcnt lgkmcnt(0)" ::: "memory");              \
                     for (int d_ = 0; d_ < 4; ++d_) for (int r = 0; r < 16; ++r) o[d_][r] *= al_l[crow(r, hi)]; } } while (0)
#define KBASE(t) ((j_lo + (t)) * KVBLK)
#define ACT(t) (KBASE(t) <= qlo + QBLK - 1 && KBASE(t) + KVBLK - 1 >= qlo - W + 1)
#define MASKT(P0_, P1_, t) do { const int kb_ = KBASE(t); if ((!SK || ACT(t)) && (kb_ + KVBLK - 1 > qlo || kb_ <= qlo + QBLK - 1 - W)) mask_tile(P0_, P1_, qm - kb_, (unsigned)W); } while (0)
    constexpr int NQL = F32 ? 16 : 8;
    constexpr bool SK = WSKIP && !F32;
#define SEAM_K0() do { VMWN(NQL); if constexpr (F32) { SWRITE_KF(0); SBAR(); SLOAD_F((const float*)nxt.V, kbn); } else { SWRITE_HK(0); } SBAR(); } while (0)
    f32x16 pA0, pA1, pB0, pB1; float mnA, mnB, alA, alB; bf16x8 pa0, pa1, pa2, pa3;
    if constexpr (F32) { VMW(); SWRITE_VF(0); SBAR(); } else { SWRITE_HV(0); SBAR(); }
    if (NT > 1) { if constexpr (F32) SLOAD_F((const float*)Kh, KBASE(1)); else SLOAD_H(Kh, Vh, KBASE(1)); }
    SBAR(); qkt<0, SK>(pA0, pA1, K_lds, r32, hi, S.qr, ACT(0), fbl + KBASE(0) * 4);
    if constexpr (F32) { if (NT > 1) { VMW(); SWRITE_KF(1); SBAR(); SLOAD_F((const float*)Vh, KBASE(1)); } }
    MASKT(pA0, pA1, 0); partialSM(pA0, pA1, m_reg, mnA, alA);
    if (NT > 1) { VMW(); if constexpr (F32) { SWRITE_VF(1); SBAR(); if (NT > 2) SLOAD_F((const float*)Kh, KBASE(2)); } else SWRITE_H(1); }
    __syncthreads();
#define HALF_STEP(PX0, PX1, mnX, alX, PY0, PY1, alY, t, KB, VB, SB) do {                                                      \
        SBAR(); qkt<KB, SK>(PX0, PX1, K_lds, r32, hi, S.qr, ACT(t), fbl + KBASE(t) * 4);                                             \
        finishSM(PY0, PY1, alY, l_reg, pa0, pa1, pa2, pa3); SBAR();                                                           \
        if ((t) + 1 < NT) { if constexpr (F32) { VMW(); SWRITE_KF(SB); SBAR(); SLOAD_F((const float*)Vh, KBASE((t) + 1)); }  \
                            else { SLOAD_H(Kh, Vh, KBASE((t) + 1)); } SBAR(); }                                               \
        pv_tile<VB, SK>(o, vb0, pa0, pa1, pa2, pa3, ACT((t) - 1)); MASKT(PX0, PX1, (t)); partialSM(PX0, PX1, m_reg, mnX, alX);                                        \
        __syncthreads();                                                                                                      \
        if ((t) + 1 < NT) { VMW(); if constexpr (F32) { SWRITE_VF(SB); SBAR(); if ((t) + 2 < NT) SLOAD_F((const float*)Kh, KBASE((t) + 2)); } \
                            else { SWRITE_H(SB); } }                                                                          \
        RESC(alX); __syncthreads(); } while (0)
    for (int t = 1; t + 1 < NT; t += 2) {
        HALF_STEP(pB0, pB1, mnB, alB, pA0, pA1, alA, t, 1, 0, 0);
        HALF_STEP(pA0, pA1, mnA, alA, pB0, pB1, alB, t + 1, 0, 1, 1);
    }
    const bool even = (NT & 1) == 0;
    if (even) { SBAR(); qkt<1, SK>(pB0, pB1, K_lds, r32, hi, S.qr, ACT(NT - 1), fbl + KBASE(NT - 1) * 4); SBAR(); }
#define QROW(e) (nxt.Q + (size_t)(wid * QBLK + r32) * D + ((e) >> 1) * 16 + hi * 8 + ((e) & 1) * 4)
    if constexpr (F32) { SLOAD_F((const float*)nxt.K, kbn); SBAR();
#pragma unroll
        for (int e = 0; e < 8; ++e) S.tq[e] = *(const f32x4*)QROW(e); }
    else { SLOAD_H(nxt.K, nxt.V, kbn); SBAR();
#pragma unroll
        for (int d0 = 0; d0 < 8; ++d0) S.qr[d0] = load8<TIn>(nxt.Q + (size_t)(wid * QBLK + r32) * D + d0 * 16 + hi * 8); }
    SBAR();
    finishSM(pA0, pA1, alA, l_reg, pa0, pa1, pa2, pa3); SBAR();
    if constexpr (F32) {
#pragma unroll
        for (int e = 8; e < 16; ++e) S.tq[e] = *(const f32x4*)QROW(e); SBAR(); }
#undef QROW
    pv_tile<0, SK>(o, vb0, pa0, pa1, pa2, pa3, ACT(even ? NT - 2 : NT - 1));
    if (even) { MASKT(pB0, pB1, NT - 1); partialSM(pB0, pB1, m_reg, mnB, alB); __syncthreads(); RESC(alB);
        finishSM(pB0, pB1, alB, l_reg, pa0, pa1, pa2, pa3); SBAR(); pv_tile<1, SK>(o, vb0, pa0, pa1, pa2, pa3, ACT(NT - 1)); }
    SBAR(); SEAM_K0();
    if (hi == 0) li_l[r32] = l_reg; asm volatile("s_waitcnt lgkmcnt(0)" ::: "memory");
    float rli[16];
#pragma unroll
    for (int r = 0; r < 16; ++r) rli[r] = __builtin_amdgcn_rcpf(li_l[crow(r, hi)]);
    TOut* Ow = cur.O + (size_t)(wid * QBLK) * OPITCH;
#pragma unroll
    for (int r = 0; r < 16; ++r) { const int orow = crow(r, hi);
#pragma unroll
        for (int d0 = 0; d0 < 4; ++d0) { const float v = o[d0][r] * rli[r];
            if constexpr (same_t<TOut, float>::v) { Ow[(size_t)orow * OPITCH + d0 * 32 + r32] = v; }
            else { const float vn = __shfl_xor(v, 1);
                   if ((r32 & 1) == 0) *(unsigned*)(Ow + (size_t)orow * OPITCH + d0 * 32 + r32) = cvtpk(v, vn); } } }
    if constexpr (F32) {
#pragma unroll
        for (int d0 = 0; d0 < 8; ++d0) S.qr[d0] = pack8(S.tq[2 * d0], S.tq[2 * d0 + 1]); }
    __syncthreads();
#undef RESC
#undef KBASE
#undef ACT
#undef MASKT
#undef SEAM_K0
#undef HALF_STEP
}
#undef ROW
#undef VMW
#undef VMWN
#undef SLOAD_H
#undef SWRITE_HK
#undef SWRITE_HV
#undef SWRITE_H
#undef SLOAD_F
#undef SWRITE_KF
#undef SWRITE_VF
constexpr int NQB = SQ / QB, NXI = NQB / 2, NITEMS = NXI * B * H;
struct SwaItem { int bh, qb0, qb1; };
__device__ __forceinline__ SwaItem swa_decode(int L) { SwaItem it; it.bh = L / NXI; const int x = L - it.bh * NXI; it.qb0 = x; it.qb1 = NQB - 1 - x; return it; }
template <class TIn, class TOut>
__device__ __forceinline__ BlockRef<TIn, TOut> swa_ref(const SwaItem& it, int pass, const TIn* Q, const TIn* K, const TIn* V, TOut* O, const float* FB) {
    const int qb = pass ? it.qb1 : it.qb0;
    BlockRef<TIn, TOut> r;
    r.Q = Q + ((size_t)it.bh * SQ + (size_t)qb * QB) * D;
    r.O = O + ((size_t)(it.bh / H) * SQ + (size_t)qb * QB) * OPITCH + (it.bh % H) * D;
    r.K = K + (size_t)it.bh * SKV * D; r.V = V + (size_t)it.bh * SKV * D; r.FB = FB + (size_t)it.bh * SKV; r.P0 = qb * QB;
    return r;
}
__device__ __forceinline__ void att_phase(char* lds, const bf16* Q, const bf16* K, const bf16* V, bf16* O, const float* FB, int wg, int nwg) {
    int L = wg; if (L >= NITEMS) return;
    SwaItem it = swa_decode(L); int pass = 0;
    BlockRef<bf16, bf16> cur = swa_ref<bf16, bf16>(it, 0, Q, K, V, O, FB);
    Seam<bf16> S;
    causal_swa_prime<bf16, bf16>(cur, WINDOW, lds, S);
    for (;;) {
        const bool more_pass = pass == 0 && it.qb1 != it.qb0, more_item = L + nwg < NITEMS, last = !more_pass && !more_item;
        SwaItem itn = it; int passn = pass + 1, Ln = L;
        if (!more_pass) { passn = 0; Ln = more_item ? L + nwg : L; itn = swa_decode(Ln); }
        const BlockRef<bf16, bf16> nxt = last ? cur : swa_ref<bf16, bf16>(itn, passn, Q, K, V, O, FB);
        causal_swa_block<bf16, bf16>(cur, nxt, SKV, WINDOW, lds, S);
        if (last) break;
        cur = nxt; it = itn; pass = passn; L = Ln;
    }
}
}
constexpr int DM = 2048, NBATCH = 8, SEQ = 4096, DEPTH = 4, NHEAD = 16, HDIM = 128, DFF = 5504, NFF2 = 2 * DFF, MTOK = NBATCH * SEQ;
constexpr int NQKVF = 3 * DM + NHEAD;
constexpr float EPS = 1e-6f;
constexpr int NWAVES = 8;
#ifndef MK_PER_PHASE
#define MK_PER_PHASE 0
#endif
constexpr size_t MiB = 1u << 20;
constexpr size_t WS_CTL = 0, CTL_ZERO_BYTES = 3 * MiB + 512 * 1024;
constexpr size_t WS_RSS = 1 * MiB;
constexpr size_t WS_VSS = 3 * MiB;
constexpr size_t WS_MOD = 3 * MiB + 512 * 1024;
constexpr size_t WS_SHT = 5 * MiB;
constexpr size_t WS_BIASV = 5 * MiB + 512 * 1024;
constexpr size_t WS_LOGF = 7 * MiB + 512 * 1024;
constexpr size_t WS_FB = 9 * MiB + 512 * 1024;
constexpr size_t WS_WQKV = 12 * MiB;
constexpr size_t WQKV_STRIDE = 25 * MiB / 2;
constexpr size_t WS_WO = 62 * MiB;
constexpr size_t WS_WGI = 78 * MiB;
constexpr size_t WS_WGO = 110 * MiB;
constexpr size_t WS_WF1 = 126 * MiB;
constexpr size_t WS_WF2 = 298 * MiB;
constexpr size_t WS_H = 384 * MiB;
constexpr size_t WS_H2 = 512 * MiB;
constexpr size_t WS_XB = 640 * MiB;
constexpr size_t WS_R = 768 * MiB;
constexpr size_t WS_END = WS_R + 384 * MiB;
constexpr int BV_QKVF = 0, BV_GI = 2 * 8 * NQKVF, BV_F1 = BV_GI + 2 * 8 * 4096;
constexpr int CW_TMO = 0, CW_BAR = 4096;

constexpr int RING_OFF = 0, RING_BYTES = 131072, XCH_OFF = 131072;
constexpr int LDSCTL_OFF = 146432, MISC_OFF = LDSCTL_OFF + 320;
constexpr int LDS_BYTES = 147456;

#define GAS __attribute__((address_space(1)))
#define LAS __attribute__((address_space(3)))
typedef unsigned short bf16;
typedef unsigned v4u __attribute__((ext_vector_type(4)));
typedef unsigned v2u __attribute__((ext_vector_type(2)));
typedef float f32x4 __attribute__((ext_vector_type(4)));
typedef short bf16x8 __attribute__((ext_vector_type(8)));
typedef GAS unsigned gu32;
typedef unsigned long long u64;
constexpr float FIXS = 1048576.0f, FIXI = 1.0f / (1048576.0f * 2048.0f);
__device__ __forceinline__ float rstd_of(u64 v) { return __builtin_amdgcn_rsqf((float)v * FIXI + 1e-6f); }
#define RLX_AGENT __ATOMIC_RELAXED, __HIP_MEMORY_SCOPE_AGENT
#define LDS_WAIT() asm volatile("s_waitcnt lgkmcnt(0)" ::: "memory")
#define VM_WAIT() asm volatile("s_waitcnt vmcnt(0)" ::: "memory")
__device__ __forceinline__ unsigned f2bf(float f) { unsigned u = __builtin_bit_cast(unsigned, f); return (u + 0x7fffu + ((u >> 16) & 1u)) >> 16; }
__device__ __forceinline__ unsigned pk2(float lo, float hi) { return f2bf(lo) | (f2bf(hi) << 16); }
__device__ __forceinline__ float bf2f(unsigned short b) { return __builtin_bit_cast(float, (unsigned)b << 16); }
__device__ __forceinline__ float bflo(unsigned w) { return __builtin_bit_cast(float, w << 16); }
__device__ __forceinline__ float bfhi(unsigned w) { return __builtin_bit_cast(float, w & 0xffff0000u); }
#define XB_TMO      128
#define XB_XCNT(j)  (256  + 64 * (j))
#define XB_XSUB(j)  (1280 + 64 * (j))
#define XB_XGEN(j)  (2304 + 64 * (j))
#define XB_TOP      3328
#define XB_TOPGEN   3392
#define XCD_BAR_WORDS 3456
#define XB_SPIN_CAP (1u << 18)

__device__ __forceinline__ unsigned xb_ld(unsigned* p)              { return __hip_atomic_load((GAS unsigned*)p, __ATOMIC_RELAXED, __HIP_MEMORY_SCOPE_AGENT); }
__device__ __forceinline__ unsigned xb_add(unsigned* p, unsigned v) { return __hip_atomic_fetch_add((GAS unsigned*)p, v, __ATOMIC_RELAXED, __HIP_MEMORY_SCOPE_AGENT); }
__device__ __forceinline__ unsigned xb_xcc_id() { return (unsigned)__builtin_amdgcn_s_getreg((3 << 11) | 20) & 0xFu; }
#define XB_SPIN(cond, bar) do { unsigned _sp = 0; while (cond) { __builtin_amdgcn_s_sleep(1); \
    if ((++_sp & 255u) == 0u) { if (xb_ld(&(bar)[XB_TMO])) break; if (_sp > XB_SPIN_CAP) { xb_add(&(bar)[XB_TMO], 1u); break; } } } } while (0)

struct XcdBarrier {
    unsigned* bar; unsigned x;
    volatile LAS unsigned* st;
};

__device__ __forceinline__ XcdBarrier xcd_barrier_post(unsigned* bar, volatile LAS unsigned* st) {
    XcdBarrier b; b.bar = bar; b.x = xb_xcc_id(); b.st = st;
    if (threadIdx.x == 0) (void)xb_add(&bar[XB_XCNT(b.x)], 1u);
    return b;
}
__device__ __forceinline__ void xcd_barrier_complete(unsigned* bar, unsigned x, unsigned& nloc, unsigned& nx) {
    const unsigned G = gridDim.x * gridDim.y * gridDim.z;
    unsigned sum, cnt, mine, sp = 0u;
    for (;;) {
        sum = 0u; cnt = 0u; mine = 0u;
#pragma unroll
        for (unsigned j = 0; j < 16; ++j) { const unsigned c = xb_ld(&bar[XB_XCNT(j)]); sum += c; cnt += (c > 0u) ? 1u : 0u; mine = (j == x) ? c : mine; }
        if (sum == G) break;
        __builtin_amdgcn_s_sleep(1);
        if ((++sp & 255u) == 0u) { if (xb_ld(&bar[XB_TMO])) break; if (sp > XB_SPIN_CAP) { xb_add(&bar[XB_TMO], 1u); break; } }
    }
    nloc = mine > 0u ? mine : 1u; nx = cnt > 0u ? cnt : 1u;
}

__device__ __forceinline__ void xcd_barrier(const XcdBarrier& b) {
    asm volatile("s_waitcnt vmcnt(0)" ::: "memory");
    __syncthreads();
    if (threadIdx.x == 0) {
        unsigned* bar = b.bar;
        __builtin_amdgcn_s_waitcnt(0);
        unsigned nloc = b.st[0], nx = b.st[1];
        if (nloc == 0u) { xcd_barrier_complete(bar, b.x, nloc, nx); b.st[0] = nloc; b.st[1] = nx; }
        const unsigned old = xb_add(&bar[XB_XSUB(b.x)], 1u);
        const unsigned gen = old / nloc;
        if (old + 1u == (gen + 1u) * nloc) {
            __builtin_amdgcn_fence(__ATOMIC_RELEASE, "agent");
            asm volatile("s_waitcnt vmcnt(0)" ::: "memory");
            const unsigned og = xb_add(&bar[XB_TOP], 1u);
            const unsigned tg = og / nx;
            if (og + 1u == (tg + 1u) * nx) xb_add(&bar[XB_TOPGEN], 1u);
            else XB_SPIN(xb_ld(&bar[XB_TOPGEN]) == tg, bar);
            __builtin_amdgcn_fence(__ATOMIC_ACQUIRE, "agent");
            xb_add(&bar[XB_XGEN(b.x)], 1u);
            asm volatile("s_waitcnt vmcnt(0)" ::: "memory");
        } else {
            XB_SPIN(xb_ld(&bar[XB_XGEN(b.x)]) == gen, bar);
            __builtin_amdgcn_fence(__ATOMIC_ACQUIRE, "agent");
            asm volatile("s_waitcnt vmcnt(0)" ::: "memory");
        }
    }
    __syncthreads();
}
struct Frame {
    LAS unsigned char* lds; char* ldsg;
    volatile LAS unsigned* MISC;
    int tid, lane, wave, vcu, G, bid;
    const GAS float* const __attribute__((address_space(4)))* inp;
    GAS float* outg; GAS unsigned char* wsg;
    __device__ __forceinline__ const float* in(int i) const { return (const float*)inp[i]; }
};
enum { IN_X = 0, IN_C, IN_MODW, IN_MODB, IN_MIXG, IN_FFNG, IN_AWIN, IN_ABF, IN_AWO, IN_GWIN, IN_GVG, IN_GWS, IN_GBS, IN_GWO, IN_FWIN, IN_FCW, IN_FCB, IN_FWOUT, IN_FING };
enum { MW_BID = 16, MW_G, MW_VCU, MW_INP, MW_INP_HI, MW_WS, MW_WS_HI, MW_OUT, MW_OUT_HI };
__device__ __forceinline__ unsigned misc_rd(const Frame& F, int k) { return (unsigned)__builtin_amdgcn_readfirstlane((int)F.MISC[k]); }
__device__ __forceinline__ bool relaunder(Frame& F) {
    int t = (int)threadIdx.x; asm volatile("" : "+v"(t)); F.tid = t; F.lane = t & 63; F.wave = __builtin_amdgcn_readfirstlane(t >> 6);
    F.bid = (int)misc_rd(F, MW_BID); F.G = (int)misc_rd(F, MW_G); F.vcu = (int)misc_rd(F, MW_VCU);
    F.inp = (const GAS float* const __attribute__((address_space(4)))*)(((unsigned long long)misc_rd(F, MW_INP_HI) << 32) | misc_rd(F, MW_INP));
    F.wsg = (GAS unsigned char*)(((unsigned long long)misc_rd(F, MW_WS_HI) << 32) | misc_rd(F, MW_WS));
    F.outg = (GAS float*)(((unsigned long long)misc_rd(F, MW_OUT_HI) << 32) | misc_rd(F, MW_OUT));
    return true; }
__device__ __forceinline__ float wave_sum(float v) {
#pragma unroll
    for (int o = 1; o < 64; o <<= 1) v += __shfl_xor(v, o);
    return v;
}
__device__ __forceinline__ void transpose_item(const float* W, int ldw, int K, bf16* WT, int k0, int n0, int dst_row0, int ncols, LAS float* scr, int lane) {
    const int nl = lane & 31;
#pragma unroll 8
    for (int i = 0; i < 32; ++i) { const int kk = 2 * i + (lane >> 5); if (nl < ncols) scr[kk * 33 + nl] = W[(size_t)(k0 + kk) * ldw + n0 + nl]; }
    LDS_WAIT(); asm volatile("" ::: "memory");
    const int c = lane & 7;
#pragma unroll
    for (int j = 0; j < 4; ++j) { const int n = (lane >> 3) + 8 * j; const LAS float* s = scr + (8 * c) * 33 + n;
        if (n < ncols) { v4u o; o.x = pk2(s[0 * 33], s[1 * 33]); o.y = pk2(s[2 * 33], s[3 * 33]); o.z = pk2(s[4 * 33], s[5 * 33]); o.w = pk2(s[6 * 33], s[7 * 33]);
            *(GAS v4u*)(WT + (size_t)(dst_row0 + n) * K + k0 + 8 * c) = o; } }
    LDS_WAIT(); asm volatile("" ::: "memory");
}
__device__ __forceinline__ void pro_a_phase(Frame& F) {
    __syncthreads();
    {
        LAS float* cact = (LAS float*)(F.lds + RING_OFF);
        LAS float* red = (LAS float*)(F.lds + RING_OFF + 65536);
        float* mod = (float*)((unsigned char*)F.wsg + WS_MOD); float* sht = (float*)((unsigned char*)F.wsg + WS_SHT);
        for (int item = F.bid; item < 192; item += F.G) {
            for (int idx = F.tid; idx < NBATCH * DM; idx += NWAVES * 64) { const int b = idx >> 11, k = idx & 2047; const float v = F.in(IN_C)[idx]; cact[k * 8 + b] = v / (1.0f + __expf(-v)); }
            __syncthreads();
            const int i = item / 48, nbase = (item % 48) * 256;
            const float* wp = F.in(IN_MODW) + ((size_t)i * DM + F.wave * 256) * 12288 + nbase + F.lane * 4;
            f32x4 acc[8];
#pragma unroll
            for (int b = 0; b < 8; ++b) acc[b] = (f32x4){0.f, 0.f, 0.f, 0.f};
#pragma unroll 8
            for (int kk = 0; kk < 256; ++kk) {
                const f32x4 w = *(const GAS f32x4*)(wp + (size_t)kk * 12288);
                const LAS f32x4* cp = (const LAS f32x4*)(cact + (F.wave * 256 + kk) * 8);
                const f32x4 c0 = cp[0], c1 = cp[1];
                acc[0] += w * c0.x; acc[1] += w * c0.y; acc[2] += w * c0.z; acc[3] += w * c0.w;
                acc[4] += w * c1.x; acc[5] += w * c1.y; acc[6] += w * c1.z; acc[7] += w * c1.w;
            }
#pragma unroll
            for (int b = 0; b < 8; ++b) *(LAS f32x4*)(red + (F.wave * 8 + b) * 256 + F.lane * 4) = acc[b];
            __syncthreads();
            for (int o = F.tid; o < 2048; o += NWAVES * 64) { const int b = o >> 8, col = o & 255, gc = nbase + col; float s = 0.f;
#pragma unroll
                for (int w = 0; w < 8; ++w) s += red[(w * 8 + b) * 256 + col];
                s += F.in(IN_MODB)[i * 12288 + gc];
                mod[((size_t)i * 8 + b) * 12288 + gc] = s;
                if (gc < DM) sht[((size_t)(2 * i) * DM + gc) * 8 + b] = s;
                else if (gc >= 3 * DM && gc < 4 * DM) sht[((size_t)(2 * i + 1) * DM + (gc - 3 * DM)) * 8 + b] = s; }
            __syncthreads();
        }
    }
    LAS float* scr = (LAS float*)(F.lds + RING_OFF + F.wave * 16384);
    const int gw = F.vcu * NWAVES + F.wave, NGW = F.G * NWAVES;
    constexpr int I_O = 32 * 64, I_GO = 32 * 64, I_F2 = 86 * 64;
    constexpr int NITEMS = 2 * (I_O + I_GO) + 4 * I_F2;
    bf16* Wo = (bf16*)((unsigned char*)F.wsg + WS_WO); bf16* Wgo = (bf16*)((unsigned char*)F.wsg + WS_WGO); bf16* Wf2 = (bf16*)((unsigned char*)F.wsg + WS_WF2);
    for (int it = gw; it < NITEMS; it += NGW) {
        int r = it;
        if (r < 2 * I_O) { const int j = r / I_O, q = r % I_O, kb = q / 64, nb = q % 64;
            transpose_item(F.in(IN_AWO) + (size_t)j * DM * DM, DM, DM, Wo + (size_t)j * DM * DM, 64 * kb, 32 * nb, 32 * nb, 32, scr, F.lane); continue; } r -= 2 * I_O;
        if (r < 2 * I_GO) { const int j = r / I_GO, q = r % I_GO, kb = q / 64, nb = q % 64;
            transpose_item(F.in(IN_GWO) + (size_t)j * DM * DM, DM, DM, Wgo + (size_t)j * DM * DM, 64 * kb, 32 * nb, 32 * nb, 32, scr, F.lane); continue; } r -= 2 * I_GO;
        { const int j = r / I_F2, q = r % I_F2, kb = q / 64, nb = q % 64;
            transpose_item(F.in(IN_FWOUT) + (size_t)j * DFF * DM, DM, DFF, Wf2 + (size_t)j * DM * DFF, 64 * kb, 32 * nb, 32 * nb, 32, scr, F.lane); }
    }
}
__device__ __forceinline__ void strip_item(const float* W, int ldw, bf16* WT, int n0, int dst_row0, int ncols, const float* sht, float* bias, int bpitch, LAS float* scr, int lane) {
    const int nl = lane & 31, bh = lane >> 5, c = lane & 7;
    f32x4 acc = (f32x4){0.f, 0.f, 0.f, 0.f};
    for (int kb = 0; kb < DM / 64; ++kb) { const int k0 = 64 * kb;
#pragma unroll 8
        for (int i = 0; i < 32; ++i) { const int kk = 2 * i + (lane >> 5); if (nl < ncols) scr[kk * 33 + nl] = W[(size_t)(k0 + kk) * ldw + n0 + nl]; }
        LDS_WAIT(); asm volatile("" ::: "memory");
#pragma unroll
        for (int j = 0; j < 4; ++j) { const int n = (lane >> 3) + 8 * j; const LAS float* s = scr + (8 * c) * 33 + n;
            if (n < ncols) { v4u o; o.x = pk2(s[0 * 33], s[1 * 33]); o.y = pk2(s[2 * 33], s[3 * 33]); o.z = pk2(s[4 * 33], s[5 * 33]); o.w = pk2(s[6 * 33], s[7 * 33]);
                *(GAS v4u*)(WT + (size_t)(dst_row0 + n) * DM + k0 + 8 * c) = o; } }
        const GAS f32x4* sp = (const GAS f32x4*)(sht + (size_t)k0 * 8 + 4 * bh);
#pragma unroll 8
        for (int kk = 0; kk < 64; ++kk) acc += sp[kk * 2] * scr[kk * 33 + nl];
        LDS_WAIT(); asm volatile("" ::: "memory");
    }
    if (nl < ncols) {
#pragma unroll
        for (int e = 0; e < 4; ++e) bias[(size_t)(4 * bh + e) * bpitch + n0 + nl] = acc[e]; }
}
__device__ __forceinline__ void pro_b_phase(Frame& F) {
    LAS float* scr = (LAS float*)(F.lds + RING_OFF + F.wave * 16384);
    const int gw = F.vcu * NWAVES + F.wave, NGW = F.G * NWAVES;
    constexpr int S_QKV = 193, S_GI = 128, S_F1 = 344, NSTRIPS = 2 * (S_QKV + S_GI) + 4 * S_F1;
    const float* sht = (const float*)((unsigned char*)F.wsg + WS_SHT); float* bv = (float*)((unsigned char*)F.wsg + WS_BIASV);
    bf16* Wqkv = (bf16*)((unsigned char*)F.wsg + WS_WQKV); bf16* Wgi = (bf16*)((unsigned char*)F.wsg + WS_WGI); bf16* Wf1 = (bf16*)((unsigned char*)F.wsg + WS_WF1);
    for (int it = gw; it < NSTRIPS; it += NGW) {
        int r = it;
        if (r < 2 * S_QKV) { const int j = r / S_QKV, nb = r % S_QKV;
            strip_item(F.in(IN_AWIN) + (size_t)j * DM * NQKVF, NQKVF, Wqkv + (size_t)j * WQKV_STRIDE, 32 * nb, 32 * nb, nb == 192 ? 16 : 32, sht + (size_t)(4 * j) * DM * 8, bv + BV_QKVF + (size_t)j * 8 * NQKVF, NQKVF, scr, F.lane); continue; } r -= 2 * S_QKV;
        if (r < 2 * S_GI) { const int j = r / S_GI, nb = r % S_GI;
            strip_item(F.in(IN_GWIN) + (size_t)j * DM * 4096, 4096, Wgi + (size_t)j * 4096 * DM, 32 * nb, 32 * nb, 32, sht + (size_t)(4 * j + 2) * DM * 8, bv + BV_GI + (size_t)j * 8 * 4096, 4096, scr, F.lane); continue; } r -= 2 * S_GI;
        { const int i = r / S_F1, nb = r % S_F1, n0 = 32 * nb, isup = n0 >= DFF, cch = n0 - isup * DFF;
            strip_item(F.in(IN_FWIN) + (size_t)i * DM * NFF2, NFF2, Wf1 + (size_t)i * NFF2 * DM, n0, 256 * (cch >> 7) + 128 * isup + (cch & 127), 32, sht + (size_t)(2 * i + 1) * DM * 8, bv + BV_F1 + (size_t)i * 8 * NFF2, NFF2, scr, F.lane); }
    }
}
__device__ __forceinline__ void xg0_phase(Frame& F, const float* xin, const float* g, const float* scale, bf16* XG, bf16* XB, u64* rss) {
    const int gw = F.vcu * NWAVES + F.wave, NGW = F.G * NWAVES;
    for (int rb = gw; rb < MTOK / 16; rb += NGW) {
        const int b = (rb * 16) >> 12;
        f32x4 gs[8];
#pragma unroll
        for (int j = 0; j < 8; ++j) { const int c4 = F.lane + 64 * j; gs[j] = ((const GAS f32x4*)g)[c4] * (((const GAS f32x4*)(scale + (size_t)b * 12288))[c4] + 1.0f); }
        for (int r = 0; r < 16; ++r) { const size_t row = (size_t)rb * 16 + r;
            const GAS f32x4* xr = (const GAS f32x4*)(xin + row * DM) + F.lane;
            f32x4 v[8]; float ss = 0.f;
#pragma unroll
            for (int j = 0; j < 8; ++j) { v[j] = xr[64 * j]; ss += (v[j].x * v[j].x + v[j].y * v[j].y) + (v[j].z * v[j].z + v[j].w * v[j].w); }
            ss = wave_sum(ss); if (F.lane == 0) rss[row] = (u64)(ss * FIXS);
            GAS v2u* o8 = (GAS v2u*)(XG + row * DM) + F.lane; GAS v2u* x8 = (GAS v2u*)(XB + row * DM) + F.lane;
#pragma unroll
            for (int j = 0; j < 8; ++j) { const f32x4 o = v[j] * gs[j]; v2u w; w.x = pk2(o.x, o.y); w.y = pk2(o.z, o.w); o8[64 * j] = w; v2u q; q.x = pk2(v[j].x, v[j].y); q.y = pk2(v[j].z, v[j].w); x8[64 * j] = q; } }
    }
}
__device__ __forceinline__ void normf_phase(Frame& F, const bf16* XB, const float* g, float* out) {
    const int gw = F.vcu * NWAVES + F.wave, NGW = F.G * NWAVES;
    for (int rb = gw; rb < MTOK / 16; rb += NGW) {
        f32x4 gs[8];
#pragma unroll
        for (int j = 0; j < 8; ++j) gs[j] = ((const GAS f32x4*)g)[F.lane + 64 * j];
        for (int r = 0; r < 16; ++r) { const size_t row = (size_t)rb * 16 + r;
            const GAS v2u* xr = (const GAS v2u*)(XB + row * DM) + F.lane; GAS f32x4* orow = (GAS f32x4*)(out + row * DM) + F.lane;
            f32x4 v[8]; float ss = 0.f;
#pragma unroll
            for (int j = 0; j < 8; ++j) { const v2u w = xr[64 * j]; v[j] = (f32x4){bflo(w.x), bfhi(w.x), bflo(w.y), bfhi(w.y)}; ss += (v[j].x * v[j].x + v[j].y * v[j].y) + (v[j].z * v[j].z + v[j].w * v[j].w); }
            const float rstd = 1.0f / sqrtf(wave_sum(ss) * (1.0f / DM) + EPS);
#pragma unroll
            for (int j = 0; j < 8; ++j) orow[64 * j] = v[j] * rstd * gs[j]; }
    }
}
__device__ __forceinline__ void fg_phase(Frame& F, const bf16* XG, const bf16* Wf, const float* bfv, const u64* rss, const float* biasf  , float* LOGF) {
    const int gw = F.vcu * NWAVES + F.wave, NGW = F.G * NWAVES, fr = F.lane & 15, fq = F.lane >> 4;
    for (int rb = gw; rb < MTOK / 16; rb += NGW) {
        const GAS bf16x8* ap = (const GAS bf16x8*)(XG + ((size_t)rb * 16 + fr) * DM + fq * 8);
        const GAS bf16x8* bp = (const GAS bf16x8*)(Wf + (size_t)fr * DM + fq * 8);
        f32x4 acc = (f32x4){0.f, 0.f, 0.f, 0.f};
#pragma unroll 8
        for (int ks = 0; ks < 64; ++ks) acc = __builtin_amdgcn_mfma_f32_16x16x32_bf16(bp[ks * 4], ap[ks * 4], acc, 0, 0, 0);
        const int b = (rb * 16) >> 12; const float rs = rstd_of(rss[(size_t)rb * 16 + fr]);
        const f32x4 bb = *(const GAS f32x4*)(bfv + 4 * fq) + *(const GAS f32x4*)(biasf + (size_t)b * NQKVF + 4 * fq); f32x4 o;
#pragma unroll
        for (int i = 0; i < 4; ++i) { const float z = acc[i] * rs + bb[i]; o[i] = fminf(z, 0.f) - log1pf(__expf(-fabsf(z))); }
        *(GAS f32x4*)(LOGF + ((size_t)rb * 16 + fr) * 16 + 4 * fq) = o;
    }
}
__device__ __forceinline__ void cum_phase(Frame& F, const float* LOGF, float* FB) {
    const int gw = F.vcu * NWAVES + F.wave, NGW = F.G * NWAVES;
    for (int bh = gw; bh < NBATCH * NHEAD; bh += NGW) { const int b = bh >> 4, h = bh & 15;
        const float* p = LOGF + ((size_t)b * SEQ + F.lane * 64) * 16 + h;
        float v[64]; float s = 0.f;
#pragma unroll
        for (int i = 0; i < 64; ++i) { s += p[i * 16]; v[i] = s; }
        float incl = s;
#pragma unroll
        for (int o = 1; o < 64; o <<= 1) { const float t = __shfl_up(incl, o); if (F.lane >= o) incl += t; }
        const float excl = incl - s;
        GAS f32x4* q = (GAS f32x4*)(FB + (size_t)bh * SEQ + F.lane * 64);
#pragma unroll
        for (int i = 0; i < 16; ++i) q[i] = (f32x4){-(excl + v[4 * i]) * 1.4426950408889634f, -(excl + v[4 * i + 1]) * 1.4426950408889634f, -(excl + v[4 * i + 2]) * 1.4426950408889634f, -(excl + v[4 * i + 3]) * 1.4426950408889634f};
    }
}
template <int VB>
__device__ __forceinline__ void gate_pv(fox::f32x16* o, int vb0, fox::bf16x8 pa0, fox::bf16x8 pa1, fox::bf16x8 pa2, fox::bf16x8 pa3) {
    using fox::s16x4; using fox::bf16x8;
#define TRRD(dst, off) asm volatile("ds_read_b64_tr_b16 %0, %1 offset:%2" : "=&v"(dst) : "v"(vb0), "i"(off) : "memory")
#define PV_D0(d0) do { s16x4 l0, l1, l2, l3, h0, h1, h2, h3; constexpr int b_ = VB * fox::SHM_V + fox::v_rd_off(d0, 0, 0); \
        TRRD(l0, b_); TRRD(h0, b_ + 2048); TRRD(l1, b_ + 4096); TRRD(h1, b_ + 6144); TRRD(l2, b_ + 8192); TRRD(h2, b_ + 10240); TRRD(l3, b_ + 12288); TRRD(h3, b_ + 14336); \
        asm volatile("s_waitcnt lgkmcnt(0)" ::: "memory"); __builtin_amdgcn_sched_barrier(0); \
        o[d0] = __builtin_amdgcn_mfma_f32_32x32x16_bf16((bf16x8){l0[0], l0[1], l0[2], l0[3], h0[0], h0[1], h0[2], h0[3]}, pa0, o[d0], 0, 0, 0);   \
        o[d0] = __builtin_amdgcn_mfma_f32_32x32x16_bf16((bf16x8){l1[0], l1[1], l1[2], l1[3], h1[0], h1[1], h1[2], h1[3]}, pa1, o[d0], 0, 0, 0);   \
        o[d0] = __builtin_amdgcn_mfma_f32_32x32x16_bf16((bf16x8){l2[0], l2[1], l2[2], l2[3], h2[0], h2[1], h2[2], h2[3]}, pa2, o[d0], 0, 0, 0);   \
        o[d0] = __builtin_amdgcn_mfma_f32_32x32x16_bf16((bf16x8){l3[0], l3[1], l3[2], l3[3], h3[0], h3[1], h3[2], h3[3]}, pa3, o[d0], 0, 0, 0); } while (0)
    PV_D0(0); PV_D0(1); PV_D0(2); PV_D0(3);
#undef PV_D0
#undef TRRD
}
__device__ __forceinline__ void gate_phase(Frame& F, const bf16* Z, const u64* VSS, const float* vg, const float* Ws, const float* bs, bf16* GT) {
    using fox::bf16x8; using fox::f32x16;
    const int r32 = F.lane & 31, hi = F.lane >> 5, c = F.wave >> 2, t0 = 32 * (F.wave & 3);
    const int vb0 = (int)(uintptr_t)(F.ldsg + RING_OFF) + c * 32768 + fox::v_rd_base(F.lane);
    bf16x8 aw[8]; int gcur = -1;
    for (int item = F.bid; item < (MTOK / 256) * 16; item += F.G) {
        const int g = item & 15, pnl = item >> 4; const size_t row0 = (size_t)pnl * 256;
        if (g != gcur) { gcur = g;
            const float* wr_ = Ws + ((size_t)g * 128 + t0 + r32) * 128 + 8 * hi;
#pragma unroll
            for (int ks = 0; ks < 8; ++ks) { const f32x4 a = *(const GAS f32x4*)(wr_ + 16 * ks), b = *(const GAS f32x4*)(wr_ + 16 * ks + 4); const int s0 = 16 * ks + 8 * hi; int t = t0 + r32; asm volatile("" : "+v"(t));
                v4u w; w.x = pk2(s0 + 0 <= t ? a.x : 0.f, s0 + 1 <= t ? a.y : 0.f); w.y = pk2(s0 + 2 <= t ? a.z : 0.f, s0 + 3 <= t ? a.w : 0.f);
                       w.z = pk2(s0 + 4 <= t ? b.x : 0.f, s0 + 5 <= t ? b.y : 0.f); w.w = pk2(s0 + 6 <= t ? b.z : 0.f, s0 + 7 <= t ? b.w : 0.f);
                aw[ks] = __builtin_bit_cast(bf16x8, w); } }
#pragma unroll 2
        for (int ps = 0; ps < 8; ++ps) { const int idx = ps * (NWAVES * 64) + F.tid, row = idx >> 4, c8 = (idx & 15) * 8, s = row & 127;
            const v4u w = *(const GAS v4u*)(Z + (row0 + row) * 4096 + 2048 + g * 128 + c8); const float rs = rstd_of(VSS[row0 + row]);
            const f32x4 g0 = *(const GAS f32x4*)(vg + g * 128 + c8), g1 = *(const GAS f32x4*)(vg + g * 128 + c8 + 4);
            v4u o; o.x = pk2(bflo(w.x) * rs * g0.x, bfhi(w.x) * rs * g0.y); o.y = pk2(bflo(w.y) * rs * g0.z, bfhi(w.y) * rs * g0.w);
                   o.z = pk2(bflo(w.z) * rs * g1.x, bfhi(w.z) * rs * g1.y); o.w = pk2(bflo(w.w) * rs * g1.z, bfhi(w.w) * rs * g1.w);
            *(LAS v4u*)(F.lds + RING_OFF + ((row >> 7) * 2 + (s >> 6)) * 16384 + fox::v_st(s & 63, c8)) = o; }
        __syncthreads();
        f32x16 o[4] = {};
        gate_pv<0>(o, vb0, aw[0], aw[1], aw[2], aw[3]);
        if (t0 >= 64) gate_pv<1>(o, vb0, aw[4], aw[5], aw[6], aw[7]);
        { const size_t grow = row0 + c * 128 + t0 + r32; const float bias = bs[g * 128 + t0 + r32];
          const GAS v2u* up = (const GAS v2u*)(Z + grow * 4096 + g * 128 + 4 * hi); GAS v4u* op = (GAS v4u*)(GT + grow * DM + g * 128 + 8 * hi);
#pragma unroll
          for (int d0 = 0; d0 < 4; ++d0) { float v[16];
#pragma unroll
            for (int q = 0; q < 4; ++q) { const v2u uw = up[d0 * 8 + q * 2];
                v[4 * q + 0] = bflo(uw.x) * (o[d0][4 * q + 0] + bias); v[4 * q + 1] = bfhi(uw.x) * (o[d0][4 * q + 1] + bias);
                v[4 * q + 2] = bflo(uw.y) * (o[d0][4 * q + 2] + bias); v[4 * q + 3] = bfhi(uw.y) * (o[d0][4 * q + 3] + bias); }
#pragma unroll
            for (int hf = 0; hf < 2; ++hf) { const unsigned a0 = fox::cvtpk(v[8 * hf + 0], v[8 * hf + 1]), a1 = fox::cvtpk(v[8 * hf + 2], v[8 * hf + 3]), b0 = fox::cvtpk(v[8 * hf + 4], v[8 * hf + 5]), b1 = fox::cvtpk(v[8 * hf + 6], v[8 * hf + 7]);
                auto r0 = __builtin_amdgcn_permlane32_swap(a0, b0, false, false); auto r1 = __builtin_amdgcn_permlane32_swap(a1, b1, false, false);
                v4u w; w.x = r0[0]; w.y = r1[0]; w.z = r0[1]; w.w = r1[1];
                op[d0 * 4 + hf * 2] = w; } } }
        __syncthreads();
    }
}
__device__ __forceinline__ float silu1(float v) { return v * __builtin_amdgcn_rcpf(1.0f + __builtin_amdgcn_exp2f(v * -1.4426950408889634f)); }
__device__ __forceinline__ void fix_phase(Frame& F, const float* HALO, const float* cw, const float* cb, bf16* ACT) {
    constexpr int C4 = DFF / 4;
    for (int item = F.bid * (NWAVES * 64) + F.tid; item < (MTOK / 256) * C4; item += F.G * NWAVES * 64) {
        const int pm = item / C4, c4 = (item % C4) * 4; if ((pm & 15) == 0) continue;
        f32x4 r0[2], r1[2];
#pragma unroll
        for (int part = 0; part < 2; ++part) { const int col = part * DFF + c4;
            const f32x4 am2 = *(const GAS f32x4*)(HALO + ((size_t)(pm - 1) * 4 + 2) * NFF2 + col), am1 = *(const GAS f32x4*)(HALO + ((size_t)(pm - 1) * 4 + 3) * NFF2 + col);
            const f32x4 a0 = *(const GAS f32x4*)(HALO + ((size_t)pm * 4 + 0) * NFF2 + col), a1 = *(const GAS f32x4*)(HALO + ((size_t)pm * 4 + 1) * NFF2 + col);
            const f32x4 w0 = *(const GAS f32x4*)(cw + col), w1 = *(const GAS f32x4*)(cw + NFF2 + col), w2 = *(const GAS f32x4*)(cw + 2 * NFF2 + col), b = *(const GAS f32x4*)(cb + col);
            r0[part] = b + w0 * am2 + w1 * am1 + w2 * a0; r1[part] = b + w0 * am1 + w1 * a0 + w2 * a1; }
        v2u o0, o1;
        o0.x = pk2(silu1(r0[0].x) * r0[1].x, silu1(r0[0].y) * r0[1].y); o0.y = pk2(silu1(r0[0].z) * r0[1].z, silu1(r0[0].w) * r0[1].w);
        o1.x = pk2(silu1(r1[0].x) * r1[1].x, silu1(r1[0].y) * r1[1].y); o1.y = pk2(silu1(r1[0].z) * r1[1].z, silu1(r1[0].w) * r1[1].w);
        *(GAS v2u*)(ACT + ((size_t)pm * 256) * DFF + c4) = o0; *(GAS v2u*)(ACT + ((size_t)pm * 256 + 1) * DFF + c4) = o1;
    }
}
constexpr int NPHASE = 2 + 2 * 7 + 2 * 6 + 1;
struct Args { const float* in[19]; float* out; unsigned char* ws; int ph_lo, ph_hi; };
static_assert(sizeof(Args) == 19 * 8 + 8 + 8 + 8, "Args has no padding bytes");
#ifndef MK_EN
#define MK_EN 0xffffffffu
#endif
#define EN(k) (((MK_EN) >> (k)) & 1u)
#ifndef MK_KREP
#define MK_KREP 1
#endif
#ifndef MK_REP
#define MK_REP 0u
#endif
#define REPN(k) ((((MK_REP) >> (k)) & 1u) ? 2 : 1)
#define W_MOD   ((float*)((unsigned char*)F.wsg + WS_MOD))
#define W_H     ((bf16*)((unsigned char*)F.wsg + WS_H))
#define W_Q     ((bf16*)((unsigned char*)F.wsg + WS_R))
#define W_K     ((bf16*)((unsigned char*)F.wsg + WS_R + 128 * MiB))
#define W_V     ((bf16*)((unsigned char*)F.wsg + WS_R + 256 * MiB))
#define W_Z     ((bf16*)((unsigned char*)F.wsg + WS_R))
#define W_ACT   ((bf16*)((unsigned char*)F.wsg + WS_R))
#define W_HALO  ((float*)((unsigned char*)F.wsg + WS_R + 344 * MiB))
#define W_LOGF  ((float*)((unsigned char*)F.wsg + WS_LOGF))
#define W_FB    ((float*)((unsigned char*)F.wsg + WS_FB))
#define W_VSS(n) ((u64*)((unsigned char*)F.wsg + WS_VSS) + (size_t)(n) * MTOK)
#define W_XB    ((bf16*)((unsigned char*)F.wsg + WS_XB))
#define W_H2    ((bf16*)((unsigned char*)F.wsg + WS_H2))
#define W_RSS(n) ((u64*)((unsigned char*)F.wsg + WS_RSS) + (size_t)(n) * MTOK)
#define W_BIASV ((float*)((unsigned char*)F.wsg + WS_BIASV))
#define W_MODI  (W_MOD + (size_t)i * 8 * 12288)
#define XOUT_(k) W_XB
#define XG_(k, p) (p)
__global__ void __launch_bounds__(NWAVES * 64, 2) mega_fwd(Args args) {
    extern __shared__ __attribute__((aligned(16))) unsigned char lds[];
    Frame F;
    F.lds = (LAS unsigned char*)lds; F.ldsg = (char*)lds;
    F.MISC = (volatile LAS unsigned*)(F.lds + MISC_OFF);
    for (int u = threadIdx.x; u < (LDS_BYTES - LDSCTL_OFF) / 4; u += NWAVES * 64) ((LAS unsigned*)(F.lds + LDSCTL_OFF))[u] = 0u;
    __syncthreads();
    if (threadIdx.x == 0) {
        const int G = gridDim.x, bx = blockIdx.x; const unsigned long long kp = (unsigned long long)__builtin_amdgcn_kernarg_segment_ptr(), wp = (unsigned long long)args.ws, op = (unsigned long long)args.out;
        F.MISC[MW_BID] = (unsigned)bx; F.MISC[MW_G] = (unsigned)G; F.MISC[MW_VCU] = (unsigned)((G % 8 == 0) ? (bx % 8) * (G / 8) + bx / 8 : bx);
        F.MISC[MW_INP] = (unsigned)kp; F.MISC[MW_INP_HI] = (unsigned)(kp >> 32); F.MISC[MW_WS] = (unsigned)wp; F.MISC[MW_WS_HI] = (unsigned)(wp >> 32); F.MISC[MW_OUT] = (unsigned)op; F.MISC[MW_OUT_HI] = (unsigned)(op >> 32);
    }
    __syncthreads();
    XcdBarrier bar; bar.bar = (unsigned*)(args.ws + WS_CTL) + CW_BAR; bar.x = 0; bar.st = nullptr;
    if (!MK_PER_PHASE) bar = xcd_barrier_post((unsigned*)(args.ws + WS_CTL) + CW_BAR, F.MISC + 8);
    const int lo = args.ph_lo, hi = args.ph_hi;
    int ph = 0;
#define RUN() (lo <= ph && ph < hi && relaunder(F))
#define SEAM() do { if (!MK_PER_PHASE) { if (lo <= ph && ph + 1 < hi) { relaunder(F); bar.bar = (unsigned*)((unsigned char*)F.wsg + WS_CTL) + CW_BAR; asm volatile("" : "+s"(bar.x)); xcd_barrier(bar); } } ++ph; } while (0)

    if (EN(0) && RUN()) for (int rep_ = 0; rep_ < REPN(0); ++rep_) pro_a_phase(F);
    SEAM();
    if (EN(1) && RUN()) for (int rep_ = 0; rep_ < REPN(1); ++rep_) { pro_b_phase(F); xg0_phase(F, F.in(IN_X), F.in(IN_MIXG), W_MOD + DM, W_H, W_XB, W_RSS(0)); }
    SEAM();
    for (int i = 0; i < DEPTH; ++i) {
        const int j = i >> 1;
        if ((i & 1) == 0) {
            if (EN(3) && RUN()) for (int rep_ = 0; rep_ < REPN(3); ++rep_) {
                const bf16* wq = (const bf16*)((unsigned char*)F.wsg + WS_WQKV) + (size_t)j * WQKV_STRIDE; const float* bvq = W_BIASV + BV_QKVF + (size_t)j * 8 * NQKVF;
                fg_phase(F, W_H, wq + (size_t)6144 * DM, F.in(IN_ABF) + j * 16, W_RSS(2 * i), bvq + 6144, W_LOGF);
                pg8::Gemm g{W_H, wq, MTOK, 6144, DM}; pg8::StaticOrder S; S.init(MTOK, 6144, F.G, F.bid);
                pg8::EpiQKV E{W_Q, (size_t)(64 * MiB), fox::QSCALE, pg8::RowAffine{W_RSS(2 * i), bvq, NQKVF, (LAS float*)(F.lds + XCH_OFF + 8192)}};
                pg8::gemm_phase<pg8::EpiQKV, pg8::StaticOrder, true, true>(F.lds + RING_OFF, g, S, E);
            }
            SEAM();
            if (EN(4) && RUN()) for (int rep_ = 0; rep_ < REPN(4); ++rep_) cum_phase(F, W_LOGF, W_FB);
            SEAM();
            if (EN(5) && RUN()) for (int rep_ = 0; rep_ < REPN(5); ++rep_) fox::att_phase(F.ldsg + RING_OFF, (const fox::bf16*)W_Q, (const fox::bf16*)W_K, (const fox::bf16*)W_V, (fox::bf16*)W_H, W_FB, F.bid, F.G);
            SEAM();
            if (EN(6) && RUN()) for (int rep_ = 0; rep_ < REPN(6); ++rep_) {
                pg8::Gemm g{W_H, (const bf16*)((unsigned char*)F.wsg + WS_WO) + (size_t)j * DM * DM, MTOK, DM, DM}; pg8::StaticOrder S; S.init(MTOK, DM, F.G, F.bid);
                pg8::EpiRes E{XOUT_(6), W_MODI + 2 * DM, 12288, XG_(6, W_H2), F.in(IN_FFNG) + i * DM, W_MODI + 4 * DM, W_RSS(2 * i + 1), (LAS float*)(F.lds + XCH_OFF)};
                pg8::gemm_phase<pg8::EpiRes, pg8::StaticOrder, true, true>(F.lds + RING_OFF, g, S, E);
            }
            SEAM();
        } else {
            if (EN(7) && RUN()) for (int rep_ = 0; rep_ < REPN(7); ++rep_) {
                pg8::Gemm g{W_H, (const bf16*)((unsigned char*)F.wsg + WS_WGI) + (size_t)j * 4096 * DM, MTOK, 4096, DM}; pg8::StaticOrder S; S.init(MTOK, 4096, F.G, F.bid);
                pg8::EpiStore<1> E{W_Z, 4096, pg8::RowAffine{W_RSS(2 * i), W_BIASV + BV_GI + (size_t)j * 8 * 4096, 4096, (LAS float*)(F.lds + XCH_OFF + 8192)}, W_VSS(j)};
                pg8::gemm_phase<pg8::EpiStore<1>, pg8::StaticOrder, true, true>(F.lds + RING_OFF, g, S, E);
            }
            SEAM();
            if (EN(9) && RUN()) for (int rep_ = 0; rep_ < REPN(9); ++rep_) gate_phase(F, W_Z, W_VSS(j), F.in(IN_GVG) + j * DM, F.in(IN_GWS) + (size_t)j * 16 * 128 * 128, F.in(IN_GBS) + j * 16 * 128, W_H);
            SEAM();
            if (EN(10) && RUN()) for (int rep_ = 0; rep_ < REPN(10); ++rep_) {
                pg8::Gemm g{W_H, (const bf16*)((unsigned char*)F.wsg + WS_WGO) + (size_t)j * DM * DM, MTOK, DM, DM}; pg8::StaticOrder S; S.init(MTOK, DM, F.G, F.bid);
                pg8::EpiRes E{XOUT_(10), W_MODI + 2 * DM, 12288, XG_(10, W_H2), F.in(IN_FFNG) + i * DM, W_MODI + 4 * DM, W_RSS(2 * i + 1), (LAS float*)(F.lds + XCH_OFF)};
                pg8::gemm_phase<pg8::EpiRes, pg8::StaticOrder, true, true>(F.lds + RING_OFF, g, S, E);
            }
            SEAM();
        }
        if (EN(11) && RUN()) for (int rep_ = 0; rep_ < REPN(11); ++rep_) {
            pg8::Gemm g{W_H2, (const bf16*)((unsigned char*)F.wsg + WS_WF1) + (size_t)i * NFF2 * DM, MTOK, NFF2, DM}; pg8::StaticOrder S; S.init(MTOK, NFF2, F.G, F.bid);
            pg8::EpiConv E{W_ACT, F.in(IN_FCW) + (size_t)i * 3 * NFF2, F.in(IN_FCB) + (size_t)i * NFF2, W_HALO, (LAS float*)(F.lds + XCH_OFF), pg8::RowAffine{W_RSS(2 * i + 1), W_BIASV + BV_F1 + (size_t)i * 8 * NFF2, NFF2, (LAS float*)(F.lds + XCH_OFF + 8192)}};
            pg8::gemm_phase<pg8::EpiConv, pg8::StaticOrder, true, true, MK_KREP>(F.lds + RING_OFF, g, S, E);
        }
        SEAM();
        if (EN(12) && RUN()) for (int rep_ = 0; rep_ < REPN(12); ++rep_) fix_phase(F, W_HALO, F.in(IN_FCW) + (size_t)i * 3 * NFF2, F.in(IN_FCB) + (size_t)i * NFF2, W_ACT);
        SEAM();
        if (EN(13) && RUN()) for (int rep_ = 0; rep_ < REPN(13); ++rep_) {
            pg8::Gemm g{W_ACT, (const bf16*)((unsigned char*)F.wsg + WS_WF2) + (size_t)i * DM * DFF, MTOK, DM, DFF}; pg8::StaticOrder S; S.init(MTOK, DM, F.G, F.bid);
            const int in_ = i < DEPTH - 1 ? i + 1 : i;
            pg8::EpiRes E{XOUT_(13), W_MODI + 5 * DM, 12288, XG_(13, i < DEPTH - 1 ? W_H : (bf16*)nullptr), F.in(IN_MIXG) + in_ * DM, W_MOD + (size_t)in_ * 8 * 12288 + DM, W_RSS(2 * in_), (LAS float*)(F.lds + XCH_OFF)};
            pg8::gemm_phase<pg8::EpiRes, pg8::StaticOrder, true, true>(F.lds + RING_OFF, g, S, E);
        }
        SEAM();
    }
    if (EN(14) && RUN()) normf_phase(F, W_XB, F.in(IN_FING), (float*)F.outg);
#undef RUN
#undef SEAM
}

extern "C" void kernel_launch(void* const* d_in, const int* in_sizes, int n_in, void* d_out, int out_size, void* d_ws, size_t ws_size, hipStream_t stream) {
    static int grid = 0;
    if (grid == 0) {
        if (n_in != 19 || out_size != MTOK * DM || ws_size < WS_END) { fprintf(stderr, "kernel_launch: unexpected shapes (n_in %d, out %d, ws %zu < %zu)\n", n_in, out_size, ws_size, (size_t)WS_END); grid = -1; return; }
        int dev = 0, cus = 0, per_cu = 0;
        if (hipGetDevice(&dev) != hipSuccess || hipDeviceGetAttribute(&cus, hipDeviceAttributeMultiprocessorCount, dev) != hipSuccess) { grid = -1; return; }
        if (hipFuncSetAttribute((const void*)mega_fwd, hipFuncAttributeMaxDynamicSharedMemorySize, LDS_BYTES) != hipSuccess) { fprintf(stderr, "kernel_launch: hipFuncSetAttribute failed\n"); grid = -1; return; }
        if (hipOccupancyMaxActiveBlocksPerMultiprocessor(&per_cu, (const void*)mega_fwd, NWAVES * 64, LDS_BYTES) != hipSuccess || per_cu < 1) { fprintf(stderr, "kernel_launch: occupancy query says %d\n", per_cu); }
        (void)hipGetLastError();
        grid = cus;
    }
    if (grid < 0) return;
    if (hipMemsetAsync((char*)d_ws + WS_CTL, 0, CTL_ZERO_BYTES, stream) != hipSuccess) return;
    Args a{};
    for (int i = 0; i < 19; ++i) a.in[i] = (const float*)d_in[i];
    a.out = (float*)d_out; a.ws = (unsigned char*)d_ws;
#if MK_PER_PHASE
    for (int p = 0; p < NPHASE; ++p) { a.ph_lo = p; a.ph_hi = p + 1; hipLaunchKernelGGL(mega_fwd, dim3(grid), dim3(NWAVES * 64), LDS_BYTES, stream, a); }
#else
    a.ph_lo = 0; a.ph_hi = NPHASE; hipLaunchKernelGGL(mega_fwd, dim3(grid), dim3(NWAVES * 64), LDS_BYTES, stream, a);
#endif
}
```

```cpp
#include <hip/hip_runtime.h>
#include <hip/hip_bf16.h>
#include <cstdio>
#include <cstdint>
__device__ __forceinline__ int ltid() { int t = (int)threadIdx.x; asm volatile("" : "+v"(t)); return t; }
namespace pg8 {
#define PG8_LAS __attribute__((address_space(3)))
typedef unsigned short bf16_t;
typedef short bf16x8 __attribute__((ext_vector_type(8)));
typedef float f32x4 __attribute__((ext_vector_type(4)));
typedef unsigned u32x4 __attribute__((ext_vector_type(4)));
constexpr int BM = 256, BK = 64, HALF = 128, HTB = HALF * BK * 2  , STAGE_BYTES = 8 * HTB, NXCD = 8;
#ifndef MK_WGM
#define MK_WGM 4
#endif
constexpr int WGM = MK_WGM;

__host__ __device__ __forceinline__ int lds_byte(int r, int c) { const int st = (r >> 4) * 2 + (c >> 5), rr = r & 15, cc = c & 31, ob = rr * 64 + cc * 2; return st * 1024 + (ob ^ (((ob >> 9) & 1) << 5)); }
__host__ __device__ __forceinline__ void stage_rc(int b, int& R, int& C) { const int st = b / 1024, sb = b % 1024, swz = sb ^ (((sb >> 9) & 1) << 5); R = (st >> 1) * 16 + swz / 64; C = (st & 1) * 32 + (swz % 64) / 2; }
__host__ __device__ __forceinline__ int perm32(int rho) { const int n = rho >> 4, i = rho & 15; return 8 * (i >> 2) + 4 * n + (i & 3); }

struct Unit { int pm, pn; };
struct Gemm { const bf16_t* A; const bf16_t* Bt; int M, N, K; };

struct StaticOrder {
    int nM, nN, nwg, G, c;
    __host__ __device__ void init(int M, int N, int G_, int c_) { nM = M / BM; nN = N / BM; nwg = nM * nN; G = G_; c = c_; }
    __host__ __device__ bool next(int i, Unit& u) const {
        const long L = (long)i * G + c; if (L >= nwg) return false;
        int wgid = (int)L; { const int q = nwg / NXCD, r = nwg % NXCD, xcd = wgid % NXCD, off = wgid / NXCD; wgid = (xcd < r ? xcd * (q + 1) : r * (q + 1) + (xcd - r) * q) + off; }
        const int nig = WGM * nN, gid = wgid / nig, fm = gid * WGM, gsz = (nM - fm) < WGM ? (nM - fm) : WGM;
        u.pm = fm + ((wgid % nig) % gsz); u.pn = (wgid % nig) / gsz; return true;
    }
    __device__ __forceinline__ void a_ready(const Unit&) const {}
    __device__ __forceinline__ void done(const Unit&) const {}
};
__device__ __forceinline__ unsigned cvt_pk_bf16(float lo, float hi) { unsigned r; asm volatile("v_cvt_pk_bf16_f32 %0, %1, %2" : "=v"(r) : "v"(lo), "v"(hi)); return r; }
typedef float f32x2 __attribute__((ext_vector_type(2)));
__device__ __forceinline__ f32x2 gelu_pk(f32x2 v) {
    const f32x2 av = __builtin_elementwise_abs(v), d = av * 0.2316418882f + 1.0f;
    f32x2 t; t.x = __builtin_amdgcn_rcpf(d.x); t.y = __builtin_amdgcn_rcpf(d.y);
    f32x2 q = t * 0.5307027145f + (-0.7265760135f); q = q * t + 0.7107068705f; q = q * t + (-0.142248368f); q = q * t + 0.127414796f; q = q * t;
    const f32x2 s = (v * v) * (-0.72134752044f);
    f32x2 e; e.x = __builtin_amdgcn_exp2f(s.x); e.y = __builtin_amdgcn_exp2f(s.y);
    const f32x2 m = v * (q * e), r = v - m;
    f32x2 o; o.x = v.x < 0.f ? m.x : r.x; o.y = v.y < 0.f ? m.y : r.y; return o;
}

struct RowAffine {
    const unsigned long long* rss; const float* biasb;
    int bpitch; PG8_LAS float* T;
    template <bool UPGATE> __device__ __forceinline__ void stage(const Unit& u, int p, int wid, int lane) const {
        if (wid == 0 || wid == 2) __builtin_amdgcn_global_load_lds((const unsigned*)(rss + (size_t)u.pm * BM + wid * 64 + lane * 2), (PG8_LAS unsigned*)(T + p * 768 + wid * 128), 16, 0, 0);
        if (wid == 1) { const int b = (u.pm * BM) >> 12;
            const int col = UPGATE ? ((lane < 32) ? (u.pn * 128 + lane * 4) : (5504 + u.pn * 128 + (lane - 32) * 4)) : (u.pn * BM + lane * 4);
            __builtin_amdgcn_global_load_lds((const unsigned*)(biasb + (size_t)b * bpitch + col), (PG8_LAS unsigned*)(T + p * 768 + 512), 16, 0, 0); }
    }
    __device__ __forceinline__ void apply(f32x4 (&acc)[2][2][4][2], int p, int wr, int wc, int fr, int fq) const {
        const PG8_LAS unsigned long long* Tr = (const PG8_LAS unsigned long long*)(T + p * 768) + wr * 64 + fr; const PG8_LAS float* Tb = T + p * 768 + 512 + wc * 32 + 8 * fq;
        float rs[2][4];
#pragma unroll
        for (int ai = 0; ai < 2; ++ai)
#pragma unroll
            for (int m = 0; m < 4; ++m) rs[ai][m] = __builtin_amdgcn_rsqf((float)Tr[ai * HALF + m * 16] * (1.0f / (1048576.0f * 2048.0f)) + 1e-6f);
#pragma unroll
        for (int bj = 0; bj < 2; ++bj)
#pragma unroll
            for (int n = 0; n < 2; ++n) { const f32x4 bv = *(const PG8_LAS f32x4*)(Tb + bj * HALF + 4 * n);
#pragma unroll
                for (int ai = 0; ai < 2; ++ai)
#pragma unroll
                    for (int m = 0; m < 4; ++m) acc[ai][bj][m][n] = acc[ai][bj][m][n] * rs[ai][m] + bv; }
    }
};
__device__ __forceinline__ float gelu_tanh1(float v) {
    const float u = v * (0.7978845608f + 0.0356774081f * v * v);
    const float e = __builtin_amdgcn_exp2f(u * -2.8853900818f);
    return v * __builtin_amdgcn_rcpf(1.0f + e);
}
template <int ACT  > struct EpiStore {
    static constexpr bool PERM = true, AFTER_DRAIN = false;
    bf16_t* O; int ldc; RowAffine ra; unsigned long long* vss;
    __device__ __forceinline__ void stage(const Unit& u, int p, int wid, int lane) const { ra.stage<false>(u, p, wid, lane); }
    __device__ __forceinline__ void operator()(f32x4 (&acc)[2][2][4][2], const Unit& u, int p, int wr, int wc, int fr, int fq) const {
        ra.apply(acc, p, wr, wc, fr, fq);
        const int row0 = u.pm * BM + wr * 64 + fr, col0 = u.pn * BM + wc * 32 + 8 * fq; float ssq[8];
#pragma unroll
        for (int ai = 0; ai < 2; ++ai)
#pragma unroll
            for (int m = 0; m < 4; ++m) { bf16_t* rowp = O + (size_t)(row0 + ai * HALF + m * 16) * ldc + col0; float s = 0.f;
#pragma unroll
                for (int bj = 0; bj < 2; ++bj) { f32x4 v0 = acc[ai][bj][m][0], v1 = acc[ai][bj][m][1];
                    if (ACT == 1) {
#pragma unroll
                        for (int j = 0; j < 4; ++j) { v0[j] = gelu_tanh1(v0[j]); v1[j] = gelu_tanh1(v1[j]); } }
                    s += (v0[0] * v0[0] + v0[1] * v0[1]) + (v0[2] * v0[2] + v0[3] * v0[3]) + (v1[0] * v1[0] + v1[1] * v1[1]) + (v1[2] * v1[2] + v1[3] * v1[3]);
                    u32x4 w; w.x = cvt_pk_bf16(v0[0], v0[1]); w.y = cvt_pk_bf16(v0[2], v0[3]); w.z = cvt_pk_bf16(v1[0], v1[1]); w.w = cvt_pk_bf16(v1[2], v1[3]);
                    *(u32x4*)(rowp + bj * HALF) = w; }
                ssq[ai * 4 + m] = s; }
        if (vss && u.pn >= 8) {
#pragma unroll
            for (int k = 0; k < 8; ++k) ssq[k] += __shfl_xor(ssq[k], 16);
#pragma unroll
            for (int k = 0; k < 8; ++k) ssq[k] += __shfl_xor(ssq[k], 32);
            if (fq == 0) {
#pragma unroll
                for (int k = 0; k < 8; ++k) __hip_atomic_fetch_add(vss + row0 + (k >> 2) * HALF + (k & 3) * 16, (unsigned long long)(ssq[k] * 1048576.0f), __ATOMIC_RELAXED, __HIP_MEMORY_SCOPE_AGENT); } }
    }
};
struct EpiQKV {
    static constexpr bool PERM = true, AFTER_DRAIN = false;
    bf16_t* QKV; size_t tstride; float qscale; RowAffine ra;
    __device__ __forceinline__ void stage(const Unit& u, int p, int wid, int lane) const { ra.stage<false>(u, p, wid, lane); }
    __device__ __forceinline__ void operator()(f32x4 (&acc)[2][2][4][2], const Unit& u, int p, int wr, int wc, int fr, int fq) const {
        ra.apply(acc, p, wr, wc, fr, fq);
        const int tok0 = u.pm * BM, b = tok0 >> 12, s0 = (tok0 & 4095) + wr * 64 + fr;
        const int colt = u.pn * BM, t = colt >> 11, hd0 = (colt & 2047) >> 7;
        bf16_t* base = QKV + (size_t)t * tstride; const float sc = t == 0 ? qscale : 1.0f;
#pragma unroll
        for (int bj = 0; bj < 2; ++bj) { bf16_t* hb = base + ((size_t)(b * 16 + hd0 + bj) * 4096 + s0) * 128 + wc * 32 + 8 * fq;
#pragma unroll
            for (int ai = 0; ai < 2; ++ai)
#pragma unroll
                for (int m = 0; m < 4; ++m) { const f32x4 v0 = acc[ai][bj][m][0] * sc, v1 = acc[ai][bj][m][1] * sc;
                    u32x4 w; w.x = cvt_pk_bf16(v0[0], v0[1]); w.y = cvt_pk_bf16(v0[2], v0[3]); w.z = cvt_pk_bf16(v1[0], v1[1]); w.w = cvt_pk_bf16(v1[2], v1[3]);
                    *(u32x4*)(hb + (size_t)(ai * HALF + m * 16) * 128) = w; } }
    }
};
struct EpiRes {
    static constexpr bool PERM = true, AFTER_DRAIN = false;
    bf16_t* xb; const float* gate; int gpitch; bf16_t* xg; const float* gn; const float* scn; unsigned long long* rss; PG8_LAS float* T;
    __device__ __forceinline__ void stage(const Unit& u, int p, int wid, int lane) const { const int b = (u.pm * BM) >> 12, c = u.pn * BM + lane * 4;
        if (wid == 0) __builtin_amdgcn_global_load_lds((const unsigned*)(gate + (size_t)b * gpitch + c), (PG8_LAS unsigned*)(T + p * 768), 16, 0, 0);
        if (wid == 1 && xg) __builtin_amdgcn_global_load_lds((const unsigned*)(gn + c), (PG8_LAS unsigned*)(T + p * 768 + 256), 16, 0, 0);
        if (wid == 2 && xg) __builtin_amdgcn_global_load_lds((const unsigned*)(scn + (size_t)b * gpitch + c), (PG8_LAS unsigned*)(T + p * 768 + 512), 16, 0, 0); }
    __device__ __forceinline__ void operator()(const f32x4 (&acc)[2][2][4][2], const Unit& u, int p, int wr, int wc, int fr, int fq) const {
        const int row0 = u.pm * BM + wr * 64 + fr, col0 = u.pn * BM + wc * 32 + 8 * fq; const PG8_LAS float* Tc = T + p * 768 + wc * 32 + 8 * fq;
        u32x4 xbuf[3][2];
#define ER_LOAD(k) do { const size_t off_ = (size_t)(row0 + ((k) >> 2) * HALF + ((k) & 3) * 16) * 2048 + col0; _Pragma("unroll") for (int bj = 0; bj < 2; ++bj) xbuf[(k) % 3][bj] = *(const u32x4*)(xb + off_ + bj * HALF); } while (0)
        ER_LOAD(0); ER_LOAD(1);
        f32x4 gv[2][2], gs[2][2];
#pragma unroll
        for (int bj = 0; bj < 2; ++bj)
#pragma unroll
            for (int n = 0; n < 2; ++n) { gv[bj][n] = *(const PG8_LAS f32x4*)(Tc + bj * HALF + n * 4);
                gs[bj][n] = xg ? *(const PG8_LAS f32x4*)(Tc + 256 + bj * HALF + n * 4) * (*(const PG8_LAS f32x4*)(Tc + 512 + bj * HALF + n * 4) + 1.0f) : (f32x4){0.f, 0.f, 0.f, 0.f}; }
        float ss[8];
#pragma unroll
        for (int k = 0; k < 8; ++k) { const int ai = k >> 2, m = k & 3, row = row0 + ai * HALF + m * 16; const size_t off = (size_t)row * 2048 + col0; float s = 0.f;
            if (k + 2 < 8) ER_LOAD(k + 2);
            __builtin_amdgcn_sched_barrier(0);
#pragma unroll
            for (int bj = 0; bj < 2; ++bj) { const u32x4 xw = xbuf[k % 3][bj];
                const f32x4 x0 = (f32x4){__builtin_bit_cast(float, xw.x << 16), __builtin_bit_cast(float, xw.x & 0xffff0000u), __builtin_bit_cast(float, xw.y << 16), __builtin_bit_cast(float, xw.y & 0xffff0000u)};
                const f32x4 x1 = (f32x4){__builtin_bit_cast(float, xw.z << 16), __builtin_bit_cast(float, xw.z & 0xffff0000u), __builtin_bit_cast(float, xw.w << 16), __builtin_bit_cast(float, xw.w & 0xffff0000u)};
                const f32x4 o0 = x0 + gv[bj][0] * acc[ai][bj][m][0], o1 = x1 + gv[bj][1] * acc[ai][bj][m][1];
                u32x4 w; w.x = cvt_pk_bf16(o0[0], o0[1]); w.y = cvt_pk_bf16(o0[2], o0[3]); w.z = cvt_pk_bf16(o1[0], o1[1]); w.w = cvt_pk_bf16(o1[2], o1[3]);
                *(u32x4*)(xb + off + bj * HALF) = w;
                if (xg) { const f32x4 y0 = o0 * gs[bj][0], y1 = o1 * gs[bj][1]; u32x4 g; g.x = cvt_pk_bf16(y0[0], y0[1]); g.y = cvt_pk_bf16(y0[2], y0[3]); g.z = cvt_pk_bf16(y1[0], y1[1]); g.w = cvt_pk_bf16(y1[2], y1[3]);
                    *(u32x4*)(xg + off + bj * HALF) = g;
                    s += (o0[0] * o0[0] + o0[1] * o0[1]) + (o0[2] * o0[2] + o0[3] * o0[3]) + (o1[0] * o1[0] + o1[1] * o1[1]) + (o1[2] * o1[2] + o1[3] * o1[3]); } }
            ss[k] = s;
            __builtin_amdgcn_sched_barrier(0); }
#undef ER_LOAD
        if (xg) {
#pragma unroll
            for (int k = 0; k < 8; ++k) ss[k] += __shfl_xor(ss[k], 16);
#pragma unroll
            for (int k = 0; k < 8; ++k) ss[k] += __shfl_xor(ss[k], 32);
            if (fq == 0) {
#pragma unroll
                for (int k = 0; k < 8; ++k) __hip_atomic_fetch_add(rss + row0 + (k >> 2) * HALF + (k & 3) * 16, (unsigned long long)(ss[k] * 1048576.0f), __ATOMIC_RELAXED, __HIP_MEMORY_SCOPE_AGENT); } }
    }
};
__device__ __forceinline__ int f2i(float v) { return __builtin_bit_cast(int, v); }
__device__ __forceinline__ float i2f(int v) { return __builtin_bit_cast(float, v); }
template <int SH> __device__ __forceinline__ float dpp_ror(float v) { return i2f(__builtin_amdgcn_update_dpp(0, f2i(v), 0x120 + SH, 0xf, 0xf, true)); }
template <int SH> __device__ __forceinline__ float dpp_shr_fill(float fill, float cur) { return i2f(__builtin_amdgcn_update_dpp(f2i(fill), f2i(cur), 0x110 + SH, 0xf, 0xf, false)); }
struct EpiConv {
    static constexpr bool PERM = true, AFTER_DRAIN = false;
    bf16_t* ACT; const float* cw; const float* cb; float* HALO; PG8_LAS float* X; RowAffine ra; PG8_LAS float* TW;
    __device__ __forceinline__ void stage(const Unit& u, int p, int wid, int lane) const { ra.stage<true>(u, p, wid, lane);
        if (wid >= 3 && wid <= 6) { const int k = wid - 3, col = (lane < 32) ? (u.pn * 128 + lane * 4) : (5504 + u.pn * 128 + (lane - 32) * 4);
            __builtin_amdgcn_global_load_lds((const unsigned*)((k < 3 ? cw + (size_t)k * 11008 : cb) + col), (PG8_LAS unsigned*)(TW + p * 1024 + k * 256), 16, 0, 0); } }
    __device__ __forceinline__ void operator()(f32x4 (&acc)[2][2][4][2], const Unit& u, int p, int wr, int wc, int fr, int fq) const {
        const int tcol = wc * 32 + 8 * fq, ch0 = u.pn * 128 + tcol;
        ra.apply(acc, p, wr, wc, fr, fq);
#if defined(MK_KREP) && MK_KREP > 1
#pragma unroll
        for (int ai = 0; ai < 2; ++ai)
#pragma unroll
            for (int bj = 0; bj < 2; ++bj)
#pragma unroll
                for (int m = 0; m < 4; ++m)
#pragma unroll
                    for (int n = 0; n < 2; ++n) acc[ai][bj][m][n] *= (1.0f / MK_KREP);
#endif
        if (fr >= 14) {
#pragma unroll
            for (int ai = 0; ai < 2; ++ai)
#pragma unroll
                for (int bj = 0; bj < 2; ++bj)
#pragma unroll
                    for (int n = 0; n < 2; ++n) *(PG8_LAS f32x4*)(X + (((ai * 2 + wr) * 2 + (fr - 14)) * 256) + bj * 128 + tcol + 4 * n) = acc[ai][bj][3][n];
            if (wr == 1) {
#pragma unroll
                for (int bj = 0; bj < 2; ++bj)
#pragma unroll
                    for (int n = 0; n < 2; ++n) *(f32x4*)(HALO + ((size_t)u.pm * 4 + 2 + (fr - 14)) * 11008 + bj * 5504 + ch0 + 4 * n) = acc[1][bj][3][n]; }
        }
        if (fr < 2 && wr == 0) {
#pragma unroll
            for (int bj = 0; bj < 2; ++bj)
#pragma unroll
                for (int n = 0; n < 2; ++n) *(f32x4*)(HALO + ((size_t)u.pm * 4 + fr) * 11008 + bj * 5504 + ch0 + 4 * n) = acc[0][bj][0][n]; }
        asm volatile("s_waitcnt lgkmcnt(0)" ::: "memory"); __builtin_amdgcn_s_barrier(); asm volatile("" ::: "memory");
        const PG8_LAS float* Tw = TW + p * 1024 + tcol;
        const int row0 = u.pm * BM + wr * 64 + fr;
#pragma unroll
        for (int ai = 0; ai < 2; ++ai) { const int g = ai * 2 + wr;
#pragma unroll
            for (int bj = 0; bj < 2; ++bj)
#pragma unroll
                for (int n = 0; n < 2; ++n) {
                    const f32x4 w0 = *(const PG8_LAS f32x4*)(Tw + bj * 128 + 4 * n), w1 = *(const PG8_LAS f32x4*)(Tw + 256 + bj * 128 + 4 * n), w2 = *(const PG8_LAS f32x4*)(Tw + 512 + bj * 128 + 4 * n), bb = *(const PG8_LAS f32x4*)(Tw + 768 + bj * 128 + 4 * n);
                    f32x4 h1 = (f32x4){0.f, 0.f, 0.f, 0.f}, h2 = h1;
                    if (g > 0) { h1 = *(const PG8_LAS f32x4*)(X + (((g - 1) * 2 + 1) * 256) + bj * 128 + tcol + 4 * n); h2 = *(const PG8_LAS f32x4*)(X + (((g - 1) * 2 + (fr & 1)) * 256) + bj * 128 + tcol + 4 * n); }
#pragma unroll
                    for (int m = 3; m >= 0; --m) { const f32x4 x = acc[ai][bj][m][n]; f32x4 r;
#pragma unroll
                        for (int e = 0; e < 4; ++e) { float f1, f2;
                            if (m > 0) { const float xp = acc[ai][bj][m - 1][n][e]; f1 = dpp_ror<1>(xp); f2 = dpp_ror<2>(xp); } else { f1 = h1[e]; f2 = h2[e]; }
                            const float p1 = dpp_shr_fill<1>(f1, x[e]), p2 = dpp_shr_fill<2>(f2, x[e]);
                            r[e] = bb[e] + w2[e] * x[e] + w1[e] * p1 + w0[e] * p2; }
                        asm volatile("" : "+v"(r));
                        acc[ai][bj][m][n] = r; }
                    __builtin_amdgcn_sched_barrier(0); }
#pragma unroll
            for (int m = 0; m < 4; ++m) { f32x4 o[2];
#pragma unroll
                for (int n = 0; n < 2; ++n)
#pragma unroll
                    for (int e = 0; e < 4; ++e) { const float gt = acc[ai][0][m][n][e]; o[n][e] = gt * __builtin_amdgcn_rcpf(1.0f + __builtin_amdgcn_exp2f(gt * -1.4426950408889634f)) * acc[ai][1][m][n][e]; }
                u32x4 w; w.x = cvt_pk_bf16(o[0][0], o[0][1]); w.y = cvt_pk_bf16(o[0][2], o[0][3]); w.z = cvt_pk_bf16(o[1][0], o[1][1]); w.w = cvt_pk_bf16(o[1][2], o[1][3]);
                *(u32x4*)(ACT + (size_t)(row0 + ai * HALF + m * 16) * 5504 + ch0) = w; }
            __builtin_amdgcn_sched_barrier(0); }
    }
};
template <class Epi, class Sched, bool ALIGN_EPI = false, bool SP2 = false, int KREP = 1>
__device__ __forceinline__ void gemm_phase(PG8_LAS unsigned char* lds, const Gemm g, const Sched& S, const Epi& E) {
    const int tid = ltid(), wid = __builtin_amdgcn_readfirstlane(tid >> 6), lane = tid & 63, wr = wid >> 2, wc = wid & 3, fr = lane & 15, fq = lane >> 4;
    const int K = g.K, nt = K / BK;
    unsigned voffA[2], voffB[2];
#pragma unroll
    for (int i = 0; i < 2; ++i) { int R, C; stage_rc(tid * 16 + i * 8192, R, C); const int Rb = Epi::PERM ? ((R & ~31) + perm32(R & 31)) : R;
        voffA[i] = (unsigned)(R * K + C) * 2u; voffB[i] = (unsigned)(Rb * K + C) * 2u; }
    const size_t kstep = (size_t)(BK * 2);
    const size_t hstep = (size_t)HALF * K * 2;
    const size_t tstep = 2 * hstep;
    const unsigned ldsw = (unsigned)wid * 1024u;
    const int aoff = lds_byte(wr * 64 + fr, fq * 8), boff = lds_byte(wc * 32 + fr, fq * 8);
#define PG8_SA(b, h) (((b) * 2 + (h)) * HTB)
#define PG8_SB(b, h) ((4 + (b) * 2 + (h)) * HTB)
#define PG8_STAGE(bufoff, gbase, voff) do { _Pragma("unroll") for (int _i = 0; _i < 2; ++_i) \
        __builtin_amdgcn_global_load_lds((const unsigned*)((const char*)(gbase) + (voff)[_i]), (PG8_LAS unsigned*)(lds + (bufoff) + ldsw + _i * 8192), 16, 0, 0); } while (0)
#define PG8_LDA(dst, b, h) do { _Pragma("unroll") for (int m = 0; m < 4; ++m) _Pragma("unroll") for (int k = 0; k < 2; ++k) dst[m][k] = *(const PG8_LAS bf16x8*)(lds + PG8_SA(b, h) + aoff + m * 2048 + k * 1024); } while (0)
#define PG8_LDB(dst, b, h) do { _Pragma("unroll") for (int n = 0; n < 2; ++n) _Pragma("unroll") for (int k = 0; k < 2; ++k) dst[n][k] = *(const PG8_LAS bf16x8*)(lds + PG8_SB(b, h) + boff + n * 2048 + k * 1024); } while (0)
#define PG8_MMA(ai, bj, At, Bt) do { __builtin_amdgcn_s_setprio(1); _Pragma("unroll") for (int m = 0; m < 4; ++m) _Pragma("unroll") for (int n = 0; n < 2; ++n) _Pragma("unroll") for (int k = 0; k < 2; ++k) \
        acc[ai][bj][m][n] = __builtin_amdgcn_mfma_f32_16x16x32_bf16(Bt[n][k], At[m][k], acc[ai][bj][m][n], 0, 0, 0); __builtin_amdgcn_s_setprio(0); } while (0)
#define PG8_WAIT_V(n) asm volatile("s_waitcnt vmcnt(" #n ")" ::: "memory")
#define PG8_WAIT_L(n) asm volatile("s_waitcnt lgkmcnt(" #n ")" ::: "memory")
#define PG8_BAR __builtin_amdgcn_s_barrier()
#define PG8_SCHED __builtin_amdgcn_sched_barrier(0)
    Unit cur, nxt; int ui = 0;
    if (!S.next(0, cur)) return;
    E.stage(cur, 0, wid, lane);
    f32x4 acc[2][2][4][2];
#pragma unroll
    for (int a = 0; a < 2; ++a)
#pragma unroll
        for (int b = 0; b < 2; ++b)
#pragma unroll
            for (int m = 0; m < 4; ++m)
#pragma unroll
                for (int n = 0; n < 2; ++n) acc[a][b][m][n] = (f32x4){0.f, 0.f, 0.f, 0.f};
    bf16x8 At[4][2], B0[2][2], B1[2][2];
    const char* cA = (const char*)g.A + (size_t)cur.pm * tstep; const char* cB = (const char*)g.Bt + (size_t)cur.pn * tstep;
    S.a_ready(cur);
    if constexpr (SP2) {
        PG8_STAGE(PG8_SB(0, 0), cB, voffB); PG8_STAGE(PG8_SB(0, 1), cB + hstep, voffB); PG8_STAGE(PG8_SA(0, 0), cA, voffA); PG8_STAGE(PG8_SA(0, 1), cA + hstep, voffA);
        if (wr == 1) PG8_BAR;
        PG8_WAIT_V(2); PG8_BAR;
        PG8_STAGE(PG8_SB(1, 0), cB + kstep, voffB); PG8_STAGE(PG8_SA(1, 0), cA + kstep, voffA); PG8_STAGE(PG8_SB(1, 1), cB + hstep + kstep, voffB);
        PG8_WAIT_V(6); PG8_BAR;
    } else {
        PG8_STAGE(PG8_SB(0, 0), cB, voffB); PG8_STAGE(PG8_SA(0, 0), cA, voffA); PG8_STAGE(PG8_SB(0, 1), cB + hstep, voffB); PG8_STAGE(PG8_SA(0, 1), cA + hstep, voffA);
        if (wr == 1) PG8_BAR;
        PG8_WAIT_V(4); PG8_BAR;
        PG8_STAGE(PG8_SB(1, 0), cB + kstep, voffB); PG8_STAGE(PG8_SA(1, 0), cA + kstep, voffA); PG8_STAGE(PG8_SB(1, 1), cB + hstep + kstep, voffB);
        PG8_WAIT_V(6); PG8_BAR;
    }
    for (;;) {
        const bool has_next = S.next(ui + 1, nxt);
        const char* nA = has_next ? (const char*)g.A + (size_t)nxt.pm * tstep : cA; const char* nB = has_next ? (const char*)g.Bt + (size_t)nxt.pn * tstep : cB;
        for (int t = 0; t < nt * KREP; t += 2) {
            const bool last = (t == nt * KREP - 2);
            const int t1w = KREP > 1 ? ((t + 1) & (nt - 1)) : t + 1, t2w = KREP > 1 ? ((t + 2) & (nt - 1)) : t + 2;
            const char* a1 = cA + (size_t)t1w * kstep;
            const char* a2 = last ? nA : cA + (size_t)t2w * kstep; const char* b2 = last ? nB : cB + (size_t)t2w * kstep;
            const char* a3 = a2 + kstep; const char* b3 = b2 + kstep;
            if (last && has_next) S.a_ready(nxt);
            if constexpr (SP2) {
            PG8_LDB(B0, 0, 0); PG8_LDB(B1, 0, 1); PG8_SCHED; PG8_LDA(At, 0, 0); PG8_STAGE(PG8_SA(1, 1), a1 + hstep, voffA);
            PG8_WAIT_V(8); PG8_WAIT_L(0); PG8_BAR; PG8_MMA(0, 0, At, B0); PG8_MMA(0, 1, At, B1); PG8_BAR; PG8_SCHED;
            PG8_LDA(At, 0, 1); PG8_STAGE(PG8_SB(0, 0), b2, voffB); PG8_STAGE(PG8_SB(0, 1), b2 + hstep, voffB); PG8_STAGE(PG8_SA(0, 0), a2, voffA);
            PG8_WAIT_V(8); PG8_WAIT_L(0); PG8_BAR; PG8_MMA(1, 0, At, B0); PG8_MMA(1, 1, At, B1); PG8_BAR; PG8_SCHED;
            PG8_LDB(B0, 1, 0); PG8_LDB(B1, 1, 1); PG8_SCHED; PG8_LDA(At, 1, 0); PG8_STAGE(PG8_SA(0, 1), a2 + hstep, voffA);
            PG8_WAIT_V(8); PG8_WAIT_L(0); PG8_BAR; PG8_MMA(0, 0, At, B0); PG8_MMA(0, 1, At, B1); PG8_BAR; PG8_SCHED;
            PG8_LDA(At, 1, 1); PG8_STAGE(PG8_SB(1, 0), b3, voffB); PG8_STAGE(PG8_SB(1, 1), b3 + hstep, voffB); PG8_STAGE(PG8_SA(1, 0), a3, voffA);
            PG8_WAIT_V(8); PG8_WAIT_L(0); PG8_BAR; PG8_MMA(1, 0, At, B0); PG8_MMA(1, 1, At, B1); PG8_BAR; PG8_SCHED;
            } else {
            PG8_LDB(B0, 0, 0); PG8_SCHED; PG8_LDA(At, 0, 0); PG8_STAGE(PG8_SA(1, 1), a1 + hstep, voffA);
            PG8_WAIT_L(8); PG8_BAR; PG8_WAIT_L(0); PG8_MMA(0, 0, At, B0); PG8_BAR; PG8_SCHED;
            PG8_LDB(B1, 0, 1); PG8_STAGE(PG8_SB(0, 0), b2, voffB);
            PG8_BAR; PG8_WAIT_L(0); PG8_MMA(0, 1, At, B1); PG8_BAR;
            PG8_LDA(At, 0, 1); PG8_STAGE(PG8_SA(0, 0), a2, voffA);
            PG8_BAR; PG8_WAIT_L(0); PG8_MMA(1, 0, At, B0); PG8_BAR; PG8_SCHED;
            PG8_STAGE(PG8_SB(0, 1), b2 + hstep, voffB);
            PG8_WAIT_V(6); PG8_BAR; PG8_MMA(1, 1, At, B1); PG8_BAR;
            PG8_LDB(B0, 1, 0); PG8_SCHED; PG8_LDA(At, 1, 0); PG8_STAGE(PG8_SA(0, 1), a2 + hstep, voffA);
            PG8_WAIT_L(8); PG8_BAR; PG8_WAIT_L(0); PG8_MMA(0, 0, At, B0); PG8_BAR; PG8_SCHED;
            PG8_LDB(B1, 1, 1); PG8_STAGE(PG8_SB(1, 0), b3, voffB);
            PG8_BAR; PG8_WAIT_L(0); PG8_MMA(0, 1, At, B1); PG8_BAR;
            PG8_LDA(At, 1, 1); PG8_STAGE(PG8_SA(1, 0), a3, voffA);
            PG8_BAR; PG8_WAIT_L(0); PG8_MMA(1, 0, At, B0); PG8_BAR; PG8_SCHED;
            PG8_STAGE(PG8_SB(1, 1), b3 + hstep, voffB);
            PG8_WAIT_V(6); PG8_BAR; PG8_MMA(1, 1, At, B1); PG8_BAR;
            }
        }
        if constexpr (ALIGN_EPI) { if (wr == 0) PG8_BAR; }
        if constexpr (!Epi::AFTER_DRAIN) { E(acc, cur, ui & 1, wr, wc, fr, fq); S.done(cur); }
        if (!has_next) break;
        E.stage(nxt, (ui + 1) & 1, wid, lane);
#pragma unroll
        for (int a = 0; a < 2; ++a)
#pragma unroll
            for (int b = 0; b < 2; ++b)
#pragma unroll
                for (int m = 0; m < 4; ++m)
#pragma unroll
                    for (int n = 0; n < 2; ++n) acc[a][b][m][n] = (f32x4){0.f, 0.f, 0.f, 0.f};
        cur = nxt; cA = nA; cB = nB; ++ui;
        if constexpr (ALIGN_EPI) { if (wr == 1) PG8_BAR; }
    }
    PG8_WAIT_V(0);
    if constexpr (!ALIGN_EPI) { if (wr == 0) PG8_BAR; }
    PG8_BAR;
    if constexpr (Epi::AFTER_DRAIN) { E.fused(acc, cur, wr, wc, fr, fq, lds, wid, lane); S.done(cur); }
#undef PG8_SA
#undef PG8_SB
#undef PG8_STAGE
#undef PG8_LDA
#undef PG8_LDB
#undef PG8_MMA
#undef PG8_WAIT_V
#undef PG8_WAIT_L
#undef PG8_BAR
#undef PG8_SCHED
}
}
namespace fox {
enum { ORDER_NATURAL = 0, ORDER_REVERSED = 1, ORDER_PAIRED = 2, ORDER_XCD = 4 };
constexpr int B = 8, H = 16, HKV = 16, SQ = 4096, SKV = 4096, D = 128;
constexpr int QOFF = 0;
constexpr int WINDOW = SKV;
constexpr float THR = 8.f;
constexpr bool WSKIP = false;
constexpr float SCALE = 0.08838834764831845f;
constexpr float QSCALE = SCALE * 1.4426950408889634f;
constexpr int NW = 8, QBLK = 32, KVBLK = 64, QB = NW * QBLK;
constexpr int SHM_V = KVBLK * D * 2, SHM_K = KVBLK * D * 2;
constexpr int LDS_FB = 2 * SHM_V + 2 * SHM_K + NW * 64 * 4;
constexpr int LDS_BYTES = LDS_FB + SKV * 4;
constexpr int OPITCH = H * D;
using bf16 = __hip_bfloat16;
typedef short bf16x8 __attribute__((ext_vector_type(8)));
typedef short s16x4 __attribute__((ext_vector_type(4)));
typedef float f32x16 __attribute__((ext_vector_type(16)));
typedef float f32x4 __attribute__((ext_vector_type(4)));
typedef unsigned u32x4 __attribute__((ext_vector_type(4)));
template <class A, class Bt> struct same_t { static constexpr bool v = false; };
template <class A> struct same_t<A, A> { static constexpr bool v = true; };

#define KSWZ(row, colB) ((row) * 256 + ((colB) ^ (((row) & 7) << 4)))
#define SBAR() __builtin_amdgcn_sched_barrier(0)
__device__ __forceinline__ int v_st(int k, int c) { const int kk = (k & ~0xC) | ((k & 4) << 1) | ((k & 8) >> 1); return ((kk >> 3) * 4 + (c >> 5)) * 512 + ((kk & 7) * 32 + (c & 31)) * 2; }
__device__ __forceinline__ int v_rd_base(int lane) { return ((lane & 3) << 3) | (((lane >> 2) & 3) << 6) | (((lane >> 4) & 1) << 5) | (((lane >> 5) & 1) << 8); }
constexpr int v_rd_off(int d0, int ks, int half) { return d0 * 512 + ks * 4096 + half * 2048; }
__device__ __forceinline__ int crow(int r, int hi) { return (r & 3) + 8 * (r >> 2) + 4 * hi; }
__device__ __forceinline__ unsigned cvtpk(float lo, float hi) {
    unsigned r; asm volatile("v_cvt_pk_bf16_f32 %0, %1, %2" : "=v"(r) : "v"(lo), "v"(hi)); return r;
}
__device__ __forceinline__ bf16x8 pack8(f32x4 a, f32x4 b) {
    u32x4 w = {cvtpk(a[0], a[1]), cvtpk(a[2], a[3]), cvtpk(b[0], b[1]), cvtpk(b[2], b[3])};
    return *reinterpret_cast<bf16x8*>(&w);
}
template <class T> __device__ __forceinline__ bf16x8 load8(const T* p) {
    if constexpr (same_t<T, float>::v) { return pack8(*(const f32x4*)p, *(const f32x4*)(p + 4)); }
    else { return *reinterpret_cast<const bf16x8*>(p); }
}
__device__ __forceinline__ void mask_tile(f32x16& p0, f32x16& p1, int dq, unsigned W) {
    const float NEG = -__builtin_inff();
#pragma unroll
    for (int r = 0; r < 16; ++r) {
        const int c = (r & 3) + 8 * (r >> 2);
        if ((unsigned)(dq - c) >= W) p0[r] = NEG;
        if ((unsigned)(dq - c - 32) >= W) p1[r] = NEG;
    }
}
__device__ __forceinline__ void partialSM(f32x16& p0, f32x16& p1, float& m_reg, float& mn, float& alpha) {
    float pmax = p0[0]; for (int r = 1; r < 16; ++r) pmax = fmaxf(pmax, p0[r]); for (int r = 0; r < 16; ++r) pmax = fmaxf(pmax, p1[r]);
    { auto rr = __builtin_amdgcn_permlane32_swap(__float_as_uint(pmax), __float_as_uint(pmax), false, false);
      pmax = fmaxf(__uint_as_float(rr[0]), __uint_as_float(rr[1])); }
    constexpr float THR2 = THR * 1.4426950408889634f;
    if (__builtin_expect(__all((pmax - m_reg) <= THR2), 1)) { mn = m_reg; alpha = 1.f; }
    else { mn = fmaxf(m_reg, pmax); alpha = __builtin_amdgcn_exp2f(m_reg - mn); m_reg = mn; }
    for (int r = 0; r < 16; ++r) p0[r] = p0[r] - mn; for (int r = 0; r < 16; ++r) p1[r] = p1[r] - mn;
    for (int r = 0; r < 16; ++r) p0[r] = __builtin_amdgcn_exp2f(p0[r]);
}
__device__ __forceinline__ void finishSM(f32x16& p0, f32x16& p1, float alpha, float& l_reg, bf16x8& pa0, bf16x8& pa1, bf16x8& pa2, bf16x8& pa3) {
    for (int r = 0; r < 16; ++r) p1[r] = __builtin_amdgcn_exp2f(p1[r]);
    float ps = 0; for (int r = 0; r < 16; ++r) ps += p0[r]; for (int r = 0; r < 16; ++r) ps += p1[r];
    { auto rr = __builtin_amdgcn_permlane32_swap(__float_as_uint(ps), __float_as_uint(ps), false, false);
      ps = __uint_as_float(rr[0]) + __uint_as_float(rr[1]); }
    l_reg = l_reg * alpha + ps;
#define PK4(P, B_, OUT) do { unsigned a0 = cvtpk(P[B_+0], P[B_+1]), a1 = cvtpk(P[B_+2], P[B_+3]);                          \
        unsigned b0 = cvtpk(P[B_+4], P[B_+5]), b1 = cvtpk(P[B_+6], P[B_+7]);                                             \
        auto r0 = __builtin_amdgcn_permlane32_swap(a0, b0, false, false); auto r1 = __builtin_amdgcn_permlane32_swap(a1, b1, false, false); \
        u32x4 w = {r0[0], r1[0], r0[1], r1[1]}; OUT = *reinterpret_cast<bf16x8*>(&w); } while (0)
    PK4(p0, 0, pa0); PK4(p0, 8, pa1); PK4(p1, 0, pa2); PK4(p1, 8, pa3);
#undef PK4
}
template <int KB, bool SK>
__device__ __forceinline__ void qkt(f32x16& p0, f32x16& p1, const char* K_lds, int r32, int hi, const bf16x8* qr, bool act, const char* fb) {
    if (SK && !act) { const float NEG = -__builtin_inff();
#pragma unroll
        for (int r = 0; r < 16; ++r) { p0[r] = NEG; p1[r] = NEG; } return; }
#pragma unroll
    for (int q = 0; q < 4; ++q) { const f32x4 b0 = *reinterpret_cast<const f32x4*>(fb + q * 32), b1 = *reinterpret_cast<const f32x4*>(fb + 128 + q * 32);
#pragma unroll
        for (int i = 0; i < 4; ++i) { p0[4 * q + i] = b0[i]; p1[4 * q + i] = b1[i]; } }
    const char* kb[4];
#pragma unroll
    for (int dd = 0; dd < 4; ++dd) kb[dd] = K_lds + KB * SHM_K + KSWZ(r32, (dd * 16 + hi * 8) * 2);
#pragma unroll
    for (int d0 = 0; d0 < 8; ++d0) { const char* a = kb[d0 & 3] + (d0 >> 2) * 128;
        bf16x8 b0 = *reinterpret_cast<const bf16x8*>(a);
        bf16x8 b1 = *reinterpret_cast<const bf16x8*>(a + 32 * 256);
        p0 = __builtin_amdgcn_mfma_f32_32x32x16_bf16(b0, qr[d0], p0, 0, 0, 0);
        p1 = __builtin_amdgcn_mfma_f32_32x32x16_bf16(b1, qr[d0], p1, 0, 0, 0); }
}
template <int VB, bool SK>
__device__ __forceinline__ void pv_tile(f32x16* o, int vb0, bf16x8 pa0, bf16x8 pa1, bf16x8 pa2, bf16x8 pa3, bool act) {
    if (SK && !act) return;
#define TRRD(dst, off) asm volatile("ds_read_b64_tr_b16 %0, %1 offset:%2" : "=&v"(dst) : "v"(vb0), "i"(off) : "memory")
#define PV_D0(d0) do { s16x4 l0, l1, l2, l3, h0, h1, h2, h3; constexpr int b_ = VB * SHM_V + v_rd_off(d0, 0, 0);     \
        TRRD(l0, b_); TRRD(h0, b_ + 2048); TRRD(l1, b_ + 4096); TRRD(h1, b_ + 6144); TRRD(l2, b_ + 8192); TRRD(h2, b_ + 10240); TRRD(l3, b_ + 12288); TRRD(h3, b_ + 14336); \
        asm volatile("s_waitcnt lgkmcnt(0)" ::: "memory"); SBAR();                 \
        o[d0] = __builtin_amdgcn_mfma_f32_32x32x16_bf16(pa0, (bf16x8){l0[0], l0[1], l0[2], l0[3], h0[0], h0[1], h0[2], h0[3]}, o[d0], 0, 0, 0);   \
        o[d0] = __builtin_amdgcn_mfma_f32_32x32x16_bf16(pa1, (bf16x8){l1[0], l1[1], l1[2], l1[3], h1[0], h1[1], h1[2], h1[3]}, o[d0], 0, 0, 0);   \
        o[d0] = __builtin_amdgcn_mfma_f32_32x32x16_bf16(pa2, (bf16x8){l2[0], l2[1], l2[2], l2[3], h2[0], h2[1], h2[2], h2[3]}, o[d0], 0, 0, 0);   \
        o[d0] = __builtin_amdgcn_mfma_f32_32x32x16_bf16(pa3, (bf16x8){l3[0], l3[1], l3[2], l3[3], h3[0], h3[1], h3[2], h3[3]}, o[d0], 0, 0, 0); } while (0)
    PV_D0(0); PV_D0(1); PV_D0(2); PV_D0(3);
#undef PV_D0
#undef TRRD
}
template <class TIn, class TOut> struct BlockRef { const TIn* Q; const TIn* K; const TIn* V; TOut* O; const float* FB; int P0; };
template <class TIn> struct Seam {
    bf16x8 qr[8];
    bf16x8 st_v0, st_v1, st_k0, st_k1; f32x4 sf0, sf1, sf2, sf3;
    f32x4 tq[16];
};
__device__ __forceinline__ int swa_jlo(int P0, int W) { const int lowk = P0 - W + 1; return lowk > 0 ? lowk / KVBLK : 0; }
#define ROW(p, k0, rr) ((p) + (size_t)((k0) + (rr)) * D + sc)
#define VMW() asm volatile("s_waitcnt vmcnt(0)" ::: "memory")
#define VMWN(n) asm volatile("s_waitcnt vmcnt(%0)" :: "i"(n) : "memory")
#define SLOAD_H(Kp, Vp, k0) do { S.st_v0 = load8<TIn>(ROW(Vp, k0, sr)); S.st_v1 = load8<TIn>(ROW(Vp, k0, 32 + sr));              \
                         S.st_k0 = load8<TIn>(ROW(Kp, k0, sr)); S.st_k1 = load8<TIn>(ROW(Kp, k0, 32 + sr)); } while (0)
#define SWRITE_HK(bf) do { *(bf16x8*)(K_lds + (bf) * SHM_K + kws) = S.st_k0; *(bf16x8*)(K_lds + (bf) * SHM_K + kws + 32 * 256) = S.st_k1; } while (0)
#define SWRITE_HV(bf) do { *(bf16x8*)(V_lds + (bf) * SHM_V + vst0) = S.st_v0; *(bf16x8*)(V_lds + (bf) * SHM_V + vst1) = S.st_v1; } while (0)
#define SWRITE_H(bf) do { SWRITE_HV(bf); SWRITE_HK(bf); } while (0)
#define SLOAD_F(p, k0) do { S.sf0 = *(const f32x4*)ROW(p, k0, sr); S.sf1 = *(const f32x4*)(ROW(p, k0, sr) + 4);                \
                            S.sf2 = *(const f32x4*)ROW(p, k0, 32 + sr); S.sf3 = *(const f32x4*)(ROW(p, k0, 32 + sr) + 4); } while (0)
#define SWRITE_KF(bf) do { *(bf16x8*)(K_lds + (bf) * SHM_K + kws) = pack8(S.sf0, S.sf1); *(bf16x8*)(K_lds + (bf) * SHM_K + kws + 32 * 256) = pack8(S.sf2, S.sf3); } while (0)
#define SWRITE_VF(bf) do { *(bf16x8*)(V_lds + (bf) * SHM_V + vst0) = pack8(S.sf0, S.sf1); *(bf16x8*)(V_lds + (bf) * SHM_V + vst1) = pack8(S.sf2, S.sf3); } while (0)
template <class TIn, class TOut>
__device__ __forceinline__ void causal_swa_prime(const BlockRef<TIn, TOut>& cur, int W, char* lds, Seam<TIn>& S) {
    constexpr bool F32 = same_t<TIn, float>::v;
    const int tid = ltid(), wid = __builtin_amdgcn_readfirstlane(tid >> 6), lane = tid & 63, r32 = lane & 31, hi = lane >> 5;
    const int sr = tid >> 4, sc = (tid & 15) * 8, kws = KSWZ(sr, sc * 2); char* K_lds = lds + 2 * SHM_V;
    const int kb0 = swa_jlo(cur.P0, W) * KVBLK;
    for (int d0 = 0; d0 < 8; ++d0) S.qr[d0] = load8<TIn>(cur.Q + (size_t)(wid * QBLK + r32) * D + d0 * 16 + hi * 8);
    if constexpr (F32) { SLOAD_F((const float*)cur.K, kb0); VMW(); SWRITE_KF(0); SBAR(); SLOAD_F((const float*)cur.V, kb0); }
    else { SLOAD_H(cur.K, cur.V, kb0); VMW(); SWRITE_HK(0); }
    __syncthreads();
}
template <class TIn, class TOut>
__device__ __forceinline__ void causal_swa_block(const BlockRef<TIn, TOut>& cur, const BlockRef<TIn, TOut>& nxt, int skv, int W, char* lds, Seam<TIn>& S) {
    constexpr bool F32 = same_t<TIn, float>::v;
    const int tid = ltid(), wid = __builtin_amdgcn_readfirstlane(tid >> 6), lane = tid & 63, r32 = lane & 31, hi = lane >> 5;
    const int j_lo = swa_jlo(cur.P0, W);
    int j_hi = (cur.P0 + QB - 1) / KVBLK + 1; if (j_hi > skv / KVBLK) j_hi = skv / KVBLK;
    const int NT = j_hi - j_lo;
    const int kbn = swa_jlo(nxt.P0, W) * KVBLK;
    const int qlo = cur.P0 + wid * QBLK, qm = qlo + r32 - 4 * hi;
    char* V_lds = lds; char* K_lds = lds + 2 * SHM_V;
    float* ws = (float*)(lds + 2 * SHM_V + 2 * SHM_K) + wid * 64; float* li_l = ws, * al_l = ws + 32;
    float m_reg = -1e30f, l_reg = 0; f32x16 o[4] = {};
    float* fbuf = (float*)(lds + LDS_FB);
    { const int nk = cur.P0 + QB;
      for (int i4 = tid * 4; i4 < nk; i4 += 64 * NW * 4) *(f32x4*)(fbuf + i4) = *(const f32x4*)(cur.FB + i4);
      __syncthreads(); }
    const char* fbl = (const char*)fbuf + hi * 16;
    const int sr = tid >> 4, sc = (tid & 15) * 8, vst0 = v_st(sr, sc), vst1 = v_st(32 + sr, sc), kws = KSWZ(sr, sc * 2);
    const int vb0 = (int)(uintptr_t)V_lds + v_rd_base(lane);
    const TIn* Kh = cur.K; const TIn* Vh = cur.V;
#define RESC(a) do { if (__any((a) < 1.f)) { if (hi == 0) al_l[r32] = (a); asm volatile("s_waitcnt lgkmcnt(0)" ::: "memory");              \
                     for (int d_ = 0; d_ < 4; ++d_) for (int r = 0; r < 16; ++r) o[d_][r] *= al_l[crow(r, hi)]; } } while (0)
#define KBASE(t) ((j_lo + (t)) * KVBLK)
#define ACT(t) (KBASE(t) <= qlo + QBLK - 1 && KBASE(t) + KVBLK - 1 >= qlo - W + 1)
#define MASKT(P0_, P1_, t) do { const int kb_ = KBASE(t); if ((!SK || ACT(t)) && (kb_ + KVBLK - 1 > qlo || kb_ <= qlo + QBLK - 1 - W)) mask_tile(P0_, P1_, qm - kb_, (unsigned)W); } while (0)
    constexpr int NQL = F32 ? 16 : 8;
    constexpr bool SK = WSKIP && !F32;
#define SEAM_K0() do { VMWN(NQL); if constexpr (F32) { SWRITE_KF(0); SBAR(); SLOAD_F((const float*)nxt.V, kbn); } else { SWRITE_HK(0); } SBAR(); } while (0)
    f32x16 pA0, pA1, pB0, pB1; float mnA, mnB, alA, alB; bf16x8 pa0, pa1, pa2, pa3;
    if constexpr (F32) { VMW(); SWRITE_VF(0); SBAR(); } else { SWRITE_HV(0); SBAR(); }
    if (NT > 1) { if constexpr (F32) SLOAD_F((const float*)Kh, KBASE(1)); else SLOAD_H(Kh, Vh, KBASE(1)); }
    SBAR(); qkt<0, SK>(pA0, pA1, K_lds, r32, hi, S.qr, ACT(0), fbl + KBASE(0) * 4);
    if constexpr (F32) { if (NT > 1) { VMW(); SWRITE_KF(1); SBAR(); SLOAD_F((const float*)Vh, KBASE(1)); } }
    MASKT(pA0, pA1, 0); partialSM(pA0, pA1, m_reg, mnA, alA);
    if (NT > 1) { VMW(); if constexpr (F32) { SWRITE_VF(1); SBAR(); if (NT > 2) SLOAD_F((const float*)Kh, KBASE(2)); } else SWRITE_H(1); }
    __syncthreads();
#define HALF_STEP(PX0, PX1, mnX, alX, PY0, PY1, alY, t, KB, VB, SB) do {                                                      \
        SBAR(); qkt<KB, SK>(PX0, PX1, K_lds, r32, hi, S.qr, ACT(t), fbl + KBASE(t) * 4);                                             \
        finishSM(PY0, PY1, alY, l_reg, pa0, pa1, pa2, pa3); SBAR();                                                           \
        if ((t) + 1 < NT) { if constexpr (F32) { VMW(); SWRITE_KF(SB); SBAR(); SLOAD_F((const float*)Vh, KBASE((t) + 1)); }  \
                            else { SLOAD_H(Kh, Vh, KBASE((t) + 1)); } SBAR(); }                                               \
        pv_tile<VB, SK>(o, vb0, pa0, pa1, pa2, pa3, ACT((t) - 1)); MASKT(PX0, PX1, (t)); partialSM(PX0, PX1, m_reg, mnX, alX);                                        \
        __syncthreads();                                                                                                      \
        if ((t) + 1 < NT) { VMW(); if constexpr (F32) { SWRITE_VF(SB); SBAR(); if ((t) + 2 < NT) SLOAD_F((const float*)Kh, KBASE((t) + 2)); } \
                            else { SWRITE_H(SB); } }                                                                          \
        RESC(alX); __syncthreads(); } while (0)
    for (int t = 1; t + 1 < NT; t += 2) {
        HALF_STEP(pB0, pB1, mnB, alB, pA0, pA1, alA, t, 1, 0, 0);
        HALF_STEP(pA0, pA1, mnA, alA, pB0, pB1, alB, t + 1, 0, 1, 1);
    }
    const bool even = (NT & 1) == 0;
    if (even) { SBAR(); qkt<1, SK>(pB0, pB1, K_lds, r32, hi, S.qr, ACT(NT - 1), fbl + KBASE(NT - 1) * 4); SBAR(); }
#define QROW(e) (nxt.Q + (size_t)(wid * QBLK + r32) * D + ((e) >> 1) * 16 + hi * 8 + ((e) & 1) * 4)
    if constexpr (F32) { SLOAD_F((const float*)nxt.K, kbn); SBAR();
#pragma unroll
        for (int e = 0; e < 8; ++e) S.tq[e] = *(const f32x4*)QROW(e); }
    else { SLOAD_H(nxt.K, nxt.V, kbn); SBAR();
#pragma unroll
        for (int d0 = 0; d0 < 8; ++d0) S.qr[d0] = load8<TIn>(nxt.Q + (size_t)(wid * QBLK + r32) * D + d0 * 16 + hi * 8); }
    SBAR();
    finishSM(pA0, pA1, alA, l_reg, pa0, pa1, pa2, pa3); SBAR();
    if constexpr (F32) {
#pragma unroll
        for (int e = 8; e < 16; ++e) S.tq[e] = *(const f32x4*)QROW(e); SBAR(); }
#undef QROW
    pv_tile<0, SK>(o, vb0, pa0, pa1, pa2, pa3, ACT(even ? NT - 2 : NT - 1));
    if (even) { MASKT(pB0, pB1, NT - 1); partialSM(pB0, pB1, m_reg, mnB, alB); __syncthreads(); RESC(alB);
        finishSM(pB0, pB1, alB, l_reg, pa0, pa1, pa2, pa3); SBAR(); pv_tile<1, SK>(o, vb0, pa0, pa1, pa2, pa3, ACT(NT - 1)); }
    SBAR(); SEAM_K0();
    if (hi == 0) li_l[r32] = l_reg; asm volatile("s_waitcnt lgkmcnt(0)" ::: "memory");
    float rli[16];
#pragma unroll
    for (int r = 0; r < 16; ++r) rli[r] = __builtin_amdgcn_rcpf(li_l[crow(r, hi)]);
    TOut* Ow = cur.O + (size_t)(wid * QBLK) * OPITCH;
#pragma unroll
    for (int r = 0; r < 16; ++r) { const int orow = crow(r, hi);
#pragma unroll
        for (int d0 = 0; d0 < 4; ++d0) { const float v = o[d0][r] * rli[r];
            if constexpr (same_t<TOut, float>::v) { Ow[(size_t)orow * OPITCH + d0 * 32 + r32] = v; }
            else { const float vn = __shfl_xor(v, 1);
                   if ((r32 & 1) == 0) *(unsigned*)(Ow + (size_t)orow * OPITCH + d0 * 32 + r32) = cvtpk(v, vn); } } }
    if constexpr (F32) {
#pragma unroll
        for (int d0 = 0; d0 < 8; ++d0) S.qr[d0] = pack8(S.tq[2 * d0], S.tq[2 * d0 + 1]); }
    __syncthreads();
#undef RESC
#undef KBASE
#undef ACT
#undef MASKT
#undef SEAM_K0
#undef HALF_STEP
}
#undef ROW
#undef VMW
#undef VMWN
#undef SLOAD_H
#undef SWRITE_HK
#undef SWRITE_HV
#undef SWRITE_H
#undef SLOAD_F
#undef SWRITE_KF
#undef SWRITE_VF
constexpr int NQB = SQ / QB, NXI = NQB / 2, NITEMS = NXI * B * H;
struct SwaItem { int bh, qb0, qb1; };
__device__ __forceinline__ SwaItem swa_decode(int L) { SwaItem it; const int xcd = L & 7, k = L >> 3; it.bh = (k / NXI) * 8 + xcd; const int x = k % NXI; it.qb0 = x; it.qb1 = NQB - 1 - x; return it; }
template <class TIn, class TOut>
__device__ __forceinline__ BlockRef<TIn, TOut> swa_ref(const SwaItem& it, int pass, const TIn* Q, const TIn* K, const TIn* V, TOut* O, const float* FB) {
    const int qb = pass ? it.qb1 : it.qb0;
    BlockRef<TIn, TOut> r;
    r.Q = Q + ((size_t)it.bh * SQ + (size_t)qb * QB) * D;
    r.O = O + ((size_t)(it.bh / H) * SQ + (size_t)qb * QB) * OPITCH + (it.bh % H) * D;
    r.K = K + (size_t)it.bh * SKV * D; r.V = V + (size_t)it.bh * SKV * D; r.FB = FB + (size_t)it.bh * SKV; r.P0 = qb * QB;
    return r;
}
__device__ __forceinline__ void att_phase(char* lds, const bf16* Q, const bf16* K, const bf16* V, bf16* O, const float* FB, int wg, int nwg) {
    int L = wg; if (L >= NITEMS) return;
    SwaItem it = swa_decode(L); int pass = 0;
    BlockRef<bf16, bf16> cur = swa_ref<bf16, bf16>(it, 0, Q, K, V, O, FB);
    Seam<bf16> S;
    causal_swa_prime<bf16, bf16>(cur, WINDOW, lds, S);
    for (;;) {
        const bool more_pass = pass == 0 && it.qb1 != it.qb0, more_item = L + nwg < NITEMS, last = !more_pass && !more_item;
        SwaItem itn = it; int passn = pass + 1, Ln = L;
        if (!more_pass) { passn = 0; Ln = more_item ? L + nwg : L; itn = swa_decode(Ln); }
        const BlockRef<bf16, bf16> nxt = last ? cur : swa_ref<bf16, bf16>(itn, passn, Q, K, V, O, FB);
        causal_swa_block<bf16, bf16>(cur, nxt, SKV, WINDOW, lds, S);
        if (last) break;
        cur = nxt; it = itn; pass = passn; L = Ln;
    }
}
}
constexpr int DM = 2048, NBATCH = 8, SEQ = 4096, DEPTH = 4, NHEAD = 16, HDIM = 128, DFF = 5504, NFF2 = 2 * DFF, MTOK = NBATCH * SEQ;
constexpr int NQKVF = 3 * DM + NHEAD;
constexpr float EPS = 1e-6f;
constexpr int NWAVES = 8;
#ifndef MK_PER_PHASE
#define MK_PER_PHASE 0
#endif
constexpr size_t MiB = 1u << 20;
constexpr size_t WS_CTL = 0, CTL_ZERO_BYTES = 3 * MiB + 512 * 1024;
constexpr size_t WS_RSS = 1 * MiB;
constexpr size_t WS_VSS = 3 * MiB;
constexpr size_t WS_MOD = 3 * MiB + 512 * 1024;
constexpr size_t WS_SHT = 5 * MiB;
constexpr size_t WS_BIASV = 5 * MiB + 512 * 1024;
constexpr size_t WS_LOGF = 7 * MiB + 512 * 1024;
constexpr size_t WS_FB = 9 * MiB + 512 * 1024;
constexpr size_t WS_WQKV = 12 * MiB;
constexpr size_t WQKV_STRIDE = 25 * MiB / 2;
constexpr size_t WS_WO = 62 * MiB;
constexpr size_t WS_WGI = 78 * MiB;
constexpr size_t WS_WGO = 110 * MiB;
constexpr size_t WS_WF1 = 126 * MiB;
constexpr size_t WS_WF2 = 298 * MiB;
constexpr size_t WS_H = 384 * MiB;
constexpr size_t WS_H2 = 512 * MiB;
constexpr size_t WS_XB = 640 * MiB;
constexpr size_t WS_R = 768 * MiB;
constexpr size_t WS_END = WS_R + 384 * MiB;
constexpr int BV_QKVF = 0, BV_GI = 2 * 8 * NQKVF, BV_F1 = BV_GI + 2 * 8 * 4096;
constexpr int CW_TMO = 0, CW_BAR = 4096;

constexpr int RING_OFF = 0, RING_BYTES = 131072, XCH_OFF = 131072;
constexpr int CWT_OFF = 131072 + 14336;
constexpr int LDSCTL_OFF = 155648, MISC_OFF = LDSCTL_OFF + 320;
constexpr int LDS_BYTES = 159744;

#define GAS __attribute__((address_space(1)))
#define LAS __attribute__((address_space(3)))
typedef unsigned short bf16;
typedef unsigned v4u __attribute__((ext_vector_type(4)));
typedef unsigned v2u __attribute__((ext_vector_type(2)));
typedef float f32x4 __attribute__((ext_vector_type(4)));
typedef short bf16x8 __attribute__((ext_vector_type(8)));
typedef GAS unsigned gu32;
typedef unsigned long long u64;
constexpr float FIXS = 1048576.0f, FIXI = 1.0f / (1048576.0f * 2048.0f);
__device__ __forceinline__ float rstd_of(u64 v) { return __builtin_amdgcn_rsqf((float)v * FIXI + 1e-6f); }
#define RLX_AGENT __ATOMIC_RELAXED, __HIP_MEMORY_SCOPE_AGENT
#define LDS_WAIT() asm volatile("s_waitcnt lgkmcnt(0)" ::: "memory")
#define VM_WAIT() asm volatile("s_waitcnt vmcnt(0)" ::: "memory")
__device__ __forceinline__ unsigned f2bf(float f) { unsigned u = __builtin_bit_cast(unsigned, f); return (u + 0x7fffu + ((u >> 16) & 1u)) >> 16; }
__device__ __forceinline__ unsigned pk2(float lo, float hi) { return f2bf(lo) | (f2bf(hi) << 16); }
__device__ __forceinline__ float bf2f(unsigned short b) { return __builtin_bit_cast(float, (unsigned)b << 16); }
__device__ __forceinline__ float bflo(unsigned w) { return __builtin_bit_cast(float, w << 16); }
__device__ __forceinline__ float bfhi(unsigned w) { return __builtin_bit_cast(float, w & 0xffff0000u); }
#define XB_TMO      128
#define XB_XCNT(j)  (256  + 64 * (j))
#define XB_XSUB(j)  (1280 + 64 * (j))
#define XB_XGEN(j)  (2304 + 64 * (j))
#define XB_TOP      3328
#define XB_TOPGEN   3392
#define XCD_BAR_WORDS 3456
#define XB_SPIN_CAP (1u << 18)

__device__ __forceinline__ unsigned xb_ld(unsigned* p)              { return __hip_atomic_load((GAS unsigned*)p, __ATOMIC_RELAXED, __HIP_MEMORY_SCOPE_AGENT); }
__device__ __forceinline__ unsigned xb_add(unsigned* p, unsigned v) { return __hip_atomic_fetch_add((GAS unsigned*)p, v, __ATOMIC_RELAXED, __HIP_MEMORY_SCOPE_AGENT); }
__device__ __forceinline__ unsigned xb_xcc_id() { return (unsigned)__builtin_amdgcn_s_getreg((3 << 11) | 20) & 0xFu; }
#define XB_SPIN(cond, bar) do { unsigned _sp = 0; while (cond) { __builtin_amdgcn_s_sleep(1); \
    if ((++_sp & 255u) == 0u) { if (xb_ld(&(bar)[XB_TMO])) break; if (_sp > XB_SPIN_CAP) { xb_add(&(bar)[XB_TMO], 1u); break; } } } } while (0)

struct XcdBarrier {
    unsigned* bar; unsigned x;
    volatile LAS unsigned* st;
};

__device__ __forceinline__ XcdBarrier xcd_barrier_post(unsigned* bar, volatile LAS unsigned* st) {
    XcdBarrier b; b.bar = bar; b.x = xb_xcc_id(); b.st = st;
    if (threadIdx.x == 0) (void)xb_add(&bar[XB_XCNT(b.x)], 1u);
    return b;
}
__device__ __forceinline__ void xcd_barrier_complete(unsigned* bar, unsigned x, unsigned& nloc, unsigned& nx) {
    const unsigned G = gridDim.x * gridDim.y * gridDim.z;
    unsigned sum, cnt, mine, sp = 0u;
    for (;;) {
        sum = 0u; cnt = 0u; mine = 0u;
#pragma unroll
        for (unsigned j = 0; j < 16; ++j) { const unsigned c = xb_ld(&bar[XB_XCNT(j)]); sum += c; cnt += (c > 0u) ? 1u : 0u; mine = (j == x) ? c : mine; }
        if (sum == G) break;
        __builtin_amdgcn_s_sleep(1);
        if ((++sp & 255u) == 0u) { if (xb_ld(&bar[XB_TMO])) break; if (sp > XB_SPIN_CAP) { xb_add(&bar[XB_TMO], 1u); break; } }
    }
    nloc = mine > 0u ? mine : 1u; nx = cnt > 0u ? cnt : 1u;
}

__device__ __forceinline__ void xcd_barrier(const XcdBarrier& b) {
    asm volatile("s_waitcnt vmcnt(0)" ::: "memory");
    __syncthreads();
    if (threadIdx.x == 0) {
        unsigned* bar = b.bar;
        __builtin_amdgcn_s_waitcnt(0);
        unsigned nloc = b.st[0], nx = b.st[1];
        if (nloc == 0u) { xcd_barrier_complete(bar, b.x, nloc, nx); b.st[0] = nloc; b.st[1] = nx; }
        const unsigned old = xb_add(&bar[XB_XSUB(b.x)], 1u);
        const unsigned gen = old / nloc;
        if (old + 1u == (gen + 1u) * nloc) {
            __builtin_amdgcn_fence(__ATOMIC_RELEASE, "agent");
            asm volatile("s_waitcnt vmcnt(0)" ::: "memory");
            const unsigned og = xb_add(&bar[XB_TOP], 1u);
            const unsigned tg = og / nx;
            if (og + 1u == (tg + 1u) * nx) xb_add(&bar[XB_TOPGEN], 1u);
            else XB_SPIN(xb_ld(&bar[XB_TOPGEN]) == tg, bar);
            __builtin_amdgcn_fence(__ATOMIC_ACQUIRE, "agent");
            xb_add(&bar[XB_XGEN(b.x)], 1u);
            asm volatile("s_waitcnt vmcnt(0)" ::: "memory");
        } else {
            XB_SPIN(xb_ld(&bar[XB_XGEN(b.x)]) == gen, bar);
            __builtin_amdgcn_fence(__ATOMIC_ACQUIRE, "agent");
            asm volatile("s_waitcnt vmcnt(0)" ::: "memory");
        }
    }
    __syncthreads();
}
struct Frame {
    LAS unsigned char* lds; char* ldsg;
    volatile LAS unsigned* MISC;
    int tid, lane, wave, vcu, G, bid;
    const GAS float* const __attribute__((address_space(4)))* inp;
    GAS float* outg; GAS unsigned char* wsg;
    __device__ __forceinline__ const float* in(int i) const { return (const float*)inp[i]; }
};
enum { IN_X = 0, IN_C, IN_MODW, IN_MODB, IN_MIXG, IN_FFNG, IN_AWIN, IN_ABF, IN_AWO, IN_GWIN, IN_GVG, IN_GWS, IN_GBS, IN_GWO, IN_FWIN, IN_FCW, IN_FCB, IN_FWOUT, IN_FING };
enum { MW_BID = 16, MW_G, MW_VCU, MW_INP, MW_INP_HI, MW_WS, MW_WS_HI, MW_OUT, MW_OUT_HI };
__device__ __forceinline__ unsigned misc_rd(const Frame& F, int k) { return (unsigned)__builtin_amdgcn_readfirstlane((int)F.MISC[k]); }
__device__ __forceinline__ bool relaunder(Frame& F) {
    int t = (int)threadIdx.x; asm volatile("" : "+v"(t)); F.tid = t; F.lane = t & 63; F.wave = __builtin_amdgcn_readfirstlane(t >> 6);
    F.bid = (int)misc_rd(F, MW_BID); F.G = (int)misc_rd(F, MW_G); F.vcu = (int)misc_rd(F, MW_VCU);
    F.inp = (const GAS float* const __attribute__((address_space(4)))*)(((unsigned long long)misc_rd(F, MW_INP_HI) << 32) | misc_rd(F, MW_INP));
    F.wsg = (GAS unsigned char*)(((unsigned long long)misc_rd(F, MW_WS_HI) << 32) | misc_rd(F, MW_WS));
    F.outg = (GAS float*)(((unsigned long long)misc_rd(F, MW_OUT_HI) << 32) | misc_rd(F, MW_OUT));
    return true; }
__device__ __forceinline__ float wave_sum(float v) {
#pragma unroll
    for (int o = 1; o < 64; o <<= 1) v += __shfl_xor(v, o);
    return v;
}
__device__ __forceinline__ void transpose_item(const float* W, int ldw, int K, bf16* WT, int k0, int n0, int dst_row0, int ncols, LAS float* scr, int lane) {
    const int nl = lane & 31;
#pragma unroll 8
    for (int i = 0; i < 32; ++i) { const int kk = 2 * i + (lane >> 5); if (nl < ncols) scr[kk * 33 + nl] = W[(size_t)(k0 + kk) * ldw + n0 + nl]; }
    LDS_WAIT(); asm volatile("" ::: "memory");
    const int c = lane & 7;
#pragma unroll
    for (int j = 0; j < 4; ++j) { const int n = (lane >> 3) + 8 * j; const LAS float* s = scr + (8 * c) * 33 + n;
        if (n < ncols) { v4u o; o.x = pk2(s[0 * 33], s[1 * 33]); o.y = pk2(s[2 * 33], s[3 * 33]); o.z = pk2(s[4 * 33], s[5 * 33]); o.w = pk2(s[6 * 33], s[7 * 33]);
            *(GAS v4u*)(WT + (size_t)(dst_row0 + n) * K + k0 + 8 * c) = o; } }
    LDS_WAIT(); asm volatile("" ::: "memory");
}
__device__ __forceinline__ void pro_a_phase(Frame& F) {
    __syncthreads();
    {
        LAS float* cact = (LAS float*)(F.lds + RING_OFF);
        LAS float* red = (LAS float*)(F.lds + RING_OFF + 65536);
        float* mod = (float*)((unsigned char*)F.wsg + WS_MOD); float* sht = (float*)((unsigned char*)F.wsg + WS_SHT);
        for (int item = F.bid; item < 192; item += F.G) {
            for (int idx = F.tid; idx < NBATCH * DM; idx += NWAVES * 64) { const int b = idx >> 11, k = idx & 2047; const float v = F.in(IN_C)[idx]; cact[k * 8 + b] = v / (1.0f + __expf(-v)); }
            __syncthreads();
            const int i = item / 48, nbase = (item % 48) * 256;
            const float* wp = F.in(IN_MODW) + ((size_t)i * DM + F.wave * 256) * 12288 + nbase + F.lane * 4;
            f32x4 acc[8];
#pragma unroll
            for (int b = 0; b < 8; ++b) acc[b] = (f32x4){0.f, 0.f, 0.f, 0.f};
#pragma unroll 8
            for (int kk = 0; kk < 256; ++kk) {
                const f32x4 w = *(const GAS f32x4*)(wp + (size_t)kk * 12288);
                const LAS f32x4* cp = (const LAS f32x4*)(cact + (F.wave * 256 + kk) * 8);
                const f32x4 c0 = cp[0], c1 = cp[1];
                acc[0] += w * c0.x; acc[1] += w * c0.y; acc[2] += w * c0.z; acc[3] += w * c0.w;
                acc[4] += w * c1.x; acc[5] += w * c1.y; acc[6] += w * c1.z; acc[7] += w * c1.w;
            }
#pragma unroll
            for (int b = 0; b < 8; ++b) *(LAS f32x4*)(red + (F.wave * 8 + b) * 256 + F.lane * 4) = acc[b];
            __syncthreads();
            for (int o = F.tid; o < 2048; o += NWAVES * 64) { const int b = o >> 8, col = o & 255, gc = nbase + col; float s = 0.f;
#pragma unroll
                for (int w = 0; w < 8; ++w) s += red[(w * 8 + b) * 256 + col];
                s += F.in(IN_MODB)[i * 12288 + gc];
                mod[((size_t)i * 8 + b) * 12288 + gc] = s;
                if (gc < DM) sht[((size_t)(2 * i) * DM + gc) * 8 + b] = s;
                else if (gc >= 3 * DM && gc < 4 * DM) sht[((size_t)(2 * i + 1) * DM + (gc - 3 * DM)) * 8 + b] = s; }
            __syncthreads();
        }
    }
    LAS float* scr = (LAS float*)(F.lds + RING_OFF + F.wave * 16384);
    const int gw = F.vcu * NWAVES + F.wave, NGW = F.G * NWAVES;
    constexpr int I_O = 32 * 64, I_GO = 32 * 64, I_F2 = 86 * 64;
    constexpr int NITEMS = 2 * (I_O + I_GO) + 4 * I_F2;
    bf16* Wo = (bf16*)((unsigned char*)F.wsg + WS_WO); bf16* Wgo = (bf16*)((unsigned char*)F.wsg + WS_WGO); bf16* Wf2 = (bf16*)((unsigned char*)F.wsg + WS_WF2);
    for (int it = gw; it < NITEMS; it += NGW) {
        int r = it;
        if (r < 2 * I_O) { const int j = r / I_O, q = r % I_O, kb = q / 64, nb = q % 64;
            transpose_item(F.in(IN_AWO) + (size_t)j * DM * DM, DM, DM, Wo + (size_t)j * DM * DM, 64 * kb, 32 * nb, 32 * nb, 32, scr, F.lane); continue; } r -= 2 * I_O;
        if (r < 2 * I_GO) { const int j = r / I_GO, q = r % I_GO, kb = q / 64, nb = q % 64;
            transpose_item(F.in(IN_GWO) + (size_t)j * DM * DM, DM, DM, Wgo + (size_t)j * DM * DM, 64 * kb, 32 * nb, 32 * nb, 32, scr, F.lane); continue; } r -= 2 * I_GO;
        { const int j = r / I_F2, q = r % I_F2, kb = q / 64, nb = q % 64;
            transpose_item(F.in(IN_FWOUT) + (size_t)j * DFF * DM, DM, DFF, Wf2 + (size_t)j * DM * DFF, 64 * kb, 32 * nb, 32 * nb, 32, scr, F.lane); }
    }
}
__device__ __forceinline__ void strip_item(const float* W, int ldw, bf16* WT, int n0, int dst_row0, int ncols, const float* sht, float* bias, int bpitch, LAS float* scr, int lane) {
    const int nl = lane & 31, bh = lane >> 5, c = lane & 7;
    f32x4 acc = (f32x4){0.f, 0.f, 0.f, 0.f};
    for (int kb = 0; kb < DM / 64; ++kb) { const int k0 = 64 * kb;
#pragma unroll 8
        for (int i = 0; i < 32; ++i) { const int kk = 2 * i + (lane >> 5); if (nl < ncols) scr[kk * 33 + nl] = W[(size_t)(k0 + kk) * ldw + n0 + nl]; }
        LDS_WAIT(); asm volatile("" ::: "memory");
#pragma unroll
        for (int j = 0; j < 4; ++j) { const int n = (lane >> 3) + 8 * j; const LAS float* s = scr + (8 * c) * 33 + n;
            if (n < ncols) { v4u o; o.x = pk2(s[0 * 33], s[1 * 33]); o.y = pk2(s[2 * 33], s[3 * 33]); o.z = pk2(s[4 * 33], s[5 * 33]); o.w = pk2(s[6 * 33], s[7 * 33]);
                *(GAS v4u*)(WT + (size_t)(dst_row0 + n) * DM + k0 + 8 * c) = o; } }
        const GAS f32x4* sp = (const GAS f32x4*)(sht + (size_t)k0 * 8 + 4 * bh);
#pragma unroll 8
        for (int kk = 0; kk < 64; ++kk) acc += sp[kk * 2] * scr[kk * 33 + nl];
        LDS_WAIT(); asm volatile("" ::: "memory");
    }
    if (nl < ncols) {
#pragma unroll
        for (int e = 0; e < 4; ++e) bias[(size_t)(4 * bh + e) * bpitch + n0 + nl] = acc[e]; }
}
__device__ __forceinline__ void pro_b_phase(Frame& F) {
    LAS float* scr = (LAS float*)(F.lds + RING_OFF + F.wave * 16384);
    const int gw = F.vcu * NWAVES + F.wave, NGW = F.G * NWAVES;
    constexpr int S_QKV = 193, S_GI = 128, S_F1 = 344, NSTRIPS = 2 * (S_QKV + S_GI) + 4 * S_F1;
    const float* sht = (const float*)((unsigned char*)F.wsg + WS_SHT); float* bv = (float*)((unsigned char*)F.wsg + WS_BIASV);
    bf16* Wqkv = (bf16*)((unsigned char*)F.wsg + WS_WQKV); bf16* Wgi = (bf16*)((unsigned char*)F.wsg + WS_WGI); bf16* Wf1 = (bf16*)((unsigned char*)F.wsg + WS_WF1);
    for (int it = gw; it < NSTRIPS; it += NGW) {
        int r = it;
        if (r < 2 * S_QKV) { const int j = r / S_QKV, nb = r % S_QKV;
            strip_item(F.in(IN_AWIN) + (size_t)j * DM * NQKVF, NQKVF, Wqkv + (size_t)j * WQKV_STRIDE, 32 * nb, 32 * nb, nb == 192 ? 16 : 32, sht + (size_t)(4 * j) * DM * 8, bv + BV_QKVF + (size_t)j * 8 * NQKVF, NQKVF, scr, F.lane); continue; } r -= 2 * S_QKV;
        if (r < 2 * S_GI) { const int j = r / S_GI, nb = r % S_GI;
            strip_item(F.in(IN_GWIN) + (size_t)j * DM * 4096, 4096, Wgi + (size_t)j * 4096 * DM, 32 * nb, 32 * nb, 32, sht + (size_t)(4 * j + 2) * DM * 8, bv + BV_GI + (size_t)j * 8 * 4096, 4096, scr, F.lane); continue; } r -= 2 * S_GI;
        { const int i = r / S_F1, nb = r % S_F1, n0 = 32 * nb, isup = n0 >= DFF, cch = n0 - isup * DFF;
            strip_item(F.in(IN_FWIN) + (size_t)i * DM * NFF2, NFF2, Wf1 + (size_t)i * NFF2 * DM, n0, 256 * (cch >> 7) + 128 * isup + (cch & 127), 32, sht + (size_t)(2 * i + 1) * DM * 8, bv + BV_F1 + (size_t)i * 8 * NFF2, NFF2, scr, F.lane); }
    }
}
__device__ __forceinline__ void xg0_phase(Frame& F, const float* xin, const float* g, const float* scale, bf16* XG, bf16* XB, u64* rss) {
    const int gw = F.vcu * NWAVES + F.wave, NGW = F.G * NWAVES;
    for (int rb = gw; rb < MTOK / 16; rb += NGW) {
        const int b = (rb * 16) >> 12;
        f32x4 gs[8];
#pragma unroll
        for (int j = 0; j < 8; ++j) { const int c4 = F.lane + 64 * j; gs[j] = ((const GAS f32x4*)g)[c4] * (((const GAS f32x4*)(scale + (size_t)b * 12288))[c4] + 1.0f); }
        for (int r = 0; r < 16; ++r) { const size_t row = (size_t)rb * 16 + r;
            const GAS f32x4* xr = (const GAS f32x4*)(xin + row * DM) + F.lane;
            f32x4 v[8]; float ss = 0.f;
#pragma unroll
            for (int j = 0; j < 8; ++j) { v[j] = xr[64 * j]; ss += (v[j].x * v[j].x + v[j].y * v[j].y) + (v[j].z * v[j].z + v[j].w * v[j].w); }
            ss = wave_sum(ss); if (F.lane == 0) rss[row] = (u64)(ss * FIXS);
            GAS v2u* o8 = (GAS v2u*)(XG + row * DM) + F.lane; GAS v2u* x8 = (GAS v2u*)(XB + row * DM) + F.lane;
#pragma unroll
            for (int j = 0; j < 8; ++j) { const f32x4 o = v[j] * gs[j]; v2u w; w.x = pk2(o.x, o.y); w.y = pk2(o.z, o.w); o8[64 * j] = w; v2u q; q.x = pk2(v[j].x, v[j].y); q.y = pk2(v[j].z, v[j].w); x8[64 * j] = q; } }
    }
}
__device__ __forceinline__ void normf_phase(Frame& F, const bf16* XB, const float* g, float* out) {
    const int gw = F.vcu * NWAVES + F.wave, NGW = F.G * NWAVES;
    for (int rb = gw; rb < MTOK / 16; rb += NGW) {
        f32x4 gs[8];
#pragma unroll
        for (int j = 0; j < 8; ++j) gs[j] = ((const GAS f32x4*)g)[F.lane + 64 * j];
        for (int r = 0; r < 16; ++r) { const size_t row = (size_t)rb * 16 + r;
            const GAS v2u* xr = (const GAS v2u*)(XB + row * DM) + F.lane; GAS f32x4* orow = (GAS f32x4*)(out + row * DM) + F.lane;
            f32x4 v[8]; float ss = 0.f;
#pragma unroll
            for (int j = 0; j < 8; ++j) { const v2u w = xr[64 * j]; v[j] = (f32x4){bflo(w.x), bfhi(w.x), bflo(w.y), bfhi(w.y)}; ss += (v[j].x * v[j].x + v[j].y * v[j].y) + (v[j].z * v[j].z + v[j].w * v[j].w); }
            const float rstd = 1.0f / sqrtf(wave_sum(ss) * (1.0f / DM) + EPS);
#pragma unroll
            for (int j = 0; j < 8; ++j) orow[64 * j] = v[j] * rstd * gs[j]; }
    }
}
__device__ __forceinline__ void fg_phase(Frame& F, const bf16* XG, const bf16* Wf, const float* bfv, const u64* rss, const float* biasf  , float* LOGF) {
    const int gw = F.vcu * NWAVES + F.wave, NGW = F.G * NWAVES, fr = F.lane & 15, fq = F.lane >> 4;
    for (int rb = gw; rb < MTOK / 16; rb += NGW) {
        const GAS bf16x8* ap = (const GAS bf16x8*)(XG + ((size_t)rb * 16 + fr) * DM + fq * 8);
        const GAS bf16x8* bp = (const GAS bf16x8*)(Wf + (size_t)fr * DM + fq * 8);
        f32x4 acc = (f32x4){0.f, 0.f, 0.f, 0.f};
#pragma unroll 8
        for (int ks = 0; ks < 64; ++ks) acc = __builtin_amdgcn_mfma_f32_16x16x32_bf16(bp[ks * 4], ap[ks * 4], acc, 0, 0, 0);
        const int b = (rb * 16) >> 12; const float rs = rstd_of(rss[(size_t)rb * 16 + fr]);
        const f32x4 bb = *(const GAS f32x4*)(bfv + 4 * fq) + *(const GAS f32x4*)(biasf + (size_t)b * NQKVF + 4 * fq); f32x4 o;
#pragma unroll
        for (int i = 0; i < 4; ++i) { const float z = acc[i] * rs + bb[i]; o[i] = fminf(z, 0.f) - log1pf(__expf(-fabsf(z))); }
        *(GAS f32x4*)(LOGF + ((size_t)rb * 16 + fr) * 16 + 4 * fq) = o;
    }
}
__device__ __forceinline__ void cum_phase(Frame& F, const float* LOGF, float* FB) {
    const int gw = F.vcu * NWAVES + F.wave, NGW = F.G * NWAVES;
    for (int bh = gw; bh < NBATCH * NHEAD; bh += NGW) { const int b = bh >> 4, h = bh & 15;
        const float* p = LOGF + ((size_t)b * SEQ + F.lane * 64) * 16 + h;
        float v[64]; float s = 0.f;
#pragma unroll
        for (int i = 0; i < 64; ++i) { s += p[i * 16]; v[i] = s; }
        float incl = s;
#pragma unroll
        for (int o = 1; o < 64; o <<= 1) { const float t = __shfl_up(incl, o); if (F.lane >= o) incl += t; }
        const float excl = incl - s;
        GAS f32x4* q = (GAS f32x4*)(FB + (size_t)bh * SEQ + F.lane * 64);
#pragma unroll
        for (int i = 0; i < 16; ++i) q[i] = (f32x4){-(excl + v[4 * i]) * 1.4426950408889634f, -(excl + v[4 * i + 1]) * 1.4426950408889634f, -(excl + v[4 * i + 2]) * 1.4426950408889634f, -(excl + v[4 * i + 3]) * 1.4426950408889634f};
    }
}
template <int VB>
__device__ __forceinline__ void gate_pv(fox::f32x16* o, int vb0, fox::bf16x8 pa0, fox::bf16x8 pa1, fox::bf16x8 pa2, fox::bf16x8 pa3) {
    using fox::s16x4; using fox::bf16x8;
#define TRRD(dst, off) asm volatile("ds_read_b64_tr_b16 %0, %1 offset:%2" : "=&v"(dst) : "v"(vb0), "i"(off) : "memory")
#define PV_D0(d0) do { s16x4 l0, l1, l2, l3, h0, h1, h2, h3; constexpr int b_ = VB * fox::SHM_V + fox::v_rd_off(d0, 0, 0); \
        TRRD(l0, b_); TRRD(h0, b_ + 2048); TRRD(l1, b_ + 4096); TRRD(h1, b_ + 6144); TRRD(l2, b_ + 8192); TRRD(h2, b_ + 10240); TRRD(l3, b_ + 12288); TRRD(h3, b_ + 14336); \
        asm volatile("s_waitcnt lgkmcnt(0)" ::: "memory"); __builtin_amdgcn_sched_barrier(0); \
        o[d0] = __builtin_amdgcn_mfma_f32_32x32x16_bf16((bf16x8){l0[0], l0[1], l0[2], l0[3], h0[0], h0[1], h0[2], h0[3]}, pa0, o[d0], 0, 0, 0);   \
        o[d0] = __builtin_amdgcn_mfma_f32_32x32x16_bf16((bf16x8){l1[0], l1[1], l1[2], l1[3], h1[0], h1[1], h1[2], h1[3]}, pa1, o[d0], 0, 0, 0);   \
        o[d0] = __builtin_amdgcn_mfma_f32_32x32x16_bf16((bf16x8){l2[0], l2[1], l2[2], l2[3], h2[0], h2[1], h2[2], h2[3]}, pa2, o[d0], 0, 0, 0);   \
        o[d0] = __builtin_amdgcn_mfma_f32_32x32x16_bf16((bf16x8){l3[0], l3[1], l3[2], l3[3], h3[0], h3[1], h3[2], h3[3]}, pa3, o[d0], 0, 0, 0); } while (0)
    PV_D0(0); PV_D0(1); PV_D0(2); PV_D0(3);
#undef PV_D0
#undef TRRD
}
__device__ __forceinline__ void gate_phase(Frame& F, const bf16* Z, const u64* VSS, const float* vg, const float* Ws, const float* bs, bf16* GT) {
    using fox::bf16x8; using fox::f32x16;
    const int r32 = F.lane & 31, hi = F.lane >> 5, c = F.wave >> 2, t0 = 32 * (F.wave & 3);
    const int vb0 = (int)(uintptr_t)(F.ldsg + RING_OFF) + c * 32768 + fox::v_rd_base(F.lane);
    bf16x8 aw[8]; int gcur = -1;
    for (int item = F.bid; item < (MTOK / 256) * 16; item += F.G) {
        const int g = item & 15, pnl = item >> 4; const size_t row0 = (size_t)pnl * 256;
        if (g != gcur) { gcur = g;
            const float* wr_ = Ws + ((size_t)g * 128 + t0 + r32) * 128 + 8 * hi;
#pragma unroll
            for (int ks = 0; ks < 8; ++ks) { const f32x4 a = *(const GAS f32x4*)(wr_ + 16 * ks), b = *(const GAS f32x4*)(wr_ + 16 * ks + 4); const int s0 = 16 * ks + 8 * hi; int t = t0 + r32; asm volatile("" : "+v"(t));
                v4u w; w.x = pk2(s0 + 0 <= t ? a.x : 0.f, s0 + 1 <= t ? a.y : 0.f); w.y = pk2(s0 + 2 <= t ? a.z : 0.f, s0 + 3 <= t ? a.w : 0.f);
                       w.z = pk2(s0 + 4 <= t ? b.x : 0.f, s0 + 5 <= t ? b.y : 0.f); w.w = pk2(s0 + 6 <= t ? b.z : 0.f, s0 + 7 <= t ? b.w : 0.f);
                aw[ks] = __builtin_bit_cast(bf16x8, w); } }
#pragma unroll 2
        for (int ps = 0; ps < 8; ++ps) { const int idx = ps * (NWAVES * 64) + F.tid, row = idx >> 4, c8 = (idx & 15) * 8, s = row & 127;
            const v4u w = *(const GAS v4u*)(Z + (row0 + row) * 4096 + 2048 + g * 128 + c8); const float rs = rstd_of(VSS[row0 + row]);
            const f32x4 g0 = *(const GAS f32x4*)(vg + g * 128 + c8), g1 = *(const GAS f32x4*)(vg + g * 128 + c8 + 4);
            v4u o; o.x = pk2(bflo(w.x) * rs * g0.x, bfhi(w.x) * rs * g0.y); o.y = pk2(bflo(w.y) * rs * g0.z, bfhi(w.y) * rs * g0.w);
                   o.z = pk2(bflo(w.z) * rs * g1.x, bfhi(w.z) * rs * g1.y); o.w = pk2(bflo(w.w) * rs * g1.z, bfhi(w.w) * rs * g1.w);
            *(LAS v4u*)(F.lds + RING_OFF + ((row >> 7) * 2 + (s >> 6)) * 16384 + fox::v_st(s & 63, c8)) = o; }
        __syncthreads();
        f32x16 o[4] = {};
        gate_pv<0>(o, vb0, aw[0], aw[1], aw[2], aw[3]);
        if (t0 >= 64) gate_pv<1>(o, vb0, aw[4], aw[5], aw[6], aw[7]);
        { const size_t grow = row0 + c * 128 + t0 + r32; const float bias = bs[g * 128 + t0 + r32];
          const GAS v2u* up = (const GAS v2u*)(Z + grow * 4096 + g * 128 + 4 * hi); GAS v4u* op = (GAS v4u*)(GT + grow * DM + g * 128 + 8 * hi);
#pragma unroll
          for (int d0 = 0; d0 < 4; ++d0) { float v[16];
#pragma unroll
            for (int q = 0; q < 4; ++q) { const v2u uw = up[d0 * 8 + q * 2];
                v[4 * q + 0] = bflo(uw.x) * (o[d0][4 * q + 0] + bias); v[4 * q + 1] = bfhi(uw.x) * (o[d0][4 * q + 1] + bias);
                v[4 * q + 2] = bflo(uw.y) * (o[d0][4 * q + 2] + bias); v[4 * q + 3] = bfhi(uw.y) * (o[d0][4 * q + 3] + bias); }
#pragma unroll
            for (int hf = 0; hf < 2; ++hf) { const unsigned a0 = fox::cvtpk(v[8 * hf + 0], v[8 * hf + 1]), a1 = fox::cvtpk(v[8 * hf + 2], v[8 * hf + 3]), b0 = fox::cvtpk(v[8 * hf + 4], v[8 * hf + 5]), b1 = fox::cvtpk(v[8 * hf + 6], v[8 * hf + 7]);
                auto r0 = __builtin_amdgcn_permlane32_swap(a0, b0, false, false); auto r1 = __builtin_amdgcn_permlane32_swap(a1, b1, false, false);
                v4u w; w.x = r0[0]; w.y = r1[0]; w.z = r0[1]; w.w = r1[1];
                op[d0 * 4 + hf * 2] = w; } } }
        __syncthreads();
    }
}
__device__ __forceinline__ float silu1(float v) { return v * __builtin_amdgcn_rcpf(1.0f + __builtin_amdgcn_exp2f(v * -1.4426950408889634f)); }
__device__ __forceinline__ void fix_phase(Frame& F, const float* HALO, const float* cw, const float* cb, bf16* ACT) {
    constexpr int C4 = DFF / 4;
    for (int item = F.bid * (NWAVES * 64) + F.tid; item < (MTOK / 256) * C4; item += F.G * NWAVES * 64) {
        const int pm = item / C4, c4 = (item % C4) * 4; if ((pm & 15) == 0) continue;
        f32x4 r0[2], r1[2];
#pragma unroll
        for (int part = 0; part < 2; ++part) { const int col = part * DFF + c4;
            const f32x4 am2 = *(const GAS f32x4*)(HALO + ((size_t)(pm - 1) * 4 + 2) * NFF2 + col), am1 = *(const GAS f32x4*)(HALO + ((size_t)(pm - 1) * 4 + 3) * NFF2 + col);
            const f32x4 a0 = *(const GAS f32x4*)(HALO + ((size_t)pm * 4 + 0) * NFF2 + col), a1 = *(const GAS f32x4*)(HALO + ((size_t)pm * 4 + 1) * NFF2 + col);
            const f32x4 w0 = *(const GAS f32x4*)(cw + col), w1 = *(const GAS f32x4*)(cw + NFF2 + col), w2 = *(const GAS f32x4*)(cw + 2 * NFF2 + col), b = *(const GAS f32x4*)(cb + col);
            r0[part] = b + w0 * am2 + w1 * am1 + w2 * a0; r1[part] = b + w0 * am1 + w1 * a0 + w2 * a1; }
        v2u o0, o1;
        o0.x = pk2(silu1(r0[0].x) * r0[1].x, silu1(r0[0].y) * r0[1].y); o0.y = pk2(silu1(r0[0].z) * r0[1].z, silu1(r0[0].w) * r0[1].w);
        o1.x = pk2(silu1(r1[0].x) * r1[1].x, silu1(r1[0].y) * r1[1].y); o1.y = pk2(silu1(r1[0].z) * r1[1].z, silu1(r1[0].w) * r1[1].w);
        *(GAS v2u*)(ACT + ((size_t)pm * 256) * DFF + c4) = o0; *(GAS v2u*)(ACT + ((size_t)pm * 256 + 1) * DFF + c4) = o1;
    }
}
constexpr int NPHASE = 2 + 2 * 7 + 2 * 6 + 1;
struct Args { const float* in[19]; float* out; unsigned char* ws; int ph_lo, ph_hi; };
static_assert(sizeof(Args) == 19 * 8 + 8 + 8 + 8, "Args has no padding bytes");
#ifndef MK_EN
#define MK_EN 0xffffffffu
#endif
#define EN(k) (((MK_EN) >> (k)) & 1u)
#ifndef MK_SP2
#define MK_SP2 true
#endif
#ifndef MK_BAR2
#define MK_BAR2 0
#endif
#ifndef MK_KREP
#define MK_KREP 1
#endif
#ifndef MK_REP
#define MK_REP 0u
#endif
#define REPN(k) ((((MK_REP) >> (k)) & 1u) ? 2 : 1)
#define W_MOD   ((float*)((unsigned char*)F.wsg + WS_MOD))
#define W_H     ((bf16*)((unsigned char*)F.wsg + WS_H))
#define W_Q     ((bf16*)((unsigned char*)F.wsg + WS_R))
#define W_K     ((bf16*)((unsigned char*)F.wsg + WS_R + 128 * MiB))
#define W_V     ((bf16*)((unsigned char*)F.wsg + WS_R + 256 * MiB))
#define W_Z     ((bf16*)((unsigned char*)F.wsg + WS_R))
#define W_ACT   ((bf16*)((unsigned char*)F.wsg + WS_R))
#define W_HALO  ((float*)((unsigned char*)F.wsg + WS_R + 344 * MiB))
#define W_LOGF  ((float*)((unsigned char*)F.wsg + WS_LOGF))
#define W_FB    ((float*)((unsigned char*)F.wsg + WS_FB))
#define W_VSS(n) ((u64*)((unsigned char*)F.wsg + WS_VSS) + (size_t)(n) * MTOK)
#define W_XB    ((bf16*)((unsigned char*)F.wsg + WS_XB))
#define W_H2    ((bf16*)((unsigned char*)F.wsg + WS_H2))
#define W_RSS(n) ((u64*)((unsigned char*)F.wsg + WS_RSS) + (size_t)(n) * MTOK)
#define W_BIASV ((float*)((unsigned char*)F.wsg + WS_BIASV))
#define W_MODI  (W_MOD + (size_t)i * 8 * 12288)
#define XOUT_(k) W_XB
#define XG_(k, p) (p)
__global__ void __launch_bounds__(NWAVES * 64, 2) mega_fwd(Args args) {
    extern __shared__ __attribute__((aligned(16))) unsigned char lds[];
    Frame F;
    F.lds = (LAS unsigned char*)lds; F.ldsg = (char*)lds;
    F.MISC = (volatile LAS unsigned*)(F.lds + MISC_OFF);
    for (int u = threadIdx.x; u < (LDS_BYTES - LDSCTL_OFF) / 4; u += NWAVES * 64) ((LAS unsigned*)(F.lds + LDSCTL_OFF))[u] = 0u;
    __syncthreads();
    if (threadIdx.x == 0) {
        const int G = gridDim.x, bx = blockIdx.x; const unsigned long long kp = (unsigned long long)__builtin_amdgcn_kernarg_segment_ptr(), wp = (unsigned long long)args.ws, op = (unsigned long long)args.out;
        F.MISC[MW_BID] = (unsigned)bx; F.MISC[MW_G] = (unsigned)G; F.MISC[MW_VCU] = (unsigned)((G % 8 == 0) ? (bx % 8) * (G / 8) + bx / 8 : bx);
        F.MISC[MW_INP] = (unsigned)kp; F.MISC[MW_INP_HI] = (unsigned)(kp >> 32); F.MISC[MW_WS] = (unsigned)wp; F.MISC[MW_WS_HI] = (unsigned)(wp >> 32); F.MISC[MW_OUT] = (unsigned)op; F.MISC[MW_OUT_HI] = (unsigned)(op >> 32);
    }
    __syncthreads();
    XcdBarrier bar; bar.bar = (unsigned*)(args.ws + WS_CTL) + CW_BAR; bar.x = 0; bar.st = nullptr;
    if (!MK_PER_PHASE) bar = xcd_barrier_post((unsigned*)(args.ws + WS_CTL) + CW_BAR, F.MISC + 8);
    const int lo = args.ph_lo, hi = args.ph_hi;
    int ph = 0;
#define RUN() (lo <= ph && ph < hi && relaunder(F))
#define SEAM() do { if (!MK_PER_PHASE) { if (lo <= ph && ph + 1 < hi) { relaunder(F); bar.bar = (unsigned*)((unsigned char*)F.wsg + WS_CTL) + CW_BAR; asm volatile("" : "+s"(bar.x)); xcd_barrier(bar); if (MK_BAR2) xcd_barrier(bar); } } ++ph; } while (0)

    if (EN(0) && RUN()) for (int rep_ = 0; rep_ < REPN(0); ++rep_) pro_a_phase(F);
    SEAM();
    if (EN(1) && RUN()) for (int rep_ = 0; rep_ < REPN(1); ++rep_) { pro_b_phase(F); xg0_phase(F, F.in(IN_X), F.in(IN_MIXG), W_MOD + DM, W_H, W_XB, W_RSS(0)); }
    SEAM();
    for (int i = 0; i < DEPTH; ++i) {
        const int j = i >> 1;
        if ((i & 1) == 0) {
            if (EN(3) && RUN()) for (int rep_ = 0; rep_ < REPN(3); ++rep_) {
                const bf16* wq = (const bf16*)((unsigned char*)F.wsg + WS_WQKV) + (size_t)j * WQKV_STRIDE; const float* bvq = W_BIASV + BV_QKVF + (size_t)j * 8 * NQKVF;
                fg_phase(F, W_H, wq + (size_t)6144 * DM, F.in(IN_ABF) + j * 16, W_RSS(2 * i), bvq + 6144, W_LOGF);
                pg8::Gemm g{W_H, wq, MTOK, 6144, DM}; pg8::StaticOrder S; S.init(MTOK, 6144, F.G, F.bid);
                pg8::EpiQKV E{W_Q, (size_t)(64 * MiB), fox::QSCALE, pg8::RowAffine{W_RSS(2 * i), bvq, NQKVF, (LAS float*)(F.lds + XCH_OFF + 8192)}};
                pg8::gemm_phase<pg8::EpiQKV, pg8::StaticOrder, true, MK_SP2>(F.lds + RING_OFF, g, S, E);
            }
            SEAM();
            if (EN(4) && RUN()) for (int rep_ = 0; rep_ < REPN(4); ++rep_) cum_phase(F, W_LOGF, W_FB);
            SEAM();
            if (EN(5) && RUN()) for (int rep_ = 0; rep_ < REPN(5); ++rep_) fox::att_phase(F.ldsg + RING_OFF, (const fox::bf16*)W_Q, (const fox::bf16*)W_K, (const fox::bf16*)W_V, (fox::bf16*)W_H, W_FB, F.bid, F.G);
            SEAM();
            if (EN(6) && RUN()) for (int rep_ = 0; rep_ < REPN(6); ++rep_) {
                pg8::Gemm g{W_H, (const bf16*)((unsigned char*)F.wsg + WS_WO) + (size_t)j * DM * DM, MTOK, DM, DM}; pg8::StaticOrder S; S.init(MTOK, DM, F.G, F.bid);
                pg8::EpiRes E{XOUT_(6), W_MODI + 2 * DM, 12288, XG_(6, W_H2), F.in(IN_FFNG) + i * DM, W_MODI + 4 * DM, W_RSS(2 * i + 1), (LAS float*)(F.lds + XCH_OFF)};
                pg8::gemm_phase<pg8::EpiRes, pg8::StaticOrder, true, MK_SP2>(F.lds + RING_OFF, g, S, E);
            }
            SEAM();
        } else {
            if (EN(7) && RUN()) for (int rep_ = 0; rep_ < REPN(7); ++rep_) {
                pg8::Gemm g{W_H, (const bf16*)((unsigned char*)F.wsg + WS_WGI) + (size_t)j * 4096 * DM, MTOK, 4096, DM}; pg8::StaticOrder S; S.init(MTOK, 4096, F.G, F.bid);
                pg8::EpiStore<1> E{W_Z, 4096, pg8::RowAffine{W_RSS(2 * i), W_BIASV + BV_GI + (size_t)j * 8 * 4096, 4096, (LAS float*)(F.lds + XCH_OFF + 8192)}, W_VSS(j)};
                pg8::gemm_phase<pg8::EpiStore<1>, pg8::StaticOrder, true, MK_SP2>(F.lds + RING_OFF, g, S, E);
            }
            SEAM();
            if (EN(9) && RUN()) for (int rep_ = 0; rep_ < REPN(9); ++rep_) gate_phase(F, W_Z, W_VSS(j), F.in(IN_GVG) + j * DM, F.in(IN_GWS) + (size_t)j * 16 * 128 * 128, F.in(IN_GBS) + j * 16 * 128, W_H);
            SEAM();
            if (EN(10) && RUN()) for (int rep_ = 0; rep_ < REPN(10); ++rep_) {
                pg8::Gemm g{W_H, (const bf16*)((unsigned char*)F.wsg + WS_WGO) + (size_t)j * DM * DM, MTOK, DM, DM}; pg8::StaticOrder S; S.init(MTOK, DM, F.G, F.bid);
                pg8::EpiRes E{XOUT_(10), W_MODI + 2 * DM, 12288, XG_(10, W_H2), F.in(IN_FFNG) + i * DM, W_MODI + 4 * DM, W_RSS(2 * i + 1), (LAS float*)(F.lds + XCH_OFF)};
                pg8::gemm_phase<pg8::EpiRes, pg8::StaticOrder, true, MK_SP2>(F.lds + RING_OFF, g, S, E);
            }
            SEAM();
        }
        if (EN(11) && RUN()) for (int rep_ = 0; rep_ < REPN(11); ++rep_) {
            pg8::Gemm g{W_H2, (const bf16*)((unsigned char*)F.wsg + WS_WF1) + (size_t)i * NFF2 * DM, MTOK, NFF2, DM}; pg8::StaticOrder S; S.init(MTOK, NFF2, F.G, F.bid);
            pg8::EpiConv E{W_ACT, F.in(IN_FCW) + (size_t)i * 3 * NFF2, F.in(IN_FCB) + (size_t)i * NFF2, W_HALO, (LAS float*)(F.lds + XCH_OFF), pg8::RowAffine{W_RSS(2 * i + 1), W_BIASV + BV_F1 + (size_t)i * 8 * NFF2, NFF2, (LAS float*)(F.lds + XCH_OFF + 8192)}, (LAS float*)(F.lds + CWT_OFF)};
            pg8::gemm_phase<pg8::EpiConv, pg8::StaticOrder, true, MK_SP2, MK_KREP>(F.lds + RING_OFF, g, S, E);
        }
        SEAM();
        if (EN(12) && RUN()) for (int rep_ = 0; rep_ < REPN(12); ++rep_) fix_phase(F, W_HALO, F.in(IN_FCW) + (size_t)i * 3 * NFF2, F.in(IN_FCB) + (size_t)i * NFF2, W_ACT);
        SEAM();
        if (EN(13) && RUN()) for (int rep_ = 0; rep_ < REPN(13); ++rep_) {
            pg8::Gemm g{W_ACT, (const bf16*)((unsigned char*)F.wsg + WS_WF2) + (size_t)i * DM * DFF, MTOK, DM, DFF}; pg8::StaticOrder S; S.init(MTOK, DM, F.G, F.bid);
            const int in_ = i < DEPTH - 1 ? i + 1 : i;
            pg8::EpiRes E{XOUT_(13), W_MODI + 5 * DM, 12288, XG_(13, i < DEPTH - 1 ? W_H : (bf16*)nullptr), F.in(IN_MIXG) + in_ * DM, W_MOD + (size_t)in_ * 8 * 12288 + DM, W_RSS(2 * in_), (LAS float*)(F.lds + XCH_OFF)};
            pg8::gemm_phase<pg8::EpiRes, pg8::StaticOrder, true, MK_SP2>(F.lds + RING_OFF, g, S, E);
        }
        SEAM();
    }
    if (EN(14) && RUN()) normf_phase(F, W_XB, F.in(IN_FING), (float*)F.outg);
#undef RUN
#undef SEAM
}

extern "C" void kernel_launch(void* const* d_in, const int* in_sizes, int n_in, void* d_out, int out_size, void* d_ws, size_t ws_size, hipStream_t stream) {
    static int grid = 0;
    if (grid == 0) {
        if (n_in != 19 || out_size != MTOK * DM || ws_size < WS_END) { fprintf(stderr, "kernel_launch: unexpected shapes (n_in %d, out %d, ws %zu < %zu)\n", n_in, out_size, ws_size, (size_t)WS_END); grid = -1; return; }
        int dev = 0, cus = 0, per_cu = 0;
        if (hipGetDevice(&dev) != hipSuccess || hipDeviceGetAttribute(&cus, hipDeviceAttributeMultiprocessorCount, dev) != hipSuccess) { grid = -1; return; }
        if (hipFuncSetAttribute((const void*)mega_fwd, hipFuncAttributeMaxDynamicSharedMemorySize, LDS_BYTES) != hipSuccess) { fprintf(stderr, "kernel_launch: hipFuncSetAttribute failed\n"); grid = -1; return; }
        if (hipOccupancyMaxActiveBlocksPerMultiprocessor(&per_cu, (const void*)mega_fwd, NWAVES * 64, LDS_BYTES) != hipSuccess || per_cu < 1) { fprintf(stderr, "kernel_launch: occupancy query says %d\n", per_cu); }
        (void)hipGetLastError();
        grid = cus;
    }
    if (grid < 0) return;
    if (hipMemsetAsync((char*)d_ws + WS_CTL, 0, CTL_ZERO_BYTES, stream) != hipSuccess) return;
    Args a{};
    for (int i = 0; i < 19; ++i) a.in[i] = (const float*)d_in[i];
    a.out = (float*)d_out; a.ws = (unsigned char*)d_ws;
#if MK_PER_PHASE
    for (int p = 0; p < NPHASE; ++p) { a.ph_lo = p; a.ph_hi = p + 1; hipLaunchKernelGGL(mega_fwd, dim3(grid), dim3(NWAVES * 64), LDS_BYTES, stream, a); }
#else
    a.ph_lo = 0; a.ph_hi = NPHASE; hipLaunchKernelGGL(mega_fwd, dim3(grid), dim3(NWAVES * 64), LDS_BYTES, stream, a);
#endif
}
```

```cpp
#include <hip/hip_runtime.h>
#include <hip/hip_bf16.h>
#include <cstdio>
#include <cstdint>
__device__ __forceinline__ int ltid() { int t = (int)threadIdx.x; asm volatile("" : "+v"(t)); return t; }
namespace pg8 {
#define PG8_LAS __attribute__((address_space(3)))
typedef unsigned short bf16_t;
typedef short bf16x8 __attribute__((ext_vector_type(8)));
typedef float f32x4 __attribute__((ext_vector_type(4)));
typedef unsigned u32x4 __attribute__((ext_vector_type(4)));
constexpr int BM = 256, BK = 64, HALF = 128, HTB = HALF * BK * 2  , STAGE_BYTES = 8 * HTB, NXCD = 8;
#ifndef MK_SETPRIO
#define MK_SETPRIO 1
#endif
#ifndef MK_DYNGLOBAL
#define MK_DYNGLOBAL 1
#endif
#ifndef MK_RELAXW
#define MK_RELAXW 0
#endif
#ifndef MK_WGM
#define MK_WGM 4
#endif
constexpr int WGM = MK_WGM;

__host__ __device__ __forceinline__ int lds_byte(int r, int c) { const int st = (r >> 4) * 2 + (c >> 5), rr = r & 15, cc = c & 31, ob = rr * 64 + cc * 2; return st * 1024 + (ob ^ (((ob >> 9) & 1) << 5)); }
__host__ __device__ __forceinline__ void stage_rc(int b, int& R, int& C) { const int st = b / 1024, sb = b % 1024, swz = sb ^ (((sb >> 9) & 1) << 5); R = (st >> 1) * 16 + swz / 64; C = (st & 1) * 32 + (swz % 64) / 2; }
__host__ __device__ __forceinline__ int perm32(int rho) { const int n = rho >> 4, i = rho & 15; return 8 * (i >> 2) + 4 * n + (i & 3); }

struct Unit { int pm, pn; };
struct Gemm { const bf16_t* A; const bf16_t* Bt; int M, N, K; };

struct StaticOrder {
    int nM, nN, nwg, G, c, lim, pm_off;
    __host__ __device__ void init(int M, int N, int G_, int c_) { nM = M / BM; nN = N / BM; nwg = nM * nN; G = G_; c = c_; lim = nwg; pm_off = 0; }
    __host__ __device__ bool next(int i, Unit& u) const { const long L = (long)i * G + c; if (L >= lim) return false; unit_of((int)L, u); return true; }
    __host__ __device__ void unit_of(int L, Unit& u) const {
        int wgid = L; { const int q = nwg / NXCD, r = nwg % NXCD, xcd = wgid % NXCD, off = wgid / NXCD; wgid = (xcd < r ? xcd * (q + 1) : r * (q + 1) + (xcd - r) * q) + off; }
        const int nig = WGM * nN, gid = wgid / nig, fm = gid * WGM, gsz = (nM - fm) < WGM ? (nM - fm) : WGM;
        u.pm = pm_off + fm + ((wgid % nig) % gsz); u.pn = (wgid % nig) / gsz;
    }
    __device__ __forceinline__ void a_ready(const Unit&) const {}
    __device__ __forceinline__ void done(const Unit&) const {}
};
struct TailClaimOrder : StaticOrder {
    int nfull, cls, nleft; unsigned* cnt; volatile PG8_LAS unsigned* slot;
    __device__ __forceinline__ void init_tail(unsigned* counters  , volatile PG8_LAS unsigned* slot_) {
        nfull = (nwg / G) * G; cls = MK_DYNGLOBAL ? 0 : (c & 7); nleft = MK_DYNGLOBAL ? (nwg - nfull) : (nwg - nfull + 7 - cls) / 8; cnt = counters + cls * 64; slot = slot_; }
    __device__ __forceinline__ bool next(int i, Unit& u) const {
        const int L = i * G + c;
        if (L < nfull) { unit_of(L, u); return true; }
        if (i * G != nfull) return false;
        if (threadIdx.x == 0) { const unsigned k = __hip_atomic_fetch_add((__attribute__((address_space(1))) unsigned*)cnt, 1u, __ATOMIC_RELAXED, __HIP_MEMORY_SCOPE_AGENT); *slot = k; }
        asm volatile("s_waitcnt lgkmcnt(0)" ::: "memory"); __builtin_amdgcn_s_barrier(); asm volatile("" ::: "memory");
        const int k = __builtin_amdgcn_readfirstlane((int)*slot);
        if (k >= nleft) return false;
        unit_of(MK_DYNGLOBAL ? (nfull + k) : (nfull + 8 * k + cls), u); return true;
    }
};
struct OneUnit { Unit u;
    __device__ __forceinline__ bool next(int i, Unit& v) const { if (i != 0) return false; v = u; return true; }
    __device__ __forceinline__ void a_ready(const Unit&) const {}
    __device__ __forceinline__ void done(const Unit&) const {}
};
__device__ __forceinline__ unsigned cvt_pk_bf16(float lo, float hi) { unsigned r; asm volatile("v_cvt_pk_bf16_f32 %0, %1, %2" : "=v"(r) : "v"(lo), "v"(hi)); return r; }
typedef float f32x2 __attribute__((ext_vector_type(2)));
__device__ __forceinline__ f32x2 gelu_pk(f32x2 v) {
    const f32x2 av = __builtin_elementwise_abs(v), d = av * 0.2316418882f + 1.0f;
    f32x2 t; t.x = __builtin_amdgcn_rcpf(d.x); t.y = __builtin_amdgcn_rcpf(d.y);
    f32x2 q = t * 0.5307027145f + (-0.7265760135f); q = q * t + 0.7107068705f; q = q * t + (-0.142248368f); q = q * t + 0.127414796f; q = q * t;
    const f32x2 s = (v * v) * (-0.72134752044f);
    f32x2 e; e.x = __builtin_amdgcn_exp2f(s.x); e.y = __builtin_amdgcn_exp2f(s.y);
    const f32x2 m = v * (q * e), r = v - m;
    f32x2 o; o.x = v.x < 0.f ? m.x : r.x; o.y = v.y < 0.f ? m.y : r.y; return o;
}

#ifndef MK_NTST
#define MK_NTST 0
#endif
#if MK_NTST
#define EPI_ST16(p, v) __builtin_nontemporal_store((v), (u32x4*)(p))
#else
#define EPI_ST16(p, v) (*(u32x4*)(p) = (v))
#endif
struct RowAffine {
    const unsigned long long* rss; const float* biasb;
    int bpitch; PG8_LAS float* T;
    template <bool UPGATE> __device__ __forceinline__ void stage(const Unit& u, int p, int wid, int lane) const {
        if (wid == 0 || wid == 2) __builtin_amdgcn_global_load_lds((const unsigned*)(rss + (size_t)u.pm * BM + wid * 64 + lane * 2), (PG8_LAS unsigned*)(T + p * 768 + wid * 128), 16, 0, 0);
        if (wid == 1) { const int b = (u.pm * BM) >> 12;
            const int col = UPGATE ? ((lane < 32) ? (u.pn * 128 + lane * 4) : (5504 + u.pn * 128 + (lane - 32) * 4)) : (u.pn * BM + lane * 4);
            __builtin_amdgcn_global_load_lds((const unsigned*)(biasb + (size_t)b * bpitch + col), (PG8_LAS unsigned*)(T + p * 768 + 512), 16, 0, 0); }
    }
    template <bool PR = false> __device__ __forceinline__ void apply(f32x4 (&acc)[2][2][4][2], int p, int wr, int wc, int fr, int fq) const {
        const PG8_LAS unsigned long long* Tr = (const PG8_LAS unsigned long long*)(T + p * 768) + wr * 64 + (PR ? 4 * fr : fr); const PG8_LAS float* Tb = T + p * 768 + 512 + wc * 32 + 8 * fq;
        float rs[2][4];
#pragma unroll
        for (int ai = 0; ai < 2; ++ai)
#pragma unroll
            for (int m = 0; m < 4; ++m) rs[ai][m] = __builtin_amdgcn_rsqf((float)Tr[ai * HALF + (PR ? m : m * 16)] * (1.0f / (1048576.0f * 2048.0f)) + 1e-6f);
#pragma unroll
        for (int bj = 0; bj < 2; ++bj)
#pragma unroll
            for (int n = 0; n < 2; ++n) { const f32x4 bv = *(const PG8_LAS f32x4*)(Tb + bj * HALF + 4 * n);
#pragma unroll
                for (int ai = 0; ai < 2; ++ai)
#pragma unroll
                    for (int m = 0; m < 4; ++m) acc[ai][bj][m][n] = acc[ai][bj][m][n] * rs[ai][m] + bv; }
    }
};
__device__ __forceinline__ float gelu_tanh1(float v) {
    const float u = v * (0.7978845608f + 0.0356774081f * v * v);
    const float e = __builtin_amdgcn_exp2f(u * -2.8853900818f);
    return v * __builtin_amdgcn_rcpf(1.0f + e);
}
__device__ __forceinline__ f32x4 gelu_tanh4(f32x4 v) {
    const f32x4 u = v * (v * v * 0.0356774081f + 0.7978845608f);
    const f32x4 a = u * -2.8853900818f;
    f32x4 e; e.x = __builtin_amdgcn_exp2f(a.x); e.y = __builtin_amdgcn_exp2f(a.y); e.z = __builtin_amdgcn_exp2f(a.z); e.w = __builtin_amdgcn_exp2f(a.w);
    const f32x4 d = e + 1.0f;
    f32x4 r; r.x = __builtin_amdgcn_rcpf(d.x); r.y = __builtin_amdgcn_rcpf(d.y); r.z = __builtin_amdgcn_rcpf(d.z); r.w = __builtin_amdgcn_rcpf(d.w);
    return v * r;
}
template <int ACT  > struct EpiStore {
    static constexpr bool PERM = true, AFTER_DRAIN = false, PERMROW = false;
    bf16_t* O; int ldc; RowAffine ra; unsigned long long* vss;
    __device__ __forceinline__ void stage(const Unit& u, int p, int wid, int lane) const { ra.stage<false>(u, p, wid, lane); }
    __device__ __forceinline__ void operator()(f32x4 (&acc)[2][2][4][2], const Unit& u, int p, int wr, int wc, int fr, int fq) const {
        ra.apply(acc, p, wr, wc, fr, fq);
        const int row0 = u.pm * BM + wr * 64 + fr, col0 = u.pn * BM + wc * 32 + 8 * fq; float ssq[8];
#pragma unroll
        for (int ai = 0; ai < 2; ++ai)
#pragma unroll
            for (int m = 0; m < 4; ++m) { bf16_t* rowp = O + (size_t)(row0 + ai * HALF + m * 16) * ldc + col0; float s = 0.f;
#pragma unroll
                for (int bj = 0; bj < 2; ++bj) { f32x4 v0 = acc[ai][bj][m][0], v1 = acc[ai][bj][m][1];
                    if (ACT == 1) { v0 = gelu_tanh4(v0); v1 = gelu_tanh4(v1); }
                    s += (v0[0] * v0[0] + v0[1] * v0[1]) + (v0[2] * v0[2] + v0[3] * v0[3]) + (v1[0] * v1[0] + v1[1] * v1[1]) + (v1[2] * v1[2] + v1[3] * v1[3]);
                    u32x4 w; w.x = cvt_pk_bf16(v0[0], v0[1]); w.y = cvt_pk_bf16(v0[2], v0[3]); w.z = cvt_pk_bf16(v1[0], v1[1]); w.w = cvt_pk_bf16(v1[2], v1[3]);
                    EPI_ST16(rowp + bj * HALF, w); }
                ssq[ai * 4 + m] = s; }
        if (vss && u.pn >= 8) {
#pragma unroll
            for (int k = 0; k < 8; ++k) ssq[k] += __shfl_xor(ssq[k], 16);
#pragma unroll
            for (int k = 0; k < 8; ++k) ssq[k] += __shfl_xor(ssq[k], 32);
            if (fq == 0) {
#pragma unroll
                for (int k = 0; k < 8; ++k) __hip_atomic_fetch_add(vss + row0 + (k >> 2) * HALF + (k & 3) * 16, (unsigned long long)(ssq[k] * 1048576.0f), __ATOMIC_RELAXED, __HIP_MEMORY_SCOPE_AGENT); } }
    }
};
struct EpiQKV {
    static constexpr bool PERM = true, AFTER_DRAIN = false, PERMROW = false;
    bf16_t* QKV; size_t tstride; float qscale; RowAffine ra;
    __device__ __forceinline__ void stage(const Unit& u, int p, int wid, int lane) const { ra.stage<false>(u, p, wid, lane); }
    __device__ __forceinline__ void operator()(f32x4 (&acc)[2][2][4][2], const Unit& u, int p, int wr, int wc, int fr, int fq) const {
        ra.apply(acc, p, wr, wc, fr, fq);
        const int tok0 = u.pm * BM, b = tok0 >> 12, s0 = (tok0 & 4095) + wr * 64 + fr;
        const int colt = u.pn * BM, t = colt >> 11, hd0 = (colt & 2047) >> 7;
        bf16_t* base = QKV + (size_t)t * tstride; const float sc = t == 0 ? qscale : 1.0f;
#pragma unroll
        for (int bj = 0; bj < 2; ++bj) { bf16_t* hb = base + ((size_t)(b * 16 + hd0 + bj) * 4096 + s0) * 128 + wc * 32 + 8 * fq;
#pragma unroll
            for (int ai = 0; ai < 2; ++ai)
#pragma unroll
                for (int m = 0; m < 4; ++m) { const f32x4 v0 = acc[ai][bj][m][0] * sc, v1 = acc[ai][bj][m][1] * sc;
                    u32x4 w; w.x = cvt_pk_bf16(v0[0], v0[1]); w.y = cvt_pk_bf16(v0[2], v0[3]); w.z = cvt_pk_bf16(v1[0], v1[1]); w.w = cvt_pk_bf16(v1[2], v1[3]);
                    EPI_ST16(hb + (size_t)(ai * HALF + m * 16) * 128, w); } }
    }
};
struct EpiRes {
    static constexpr bool PERM = true, AFTER_DRAIN = false, PERMROW = false;
    bf16_t* xb; const float* gate; int gpitch; bf16_t* xg; const float* gn; const float* scn; unsigned long long* rss; PG8_LAS float* T; float* xf;
    __device__ __forceinline__ void stage(const Unit& u, int p, int wid, int lane) const { const int b = (u.pm * BM) >> 12, c = u.pn * BM + lane * 4;
        if (wid == 0) __builtin_amdgcn_global_load_lds((const unsigned*)(gate + (size_t)b * gpitch + c), (PG8_LAS unsigned*)(T + p * 768), 16, 0, 0);
        if (wid == 1 && xg) __builtin_amdgcn_global_load_lds((const unsigned*)(gn + c), (PG8_LAS unsigned*)(T + p * 768 + 256), 16, 0, 0);
        if (wid == 2 && xg) __builtin_amdgcn_global_load_lds((const unsigned*)(scn + (size_t)b * gpitch + c), (PG8_LAS unsigned*)(T + p * 768 + 512), 16, 0, 0); }
    __device__ __forceinline__ void operator()(const f32x4 (&acc)[2][2][4][2], const Unit& u, int p, int wr, int wc, int fr, int fq) const {
        const int row0 = u.pm * BM + wr * 64 + fr, col0 = u.pn * BM + wc * 32 + 8 * fq; const PG8_LAS float* Tc = T + p * 768 + wc * 32 + 8 * fq;
        u32x4 xbuf[4][2];
#define ER_LOAD(k) do { const size_t off_ = (size_t)(row0 + ((k) >> 2) * HALF + ((k) & 3) * 16) * 2048 + col0; _Pragma("unroll") for (int bj = 0; bj < 2; ++bj) xbuf[(k) % 4][bj] = *(const u32x4*)(xb + off_ + bj * HALF); } while (0)
        ER_LOAD(0); ER_LOAD(1); ER_LOAD(2); ER_LOAD(3);
        f32x4 gv[2][2], gs[2][2];
#pragma unroll
        for (int bj = 0; bj < 2; ++bj)
#pragma unroll
            for (int n = 0; n < 2; ++n) { gv[bj][n] = *(const PG8_LAS f32x4*)(Tc + bj * HALF + n * 4);
                gs[bj][n] = xg ? *(const PG8_LAS f32x4*)(Tc + 256 + bj * HALF + n * 4) * (*(const PG8_LAS f32x4*)(Tc + 512 + bj * HALF + n * 4) + 1.0f) : (f32x4){0.f, 0.f, 0.f, 0.f}; }
        float ss[8];
#pragma unroll
        for (int k = 0; k < 8; ++k) { const int ai = k >> 2, m = k & 3, row = row0 + ai * HALF + m * 16; const size_t off = (size_t)row * 2048 + col0; float s = 0.f;
            __builtin_amdgcn_sched_barrier(0);
#pragma unroll
            for (int bj = 0; bj < 2; ++bj) { const u32x4 xw = xbuf[k % 4][bj];
                const f32x4 x0 = (f32x4){__builtin_bit_cast(float, xw.x << 16), __builtin_bit_cast(float, xw.x & 0xffff0000u), __builtin_bit_cast(float, xw.y << 16), __builtin_bit_cast(float, xw.y & 0xffff0000u)};
                const f32x4 x1 = (f32x4){__builtin_bit_cast(float, xw.z << 16), __builtin_bit_cast(float, xw.z & 0xffff0000u), __builtin_bit_cast(float, xw.w << 16), __builtin_bit_cast(float, xw.w & 0xffff0000u)};
                const f32x4 o0 = x0 + gv[bj][0] * acc[ai][bj][m][0], o1 = x1 + gv[bj][1] * acc[ai][bj][m][1];
                u32x4 w; w.x = cvt_pk_bf16(o0[0], o0[1]); w.y = cvt_pk_bf16(o0[2], o0[3]); w.z = cvt_pk_bf16(o1[0], o1[1]); w.w = cvt_pk_bf16(o1[2], o1[3]);
                if (xf) { *(f32x4*)(xf + off + bj * HALF) = o0; *(f32x4*)(xf + off + bj * HALF + 4) = o1; } else EPI_ST16(xb + off + bj * HALF, w);
                if (xg) { const f32x4 y0 = o0 * gs[bj][0], y1 = o1 * gs[bj][1]; u32x4 g; g.x = cvt_pk_bf16(y0[0], y0[1]); g.y = cvt_pk_bf16(y0[2], y0[3]); g.z = cvt_pk_bf16(y1[0], y1[1]); g.w = cvt_pk_bf16(y1[2], y1[3]);
                    EPI_ST16(xg + off + bj * HALF, g);
                    s += (o0[0] * o0[0] + o0[1] * o0[1]) + (o0[2] * o0[2] + o0[3] * o0[3]) + (o1[0] * o1[0] + o1[1] * o1[1]) + (o1[2] * o1[2] + o1[3] * o1[3]); } }
            ss[k] = s;
            __builtin_amdgcn_sched_barrier(0);
            if (k + 4 < 8) ER_LOAD(k + 4); }
#undef ER_LOAD
        if (xg) {
#pragma unroll
            for (int k = 0; k < 8; ++k) ss[k] += __shfl_xor(ss[k], 16);
#pragma unroll
            for (int k = 0; k < 8; ++k) ss[k] += __shfl_xor(ss[k], 32);
            if (fq == 0) {
#pragma unroll
                for (int k = 0; k < 8; ++k) __hip_atomic_fetch_add(rss + row0 + (k >> 2) * HALF + (k & 3) * 16, (unsigned long long)(ss[k] * 1048576.0f), __ATOMIC_RELAXED, __HIP_MEMORY_SCOPE_AGENT); } }
    }
};
struct EpiResF : EpiRes {
    float* outp; const float* gfin; unsigned long long* rssf; unsigned* pcnt;
    __device__ __forceinline__ void stage(const Unit& u, int p, int wid, int lane) const { const int b = (u.pm * BM) >> 12, c = u.pn * BM + lane * 4;
        if (wid == 0) __builtin_amdgcn_global_load_lds((const unsigned*)(gate + (size_t)b * gpitch + c), (PG8_LAS unsigned*)(T + p * 768), 16, 0, 0);
        if (wid == 1 && (xg || outp)) __builtin_amdgcn_global_load_lds((const unsigned*)((outp ? gfin : gn) + c), (PG8_LAS unsigned*)(T + p * 768 + 256), 16, 0, 0);
        if (wid == 2 && xg) __builtin_amdgcn_global_load_lds((const unsigned*)(scn + (size_t)b * gpitch + c), (PG8_LAS unsigned*)(T + p * 768 + 512), 16, 0, 0); }
    __device__ __forceinline__ void operator()(f32x4 (&acc)[2][2][4][2], const Unit& u, int p, int wr, int wc, int fr, int fq) const {
        if (!outp) { EpiRes::operator()(acc, u, p, wr, wc, fr, fq); return; }
        asm volatile("; final-norm epilogue" ::: "memory");
        const int row0 = u.pm * BM + wr * 64 + fr, col0 = u.pn * BM + wc * 32 + 8 * fq; const PG8_LAS float* Tc = T + p * 768 + wc * 32 + 8 * fq;
        u32x4 xbuf[4][2];
#define ER_LOAD(k) do { const size_t off_ = (size_t)(row0 + ((k) >> 2) * HALF + ((k) & 3) * 16) * 2048 + col0; _Pragma("unroll") for (int bj = 0; bj < 2; ++bj) xbuf[(k) % 4][bj] = *(const u32x4*)(xb + off_ + bj * HALF); } while (0)
#define ER_X(xw, g0, g1, a0, a1, o0, o1) const f32x4 o0 = (f32x4){__builtin_bit_cast(float, xw.x << 16), __builtin_bit_cast(float, xw.x & 0xffff0000u), __builtin_bit_cast(float, xw.y << 16), __builtin_bit_cast(float, xw.y & 0xffff0000u)} + g0 * a0, \
                                                            o1 = (f32x4){__builtin_bit_cast(float, xw.z << 16), __builtin_bit_cast(float, xw.z & 0xffff0000u), __builtin_bit_cast(float, xw.w << 16), __builtin_bit_cast(float, xw.w & 0xffff0000u)} + g1 * a1
        ER_LOAD(0); ER_LOAD(1); ER_LOAD(2); ER_LOAD(3);
        f32x4 gv[2][2];
#pragma unroll
        for (int bj = 0; bj < 2; ++bj)
#pragma unroll
            for (int n = 0; n < 2; ++n) gv[bj][n] = *(const PG8_LAS f32x4*)(Tc + bj * HALF + n * 4);
        float ss[8];
#pragma unroll
        for (int k = 0; k < 8; ++k) { const int ai = k >> 2, m = k & 3; float s = 0.f;
            __builtin_amdgcn_sched_barrier(0);
#pragma unroll
            for (int bj = 0; bj < 2; ++bj) { const u32x4 xw = xbuf[k % 4][bj]; ER_X(xw, gv[bj][0], gv[bj][1], acc[ai][bj][m][0], acc[ai][bj][m][1], o0, o1);
                s += (o0[0] * o0[0] + o0[1] * o0[1]) + (o0[2] * o0[2] + o0[3] * o0[3]) + (o1[0] * o1[0] + o1[1] * o1[1]) + (o1[2] * o1[2] + o1[3] * o1[3]); }
            ss[k] = s;
            __builtin_amdgcn_sched_barrier(0);
            ER_LOAD((k + 4) & 7); }
#pragma unroll
        for (int k = 0; k < 8; ++k) ss[k] += __shfl_xor(ss[k], 16);
#pragma unroll
        for (int k = 0; k < 8; ++k) ss[k] += __shfl_xor(ss[k], 32);
        unsigned long long old = 0;
        if (fq == 0) {
#pragma unroll
            for (int k = 0; k < 8; ++k) old |= __hip_atomic_fetch_add(rssf + row0 + (k >> 2) * HALF + (k & 3) * 16, (unsigned long long)(ss[k] * 1048576.0f), __ATOMIC_RELAXED, __HIP_MEMORY_SCOPE_AGENT); }
        asm volatile("" :: "v"((unsigned)old), "v"((unsigned)(old >> 32)) : "memory");
        unsigned* cnt = pcnt + u.pm * 16;
        if ((threadIdx.x & 63) == 0) { __hip_atomic_fetch_add(cnt, 1u, __ATOMIC_RELAXED, __HIP_MEMORY_SCOPE_AGENT);
            unsigned tries = 0; while (__hip_atomic_load(cnt, __ATOMIC_RELAXED, __HIP_MEMORY_SCOPE_AGENT) < 64u && ++tries < (1u << 21)) __builtin_amdgcn_s_sleep(4); }
        asm volatile("" : "+v"(gv[0][0]), "+v"(gv[0][1]), "+v"(gv[1][0]), "+v"(gv[1][1]) :: "memory");
        float rs[8];
#pragma unroll
        for (int k = 0; k < 8; ++k) rs[k] = __builtin_amdgcn_rsqf((float)__hip_atomic_load(rssf + row0 + (k >> 2) * HALF + (k & 3) * 16, __ATOMIC_RELAXED, __HIP_MEMORY_SCOPE_AGENT) * (1.0f / (1048576.0f * 2048.0f)) + 1e-6f);
        int row0b = row0; asm volatile("" : "+v"(row0b));
        f32x4 gf[2][2];
#pragma unroll
        for (int bj = 0; bj < 2; ++bj)
#pragma unroll
            for (int n = 0; n < 2; ++n) gf[bj][n] = *(const PG8_LAS f32x4*)(Tc + 256 + bj * HALF + n * 4);
#pragma unroll
        for (int k = 0; k < 8; ++k) { const int ai = k >> 2, m = k & 3; const size_t off = (size_t)(row0b + ai * HALF + m * 16) * 2048 + col0;
            __builtin_amdgcn_sched_barrier(0);
#pragma unroll
            for (int bj = 0; bj < 2; ++bj) { const u32x4 xw = xbuf[k % 4][bj]; ER_X(xw, gv[bj][0], gv[bj][1], acc[ai][bj][m][0], acc[ai][bj][m][1], o0, o1);
                *(f32x4*)(outp + off + bj * HALF) = o0 * (gf[bj][0] * rs[k]); *(f32x4*)(outp + off + bj * HALF + 4) = o1 * (gf[bj][1] * rs[k]); }
            __builtin_amdgcn_sched_barrier(0);
            if (k + 4 < 8) ER_LOAD(k + 4); }
#undef ER_X
#undef ER_LOAD
    }
};
__device__ __forceinline__ int f2i(float v) { return __builtin_bit_cast(int, v); }
__device__ __forceinline__ float i2f(int v) { return __builtin_bit_cast(float, v); }
template <int SH> __device__ __forceinline__ float dpp_ror(float v) { return i2f(__builtin_amdgcn_update_dpp(0, f2i(v), 0x120 + SH, 0xf, 0xf, true)); }
template <int SH> __device__ __forceinline__ float dpp_shr_fill(float fill, float cur) { return i2f(__builtin_amdgcn_update_dpp(f2i(fill), f2i(cur), 0x110 + SH, 0xf, 0xf, false)); }
struct EpiConv {
    static constexpr bool PERM = true, AFTER_DRAIN = false, PERMROW = true;
    bf16_t* ACT; const float* cw; const float* cb; float* HALO; PG8_LAS float* X; RowAffine ra; PG8_LAS float* TW;
    __device__ __forceinline__ void stage(const Unit& u, int p, int wid, int lane) const { ra.stage<true>(u, p, wid, lane);
        if (wid >= 3 && wid <= 6) { const int k = wid - 3, col = (lane < 32) ? (u.pn * 128 + lane * 4) : (5504 + u.pn * 128 + (lane - 32) * 4);
            __builtin_amdgcn_global_load_lds((const unsigned*)((k < 3 ? cw + (size_t)k * 11008 : cb) + col), (PG8_LAS unsigned*)(TW + p * 1024 + k * 256), 16, 0, 0); } }
    __device__ __forceinline__ void operator()(f32x4 (&acc)[2][2][4][2], const Unit& u, int p, int wr, int wc, int fr, int fq) const {
        const int tcol = wc * 32 + 8 * fq, ch0 = u.pn * 128 + tcol;
        ra.apply<true>(acc, p, wr, wc, fr, fq);
#if defined(MK_KREP) && MK_KREP > 1
#pragma unroll
        for (int ai = 0; ai < 2; ++ai)
#pragma unroll
            for (int bj = 0; bj < 2; ++bj)
#pragma unroll
                for (int m = 0; m < 4; ++m)
#pragma unroll
                    for (int n = 0; n < 2; ++n) acc[ai][bj][m][n] *= (1.0f / MK_KREP);
#endif
        if (fr == 15) {
#pragma unroll
            for (int ai = 0; ai < 2; ++ai)
#pragma unroll
                for (int mm = 0; mm < 2; ++mm)
#pragma unroll
                    for (int bj = 0; bj < 2; ++bj)
#pragma unroll
                        for (int n = 0; n < 2; ++n) *(PG8_LAS f32x4*)(X + (((ai * 2 + wr) * 2 + mm) * 256) + bj * 128 + tcol + 4 * n) = acc[ai][bj][2 + mm][n];
            if (wr == 1) {
#pragma unroll
                for (int mm = 0; mm < 2; ++mm)
#pragma unroll
                    for (int bj = 0; bj < 2; ++bj)
#pragma unroll
                        for (int n = 0; n < 2; ++n) *(f32x4*)(HALO + ((size_t)u.pm * 4 + 2 + mm) * 11008 + bj * 5504 + ch0 + 4 * n) = acc[1][bj][2 + mm][n]; }
        }
        if (fr == 0 && wr == 0) {
#pragma unroll
            for (int mm = 0; mm < 2; ++mm)
#pragma unroll
                for (int bj = 0; bj < 2; ++bj)
#pragma unroll
                    for (int n = 0; n < 2; ++n) *(f32x4*)(HALO + ((size_t)u.pm * 4 + mm) * 11008 + bj * 5504 + ch0 + 4 * n) = acc[0][bj][mm][n]; }
        asm volatile("s_waitcnt lgkmcnt(0)" ::: "memory"); __builtin_amdgcn_s_barrier(); asm volatile("" ::: "memory");
        const PG8_LAS float* Tw = TW + p * 1024 + tcol;
        const int row0 = u.pm * BM + wr * 64 + 4 * fr;
#pragma unroll
        for (int ai = 0; ai < 2; ++ai) { const int g = ai * 2 + wr;
#pragma unroll
            for (int bj = 0; bj < 2; ++bj)
#pragma unroll
                for (int n = 0; n < 2; ++n) {
                    const f32x4 w0 = *(const PG8_LAS f32x4*)(Tw + bj * 128 + 4 * n), w1 = *(const PG8_LAS f32x4*)(Tw + 256 + bj * 128 + 4 * n), w2 = *(const PG8_LAS f32x4*)(Tw + 512 + bj * 128 + 4 * n), bb = *(const PG8_LAS f32x4*)(Tw + 768 + bj * 128 + 4 * n);
                    f32x4 h62 = (f32x4){0.f, 0.f, 0.f, 0.f}, h63 = h62;
                    if (g > 0) { h62 = *(const PG8_LAS f32x4*)(X + (((g - 1) * 2 + 0) * 256) + bj * 128 + tcol + 4 * n); h63 = *(const PG8_LAS f32x4*)(X + (((g - 1) * 2 + 1) * 256) + bj * 128 + tcol + 4 * n); }
                    const f32x4 x0 = acc[ai][bj][0][n], x1 = acc[ai][bj][1][n], x2 = acc[ai][bj][2][n], x3 = acc[ai][bj][3][n];
                    f32x4 s2, s3;
#pragma unroll
                    for (int e = 0; e < 4; ++e) { s3[e] = dpp_shr_fill<1>(h63[e], x3[e]); s2[e] = dpp_shr_fill<1>(h62[e], x2[e]); }
                    f32x4 r0 = bb + w2 * x0 + w1 * s3 + w0 * s2, r1 = bb + w2 * x1 + w1 * x0 + w0 * s3, r2 = bb + w2 * x2 + w1 * x1 + w0 * x0, r3 = bb + w2 * x3 + w1 * x2 + w0 * x1;
                    asm volatile("" : "+v"(r0), "+v"(r1), "+v"(r2), "+v"(r3));
                    acc[ai][bj][0][n] = r0; acc[ai][bj][1][n] = r1; acc[ai][bj][2][n] = r2; acc[ai][bj][3][n] = r3;
                    __builtin_amdgcn_sched_barrier(0); }
#pragma unroll
            for (int m = 0; m < 4; ++m) { f32x4 o[2];
#pragma unroll
                for (int n = 0; n < 2; ++n) { const f32x4 gt = acc[ai][0][m][n], a = gt * -1.4426950408889634f, gu = gt * acc[ai][1][m][n];
                    f32x4 ex; ex.x = __builtin_amdgcn_exp2f(a.x); ex.y = __builtin_amdgcn_exp2f(a.y); ex.z = __builtin_amdgcn_exp2f(a.z); ex.w = __builtin_amdgcn_exp2f(a.w);
                    const f32x4 d = ex + 1.0f; f32x4 r; r.x = __builtin_amdgcn_rcpf(d.x); r.y = __builtin_amdgcn_rcpf(d.y); r.z = __builtin_amdgcn_rcpf(d.z); r.w = __builtin_amdgcn_rcpf(d.w);
                    o[n] = gu * r; }
                u32x4 w; w.x = cvt_pk_bf16(o[0][0], o[0][1]); w.y = cvt_pk_bf16(o[0][2], o[0][3]); w.z = cvt_pk_bf16(o[1][0], o[1][1]); w.w = cvt_pk_bf16(o[1][2], o[1][3]);
                EPI_ST16(ACT + (size_t)(row0 + ai * HALF + m) * 5504 + ch0, w); }
            __builtin_amdgcn_sched_barrier(0); }
    }
};
template <class Epi, class Sched, bool ALIGN_EPI = false, bool SP2 = false, int KREP = 1, int TP = 0>
__device__ __forceinline__ void gemm_phase(PG8_LAS unsigned char* lds, const Gemm g, const Sched& S, const Epi& E, unsigned long long* tp_out = nullptr) {
    unsigned long long tp_acc = 0, tp3 = 0;
    const int tid = ltid(), wid = __builtin_amdgcn_readfirstlane(tid >> 6), lane = tid & 63, wr = wid >> 2, wc = wid & 3, fr = lane & 15, fq = lane >> 4;
    const int K = g.K, nt = K / BK;
    unsigned voffA[2], voffB[2];
#pragma unroll
    for (int i = 0; i < 2; ++i) { int R, C; stage_rc(tid * 16 + i * 8192, R, C); const int Rb = Epi::PERM ? ((R & ~31) + perm32(R & 31)) : R;
        const int Ra = Epi::PERMROW ? ((R & ~63) + 4 * (R & 15) + ((R >> 4) & 3)) : R;
        voffA[i] = (unsigned)(Ra * K + C) * 2u; voffB[i] = (unsigned)(Rb * K + C) * 2u; }
    const size_t kstep = (size_t)(BK * 2);
    const size_t hstep = (size_t)HALF * K * 2;
    const size_t tstep = 2 * hstep;
    const unsigned ldsw = (unsigned)wid * 1024u;
    const int aoff = lds_byte(wr * 64 + fr, fq * 8), boff = lds_byte(wc * 32 + fr, fq * 8);
#define PG8_SA(b, h) (((b) * 2 + (h)) * HTB)
#define PG8_SB(b, h) ((4 + (b) * 2 + (h)) * HTB)
#define PG8_STAGE(bufoff, gbase, voff) do { _Pragma("unroll") for (int _i = 0; _i < 2; ++_i) \
        __builtin_amdgcn_global_load_lds((const unsigned*)((const char*)(gbase) + (voff)[_i]), (PG8_LAS unsigned*)(lds + (bufoff) + ldsw + _i * 8192), 16, 0, 0); } while (0)
#define PG8_LDA(dst, b, h) do { _Pragma("unroll") for (int m = 0; m < 4; ++m) _Pragma("unroll") for (int k = 0; k < 2; ++k) dst[m][k] = *(const PG8_LAS bf16x8*)(lds + PG8_SA(b, h) + aoff + m * 2048 + k * 1024); } while (0)
#define PG8_LDB(dst, b, h) do { _Pragma("unroll") for (int n = 0; n < 2; ++n) _Pragma("unroll") for (int k = 0; k < 2; ++k) dst[n][k] = *(const PG8_LAS bf16x8*)(lds + PG8_SB(b, h) + boff + n * 2048 + k * 1024); } while (0)
#define PG8_MMA(ai, bj, At, Bt) do { if (MK_SETPRIO) __builtin_amdgcn_s_setprio(MK_SETPRIO); _Pragma("unroll") for (int m = 0; m < 4; ++m) _Pragma("unroll") for (int n = 0; n < 2; ++n) _Pragma("unroll") for (int k = 0; k < 2; ++k) \
        acc[ai][bj][m][n] = __builtin_amdgcn_mfma_f32_16x16x32_bf16(Bt[n][k], At[m][k], acc[ai][bj][m][n], 0, 0, 0); if (MK_SETPRIO) __builtin_amdgcn_s_setprio(0); } while (0)
#define PG8_WAIT_V(n) asm volatile("s_waitcnt vmcnt(" #n ")" ::: "memory")
#define PG8_WAIT_L(n) asm volatile("s_waitcnt lgkmcnt(" #n ")" ::: "memory")
#define PG8_WAIT_V_SEL(sel) asm volatile("s_cmp_eq_u32 %0, 0\n\ts_cbranch_scc1 .Lw8_%=\n\ts_waitcnt vmcnt(22)\n\ts_branch .Lwd_%=\n.Lw8_%=:\n\ts_waitcnt vmcnt(8)\n.Lwd_%=:" :: "s"(sel) : "memory", "scc")
#define PG8_BAR __builtin_amdgcn_s_barrier()
#define PG8_SCHED __builtin_amdgcn_sched_barrier(0)
    Unit cur, nxt; int ui = 0;
    if (!S.next(0, cur)) return;
    E.stage(cur, 0, wid, lane);
    f32x4 acc[2][2][4][2];
#pragma unroll
    for (int a = 0; a < 2; ++a)
#pragma unroll
        for (int b = 0; b < 2; ++b)
#pragma unroll
            for (int m = 0; m < 4; ++m)
#pragma unroll
                for (int n = 0; n < 2; ++n) acc[a][b][m][n] = (f32x4){0.f, 0.f, 0.f, 0.f};
    bf16x8 At[4][2], B0[2][2], B1[2][2];
    const char* cA = (const char*)g.A + (size_t)cur.pm * tstep; const char* cB = (const char*)g.Bt + (size_t)cur.pn * tstep;
    S.a_ready(cur);
    if constexpr (SP2) {
        PG8_STAGE(PG8_SB(0, 0), cB, voffB); PG8_STAGE(PG8_SB(0, 1), cB + hstep, voffB); PG8_STAGE(PG8_SA(0, 0), cA, voffA); PG8_STAGE(PG8_SA(0, 1), cA + hstep, voffA);
        if (wr == 1) PG8_BAR;
        PG8_WAIT_V(2); PG8_BAR;
        PG8_STAGE(PG8_SB(1, 0), cB + kstep, voffB); PG8_STAGE(PG8_SA(1, 0), cA + kstep, voffA); PG8_STAGE(PG8_SB(1, 1), cB + hstep + kstep, voffB);
        PG8_WAIT_V(6); PG8_BAR;
    } else {
        PG8_STAGE(PG8_SB(0, 0), cB, voffB); PG8_STAGE(PG8_SA(0, 0), cA, voffA); PG8_STAGE(PG8_SB(0, 1), cB + hstep, voffB); PG8_STAGE(PG8_SA(0, 1), cA + hstep, voffA);
        if (wr == 1) PG8_BAR;
        PG8_WAIT_V(4); PG8_BAR;
        PG8_STAGE(PG8_SB(1, 0), cB + kstep, voffB); PG8_STAGE(PG8_SA(1, 0), cA + kstep, voffA); PG8_STAGE(PG8_SB(1, 1), cB + hstep + kstep, voffB);
        PG8_WAIT_V(6); PG8_BAR;
    }
    for (;;) {
        const bool has_next = S.next(ui + 1, nxt);
        if constexpr (TP == 3) { if (ui > 0) tp_acc += __builtin_amdgcn_s_memrealtime() - tp3; }
        const char* nA = has_next ? (const char*)g.A + (size_t)nxt.pm * tstep : cA; const char* nB = has_next ? (const char*)g.Bt + (size_t)nxt.pn * tstep : cB;
        for (int t = 0; t < nt * KREP; t += 2) {
            const bool last = (t == nt * KREP - 2);
            const int t1w = KREP > 1 ? ((t + 1) & (nt - 1)) : t + 1, t2w = KREP > 1 ? ((t + 2) & (nt - 1)) : t + 2;
            const char* a1 = cA + (size_t)t1w * kstep;
            const char* a2 = last ? nA : cA + (size_t)t2w * kstep; const char* b2 = last ? nB : cB + (size_t)t2w * kstep;
            const char* a3 = a2 + kstep; const char* b3 = b2 + kstep;
            if (last && has_next) S.a_ready(nxt);
            const int relax = __builtin_amdgcn_readfirstlane((MK_RELAXW && t == 0 && ui > 0) ? 1 : 0);
            if constexpr (SP2) {
            PG8_LDB(B0, 0, 0); PG8_LDB(B1, 0, 1); PG8_SCHED; PG8_LDA(At, 0, 0); PG8_STAGE(PG8_SA(1, 1), a1 + hstep, voffA);
            PG8_WAIT_V_SEL(relax);
            PG8_WAIT_L(0); PG8_BAR; PG8_MMA(0, 0, At, B0); PG8_MMA(0, 1, At, B1); PG8_BAR; PG8_SCHED;
            PG8_LDA(At, 0, 1); PG8_STAGE(PG8_SB(0, 0), b2, voffB); PG8_STAGE(PG8_SB(0, 1), b2 + hstep, voffB); PG8_STAGE(PG8_SA(0, 0), a2, voffA);
            PG8_WAIT_V_SEL(relax);
            PG8_WAIT_L(0); PG8_BAR; PG8_MMA(1, 0, At, B0); PG8_MMA(1, 1, At, B1); PG8_BAR; PG8_SCHED;
            PG8_LDB(B0, 1, 0); PG8_LDB(B1, 1, 1); PG8_SCHED; PG8_LDA(At, 1, 0); PG8_STAGE(PG8_SA(0, 1), a2 + hstep, voffA);
            PG8_WAIT_V(8); PG8_WAIT_L(0); PG8_BAR; PG8_MMA(0, 0, At, B0); PG8_MMA(0, 1, At, B1); PG8_BAR; PG8_SCHED;
            PG8_LDA(At, 1, 1); PG8_STAGE(PG8_SB(1, 0), b3, voffB); PG8_STAGE(PG8_SB(1, 1), b3 + hstep, voffB); PG8_STAGE(PG8_SA(1, 0), a3, voffA);
            PG8_WAIT_V(8); PG8_WAIT_L(0); PG8_BAR; PG8_MMA(1, 0, At, B0); PG8_MMA(1, 1, At, B1); PG8_BAR; PG8_SCHED;
            } else {
            PG8_LDB(B0, 0, 0); PG8_SCHED; PG8_LDA(At, 0, 0); PG8_STAGE(PG8_SA(1, 1), a1 + hstep, voffA);
            PG8_WAIT_L(8); PG8_BAR; PG8_WAIT_L(0); PG8_MMA(0, 0, At, B0); PG8_BAR; PG8_SCHED;
            PG8_LDB(B1, 0, 1); PG8_STAGE(PG8_SB(0, 0), b2, voffB);
            PG8_BAR; PG8_WAIT_L(0); PG8_MMA(0, 1, At, B1); PG8_BAR;
            PG8_LDA(At, 0, 1); PG8_STAGE(PG8_SA(0, 0), a2, voffA);
            PG8_BAR; PG8_WAIT_L(0); PG8_MMA(1, 0, At, B0); PG8_BAR; PG8_SCHED;
            PG8_STAGE(PG8_SB(0, 1), b2 + hstep, voffB);
            PG8_WAIT_V(6); PG8_BAR; PG8_MMA(1, 1, At, B1); PG8_BAR;
            PG8_LDB(B0, 1, 0); PG8_SCHED; PG8_LDA(At, 1, 0); PG8_STAGE(PG8_SA(0, 1), a2 + hstep, voffA);
            PG8_WAIT_L(8); PG8_BAR; PG8_WAIT_L(0); PG8_MMA(0, 0, At, B0); PG8_BAR; PG8_SCHED;
            PG8_LDB(B1, 1, 1); PG8_STAGE(PG8_SB(1, 0), b3, voffB);
            PG8_BAR; PG8_WAIT_L(0); PG8_MMA(0, 1, At, B1); PG8_BAR;
            PG8_LDA(At, 1, 1); PG8_STAGE(PG8_SA(1, 0), a3, voffA);
            PG8_BAR; PG8_WAIT_L(0); PG8_MMA(1, 0, At, B0); PG8_BAR; PG8_SCHED;
            PG8_STAGE(PG8_SB(1, 1), b3 + hstep, voffB);
            PG8_WAIT_V(6); PG8_BAR; PG8_MMA(1, 1, At, B1); PG8_BAR;
            }
        }
        unsigned long long tp0 = 0; if constexpr (TP == 1) tp0 = __builtin_amdgcn_s_memrealtime();
        if constexpr (ALIGN_EPI) { if (wr == 0) PG8_BAR; }
        if constexpr (TP == 2) tp0 = __builtin_amdgcn_s_memrealtime();
        if constexpr (!Epi::AFTER_DRAIN) { E(acc, cur, ui & 1, wr, wc, fr, fq); S.done(cur); }
        if constexpr (TP == 1 || TP == 2) tp_acc += __builtin_amdgcn_s_memrealtime() - tp0;
        if constexpr (TP == 3) tp3 = __builtin_amdgcn_s_memrealtime();
        if (!has_next) break;
        E.stage(nxt, (ui + 1) & 1, wid, lane);
#pragma unroll
        for (int a = 0; a < 2; ++a)
#pragma unroll
            for (int b = 0; b < 2; ++b)
#pragma unroll
                for (int m = 0; m < 4; ++m)
#pragma unroll
                    for (int n = 0; n < 2; ++n) acc[a][b][m][n] = (f32x4){0.f, 0.f, 0.f, 0.f};
        cur = nxt; cA = nA; cB = nB; ++ui;
        if constexpr (ALIGN_EPI) { if (wr == 1) PG8_BAR; }
    }
    if constexpr (TP != 0) { if (tp_out) *tp_out = tp_acc; }
    PG8_WAIT_V(0);
    if constexpr (!ALIGN_EPI) { if (wr == 0) PG8_BAR; }
    PG8_BAR;
    if constexpr (Epi::AFTER_DRAIN) { E.fused(acc, cur, wr, wc, fr, fq, lds, wid, lane); S.done(cur); }
#undef PG8_SA
#undef PG8_SB
#undef PG8_STAGE
#undef PG8_LDA
#undef PG8_LDB
#undef PG8_MMA
#undef PG8_WAIT_V
#undef PG8_WAIT_L
#undef PG8_WAIT_V_SEL
#undef PG8_BAR
#undef PG8_SCHED
}
}
#ifndef MK_ATTSKIP
#define MK_ATTSKIP 0
#endif
#ifndef MK_PPPROBE
#define MK_PPPROBE 0
#endif
#ifndef MK_YPRIO
#define MK_YPRIO 0
#endif
#ifndef MK_DMALATE
#define MK_DMALATE 0
#endif
#ifndef MK_ATTPRIO
#define MK_ATTPRIO 0
#endif
namespace fox {
enum { ORDER_NATURAL = 0, ORDER_REVERSED = 1, ORDER_PAIRED = 2, ORDER_XCD = 4 };
constexpr int B = 8, H = 16, HKV = 16, SQ = 4096, SKV = 4096, D = 128;
constexpr int QOFF = 0;
constexpr int WINDOW = SKV;
constexpr float THR = 8.f;
constexpr bool WSKIP = false;
constexpr float SCALE = 0.08838834764831845f;
constexpr float QSCALE = SCALE * 1.4426950408889634f;
constexpr int NW = 8, QBLK = 32, KVBLK = 64, QB = NW * QBLK;
constexpr int SHM_V = KVBLK * D * 2, SHM_K = KVBLK * D * 2;
constexpr int NBUF = 3;
constexpr int LDS_FB = NBUF * SHM_V + NBUF * SHM_K;
constexpr int LDS_BYTES = LDS_FB + 2 * SKV * 4;
constexpr int OPITCH = H * D;
using bf16 = __hip_bfloat16;
typedef short bf16x8 __attribute__((ext_vector_type(8)));
typedef short s16x4 __attribute__((ext_vector_type(4)));
typedef float f32x16 __attribute__((ext_vector_type(16)));
typedef float f32x4 __attribute__((ext_vector_type(4)));
typedef unsigned u32x4 __attribute__((ext_vector_type(4)));
template <class A, class Bt> struct same_t { static constexpr bool v = false; };
template <class A> struct same_t<A, A> { static constexpr bool v = true; };

#define KSWZ(row, colB) ((row) * 256 + ((colB) ^ (((row) & 7) << 4)))
#define SBAR() __builtin_amdgcn_sched_barrier(0)
__device__ __forceinline__ int v_st(int k, int c) { const int kk = (k & ~0xC) | ((k & 4) << 1) | ((k & 8) >> 1); return ((kk >> 3) * 4 + (c >> 5)) * 512 + ((kk & 7) * 32 + (c & 31)) * 2; }
__device__ __forceinline__ int v_rd_base(int lane) { return ((lane & 3) << 3) | (((lane >> 2) & 3) << 6) | (((lane >> 4) & 1) << 5) | (((lane >> 5) & 1) << 8); }
constexpr int v_rd_off(int d0, int ks, int half) { return d0 * 512 + ks * 4096 + half * 2048; }
__device__ __forceinline__ int crow(int r, int hi) { return (r & 3) + 8 * (r >> 2) + 4 * hi; }
__device__ __forceinline__ unsigned cvtpk(float lo, float hi) {
    unsigned r; asm volatile("v_cvt_pk_bf16_f32 %0, %1, %2" : "=v"(r) : "v"(lo), "v"(hi)); return r;
}
__device__ __forceinline__ bf16x8 pack8(f32x4 a, f32x4 b) {
    u32x4 w = {cvtpk(a[0], a[1]), cvtpk(a[2], a[3]), cvtpk(b[0], b[1]), cvtpk(b[2], b[3])};
    return *reinterpret_cast<bf16x8*>(&w);
}
template <class T> __device__ __forceinline__ bf16x8 load8(const T* p) {
    if constexpr (same_t<T, float>::v) { return pack8(*(const f32x4*)p, *(const f32x4*)(p + 4)); }
    else { return *reinterpret_cast<const bf16x8*>(p); }
}
__device__ __forceinline__ void mask_tile(f32x16& p0, f32x16& p1, int dq, unsigned W) {
    const float NEG = -__builtin_inff();
#pragma unroll
    for (int r = 0; r < 16; ++r) {
        const int c = (r & 3) + 8 * (r >> 2);
        if ((unsigned)(dq - c) >= W) p0[r] = NEG;
        if ((unsigned)(dq - c - 32) >= W) p1[r] = NEG;
    }
}
__device__ __forceinline__ void partialSM(f32x16& p0, f32x16& p1, float& m_reg, float& mn, float& alpha) {
    float pmax = p0[0]; for (int r = 1; r < 16; ++r) pmax = fmaxf(pmax, p0[r]); for (int r = 0; r < 16; ++r) pmax = fmaxf(pmax, p1[r]);
    { auto rr = __builtin_amdgcn_permlane32_swap(__float_as_uint(pmax), __float_as_uint(pmax), false, false);
      pmax = fmaxf(__uint_as_float(rr[0]), __uint_as_float(rr[1])); }
    constexpr float THR2 = THR * 1.4426950408889634f;
    if (__builtin_expect(__all((pmax - m_reg) <= THR2), 1)) { mn = m_reg; alpha = 1.f; }
    else { mn = fmaxf(m_reg, pmax); alpha = __builtin_amdgcn_exp2f(m_reg - mn); m_reg = mn; }
    p0 = p0 - mn; p1 = p1 - mn;
    for (int r = 0; r < 16; ++r) p0[r] = __builtin_amdgcn_exp2f(p0[r]);
}
__device__ __forceinline__ void finishSM(f32x16& p0, f32x16& p1, float alpha, float& l_reg, bf16x8& pa0, bf16x8& pa1, bf16x8& pa2, bf16x8& pa3) {
    for (int r = 0; r < 16; ++r) p1[r] = __builtin_amdgcn_exp2f(p1[r]);
    typedef float f32x8_ __attribute__((ext_vector_type(8))); typedef float f32x2_ __attribute__((ext_vector_type(2)));
    const f32x16 s16 = p0 + p1; const f32x8_ s8 = s16.lo + s16.hi; const f32x4 s4 = s8.lo + s8.hi; const f32x2_ s2 = s4.lo + s4.hi; float ps = s2.x + s2.y;
    { auto rr = __builtin_amdgcn_permlane32_swap(__float_as_uint(ps), __float_as_uint(ps), false, false);
      ps = __uint_as_float(rr[0]) + __uint_as_float(rr[1]); }
    l_reg = l_reg * alpha + ps;
#define PK4(P, B_, OUT) do { unsigned a0 = cvtpk(P[B_+0], P[B_+1]), a1 = cvtpk(P[B_+2], P[B_+3]);                          \
        unsigned b0 = cvtpk(P[B_+4], P[B_+5]), b1 = cvtpk(P[B_+6], P[B_+7]);                                             \
        auto r0 = __builtin_amdgcn_permlane32_swap(a0, b0, false, false); auto r1 = __builtin_amdgcn_permlane32_swap(a1, b1, false, false); \
        u32x4 w = {r0[0], r1[0], r0[1], r1[1]}; OUT = *reinterpret_cast<bf16x8*>(&w); } while (0)
    PK4(p0, 0, pa0); PK4(p0, 8, pa1); PK4(p1, 0, pa2); PK4(p1, 8, pa3);
#undef PK4
}
template <int KB, bool SK>
__device__ __forceinline__ void qkt(f32x16& p0, f32x16& p1, const char* K_lds, int r32, int hi, const bf16x8* qr, bool act, const char* fb) {
    if (SK && !act) { const float NEG = -__builtin_inff();
#pragma unroll
        for (int r = 0; r < 16; ++r) { p0[r] = NEG; p1[r] = NEG; } return; }
#pragma unroll
    for (int q = 0; q < 4; ++q) { const f32x4 b0 = *reinterpret_cast<const f32x4*>(fb + q * 32), b1 = *reinterpret_cast<const f32x4*>(fb + 128 + q * 32);
#pragma unroll
        for (int i = 0; i < 4; ++i) { p0[4 * q + i] = b0[i]; p1[4 * q + i] = b1[i]; } }
    const char* kb[4];
#pragma unroll
    for (int dd = 0; dd < 4; ++dd) kb[dd] = K_lds + KB * SHM_K + KSWZ(r32, (dd * 16 + hi * 8) * 2);
    if (MK_ATTPRIO) __builtin_amdgcn_s_setprio(1);
#pragma unroll
    for (int d0 = 0; d0 < 8; ++d0) { const char* a = kb[d0 & 3] + (d0 >> 2) * 128;
        bf16x8 b0 = *reinterpret_cast<const bf16x8*>(a);
        bf16x8 b1 = *reinterpret_cast<const bf16x8*>(a + 32 * 256);
        p0 = __builtin_amdgcn_mfma_f32_32x32x16_bf16(b0, qr[d0], p0, 0, 0, 0);
        p1 = __builtin_amdgcn_mfma_f32_32x32x16_bf16(b1, qr[d0], p1, 0, 0, 0); }
    if (MK_ATTPRIO) __builtin_amdgcn_s_setprio(0);
}
template <bool SK>
__device__ __forceinline__ void qkt_x(f32x16& p0, f32x16& p1, const char* K_lds, int r32, int hi, const bf16x8* qr, bool act, const char* fb) {
    const int k0a = (int)(uintptr_t)K_lds + KSWZ(r32, (0 * 16 + hi * 8) * 2), k1a = (int)(uintptr_t)K_lds + KSWZ(r32, (1 * 16 + hi * 8) * 2), k2a = (int)(uintptr_t)K_lds + KSWZ(r32, (2 * 16 + hi * 8) * 2), k3a = (int)(uintptr_t)K_lds + KSWZ(r32, (3 * 16 + hi * 8) * 2);
#define KRD(dst, a, off) asm volatile("ds_read_b128 %0, %1 offset:%2" : "=&v"(dst) : "v"(a), "i"(off) : "memory")
#define K_LD(R, A0, A1, off) do { KRD(R##0, A0, off); KRD(R##1, A0, off + 8192); KRD(R##2, A1, off); KRD(R##3, A1, off + 8192); } while (0)
#define K_MM(R, d) do { p0 = __builtin_amdgcn_mfma_f32_32x32x16_bf16(R##0, qr[d + 0], p0, 0, 0, 0); p1 = __builtin_amdgcn_mfma_f32_32x32x16_bf16(R##1, qr[d + 0], p1, 0, 0, 0); \
        p0 = __builtin_amdgcn_mfma_f32_32x32x16_bf16(R##2, qr[d + 1], p0, 0, 0, 0); p1 = __builtin_amdgcn_mfma_f32_32x32x16_bf16(R##3, qr[d + 1], p1, 0, 0, 0); } while (0)
#define K_W(n, R) asm volatile("s_waitcnt lgkmcnt(" #n ")" : "+v"(R##0), "+v"(R##1), "+v"(R##2), "+v"(R##3) :: "memory")
    bf16x8 ka0, ka1, ka2, ka3, kb0, kb1, kb2, kb3;
    K_LD(ka, k0a, k1a, 0); K_LD(kb, k2a, k3a, 0);
#pragma unroll
    for (int q = 0; q < 4; ++q) { const f32x4 b0 = *reinterpret_cast<const f32x4*>(fb + q * 32), b1 = *reinterpret_cast<const f32x4*>(fb + 128 + q * 32);
#pragma unroll
        for (int i = 0; i < 4; ++i) { p0[4 * q + i] = b0[i]; p1[4 * q + i] = b1[i]; } }
    K_W(12, ka);
    K_MM(ka, 0); K_LD(ka, k0a, k1a, 128);
    K_W(4, kb); K_MM(kb, 2); K_LD(kb, k2a, k3a, 128);
    K_W(4, ka); K_MM(ka, 4);
    K_W(0, kb); K_MM(kb, 6);
#undef K_W
#undef K_MM
#undef K_LD
#undef KRD
}
template <int VB, bool SK>
__device__ __forceinline__ void pv_tile(f32x16* o, int vb0, bf16x8 pa0, bf16x8 pa1, bf16x8 pa2, bf16x8 pa3, bool act) {
    if (SK && !act) return;
#define TRRD(dst, off) asm volatile("ds_read_b64_tr_b16 %0, %1 offset:%2" : "=&v"(dst) : "v"(vb0), "i"(off) : "memory")
#define PV_D0(d0) do { s16x4 l0, l1, l2, l3, h0, h1, h2, h3; constexpr int b_ = VB * SHM_V + v_rd_off(d0, 0, 0);     \
        TRRD(l0, b_); TRRD(h0, b_ + 2048); TRRD(l1, b_ + 4096); TRRD(h1, b_ + 6144); TRRD(l2, b_ + 8192); TRRD(h2, b_ + 10240); TRRD(l3, b_ + 12288); TRRD(h3, b_ + 14336); \
        asm volatile("s_waitcnt lgkmcnt(0)" ::: "memory"); SBAR();                 \
        o[d0] = __builtin_amdgcn_mfma_f32_32x32x16_bf16((bf16x8){l0[0], l0[1], l0[2], l0[3], h0[0], h0[1], h0[2], h0[3]}, pa0, o[d0], 0, 0, 0);   \
        o[d0] = __builtin_amdgcn_mfma_f32_32x32x16_bf16((bf16x8){l1[0], l1[1], l1[2], l1[3], h1[0], h1[1], h1[2], h1[3]}, pa1, o[d0], 0, 0, 0);   \
        o[d0] = __builtin_amdgcn_mfma_f32_32x32x16_bf16((bf16x8){l2[0], l2[1], l2[2], l2[3], h2[0], h2[1], h2[2], h2[3]}, pa2, o[d0], 0, 0, 0);   \
        o[d0] = __builtin_amdgcn_mfma_f32_32x32x16_bf16((bf16x8){l3[0], l3[1], l3[2], l3[3], h3[0], h3[1], h3[2], h3[3]}, pa3, o[d0], 0, 0, 0); } while (0)
    if (MK_ATTPRIO) __builtin_amdgcn_s_setprio(1);
    PV_D0(0); PV_D0(1); PV_D0(2); PV_D0(3);
    if (MK_ATTPRIO) __builtin_amdgcn_s_setprio(0);
#undef PV_D0
#undef TRRD
}
template <bool SK>
__device__ __forceinline__ void pv_tile_x(f32x16* o, int vb, bf16x8 pa0, bf16x8 pa1, bf16x8 pa2, bf16x8 pa3, bool act) {
    if (SK && !act) return;
#define TRRD(dst, off) asm volatile("ds_read_b64_tr_b16 %0, %1 offset:%2" : "=&v"(dst) : "v"(vb), "i"(off) : "memory")
#define PV_LD(R, d0) do { constexpr int b_ = v_rd_off(d0, 0, 0); TRRD(R##0, b_); TRRD(R##1, b_ + 2048); TRRD(R##2, b_ + 4096); TRRD(R##3, b_ + 6144); TRRD(R##4, b_ + 8192); TRRD(R##5, b_ + 10240); TRRD(R##6, b_ + 12288); TRRD(R##7, b_ + 14336); } while (0)
#define PV_J(l, h) ((bf16x8){l[0], l[1], l[2], l[3], h[0], h[1], h[2], h[3]})
#define PV_MM(R, d0) do { o[d0] = __builtin_amdgcn_mfma_f32_32x32x16_bf16(PV_J(R##0, R##1), pa0, o[d0], 0, 0, 0); o[d0] = __builtin_amdgcn_mfma_f32_32x32x16_bf16(PV_J(R##2, R##3), pa1, o[d0], 0, 0, 0); \
        o[d0] = __builtin_amdgcn_mfma_f32_32x32x16_bf16(PV_J(R##4, R##5), pa2, o[d0], 0, 0, 0); o[d0] = __builtin_amdgcn_mfma_f32_32x32x16_bf16(PV_J(R##6, R##7), pa3, o[d0], 0, 0, 0); } while (0)
#define PV_W(n, R) asm volatile("s_waitcnt lgkmcnt(" #n ")" : "+v"(R##0), "+v"(R##1), "+v"(R##2), "+v"(R##3), "+v"(R##4), "+v"(R##5), "+v"(R##6), "+v"(R##7) :: "memory")
    s16x4 fa0, fa1, fa2, fa3, fa4, fa5, fa6, fa7, fb0, fb1, fb2, fb3, fb4, fb5, fb6, fb7;
    PV_LD(fa, 0); PV_LD(fb, 1);
    PV_W(8, fa); PV_MM(fa, 0); PV_LD(fa, 2);
    PV_W(8, fb); PV_MM(fb, 1); PV_LD(fb, 3);
    PV_W(8, fa); PV_MM(fa, 2);
    PV_W(0, fb); PV_MM(fb, 3);
#undef PV_W
#undef PV_MM
#undef PV_J
#undef PV_LD
#undef TRRD
}
template <class TIn, class TOut> struct BlockRef { const TIn* Q; const TIn* K; const TIn* V; TOut* O; const float* FB; int P0; };
template <class TIn> struct Seam { bf16x8 qr[8]; int b0, fp; };
#define FOX_LAS __attribute__((address_space(3)))
#define VMW() asm volatile("s_waitcnt vmcnt(0)" ::: "memory")
struct DmaMap { unsigned k0, k1, v0, v1, kl, vl; };
__device__ __forceinline__ DmaMap dma_map(char* lds, int wid, int lane) {
    DmaMap m;
#pragma unroll
    for (int j = 0; j < 2; ++j) {
        const int pk = wid * 2 + j;
        const int r = pk * 4 + (lane >> 4), p = lane & 15, c = p ^ (r & 7);
        const unsigned ko = (unsigned)(r * 256 + c * 16);
        const int s = pk * 2 + (lane >> 5), kk = (s >> 2) * 8 + ((lane & 31) >> 2), cc = (s & 3) * 32 + (lane & 3) * 8;
        const int k = (kk & ~0xC) | ((kk & 4) << 1) | ((kk & 8) >> 1);
        const unsigned vo = (unsigned)(k * 256 + cc * 2);
        if (j == 0) { m.k0 = ko; m.v0 = vo; } else { m.k1 = ko; m.v1 = vo; }
    }
    m.kl = (unsigned)(uintptr_t)(lds + NBUF * SHM_V) + (unsigned)wid * 2048u; m.vl = (unsigned)(uintptr_t)lds + (unsigned)wid * 2048u;
    return m;
}
#define DMA_TILE(Kp, Vp, kb_, buf_) do { const char* kp_ = (const char*)(Kp) + (size_t)(kb_) * (D * 2); const char* vp_ = (const char*)(Vp) + (size_t)(kb_) * (D * 2);                 \
        __builtin_amdgcn_global_load_lds((const unsigned*)(kp_ + M.k0), (FOX_LAS unsigned*)(M.kl + (unsigned)(buf_) * SHM_K), 16, 0, 0);                                           \
        __builtin_amdgcn_global_load_lds((const unsigned*)(kp_ + M.k1), (FOX_LAS unsigned*)(M.kl + (unsigned)(buf_) * SHM_K + 1024u), 16, 0, 0);                                   \
        __builtin_amdgcn_global_load_lds((const unsigned*)(vp_ + M.v0), (FOX_LAS unsigned*)(M.vl + (unsigned)(buf_) * SHM_V), 16, 0, 0);                                           \
        __builtin_amdgcn_global_load_lds((const unsigned*)(vp_ + M.v1), (FOX_LAS unsigned*)(M.vl + (unsigned)(buf_) * SHM_V + 1024u), 16, 0, 0); } while (0)
#define BIAS_DMA(FBp, nk, img) do { const int np_ = (nk) >> 8; const unsigned fl_ = (unsigned)(uintptr_t)(lds + LDS_FB) + (unsigned)(img) * (SKV * 4);                       \
        for (int pc_ = wid; pc_ < np_; pc_ += NW) __builtin_amdgcn_global_load_lds((const unsigned*)((const char*)(FBp) + pc_ * 1024 + lane * 16), (FOX_LAS unsigned*)(fl_ + (unsigned)pc_ * 1024u), 16, 0, 0); } while (0)
template <class TIn, class TOut>
__device__ __forceinline__ void causal_swa_prime(const BlockRef<TIn, TOut>& cur, int W, char* lds, Seam<TIn>& S) {
    static_assert(!same_t<TIn, float>::v, "bf16 q/k/v only");
    const int tid = ltid(), wid = __builtin_amdgcn_readfirstlane(tid >> 6), lane = tid & 63, r32 = lane & 31, hi = lane >> 5;
    const DmaMap M = dma_map(lds, wid, lane);
    DMA_TILE(cur.K, cur.V, 0, 0); S.b0 = 0; BIAS_DMA(cur.FB, cur.P0 + QB, 0); S.fp = 0;
    for (int d0 = 0; d0 < 8; ++d0) S.qr[d0] = load8<TIn>(cur.Q + (size_t)(wid * QBLK + r32) * D + d0 * 16 + hi * 8);
    VMW(); __syncthreads();
}
template <class TIn, class TOut>
__device__ __forceinline__ void causal_swa_block(const BlockRef<TIn, TOut>& cur, const BlockRef<TIn, TOut>& nxt, int skv, int W, char* lds, Seam<TIn>& S) {
    static_assert(!same_t<TIn, float>::v && !same_t<TOut, float>::v, "bf16 q/k/v/o only");
    const int tid = ltid(), wid = __builtin_amdgcn_readfirstlane(tid >> 6), lane = tid & 63, r32 = lane & 31, hi = lane >> 5;
    const int NT = (cur.P0 + QB) / KVBLK;
    const int qlo = cur.P0 + wid * QBLK, qm = qlo + r32 - 4 * hi;
    char* V_lds = lds; char* K_lds = lds + NBUF * SHM_V;
    float m_reg = -1e30f, l_reg = 0; f32x16 o[4] = {};
    float* fbuf = (float*)(lds + LDS_FB) + S.fp * SKV;
    BIAS_DMA(nxt.FB, nxt.P0 + QB, S.fp ^ 1);
    const char* fbl = (const char*)fbuf + hi * 16;
    m_reg = fbuf[cur.P0 + wid * QBLK + r32];
    const int vb0 = (int)(uintptr_t)V_lds + v_rd_base(lane);
    const DmaMap M = dma_map(lds, wid, lane);
    const TIn* Kh = cur.K; const TIn* Vh = cur.V;
    constexpr bool SK = MK_ATTSKIP;
#define RESC(a) do { if (__any((a) < 1.f)) { for (int d_ = 0; d_ < 4; ++d_) o[d_] = o[d_] * (a); } } while (0)
#define KBASE(t) ((t) * KVBLK)
#define ACT(t) (!SK || KBASE(t) <= qlo + QBLK - 1)
#define NXB(b) ((b) == NBUF - 1 ? 0 : (b) + 1)
#define MASKT(P0_, P1_, t) do { const int kb_ = KBASE(t); if (kb_ + KVBLK - 1 > qlo) mask_tile(P0_, P1_, qm - kb_, (unsigned)W); } while (0)
    f32x16 pA0, pA1, pB0, pB1; float mnA, mnB, alA, alB; bf16x8 pa0, pa1, pa2, pa3;
    const int b0 = S.b0; int kbt = NXB(b0);
    if (NT > 1) DMA_TILE(Kh, Vh, KBASE(1), kbt);
    SBAR(); qkt_x<SK>(pA0, pA1, K_lds + b0 * SHM_K, r32, hi, S.qr, ACT(0), fbl + KBASE(0) * 4);
    MASKT(pA0, pA1, 0); partialSM(pA0, pA1, m_reg, mnA, alA);
    VMW(); __syncthreads();
#define HALF_STEP3(PX0, PX1, mnX, alX, PY0, PY1, alY, t) do {                                                                 \
        const int bt_ = kbt, bp_ = (kbt == 0 ? NBUF - 1 : kbt - 1), bn_ = NXB(kbt);                                           \
        if (!MK_DMALATE && (t) + 1 < NT) DMA_TILE(Kh, Vh, KBASE((t) + 1), bn_);                                               \
        SBAR(); qkt_x<SK>(PX0, PX1, K_lds + bt_ * SHM_K, r32, hi, S.qr, ACT(t), fbl + KBASE(t) * 4);                         \
        if (MK_DMALATE && (t) + 1 < NT) { SBAR(); DMA_TILE(Kh, Vh, KBASE((t) + 1), bn_); SBAR(); }     \
        finishSM(PY0, PY1, alY, l_reg, pa0, pa1, pa2, pa3); SBAR();                                                           \
        pv_tile_x<SK>(o, vb0 + bp_ * SHM_V, pa0, pa1, pa2, pa3, ACT((t) - 1)); MASKT(PX0, PX1, (t)); partialSM(PX0, PX1, m_reg, mnX, alX); \
        RESC(alX); VMW(); __syncthreads(); kbt = bn_; } while (0)
    for (int t = 1; t + 1 < NT; t += 2) {
        HALF_STEP3(pB0, pB1, mnB, alB, pA0, pA1, alA, t);
        HALF_STEP3(pA0, pA1, mnA, alA, pB0, pB1, alB, t + 1);
    }
    const int bl_ = kbt, blp_ = (kbt == 0 ? NBUF - 1 : kbt - 1), bf_ = 3 - bl_ - blp_;
    const bool even = (NT & 1) == 0;
    if (even) { SBAR(); qkt_x<SK>(pB0, pB1, K_lds + bl_ * SHM_K, r32, hi, S.qr, ACT(NT - 1), fbl + KBASE(NT - 1) * 4); SBAR(); }
    DMA_TILE(nxt.K, nxt.V, 0, bf_); S.b0 = bf_; S.fp ^= 1; SBAR();
#pragma unroll
    for (int d0 = 0; d0 < 8; ++d0) S.qr[d0] = load8<TIn>(nxt.Q + (size_t)(wid * QBLK + r32) * D + d0 * 16 + hi * 8);
    SBAR();
    finishSM(pA0, pA1, alA, l_reg, pa0, pa1, pa2, pa3); SBAR();
    pv_tile_x<SK>(o, vb0 + blp_ * SHM_V, pa0, pa1, pa2, pa3, ACT(even ? NT - 2 : NT - 1));
    if (even) { MASKT(pB0, pB1, NT - 1); partialSM(pB0, pB1, m_reg, mnB, alB); RESC(alB);
        finishSM(pB0, pB1, alB, l_reg, pa0, pa1, pa2, pa3); SBAR(); pv_tile_x<SK>(o, vb0 + bl_ * SHM_V, pa0, pa1, pa2, pa3, ACT(NT - 1)); }
    SBAR();
    { const float rl = __builtin_amdgcn_rcpf(l_reg);
      TOut* Ow = cur.O + (size_t)(wid * QBLK + r32) * OPITCH + 8 * hi;
#pragma unroll
      for (int d0 = 0; d0 < 4; ++d0) { const f32x16 v = o[d0] * rl;
#pragma unroll
        for (int hf = 0; hf < 2; ++hf) { const unsigned a0 = cvtpk(v[8 * hf + 0], v[8 * hf + 1]), a1 = cvtpk(v[8 * hf + 2], v[8 * hf + 3]), b0_ = cvtpk(v[8 * hf + 4], v[8 * hf + 5]), b1_ = cvtpk(v[8 * hf + 6], v[8 * hf + 7]);
            auto r0 = __builtin_amdgcn_permlane32_swap(a0, b0_, false, false); auto r1 = __builtin_amdgcn_permlane32_swap(a1, b1_, false, false);
            u32x4 w = {r0[0], r1[0], r0[1], r1[1]};
            *(u32x4*)(Ow + d0 * 32 + 16 * hf) = w; } } }
    VMW(); __syncthreads();
#undef RESC
#undef KBASE
#undef ACT
#undef NXB
#undef MASKT
#undef HALF_STEP3
}
#undef VMW
#undef BIAS_DMA
#undef DMA_TILE
constexpr int NQB = SQ / QB, NXI = NQB / 2, NITEMS = NXI * B * H;
struct SwaItem { int bh, qb0, qb1; };
__device__ __forceinline__ SwaItem swa_decode(int L) { SwaItem it; const int xcd = L & 7, k = L >> 3; it.bh = (k / NXI) * 8 + xcd; const int x = k % NXI; it.qb0 = x; it.qb1 = NQB - 1 - x; return it; }
template <class TIn, class TOut>
__device__ __forceinline__ BlockRef<TIn, TOut> swa_ref(const SwaItem& it, int pass, const TIn* Q, const TIn* K, const TIn* V, TOut* O, const float* FB) {
    const int qb = pass ? it.qb1 : it.qb0;
    BlockRef<TIn, TOut> r;
    r.Q = Q + ((size_t)it.bh * SQ + (size_t)qb * QB) * D;
    r.O = O + ((size_t)(it.bh / H) * SQ + (size_t)qb * QB) * OPITCH + (it.bh % H) * D;
    r.K = K + (size_t)it.bh * SKV * D; r.V = V + (size_t)it.bh * SKV * D; r.FB = FB + (size_t)it.bh * SKV; r.P0 = qb * QB;
    return r;
}
__device__ __forceinline__ void att_phase(char* lds, const bf16* Q, const bf16* K, const bf16* V, bf16* O, const float* FB, int wg, int nwg) {
    int L = wg; if (L >= NITEMS) return;
    SwaItem it = swa_decode(L); int pass = 0;
    BlockRef<bf16, bf16> cur = swa_ref<bf16, bf16>(it, 0, Q, K, V, O, FB);
    Seam<bf16> S;
    causal_swa_prime<bf16, bf16>(cur, WINDOW, lds, S);
    for (;;) {
        const bool more_pass = pass == 0 && it.qb1 != it.qb0, more_item = L + nwg < NITEMS, last = !more_pass && !more_item;
        SwaItem itn = it; int passn = pass + 1, Ln = L;
        if (!more_pass) { passn = 0; Ln = more_item ? L + nwg : L; itn = swa_decode(Ln); }
        const BlockRef<bf16, bf16> nxt = last ? cur : swa_ref<bf16, bf16>(itn, passn, Q, K, V, O, FB);
        causal_swa_block<bf16, bf16>(cur, nxt, SKV, WINDOW, lds, S);
        if (last) break;
        cur = nxt; it = itn; pass = passn; L = Ln;
    }
}
}
constexpr int DM = 2048, NBATCH = 8, SEQ = 4096, DEPTH = 4, NHEAD = 16, HDIM = 128, DFF = 5504, NFF2 = 2 * DFF, MTOK = NBATCH * SEQ;
constexpr int NQKVF = 3 * DM + NHEAD;
constexpr float EPS = 1e-6f;
constexpr int NWAVES = 8;
#ifndef MK_BARBLK
#define MK_BARBLK 0
#endif
#define BARPROBE_BLK(b) (MK_BARBLK == 0 ? true : MK_BARBLK == 1 ? ((b) < 128) : MK_BARBLK == 2 ? ((b) >= 128) : true)
#ifndef MK_PROA_SHARE
#define MK_PROA_SHARE 54
#endif
#ifndef MK_PER_PHASE
#define MK_PER_PHASE 0
#endif
constexpr size_t MiB = 1u << 20;
constexpr size_t WS_CTL = 0, CTL_ZERO_BYTES = 3 * MiB + 512 * 1024;
constexpr size_t WS_RSSF = 256 * 1024, WS_PCNT = 896 * 1024;
constexpr size_t WS_RSS = 1 * MiB;
constexpr size_t WS_VSS = 3 * MiB;
constexpr size_t WS_MOD = 3 * MiB + 512 * 1024;
constexpr size_t WS_SHT = 5 * MiB;
constexpr size_t WS_BIASV = 5 * MiB + 512 * 1024;
constexpr size_t WS_LOGF = 7 * MiB + 512 * 1024;
constexpr size_t WS_FB = 9 * MiB + 512 * 1024;
constexpr size_t WS_WQKV = 12 * MiB;
constexpr size_t WQKV_STRIDE = 25 * MiB / 2;
constexpr size_t WS_WO = 62 * MiB;
constexpr size_t WS_WGI = 78 * MiB;
constexpr size_t WS_WGO = 110 * MiB;
constexpr size_t WS_WF1 = 126 * MiB;
constexpr size_t WS_WF2 = 298 * MiB;
constexpr size_t WS_H = 384 * MiB;
constexpr size_t WS_H2 = 512 * MiB;
constexpr size_t WS_XB = 640 * MiB;
constexpr size_t WS_R = 768 * MiB;
constexpr size_t WS_END = WS_R + 384 * MiB;
constexpr int BV_QKVF = 0, BV_GI = 2 * 8 * NQKVF, BV_F1 = BV_GI + 2 * 8 * 4096;
constexpr int CW_TMO = 0, CW_BAR = 4096;

constexpr int RING_OFF = 0, RING_BYTES = 131072, XCH_OFF = 131072;
constexpr int CWT_OFF = 131072 + 14336;
constexpr int LDSCTL_OFF = 155648, MISC_OFF = LDSCTL_OFF + 320;
constexpr int LDS_BYTES = 159744;

#define GAS __attribute__((address_space(1)))
#define LAS __attribute__((address_space(3)))
typedef unsigned short bf16;
typedef unsigned v4u __attribute__((ext_vector_type(4)));
typedef unsigned v2u __attribute__((ext_vector_type(2)));
typedef float f32x4 __attribute__((ext_vector_type(4)));
typedef short bf16x8 __attribute__((ext_vector_type(8)));
typedef GAS unsigned gu32;
typedef unsigned long long u64;
constexpr float FIXS = 1048576.0f, FIXI = 1.0f / (1048576.0f * 2048.0f);
__device__ __forceinline__ float rstd_of(u64 v) { return __builtin_amdgcn_rsqf((float)v * FIXI + 1e-6f); }
#define RLX_AGENT __ATOMIC_RELAXED, __HIP_MEMORY_SCOPE_AGENT
#define LDS_WAIT() asm volatile("s_waitcnt lgkmcnt(0)" ::: "memory")
#define VM_WAIT() asm volatile("s_waitcnt vmcnt(0)" ::: "memory")
__device__ __forceinline__ unsigned f2bf(float f) { unsigned u = __builtin_bit_cast(unsigned, f); return (u + 0x7fffu + ((u >> 16) & 1u)) >> 16; }
__device__ __forceinline__ unsigned pk2(float lo, float hi) { return f2bf(lo) | (f2bf(hi) << 16); }
__device__ __forceinline__ float bf2f(unsigned short b) { return __builtin_bit_cast(float, (unsigned)b << 16); }
__device__ __forceinline__ float bflo(unsigned w) { return __builtin_bit_cast(float, w << 16); }
__device__ __forceinline__ float bfhi(unsigned w) { return __builtin_bit_cast(float, w & 0xffff0000u); }
#define XB_TMO      128
#define XB_XCNT(j)  (256  + 64 * (j))
#define XB_XSUB(j)  (1280 + 64 * (j))
#define XB_XGEN(j)  (2304 + 64 * (j))
#define XB_TOP      3328
#define XB_TOPGEN   3392
#define XCD_BAR_WORDS 3456
#define XB_SPIN_CAP (1u << 18)

__device__ __forceinline__ unsigned xb_ld(unsigned* p)              { return __hip_atomic_load((GAS unsigned*)p, __ATOMIC_RELAXED, __HIP_MEMORY_SCOPE_AGENT); }
__device__ __forceinline__ unsigned xb_add(unsigned* p, unsigned v) { return __hip_atomic_fetch_add((GAS unsigned*)p, v, __ATOMIC_RELAXED, __HIP_MEMORY_SCOPE_AGENT); }
__device__ __forceinline__ unsigned xb_xcc_id() { return (unsigned)__builtin_amdgcn_s_getreg((3 << 11) | 20) & 0xFu; }
#define XB_SPIN(cond, bar) do { unsigned _sp = 0; while (cond) { __builtin_amdgcn_s_sleep(1); \
    if ((++_sp & 255u) == 0u) { if (xb_ld(&(bar)[XB_TMO])) break; if (_sp > XB_SPIN_CAP) { xb_add(&(bar)[XB_TMO], 1u); break; } } } } while (0)

struct XcdBarrier {
    unsigned* bar; unsigned x;
    volatile LAS unsigned* st;
};

__device__ __forceinline__ XcdBarrier xcd_barrier_post(unsigned* bar, volatile LAS unsigned* st) {
    XcdBarrier b; b.bar = bar; b.x = xb_xcc_id(); b.st = st;
    if (threadIdx.x == 0) (void)xb_add(&bar[XB_XCNT(b.x)], 1u);
    return b;
}
__device__ __forceinline__ void xcd_barrier_complete(unsigned* bar, unsigned x, unsigned& nloc, unsigned& nx) {
    const unsigned G = gridDim.x * gridDim.y * gridDim.z;
    unsigned sum, cnt, mine, sp = 0u;
    for (;;) {
        sum = 0u; cnt = 0u; mine = 0u;
#pragma unroll
        for (unsigned j = 0; j < 16; ++j) { const unsigned c = xb_ld(&bar[XB_XCNT(j)]); sum += c; cnt += (c > 0u) ? 1u : 0u; mine = (j == x) ? c : mine; }
        if (sum == G) break;
        __builtin_amdgcn_s_sleep(1);
        if ((++sp & 255u) == 0u) { if (xb_ld(&bar[XB_TMO])) break; if (sp > XB_SPIN_CAP) { xb_add(&bar[XB_TMO], 1u); break; } }
    }
    nloc = mine > 0u ? mine : 1u; nx = cnt > 0u ? cnt : 1u;
}

__device__ __forceinline__ void xcd_barrier(const XcdBarrier& b) {
#if defined(MK_BARPROBE) && MK_BARPROBE
    const unsigned long long bpt0_ = __builtin_amdgcn_s_memrealtime();
#endif
    asm volatile("s_waitcnt vmcnt(0)" ::: "memory");
    __syncthreads();
    if (threadIdx.x == 0) {
        unsigned* bar = b.bar;
        __builtin_amdgcn_s_waitcnt(0);
        unsigned nloc = b.st[0], nx = b.st[1];
        if (nloc == 0u) { xcd_barrier_complete(bar, b.x, nloc, nx); b.st[0] = nloc; b.st[1] = nx; }
        const unsigned old = xb_add(&bar[XB_XSUB(b.x)], 1u);
        const unsigned gen = old / nloc;
        if (old + 1u == (gen + 1u) * nloc) {
            __builtin_amdgcn_fence(__ATOMIC_RELEASE, "agent");
            asm volatile("s_waitcnt vmcnt(0)" ::: "memory");
            const unsigned og = xb_add(&bar[XB_TOP], 1u);
            const unsigned tg = og / nx;
            if (og + 1u == (tg + 1u) * nx) xb_add(&bar[XB_TOPGEN], 1u);
            else XB_SPIN(xb_ld(&bar[XB_TOPGEN]) == tg, bar);
            __builtin_amdgcn_fence(__ATOMIC_ACQUIRE, "agent");
            xb_add(&bar[XB_XGEN(b.x)], 1u);
            asm volatile("s_waitcnt vmcnt(0)" ::: "memory");
        } else {
            XB_SPIN(xb_ld(&bar[XB_XGEN(b.x)]) == gen, bar);
            __builtin_amdgcn_fence(__ATOMIC_ACQUIRE, "agent");
            asm volatile("s_waitcnt vmcnt(0)" ::: "memory");
        }
#if defined(MK_BARPROBE) && MK_BARPROBE
        if (b.st[33] && BARPROBE_BLK(blockIdx.x)) __hip_atomic_fetch_add((GAS unsigned long long*)(bar + 3600), __builtin_amdgcn_s_memrealtime() - bpt0_, __ATOMIC_RELAXED, __HIP_MEMORY_SCOPE_AGENT);
#endif
    }
    __syncthreads();
}
struct Frame {
    LAS unsigned char* lds; char* ldsg;
    volatile LAS unsigned* MISC;
    int tid, lane, wave, vcu, G, bid;
    const GAS float* const __attribute__((address_space(4)))* inp;
    GAS float* outg; GAS unsigned char* wsg;
    __device__ __forceinline__ const float* in(int i) const { return (const float*)inp[i]; }
};
enum { IN_X = 0, IN_C, IN_MODW, IN_MODB, IN_MIXG, IN_FFNG, IN_AWIN, IN_ABF, IN_AWO, IN_GWIN, IN_GVG, IN_GWS, IN_GBS, IN_GWO, IN_FWIN, IN_FCW, IN_FCB, IN_FWOUT, IN_FING };
enum { MW_BID = 16, MW_G, MW_VCU, MW_INP, MW_INP_HI, MW_WS, MW_WS_HI, MW_OUT, MW_OUT_HI };
__device__ __forceinline__ unsigned misc_rd(const Frame& F, int k) { return (unsigned)__builtin_amdgcn_readfirstlane((int)F.MISC[k]); }
__device__ __forceinline__ bool relaunder(Frame& F) {
    int t = (int)threadIdx.x; asm volatile("" : "+v"(t)); F.tid = t; F.lane = t & 63; F.wave = __builtin_amdgcn_readfirstlane(t >> 6);
    F.bid = (int)misc_rd(F, MW_BID); F.G = (int)misc_rd(F, MW_G); F.vcu = (int)misc_rd(F, MW_VCU);
    F.inp = (const GAS float* const __attribute__((address_space(4)))*)(((unsigned long long)misc_rd(F, MW_INP_HI) << 32) | misc_rd(F, MW_INP));
    F.wsg = (GAS unsigned char*)(((unsigned long long)misc_rd(F, MW_WS_HI) << 32) | misc_rd(F, MW_WS));
    F.outg = (GAS float*)(((unsigned long long)misc_rd(F, MW_OUT_HI) << 32) | misc_rd(F, MW_OUT));
    return true; }
__device__ __forceinline__ void stagger(const Frame& F, unsigned ticks) {
    if (ticks && ((F.bid >> 3) & 1)) { const unsigned long long t0 = __builtin_amdgcn_s_memrealtime(); while (__builtin_amdgcn_s_memrealtime() - t0 < ticks) __builtin_amdgcn_s_sleep(16); }
}
__device__ __forceinline__ float wave_sum(float v) {
#pragma unroll
    for (int o = 1; o < 64; o <<= 1) v += __shfl_xor(v, o);
    return v;
}
__device__ __forceinline__ void transpose_item(const float* W, int ldw, int K, bf16* WT, int k0, int n0, int dst_row0, int ncols, LAS float* scr, int lane) {
    const int nl = lane & 31;
    if (ncols == 32) {
        const int n4 = (lane & 7) * 4, kr = lane >> 3; f32x4 t[8];
#pragma unroll
        for (int i = 0; i < 8; ++i) t[i] = *(const GAS f32x4*)(W + (size_t)(k0 + 8 * i + kr) * ldw + n0 + n4);
#pragma unroll
        for (int i = 0; i < 8; ++i) { LAS float* d = scr + (8 * i + kr) * 33 + n4; d[0] = t[i].x; d[1] = t[i].y; d[2] = t[i].z; d[3] = t[i].w; }
    } else {
#pragma unroll 8
        for (int i = 0; i < 32; ++i) { const int kk = 2 * i + (lane >> 5); if (nl < ncols) scr[kk * 33 + nl] = W[(size_t)(k0 + kk) * ldw + n0 + nl]; } }
    LDS_WAIT(); asm volatile("" ::: "memory");
    const int c = lane & 7;
#pragma unroll
    for (int j = 0; j < 4; ++j) { const int n = (lane >> 3) + 8 * j; const LAS float* s = scr + (8 * c) * 33 + n;
        if (n < ncols) { v4u o; o.x = pk2(s[0 * 33], s[1 * 33]); o.y = pk2(s[2 * 33], s[3 * 33]); o.z = pk2(s[4 * 33], s[5 * 33]); o.w = pk2(s[6 * 33], s[7 * 33]);
            *(GAS v4u*)(WT + (size_t)(dst_row0 + n) * K + k0 + 8 * c) = o; } }
    LDS_WAIT(); asm volatile("" ::: "memory");
}
__device__ __forceinline__ void pro_a_phase(Frame& F) {
    __syncthreads();
    {
        LAS float* cact = (LAS float*)(F.lds + RING_OFF);
        LAS float* red = (LAS float*)(F.lds + RING_OFF + 65536);
        float* mod = (float*)((unsigned char*)F.wsg + WS_MOD); float* sht = (float*)((unsigned char*)F.wsg + WS_SHT);
        for (int item = F.bid; item < 192; item += F.G) {
            for (int idx = F.tid; idx < NBATCH * DM; idx += NWAVES * 64) { const int b = idx >> 11, k = idx & 2047; const float v = F.in(IN_C)[idx]; cact[k * 8 + b] = v / (1.0f + __expf(-v)); }
            __syncthreads();
            const int i = item / 48, nbase = (item % 48) * 256;
            const float* wp = F.in(IN_MODW) + ((size_t)i * DM + F.wave * 256) * 12288 + nbase + F.lane * 4;
            f32x4 acc[8];
#pragma unroll
            for (int b = 0; b < 8; ++b) acc[b] = (f32x4){0.f, 0.f, 0.f, 0.f};
#pragma unroll 8
            for (int kk = 0; kk < 256; ++kk) {
                const f32x4 w = *(const GAS f32x4*)(wp + (size_t)kk * 12288);
                const LAS f32x4* cp = (const LAS f32x4*)(cact + (F.wave * 256 + kk) * 8);
                const f32x4 c0 = cp[0], c1 = cp[1];
                acc[0] += w * c0.x; acc[1] += w * c0.y; acc[2] += w * c0.z; acc[3] += w * c0.w;
                acc[4] += w * c1.x; acc[5] += w * c1.y; acc[6] += w * c1.z; acc[7] += w * c1.w;
            }
#pragma unroll
            for (int b = 0; b < 8; ++b) *(LAS f32x4*)(red + (F.wave * 8 + b) * 256 + F.lane * 4) = acc[b];
            __syncthreads();
            for (int o = F.tid; o < 2048; o += NWAVES * 64) { const int b = o >> 8, col = o & 255, gc = nbase + col; float s = 0.f;
#pragma unroll
                for (int w = 0; w < 8; ++w) s += red[(w * 8 + b) * 256 + col];
                s += F.in(IN_MODB)[i * 12288 + gc];
                mod[((size_t)i * 8 + b) * 12288 + gc] = s;
                if (gc < DM) sht[((size_t)(2 * i) * DM + gc) * 8 + b] = s;
                else if (gc >= 3 * DM && gc < 4 * DM) sht[((size_t)(2 * i + 1) * DM + (gc - 3 * DM)) * 8 + b] = s; }
            __syncthreads();
        }
    }
    LAS float* scr = (LAS float*)(F.lds + RING_OFF + F.wave * 16384);
    const int gw = F.vcu * NWAVES + F.wave, NGW = F.G * NWAVES;
    constexpr int I_O = 32 * 64, I_GO = 32 * 64, I_F2 = 86 * 64;
    constexpr int NITEMS = 2 * (I_O + I_GO) + 4 * I_F2;
    bf16* Wo = (bf16*)((unsigned char*)F.wsg + WS_WO); bf16* Wgo = (bf16*)((unsigned char*)F.wsg + WS_WGO); bf16* Wf2 = (bf16*)((unsigned char*)F.wsg + WS_WF2);
    const int nfree = F.G > 192 ? (F.G - 192) * NWAVES : 0, nbusy = F.G * NWAVES - nfree, isfree = F.bid >= 192;
    const int n_free_items = nfree ? (int)((long)NITEMS * MK_PROA_SHARE / 100) : 0;
    const int it0 = isfree ? ((F.bid - 192) * NWAVES + F.wave) : (n_free_items + (F.bid < 192 ? F.bid : 0) * NWAVES + F.wave), its = isfree ? nfree : nbusy, itend = isfree ? n_free_items : NITEMS;
    for (int it = it0; it < itend; it += its) {
        int r = it;
        if (r < 2 * I_O) { const int j = r / I_O, q = r % I_O, kb = q / 64, nb = q % 64;
            transpose_item(F.in(IN_AWO) + (size_t)j * DM * DM, DM, DM, Wo + (size_t)j * DM * DM, 64 * kb, 32 * nb, 32 * nb, 32, scr, F.lane); continue; } r -= 2 * I_O;
        if (r < 2 * I_GO) { const int j = r / I_GO, q = r % I_GO, kb = q / 64, nb = q % 64;
            transpose_item(F.in(IN_GWO) + (size_t)j * DM * DM, DM, DM, Wgo + (size_t)j * DM * DM, 64 * kb, 32 * nb, 32 * nb, 32, scr, F.lane); continue; } r -= 2 * I_GO;
        { const int j = r / I_F2, q = r % I_F2, kb = q / 64, nb = q % 64;
            transpose_item(F.in(IN_FWOUT) + (size_t)j * DFF * DM, DM, DFF, Wf2 + (size_t)j * DM * DFF, 64 * kb, 32 * nb, 32 * nb, 32, scr, F.lane); }
    }
}
__device__ __forceinline__ void strip_item(const float* W, int ldw, bf16* WT, int n0, int dst_row0, int ncols, const float* sht, float* bias, int bpitch, LAS float* scr, int lane) {
    const int nl = lane & 31, bh = lane >> 5, c = lane & 7;
    f32x4 acc = (f32x4){0.f, 0.f, 0.f, 0.f};
    for (int kb = 0; kb < DM / 64; ++kb) { const int k0 = 64 * kb;
        const f32x4 sa = *(const GAS f32x4*)(sht + (size_t)k0 * 8 + lane * 4), sb = *(const GAS f32x4*)(sht + (size_t)k0 * 8 + 256 + lane * 4);
        if (ncols == 32) { const int n4 = (lane & 7) * 4, kr = lane >> 3; f32x4 t[8];
#pragma unroll
            for (int i = 0; i < 8; ++i) t[i] = *(const GAS f32x4*)(W + (size_t)(k0 + 8 * i + kr) * ldw + n0 + n4);
#pragma unroll
            for (int i = 0; i < 8; ++i) { LAS float* d = scr + (8 * i + kr) * 33 + n4; d[0] = t[i].x; d[1] = t[i].y; d[2] = t[i].z; d[3] = t[i].w; }
        } else {
#pragma unroll 8
            for (int i = 0; i < 32; ++i) { const int kk = 2 * i + (lane >> 5); if (nl < ncols) scr[kk * 33 + nl] = W[(size_t)(k0 + kk) * ldw + n0 + nl]; } }
        LDS_WAIT(); asm volatile("" ::: "memory");
#pragma unroll
        for (int j = 0; j < 4; ++j) { const int n = (lane >> 3) + 8 * j; const LAS float* s = scr + (8 * c) * 33 + n;
            if (n < ncols) { v4u o; o.x = pk2(s[0 * 33], s[1 * 33]); o.y = pk2(s[2 * 33], s[3 * 33]); o.z = pk2(s[4 * 33], s[5 * 33]); o.w = pk2(s[6 * 33], s[7 * 33]);
                *(GAS v4u*)(WT + (size_t)(dst_row0 + n) * DM + k0 + 8 * c) = o; } }
        LAS f32x4* sl = (LAS f32x4*)(scr + 64 * 33 + 16);
        sl[lane] = sa; sl[64 + lane] = sb;
        LDS_WAIT(); asm volatile("" ::: "memory");
#pragma unroll 8
        for (int kk = 0; kk < 64; ++kk) acc += sl[kk * 2 + bh] * scr[kk * 33 + nl];
        LDS_WAIT(); asm volatile("" ::: "memory");
    }
    if (nl < ncols) {
#pragma unroll
        for (int e = 0; e < 4; ++e) bias[(size_t)(4 * bh + e) * bpitch + n0 + nl] = acc[e]; }
}
__device__ __forceinline__ void pro_b_phase(Frame& F) {
    LAS float* scr = (LAS float*)(F.lds + RING_OFF + F.wave * 16384);
    const int gw = F.vcu * NWAVES + F.wave, NGW = F.G * NWAVES;
    constexpr int S_QKV = 193, S_GI = 128, S_F1 = 344, NSTRIPS = 2 * (S_QKV + S_GI) + 4 * S_F1;
    const float* sht = (const float*)((unsigned char*)F.wsg + WS_SHT); float* bv = (float*)((unsigned char*)F.wsg + WS_BIASV);
    bf16* Wqkv = (bf16*)((unsigned char*)F.wsg + WS_WQKV); bf16* Wgi = (bf16*)((unsigned char*)F.wsg + WS_WGI); bf16* Wf1 = (bf16*)((unsigned char*)F.wsg + WS_WF1);
    for (int it = gw; it < NSTRIPS; it += NGW) {
        int r = it;
        if (r < 2 * S_QKV) { const int j = r / S_QKV, nb = r % S_QKV;
            strip_item(F.in(IN_AWIN) + (size_t)j * DM * NQKVF, NQKVF, Wqkv + (size_t)j * WQKV_STRIDE, 32 * nb, 32 * nb, nb == 192 ? 16 : 32, sht + (size_t)(4 * j) * DM * 8, bv + BV_QKVF + (size_t)j * 8 * NQKVF, NQKVF, scr, F.lane); continue; } r -= 2 * S_QKV;
        if (r < 2 * S_GI) { const int j = r / S_GI, nb = r % S_GI;
            strip_item(F.in(IN_GWIN) + (size_t)j * DM * 4096, 4096, Wgi + (size_t)j * 4096 * DM, 32 * nb, 32 * nb, 32, sht + (size_t)(4 * j + 2) * DM * 8, bv + BV_GI + (size_t)j * 8 * 4096, 4096, scr, F.lane); continue; } r -= 2 * S_GI;
        { const int i = r / S_F1, nb = r % S_F1, n0 = 32 * nb, isup = n0 >= DFF, cch = n0 - isup * DFF;
            strip_item(F.in(IN_FWIN) + (size_t)i * DM * NFF2, NFF2, Wf1 + (size_t)i * NFF2 * DM, n0, 256 * (cch >> 7) + 128 * isup + (cch & 127), 32, sht + (size_t)(2 * i + 1) * DM * 8, bv + BV_F1 + (size_t)i * 8 * NFF2, NFF2, scr, F.lane); }
    }
}
__device__ __forceinline__ void xg0_phase(Frame& F, const float* xin, const float* g, const float* scale, bf16* XG, bf16* XB, u64* rss) {
    const int gw = F.vcu * NWAVES + F.wave, NGW = F.G * NWAVES;
    for (int rb = gw; rb < MTOK / 16; rb += NGW) {
        const int b = (rb * 16) >> 12;
        f32x4 gs[8];
#pragma unroll
        for (int j = 0; j < 8; ++j) { const int c4 = F.lane + 64 * j; gs[j] = ((const GAS f32x4*)g)[c4] * (((const GAS f32x4*)(scale + (size_t)b * 12288))[c4] + 1.0f); }
        for (int r = 0; r < 16; ++r) { const size_t row = (size_t)rb * 16 + r;
            const GAS f32x4* xr = (const GAS f32x4*)(xin + row * DM) + F.lane;
            f32x4 v[8]; float ss = 0.f;
#pragma unroll
            for (int j = 0; j < 8; ++j) { v[j] = xr[64 * j]; ss += (v[j].x * v[j].x + v[j].y * v[j].y) + (v[j].z * v[j].z + v[j].w * v[j].w); }
            ss = wave_sum(ss); if (F.lane == 0) rss[row] = (u64)(ss * FIXS);
            GAS v2u* o8 = (GAS v2u*)(XG + row * DM) + F.lane; GAS v2u* x8 = (GAS v2u*)(XB + row * DM) + F.lane;
#pragma unroll
            for (int j = 0; j < 8; ++j) { const f32x4 o = v[j] * gs[j]; v2u w; w.x = pk2(o.x, o.y); w.y = pk2(o.z, o.w); o8[64 * j] = w; v2u q; q.x = pk2(v[j].x, v[j].y); q.y = pk2(v[j].z, v[j].w); x8[64 * j] = q; } }
    }
}
__device__ __forceinline__ void normf_phase(Frame& F, float* x, const float* g) {
    const int gw = F.vcu * NWAVES + F.wave, NGW = F.G * NWAVES;
    for (int rb = gw; rb < MTOK / 16; rb += NGW) {
        f32x4 gs[8];
#pragma unroll
        for (int j = 0; j < 8; ++j) gs[j] = ((const GAS f32x4*)g)[F.lane + 64 * j];
        for (int r = 0; r < 16; ++r) { const size_t row = (size_t)rb * 16 + r;
            GAS f32x4* xr = (GAS f32x4*)(x + row * DM) + F.lane;
            f32x4 v[8]; float ss = 0.f;
#pragma unroll
            for (int j = 0; j < 8; ++j) { v[j] = xr[64 * j]; ss += (v[j].x * v[j].x + v[j].y * v[j].y) + (v[j].z * v[j].z + v[j].w * v[j].w); }
            const float rstd = 1.0f / sqrtf(wave_sum(ss) * (1.0f / DM) + EPS);
#pragma unroll
            for (int j = 0; j < 8; ++j) xr[64 * j] = v[j] * rstd * gs[j]; }
    }
}
__device__ __forceinline__ void fg_phase(Frame& F, const bf16* XG, const bf16* Wf, const float* bfv, const u64* rss, const float* biasf  , float* LOGF) {
    const int gw = F.vcu * NWAVES + F.wave, NGW = F.G * NWAVES, fr = F.lane & 15, fq = F.lane >> 4;
    for (int rb = gw; rb < MTOK / 16; rb += NGW) {
        const GAS bf16x8* ap = (const GAS bf16x8*)(XG + ((size_t)rb * 16 + fr) * DM + fq * 8);
        const GAS bf16x8* bp = (const GAS bf16x8*)(Wf + (size_t)fr * DM + fq * 8);
        f32x4 acc = (f32x4){0.f, 0.f, 0.f, 0.f};
#pragma unroll 8
        for (int ks = 0; ks < 64; ++ks) acc = __builtin_amdgcn_mfma_f32_16x16x32_bf16(bp[ks * 4], ap[ks * 4], acc, 0, 0, 0);
        const int b = (rb * 16) >> 12; const float rs = rstd_of(rss[(size_t)rb * 16 + fr]);
        const f32x4 bb = *(const GAS f32x4*)(bfv + 4 * fq) + *(const GAS f32x4*)(biasf + (size_t)b * NQKVF + 4 * fq); f32x4 o;
#pragma unroll
        for (int i = 0; i < 4; ++i) { const float z = acc[i] * rs + bb[i]; o[i] = fminf(z, 0.f) - log1pf(__expf(-fabsf(z))); }
        *(GAS f32x4*)(LOGF + ((size_t)rb * 16 + fr) * 16 + 4 * fq) = o;
    }
}
__device__ __forceinline__ void cum_phase(Frame& F, const float* LOGF, float* FB) {
    LAS float* wt = (LAS float*)(F.lds + RING_OFF);
    for (int bh = F.bid; bh < NBATCH * NHEAD; bh += F.G) { const int b = bh >> 4, h = bh & 15;
        const float* p = LOGF + ((size_t)b * SEQ + F.tid * 8) * 16 + h;
        float v[8]; float s = 0.f;
#pragma unroll
        for (int i = 0; i < 8; ++i) { s += p[i * 16]; v[i] = s; }
        float incl = s;
#pragma unroll
        for (int o = 1; o < 64; o <<= 1) { const float t = __shfl_up(incl, o); if (F.lane >= o) incl += t; }
        if (F.lane == 63) wt[F.wave] = incl;
        __syncthreads();
        float base = incl - s;
        for (int w = 0; w < F.wave; ++w) base += wt[w];
        GAS f32x4* q = (GAS f32x4*)(FB + (size_t)bh * SEQ + F.tid * 8);
        q[0] = (f32x4){-(base + v[0]) * 1.4426950408889634f, -(base + v[1]) * 1.4426950408889634f, -(base + v[2]) * 1.4426950408889634f, -(base + v[3]) * 1.4426950408889634f};
        q[1] = (f32x4){-(base + v[4]) * 1.4426950408889634f, -(base + v[5]) * 1.4426950408889634f, -(base + v[6]) * 1.4426950408889634f, -(base + v[7]) * 1.4426950408889634f};
        __syncthreads();
    }
}
template <int VB>
__device__ __forceinline__ void gate_pv(fox::f32x16* o, int vb0, fox::bf16x8 pa0, fox::bf16x8 pa1, fox::bf16x8 pa2, fox::bf16x8 pa3) {
    using fox::s16x4; using fox::bf16x8;
#define TRRD(dst, off) asm volatile("ds_read_b64_tr_b16 %0, %1 offset:%2" : "=&v"(dst) : "v"(vb0), "i"(off) : "memory")
#define PV_D0(d0) do { s16x4 l0, l1, l2, l3, h0, h1, h2, h3; constexpr int b_ = VB * fox::SHM_V + fox::v_rd_off(d0, 0, 0); \
        TRRD(l0, b_); TRRD(h0, b_ + 2048); TRRD(l1, b_ + 4096); TRRD(h1, b_ + 6144); TRRD(l2, b_ + 8192); TRRD(h2, b_ + 10240); TRRD(l3, b_ + 12288); TRRD(h3, b_ + 14336); \
        asm volatile("s_waitcnt lgkmcnt(0)" ::: "memory"); __builtin_amdgcn_sched_barrier(0); \
        o[d0] = __builtin_amdgcn_mfma_f32_32x32x16_bf16((bf16x8){l0[0], l0[1], l0[2], l0[3], h0[0], h0[1], h0[2], h0[3]}, pa0, o[d0], 0, 0, 0);   \
        o[d0] = __builtin_amdgcn_mfma_f32_32x32x16_bf16((bf16x8){l1[0], l1[1], l1[2], l1[3], h1[0], h1[1], h1[2], h1[3]}, pa1, o[d0], 0, 0, 0);   \
        o[d0] = __builtin_amdgcn_mfma_f32_32x32x16_bf16((bf16x8){l2[0], l2[1], l2[2], l2[3], h2[0], h2[1], h2[2], h2[3]}, pa2, o[d0], 0, 0, 0);   \
        o[d0] = __builtin_amdgcn_mfma_f32_32x32x16_bf16((bf16x8){l3[0], l3[1], l3[2], l3[3], h3[0], h3[1], h3[2], h3[3]}, pa3, o[d0], 0, 0, 0); } while (0)
    PV_D0(0); PV_D0(1); PV_D0(2); PV_D0(3);
#undef PV_D0
#undef TRRD
}
__device__ __forceinline__ void gate_phase(Frame& F, const bf16* Z, const u64* VSS, const float* vg, const float* Ws, const float* bs, bf16* GT) {
    using fox::bf16x8; using fox::f32x16;
    const int r32 = F.lane & 31, hi = F.lane >> 5, c = F.wave >> 2, t0 = 32 * (F.wave & 3);
    const int vb0 = (int)(uintptr_t)(F.ldsg + RING_OFF) + c * 32768 + fox::v_rd_base(F.lane);
    constexpr int NITEM = (MTOK / 256) * 16;
    int item = F.bid; if (item >= NITEM) return;
    bf16x8 aw[8]; int gcur = -1;
    const int srow = F.tid >> 4, c8 = (F.tid & 15) * 8;
    v4u vw[8]; u64 vs[8];
    const unsigned vo_u = (unsigned)((c * 128 + t0 + r32) * 4096 + 8 * hi) * 2u, vo_o = (unsigned)((c * 128 + t0 + r32) * DM + 8 * hi) * 2u;
    const unsigned vo_z = (unsigned)(srow * 4096 + c8) * 2u, vo_s = (unsigned)srow * 8u;
#define GATE_LOADV(it_) do { const int g_ = (it_) & 15; const size_t r_ = (size_t)((it_) >> 4) * 256;                                             \
        _Pragma("unroll") for (int ps = 0; ps < 8; ++ps) vw[ps] = *(const GAS v4u*)((const GAS char*)(Z + (r_ + 32 * ps) * 4096 + 2048 + g_ * 128) + vo_z); } while (0)
#define GATE_LOADS(it_) do { const size_t r_ = (size_t)((it_) >> 4) * 256;                                                                        \
        _Pragma("unroll") for (int ps = 0; ps < 8; ++ps) vs[ps] = *(const GAS u64*)((const GAS char*)(VSS + r_ + 32 * ps) + vo_s); } while (0)
#define GATE_RSTD() do { _Pragma("unroll") for (int ps = 0; ps < 8; ++ps) rs8[ps] = rstd_of(vs[ps]); } while (0)
    float rs8[8];
    GATE_LOADS(item); GATE_LOADV(item); GATE_RSTD();
    for (int i = 0; ; ++i) {
        const int g = item & 15, pnl = item >> 4; const size_t row0 = (size_t)pnl * 256;
        if (g != gcur) { gcur = g;
            const float* wr_ = Ws + ((size_t)g * 128 + t0 + r32) * 128 + 8 * hi;
#pragma unroll
            for (int ks = 0; ks < 8; ++ks) { const f32x4 a = *(const GAS f32x4*)(wr_ + 16 * ks), b = *(const GAS f32x4*)(wr_ + 16 * ks + 4); const int s0 = 16 * ks + 8 * hi; int t = t0 + r32; asm volatile("" : "+v"(t));
                v4u w; w.x = pk2(s0 + 0 <= t ? a.x : 0.f, s0 + 1 <= t ? a.y : 0.f); w.y = pk2(s0 + 2 <= t ? a.z : 0.f, s0 + 3 <= t ? a.w : 0.f);
                       w.z = pk2(s0 + 4 <= t ? b.x : 0.f, s0 + 5 <= t ? b.y : 0.f); w.w = pk2(s0 + 6 <= t ? b.z : 0.f, s0 + 7 <= t ? b.w : 0.f);
                aw[ks] = __builtin_bit_cast(bf16x8, w); } }
        { const f32x4 g0 = *(const GAS f32x4*)(vg + g * 128 + c8), g1 = *(const GAS f32x4*)(vg + g * 128 + c8 + 4);
#pragma unroll
          for (int ps = 0; ps < 8; ++ps) { const int row = srow + 32 * ps, s = row & 127; const v4u w = vw[ps]; const float rs = rs8[ps];
            v4u o; o.x = pk2(bflo(w.x) * rs * g0.x, bfhi(w.x) * rs * g0.y); o.y = pk2(bflo(w.y) * rs * g0.z, bfhi(w.y) * rs * g0.w);
                   o.z = pk2(bflo(w.z) * rs * g1.x, bfhi(w.z) * rs * g1.y); o.w = pk2(bflo(w.w) * rs * g1.z, bfhi(w.w) * rs * g1.w);
            *(LAS v4u*)(F.lds + RING_OFF + (i & 1) * 65536 + ((row >> 7) * 2 + (s >> 6)) * 16384 + fox::v_st(s & 63, c8)) = o; } }
        const int nxt = item + F.G; const bool more = nxt < NITEM;
        if (more) GATE_LOADS(nxt);
        v4u uq[8];
        { const GAS v4u* up = (const GAS v4u*)((const GAS char*)(Z + row0 * 4096 + g * 128) + vo_u);
#pragma unroll
          for (int j = 0; j < 8; ++j) uq[j] = up[j * 2]; }
        const float bias = bs[g * 128 + t0 + r32];
        if (more) GATE_LOADV(nxt);
        LDS_WAIT(); asm volatile("" ::: "memory"); __builtin_amdgcn_s_barrier(); asm volatile("" ::: "memory");
        if (more) GATE_RSTD();
        { const int vbi = vb0 + (i & 1) * 65536; GAS v4u* op = (GAS v4u*)((GAS char*)(GT + row0 * DM + g * 128) + vo_o);
          using fox::s16x4;
#define G_TRRD(dst, off) asm volatile("ds_read_b64_tr_b16 %0, %1 offset:%2" : "=&v"(dst) : "v"(vbi), "i"(off) : "memory")
#define G_LD(R, tile, d0) do { constexpr int b_ = (tile) * 16384 + fox::v_rd_off(d0, 0, 0); G_TRRD(R##0, b_); G_TRRD(R##1, b_ + 2048); G_TRRD(R##2, b_ + 4096); G_TRRD(R##3, b_ + 6144); G_TRRD(R##4, b_ + 8192); G_TRRD(R##5, b_ + 10240); G_TRRD(R##6, b_ + 12288); G_TRRD(R##7, b_ + 14336); } while (0)
#define G_J(l, h) ((bf16x8){l[0], l[1], l[2], l[3], h[0], h[1], h[2], h[3]})
#define G_MM(R, A) do { acc = __builtin_amdgcn_mfma_f32_32x32x16_bf16(G_J(R##0, R##1), aw[(A) + 0], acc, 0, 0, 0); acc = __builtin_amdgcn_mfma_f32_32x32x16_bf16(G_J(R##2, R##3), aw[(A) + 1], acc, 0, 0, 0); \
        acc = __builtin_amdgcn_mfma_f32_32x32x16_bf16(G_J(R##4, R##5), aw[(A) + 2], acc, 0, 0, 0); acc = __builtin_amdgcn_mfma_f32_32x32x16_bf16(G_J(R##6, R##7), aw[(A) + 3], acc, 0, 0, 0); } while (0)
#define G_W(n, R) asm volatile("s_waitcnt lgkmcnt(" #n ")" : "+v"(R##0), "+v"(R##1), "+v"(R##2), "+v"(R##3), "+v"(R##4), "+v"(R##5), "+v"(R##6), "+v"(R##7) :: "memory")
#define G_EPI(d0) do { _Pragma("unroll") for (int hf = 0; hf < 2; ++hf) { const v4u uw = uq[(d0) * 2 + hf];                                                                                          \
                auto s0 = __builtin_amdgcn_permlane32_swap(uw.x, uw.z, false, false); auto s1 = __builtin_amdgcn_permlane32_swap(uw.y, uw.w, false, false);     \
                const int j0 = 8 * hf;                                                                                                                                                            \
                const float v0 = bflo(s0[0]) * (acc[j0 + 0] + bias), v1 = bfhi(s0[0]) * (acc[j0 + 1] + bias), v2 = bflo(s1[0]) * (acc[j0 + 2] + bias), v3 = bfhi(s1[0]) * (acc[j0 + 3] + bias);      \
                const float v4 = bflo(s0[1]) * (acc[j0 + 4] + bias), v5 = bfhi(s0[1]) * (acc[j0 + 5] + bias), v6 = bflo(s1[1]) * (acc[j0 + 6] + bias), v7 = bfhi(s1[1]) * (acc[j0 + 7] + bias);      \
                const unsigned a0 = fox::cvtpk(v0, v1), a1 = fox::cvtpk(v2, v3), b0 = fox::cvtpk(v4, v5), b1 = fox::cvtpk(v6, v7);                                                                 \
                auto r0 = __builtin_amdgcn_permlane32_swap(a0, b0, false, false); auto r1 = __builtin_amdgcn_permlane32_swap(a1, b1, false, false);                                                \
                v4u w; w.x = r0[0]; w.y = r1[0]; w.z = r0[1]; w.w = r1[1];                                                                                                                         \
                op[(d0) * 4 + hf * 2] = w; } } while (0)
          s16x4 fa0, fa1, fa2, fa3, fa4, fa5, fa6, fa7, fb0, fb1, fb2, fb3, fb4, fb5, fb6, fb7; f32x16 acc;
          if (t0 >= 64) {
              G_LD(fa, 0, 0); G_LD(fb, 1, 0);
              G_W(8, fa); acc = (f32x16){}; G_MM(fa, 0); G_LD(fa, 0, 1); G_W(8, fb); G_MM(fb, 4); G_LD(fb, 1, 1); G_EPI(0);
              G_W(8, fa); acc = (f32x16){}; G_MM(fa, 0); G_LD(fa, 0, 2); G_W(8, fb); G_MM(fb, 4); G_LD(fb, 1, 2); G_EPI(1);
              G_W(8, fa); acc = (f32x16){}; G_MM(fa, 0); G_LD(fa, 0, 3); G_W(8, fb); G_MM(fb, 4); G_LD(fb, 1, 3); G_EPI(2);
              G_W(8, fa); acc = (f32x16){}; G_MM(fa, 0); G_W(0, fb); G_MM(fb, 4); G_EPI(3);
          } else {
              G_LD(fa, 0, 0); G_LD(fb, 0, 1);
              G_W(8, fa); acc = (f32x16){}; G_MM(fa, 0); G_LD(fa, 0, 2); G_EPI(0);
              G_W(8, fb); acc = (f32x16){}; G_MM(fb, 0); G_LD(fb, 0, 3); G_EPI(1);
              G_W(8, fa); acc = (f32x16){}; G_MM(fa, 0); G_EPI(2);
              G_W(0, fb); acc = (f32x16){}; G_MM(fb, 0); G_EPI(3);
          }
#undef G_EPI
#undef G_W
#undef G_MM
#undef G_J
#undef G_LD
#undef G_TRRD
        }
        if (!more) break;
        item = nxt;
    }
#undef GATE_RSTD
#undef GATE_LOADS
#undef GATE_LOADV
    __syncthreads();
}
__device__ __forceinline__ float silu1(float v) { return v * __builtin_amdgcn_rcpf(1.0f + __builtin_amdgcn_exp2f(v * -1.4426950408889634f)); }
__device__ __forceinline__ void fix_phase(Frame& F, const float* HALO, const float* cw, const float* cb, bf16* ACT, int pm_lo, int pm_n) {
    constexpr int C4 = DFF / 4;
    for (int item = F.bid * (NWAVES * 64) + F.tid; item < pm_n * C4; item += F.G * NWAVES * 64) {
        const int pm = pm_lo + item / C4, c4 = (item % C4) * 4; if ((pm & 15) == 0) continue;
        f32x4 r0[2], r1[2];
#pragma unroll
        for (int part = 0; part < 2; ++part) { const int col = part * DFF + c4;
            const f32x4 am2 = *(const GAS f32x4*)(HALO + ((size_t)(pm - 1) * 4 + 2) * NFF2 + col), am1 = *(const GAS f32x4*)(HALO + ((size_t)(pm - 1) * 4 + 3) * NFF2 + col);
            const f32x4 a0 = *(const GAS f32x4*)(HALO + ((size_t)pm * 4 + 0) * NFF2 + col), a1 = *(const GAS f32x4*)(HALO + ((size_t)pm * 4 + 1) * NFF2 + col);
            const f32x4 w0 = *(const GAS f32x4*)(cw + col), w1 = *(const GAS f32x4*)(cw + NFF2 + col), w2 = *(const GAS f32x4*)(cw + 2 * NFF2 + col), b = *(const GAS f32x4*)(cb + col);
            r0[part] = b + w0 * am2 + w1 * am1 + w2 * a0; r1[part] = b + w0 * am1 + w1 * a0 + w2 * a1; }
        v2u o0, o1;
        o0.x = pk2(silu1(r0[0].x) * r0[1].x, silu1(r0[0].y) * r0[1].y); o0.y = pk2(silu1(r0[0].z) * r0[1].z, silu1(r0[0].w) * r0[1].w);
        o1.x = pk2(silu1(r1[0].x) * r1[1].x, silu1(r1[0].y) * r1[1].y); o1.y = pk2(silu1(r1[0].z) * r1[1].z, silu1(r1[0].w) * r1[1].w);
        *(GAS v2u*)(ACT + ((size_t)pm * 256) * DFF + c4) = o0; *(GAS v2u*)(ACT + ((size_t)pm * 256 + 1) * DFF + c4) = o1;
    }
}
constexpr int NPHASE = 96;
struct Args { const float* in[19]; float* out; unsigned char* ws; int ph_lo, ph_hi; };
static_assert(sizeof(Args) == 19 * 8 + 8 + 8 + 8, "Args has no padding bytes");
#ifndef MK_EN
#define MK_EN 0xffffffffu
#endif
#define EN(k) (((MK_EN) >> (k)) & 1u)
#ifndef MK_BARPROBE
#define MK_BARPROBE 0
#endif
#ifndef MK_BARSEL
#define MK_BARSEL 0
#endif
#define BARSEL(ph) (MK_BARSEL == 0 ? true : MK_BARSEL == 1 ? ((ph) < 2) : MK_BARSEL == 2 ? ((ph) == 2 || (ph) == 15) : MK_BARSEL == 3 ? ((ph) == 3 || (ph) == 16) : MK_BARSEL == 4 ? ((ph) == 4 || (ph) == 17) : MK_BARSEL == 5 ? ((ph) == 5 || (ph) == 18 || (ph) == 11 || (ph) == 24) : \
    MK_BARSEL == 6 ? ((ph) == 6 || (ph) == 19 || (ph) == 12 || (ph) == 25) : MK_BARSEL == 7 ? ((ph) == 7 || (ph) == 20 || (ph) == 13 || (ph) == 26) : MK_BARSEL == 8 ? ((ph) == 8 || (ph) == 21 || (ph) == 14 || (ph) == 27) : MK_BARSEL == 9 ? ((ph) == 9 || (ph) == 22) : MK_BARSEL == 10 ? ((ph) == 10 || (ph) == 23) : false)
#if MK_BARPROBE
#define BARPROBE_T0() const unsigned long long bpt0_ = __builtin_amdgcn_s_memrealtime()
#define BARPROBE_T1() do { if (threadIdx.x == 0 && ph + 2 < hi) __hip_atomic_fetch_add((unsigned long long*)((unsigned char*)F.wsg + WS_CTL + 512 * 1024), __builtin_amdgcn_s_memrealtime() - bpt0_, __ATOMIC_RELAXED, __HIP_MEMORY_SCOPE_AGENT); } while (0)
#else
#define BARPROBE_T0() do {} while (0)
#define BARPROBE_T1() do {} while (0)
#endif
#ifndef MK_TPSITE
#define MK_TPSITE 1
#endif
#ifndef MK_TPROBE
#define MK_TPROBE 0
#endif
#ifndef MK_CLKPROBE
#define MK_CLKPROBE 0
#endif
#ifndef MK_FUSEFIN
#define MK_FUSEFIN 0
#endif
#ifndef MK_FFN_SPLIT
#define MK_FFN_SPLIT 1
#endif
#ifndef MK_PAD
#define MK_PAD 0
#endif
#define MK_STR2(x) #x
#define MK_STR(x) MK_STR2(x)
#define MK_PAD_STR MK_STR(MK_PAD)
#ifndef MK_DYNTAIL
#define MK_DYNTAIL 0
#endif
#ifndef MK_ALIGN
#define MK_ALIGN true
#endif
#ifndef MK_STAG_F1
#define MK_STAG_F1 0
#endif
#ifndef MK_REPBAR
#define MK_REPBAR 0
#endif
#ifndef MK_SP2
#define MK_SP2 true
#endif
#ifndef MK_BAR2
#define MK_BAR2 0
#endif
#ifndef MK_KREP
#define MK_KREP 1
#endif
#ifndef MK_REP
#define MK_REP 0u
#endif
#define REPN(k) ((((MK_REP) >> (k)) & 1u) ? 2 : 1)
#define W_MOD   ((float*)((unsigned char*)F.wsg + WS_MOD))
#define W_H     ((bf16*)((unsigned char*)F.wsg + WS_H))
#define W_Q     ((bf16*)((unsigned char*)F.wsg + WS_R))
#define W_K     ((bf16*)((unsigned char*)F.wsg + WS_R + 128 * MiB))
#define W_V     ((bf16*)((unsigned char*)F.wsg + WS_R + 256 * MiB))
#define W_Z     ((bf16*)((unsigned char*)F.wsg + WS_R))
#define W_ACT   ((bf16*)((unsigned char*)F.wsg + WS_R))
#define W_HALO  ((float*)((unsigned char*)F.wsg + WS_R + 344 * MiB))
#define W_LOGF  ((float*)((unsigned char*)F.wsg + WS_LOGF))
#define W_FB    ((float*)((unsigned char*)F.wsg + WS_FB))
#define W_VSS(n) ((u64*)((unsigned char*)F.wsg + WS_VSS) + (size_t)(n) * MTOK)
#define W_XB    ((bf16*)((unsigned char*)F.wsg + WS_XB))
#define W_H2    ((bf16*)((unsigned char*)F.wsg + WS_H2))
#define W_RSS(n) ((u64*)((unsigned char*)F.wsg + WS_RSS) + (size_t)(n) * MTOK)
#define W_BIASV ((float*)((unsigned char*)F.wsg + WS_BIASV))
#define W_MODI  (W_MOD + (size_t)i * 8 * 12288)
#define XOUT_(k) ((REPN(k) == 2 && rep_ == 0) ? W_H : W_XB)
#define XG_(k, p) ((REPN(k) == 2 && rep_ == 0) ? (bf16*)nullptr : (p))
__global__ void __launch_bounds__(NWAVES * 64, 2) mega_fwd(Args args) {
    extern __shared__ __attribute__((aligned(16))) unsigned char lds[];
    Frame F;
#if MK_PAD > 0
    asm volatile(".rept " MK_PAD_STR "\n\ts_nop 0\n\t.endr" ::: "memory");
#endif
    F.lds = (LAS unsigned char*)lds; F.ldsg = (char*)lds;
    F.MISC = (volatile LAS unsigned*)(F.lds + MISC_OFF);
    for (int u = threadIdx.x; u < (LDS_BYTES - LDSCTL_OFF) / 4; u += NWAVES * 64) ((LAS unsigned*)(F.lds + LDSCTL_OFF))[u] = 0u;
    __syncthreads();
    if (threadIdx.x == 0) {
        const int G = gridDim.x, bx = blockIdx.x; const unsigned long long kp = (unsigned long long)__builtin_amdgcn_kernarg_segment_ptr(), wp = (unsigned long long)args.ws, op = (unsigned long long)args.out;
        F.MISC[MW_BID] = (unsigned)bx; F.MISC[MW_G] = (unsigned)G; F.MISC[MW_VCU] = (unsigned)((G % 8 == 0) ? (bx % 8) * (G / 8) + bx / 8 : bx);
        F.MISC[MW_INP] = (unsigned)kp; F.MISC[MW_INP_HI] = (unsigned)(kp >> 32); F.MISC[MW_WS] = (unsigned)wp; F.MISC[MW_WS_HI] = (unsigned)(wp >> 32); F.MISC[MW_OUT] = (unsigned)op; F.MISC[MW_OUT_HI] = (unsigned)(op >> 32);
    }
    __syncthreads();
    XcdBarrier bar; bar.bar = (unsigned*)(args.ws + WS_CTL) + CW_BAR; bar.x = 0; bar.st = nullptr;
    if (!MK_PER_PHASE) bar = xcd_barrier_post((unsigned*)(args.ws + WS_CTL) + CW_BAR, F.MISC + 8);
    const int lo = args.ph_lo, hi = args.ph_hi;
    int ph = 0;
#define REPBAR(k) ((MK_REPBAR && rep_ < REPN(k)) ? (relaunder(F), bar.bar = (unsigned*)((unsigned char*)F.wsg + WS_CTL) + CW_BAR, xcd_barrier(bar), 0) : 0)
#define RUN() (lo <= ph && ph < hi && relaunder(F))
#define SEAM() do { if (!MK_PER_PHASE) { if (lo <= ph && ph + 1 < hi) { relaunder(F); bar.bar = (unsigned*)((unsigned char*)F.wsg + WS_CTL) + CW_BAR; asm volatile("" : "+s"(bar.x)); if (MK_BARPROBE && threadIdx.x == 0) F.MISC[41] = BARSEL(ph) ? 1u : 0u; xcd_barrier(bar); if (MK_BAR2) xcd_barrier(bar); } } ++ph; } while (0)

    if (EN(0) && RUN()) for (int rep_ = 0; rep_ < REPN(0); ++rep_, REPBAR(0)) pro_a_phase(F);
    SEAM();
    if (EN(1) && RUN()) for (int rep_ = 0; rep_ < REPN(1); ++rep_, REPBAR(1)) { pro_b_phase(F); xg0_phase(F, F.in(IN_X), F.in(IN_MIXG), W_MOD + DM, W_H, W_XB, W_RSS(0)); }
    SEAM();
    for (int i = 0; i < DEPTH; ++i) {
        const int j = i >> 1;
        if ((i & 1) == 0) {
            if (EN(3) && RUN()) for (int rep_ = 0; rep_ < REPN(3); ++rep_, REPBAR(3)) {
                const bf16* wq = (const bf16*)((unsigned char*)F.wsg + WS_WQKV) + (size_t)j * WQKV_STRIDE; const float* bvq = W_BIASV + BV_QKVF + (size_t)j * 8 * NQKVF;
                fg_phase(F, W_H, wq + (size_t)6144 * DM, F.in(IN_ABF) + j * 16, W_RSS(2 * i), bvq + 6144, W_LOGF);
                pg8::Gemm g{W_H, wq, MTOK, 6144, DM}; pg8::StaticOrder S; S.init(MTOK, 6144, F.G, F.bid);
                pg8::EpiQKV E{W_Q, (size_t)(64 * MiB), fox::QSCALE, pg8::RowAffine{W_RSS(2 * i), bvq, NQKVF, (LAS float*)(F.lds + XCH_OFF + 8192)}};
                pg8::gemm_phase<pg8::EpiQKV, pg8::StaticOrder, MK_ALIGN, MK_SP2>(F.lds + RING_OFF, g, S, E);
            }
            SEAM();
            if (EN(4) && RUN()) for (int rep_ = 0; rep_ < REPN(4); ++rep_, REPBAR(4)) cum_phase(F, W_LOGF, W_FB);
            SEAM();
            if (EN(5) && RUN()) for (int rep_ = 0; rep_ < REPN(5); ++rep_, REPBAR(5)) fox::att_phase(F.ldsg + RING_OFF, (const fox::bf16*)W_Q, (const fox::bf16*)W_K, (const fox::bf16*)W_V, (fox::bf16*)W_H, W_FB, F.bid, F.G);
            SEAM();
            if (EN(6) && RUN()) for (int rep_ = 0; rep_ < REPN(6); ++rep_, REPBAR(6)) {
                pg8::Gemm g{W_H, (const bf16*)((unsigned char*)F.wsg + WS_WO) + (size_t)j * DM * DM, MTOK, DM, DM}; pg8::StaticOrder S; S.init(MTOK, DM, F.G, F.bid);
                pg8::EpiRes E{XOUT_(6), W_MODI + 2 * DM, 12288, XG_(6, W_H2), F.in(IN_FFNG) + i * DM, W_MODI + 4 * DM, W_RSS(2 * i + 1), (LAS float*)(F.lds + XCH_OFF), (float*)nullptr};
                pg8::gemm_phase<pg8::EpiRes, pg8::StaticOrder, MK_ALIGN, MK_SP2>(F.lds + RING_OFF, g, S, E);
            }
            SEAM();
        } else {
            if (EN(7) && RUN()) for (int rep_ = 0; rep_ < REPN(7); ++rep_, REPBAR(7)) {
                pg8::Gemm g{W_H, (const bf16*)((unsigned char*)F.wsg + WS_WGI) + (size_t)j * 4096 * DM, MTOK, 4096, DM}; pg8::StaticOrder S; S.init(MTOK, 4096, F.G, F.bid);
                pg8::EpiStore<1> E{W_Z, 4096, pg8::RowAffine{W_RSS(2 * i), W_BIASV + BV_GI + (size_t)j * 8 * 4096, 4096, (LAS float*)(F.lds + XCH_OFF + 8192)}, W_VSS(j)};
                pg8::gemm_phase<pg8::EpiStore<1>, pg8::StaticOrder, MK_ALIGN, MK_SP2>(F.lds + RING_OFF, g, S, E);
            }
            SEAM();
            if (EN(9) && RUN()) for (int rep_ = 0; rep_ < REPN(9); ++rep_, REPBAR(9)) gate_phase(F, W_Z, W_VSS(j), F.in(IN_GVG) + j * DM, F.in(IN_GWS) + (size_t)j * 16 * 128 * 128, F.in(IN_GBS) + j * 16 * 128, W_H);
            SEAM();
            if (EN(10) && RUN()) for (int rep_ = 0; rep_ < REPN(10); ++rep_, REPBAR(10)) {
                pg8::Gemm g{W_H, (const bf16*)((unsigned char*)F.wsg + WS_WGO) + (size_t)j * DM * DM, MTOK, DM, DM}; pg8::StaticOrder S; S.init(MTOK, DM, F.G, F.bid);
                pg8::EpiRes E{XOUT_(10), W_MODI + 2 * DM, 12288, XG_(10, W_H2), F.in(IN_FFNG) + i * DM, W_MODI + 4 * DM, W_RSS(2 * i + 1), (LAS float*)(F.lds + XCH_OFF), (float*)nullptr};
                pg8::gemm_phase<pg8::EpiRes, pg8::StaticOrder, MK_ALIGN, MK_SP2>(F.lds + RING_OFF, g, S, E);
            }
            SEAM();
        }
        for (int hf_ = 0; hf_ < MK_FFN_SPLIT; ++hf_) {
        const int pmn_ = (MTOK / 256) / MK_FFN_SPLIT, pm0_ = hf_ * pmn_;
        if (EN(11) && RUN()) for (int rep_ = 0; rep_ < REPN(11); ++rep_, REPBAR(11)) {
            stagger(F, MK_STAG_F1);
#if MK_CLKPROBE
            unsigned long long pc0_ = 0, pr0_ = 0; if (i == 0 && F.bid == 0) { pc0_ = __builtin_amdgcn_s_memtime(); pr0_ = __builtin_amdgcn_s_memrealtime(); }
#endif
            pg8::Gemm g{W_H2, (const bf16*)((unsigned char*)F.wsg + WS_WF1) + (size_t)i * NFF2 * DM, MTOK, NFF2, DM}; pg8::StaticOrder S; S.init(MTOK / MK_FFN_SPLIT, NFF2, F.G, F.bid); S.pm_off = pm0_;
            pg8::EpiConv E{W_ACT, F.in(IN_FCW) + (size_t)i * 3 * NFF2, F.in(IN_FCB) + (size_t)i * NFF2, W_HALO, (LAS float*)(F.lds + XCH_OFF), pg8::RowAffine{W_RSS(2 * i + 1), W_BIASV + BV_F1 + (size_t)i * 8 * NFF2, NFF2, (LAS float*)(F.lds + XCH_OFF + 8192)}, (LAS float*)(F.lds + CWT_OFF)};
#if MK_TPROBE && MK_TPSITE == 1
            { unsigned long long tpv_ = 0; pg8::gemm_phase<pg8::EpiConv, pg8::StaticOrder, true, MK_SP2, MK_KREP, MK_TPROBE>(F.lds + RING_OFF, g, S, E, &tpv_);
              if (i == 0 && F.bid == 0 && threadIdx.x == 0) F.MISC[40] = (unsigned)(tpv_ * 10ull); }
#elif MK_DYNTAIL
            { pg8::TailClaimOrder T; T.init(MTOK, NFF2, F.G, F.bid); T.init_tail((unsigned*)((unsigned char*)F.wsg + WS_CTL + 768 * 1024) + i * 8 * 64, (volatile LAS unsigned*)(F.MISC + 42));
              pg8::gemm_phase<pg8::EpiConv, pg8::TailClaimOrder, true, MK_SP2, MK_KREP>(F.lds + RING_OFF, g, T, E); }
#else
            pg8::gemm_phase<pg8::EpiConv, pg8::StaticOrder, true, MK_SP2, MK_KREP>(F.lds + RING_OFF, g, S, E);
#endif
#if MK_CLKPROBE
            if (i == 0 && F.bid == 0) { const unsigned long long dc_ = __builtin_amdgcn_s_memtime() - pc0_, dr_ = __builtin_amdgcn_s_memrealtime() - pr0_;
                if (threadIdx.x == 0) { F.MISC[40] = (unsigned)(dc_ * 5000ull / (dr_ ? dr_ : 1ull)); } }
#endif
        }
        SEAM();
        if (EN(12) && RUN()) for (int rep_ = 0; rep_ < REPN(12); ++rep_, REPBAR(12)) fix_phase(F, W_HALO, F.in(IN_FCW) + (size_t)i * 3 * NFF2, F.in(IN_FCB) + (size_t)i * NFF2, W_ACT, pm0_, pmn_);
        SEAM();
        if (EN(13) && RUN()) for (int rep_ = 0; rep_ < REPN(13); ++rep_, REPBAR(13)) {
            pg8::Gemm g{W_ACT, (const bf16*)((unsigned char*)F.wsg + WS_WF2) + (size_t)i * DM * DFF, MTOK, DM, DFF}; pg8::StaticOrder S; S.init(MTOK / MK_FFN_SPLIT, DM, F.G, F.bid); S.pm_off = pm0_;
            const int in_ = i < DEPTH - 1 ? i + 1 : i;
#if MK_FUSEFIN
            pg8::EpiResF E{{XOUT_(13), W_MODI + 5 * DM, 12288, XG_(13, i < DEPTH - 1 ? W_H : (bf16*)nullptr), F.in(IN_MIXG) + in_ * DM, W_MOD + (size_t)in_ * 8 * 12288 + DM, W_RSS(2 * in_), (LAS float*)(F.lds + XCH_OFF), (float*)nullptr},
                i < DEPTH - 1 ? (float*)nullptr : (float*)F.outg, F.in(IN_FING), (u64*)((unsigned char*)F.wsg + WS_RSSF), (unsigned*)((unsigned char*)F.wsg + WS_PCNT)};
#else
            pg8::EpiRes E{XOUT_(13), W_MODI + 5 * DM, 12288, XG_(13, i < DEPTH - 1 ? W_H : (bf16*)nullptr), F.in(IN_MIXG) + in_ * DM, W_MOD + (size_t)in_ * 8 * 12288 + DM, W_RSS(2 * in_), (LAS float*)(F.lds + XCH_OFF), i < DEPTH - 1 ? (float*)nullptr : (float*)F.outg};
#endif
#if MK_TPROBE && MK_TPSITE == 2
            { unsigned long long tpv_ = 0; pg8::gemm_phase<pg8::EpiRes, pg8::StaticOrder, MK_ALIGN, MK_SP2, 1, MK_TPROBE>(F.lds + RING_OFF, g, S, E, &tpv_);
              if (i == 0 && F.bid == 0 && threadIdx.x == 0) F.MISC[40] = (unsigned)(tpv_ * 10ull); }
#else
#if MK_FUSEFIN
            pg8::gemm_phase<pg8::EpiResF, pg8::StaticOrder, MK_ALIGN, MK_SP2>(F.lds + RING_OFF, g, S, E);
#else
            pg8::gemm_phase<pg8::EpiRes, pg8::StaticOrder, MK_ALIGN, MK_SP2>(F.lds + RING_OFF, g, S, E);
#endif
#endif
        }
        if (MK_FUSEFIN && i == DEPTH - 1) ++ph; else SEAM();
        }
    }
#if MK_BARPROBE
    if (blockIdx.x == 0 && threadIdx.x == 0) F.MISC[40] = (unsigned)(__hip_atomic_load((unsigned long long*)((unsigned char*)F.wsg + WS_CTL + (CW_BAR + 3600) * 4), __ATOMIC_RELAXED, __HIP_MEMORY_SCOPE_AGENT) * 10ull / 256ull);
#endif
#if MK_CLKPROBE || MK_TPROBE || MK_BARPROBE || MK_PPPROBE
    if (blockIdx.x == 0) { __syncthreads(); const unsigned w_ = F.MISC[40]; const unsigned long long t0_ = __builtin_amdgcn_s_memrealtime(); while (__builtin_amdgcn_s_memrealtime() - t0_ < (unsigned long long)w_) __builtin_amdgcn_s_sleep(32); }
#endif
    if (!MK_FUSEFIN && EN(14) && RUN()) normf_phase(F, (float*)F.outg, F.in(IN_FING));
#undef RUN
#undef SEAM
}

extern "C" void kernel_launch(void* const* d_in, const int* in_sizes, int n_in, void* d_out, int out_size, void* d_ws, size_t ws_size, hipStream_t stream) {
    static int grid = 0;
    if (grid == 0) {
        if (n_in != 19 || out_size != MTOK * DM || ws_size < WS_END) { fprintf(stderr, "kernel_launch: unexpected shapes (n_in %d, out %d, ws %zu < %zu)\n", n_in, out_size, ws_size, (size_t)WS_END); grid = -1; return; }
        int dev = 0, cus = 0, per_cu = 0;
        if (hipGetDevice(&dev) != hipSuccess || hipDeviceGetAttribute(&cus, hipDeviceAttributeMultiprocessorCount, dev) != hipSuccess) { grid = -1; return; }
        if (hipFuncSetAttribute((const void*)mega_fwd, hipFuncAttributeMaxDynamicSharedMemorySize, LDS_BYTES) != hipSuccess) { fprintf(stderr, "kernel_launch: hipFuncSetAttribute failed\n"); grid = -1; return; }
        if (hipOccupancyMaxActiveBlocksPerMultiprocessor(&per_cu, (const void*)mega_fwd, NWAVES * 64, LDS_BYTES) != hipSuccess || per_cu < 1) { fprintf(stderr, "kernel_launch: occupancy query says %d\n", per_cu); }
        (void)hipGetLastError();
        grid = cus;
    }
    if (grid < 0) return;
    if (hipMemsetAsync((char*)d_ws + WS_CTL, 0, CTL_ZERO_BYTES, stream) != hipSuccess) return;
    Args a{};
    for (int i = 0; i < 19; ++i) a.in[i] = (const float*)d_in[i];
    a.out = (float*)d_out; a.ws = (unsigned char*)d_ws;
#if MK_PER_PHASE
    for (int p = 0; p < NPHASE; ++p) { a.ph_lo = p; a.ph_hi = p + 1; hipLaunchKernelGGL(mega_fwd, dim3(grid), dim3(NWAVES * 64), LDS_BYTES, stream, a); }
#else
    a.ph_lo = 0; a.ph_hi = NPHASE; hipLaunchKernelGGL(mega_fwd, dim3(grid), dim3(NWAVES * 64), LDS_BYTES, stream, a);
#endif
}
```

```cpp
#include <hip/hip_runtime.h>
#include <hip/hip_bf16.h>
#include <cstdio>
#include <cstdint>
__device__ __forceinline__ int ltid() { int t = (int)threadIdx.x; asm volatile("" : "+v"(t)); return t; }
namespace pg8 {
#define PG8_LAS __attribute__((address_space(3)))
typedef unsigned short bf16_t;
typedef short bf16x8 __attribute__((ext_vector_type(8)));
typedef float f32x4 __attribute__((ext_vector_type(4)));
typedef unsigned u32x4 __attribute__((ext_vector_type(4)));
constexpr int BM = 256, BK = 64, HALF = 128, HTB = HALF * BK * 2  , STAGE_BYTES = 8 * HTB, NXCD = 8;
#ifndef MK_SETPRIO
#define MK_SETPRIO 1
#endif
#ifndef MK_DYNGLOBAL
#define MK_DYNGLOBAL 1
#endif
#ifndef MK_RELAXW
#define MK_RELAXW 0
#endif
#ifndef MK_WGM
#define MK_WGM 4
#endif
constexpr int WGM = MK_WGM;

__host__ __device__ __forceinline__ int lds_byte(int r, int c) { const int st = (r >> 4) * 2 + (c >> 5), rr = r & 15, cc = c & 31, ob = rr * 64 + cc * 2; return st * 1024 + (ob ^ (((ob >> 9) & 1) << 5)); }
__host__ __device__ __forceinline__ void stage_rc(int b, int& R, int& C) { const int st = b / 1024, sb = b % 1024, swz = sb ^ (((sb >> 9) & 1) << 5); R = (st >> 1) * 16 + swz / 64; C = (st & 1) * 32 + (swz % 64) / 2; }
__host__ __device__ __forceinline__ int perm32(int rho) { const int n = rho >> 4, i = rho & 15; return 8 * (i >> 2) + 4 * n + (i & 3); }

struct Unit { int pm, pn; };
struct Gemm { const bf16_t* A; const bf16_t* Bt; int M, N, K; };

struct StaticOrder {
    int nM, nN, nwg, G, c, lim, pm_off;
    __host__ __device__ void init(int M, int N, int G_, int c_) { nM = M / BM; nN = N / BM; nwg = nM * nN; G = G_; c = c_; lim = nwg; pm_off = 0; }
    __host__ __device__ bool next(int i, Unit& u) const { const long L = (long)i * G + c; if (L >= lim) return false; unit_of((int)L, u); return true; }
    __host__ __device__ void unit_of(int L, Unit& u) const {
        int wgid = L; { const int q = nwg / NXCD, r = nwg % NXCD, xcd = wgid % NXCD, off = wgid / NXCD; wgid = (xcd < r ? xcd * (q + 1) : r * (q + 1) + (xcd - r) * q) + off; }
        const int nig = WGM * nN, gid = wgid / nig, fm = gid * WGM, gsz = (nM - fm) < WGM ? (nM - fm) : WGM;
        u.pm = pm_off + fm + ((wgid % nig) % gsz); u.pn = (wgid % nig) / gsz;
    }
    __device__ __forceinline__ void a_ready(const Unit&) const {}
    __device__ __forceinline__ void done(const Unit&) const {}
};
struct TailClaimOrder : StaticOrder {
    int nfull, cls, nleft; unsigned* cnt; volatile PG8_LAS unsigned* slot;
    __device__ __forceinline__ void init_tail(unsigned* counters  , volatile PG8_LAS unsigned* slot_) {
        nfull = (nwg / G) * G; cls = MK_DYNGLOBAL ? 0 : (c & 7); nleft = MK_DYNGLOBAL ? (nwg - nfull) : (nwg - nfull + 7 - cls) / 8; cnt = counters + cls * 64; slot = slot_; }
    __device__ __forceinline__ bool next(int i, Unit& u) const {
        const int L = i * G + c;
        if (L < nfull) { unit_of(L, u); return true; }
        if (i * G != nfull) return false;
        if (threadIdx.x == 0) { const unsigned k = __hip_atomic_fetch_add((__attribute__((address_space(1))) unsigned*)cnt, 1u, __ATOMIC_RELAXED, __HIP_MEMORY_SCOPE_AGENT); *slot = k; }
        asm volatile("s_waitcnt lgkmcnt(0)" ::: "memory"); __builtin_amdgcn_s_barrier(); asm volatile("" ::: "memory");
        const int k = __builtin_amdgcn_readfirstlane((int)*slot);
        if (k >= nleft) return false;
        unit_of(MK_DYNGLOBAL ? (nfull + k) : (nfull + 8 * k + cls), u); return true;
    }
};
struct OneUnit { Unit u;
    __device__ __forceinline__ bool next(int i, Unit& v) const { if (i != 0) return false; v = u; return true; }
    __device__ __forceinline__ void a_ready(const Unit&) const {}
    __device__ __forceinline__ void done(const Unit&) const {}
};
__device__ __forceinline__ unsigned cvt_pk_bf16(float lo, float hi) { unsigned r; asm volatile("v_cvt_pk_bf16_f32 %0, %1, %2" : "=v"(r) : "v"(lo), "v"(hi)); return r; }
typedef float f32x2 __attribute__((ext_vector_type(2)));
__device__ __forceinline__ f32x2 gelu_pk(f32x2 v) {
    const f32x2 av = __builtin_elementwise_abs(v), d = av * 0.2316418882f + 1.0f;
    f32x2 t; t.x = __builtin_amdgcn_rcpf(d.x); t.y = __builtin_amdgcn_rcpf(d.y);
    f32x2 q = t * 0.5307027145f + (-0.7265760135f); q = q * t + 0.7107068705f; q = q * t + (-0.142248368f); q = q * t + 0.127414796f; q = q * t;
    const f32x2 s = (v * v) * (-0.72134752044f);
    f32x2 e; e.x = __builtin_amdgcn_exp2f(s.x); e.y = __builtin_amdgcn_exp2f(s.y);
    const f32x2 m = v * (q * e), r = v - m;
    f32x2 o; o.x = v.x < 0.f ? m.x : r.x; o.y = v.y < 0.f ? m.y : r.y; return o;
}

#ifndef MK_NTST
#define MK_NTST 0
#endif
#if MK_NTST
#define EPI_ST16(p, v) __builtin_nontemporal_store((v), (u32x4*)(p))
#else
#define EPI_ST16(p, v) (*(u32x4*)(p) = (v))
#endif
struct RowAffine {
    const unsigned long long* rss; const float* biasb;
    int bpitch; PG8_LAS float* T;
    template <bool UPGATE> __device__ __forceinline__ void stage(const Unit& u, int p, int wid, int lane) const {
        if (wid == 0 || wid == 2) __builtin_amdgcn_global_load_lds((const unsigned*)(rss + (size_t)u.pm * BM + wid * 64 + lane * 2), (PG8_LAS unsigned*)(T + p * 768 + wid * 128), 16, 0, 0);
        if (wid == 1) { const int b = (u.pm * BM) >> 12;
            const int col = UPGATE ? ((lane < 32) ? (u.pn * 128 + lane * 4) : (5504 + u.pn * 128 + (lane - 32) * 4)) : (u.pn * BM + lane * 4);
            __builtin_amdgcn_global_load_lds((const unsigned*)(biasb + (size_t)b * bpitch + col), (PG8_LAS unsigned*)(T + p * 768 + 512), 16, 0, 0); }
    }
    template <bool PR = false> __device__ __forceinline__ void apply(f32x4 (&acc)[2][2][4][2], int p, int wr, int wc, int fr, int fq) const {
        const PG8_LAS unsigned long long* Tr = (const PG8_LAS unsigned long long*)(T + p * 768) + wr * 64 + (PR ? 4 * fr : fr); const PG8_LAS float* Tb = T + p * 768 + 512 + wc * 32 + 8 * fq;
        float rs[2][4];
#pragma unroll
        for (int ai = 0; ai < 2; ++ai)
#pragma unroll
            for (int m = 0; m < 4; ++m) rs[ai][m] = __builtin_amdgcn_rsqf((float)Tr[ai * HALF + (PR ? m : m * 16)] * (1.0f / (1048576.0f * 2048.0f)) + 1e-6f);
#pragma unroll
        for (int bj = 0; bj < 2; ++bj)
#pragma unroll
            for (int n = 0; n < 2; ++n) { const f32x4 bv = *(const PG8_LAS f32x4*)(Tb + bj * HALF + 4 * n);
#pragma unroll
                for (int ai = 0; ai < 2; ++ai)
#pragma unroll
                    for (int m = 0; m < 4; ++m) acc[ai][bj][m][n] = acc[ai][bj][m][n] * rs[ai][m] + bv; }
    }
};
__device__ __forceinline__ float gelu_tanh1(float v) {
    const float u = v * (0.7978845608f + 0.0356774081f * v * v);
    const float e = __builtin_amdgcn_exp2f(u * -2.8853900818f);
    return v * __builtin_amdgcn_rcpf(1.0f + e);
}
__device__ __forceinline__ f32x4 gelu_tanh4(f32x4 v) {
    const f32x4 u = v * (v * v * 0.0356774081f + 0.7978845608f);
    const f32x4 a = u * -2.8853900818f;
    f32x4 e; e.x = __builtin_amdgcn_exp2f(a.x); e.y = __builtin_amdgcn_exp2f(a.y); e.z = __builtin_amdgcn_exp2f(a.z); e.w = __builtin_amdgcn_exp2f(a.w);
    const f32x4 d = e + 1.0f;
    f32x4 r; r.x = __builtin_amdgcn_rcpf(d.x); r.y = __builtin_amdgcn_rcpf(d.y); r.z = __builtin_amdgcn_rcpf(d.z); r.w = __builtin_amdgcn_rcpf(d.w);
    return v * r;
}
template <int ACT  > struct EpiStore {
    static constexpr bool PERM = true, AFTER_DRAIN = false, PERMROW = false;
    bf16_t* O; int ldc; RowAffine ra; unsigned long long* vss;
    __device__ __forceinline__ void stage(const Unit& u, int p, int wid, int lane) const { ra.stage<false>(u, p, wid, lane); }
    __device__ __forceinline__ void operator()(f32x4 (&acc)[2][2][4][2], const Unit& u, int p, int wr, int wc, int fr, int fq) const {
        ra.apply(acc, p, wr, wc, fr, fq);
        const int row0 = u.pm * BM + wr * 64 + fr, col0 = u.pn * BM + wc * 32 + 8 * fq; float ssq[8];
#pragma unroll
        for (int ai = 0; ai < 2; ++ai)
#pragma unroll
            for (int m = 0; m < 4; ++m) { bf16_t* rowp = O + (size_t)(row0 + ai * HALF + m * 16) * ldc + col0; float s = 0.f;
#pragma unroll
                for (int bj = 0; bj < 2; ++bj) { f32x4 v0 = acc[ai][bj][m][0], v1 = acc[ai][bj][m][1];
                    if (ACT == 1) { v0 = gelu_tanh4(v0); v1 = gelu_tanh4(v1); }
                    s += (v0[0] * v0[0] + v0[1] * v0[1]) + (v0[2] * v0[2] + v0[3] * v0[3]) + (v1[0] * v1[0] + v1[1] * v1[1]) + (v1[2] * v1[2] + v1[3] * v1[3]);
                    u32x4 w; w.x = cvt_pk_bf16(v0[0], v0[1]); w.y = cvt_pk_bf16(v0[2], v0[3]); w.z = cvt_pk_bf16(v1[0], v1[1]); w.w = cvt_pk_bf16(v1[2], v1[3]);
                    EPI_ST16(rowp + bj * HALF, w); }
                ssq[ai * 4 + m] = s; }
        if (vss && u.pn >= 8) {
#pragma unroll
            for (int k = 0; k < 8; ++k) ssq[k] += __shfl_xor(ssq[k], 16);
#pragma unroll
            for (int k = 0; k < 8; ++k) ssq[k] += __shfl_xor(ssq[k], 32);
            if (fq == 0) {
#pragma unroll
                for (int k = 0; k < 8; ++k) __hip_atomic_fetch_add(vss + row0 + (k >> 2) * HALF + (k & 3) * 16, (unsigned long long)(ssq[k] * 1048576.0f), __ATOMIC_RELAXED, __HIP_MEMORY_SCOPE_AGENT); } }
    }
};
struct EpiQKV {
    static constexpr bool PERM = true, AFTER_DRAIN = false, PERMROW = false;
    bf16_t* QKV; size_t tstride; float qscale; RowAffine ra;
    __device__ __forceinline__ void stage(const Unit& u, int p, int wid, int lane) const { ra.stage<false>(u, p, wid, lane); }
    __device__ __forceinline__ void operator()(f32x4 (&acc)[2][2][4][2], const Unit& u, int p, int wr, int wc, int fr, int fq) const {
        ra.apply(acc, p, wr, wc, fr, fq);
        const int tok0 = u.pm * BM, b = tok0 >> 12, s0 = (tok0 & 4095) + wr * 64 + fr;
        const int colt = u.pn * BM, t = colt >> 11, hd0 = (colt & 2047) >> 7;
        bf16_t* base = QKV + (size_t)t * tstride; const float sc = t == 0 ? qscale : 1.0f;
#pragma unroll
        for (int bj = 0; bj < 2; ++bj) { bf16_t* hb = base + ((size_t)(b * 16 + hd0 + bj) * 4096 + s0) * 128 + wc * 32 + 8 * fq;
#pragma unroll
            for (int ai = 0; ai < 2; ++ai)
#pragma unroll
                for (int m = 0; m < 4; ++m) { const f32x4 v0 = acc[ai][bj][m][0] * sc, v1 = acc[ai][bj][m][1] * sc;
                    u32x4 w; w.x = cvt_pk_bf16(v0[0], v0[1]); w.y = cvt_pk_bf16(v0[2], v0[3]); w.z = cvt_pk_bf16(v1[0], v1[1]); w.w = cvt_pk_bf16(v1[2], v1[3]);
                    EPI_ST16(hb + (size_t)(ai * HALF + m * 16) * 128, w); } }
    }
};
struct EpiRes {
    static constexpr bool PERM = true, AFTER_DRAIN = false, PERMROW = false;
    bf16_t* xb; const float* gate; int gpitch; bf16_t* xg; const float* gn; const float* scn; unsigned long long* rss; PG8_LAS float* T; float* xf;
    __device__ __forceinline__ void stage(const Unit& u, int p, int wid, int lane) const { const int b = (u.pm * BM) >> 12, c = u.pn * BM + lane * 4;
        if (wid == 0) __builtin_amdgcn_global_load_lds((const unsigned*)(gate + (size_t)b * gpitch + c), (PG8_LAS unsigned*)(T + p * 768), 16, 0, 0);
        if (wid == 1 && xg) __builtin_amdgcn_global_load_lds((const unsigned*)(gn + c), (PG8_LAS unsigned*)(T + p * 768 + 256), 16, 0, 0);
        if (wid == 2 && xg) __builtin_amdgcn_global_load_lds((const unsigned*)(scn + (size_t)b * gpitch + c), (PG8_LAS unsigned*)(T + p * 768 + 512), 16, 0, 0); }
    __device__ __forceinline__ void operator()(const f32x4 (&acc)[2][2][4][2], const Unit& u, int p, int wr, int wc, int fr, int fq) const {
        const int row0 = u.pm * BM + wr * 64 + fr, col0 = u.pn * BM + wc * 32 + 8 * fq; const PG8_LAS float* Tc = T + p * 768 + wc * 32 + 8 * fq;
        u32x4 xbuf[4][2];
#define ER_LOAD(k) do { const size_t off_ = (size_t)(row0 + ((k) >> 2) * HALF + ((k) & 3) * 16) * 2048 + col0; _Pragma("unroll") for (int bj = 0; bj < 2; ++bj) xbuf[(k) % 4][bj] = *(const u32x4*)(xb + off_ + bj * HALF); } while (0)
        ER_LOAD(0); ER_LOAD(1); ER_LOAD(2); ER_LOAD(3);
        f32x4 gv[2][2], gs[2][2];
#pragma unroll
        for (int bj = 0; bj < 2; ++bj)
#pragma unroll
            for (int n = 0; n < 2; ++n) { gv[bj][n] = *(const PG8_LAS f32x4*)(Tc + bj * HALF + n * 4);
                gs[bj][n] = xg ? *(const PG8_LAS f32x4*)(Tc + 256 + bj * HALF + n * 4) * (*(const PG8_LAS f32x4*)(Tc + 512 + bj * HALF + n * 4) + 1.0f) : (f32x4){0.f, 0.f, 0.f, 0.f}; }
        float ss[8];
#pragma unroll
        for (int k = 0; k < 8; ++k) { const int ai = k >> 2, m = k & 3, row = row0 + ai * HALF + m * 16; const size_t off = (size_t)row * 2048 + col0; float s = 0.f;
            __builtin_amdgcn_sched_barrier(0);
#pragma unroll
            for (int bj = 0; bj < 2; ++bj) { const u32x4 xw = xbuf[k % 4][bj];
                const f32x4 x0 = (f32x4){__builtin_bit_cast(float, xw.x << 16), __builtin_bit_cast(float, xw.x & 0xffff0000u), __builtin_bit_cast(float, xw.y << 16), __builtin_bit_cast(float, xw.y & 0xffff0000u)};
                const f32x4 x1 = (f32x4){__builtin_bit_cast(float, xw.z << 16), __builtin_bit_cast(float, xw.z & 0xffff0000u), __builtin_bit_cast(float, xw.w << 16), __builtin_bit_cast(float, xw.w & 0xffff0000u)};
                const f32x4 o0 = x0 + gv[bj][0] * acc[ai][bj][m][0], o1 = x1 + gv[bj][1] * acc[ai][bj][m][1];
                u32x4 w; w.x = cvt_pk_bf16(o0[0], o0[1]); w.y = cvt_pk_bf16(o0[2], o0[3]); w.z = cvt_pk_bf16(o1[0], o1[1]); w.w = cvt_pk_bf16(o1[2], o1[3]);
                if (xf) { *(f32x4*)(xf + off + bj * HALF) = o0; *(f32x4*)(xf + off + bj * HALF + 4) = o1; } else EPI_ST16(xb + off + bj * HALF, w);
                if (xg) { const f32x4 y0 = o0 * gs[bj][0], y1 = o1 * gs[bj][1]; u32x4 g; g.x = cvt_pk_bf16(y0[0], y0[1]); g.y = cvt_pk_bf16(y0[2], y0[3]); g.z = cvt_pk_bf16(y1[0], y1[1]); g.w = cvt_pk_bf16(y1[2], y1[3]);
                    EPI_ST16(xg + off + bj * HALF, g);
                    s += (o0[0] * o0[0] + o0[1] * o0[1]) + (o0[2] * o0[2] + o0[3] * o0[3]) + (o1[0] * o1[0] + o1[1] * o1[1]) + (o1[2] * o1[2] + o1[3] * o1[3]); } }
            ss[k] = s;
            __builtin_amdgcn_sched_barrier(0);
            if (k + 4 < 8) ER_LOAD(k + 4); }
#undef ER_LOAD
        if (xg) {
#pragma unroll
            for (int k = 0; k < 8; ++k) ss[k] += __shfl_xor(ss[k], 16);
#pragma unroll
            for (int k = 0; k < 8; ++k) ss[k] += __shfl_xor(ss[k], 32);
            if (fq == 0) {
#pragma unroll
                for (int k = 0; k < 8; ++k) __hip_atomic_fetch_add(rss + row0 + (k >> 2) * HALF + (k & 3) * 16, (unsigned long long)(ss[k] * 1048576.0f), __ATOMIC_RELAXED, __HIP_MEMORY_SCOPE_AGENT); } }
    }
};
struct EpiResF : EpiRes {
    float* outp; const float* gfin; unsigned long long* rssf; unsigned* pcnt;
    __device__ __forceinline__ void stage(const Unit& u, int p, int wid, int lane) const { const int b = (u.pm * BM) >> 12, c = u.pn * BM + lane * 4;
        if (wid == 0) __builtin_amdgcn_global_load_lds((const unsigned*)(gate + (size_t)b * gpitch + c), (PG8_LAS unsigned*)(T + p * 768), 16, 0, 0);
        if (wid == 1 && (xg || outp)) __builtin_amdgcn_global_load_lds((const unsigned*)((outp ? gfin : gn) + c), (PG8_LAS unsigned*)(T + p * 768 + 256), 16, 0, 0);
        if (wid == 2 && xg) __builtin_amdgcn_global_load_lds((const unsigned*)(scn + (size_t)b * gpitch + c), (PG8_LAS unsigned*)(T + p * 768 + 512), 16, 0, 0); }
    __device__ __forceinline__ void operator()(f32x4 (&acc)[2][2][4][2], const Unit& u, int p, int wr, int wc, int fr, int fq) const {
        if (!outp) { EpiRes::operator()(acc, u, p, wr, wc, fr, fq); return; }
        asm volatile("; final-norm epilogue" ::: "memory");
        const int row0 = u.pm * BM + wr * 64 + fr, col0 = u.pn * BM + wc * 32 + 8 * fq; const PG8_LAS float* Tc = T + p * 768 + wc * 32 + 8 * fq;
        u32x4 xbuf[4][2];
#define ER_LOAD(k) do { const size_t off_ = (size_t)(row0 + ((k) >> 2) * HALF + ((k) & 3) * 16) * 2048 + col0; _Pragma("unroll") for (int bj = 0; bj < 2; ++bj) xbuf[(k) % 4][bj] = *(const u32x4*)(xb + off_ + bj * HALF); } while (0)
#define ER_X(xw, g0, g1, a0, a1, o0, o1) const f32x4 o0 = (f32x4){__builtin_bit_cast(float, xw.x << 16), __builtin_bit_cast(float, xw.x & 0xffff0000u), __builtin_bit_cast(float, xw.y << 16), __builtin_bit_cast(float, xw.y & 0xffff0000u)} + g0 * a0, \
                                                            o1 = (f32x4){__builtin_bit_cast(float, xw.z << 16), __builtin_bit_cast(float, xw.z & 0xffff0000u), __builtin_bit_cast(float, xw.w << 16), __builtin_bit_cast(float, xw.w & 0xffff0000u)} + g1 * a1
        ER_LOAD(0); ER_LOAD(1); ER_LOAD(2); ER_LOAD(3);
        f32x4 gv[2][2];
#pragma unroll
        for (int bj = 0; bj < 2; ++bj)
#pragma unroll
            for (int n = 0; n < 2; ++n) gv[bj][n] = *(const PG8_LAS f32x4*)(Tc + bj * HALF + n * 4);
        float ss[8];
#pragma unroll
        for (int k = 0; k < 8; ++k) { const int ai = k >> 2, m = k & 3; float s = 0.f;
            __builtin_amdgcn_sched_barrier(0);
#pragma unroll
            for (int bj = 0; bj < 2; ++bj) { const u32x4 xw = xbuf[k % 4][bj]; ER_X(xw, gv[bj][0], gv[bj][1], acc[ai][bj][m][0], acc[ai][bj][m][1], o0, o1);
                s += (o0[0] * o0[0] + o0[1] * o0[1]) + (o0[2] * o0[2] + o0[3] * o0[3]) + (o1[0] * o1[0] + o1[1] * o1[1]) + (o1[2] * o1[2] + o1[3] * o1[3]); }
            ss[k] = s;
            __builtin_amdgcn_sched_barrier(0);
            ER_LOAD((k + 4) & 7); }
#pragma unroll
        for (int k = 0; k < 8; ++k) ss[k] += __shfl_xor(ss[k], 16);
#pragma unroll
        for (int k = 0; k < 8; ++k) ss[k] += __shfl_xor(ss[k], 32);
        unsigned long long old = 0;
        if (fq == 0) {
#pragma unroll
            for (int k = 0; k < 8; ++k) old |= __hip_atomic_fetch_add(rssf + row0 + (k >> 2) * HALF + (k & 3) * 16, (unsigned long long)(ss[k] * 1048576.0f), __ATOMIC_RELAXED, __HIP_MEMORY_SCOPE_AGENT); }
        asm volatile("" :: "v"((unsigned)old), "v"((unsigned)(old >> 32)) : "memory");
        unsigned* cnt = pcnt + u.pm * 16;
        if ((threadIdx.x & 63) == 0) { __hip_atomic_fetch_add(cnt, 1u, __ATOMIC_RELAXED, __HIP_MEMORY_SCOPE_AGENT);
            unsigned tries = 0; while (__hip_atomic_load(cnt, __ATOMIC_RELAXED, __HIP_MEMORY_SCOPE_AGENT) < 64u && ++tries < (1u << 21)) __builtin_amdgcn_s_sleep(4); }
        asm volatile("" : "+v"(gv[0][0]), "+v"(gv[0][1]), "+v"(gv[1][0]), "+v"(gv[1][1]) :: "memory");
        float rs[8];
#pragma unroll
        for (int k = 0; k < 8; ++k) rs[k] = __builtin_amdgcn_rsqf((float)__hip_atomic_load(rssf + row0 + (k >> 2) * HALF + (k & 3) * 16, __ATOMIC_RELAXED, __HIP_MEMORY_SCOPE_AGENT) * (1.0f / (1048576.0f * 2048.0f)) + 1e-6f);
        int row0b = row0; asm volatile("" : "+v"(row0b));
        f32x4 gf[2][2];
#pragma unroll
        for (int bj = 0; bj < 2; ++bj)
#pragma unroll
            for (int n = 0; n < 2; ++n) gf[bj][n] = *(const PG8_LAS f32x4*)(Tc + 256 + bj * HALF + n * 4);
#pragma unroll
        for (int k = 0; k < 8; ++k) { const int ai = k >> 2, m = k & 3; const size_t off = (size_t)(row0b + ai * HALF + m * 16) * 2048 + col0;
            __builtin_amdgcn_sched_barrier(0);
#pragma unroll
            for (int bj = 0; bj < 2; ++bj) { const u32x4 xw = xbuf[k % 4][bj]; ER_X(xw, gv[bj][0], gv[bj][1], acc[ai][bj][m][0], acc[ai][bj][m][1], o0, o1);
                *(f32x4*)(outp + off + bj * HALF) = o0 * (gf[bj][0] * rs[k]); *(f32x4*)(outp + off + bj * HALF + 4) = o1 * (gf[bj][1] * rs[k]); }
            __builtin_amdgcn_sched_barrier(0);
            if (k + 4 < 8) ER_LOAD(k + 4); }
#undef ER_X
#undef ER_LOAD
    }
};
__device__ __forceinline__ int f2i(float v) { return __builtin_bit_cast(int, v); }
__device__ __forceinline__ float i2f(int v) { return __builtin_bit_cast(float, v); }
template <int SH> __device__ __forceinline__ float dpp_ror(float v) { return i2f(__builtin_amdgcn_update_dpp(0, f2i(v), 0x120 + SH, 0xf, 0xf, true)); }
template <int SH> __device__ __forceinline__ float dpp_shr_fill(float fill, float cur) { return i2f(__builtin_amdgcn_update_dpp(f2i(fill), f2i(cur), 0x110 + SH, 0xf, 0xf, false)); }
struct EpiConv {
    static constexpr bool PERM = true, AFTER_DRAIN = false, PERMROW = true;
    bf16_t* ACT; const float* cw; const float* cb; float* HALO; PG8_LAS float* X; RowAffine ra; PG8_LAS float* TW;
    __device__ __forceinline__ void stage(const Unit& u, int p, int wid, int lane) const { ra.stage<true>(u, p, wid, lane);
        if (wid >= 3 && wid <= 6) { const int k = wid - 3, col = (lane < 32) ? (u.pn * 128 + lane * 4) : (5504 + u.pn * 128 + (lane - 32) * 4);
            __builtin_amdgcn_global_load_lds((const unsigned*)((k < 3 ? cw + (size_t)k * 11008 : cb) + col), (PG8_LAS unsigned*)(TW + p * 1024 + k * 256), 16, 0, 0); } }
    __device__ __forceinline__ void operator()(f32x4 (&acc)[2][2][4][2], const Unit& u, int p, int wr, int wc, int fr, int fq) const {
        const int tcol = wc * 32 + 8 * fq, ch0 = u.pn * 128 + tcol;
        ra.apply<true>(acc, p, wr, wc, fr, fq);
#if defined(MK_KREP) && MK_KREP > 1
#pragma unroll
        for (int ai = 0; ai < 2; ++ai)
#pragma unroll
            for (int bj = 0; bj < 2; ++bj)
#pragma unroll
                for (int m = 0; m < 4; ++m)
#pragma unroll
                    for (int n = 0; n < 2; ++n) acc[ai][bj][m][n] *= (1.0f / MK_KREP);
#endif
        if (fr == 15) {
#pragma unroll
            for (int ai = 0; ai < 2; ++ai)
#pragma unroll
                for (int mm = 0; mm < 2; ++mm)
#pragma unroll
                    for (int bj = 0; bj < 2; ++bj)
#pragma unroll
                        for (int n = 0; n < 2; ++n) *(PG8_LAS f32x4*)(X + (((ai * 2 + wr) * 2 + mm) * 256) + bj * 128 + tcol + 4 * n) = acc[ai][bj][2 + mm][n];
            if (wr == 1) {
#pragma unroll
                for (int mm = 0; mm < 2; ++mm)
#pragma unroll
                    for (int bj = 0; bj < 2; ++bj)
#pragma unroll
                        for (int n = 0; n < 2; ++n) *(f32x4*)(HALO + ((size_t)u.pm * 4 + 2 + mm) * 11008 + bj * 5504 + ch0 + 4 * n) = acc[1][bj][2 + mm][n]; }
        }
        if (fr == 0 && wr == 0) {
#pragma unroll
            for (int mm = 0; mm < 2; ++mm)
#pragma unroll
                for (int bj = 0; bj < 2; ++bj)
#pragma unroll
                    for (int n = 0; n < 2; ++n) *(f32x4*)(HALO + ((size_t)u.pm * 4 + mm) * 11008 + bj * 5504 + ch0 + 4 * n) = acc[0][bj][mm][n]; }
        asm volatile("s_waitcnt lgkmcnt(0)" ::: "memory"); __builtin_amdgcn_s_barrier(); asm volatile("" ::: "memory");
        const PG8_LAS float* Tw = TW + p * 1024 + tcol;
        const int row0 = u.pm * BM + wr * 64 + 4 * fr;
#pragma unroll
        for (int ai = 0; ai < 2; ++ai) { const int g = ai * 2 + wr;
#pragma unroll
            for (int bj = 0; bj < 2; ++bj)
#pragma unroll
                for (int n = 0; n < 2; ++n) {
                    const f32x4 w0 = *(const PG8_LAS f32x4*)(Tw + bj * 128 + 4 * n), w1 = *(const PG8_LAS f32x4*)(Tw + 256 + bj * 128 + 4 * n), w2 = *(const PG8_LAS f32x4*)(Tw + 512 + bj * 128 + 4 * n), bb = *(const PG8_LAS f32x4*)(Tw + 768 + bj * 128 + 4 * n);
                    f32x4 h62 = (f32x4){0.f, 0.f, 0.f, 0.f}, h63 = h62;
                    if (g > 0) { h62 = *(const PG8_LAS f32x4*)(X + (((g - 1) * 2 + 0) * 256) + bj * 128 + tcol + 4 * n); h63 = *(const PG8_LAS f32x4*)(X + (((g - 1) * 2 + 1) * 256) + bj * 128 + tcol + 4 * n); }
                    const f32x4 x0 = acc[ai][bj][0][n], x1 = acc[ai][bj][1][n], x2 = acc[ai][bj][2][n], x3 = acc[ai][bj][3][n];
                    f32x4 s2, s3;
#pragma unroll
                    for (int e = 0; e < 4; ++e) { s3[e] = dpp_shr_fill<1>(h63[e], x3[e]); s2[e] = dpp_shr_fill<1>(h62[e], x2[e]); }
                    f32x4 r0 = bb + w2 * x0 + w1 * s3 + w0 * s2, r1 = bb + w2 * x1 + w1 * x0 + w0 * s3, r2 = bb + w2 * x2 + w1 * x1 + w0 * x0, r3 = bb + w2 * x3 + w1 * x2 + w0 * x1;
                    asm volatile("" : "+v"(r0), "+v"(r1), "+v"(r2), "+v"(r3));
                    acc[ai][bj][0][n] = r0; acc[ai][bj][1][n] = r1; acc[ai][bj][2][n] = r2; acc[ai][bj][3][n] = r3;
                    __builtin_amdgcn_sched_barrier(0); }
#pragma unroll
            for (int m = 0; m < 4; ++m) { f32x4 o[2];
#pragma unroll
                for (int n = 0; n < 2; ++n) { const f32x4 gt = acc[ai][0][m][n], a = gt * -1.4426950408889634f, gu = gt * acc[ai][1][m][n];
                    f32x4 ex; ex.x = __builtin_amdgcn_exp2f(a.x); ex.y = __builtin_amdgcn_exp2f(a.y); ex.z = __builtin_amdgcn_exp2f(a.z); ex.w = __builtin_amdgcn_exp2f(a.w);
                    const f32x4 d = ex + 1.0f; f32x4 r; r.x = __builtin_amdgcn_rcpf(d.x); r.y = __builtin_amdgcn_rcpf(d.y); r.z = __builtin_amdgcn_rcpf(d.z); r.w = __builtin_amdgcn_rcpf(d.w);
                    o[n] = gu * r; }
                u32x4 w; w.x = cvt_pk_bf16(o[0][0], o[0][1]); w.y = cvt_pk_bf16(o[0][2], o[0][3]); w.z = cvt_pk_bf16(o[1][0], o[1][1]); w.w = cvt_pk_bf16(o[1][2], o[1][3]);
                EPI_ST16(ACT + (size_t)(row0 + ai * HALF + m) * 5504 + ch0, w); }
            __builtin_amdgcn_sched_barrier(0); }
    }
};
template <class Epi, class Sched, bool ALIGN_EPI = false, bool SP2 = false, int KREP = 1, int TP = 0>
__device__ __forceinline__ void gemm_phase(PG8_LAS unsigned char* lds, const Gemm g, const Sched& S, const Epi& E, unsigned long long* tp_out = nullptr) {
    unsigned long long tp_acc = 0, tp3 = 0;
    const int tid = ltid(), wid = __builtin_amdgcn_readfirstlane(tid >> 6), lane = tid & 63, wr = wid >> 2, wc = wid & 3, fr = lane & 15, fq = lane >> 4;
    const int K = g.K, nt = K / BK;
    unsigned voffA[2], voffB[2];
#pragma unroll
    for (int i = 0; i < 2; ++i) { int R, C; stage_rc(tid * 16 + i * 8192, R, C); const int Rb = Epi::PERM ? ((R & ~31) + perm32(R & 31)) : R;
        const int Ra = Epi::PERMROW ? ((R & ~63) + 4 * (R & 15) + ((R >> 4) & 3)) : R;
        voffA[i] = (unsigned)(Ra * K + C) * 2u; voffB[i] = (unsigned)(Rb * K + C) * 2u; }
    const size_t kstep = (size_t)(BK * 2);
    const size_t hstep = (size_t)HALF * K * 2;
    const size_t tstep = 2 * hstep;
    const unsigned ldsw = (unsigned)wid * 1024u;
    const int aoff = lds_byte(wr * 64 + fr, fq * 8), boff = lds_byte(wc * 32 + fr, fq * 8);
#define PG8_SA(b, h) (((b) * 2 + (h)) * HTB)
#define PG8_SB(b, h) ((4 + (b) * 2 + (h)) * HTB)
#define PG8_STAGE(bufoff, gbase, voff) do { _Pragma("unroll") for (int _i = 0; _i < 2; ++_i) \
        __builtin_amdgcn_global_load_lds((const unsigned*)((const char*)(gbase) + (voff)[_i]), (PG8_LAS unsigned*)(lds + (bufoff) + ldsw + _i * 8192), 16, 0, 0); } while (0)
#define PG8_LDA(dst, b, h) do { _Pragma("unroll") for (int m = 0; m < 4; ++m) _Pragma("unroll") for (int k = 0; k < 2; ++k) dst[m][k] = *(const PG8_LAS bf16x8*)(lds + PG8_SA(b, h) + aoff + m * 2048 + k * 1024); } while (0)
#define PG8_LDB(dst, b, h) do { _Pragma("unroll") for (int n = 0; n < 2; ++n) _Pragma("unroll") for (int k = 0; k < 2; ++k) dst[n][k] = *(const PG8_LAS bf16x8*)(lds + PG8_SB(b, h) + boff + n * 2048 + k * 1024); } while (0)
#define PG8_MMA(ai, bj, At, Bt) do { if (MK_SETPRIO) __builtin_amdgcn_s_setprio(MK_SETPRIO); _Pragma("unroll") for (int m = 0; m < 4; ++m) _Pragma("unroll") for (int n = 0; n < 2; ++n) _Pragma("unroll") for (int k = 0; k < 2; ++k) \
        acc[ai][bj][m][n] = __builtin_amdgcn_mfma_f32_16x16x32_bf16(Bt[n][k], At[m][k], acc[ai][bj][m][n], 0, 0, 0); if (MK_SETPRIO) __builtin_amdgcn_s_setprio(0); } while (0)
#define PG8_WAIT_V(n) asm volatile("s_waitcnt vmcnt(" #n ")" ::: "memory")
#define PG8_WAIT_L(n) asm volatile("s_waitcnt lgkmcnt(" #n ")" ::: "memory")
#define PG8_WAIT_V_SEL(sel) asm volatile("s_cmp_eq_u32 %0, 0\n\ts_cbranch_scc1 .Lw8_%=\n\ts_waitcnt vmcnt(22)\n\ts_branch .Lwd_%=\n.Lw8_%=:\n\ts_waitcnt vmcnt(8)\n.Lwd_%=:" :: "s"(sel) : "memory", "scc")
#define PG8_BAR __builtin_amdgcn_s_barrier()
#define PG8_SCHED __builtin_amdgcn_sched_barrier(0)
    Unit cur, nxt; int ui = 0;
    if (!S.next(0, cur)) return;
    E.stage(cur, 0, wid, lane);
    f32x4 acc[2][2][4][2];
#pragma unroll
    for (int a = 0; a < 2; ++a)
#pragma unroll
        for (int b = 0; b < 2; ++b)
#pragma unroll
            for (int m = 0; m < 4; ++m)
#pragma unroll
                for (int n = 0; n < 2; ++n) acc[a][b][m][n] = (f32x4){0.f, 0.f, 0.f, 0.f};
    bf16x8 At[4][2], B0[2][2], B1[2][2];
    const char* cA = (const char*)g.A + (size_t)cur.pm * tstep; const char* cB = (const char*)g.Bt + (size_t)cur.pn * tstep;
    S.a_ready(cur);
    if constexpr (SP2) {
        PG8_STAGE(PG8_SB(0, 0), cB, voffB); PG8_STAGE(PG8_SB(0, 1), cB + hstep, voffB); PG8_STAGE(PG8_SA(0, 0), cA, voffA); PG8_STAGE(PG8_SA(0, 1), cA + hstep, voffA);
        if (wr == 1) PG8_BAR;
        PG8_WAIT_V(2); PG8_BAR;
        PG8_STAGE(PG8_SB(1, 0), cB + kstep, voffB); PG8_STAGE(PG8_SA(1, 0), cA + kstep, voffA); PG8_STAGE(PG8_SB(1, 1), cB + hstep + kstep, voffB);
        PG8_WAIT_V(6); PG8_BAR;
    } else {
        PG8_STAGE(PG8_SB(0, 0), cB, voffB); PG8_STAGE(PG8_SA(0, 0), cA, voffA); PG8_STAGE(PG8_SB(0, 1), cB + hstep, voffB); PG8_STAGE(PG8_SA(0, 1), cA + hstep, voffA);
        if (wr == 1) PG8_BAR;
        PG8_WAIT_V(4); PG8_BAR;
        PG8_STAGE(PG8_SB(1, 0), cB + kstep, voffB); PG8_STAGE(PG8_SA(1, 0), cA + kstep, voffA); PG8_STAGE(PG8_SB(1, 1), cB + hstep + kstep, voffB);
        PG8_WAIT_V(6); PG8_BAR;
    }
    for (;;) {
        const bool has_next = S.next(ui + 1, nxt);
        if constexpr (TP == 3) { if (ui > 0) tp_acc += __builtin_amdgcn_s_memrealtime() - tp3; }
        const char* nA = has_next ? (const char*)g.A + (size_t)nxt.pm * tstep : cA; const char* nB = has_next ? (const char*)g.Bt + (size_t)nxt.pn * tstep : cB;
        for (int t = 0; t < nt * KREP; t += 2) {
            const bool last = (t == nt * KREP - 2);
            const int t1w = KREP > 1 ? ((t + 1) & (nt - 1)) : t + 1, t2w = KREP > 1 ? ((t + 2) & (nt - 1)) : t + 2;
            const char* a1 = cA + (size_t)t1w * kstep;
            const char* a2 = last ? nA : cA + (size_t)t2w * kstep; const char* b2 = last ? nB : cB + (size_t)t2w * kstep;
            const char* a3 = a2 + kstep; const char* b3 = b2 + kstep;
            if (last && has_next) S.a_ready(nxt);
            const int relax = __builtin_amdgcn_readfirstlane((MK_RELAXW && t == 0 && ui > 0) ? 1 : 0);
            if constexpr (SP2) {
            PG8_LDB(B0, 0, 0); PG8_LDB(B1, 0, 1); PG8_SCHED; PG8_LDA(At, 0, 0); PG8_STAGE(PG8_SA(1, 1), a1 + hstep, voffA);
            PG8_WAIT_V_SEL(relax);
            PG8_WAIT_L(0); PG8_BAR; PG8_MMA(0, 0, At, B0); PG8_MMA(0, 1, At, B1); PG8_BAR; PG8_SCHED;
            PG8_LDA(At, 0, 1); PG8_STAGE(PG8_SB(0, 0), b2, voffB); PG8_STAGE(PG8_SB(0, 1), b2 + hstep, voffB); PG8_STAGE(PG8_SA(0, 0), a2, voffA);
            PG8_WAIT_V_SEL(relax);
            PG8_WAIT_L(0); PG8_BAR; PG8_MMA(1, 0, At, B0); PG8_MMA(1, 1, At, B1); PG8_BAR; PG8_SCHED;
            PG8_LDB(B0, 1, 0); PG8_LDB(B1, 1, 1); PG8_SCHED; PG8_LDA(At, 1, 0); PG8_STAGE(PG8_SA(0, 1), a2 + hstep, voffA);
            PG8_WAIT_V(8); PG8_WAIT_L(0); PG8_BAR; PG8_MMA(0, 0, At, B0); PG8_MMA(0, 1, At, B1); PG8_BAR; PG8_SCHED;
            PG8_LDA(At, 1, 1); PG8_STAGE(PG8_SB(1, 0), b3, voffB); PG8_STAGE(PG8_SB(1, 1), b3 + hstep, voffB); PG8_STAGE(PG8_SA(1, 0), a3, voffA);
            PG8_WAIT_V(8); PG8_WAIT_L(0); PG8_BAR; PG8_MMA(1, 0, At, B0); PG8_MMA(1, 1, At, B1); PG8_BAR; PG8_SCHED;
            } else {
            PG8_LDB(B0, 0, 0); PG8_SCHED; PG8_LDA(At, 0, 0); PG8_STAGE(PG8_SA(1, 1), a1 + hstep, voffA);
            PG8_WAIT_L(8); PG8_BAR; PG8_WAIT_L(0); PG8_MMA(0, 0, At, B0); PG8_BAR; PG8_SCHED;
            PG8_LDB(B1, 0, 1); PG8_STAGE(PG8_SB(0, 0), b2, voffB);
            PG8_BAR; PG8_WAIT_L(0); PG8_MMA(0, 1, At, B1); PG8_BAR;
            PG8_LDA(At, 0, 1); PG8_STAGE(PG8_SA(0, 0), a2, voffA);
            PG8_BAR; PG8_WAIT_L(0); PG8_MMA(1, 0, At, B0); PG8_BAR; PG8_SCHED;
            PG8_STAGE(PG8_SB(0, 1), b2 + hstep, voffB);
            PG8_WAIT_V(6); PG8_BAR; PG8_MMA(1, 1, At, B1); PG8_BAR;
            PG8_LDB(B0, 1, 0); PG8_SCHED; PG8_LDA(At, 1, 0); PG8_STAGE(PG8_SA(0, 1), a2 + hstep, voffA);
            PG8_WAIT_L(8); PG8_BAR; PG8_WAIT_L(0); PG8_MMA(0, 0, At, B0); PG8_BAR; PG8_SCHED;
            PG8_LDB(B1, 1, 1); PG8_STAGE(PG8_SB(1, 0), b3, voffB);
            PG8_BAR; PG8_WAIT_L(0); PG8_MMA(0, 1, At, B1); PG8_BAR;
            PG8_LDA(At, 1, 1); PG8_STAGE(PG8_SA(1, 0), a3, voffA);
            PG8_BAR; PG8_WAIT_L(0); PG8_MMA(1, 0, At, B0); PG8_BAR; PG8_SCHED;
            PG8_STAGE(PG8_SB(1, 1), b3 + hstep, voffB);
            PG8_WAIT_V(6); PG8_BAR; PG8_MMA(1, 1, At, B1); PG8_BAR;
            }
        }
        unsigned long long tp0 = 0; if constexpr (TP == 1) tp0 = __builtin_amdgcn_s_memrealtime();
        if constexpr (ALIGN_EPI) { if (wr == 0) PG8_BAR; }
        if constexpr (TP == 2) tp0 = __builtin_amdgcn_s_memrealtime();
        if constexpr (!Epi::AFTER_DRAIN) { E(acc, cur, ui & 1, wr, wc, fr, fq); S.done(cur); }
        if constexpr (TP == 1 || TP == 2) tp_acc += __builtin_amdgcn_s_memrealtime() - tp0;
        if constexpr (TP == 3) tp3 = __builtin_amdgcn_s_memrealtime();
        if (!has_next) break;
        E.stage(nxt, (ui + 1) & 1, wid, lane);
#pragma unroll
        for (int a = 0; a < 2; ++a)
#pragma unroll
            for (int b = 0; b < 2; ++b)
#pragma unroll
                for (int m = 0; m < 4; ++m)
#pragma unroll
                    for (int n = 0; n < 2; ++n) acc[a][b][m][n] = (f32x4){0.f, 0.f, 0.f, 0.f};
        cur = nxt; cA = nA; cB = nB; ++ui;
        if constexpr (ALIGN_EPI) { if (wr == 1) PG8_BAR; }
    }
    if constexpr (TP != 0) { if (tp_out) *tp_out = tp_acc; }
    PG8_WAIT_V(0);
    if constexpr (!ALIGN_EPI) { if (wr == 0) PG8_BAR; }
    PG8_BAR;
    if constexpr (Epi::AFTER_DRAIN) { E.fused(acc, cur, wr, wc, fr, fq, lds, wid, lane); S.done(cur); }
#undef PG8_SA
#undef PG8_SB
#undef PG8_STAGE
#undef PG8_LDA
#undef PG8_LDB
#undef PG8_MMA
#undef PG8_WAIT_V
#undef PG8_WAIT_L
#undef PG8_WAIT_V_SEL
#undef PG8_BAR
#undef PG8_SCHED
}
}
#ifndef MK_ATTSKIP
#define MK_ATTSKIP 0
#endif
#ifndef MK_PPPROBE
#define MK_PPPROBE 0
#endif
#ifndef MK_YPRIO
#define MK_YPRIO 0
#endif
#ifndef MK_DMALATE
#define MK_DMALATE 0
#endif
#ifndef MK_VWPROBE
#define MK_VWPROBE 0
#endif
#ifndef MK_ATTPRIO
#define MK_ATTPRIO 0
#endif
namespace fox {
enum { ORDER_NATURAL = 0, ORDER_REVERSED = 1, ORDER_PAIRED = 2, ORDER_XCD = 4 };
constexpr int B = 8, H = 16, HKV = 16, SQ = 4096, SKV = 4096, D = 128;
constexpr int QOFF = 0;
constexpr int WINDOW = SKV;
constexpr float THR = 8.f;
constexpr bool WSKIP = false;
constexpr float SCALE = 0.08838834764831845f;
constexpr float QSCALE = SCALE * 1.4426950408889634f;
constexpr int NW = 8, QBLK = 32, KVBLK = 64, QB = NW * QBLK;
constexpr int SHM_V = KVBLK * D * 2, SHM_K = KVBLK * D * 2;
constexpr int NBUF = 3;
constexpr int LDS_FB = NBUF * SHM_V + NBUF * SHM_K;
constexpr int LDS_BYTES = LDS_FB + 2 * SKV * 4;
constexpr int OPITCH = H * D;
using bf16 = __hip_bfloat16;
typedef short bf16x8 __attribute__((ext_vector_type(8)));
typedef short s16x4 __attribute__((ext_vector_type(4)));
typedef float f32x16 __attribute__((ext_vector_type(16)));
typedef float f32x4 __attribute__((ext_vector_type(4)));
typedef unsigned u32x4 __attribute__((ext_vector_type(4)));
template <class A, class Bt> struct same_t { static constexpr bool v = false; };
template <class A> struct same_t<A, A> { static constexpr bool v = true; };

#define KSWZ(row, colB) ((row) * 256 + ((colB) ^ (((row) & 7) << 4)))
#define SBAR() __builtin_amdgcn_sched_barrier(0)
__device__ __forceinline__ int v_st(int k, int c) { const int kk = (k & ~0xC) | ((k & 4) << 1) | ((k & 8) >> 1); return ((kk >> 3) * 4 + (c >> 5)) * 512 + ((kk & 7) * 32 + (c & 31)) * 2; }
__device__ __forceinline__ int v_rd_base(int lane) { return ((lane & 3) << 3) | (((lane >> 2) & 3) << 6) | (((lane >> 4) & 1) << 5) | (((lane >> 5) & 1) << 8); }
constexpr int v_rd_off(int d0, int ks, int half) { return d0 * 512 + ks * 4096 + half * 2048; }
__device__ __forceinline__ int crow(int r, int hi) { return (r & 3) + 8 * (r >> 2) + 4 * hi; }
__device__ __forceinline__ unsigned cvtpk(float lo, float hi) {
    unsigned r; asm volatile("v_cvt_pk_bf16_f32 %0, %1, %2" : "=v"(r) : "v"(lo), "v"(hi)); return r;
}
__device__ __forceinline__ bf16x8 pack8(f32x4 a, f32x4 b) {
    u32x4 w = {cvtpk(a[0], a[1]), cvtpk(a[2], a[3]), cvtpk(b[0], b[1]), cvtpk(b[2], b[3])};
    return *reinterpret_cast<bf16x8*>(&w);
}
template <class T> __device__ __forceinline__ bf16x8 load8(const T* p) {
    if constexpr (same_t<T, float>::v) { return pack8(*(const f32x4*)p, *(const f32x4*)(p + 4)); }
    else { return *reinterpret_cast<const bf16x8*>(p); }
}
__device__ __forceinline__ void mask_tile(f32x16& p0, f32x16& p1, int dq, unsigned W) {
    const float NEG = -__builtin_inff();
#pragma unroll
    for (int r = 0; r < 16; ++r) {
        const int c = (r & 3) + 8 * (r >> 2);
        if ((unsigned)(dq - c) >= W) p0[r] = NEG;
        if ((unsigned)(dq - c - 32) >= W) p1[r] = NEG;
    }
}
__device__ __forceinline__ void partialSM(f32x16& p0, f32x16& p1, float& m_reg, float& mn, float& alpha) {
    float pmax = p0[0]; for (int r = 1; r < 16; ++r) pmax = fmaxf(pmax, p0[r]); for (int r = 0; r < 16; ++r) pmax = fmaxf(pmax, p1[r]);
    { auto rr = __builtin_amdgcn_permlane32_swap(__float_as_uint(pmax), __float_as_uint(pmax), false, false);
      pmax = fmaxf(__uint_as_float(rr[0]), __uint_as_float(rr[1])); }
    constexpr float THR2 = THR * 1.4426950408889634f;
    if (__builtin_expect(__all((pmax - m_reg) <= THR2), 1)) { mn = m_reg; alpha = 1.f; }
    else { mn = fmaxf(m_reg, pmax); alpha = __builtin_amdgcn_exp2f(m_reg - mn); m_reg = mn; }
    p0 = p0 - mn; p1 = p1 - mn;
    for (int r = 0; r < 16; ++r) p0[r] = __builtin_amdgcn_exp2f(p0[r]);
}
__device__ __forceinline__ void finishSM(f32x16& p0, f32x16& p1, float alpha, float& l_reg, bf16x8& pa0, bf16x8& pa1, bf16x8& pa2, bf16x8& pa3) {
    for (int r = 0; r < 16; ++r) p1[r] = __builtin_amdgcn_exp2f(p1[r]);
    typedef float f32x8_ __attribute__((ext_vector_type(8))); typedef float f32x2_ __attribute__((ext_vector_type(2)));
    const f32x16 s16 = p0 + p1; const f32x8_ s8 = s16.lo + s16.hi; const f32x4 s4 = s8.lo + s8.hi; const f32x2_ s2 = s4.lo + s4.hi; float ps = s2.x + s2.y;
    { auto rr = __builtin_amdgcn_permlane32_swap(__float_as_uint(ps), __float_as_uint(ps), false, false);
      ps = __uint_as_float(rr[0]) + __uint_as_float(rr[1]); }
    l_reg = l_reg * alpha + ps;
#define PK4(P, B_, OUT) do { unsigned a0 = cvtpk(P[B_+0], P[B_+1]), a1 = cvtpk(P[B_+2], P[B_+3]);                          \
        unsigned b0 = cvtpk(P[B_+4], P[B_+5]), b1 = cvtpk(P[B_+6], P[B_+7]);                                             \
        auto r0 = __builtin_amdgcn_permlane32_swap(a0, b0, false, false); auto r1 = __builtin_amdgcn_permlane32_swap(a1, b1, false, false); \
        u32x4 w = {r0[0], r1[0], r0[1], r1[1]}; OUT = *reinterpret_cast<bf16x8*>(&w); } while (0)
    PK4(p0, 0, pa0); PK4(p0, 8, pa1); PK4(p1, 0, pa2); PK4(p1, 8, pa3);
#undef PK4
}
template <int KB, bool SK>
__device__ __forceinline__ void qkt(f32x16& p0, f32x16& p1, const char* K_lds, int r32, int hi, const bf16x8* qr, bool act, const char* fb) {
    if (SK && !act) { const float NEG = -__builtin_inff();
#pragma unroll
        for (int r = 0; r < 16; ++r) { p0[r] = NEG; p1[r] = NEG; } return; }
#pragma unroll
    for (int q = 0; q < 4; ++q) { const f32x4 b0 = *reinterpret_cast<const f32x4*>(fb + q * 32), b1 = *reinterpret_cast<const f32x4*>(fb + 128 + q * 32);
#pragma unroll
        for (int i = 0; i < 4; ++i) { p0[4 * q + i] = b0[i]; p1[4 * q + i] = b1[i]; } }
    const char* kb[4];
#pragma unroll
    for (int dd = 0; dd < 4; ++dd) kb[dd] = K_lds + KB * SHM_K + KSWZ(r32, (dd * 16 + hi * 8) * 2);
    if (MK_ATTPRIO) __builtin_amdgcn_s_setprio(1);
#pragma unroll
    for (int d0 = 0; d0 < 8; ++d0) { const char* a = kb[d0 & 3] + (d0 >> 2) * 128;
        bf16x8 b0 = *reinterpret_cast<const bf16x8*>(a);
        bf16x8 b1 = *reinterpret_cast<const bf16x8*>(a + 32 * 256);
        p0 = __builtin_amdgcn_mfma_f32_32x32x16_bf16(b0, qr[d0], p0, 0, 0, 0);
        p1 = __builtin_amdgcn_mfma_f32_32x32x16_bf16(b1, qr[d0], p1, 0, 0, 0); }
    if (MK_ATTPRIO) __builtin_amdgcn_s_setprio(0);
}
template <bool SK>
__device__ __forceinline__ void qkt_x(f32x16& p0, f32x16& p1, const char* K_lds, int r32, int hi, const bf16x8* qr, bool act, const char* fb) {
    const int k0a = (int)(uintptr_t)K_lds + KSWZ(r32, (0 * 16 + hi * 8) * 2), k1a = (int)(uintptr_t)K_lds + KSWZ(r32, (1 * 16 + hi * 8) * 2), k2a = (int)(uintptr_t)K_lds + KSWZ(r32, (2 * 16 + hi * 8) * 2), k3a = (int)(uintptr_t)K_lds + KSWZ(r32, (3 * 16 + hi * 8) * 2);
#define KRD(dst, a, off) asm volatile("ds_read_b128 %0, %1 offset:%2" : "=&v"(dst) : "v"(a), "i"(off) : "memory")
#define K_LD(R, A0, A1, off) do { KRD(R##0, A0, off); KRD(R##1, A0, off + 8192); KRD(R##2, A1, off); KRD(R##3, A1, off + 8192); } while (0)
#define K_MM(R, d) do { p0 = __builtin_amdgcn_mfma_f32_32x32x16_bf16(R##0, qr[d + 0], p0, 0, 0, 0); p1 = __builtin_amdgcn_mfma_f32_32x32x16_bf16(R##1, qr[d + 0], p1, 0, 0, 0); \
        p0 = __builtin_amdgcn_mfma_f32_32x32x16_bf16(R##2, qr[d + 1], p0, 0, 0, 0); p1 = __builtin_amdgcn_mfma_f32_32x32x16_bf16(R##3, qr[d + 1], p1, 0, 0, 0); } while (0)
#define K_W(n, R) asm volatile("s_waitcnt lgkmcnt(" #n ")" : "+v"(R##0), "+v"(R##1), "+v"(R##2), "+v"(R##3) :: "memory")
    bf16x8 ka0, ka1, ka2, ka3, kb0, kb1, kb2, kb3;
    K_LD(ka, k0a, k1a, 0); K_LD(kb, k2a, k3a, 0);
#pragma unroll
    for (int q = 0; q < 4; ++q) { const f32x4 b0 = *reinterpret_cast<const f32x4*>(fb + q * 32), b1 = *reinterpret_cast<const f32x4*>(fb + 128 + q * 32);
#pragma unroll
        for (int i = 0; i < 4; ++i) { p0[4 * q + i] = b0[i]; p1[4 * q + i] = b1[i]; } }
    K_W(12, ka);
    K_MM(ka, 0); K_LD(ka, k0a, k1a, 128);
    K_W(4, kb); K_MM(kb, 2); K_LD(kb, k2a, k3a, 128);
    K_W(4, ka); K_MM(ka, 4);
    K_W(0, kb); K_MM(kb, 6);
#undef K_W
#undef K_MM
#undef K_LD
#undef KRD
}
template <int VB, bool SK>
__device__ __forceinline__ void pv_tile(f32x16* o, int vb0, bf16x8 pa0, bf16x8 pa1, bf16x8 pa2, bf16x8 pa3, bool act) {
    if (SK && !act) return;
#define TRRD(dst, off) asm volatile("ds_read_b64_tr_b16 %0, %1 offset:%2" : "=&v"(dst) : "v"(vb0), "i"(off) : "memory")
#define PV_D0(d0) do { s16x4 l0, l1, l2, l3, h0, h1, h2, h3; constexpr int b_ = VB * SHM_V + v_rd_off(d0, 0, 0);     \
        TRRD(l0, b_); TRRD(h0, b_ + 2048); TRRD(l1, b_ + 4096); TRRD(h1, b_ + 6144); TRRD(l2, b_ + 8192); TRRD(h2, b_ + 10240); TRRD(l3, b_ + 12288); TRRD(h3, b_ + 14336); \
        asm volatile("s_waitcnt lgkmcnt(0)" ::: "memory"); SBAR();                 \
        o[d0] = __builtin_amdgcn_mfma_f32_32x32x16_bf16((bf16x8){l0[0], l0[1], l0[2], l0[3], h0[0], h0[1], h0[2], h0[3]}, pa0, o[d0], 0, 0, 0);   \
        o[d0] = __builtin_amdgcn_mfma_f32_32x32x16_bf16((bf16x8){l1[0], l1[1], l1[2], l1[3], h1[0], h1[1], h1[2], h1[3]}, pa1, o[d0], 0, 0, 0);   \
        o[d0] = __builtin_amdgcn_mfma_f32_32x32x16_bf16((bf16x8){l2[0], l2[1], l2[2], l2[3], h2[0], h2[1], h2[2], h2[3]}, pa2, o[d0], 0, 0, 0);   \
        o[d0] = __builtin_amdgcn_mfma_f32_32x32x16_bf16((bf16x8){l3[0], l3[1], l3[2], l3[3], h3[0], h3[1], h3[2], h3[3]}, pa3, o[d0], 0, 0, 0); } while (0)
    if (MK_ATTPRIO) __builtin_amdgcn_s_setprio(1);
    PV_D0(0); PV_D0(1); PV_D0(2); PV_D0(3);
    if (MK_ATTPRIO) __builtin_amdgcn_s_setprio(0);
#undef PV_D0
#undef TRRD
}
template <bool SK>
__device__ __forceinline__ void pv_tile_x(f32x16* o, int vb, bf16x8 pa0, bf16x8 pa1, bf16x8 pa2, bf16x8 pa3, bool act) {
    if (SK && !act) return;
#define TRRD(dst, off) asm volatile("ds_read_b64_tr_b16 %0, %1 offset:%2" : "=&v"(dst) : "v"(vb), "i"(off) : "memory")
#define PV_LD(R, d0) do { constexpr int b_ = v_rd_off(d0, 0, 0); TRRD(R##0, b_); TRRD(R##1, b_ + 2048); TRRD(R##2, b_ + 4096); TRRD(R##3, b_ + 6144); TRRD(R##4, b_ + 8192); TRRD(R##5, b_ + 10240); TRRD(R##6, b_ + 12288); TRRD(R##7, b_ + 14336); } while (0)
#define PV_J(l, h) ((bf16x8){l[0], l[1], l[2], l[3], h[0], h[1], h[2], h[3]})
#define PV_MM(R, d0) do { o[d0] = __builtin_amdgcn_mfma_f32_32x32x16_bf16(PV_J(R##0, R##1), pa0, o[d0], 0, 0, 0); o[d0] = __builtin_amdgcn_mfma_f32_32x32x16_bf16(PV_J(R##2, R##3), pa1, o[d0], 0, 0, 0); \
        o[d0] = __builtin_amdgcn_mfma_f32_32x32x16_bf16(PV_J(R##4, R##5), pa2, o[d0], 0, 0, 0); o[d0] = __builtin_amdgcn_mfma_f32_32x32x16_bf16(PV_J(R##6, R##7), pa3, o[d0], 0, 0, 0); } while (0)
#define PV_W(n, R) asm volatile("s_waitcnt lgkmcnt(" #n ")" : "+v"(R##0), "+v"(R##1), "+v"(R##2), "+v"(R##3), "+v"(R##4), "+v"(R##5), "+v"(R##6), "+v"(R##7) :: "memory")
    s16x4 fa0, fa1, fa2, fa3, fa4, fa5, fa6, fa7, fb0, fb1, fb2, fb3, fb4, fb5, fb6, fb7;
    PV_LD(fa, 0); PV_LD(fb, 1);
    PV_W(8, fa); PV_MM(fa, 0); PV_LD(fa, 2);
    PV_W(8, fb); PV_MM(fb, 1); PV_LD(fb, 3);
    PV_W(8, fa); PV_MM(fa, 2);
    PV_W(0, fb); PV_MM(fb, 3);
#undef PV_W
#undef PV_MM
#undef PV_J
#undef PV_LD
#undef TRRD
}
template <class TIn, class TOut> struct BlockRef { const TIn* Q; const TIn* K; const TIn* V; TOut* O; const float* FB; int P0; };
template <class TIn> struct Seam { bf16x8 qr[8]; int b0, fp; };
#define FOX_LAS __attribute__((address_space(3)))
#define VMW() asm volatile("s_waitcnt vmcnt(0)" ::: "memory")
struct DmaMap { unsigned k0, k1, v0, v1, kl, vl; };
__device__ __forceinline__ DmaMap dma_map(char* lds, int wid, int lane) {
    DmaMap m;
#pragma unroll
    for (int j = 0; j < 2; ++j) {
        const int pk = wid * 2 + j;
        const int r = pk * 4 + (lane >> 4), p = lane & 15, c = p ^ (r & 7);
        const unsigned ko = (unsigned)(r * 256 + c * 16);
        const int s = pk * 2 + (lane >> 5), kk = (s >> 2) * 8 + ((lane & 31) >> 2), cc = (s & 3) * 32 + (lane & 3) * 8;
        const int k = (kk & ~0xC) | ((kk & 4) << 1) | ((kk & 8) >> 1);
        const unsigned vo = (unsigned)(k * 256 + cc * 2);
        if (j == 0) { m.k0 = ko; m.v0 = vo; } else { m.k1 = ko; m.v1 = vo; }
    }
    m.kl = (unsigned)(uintptr_t)(lds + NBUF * SHM_V) + (unsigned)wid * 2048u; m.vl = (unsigned)(uintptr_t)lds + (unsigned)wid * 2048u;
    return m;
}
#define DMA_TILE(Kp, Vp, kb_, buf_) do { const char* kp_ = (const char*)(Kp) + (size_t)(kb_) * (D * 2); const char* vp_ = (const char*)(Vp) + (size_t)(kb_) * (D * 2);                 \
        __builtin_amdgcn_global_load_lds((const unsigned*)(kp_ + M.k0), (FOX_LAS unsigned*)(M.kl + (unsigned)(buf_) * SHM_K), 16, 0, 0);                                           \
        __builtin_amdgcn_global_load_lds((const unsigned*)(kp_ + M.k1), (FOX_LAS unsigned*)(M.kl + (unsigned)(buf_) * SHM_K + 1024u), 16, 0, 0);                                   \
        __builtin_amdgcn_global_load_lds((const unsigned*)(vp_ + M.v0), (FOX_LAS unsigned*)(M.vl + (unsigned)(buf_) * SHM_V), 16, 0, 0);                                           \
        __builtin_amdgcn_global_load_lds((const unsigned*)(vp_ + M.v1), (FOX_LAS unsigned*)(M.vl + (unsigned)(buf_) * SHM_V + 1024u), 16, 0, 0); } while (0)
#define BIAS_DMA(FBp, nk, img) do { const int np_ = (nk) >> 8; const unsigned fl_ = (unsigned)(uintptr_t)(lds + LDS_FB) + (unsigned)(img) * (SKV * 4);                       \
        for (int pc_ = wid; pc_ < np_; pc_ += NW) __builtin_amdgcn_global_load_lds((const unsigned*)((const char*)(FBp) + pc_ * 1024 + lane * 16), (FOX_LAS unsigned*)(fl_ + (unsigned)pc_ * 1024u), 16, 0, 0); } while (0)
template <class TIn, class TOut>
__device__ __forceinline__ void causal_swa_prime(const BlockRef<TIn, TOut>& cur, int W, char* lds, Seam<TIn>& S) {
    static_assert(!same_t<TIn, float>::v, "bf16 q/k/v only");
    const int tid = ltid(), wid = __builtin_amdgcn_readfirstlane(tid >> 6), lane = tid & 63, r32 = lane & 31, hi = lane >> 5;
    const DmaMap M = dma_map(lds, wid, lane);
    DMA_TILE(cur.K, cur.V, 0, 0); S.b0 = 0; BIAS_DMA(cur.FB, cur.P0 + QB, 0); S.fp = 0;
    for (int d0 = 0; d0 < 8; ++d0) S.qr[d0] = load8<TIn>(cur.Q + (size_t)(wid * QBLK + r32) * D + d0 * 16 + hi * 8);
    VMW(); __syncthreads();
}
template <class TIn, class TOut>
__device__ __forceinline__ void causal_swa_block(const BlockRef<TIn, TOut>& cur, const BlockRef<TIn, TOut>& nxt, int skv, int W, char* lds, Seam<TIn>& S) {
    static_assert(!same_t<TIn, float>::v && !same_t<TOut, float>::v, "bf16 q/k/v/o only");
    const int tid = ltid(), wid = __builtin_amdgcn_readfirstlane(tid >> 6), lane = tid & 63, r32 = lane & 31, hi = lane >> 5;
    const int NT = (cur.P0 + QB) / KVBLK;
    const int qlo = cur.P0 + wid * QBLK, qm = qlo + r32 - 4 * hi;
    char* V_lds = lds; char* K_lds = lds + NBUF * SHM_V;
    float m_reg = -1e30f, l_reg = 0; f32x16 o[4] = {};
    float* fbuf = (float*)(lds + LDS_FB) + S.fp * SKV;
    BIAS_DMA(nxt.FB, nxt.P0 + QB, S.fp ^ 1);
    const char* fbl = (const char*)fbuf + hi * 16;
    m_reg = fbuf[cur.P0 + wid * QBLK + r32];
    const int vb0 = (int)(uintptr_t)V_lds + v_rd_base(lane);
    const DmaMap M = dma_map(lds, wid, lane);
    const TIn* Kh = cur.K; const TIn* Vh = cur.V;
#if MK_VWPROBE
    unsigned long long vwp_acc = 0, vwp_t0 = 0;
#define VWP_T0() do { if (wid == 0) vwp_t0 = __builtin_amdgcn_s_memtime(); } while (0)
#define VWP_T1() do { if (wid == 0) vwp_acc += __builtin_amdgcn_s_memtime() - vwp_t0; } while (0)
#else
#define VWP_T0() do {} while (0)
#define VWP_T1() do {} while (0)
#endif
    constexpr bool SK = MK_ATTSKIP;
#define RESC(a) do { if (__any((a) < 1.f)) { for (int d_ = 0; d_ < 4; ++d_) o[d_] = o[d_] * (a); } } while (0)
#define KBASE(t) ((t) * KVBLK)
#define ACT(t) (!SK || KBASE(t) <= qlo + QBLK - 1)
#define NXB(b) ((b) == NBUF - 1 ? 0 : (b) + 1)
#define MASKT(P0_, P1_, t) do { const int kb_ = KBASE(t); if (kb_ + KVBLK - 1 > qlo) mask_tile(P0_, P1_, qm - kb_, (unsigned)W); } while (0)
    f32x16 pA0, pA1, pB0, pB1; float mnA, mnB, alA, alB; bf16x8 pa0, pa1, pa2, pa3;
    const int b0 = S.b0; int kbt = NXB(b0);
    if (NT > 1) DMA_TILE(Kh, Vh, KBASE(1), kbt);
    SBAR(); qkt_x<SK>(pA0, pA1, K_lds + b0 * SHM_K, r32, hi, S.qr, ACT(0), fbl + KBASE(0) * 4);
    MASKT(pA0, pA1, 0); partialSM(pA0, pA1, m_reg, mnA, alA);
    VMW(); __syncthreads();
#define HALF_STEP3(PX0, PX1, mnX, alX, PY0, PY1, alY, t) do {                                                                 \
        const int bt_ = kbt, bp_ = (kbt == 0 ? NBUF - 1 : kbt - 1), bn_ = NXB(kbt);                                           \
        if (!MK_DMALATE && (t) + 1 < NT) DMA_TILE(Kh, Vh, KBASE((t) + 1), bn_);                                               \
        SBAR(); qkt_x<SK>(PX0, PX1, K_lds + bt_ * SHM_K, r32, hi, S.qr, ACT(t), fbl + KBASE(t) * 4);                         \
        if (MK_DMALATE && (t) + 1 < NT) { SBAR(); DMA_TILE(Kh, Vh, KBASE((t) + 1), bn_); SBAR(); }     \
        finishSM(PY0, PY1, alY, l_reg, pa0, pa1, pa2, pa3); SBAR();                                                           \
        pv_tile_x<SK>(o, vb0 + bp_ * SHM_V, pa0, pa1, pa2, pa3, ACT((t) - 1)); MASKT(PX0, PX1, (t)); partialSM(PX0, PX1, m_reg, mnX, alX); \
        RESC(alX); VWP_T0(); VMW(); VWP_T1(); __syncthreads(); kbt = bn_; } while (0)
    for (int t = 1; t + 1 < NT; t += 2) {
        HALF_STEP3(pB0, pB1, mnB, alB, pA0, pA1, alA, t);
        HALF_STEP3(pA0, pA1, mnA, alA, pB0, pB1, alB, t + 1);
    }
    const int bl_ = kbt, blp_ = (kbt == 0 ? NBUF - 1 : kbt - 1), bf_ = 3 - bl_ - blp_;
    const bool even = (NT & 1) == 0;
    if (even) { SBAR(); qkt_x<SK>(pB0, pB1, K_lds + bl_ * SHM_K, r32, hi, S.qr, ACT(NT - 1), fbl + KBASE(NT - 1) * 4); SBAR(); }
    DMA_TILE(nxt.K, nxt.V, 0, bf_); S.b0 = bf_; S.fp ^= 1; SBAR();
#pragma unroll
    for (int d0 = 0; d0 < 8; ++d0) S.qr[d0] = load8<TIn>(nxt.Q + (size_t)(wid * QBLK + r32) * D + d0 * 16 + hi * 8);
    SBAR();
    finishSM(pA0, pA1, alA, l_reg, pa0, pa1, pa2, pa3); SBAR();
    pv_tile_x<SK>(o, vb0 + blp_ * SHM_V, pa0, pa1, pa2, pa3, ACT(even ? NT - 2 : NT - 1));
    if (even) { MASKT(pB0, pB1, NT - 1); partialSM(pB0, pB1, m_reg, mnB, alB); RESC(alB);
        finishSM(pB0, pB1, alB, l_reg, pa0, pa1, pa2, pa3); SBAR(); pv_tile_x<SK>(o, vb0 + bl_ * SHM_V, pa0, pa1, pa2, pa3, ACT(NT - 1)); }
    SBAR();
    { const float rl = __builtin_amdgcn_rcpf(l_reg);
      TOut* Ow = cur.O + (size_t)(wid * QBLK + r32) * OPITCH + 8 * hi;
#pragma unroll
      for (int d0 = 0; d0 < 4; ++d0) { const f32x16 v = o[d0] * rl;
#pragma unroll
        for (int hf = 0; hf < 2; ++hf) { const unsigned a0 = cvtpk(v[8 * hf + 0], v[8 * hf + 1]), a1 = cvtpk(v[8 * hf + 2], v[8 * hf + 3]), b0_ = cvtpk(v[8 * hf + 4], v[8 * hf + 5]), b1_ = cvtpk(v[8 * hf + 6], v[8 * hf + 7]);
            auto r0 = __builtin_amdgcn_permlane32_swap(a0, b0_, false, false); auto r1 = __builtin_amdgcn_permlane32_swap(a1, b1_, false, false);
            u32x4 w = {r0[0], r1[0], r0[1], r1[1]};
            *(u32x4*)(Ow + d0 * 32 + 16 * hf) = w; } } }
#if MK_VWPROBE
    if (wid == 0 && lane == 0 && blockIdx.x == 0) *(volatile unsigned*)(lds + 155648 + 320 + 40 * 4) += (unsigned)(vwp_acc / 4);
#endif
    VMW(); __syncthreads();
#undef RESC
#undef KBASE
#undef ACT
#undef NXB
#undef MASKT
#undef HALF_STEP3
#undef VWP_T0
#undef VWP_T1
}
#undef VMW
#undef BIAS_DMA
#undef DMA_TILE
constexpr int NQB = SQ / QB, NXI = NQB / 2, NITEMS = NXI * B * H;
struct SwaItem { int bh, qb0, qb1; };
__device__ __forceinline__ SwaItem swa_decode(int L, bool grp) { SwaItem it; const int xcd = L & 7, k = L >> 3; it.bh = grp ? xcd * H + (k / NXI) : (k / NXI) * 8 + xcd; const int x = k % NXI; it.qb0 = x; it.qb1 = NQB - 1 - x; return it; }
template <class TIn, class TOut>
__device__ __forceinline__ BlockRef<TIn, TOut> swa_ref(const SwaItem& it, int pass, const TIn* Q, const TIn* K, const TIn* V, TOut* O, const float* FB) {
    const int qb = pass ? it.qb1 : it.qb0;
    BlockRef<TIn, TOut> r;
    r.Q = Q + ((size_t)it.bh * SQ + (size_t)qb * QB) * D;
    r.O = O + ((size_t)(it.bh / H) * SQ + (size_t)qb * QB) * OPITCH + (it.bh % H) * D;
    r.K = K + (size_t)it.bh * SKV * D; r.V = V + (size_t)it.bh * SKV * D; r.FB = FB + (size_t)it.bh * SKV; r.P0 = qb * QB;
    return r;
}
__device__ __forceinline__ void att_phase(char* lds, const bf16* Q, const bf16* K, const bf16* V, bf16* O, const float* FB, int wg, int nwg, bool grp) {
    int L = wg; if (L >= NITEMS) return;
    SwaItem it = swa_decode(L, grp); int pass = 0;
    BlockRef<bf16, bf16> cur = swa_ref<bf16, bf16>(it, 0, Q, K, V, O, FB);
    Seam<bf16> S;
    causal_swa_prime<bf16, bf16>(cur, WINDOW, lds, S);
    for (;;) {
        const bool more_pass = pass == 0 && it.qb1 != it.qb0, more_item = L + nwg < NITEMS, last = !more_pass && !more_item;
        SwaItem itn = it; int passn = pass + 1, Ln = L;
        if (!more_pass) { passn = 0; Ln = more_item ? L + nwg : L; itn = swa_decode(Ln, grp); }
        const BlockRef<bf16, bf16> nxt = last ? cur : swa_ref<bf16, bf16>(itn, passn, Q, K, V, O, FB);
        causal_swa_block<bf16, bf16>(cur, nxt, SKV, WINDOW, lds, S);
        if (last) break;
        cur = nxt; it = itn; pass = passn; L = Ln;
    }
}
}
constexpr int DM = 2048, NBATCH = 8, SEQ = 4096, DEPTH = 4, NHEAD = 16, HDIM = 128, DFF = 5504, NFF2 = 2 * DFF, MTOK = NBATCH * SEQ;
constexpr int NQKVF = 3 * DM + NHEAD;
constexpr float EPS = 1e-6f;
constexpr int NWAVES = 8;
#ifndef MK_BARBLK
#define MK_BARBLK 0
#endif
#define BARPROBE_BLK(b) (MK_BARBLK == 0 ? true : MK_BARBLK == 1 ? ((b) < 128) : MK_BARBLK == 2 ? ((b) >= 128) : true)
#ifndef MK_PROA_SHARE
#define MK_PROA_SHARE 54
#endif
#ifndef MK_PER_PHASE
#define MK_PER_PHASE 0
#endif
constexpr size_t MiB = 1u << 20;
constexpr size_t WS_CTL = 0, CTL_ZERO_BYTES = 3 * MiB + 512 * 1024;
constexpr size_t WS_RSSF = 256 * 1024, WS_PCNT = 896 * 1024;
constexpr size_t WS_RSS = 1 * MiB;
constexpr size_t WS_VSS = 3 * MiB;
constexpr size_t WS_MOD = 3 * MiB + 512 * 1024;
constexpr size_t WS_SHT = 5 * MiB;
constexpr size_t WS_BIASV = 5 * MiB + 512 * 1024;
constexpr size_t WS_LOGF = 7 * MiB + 512 * 1024;
constexpr size_t WS_FB = 9 * MiB + 512 * 1024;
constexpr size_t WS_WQKV = 12 * MiB;
constexpr size_t WQKV_STRIDE = 25 * MiB / 2;
constexpr size_t WS_WO = 62 * MiB;
constexpr size_t WS_WGI = 78 * MiB;
constexpr size_t WS_WGO = 110 * MiB;
constexpr size_t WS_WF1 = 126 * MiB;
constexpr size_t WS_WF2 = 298 * MiB;
constexpr size_t WS_H = 384 * MiB;
constexpr size_t WS_H2 = 512 * MiB;
constexpr size_t WS_XB = 640 * MiB;
constexpr size_t WS_R = 768 * MiB;
constexpr size_t WS_ACT = WS_R + 384 * MiB;
constexpr size_t WS_END = WS_ACT + 366 * MiB;
constexpr int BV_QKVF = 0, BV_GI = 2 * 8 * NQKVF, BV_F1 = BV_GI + 2 * 8 * 4096;
constexpr int CW_TMO = 0, CW_BAR = 4096;

constexpr int RING_OFF = 0, RING_BYTES = 131072, XCH_OFF = 131072;
constexpr int CWT_OFF = 131072 + 14336;
constexpr int LDSCTL_OFF = 155648, MISC_OFF = LDSCTL_OFF + 320;
constexpr int LDS_BYTES = 159744;

#define GAS __attribute__((address_space(1)))
#define LAS __attribute__((address_space(3)))
typedef unsigned short bf16;
typedef unsigned v4u __attribute__((ext_vector_type(4)));
typedef unsigned v2u __attribute__((ext_vector_type(2)));
typedef float f32x4 __attribute__((ext_vector_type(4)));
typedef short bf16x8 __attribute__((ext_vector_type(8)));
typedef GAS unsigned gu32;
typedef unsigned long long u64;
constexpr float FIXS = 1048576.0f, FIXI = 1.0f / (1048576.0f * 2048.0f);
__device__ __forceinline__ float rstd_of(u64 v) { return __builtin_amdgcn_rsqf((float)v * FIXI + 1e-6f); }
#define RLX_AGENT __ATOMIC_RELAXED, __HIP_MEMORY_SCOPE_AGENT
#define LDS_WAIT() asm volatile("s_waitcnt lgkmcnt(0)" ::: "memory")
#define VM_WAIT() asm volatile("s_waitcnt vmcnt(0)" ::: "memory")
__device__ __forceinline__ unsigned f2bf(float f) { unsigned u = __builtin_bit_cast(unsigned, f); return (u + 0x7fffu + ((u >> 16) & 1u)) >> 16; }
__device__ __forceinline__ unsigned pk2(float lo, float hi) { return f2bf(lo) | (f2bf(hi) << 16); }
__device__ __forceinline__ float bf2f(unsigned short b) { return __builtin_bit_cast(float, (unsigned)b << 16); }
__device__ __forceinline__ float bflo(unsigned w) { return __builtin_bit_cast(float, w << 16); }
__device__ __forceinline__ float bfhi(unsigned w) { return __builtin_bit_cast(float, w & 0xffff0000u); }
#define XB_TMO      128
#define XB_XCNT(j)  (256  + 64 * (j))
#define XB_XSUB(j)  (1280 + 64 * (j))
#define XB_XGEN(j)  (2304 + 64 * (j))
#define XB_TOP      3328
#define XB_TOPGEN   3392
#define XCD_BAR_WORDS 3456
#define XB_SPIN_CAP (1u << 18)

__device__ __forceinline__ unsigned xb_ld(unsigned* p)              { return __hip_atomic_load((GAS unsigned*)p, __ATOMIC_RELAXED, __HIP_MEMORY_SCOPE_AGENT); }
__device__ __forceinline__ unsigned xb_add(unsigned* p, unsigned v) { return __hip_atomic_fetch_add((GAS unsigned*)p, v, __ATOMIC_RELAXED, __HIP_MEMORY_SCOPE_AGENT); }
__device__ __forceinline__ unsigned xb_xcc_id() { return (unsigned)__builtin_amdgcn_s_getreg((3 << 11) | 20) & 0xFu; }
#define XB_SPIN(cond, bar) do { unsigned _sp = 0; while (cond) { __builtin_amdgcn_s_sleep(1); \
    if ((++_sp & 255u) == 0u) { if (xb_ld(&(bar)[XB_TMO])) break; if (_sp > XB_SPIN_CAP) { xb_add(&(bar)[XB_TMO], 1u); break; } } } } while (0)

struct XcdBarrier {
    unsigned* bar; unsigned x, total;
    volatile LAS unsigned* st;
};

__device__ __forceinline__ XcdBarrier xcd_barrier_post(unsigned* bar, volatile LAS unsigned* st) {
    XcdBarrier b; b.bar = bar; b.x = xb_xcc_id(); b.st = st; b.total = gridDim.x * gridDim.y * gridDim.z;
    if (threadIdx.x == 0) (void)xb_add(&bar[XB_XCNT(b.x)], 1u);
    return b;
}
__device__ __forceinline__ void xcd_barrier_complete(unsigned* bar, unsigned x, unsigned G, unsigned& nloc, unsigned& nx) {
    unsigned sum, cnt, mine, sp = 0u;
    for (;;) {
        sum = 0u; cnt = 0u; mine = 0u;
#pragma unroll
        for (unsigned j = 0; j < 16; ++j) { const unsigned c = xb_ld(&bar[XB_XCNT(j)]); sum += c; cnt += (c > 0u) ? 1u : 0u; mine = (j == x) ? c : mine; }
        if (sum == G) break;
        __builtin_amdgcn_s_sleep(1);
        if ((++sp & 255u) == 0u) { if (xb_ld(&bar[XB_TMO])) break; if (sp > XB_SPIN_CAP) { xb_add(&bar[XB_TMO], 1u); break; } }
    }
    nloc = mine > 0u ? mine : 1u; nx = cnt > 0u ? cnt : 1u;
}

__device__ __forceinline__ void xcd_barrier(const XcdBarrier& b) {
#if defined(MK_BARPROBE) && MK_BARPROBE
    const unsigned long long bpt0_ = __builtin_amdgcn_s_memrealtime();
#endif
    asm volatile("s_waitcnt vmcnt(0)" ::: "memory");
    __syncthreads();
    if (threadIdx.x == 0) {
        unsigned* bar = b.bar;
        __builtin_amdgcn_s_waitcnt(0);
        unsigned nloc = b.st[0], nx = b.st[1];
        if (nloc == 0u) { xcd_barrier_complete(bar, b.x, b.total, nloc, nx); b.st[0] = nloc; b.st[1] = nx; }
        const unsigned old = xb_add(&bar[XB_XSUB(b.x)], 1u);
        const unsigned gen = old / nloc;
        if (old + 1u == (gen + 1u) * nloc) {
            __builtin_amdgcn_fence(__ATOMIC_RELEASE, "agent");
            asm volatile("s_waitcnt vmcnt(0)" ::: "memory");
            const unsigned og = xb_add(&bar[XB_TOP], 1u);
            const unsigned tg = og / nx;
            if (og + 1u == (tg + 1u) * nx) xb_add(&bar[XB_TOPGEN], 1u);
            else XB_SPIN(xb_ld(&bar[XB_TOPGEN]) == tg, bar);
            __builtin_amdgcn_fence(__ATOMIC_ACQUIRE, "agent");
            xb_add(&bar[XB_XGEN(b.x)], 1u);
            asm volatile("s_waitcnt vmcnt(0)" ::: "memory");
        } else {
            XB_SPIN(xb_ld(&bar[XB_XGEN(b.x)]) == gen, bar);
            __builtin_amdgcn_fence(__ATOMIC_ACQUIRE, "agent");
            asm volatile("s_waitcnt vmcnt(0)" ::: "memory");
        }
#if defined(MK_BARPROBE) && MK_BARPROBE
        if (b.st[33] && BARPROBE_BLK(blockIdx.x)) __hip_atomic_fetch_add((GAS unsigned long long*)(bar + 3600), __builtin_amdgcn_s_memrealtime() - bpt0_, __ATOMIC_RELAXED, __HIP_MEMORY_SCOPE_AGENT);
#endif
    }
    __syncthreads();
}
struct Frame {
    LAS unsigned char* lds; char* ldsg;
    volatile LAS unsigned* MISC;
    int tid, lane, wave, vcu, G, bid;
    const GAS float* const __attribute__((address_space(4)))* inp;
    GAS float* outg; GAS unsigned char* wsg;
    __device__ __forceinline__ const float* in(int i) const { return (const float*)inp[i]; }
};
enum { IN_X = 0, IN_C, IN_MODW, IN_MODB, IN_MIXG, IN_FFNG, IN_AWIN, IN_ABF, IN_AWO, IN_GWIN, IN_GVG, IN_GWS, IN_GBS, IN_GWO, IN_FWIN, IN_FCW, IN_FCB, IN_FWOUT, IN_FING };
enum { MW_BID = 16, MW_G, MW_VCU, MW_INP, MW_INP_HI, MW_WS, MW_WS_HI, MW_OUT, MW_OUT_HI };
__device__ __forceinline__ unsigned misc_rd(const Frame& F, int k) { return (unsigned)__builtin_amdgcn_readfirstlane((int)F.MISC[k]); }
__device__ __forceinline__ bool relaunder(Frame& F) {
    int t = (int)threadIdx.x; asm volatile("" : "+v"(t)); F.tid = t; F.lane = t & 63; F.wave = __builtin_amdgcn_readfirstlane(t >> 6);
    F.bid = (int)misc_rd(F, MW_BID); F.G = (int)misc_rd(F, MW_G); F.vcu = (int)misc_rd(F, MW_VCU);
    F.inp = (const GAS float* const __attribute__((address_space(4)))*)(((unsigned long long)misc_rd(F, MW_INP_HI) << 32) | misc_rd(F, MW_INP));
    F.wsg = (GAS unsigned char*)(((unsigned long long)misc_rd(F, MW_WS_HI) << 32) | misc_rd(F, MW_WS));
    F.outg = (GAS float*)(((unsigned long long)misc_rd(F, MW_OUT_HI) << 32) | misc_rd(F, MW_OUT));
    return true; }
__device__ __forceinline__ void stagger(const Frame& F, unsigned ticks) {
    if (ticks && ((F.bid >> 3) & 1)) { const unsigned long long t0 = __builtin_amdgcn_s_memrealtime(); while (__builtin_amdgcn_s_memrealtime() - t0 < ticks) __builtin_amdgcn_s_sleep(16); }
}
__device__ __forceinline__ float wave_sum(float v) {
#pragma unroll
    for (int o = 1; o < 64; o <<= 1) v += __shfl_xor(v, o);
    return v;
}
__device__ __forceinline__ void transpose_item(const float* W, int ldw, int K, bf16* WT, int k0, int n0, int dst_row0, int ncols, LAS float* scr, int lane) {
    const int nl = lane & 31;
    if (ncols == 32) {
        const int n4 = (lane & 7) * 4, kr = lane >> 3; f32x4 t[8];
#pragma unroll
        for (int i = 0; i < 8; ++i) t[i] = *(const GAS f32x4*)(W + (size_t)(k0 + 8 * i + kr) * ldw + n0 + n4);
#pragma unroll
        for (int i = 0; i < 8; ++i) { LAS float* d = scr + (8 * i + kr) * 33 + n4; d[0] = t[i].x; d[1] = t[i].y; d[2] = t[i].z; d[3] = t[i].w; }
    } else {
#pragma unroll 8
        for (int i = 0; i < 32; ++i) { const int kk = 2 * i + (lane >> 5); if (nl < ncols) scr[kk * 33 + nl] = W[(size_t)(k0 + kk) * ldw + n0 + nl]; } }
    LDS_WAIT(); asm volatile("" ::: "memory");
    const int c = lane & 7;
#pragma unroll
    for (int j = 0; j < 4; ++j) { const int n = (lane >> 3) + 8 * j; const LAS float* s = scr + (8 * c) * 33 + n;
        if (n < ncols) { v4u o; o.x = pk2(s[0 * 33], s[1 * 33]); o.y = pk2(s[2 * 33], s[3 * 33]); o.z = pk2(s[4 * 33], s[5 * 33]); o.w = pk2(s[6 * 33], s[7 * 33]);
            *(GAS v4u*)(WT + (size_t)(dst_row0 + n) * K + k0 + 8 * c) = o; } }
    LDS_WAIT(); asm volatile("" ::: "memory");
}
__device__ __forceinline__ void pro_a_phase(Frame& F) {
    __syncthreads();
    {
        LAS float* cact = (LAS float*)(F.lds + RING_OFF);
        LAS float* red = (LAS float*)(F.lds + RING_OFF + 65536);
        float* mod = (float*)((unsigned char*)F.wsg + WS_MOD); float* sht = (float*)((unsigned char*)F.wsg + WS_SHT);
        for (int item = F.bid; item < 192; item += F.G) {
            for (int idx = F.tid; idx < NBATCH * DM; idx += NWAVES * 64) { const int b = idx >> 11, k = idx & 2047; const float v = F.in(IN_C)[idx]; cact[k * 8 + b] = v / (1.0f + __expf(-v)); }
            __syncthreads();
            const int i = item / 48, nbase = (item % 48) * 256;
            const float* wp = F.in(IN_MODW) + ((size_t)i * DM + F.wave * 256) * 12288 + nbase + F.lane * 4;
            f32x4 acc[8];
#pragma unroll
            for (int b = 0; b < 8; ++b) acc[b] = (f32x4){0.f, 0.f, 0.f, 0.f};
#pragma unroll 8
            for (int kk = 0; kk < 256; ++kk) {
                const f32x4 w = *(const GAS f32x4*)(wp + (size_t)kk * 12288);
                const LAS f32x4* cp = (const LAS f32x4*)(cact + (F.wave * 256 + kk) * 8);
                const f32x4 c0 = cp[0], c1 = cp[1];
                acc[0] += w * c0.x; acc[1] += w * c0.y; acc[2] += w * c0.z; acc[3] += w * c0.w;
                acc[4] += w * c1.x; acc[5] += w * c1.y; acc[6] += w * c1.z; acc[7] += w * c1.w;
            }
#pragma unroll
            for (int b = 0; b < 8; ++b) *(LAS f32x4*)(red + (F.wave * 8 + b) * 256 + F.lane * 4) = acc[b];
            __syncthreads();
            for (int o = F.tid; o < 2048; o += NWAVES * 64) { const int b = o >> 8, col = o & 255, gc = nbase + col; float s = 0.f;
#pragma unroll
                for (int w = 0; w < 8; ++w) s += red[(w * 8 + b) * 256 + col];
                s += F.in(IN_MODB)[i * 12288 + gc];
                mod[((size_t)i * 8 + b) * 12288 + gc] = s;
                if (gc < DM) sht[((size_t)(2 * i) * DM + gc) * 8 + b] = s;
                else if (gc >= 3 * DM && gc < 4 * DM) sht[((size_t)(2 * i + 1) * DM + (gc - 3 * DM)) * 8 + b] = s; }
            __syncthreads();
        }
    }
    LAS float* scr = (LAS float*)(F.lds + RING_OFF + F.wave * 16384);
    const int gw = F.vcu * NWAVES + F.wave, NGW = F.G * NWAVES;
    constexpr int I_O = 32 * 64, I_GO = 32 * 64, I_F2 = 86 * 64;
    constexpr int NITEMS = 2 * (I_O + I_GO) + 4 * I_F2;
    bf16* Wo = (bf16*)((unsigned char*)F.wsg + WS_WO); bf16* Wgo = (bf16*)((unsigned char*)F.wsg + WS_WGO); bf16* Wf2 = (bf16*)((unsigned char*)F.wsg + WS_WF2);
    const int nfree = F.G > 192 ? (F.G - 192) * NWAVES : 0, nbusy = F.G * NWAVES - nfree, isfree = F.bid >= 192;
    const int n_free_items = nfree ? (int)((long)NITEMS * MK_PROA_SHARE / 100) : 0;
    const int it0 = isfree ? ((F.bid - 192) * NWAVES + F.wave) : (n_free_items + (F.bid < 192 ? F.bid : 0) * NWAVES + F.wave), its = isfree ? nfree : nbusy, itend = isfree ? n_free_items : NITEMS;
    for (int it = it0; it < itend; it += its) {
        int r = it;
        if (r < 2 * I_O) { const int j = r / I_O, q = r % I_O, kb = q / 64, nb = q % 64;
            transpose_item(F.in(IN_AWO) + (size_t)j * DM * DM, DM, DM, Wo + (size_t)j * DM * DM, 64 * kb, 32 * nb, 32 * nb, 32, scr, F.lane); continue; } r -= 2 * I_O;
        if (r < 2 * I_GO) { const int j = r / I_GO, q = r % I_GO, kb = q / 64, nb = q % 64;
            transpose_item(F.in(IN_GWO) + (size_t)j * DM * DM, DM, DM, Wgo + (size_t)j * DM * DM, 64 * kb, 32 * nb, 32 * nb, 32, scr, F.lane); continue; } r -= 2 * I_GO;
        { const int j = r / I_F2, q = r % I_F2, kb = q / 64, nb = q % 64;
            transpose_item(F.in(IN_FWOUT) + (size_t)j * DFF * DM, DM, DFF, Wf2 + (size_t)j * DM * DFF, 64 * kb, 32 * nb, 32 * nb, 32, scr, F.lane); }
    }
}
__device__ __forceinline__ void strip_item(const float* W, int ldw, bf16* WT, int n0, int dst_row0, int ncols, const float* sht, float* bias, int bpitch, LAS float* scr, int lane) {
    const int nl = lane & 31, bh = lane >> 5, c = lane & 7;
    f32x4 acc = (f32x4){0.f, 0.f, 0.f, 0.f};
    for (int kb = 0; kb < DM / 64; ++kb) { const int k0 = 64 * kb;
        const f32x4 sa = *(const GAS f32x4*)(sht + (size_t)k0 * 8 + lane * 4), sb = *(const GAS f32x4*)(sht + (size_t)k0 * 8 + 256 + lane * 4);
        if (ncols == 32) { const int n4 = (lane & 7) * 4, kr = lane >> 3; f32x4 t[8];
#pragma unroll
            for (int i = 0; i < 8; ++i) t[i] = *(const GAS f32x4*)(W + (size_t)(k0 + 8 * i + kr) * ldw + n0 + n4);
#pragma unroll
            for (int i = 0; i < 8; ++i) { LAS float* d = scr + (8 * i + kr) * 33 + n4; d[0] = t[i].x; d[1] = t[i].y; d[2] = t[i].z; d[3] = t[i].w; }
        } else {
#pragma unroll 8
            for (int i = 0; i < 32; ++i) { const int kk = 2 * i + (lane >> 5); if (nl < ncols) scr[kk * 33 + nl] = W[(size_t)(k0 + kk) * ldw + n0 + nl]; } }
        LDS_WAIT(); asm volatile("" ::: "memory");
#pragma unroll
        for (int j = 0; j < 4; ++j) { const int n = (lane >> 3) + 8 * j; const LAS float* s = scr + (8 * c) * 33 + n;
            if (n < ncols) { v4u o; o.x = pk2(s[0 * 33], s[1 * 33]); o.y = pk2(s[2 * 33], s[3 * 33]); o.z = pk2(s[4 * 33], s[5 * 33]); o.w = pk2(s[6 * 33], s[7 * 33]);
                *(GAS v4u*)(WT + (size_t)(dst_row0 + n) * DM + k0 + 8 * c) = o; } }
        LAS f32x4* sl = (LAS f32x4*)(scr + 64 * 33 + 16);
        sl[lane] = sa; sl[64 + lane] = sb;
        LDS_WAIT(); asm volatile("" ::: "memory");
#pragma unroll 8
        for (int kk = 0; kk < 64; ++kk) acc += sl[kk * 2 + bh] * scr[kk * 33 + nl];
        LDS_WAIT(); asm volatile("" ::: "memory");
    }
    if (nl < ncols) {
#pragma unroll
        for (int e = 0; e < 4; ++e) bias[(size_t)(4 * bh + e) * bpitch + n0 + nl] = acc[e]; }
}
__device__ __forceinline__ void pro_b_phase(Frame& F) {
    LAS float* scr = (LAS float*)(F.lds + RING_OFF + F.wave * 16384);
    const int gw = F.vcu * NWAVES + F.wave, NGW = F.G * NWAVES;
    constexpr int S_QKV = 193, S_GI = 128, S_F1 = 344, NSTRIPS = 2 * (S_QKV + S_GI) + 4 * S_F1;
    const float* sht = (const float*)((unsigned char*)F.wsg + WS_SHT); float* bv = (float*)((unsigned char*)F.wsg + WS_BIASV);
    bf16* Wqkv = (bf16*)((unsigned char*)F.wsg + WS_WQKV); bf16* Wgi = (bf16*)((unsigned char*)F.wsg + WS_WGI); bf16* Wf1 = (bf16*)((unsigned char*)F.wsg + WS_WF1);
    for (int it = gw; it < NSTRIPS; it += NGW) {
        int r = it;
        if (r < 2 * S_QKV) { const int j = r / S_QKV, nb = r % S_QKV;
            strip_item(F.in(IN_AWIN) + (size_t)j * DM * NQKVF, NQKVF, Wqkv + (size_t)j * WQKV_STRIDE, 32 * nb, 32 * nb, nb == 192 ? 16 : 32, sht + (size_t)(4 * j) * DM * 8, bv + BV_QKVF + (size_t)j * 8 * NQKVF, NQKVF, scr, F.lane); continue; } r -= 2 * S_QKV;
        if (r < 2 * S_GI) { const int j = r / S_GI, nb = r % S_GI;
            strip_item(F.in(IN_GWIN) + (size_t)j * DM * 4096, 4096, Wgi + (size_t)j * 4096 * DM, 32 * nb, 32 * nb, 32, sht + (size_t)(4 * j + 2) * DM * 8, bv + BV_GI + (size_t)j * 8 * 4096, 4096, scr, F.lane); continue; } r -= 2 * S_GI;
        { const int i = r / S_F1, nb = r % S_F1, n0 = 32 * nb, isup = n0 >= DFF, cch = n0 - isup * DFF;
            strip_item(F.in(IN_FWIN) + (size_t)i * DM * NFF2, NFF2, Wf1 + (size_t)i * NFF2 * DM, n0, 256 * (cch >> 7) + 128 * isup + (cch & 127), 32, sht + (size_t)(2 * i + 1) * DM * 8, bv + BV_F1 + (size_t)i * 8 * NFF2, NFF2, scr, F.lane); }
    }
}
__device__ __forceinline__ void xg0_phase(Frame& F, const float* xin, const float* g, const float* scale, bf16* XG, bf16* XB, u64* rss) {
    const int gw = F.vcu * NWAVES + F.wave, NGW = F.G * NWAVES;
    for (int rb = gw; rb < MTOK / 16; rb += NGW) {
        const int b = (rb * 16) >> 12;
        f32x4 gs[8];
#pragma unroll
        for (int j = 0; j < 8; ++j) { const int c4 = F.lane + 64 * j; gs[j] = ((const GAS f32x4*)g)[c4] * (((const GAS f32x4*)(scale + (size_t)b * 12288))[c4] + 1.0f); }
        for (int r = 0; r < 16; ++r) { const size_t row = (size_t)rb * 16 + r;
            const GAS f32x4* xr = (const GAS f32x4*)(xin + row * DM) + F.lane;
            f32x4 v[8]; float ss = 0.f;
#pragma unroll
            for (int j = 0; j < 8; ++j) { v[j] = xr[64 * j]; ss += (v[j].x * v[j].x + v[j].y * v[j].y) + (v[j].z * v[j].z + v[j].w * v[j].w); }
            ss = wave_sum(ss); if (F.lane == 0) rss[row] = (u64)(ss * FIXS);
            GAS v2u* o8 = (GAS v2u*)(XG + row * DM) + F.lane; GAS v2u* x8 = (GAS v2u*)(XB + row * DM) + F.lane;
#pragma unroll
            for (int j = 0; j < 8; ++j) { const f32x4 o = v[j] * gs[j]; v2u w; w.x = pk2(o.x, o.y); w.y = pk2(o.z, o.w); o8[64 * j] = w; v2u q; q.x = pk2(v[j].x, v[j].y); q.y = pk2(v[j].z, v[j].w); x8[64 * j] = q; } }
    }
}
__device__ __forceinline__ void normf_phase(Frame& F, float* x, const float* g) {
    const int gw = F.vcu * NWAVES + F.wave, NGW = F.G * NWAVES;
    for (int rb = gw; rb < MTOK / 16; rb += NGW) {
        f32x4 gs[8];
#pragma unroll
        for (int j = 0; j < 8; ++j) gs[j] = ((const GAS f32x4*)g)[F.lane + 64 * j];
        for (int r = 0; r < 16; ++r) { const size_t row = (size_t)rb * 16 + r;
            GAS f32x4* xr = (GAS f32x4*)(x + row * DM) + F.lane;
            f32x4 v[8]; float ss = 0.f;
#pragma unroll
            for (int j = 0; j < 8; ++j) { v[j] = xr[64 * j]; ss += (v[j].x * v[j].x + v[j].y * v[j].y) + (v[j].z * v[j].z + v[j].w * v[j].w); }
            const float rstd = 1.0f / sqrtf(wave_sum(ss) * (1.0f / DM) + EPS);
#pragma unroll
            for (int j = 0; j < 8; ++j) xr[64 * j] = v[j] * rstd * gs[j]; }
    }
}
__device__ __forceinline__ void fg_phase(Frame& F, const bf16* XG, const bf16* Wf, const float* bfv, const u64* rss, const float* biasf  , float* LOGF) {
    const int gw = F.vcu * NWAVES + F.wave, NGW = F.G * NWAVES, fr = F.lane & 15, fq = F.lane >> 4;
    for (int rb = gw; rb < MTOK / 16; rb += NGW) {
        const GAS bf16x8* ap = (const GAS bf16x8*)(XG + ((size_t)rb * 16 + fr) * DM + fq * 8);
        const GAS bf16x8* bp = (const GAS bf16x8*)(Wf + (size_t)fr * DM + fq * 8);
        f32x4 acc = (f32x4){0.f, 0.f, 0.f, 0.f};
#pragma unroll 8
        for (int ks = 0; ks < 64; ++ks) acc = __builtin_amdgcn_mfma_f32_16x16x32_bf16(bp[ks * 4], ap[ks * 4], acc, 0, 0, 0);
        const int b = (rb * 16) >> 12; const float rs = rstd_of(rss[(size_t)rb * 16 + fr]);
        const f32x4 bb = *(const GAS f32x4*)(bfv + 4 * fq) + *(const GAS f32x4*)(biasf + (size_t)b * NQKVF + 4 * fq); f32x4 o;
#pragma unroll
        for (int i = 0; i < 4; ++i) { const float z = acc[i] * rs + bb[i]; o[i] = fminf(z, 0.f) - log1pf(__expf(-fabsf(z))); }
        *(GAS f32x4*)(LOGF + ((size_t)rb * 16 + fr) * 16 + 4 * fq) = o;
    }
}
__device__ __forceinline__ void cum_phase(Frame& F, const float* LOGF, float* FB, bool grp) {
    LAS float* wt = (LAS float*)(F.lds + RING_OFF);
    for (int bh0 = grp ? (F.bid >> 3) : F.bid; bh0 < (grp ? NHEAD : NBATCH * NHEAD); bh0 += F.G) { const int bh = grp ? (F.bid & 7) * NHEAD + bh0 : bh0, b = bh >> 4, h = bh & 15;
        const float* p = LOGF + ((size_t)b * SEQ + F.tid * 8) * 16 + h;
        float v[8]; float s = 0.f;
#pragma unroll
        for (int i = 0; i < 8; ++i) { s += p[i * 16]; v[i] = s; }
        float incl = s;
#pragma unroll
        for (int o = 1; o < 64; o <<= 1) { const float t = __shfl_up(incl, o); if (F.lane >= o) incl += t; }
        if (F.lane == 63) wt[F.wave] = incl;
        __syncthreads();
        float base = incl - s;
        for (int w = 0; w < F.wave; ++w) base += wt[w];
        GAS f32x4* q = (GAS f32x4*)(FB + (size_t)bh * SEQ + F.tid * 8);
        q[0] = (f32x4){-(base + v[0]) * 1.4426950408889634f, -(base + v[1]) * 1.4426950408889634f, -(base + v[2]) * 1.4426950408889634f, -(base + v[3]) * 1.4426950408889634f};
        q[1] = (f32x4){-(base + v[4]) * 1.4426950408889634f, -(base + v[5]) * 1.4426950408889634f, -(base + v[6]) * 1.4426950408889634f, -(base + v[7]) * 1.4426950408889634f};
        __syncthreads();
    }
}
template <int VB>
__device__ __forceinline__ void gate_pv(fox::f32x16* o, int vb0, fox::bf16x8 pa0, fox::bf16x8 pa1, fox::bf16x8 pa2, fox::bf16x8 pa3) {
    using fox::s16x4; using fox::bf16x8;
#define TRRD(dst, off) asm volatile("ds_read_b64_tr_b16 %0, %1 offset:%2" : "=&v"(dst) : "v"(vb0), "i"(off) : "memory")
#define PV_D0(d0) do { s16x4 l0, l1, l2, l3, h0, h1, h2, h3; constexpr int b_ = VB * fox::SHM_V + fox::v_rd_off(d0, 0, 0); \
        TRRD(l0, b_); TRRD(h0, b_ + 2048); TRRD(l1, b_ + 4096); TRRD(h1, b_ + 6144); TRRD(l2, b_ + 8192); TRRD(h2, b_ + 10240); TRRD(l3, b_ + 12288); TRRD(h3, b_ + 14336); \
        asm volatile("s_waitcnt lgkmcnt(0)" ::: "memory"); __builtin_amdgcn_sched_barrier(0); \
        o[d0] = __builtin_amdgcn_mfma_f32_32x32x16_bf16((bf16x8){l0[0], l0[1], l0[2], l0[3], h0[0], h0[1], h0[2], h0[3]}, pa0, o[d0], 0, 0, 0);   \
        o[d0] = __builtin_amdgcn_mfma_f32_32x32x16_bf16((bf16x8){l1[0], l1[1], l1[2], l1[3], h1[0], h1[1], h1[2], h1[3]}, pa1, o[d0], 0, 0, 0);   \
        o[d0] = __builtin_amdgcn_mfma_f32_32x32x16_bf16((bf16x8){l2[0], l2[1], l2[2], l2[3], h2[0], h2[1], h2[2], h2[3]}, pa2, o[d0], 0, 0, 0);   \
        o[d0] = __builtin_amdgcn_mfma_f32_32x32x16_bf16((bf16x8){l3[0], l3[1], l3[2], l3[3], h3[0], h3[1], h3[2], h3[3]}, pa3, o[d0], 0, 0, 0); } while (0)
    PV_D0(0); PV_D0(1); PV_D0(2); PV_D0(3);
#undef PV_D0
#undef TRRD
}
__device__ __forceinline__ void gate_phase(Frame& F, const bf16* Z, const u64* VSS, const float* vg, const float* Ws, const float* bs, bf16* GT, bool grp) {
    using fox::bf16x8; using fox::f32x16;
    const int r32 = F.lane & 31, hi = F.lane >> 5, c = F.wave >> 2, t0 = 32 * (F.wave & 3);
    const int vb0 = (int)(uintptr_t)(F.ldsg + RING_OFF) + c * 32768 + fox::v_rd_base(F.lane);
    constexpr int NITEM = (MTOK / 256) * 16;
#define GATE_MAP(it_) (grp ? ((((F.bid & 7) * 16 + ((it_) >> 4)) << 4) | ((it_) & 15)) : (it_))
    int itq = grp ? (F.bid >> 3) : F.bid; const int itstep = grp ? (F.G >> 3) : F.G, itend = grp ? 256 : NITEM; if (itq >= itend) return;
    int item = GATE_MAP(itq);
    bf16x8 aw[8]; int gcur = -1;
    const int srow = F.tid >> 4, c8 = (F.tid & 15) * 8;
    v4u vw[8]; u64 vs[8];
#define VO_Z() ((unsigned)((ltid() >> 4) * 4096 + (ltid() & 15) * 8) * 2u)
#define VO_S() ((unsigned)(ltid() >> 4) * 8u)
#define VO_U() ((unsigned)((c * 128 + t0 + (ltid() & 31)) * 4096 + 8 * ((ltid() >> 5) & 1)) * 2u)
#define VO_O() ((unsigned)((c * 128 + t0 + (ltid() & 31)) * DM + 8 * ((ltid() >> 5) & 1)) * 2u)
#define GATE_LOADV(it_) do { const int g_ = (it_) & 15; const size_t r_ = (size_t)((it_) >> 4) * 256;                                             \
        const unsigned vo_z = VO_Z(); _Pragma("unroll") for (int ps = 0; ps < 8; ++ps) vw[ps] = *(const GAS v4u*)((const GAS char*)(Z + (r_ + 32 * ps) * 4096 + 2048 + g_ * 128) + vo_z); } while (0)
#define GATE_LOADS(it_) do { const size_t r_ = (size_t)((it_) >> 4) * 256;                                                                        \
        const unsigned vo_s = VO_S(); _Pragma("unroll") for (int ps = 0; ps < 8; ++ps) vs[ps] = *(const GAS u64*)((const GAS char*)(VSS + r_ + 32 * ps) + vo_s); } while (0)
#define GATE_RSTD() do { _Pragma("unroll") for (int ps = 0; ps < 8; ++ps) rs8[ps] = rstd_of(vs[ps]); } while (0)
    float rs8[8];
    GATE_LOADS(item); GATE_LOADV(item); GATE_RSTD();
    for (int i = 0; ; ++i) {
        const int g = item & 15, pnl = item >> 4; const size_t row0 = (size_t)pnl * 256;
        if (g != gcur) { gcur = g;
            const float* wr_ = Ws + ((size_t)g * 128 + t0 + r32) * 128 + 8 * hi;
#pragma unroll
            for (int ks = 0; ks < 8; ++ks) { const f32x4 a = *(const GAS f32x4*)(wr_ + 16 * ks), b = *(const GAS f32x4*)(wr_ + 16 * ks + 4); const int s0 = 16 * ks + 8 * hi; int t = t0 + r32; asm volatile("" : "+v"(t));
                v4u w; w.x = pk2(s0 + 0 <= t ? a.x : 0.f, s0 + 1 <= t ? a.y : 0.f); w.y = pk2(s0 + 2 <= t ? a.z : 0.f, s0 + 3 <= t ? a.w : 0.f);
                       w.z = pk2(s0 + 4 <= t ? b.x : 0.f, s0 + 5 <= t ? b.y : 0.f); w.w = pk2(s0 + 6 <= t ? b.z : 0.f, s0 + 7 <= t ? b.w : 0.f);
                aw[ks] = __builtin_bit_cast(bf16x8, w); } }
        { const f32x4 g0 = *(const GAS f32x4*)(vg + g * 128 + c8), g1 = *(const GAS f32x4*)(vg + g * 128 + c8 + 4);
#pragma unroll
          for (int ps = 0; ps < 8; ++ps) { const int row = srow + 32 * ps, s = row & 127; const v4u w = vw[ps]; const float rs = rs8[ps];
            v4u o; o.x = pk2(bflo(w.x) * rs * g0.x, bfhi(w.x) * rs * g0.y); o.y = pk2(bflo(w.y) * rs * g0.z, bfhi(w.y) * rs * g0.w);
                   o.z = pk2(bflo(w.z) * rs * g1.x, bfhi(w.z) * rs * g1.y); o.w = pk2(bflo(w.w) * rs * g1.z, bfhi(w.w) * rs * g1.w);
            *(LAS v4u*)(F.lds + RING_OFF + (i & 1) * 65536 + ((row >> 7) * 2 + (s >> 6)) * 16384 + fox::v_st(s & 63, c8)) = o; } }
        const int nxq = itq + itstep; const bool more = nxq < itend; const int nxt = GATE_MAP(nxq);
        if (more) GATE_LOADS(nxt);
        v4u uq[8];
        { const GAS v4u* up = (const GAS v4u*)((const GAS char*)(Z + row0 * 4096 + g * 128) + VO_U());
#pragma unroll
          for (int j = 0; j < 8; ++j) uq[j] = up[j * 2]; }
        const float bias = bs[g * 128 + t0 + r32];
        if (more) GATE_LOADV(nxt);
        LDS_WAIT(); asm volatile("" ::: "memory"); __builtin_amdgcn_s_barrier(); asm volatile("" ::: "memory");
        if (more) GATE_RSTD();
        { const int vbi = vb0 + (i & 1) * 65536; GAS v4u* op = (GAS v4u*)((GAS char*)(GT + row0 * DM + g * 128) + VO_O());
          using fox::s16x4;
#define G_TRRD(dst, off) asm volatile("ds_read_b64_tr_b16 %0, %1 offset:%2" : "=&v"(dst) : "v"(vbi), "i"(off) : "memory")
#define G_LD(R, tile, d0) do { constexpr int b_ = (tile) * 16384 + fox::v_rd_off(d0, 0, 0); G_TRRD(R##0, b_); G_TRRD(R##1, b_ + 2048); G_TRRD(R##2, b_ + 4096); G_TRRD(R##3, b_ + 6144); G_TRRD(R##4, b_ + 8192); G_TRRD(R##5, b_ + 10240); G_TRRD(R##6, b_ + 12288); G_TRRD(R##7, b_ + 14336); } while (0)
#define G_J(l, h) ((bf16x8){l[0], l[1], l[2], l[3], h[0], h[1], h[2], h[3]})
#define G_MM(R, A) do { acc = __builtin_amdgcn_mfma_f32_32x32x16_bf16(G_J(R##0, R##1), aw[(A) + 0], acc, 0, 0, 0); acc = __builtin_amdgcn_mfma_f32_32x32x16_bf16(G_J(R##2, R##3), aw[(A) + 1], acc, 0, 0, 0); \
        acc = __builtin_amdgcn_mfma_f32_32x32x16_bf16(G_J(R##4, R##5), aw[(A) + 2], acc, 0, 0, 0); acc = __builtin_amdgcn_mfma_f32_32x32x16_bf16(G_J(R##6, R##7), aw[(A) + 3], acc, 0, 0, 0); } while (0)
#define G_W(n, R) asm volatile("s_waitcnt lgkmcnt(" #n ")" : "+v"(R##0), "+v"(R##1), "+v"(R##2), "+v"(R##3), "+v"(R##4), "+v"(R##5), "+v"(R##6), "+v"(R##7) :: "memory")
#define G_EPI(d0) do { _Pragma("unroll") for (int hf = 0; hf < 2; ++hf) { const v4u uw = uq[(d0) * 2 + hf];                                                                                          \
                auto s0 = __builtin_amdgcn_permlane32_swap(uw.x, uw.z, false, false); auto s1 = __builtin_amdgcn_permlane32_swap(uw.y, uw.w, false, false);     \
                const int j0 = 8 * hf;                                                                                                                                                            \
                const float v0 = bflo(s0[0]) * (acc[j0 + 0] + bias), v1 = bfhi(s0[0]) * (acc[j0 + 1] + bias), v2 = bflo(s1[0]) * (acc[j0 + 2] + bias), v3 = bfhi(s1[0]) * (acc[j0 + 3] + bias);      \
                const float v4 = bflo(s0[1]) * (acc[j0 + 4] + bias), v5 = bfhi(s0[1]) * (acc[j0 + 5] + bias), v6 = bflo(s1[1]) * (acc[j0 + 6] + bias), v7 = bfhi(s1[1]) * (acc[j0 + 7] + bias);      \
                const unsigned a0 = fox::cvtpk(v0, v1), a1 = fox::cvtpk(v2, v3), b0 = fox::cvtpk(v4, v5), b1 = fox::cvtpk(v6, v7);                                                                 \
                auto r0 = __builtin_amdgcn_permlane32_swap(a0, b0, false, false); auto r1 = __builtin_amdgcn_permlane32_swap(a1, b1, false, false);                                                \
                v4u w; w.x = r0[0]; w.y = r1[0]; w.z = r0[1]; w.w = r1[1];                                                                                                                         \
                op[(d0) * 4 + hf * 2] = w; } } while (0)
          s16x4 fa0, fa1, fa2, fa3, fa4, fa5, fa6, fa7, fb0, fb1, fb2, fb3, fb4, fb5, fb6, fb7; f32x16 acc;
          if (t0 >= 64) {
              G_LD(fa, 0, 0); G_LD(fb, 1, 0);
              G_W(8, fa); acc = (f32x16){}; G_MM(fa, 0); G_LD(fa, 0, 1); G_W(8, fb); G_MM(fb, 4); G_LD(fb, 1, 1); G_EPI(0);
              G_W(8, fa); acc = (f32x16){}; G_MM(fa, 0); G_LD(fa, 0, 2); G_W(8, fb); G_MM(fb, 4); G_LD(fb, 1, 2); G_EPI(1);
              G_W(8, fa); acc = (f32x16){}; G_MM(fa, 0); G_LD(fa, 0, 3); G_W(8, fb); G_MM(fb, 4); G_LD(fb, 1, 3); G_EPI(2);
              G_W(8, fa); acc = (f32x16){}; G_MM(fa, 0); G_W(0, fb); G_MM(fb, 4); G_EPI(3);
          } else {
              G_LD(fa, 0, 0); G_LD(fb, 0, 1);
              G_W(8, fa); acc = (f32x16){}; G_MM(fa, 0); G_LD(fa, 0, 2); G_EPI(0);
              G_W(8, fb); acc = (f32x16){}; G_MM(fb, 0); G_LD(fb, 0, 3); G_EPI(1);
              G_W(8, fa); acc = (f32x16){}; G_MM(fa, 0); G_EPI(2);
              G_W(0, fb); acc = (f32x16){}; G_MM(fb, 0); G_EPI(3);
          }
#undef G_EPI
#undef G_W
#undef G_MM
#undef G_J
#undef G_LD
#undef G_TRRD
        }
        if (!more) break;
        item = nxt; itq = nxq;
    }
#undef VO_O
#undef VO_U
#undef VO_S
#undef VO_Z
#undef GATE_MAP
#undef GATE_RSTD
#undef GATE_LOADS
#undef GATE_LOADV
    __syncthreads();
}
__device__ __forceinline__ float silu1(float v) { return v * __builtin_amdgcn_rcpf(1.0f + __builtin_amdgcn_exp2f(v * -1.4426950408889634f)); }
__device__ __forceinline__ void fix_phase(Frame& F, const float* HALO, const float* cw, const float* cb, bf16* ACT, int pm_lo, int pm_n, bool grp) {
    constexpr int C4 = DFF / 4;
    const int wgi = grp ? (F.bid >> 3) : F.bid, wgn = grp ? (F.G >> 3) : F.G, nit = grp ? 16 * C4 : pm_n * C4, pbase = grp ? (F.bid & 7) * 16 : pm_lo;
    for (int item = wgi * (NWAVES * 64) + F.tid; item < nit; item += wgn * NWAVES * 64) {
        const int pm = pbase + item / C4, c4 = (item % C4) * 4; if ((pm & 15) == 0) continue;
        f32x4 r0[2], r1[2];
#pragma unroll
        for (int part = 0; part < 2; ++part) { const int col = part * DFF + c4;
            const f32x4 am2 = *(const GAS f32x4*)(HALO + ((size_t)(pm - 1) * 4 + 2) * NFF2 + col), am1 = *(const GAS f32x4*)(HALO + ((size_t)(pm - 1) * 4 + 3) * NFF2 + col);
            const f32x4 a0 = *(const GAS f32x4*)(HALO + ((size_t)pm * 4 + 0) * NFF2 + col), a1 = *(const GAS f32x4*)(HALO + ((size_t)pm * 4 + 1) * NFF2 + col);
            const f32x4 w0 = *(const GAS f32x4*)(cw + col), w1 = *(const GAS f32x4*)(cw + NFF2 + col), w2 = *(const GAS f32x4*)(cw + 2 * NFF2 + col), b = *(const GAS f32x4*)(cb + col);
            r0[part] = b + w0 * am2 + w1 * am1 + w2 * a0; r1[part] = b + w0 * am1 + w1 * a0 + w2 * a1; }
        v2u o0, o1;
        o0.x = pk2(silu1(r0[0].x) * r0[1].x, silu1(r0[0].y) * r0[1].y); o0.y = pk2(silu1(r0[0].z) * r0[1].z, silu1(r0[0].w) * r0[1].w);
        o1.x = pk2(silu1(r1[0].x) * r1[1].x, silu1(r1[0].y) * r1[1].y); o1.y = pk2(silu1(r1[0].z) * r1[1].z, silu1(r1[0].w) * r1[1].w);
        *(GAS v2u*)(ACT + ((size_t)pm * 256) * DFF + c4) = o0; *(GAS v2u*)(ACT + ((size_t)pm * 256 + 1) * DFF + c4) = o1;
    }
}
constexpr int NPHASE = 96;
struct Args { const float* in[19]; float* out; unsigned char* ws; int ph_lo, ph_hi; };
static_assert(sizeof(Args) == 19 * 8 + 8 + 8 + 8, "Args has no padding bytes");
#ifndef MK_EN
#define MK_EN 0xffffffffu
#endif
#define EN(k) (((MK_EN) >> (k)) & 1u)
#ifndef MK_BARPROBE
#define MK_BARPROBE 0
#endif
#ifndef MK_BARSEL
#define MK_BARSEL 0
#endif
#define BARSEL(ph) (MK_BARSEL == 0 ? true : MK_BARSEL == 1 ? ((ph) < 2) : MK_BARSEL == 2 ? ((ph) == 2 || (ph) == 15) : MK_BARSEL == 3 ? ((ph) == 3 || (ph) == 16) : MK_BARSEL == 4 ? ((ph) == 4 || (ph) == 17) : MK_BARSEL == 5 ? ((ph) == 5 || (ph) == 18 || (ph) == 11 || (ph) == 24) : \
    MK_BARSEL == 6 ? ((ph) == 6 || (ph) == 19 || (ph) == 12 || (ph) == 25) : MK_BARSEL == 7 ? ((ph) == 7 || (ph) == 20 || (ph) == 13 || (ph) == 26) : MK_BARSEL == 8 ? ((ph) == 8 || (ph) == 21 || (ph) == 14 || (ph) == 27) : MK_BARSEL == 9 ? ((ph) == 9 || (ph) == 22) : MK_BARSEL == 10 ? ((ph) == 10 || (ph) == 23) : false)
#if MK_BARPROBE
#define BARPROBE_T0() const unsigned long long bpt0_ = __builtin_amdgcn_s_memrealtime()
#define BARPROBE_T1() do { if (threadIdx.x == 0 && ph + 2 < hi) __hip_atomic_fetch_add((unsigned long long*)((unsigned char*)F.wsg + WS_CTL + 512 * 1024), __builtin_amdgcn_s_memrealtime() - bpt0_, __ATOMIC_RELAXED, __HIP_MEMORY_SCOPE_AGENT); } while (0)
#else
#define BARPROBE_T0() do {} while (0)
#define BARPROBE_T1() do {} while (0)
#endif
#ifndef MK_TPSITE
#define MK_TPSITE 1
#endif
#ifndef MK_TPROBE
#define MK_TPROBE 0
#endif
#ifndef MK_CLKPROBE
#define MK_CLKPROBE 0
#endif
#ifndef MK_GROUPS
#define MK_GROUPS 1
#endif
#ifndef MK_FUSEFIN
#define MK_FUSEFIN 0
#endif
#ifndef MK_FFN_SPLIT
#define MK_FFN_SPLIT 1
#endif
#ifndef MK_PAD
#define MK_PAD 0
#endif
#define MK_STR2(x) #x
#define MK_STR(x) MK_STR2(x)
#define MK_PAD_STR MK_STR(MK_PAD)
#ifndef MK_DYNTAIL
#define MK_DYNTAIL 0
#endif
#ifndef MK_ALIGN
#define MK_ALIGN true
#endif
#ifndef MK_STAG_F1
#define MK_STAG_F1 0
#endif
#ifndef MK_REPBAR
#define MK_REPBAR 0
#endif
#ifndef MK_SP2
#define MK_SP2 true
#endif
#ifndef MK_BAR2
#define MK_BAR2 0
#endif
#ifndef MK_KREP
#define MK_KREP 1
#endif
#ifndef MK_REP
#define MK_REP 0u
#endif
#define REPN(k) ((((MK_REP) >> (k)) & 1u) ? 2 : 1)
#define W_MOD   ((float*)((unsigned char*)F.wsg + WS_MOD))
#define W_H     ((bf16*)((unsigned char*)F.wsg + WS_H))
#define W_Q     ((bf16*)((unsigned char*)F.wsg + WS_R))
#define W_K     ((bf16*)((unsigned char*)F.wsg + WS_R + 128 * MiB))
#define W_V     ((bf16*)((unsigned char*)F.wsg + WS_R + 256 * MiB))
#define W_Z     ((bf16*)((unsigned char*)F.wsg + WS_R))
#define W_ACT   ((bf16*)((unsigned char*)F.wsg + WS_ACT))
#define W_HALO  ((float*)((unsigned char*)F.wsg + WS_ACT + 344 * MiB))
#define W_LOGF  ((float*)((unsigned char*)F.wsg + WS_LOGF))
#define W_FB    ((float*)((unsigned char*)F.wsg + WS_FB))
#define W_VSS(n) ((u64*)((unsigned char*)F.wsg + WS_VSS) + (size_t)(n) * MTOK)
#define W_XB    ((bf16*)((unsigned char*)F.wsg + WS_XB))
#define W_H2    ((bf16*)((unsigned char*)F.wsg + WS_H2))
#define W_RSS(n) ((u64*)((unsigned char*)F.wsg + WS_RSS) + (size_t)(n) * MTOK)
#define W_BIASV ((float*)((unsigned char*)F.wsg + WS_BIASV))
#define W_MODI  (W_MOD + (size_t)i * 8 * 12288)
#define XOUT_(k) ((REPN(k) == 2 && rep_ == 0) ? W_H : W_XB)
#define XG_(k, p) ((REPN(k) == 2 && rep_ == 0) ? (bf16*)nullptr : (p))
__global__ void __launch_bounds__(NWAVES * 64, 2) mega_fwd(Args args) {
    extern __shared__ __attribute__((aligned(16))) unsigned char lds[];
    Frame F;
#if MK_PAD > 0
    asm volatile(".rept " MK_PAD_STR "\n\ts_nop 0\n\t.endr" ::: "memory");
#endif
    F.lds = (LAS unsigned char*)lds; F.ldsg = (char*)lds;
    F.MISC = (volatile LAS unsigned*)(F.lds + MISC_OFF);
    for (int u = threadIdx.x; u < (LDS_BYTES - LDSCTL_OFF) / 4; u += NWAVES * 64) ((LAS unsigned*)(F.lds + LDSCTL_OFF))[u] = 0u;
    __syncthreads();
    if (threadIdx.x == 0) {
        const int G = gridDim.x, bx = blockIdx.x; const unsigned long long kp = (unsigned long long)__builtin_amdgcn_kernarg_segment_ptr(), wp = (unsigned long long)args.ws, op = (unsigned long long)args.out;
        F.MISC[MW_BID] = (unsigned)bx; F.MISC[MW_G] = (unsigned)G; F.MISC[MW_VCU] = (unsigned)((G % 8 == 0) ? (bx % 8) * (G / 8) + bx / 8 : bx);
        F.MISC[MW_INP] = (unsigned)kp; F.MISC[MW_INP_HI] = (unsigned)(kp >> 32); F.MISC[MW_WS] = (unsigned)wp; F.MISC[MW_WS_HI] = (unsigned)(wp >> 32); F.MISC[MW_OUT] = (unsigned)op; F.MISC[MW_OUT_HI] = (unsigned)(op >> 32);
    }
    __syncthreads();
    XcdBarrier bar; bar.bar = (unsigned*)(args.ws + WS_CTL) + CW_BAR; bar.x = 0; bar.st = nullptr;
    if (!MK_PER_PHASE) bar = xcd_barrier_post((unsigned*)(args.ws + WS_CTL) + CW_BAR, F.MISC + 8);
    XcdBarrier gbar = bar; const bool grp = MK_GROUPS && !MK_PER_PHASE && gridDim.x == 256;
    if (grp) { gbar = xcd_barrier_post((unsigned*)(args.ws + WS_CTL) + CW_BAR + XCD_BAR_WORDS * (1 + (blockIdx.x & 7)), F.MISC + 10); gbar.total = 32u; }
    const int lo = args.ph_lo, hi = args.ph_hi;
    int ph = 0;
#define REPBAR(k) ((MK_REPBAR && rep_ < REPN(k)) ? (relaunder(F), bar.bar = (unsigned*)((unsigned char*)F.wsg + WS_CTL) + CW_BAR, xcd_barrier(bar), 0) : 0)
#define RUN() (lo <= ph && ph < hi && relaunder(F))
#define SEAMX(glob) do { if (!MK_PER_PHASE) { if (lo <= ph && ph + 1 < hi) { relaunder(F); if ((glob) || !grp) { bar.bar = (unsigned*)((unsigned char*)F.wsg + WS_CTL) + CW_BAR; asm volatile("" : "+s"(bar.x)); if (MK_BARPROBE && threadIdx.x == 0) F.MISC[41] = BARSEL(ph) ? 1u : 0u; xcd_barrier(bar); if (MK_BAR2) xcd_barrier(bar); } \
        else { gbar.bar = (unsigned*)((unsigned char*)F.wsg + WS_CTL) + CW_BAR + XCD_BAR_WORDS * (1 + (F.bid & 7)); asm volatile("" : "+s"(gbar.x)); if (MK_BARPROBE && threadIdx.x == 0) F.MISC[41] = BARSEL(ph) ? 1u : 0u; xcd_barrier(gbar); } } } ++ph; } while (0)
#define SEAM() SEAMX(true)
#define SEAMG() SEAMX(false)

    if (EN(0) && RUN()) for (int rep_ = 0; rep_ < REPN(0); ++rep_, REPBAR(0)) pro_a_phase(F);
    SEAM();
    if (EN(1) && RUN()) for (int rep_ = 0; rep_ < REPN(1); ++rep_, REPBAR(1)) { pro_b_phase(F); xg0_phase(F, F.in(IN_X), F.in(IN_MIXG), W_MOD + DM, W_H, W_XB, W_RSS(0)); }
    SEAM();
    for (int i = 0; i < DEPTH; ++i) {
        const int j = i >> 1;
        if ((i & 1) == 0) {
            if (EN(3) && RUN()) for (int rep_ = 0; rep_ < REPN(3); ++rep_, REPBAR(3)) {
                const bf16* wq = (const bf16*)((unsigned char*)F.wsg + WS_WQKV) + (size_t)j * WQKV_STRIDE; const float* bvq = W_BIASV + BV_QKVF + (size_t)j * 8 * NQKVF;
                fg_phase(F, W_H, wq + (size_t)6144 * DM, F.in(IN_ABF) + j * 16, W_RSS(2 * i), bvq + 6144, W_LOGF);
                pg8::Gemm g{W_H, wq, MTOK, 6144, DM}; pg8::StaticOrder S; S.init(MTOK, 6144, F.G, F.bid);
                pg8::EpiQKV E{W_Q, (size_t)(64 * MiB), fox::QSCALE, pg8::RowAffine{W_RSS(2 * i), bvq, NQKVF, (LAS float*)(F.lds + XCH_OFF + 8192)}};
                pg8::gemm_phase<pg8::EpiQKV, pg8::StaticOrder, MK_ALIGN, MK_SP2>(F.lds + RING_OFF, g, S, E);
            }
            SEAMG();
            if (EN(4) && RUN()) for (int rep_ = 0; rep_ < REPN(4); ++rep_, REPBAR(4)) cum_phase(F, W_LOGF, W_FB, grp);
            SEAMG();
            if (EN(5) && RUN()) for (int rep_ = 0; rep_ < REPN(5); ++rep_, REPBAR(5)) fox::att_phase(F.ldsg + RING_OFF, (const fox::bf16*)W_Q, (const fox::bf16*)W_K, (const fox::bf16*)W_V, (fox::bf16*)W_H, W_FB, F.bid, F.G, grp);
            SEAMG();
            if (EN(6) && RUN()) for (int rep_ = 0; rep_ < REPN(6); ++rep_, REPBAR(6)) {
                pg8::Gemm g{W_H, (const bf16*)((unsigned char*)F.wsg + WS_WO) + (size_t)j * DM * DM, MTOK, DM, DM}; pg8::StaticOrder S; S.init(MTOK, DM, F.G, F.bid);
                pg8::EpiRes E{XOUT_(6), W_MODI + 2 * DM, 12288, XG_(6, W_H2), F.in(IN_FFNG) + i * DM, W_MODI + 4 * DM, W_RSS(2 * i + 1), (LAS float*)(F.lds + XCH_OFF), (float*)nullptr};
                pg8::gemm_phase<pg8::EpiRes, pg8::StaticOrder, MK_ALIGN, MK_SP2>(F.lds + RING_OFF, g, S, E);
            }
            SEAMG();
        } else {
            if (EN(7) && RUN()) for (int rep_ = 0; rep_ < REPN(7); ++rep_, REPBAR(7)) {
                pg8::Gemm g{W_H, (const bf16*)((unsigned char*)F.wsg + WS_WGI) + (size_t)j * 4096 * DM, MTOK, 4096, DM}; pg8::StaticOrder S; S.init(MTOK, 4096, F.G, F.bid);
                pg8::EpiStore<1> E{W_Z, 4096, pg8::RowAffine{W_RSS(2 * i), W_BIASV + BV_GI + (size_t)j * 8 * 4096, 4096, (LAS float*)(F.lds + XCH_OFF + 8192)}, W_VSS(j)};
                pg8::gemm_phase<pg8::EpiStore<1>, pg8::StaticOrder, MK_ALIGN, MK_SP2>(F.lds + RING_OFF, g, S, E);
            }
            SEAMG();
            if (EN(9) && RUN()) for (int rep_ = 0; rep_ < REPN(9); ++rep_, REPBAR(9)) gate_phase(F, W_Z, W_VSS(j), F.in(IN_GVG) + j * DM, F.in(IN_GWS) + (size_t)j * 16 * 128 * 128, F.in(IN_GBS) + j * 16 * 128, W_H, grp);
            SEAMG();
            if (EN(10) && RUN()) for (int rep_ = 0; rep_ < REPN(10); ++rep_, REPBAR(10)) {
                pg8::Gemm g{W_H, (const bf16*)((unsigned char*)F.wsg + WS_WGO) + (size_t)j * DM * DM, MTOK, DM, DM}; pg8::StaticOrder S; S.init(MTOK, DM, F.G, F.bid);
                pg8::EpiRes E{XOUT_(10), W_MODI + 2 * DM, 12288, XG_(10, W_H2), F.in(IN_FFNG) + i * DM, W_MODI + 4 * DM, W_RSS(2 * i + 1), (LAS float*)(F.lds + XCH_OFF), (float*)nullptr};
                pg8::gemm_phase<pg8::EpiRes, pg8::StaticOrder, MK_ALIGN, MK_SP2>(F.lds + RING_OFF, g, S, E);
            }
            SEAMG();
        }
        for (int hf_ = 0; hf_ < MK_FFN_SPLIT; ++hf_) {
        const int pmn_ = (MTOK / 256) / MK_FFN_SPLIT, pm0_ = hf_ * pmn_;
        if (EN(11) && RUN()) for (int rep_ = 0; rep_ < REPN(11); ++rep_, REPBAR(11)) {
            stagger(F, MK_STAG_F1);
#if MK_CLKPROBE
            unsigned long long pc0_ = 0, pr0_ = 0; if (i == 0 && F.bid == 0) { pc0_ = __builtin_amdgcn_s_memtime(); pr0_ = __builtin_amdgcn_s_memrealtime(); }
#endif
            pg8::Gemm g{W_H2, (const bf16*)((unsigned char*)F.wsg + WS_WF1) + (size_t)i * NFF2 * DM, MTOK, NFF2, DM}; pg8::StaticOrder S; S.init(MTOK / MK_FFN_SPLIT, NFF2, F.G, F.bid); S.pm_off = pm0_;
            pg8::EpiConv E{W_ACT, F.in(IN_FCW) + (size_t)i * 3 * NFF2, F.in(IN_FCB) + (size_t)i * NFF2, W_HALO, (LAS float*)(F.lds + XCH_OFF), pg8::RowAffine{W_RSS(2 * i + 1), W_BIASV + BV_F1 + (size_t)i * 8 * NFF2, NFF2, (LAS float*)(F.lds + XCH_OFF + 8192)}, (LAS float*)(F.lds + CWT_OFF)};
#if MK_TPROBE && MK_TPSITE == 1
            { unsigned long long tpv_ = 0; pg8::gemm_phase<pg8::EpiConv, pg8::StaticOrder, true, MK_SP2, MK_KREP, MK_TPROBE>(F.lds + RING_OFF, g, S, E, &tpv_);
              if (i == 0 && F.bid == 0 && threadIdx.x == 0) F.MISC[40] = (unsigned)(tpv_ * 10ull); }
#elif MK_DYNTAIL
            { pg8::TailClaimOrder T; T.init(MTOK, NFF2, F.G, F.bid); T.init_tail((unsigned*)((unsigned char*)F.wsg + WS_CTL + 768 * 1024) + i * 8 * 64, (volatile LAS unsigned*)(F.MISC + 42));
              pg8::gemm_phase<pg8::EpiConv, pg8::TailClaimOrder, true, MK_SP2, MK_KREP>(F.lds + RING_OFF, g, T, E); }
#else
            pg8::gemm_phase<pg8::EpiConv, pg8::StaticOrder, true, MK_SP2, MK_KREP>(F.lds + RING_OFF, g, S, E);
#endif
#if MK_CLKPROBE
            if (i == 0 && F.bid == 0) { const unsigned long long dc_ = __builtin_amdgcn_s_memtime() - pc0_, dr_ = __builtin_amdgcn_s_memrealtime() - pr0_;
                if (threadIdx.x == 0) { F.MISC[40] = (unsigned)(dc_ * 5000ull / (dr_ ? dr_ : 1ull)); } }
#endif
        }
        SEAMG();
        if (EN(12) && RUN()) for (int rep_ = 0; rep_ < REPN(12); ++rep_, REPBAR(12)) fix_phase(F, W_HALO, F.in(IN_FCW) + (size_t)i * 3 * NFF2, F.in(IN_FCB) + (size_t)i * NFF2, W_ACT, pm0_, pmn_, grp);
        SEAMG();
        if (EN(13) && RUN()) for (int rep_ = 0; rep_ < REPN(13); ++rep_, REPBAR(13)) {
            pg8::Gemm g{W_ACT, (const bf16*)((unsigned char*)F.wsg + WS_WF2) + (size_t)i * DM * DFF, MTOK, DM, DFF}; pg8::StaticOrder S; S.init(MTOK / MK_FFN_SPLIT, DM, F.G, F.bid); S.pm_off = pm0_;
            const int in_ = i < DEPTH - 1 ? i + 1 : i;
#if MK_FUSEFIN
            pg8::EpiResF E{{XOUT_(13), W_MODI + 5 * DM, 12288, XG_(13, i < DEPTH - 1 ? W_H : (bf16*)nullptr), F.in(IN_MIXG) + in_ * DM, W_MOD + (size_t)in_ * 8 * 12288 + DM, W_RSS(2 * in_), (LAS float*)(F.lds + XCH_OFF), (float*)nullptr},
                i < DEPTH - 1 ? (float*)nullptr : (float*)F.outg, F.in(IN_FING), (u64*)((unsigned char*)F.wsg + WS_RSSF), (unsigned*)((unsigned char*)F.wsg + WS_PCNT)};
#else
            pg8::EpiRes E{XOUT_(13), W_MODI + 5 * DM, 12288, XG_(13, i < DEPTH - 1 ? W_H : (bf16*)nullptr), F.in(IN_MIXG) + in_ * DM, W_MOD + (size_t)in_ * 8 * 12288 + DM, W_RSS(2 * in_), (LAS float*)(F.lds + XCH_OFF), i < DEPTH - 1 ? (float*)nullptr : (float*)F.outg};
#endif
#if MK_TPROBE && MK_TPSITE == 2
            { unsigned long long tpv_ = 0; pg8::gemm_phase<pg8::EpiRes, pg8::StaticOrder, MK_ALIGN, MK_SP2, 1, MK_TPROBE>(F.lds + RING_OFF, g, S, E, &tpv_);
              if (i == 0 && F.bid == 0 && threadIdx.x == 0) F.MISC[40] = (unsigned)(tpv_ * 10ull); }
#else
#if MK_FUSEFIN
            pg8::gemm_phase<pg8::EpiResF, pg8::StaticOrder, MK_ALIGN, MK_SP2>(F.lds + RING_OFF, g, S, E);
#else
            pg8::gemm_phase<pg8::EpiRes, pg8::StaticOrder, MK_ALIGN, MK_SP2>(F.lds + RING_OFF, g, S, E);
#endif
#endif
        }
        if (MK_FUSEFIN && i == DEPTH - 1) ++ph; else if (i < DEPTH - 1) SEAM(); else SEAMG();
        }
    }
#if MK_BARPROBE
    if (blockIdx.x == 0 && threadIdx.x == 0) F.MISC[40] = (unsigned)(__hip_atomic_load((unsigned long long*)((unsigned char*)F.wsg + WS_CTL + (CW_BAR + 3600) * 4), __ATOMIC_RELAXED, __HIP_MEMORY_SCOPE_AGENT) * 10ull / 256ull);
#endif
#if MK_CLKPROBE || MK_TPROBE || MK_BARPROBE || MK_PPPROBE || MK_VWPROBE
    if (blockIdx.x == 0) { __syncthreads(); const unsigned w_ = F.MISC[40]; const unsigned long long t0_ = __builtin_amdgcn_s_memrealtime(); while (__builtin_amdgcn_s_memrealtime() - t0_ < (unsigned long long)w_) __builtin_amdgcn_s_sleep(32); }
#endif
    if (!MK_FUSEFIN && EN(14) && RUN()) normf_phase(F, (float*)F.outg, F.in(IN_FING));
#undef RUN
#undef SEAM
}

extern "C" void kernel_launch(void* const* d_in, const int* in_sizes, int n_in, void* d_out, int out_size, void* d_ws, size_t ws_size, hipStream_t stream) {
    static int grid = 0;
    if (grid == 0) {
        if (n_in != 19 || out_size != MTOK * DM || ws_size < WS_END) { fprintf(stderr, "kernel_launch: unexpected shapes (n_in %d, out %d, ws %zu < %zu)\n", n_in, out_size, ws_size, (size_t)WS_END); grid = -1; return; }
        int dev = 0, cus = 0, per_cu = 0;
        if (hipGetDevice(&dev) != hipSuccess || hipDeviceGetAttribute(&cus, hipDeviceAttributeMultiprocessorCount, dev) != hipSuccess) { grid = -1; return; }
        if (hipFuncSetAttribute((const void*)mega_fwd, hipFuncAttributeMaxDynamicSharedMemorySize, LDS_BYTES) != hipSuccess) { fprintf(stderr, "kernel_launch: hipFuncSetAttribute failed\n"); grid = -1; return; }
        if (hipOccupancyMaxActiveBlocksPerMultiprocessor(&per_cu, (const void*)mega_fwd, NWAVES * 64, LDS_BYTES) != hipSuccess || per_cu < 1) { fprintf(stderr, "kernel_launch: occupancy query says %d\n", per_cu); }
        (void)hipGetLastError();
        grid = cus;
    }
    if (grid < 0) return;
    if (hipMemsetAsync((char*)d_ws + WS_CTL, 0, CTL_ZERO_BYTES, stream) != hipSuccess) return;
    Args a{};
    for (int i = 0; i < 19; ++i) a.in[i] = (const float*)d_in[i];
    a.out = (float*)d_out; a.ws = (unsigned char*)d_ws;
#if MK_PER_PHASE
    for (int p = 0; p < NPHASE; ++p) { a.ph_lo = p; a.ph_hi = p + 1; hipLaunchKernelGGL(mega_fwd, dim3(grid), dim3(NWAVES * 64), LDS_BYTES, stream, a); }
#else
    a.ph_lo = 0; a.ph_hi = NPHASE; hipLaunchKernelGGL(mega_fwd, dim3(grid), dim3(NWAVES * 64), LDS_BYTES, stream, a);
#endif
}
```

```cpp
#include <hip/hip_runtime.h>
#include <hip/hip_bf16.h>
#include <cstdio>
#include <cstdint>
__device__ __forceinline__ int ltid() { int t = (int)threadIdx.x; asm volatile("" : "+v"(t)); return t; }
namespace pg8 {
#define PG8_LAS __attribute__((address_space(3)))
typedef unsigned short bf16_t;
typedef short bf16x8 __attribute__((ext_vector_type(8)));
typedef float f32x4 __attribute__((ext_vector_type(4)));
typedef unsigned u32x4 __attribute__((ext_vector_type(4)));
constexpr int BM = 256, BK = 64, HALF = 128, HTB = HALF * BK * 2  , STAGE_BYTES = 8 * HTB, NXCD = 8;
#ifndef MK_SETPRIO
#define MK_SETPRIO 1
#endif
#ifndef MK_DYNGLOBAL
#define MK_DYNGLOBAL 1
#endif
#ifndef MK_RELAXW
#define MK_RELAXW 0
#endif
#ifndef MK_WGM
#define MK_WGM 4
#endif
constexpr int WGM = MK_WGM;

__host__ __device__ __forceinline__ int lds_byte(int r, int c) { const int st = (r >> 4) * 2 + (c >> 5), rr = r & 15, cc = c & 31, ob = rr * 64 + cc * 2; return st * 1024 + (ob ^ (((ob >> 9) & 1) << 5)); }
__host__ __device__ __forceinline__ void stage_rc(int b, int& R, int& C) { const int st = b / 1024, sb = b % 1024, swz = sb ^ (((sb >> 9) & 1) << 5); R = (st >> 1) * 16 + swz / 64; C = (st & 1) * 32 + (swz % 64) / 2; }
__host__ __device__ __forceinline__ int perm32(int rho) { const int n = rho >> 4, i = rho & 15; return 8 * (i >> 2) + 4 * n + (i & 3); }

struct Unit { int pm, pn; };
struct Gemm { const bf16_t* A; const bf16_t* Bt; int M, N, K; };

struct StaticOrder {
    int nM, nN, nwg, G, c, lim, pm_off;
    __host__ __device__ void init(int M, int N, int G_, int c_) { nM = M / BM; nN = N / BM; nwg = nM * nN; G = G_; c = c_; lim = nwg; pm_off = 0; }
    __host__ __device__ bool next(int i, Unit& u) const { const long L = (long)i * G + c; if (L >= lim) return false; unit_of((int)L, u); return true; }
    __host__ __device__ void unit_of(int L, Unit& u) const {
        int wgid = L; { const int q = nwg / NXCD, r = nwg % NXCD, xcd = wgid % NXCD, off = wgid / NXCD; wgid = (xcd < r ? xcd * (q + 1) : r * (q + 1) + (xcd - r) * q) + off; }
        const int nig = WGM * nN, gid = wgid / nig, fm = gid * WGM, gsz = (nM - fm) < WGM ? (nM - fm) : WGM;
        u.pm = pm_off + fm + ((wgid % nig) % gsz); u.pn = (wgid % nig) / gsz;
    }
    __device__ __forceinline__ void a_ready(const Unit&) const {}
    __device__ __forceinline__ void done(const Unit&) const {}
};
struct TailClaimOrder : StaticOrder {
    int nfull, cls, nleft; unsigned* cnt; volatile PG8_LAS unsigned* slot;
    __device__ __forceinline__ void init_tail(unsigned* counters  , volatile PG8_LAS unsigned* slot_) {
        nfull = (nwg / G) * G; cls = MK_DYNGLOBAL ? 0 : (c & 7); nleft = MK_DYNGLOBAL ? (nwg - nfull) : (nwg - nfull + 7 - cls) / 8; cnt = counters + cls * 64; slot = slot_; }
    __device__ __forceinline__ bool next(int i, Unit& u) const {
        const int L = i * G + c;
        if (L < nfull) { unit_of(L, u); return true; }
        if (i * G != nfull) return false;
        if (threadIdx.x == 0) { const unsigned k = __hip_atomic_fetch_add((__attribute__((address_space(1))) unsigned*)cnt, 1u, __ATOMIC_RELAXED, __HIP_MEMORY_SCOPE_AGENT); *slot = k; }
        asm volatile("s_waitcnt lgkmcnt(0)" ::: "memory"); __builtin_amdgcn_s_barrier(); asm volatile("" ::: "memory");
        const int k = __builtin_amdgcn_readfirstlane((int)*slot);
        if (k >= nleft) return false;
        unit_of(MK_DYNGLOBAL ? (nfull + k) : (nfull + 8 * k + cls), u); return true;
    }
};
struct OneUnit { Unit u;
    __device__ __forceinline__ bool next(int i, Unit& v) const { if (i != 0) return false; v = u; return true; }
    __device__ __forceinline__ void a_ready(const Unit&) const {}
    __device__ __forceinline__ void done(const Unit&) const {}
};
__device__ __forceinline__ unsigned cvt_pk_bf16(float lo, float hi) { unsigned r; asm volatile("v_cvt_pk_bf16_f32 %0, %1, %2" : "=v"(r) : "v"(lo), "v"(hi)); return r; }
typedef float f32x2 __attribute__((ext_vector_type(2)));
__device__ __forceinline__ f32x2 gelu_pk(f32x2 v) {
    const f32x2 av = __builtin_elementwise_abs(v), d = av * 0.2316418882f + 1.0f;
    f32x2 t; t.x = __builtin_amdgcn_rcpf(d.x); t.y = __builtin_amdgcn_rcpf(d.y);
    f32x2 q = t * 0.5307027145f + (-0.7265760135f); q = q * t + 0.7107068705f; q = q * t + (-0.142248368f); q = q * t + 0.127414796f; q = q * t;
    const f32x2 s = (v * v) * (-0.72134752044f);
    f32x2 e; e.x = __builtin_amdgcn_exp2f(s.x); e.y = __builtin_amdgcn_exp2f(s.y);
    const f32x2 m = v * (q * e), r = v - m;
    f32x2 o; o.x = v.x < 0.f ? m.x : r.x; o.y = v.y < 0.f ? m.y : r.y; return o;
}

#ifndef MK_NTST
#define MK_NTST 0
#endif
#if MK_NTST
#define EPI_ST16(p, v) __builtin_nontemporal_store((v), (u32x4*)(p))
#else
#define EPI_ST16(p, v) (*(u32x4*)(p) = (v))
#endif
struct RowAffine {
    const unsigned long long* rss; const float* biasb;
    int bpitch; PG8_LAS float* T;
    template <bool UPGATE> __device__ __forceinline__ void stage(const Unit& u, int p, int wid, int lane) const {
        if (wid == 0 || wid == 2) __builtin_amdgcn_global_load_lds((const unsigned*)(rss + (size_t)u.pm * BM + wid * 64 + lane * 2), (PG8_LAS unsigned*)(T + p * 768 + wid * 128), 16, 0, 0);
        if (wid == 1) { const int b = (u.pm * BM) >> 12;
            const int col = UPGATE ? ((lane < 32) ? (u.pn * 128 + lane * 4) : (5504 + u.pn * 128 + (lane - 32) * 4)) : (u.pn * BM + lane * 4);
            __builtin_amdgcn_global_load_lds((const unsigned*)(biasb + (size_t)b * bpitch + col), (PG8_LAS unsigned*)(T + p * 768 + 512), 16, 0, 0); }
    }
    template <bool PR = false> __device__ __forceinline__ void apply(f32x4 (&acc)[2][2][4][2], int p, int wr, int wc, int fr, int fq) const {
        const PG8_LAS unsigned long long* Tr = (const PG8_LAS unsigned long long*)(T + p * 768) + wr * 64 + (PR ? 4 * fr : fr); const PG8_LAS float* Tb = T + p * 768 + 512 + wc * 32 + 8 * fq;
        float rs[2][4];
#pragma unroll
        for (int ai = 0; ai < 2; ++ai)
#pragma unroll
            for (int m = 0; m < 4; ++m) rs[ai][m] = __builtin_amdgcn_rsqf((float)Tr[ai * HALF + (PR ? m : m * 16)] * (1.0f / (1048576.0f * 2048.0f)) + 1e-6f);
#pragma unroll
        for (int bj = 0; bj < 2; ++bj)
#pragma unroll
            for (int n = 0; n < 2; ++n) { const f32x4 bv = *(const PG8_LAS f32x4*)(Tb + bj * HALF + 4 * n);
#pragma unroll
                for (int ai = 0; ai < 2; ++ai)
#pragma unroll
                    for (int m = 0; m < 4; ++m) acc[ai][bj][m][n] = acc[ai][bj][m][n] * rs[ai][m] + bv; }
    }
};
__device__ __forceinline__ float gelu_tanh1(float v) {
    const float u = v * (0.7978845608f + 0.0356774081f * v * v);
    const float e = __builtin_amdgcn_exp2f(u * -2.8853900818f);
    return v * __builtin_amdgcn_rcpf(1.0f + e);
}
__device__ __forceinline__ f32x4 gelu_tanh4(f32x4 v) {
    const f32x4 u = v * (v * v * 0.0356774081f + 0.7978845608f);
    const f32x4 a = u * -2.8853900818f;
    f32x4 e; e.x = __builtin_amdgcn_exp2f(a.x); e.y = __builtin_amdgcn_exp2f(a.y); e.z = __builtin_amdgcn_exp2f(a.z); e.w = __builtin_amdgcn_exp2f(a.w);
    const f32x4 d = e + 1.0f;
    f32x4 r; r.x = __builtin_amdgcn_rcpf(d.x); r.y = __builtin_amdgcn_rcpf(d.y); r.z = __builtin_amdgcn_rcpf(d.z); r.w = __builtin_amdgcn_rcpf(d.w);
    return v * r;
}
template <int ACT  > struct EpiStore {
    static constexpr bool PERM = true, AFTER_DRAIN = false, PERMROW = false;
    bf16_t* O; int ldc; RowAffine ra; unsigned long long* vss; size_t obump;
    __device__ __forceinline__ void stage(const Unit& u, int p, int wid, int lane) const { ra.stage<false>(u, p, wid, lane); }
    __device__ __forceinline__ void operator()(f32x4 (&acc)[2][2][4][2], const Unit& u, int p, int wr, int wc, int fr, int fq) const {
        ra.apply(acc, p, wr, wc, fr, fq);
        const int row0 = u.pm * BM + wr * 64 + fr, col0 = u.pn * BM + wc * 32 + 8 * fq; float ssq[8];
#pragma unroll
        for (int ai = 0; ai < 2; ++ai)
#pragma unroll
            for (int m = 0; m < 4; ++m) { bf16_t* rowp = O + (size_t)((u.pm * BM) >> 12) * obump + (size_t)(row0 + ai * HALF + m * 16) * ldc + col0; float s = 0.f;
#pragma unroll
                for (int bj = 0; bj < 2; ++bj) { f32x4 v0 = acc[ai][bj][m][0], v1 = acc[ai][bj][m][1];
                    if (ACT == 1) { v0 = gelu_tanh4(v0); v1 = gelu_tanh4(v1); }
                    s += (v0[0] * v0[0] + v0[1] * v0[1]) + (v0[2] * v0[2] + v0[3] * v0[3]) + (v1[0] * v1[0] + v1[1] * v1[1]) + (v1[2] * v1[2] + v1[3] * v1[3]);
                    u32x4 w; w.x = cvt_pk_bf16(v0[0], v0[1]); w.y = cvt_pk_bf16(v0[2], v0[3]); w.z = cvt_pk_bf16(v1[0], v1[1]); w.w = cvt_pk_bf16(v1[2], v1[3]);
                    EPI_ST16(rowp + bj * HALF, w); }
                ssq[ai * 4 + m] = s; }
        if (vss && u.pn >= 8) {
#pragma unroll
            for (int k = 0; k < 8; ++k) ssq[k] += __shfl_xor(ssq[k], 16);
#pragma unroll
            for (int k = 0; k < 8; ++k) ssq[k] += __shfl_xor(ssq[k], 32);
            if (fq == 0) {
#pragma unroll
                for (int k = 0; k < 8; ++k) __hip_atomic_fetch_add(vss + row0 + (k >> 2) * HALF + (k & 3) * 16, (unsigned long long)(ssq[k] * 1048576.0f), __ATOMIC_RELAXED, __HIP_MEMORY_SCOPE_AGENT); } }
    }
};
struct EpiQKV {
    static constexpr bool PERM = true, AFTER_DRAIN = false, PERMROW = false;
    bf16_t* QKV; size_t tstride, bstride; float qscale; RowAffine ra;
    __device__ __forceinline__ void stage(const Unit& u, int p, int wid, int lane) const { ra.stage<false>(u, p, wid, lane); }
    __device__ __forceinline__ void operator()(f32x4 (&acc)[2][2][4][2], const Unit& u, int p, int wr, int wc, int fr, int fq) const {
        ra.apply(acc, p, wr, wc, fr, fq);
        const int tok0 = u.pm * BM, b = tok0 >> 12, s0 = (tok0 & 4095) + wr * 64 + fr;
        const int colt = u.pn * BM, t = colt >> 11, hd0 = (colt & 2047) >> 7;
        bf16_t* base = QKV + (size_t)b * bstride + (size_t)t * tstride; const float sc = t == 0 ? qscale : 1.0f;
#pragma unroll
        for (int bj = 0; bj < 2; ++bj) { bf16_t* hb = base + ((size_t)(hd0 + bj) * 4096 + s0) * 128 + wc * 32 + 8 * fq;
#pragma unroll
            for (int ai = 0; ai < 2; ++ai)
#pragma unroll
                for (int m = 0; m < 4; ++m) { const f32x4 v0 = acc[ai][bj][m][0] * sc, v1 = acc[ai][bj][m][1] * sc;
                    u32x4 w; w.x = cvt_pk_bf16(v0[0], v0[1]); w.y = cvt_pk_bf16(v0[2], v0[3]); w.z = cvt_pk_bf16(v1[0], v1[1]); w.w = cvt_pk_bf16(v1[2], v1[3]);
                    EPI_ST16(hb + (size_t)(ai * HALF + m * 16) * 128, w); } }
    }
};
struct EpiRes {
    static constexpr bool PERM = true, AFTER_DRAIN = false, PERMROW = false;
    bf16_t* xb; const float* gate; int gpitch; bf16_t* xg; const float* gn; const float* scn; unsigned long long* rss; PG8_LAS float* T; float* xf;
    __device__ __forceinline__ void stage(const Unit& u, int p, int wid, int lane) const { const int b = (u.pm * BM) >> 12, c = u.pn * BM + lane * 4;
        if (wid == 0) __builtin_amdgcn_global_load_lds((const unsigned*)(gate + (size_t)b * gpitch + c), (PG8_LAS unsigned*)(T + p * 768), 16, 0, 0);
        if (wid == 1 && xg) __builtin_amdgcn_global_load_lds((const unsigned*)(gn + c), (PG8_LAS unsigned*)(T + p * 768 + 256), 16, 0, 0);
        if (wid == 2 && xg) __builtin_amdgcn_global_load_lds((const unsigned*)(scn + (size_t)b * gpitch + c), (PG8_LAS unsigned*)(T + p * 768 + 512), 16, 0, 0); }
    __device__ __forceinline__ void operator()(const f32x4 (&acc)[2][2][4][2], const Unit& u, int p, int wr, int wc, int fr, int fq) const {
        const int row0 = u.pm * BM + wr * 64 + fr, col0 = u.pn * BM + wc * 32 + 8 * fq; const PG8_LAS float* Tc = T + p * 768 + wc * 32 + 8 * fq;
        u32x4 xbuf[4][2];
#define ER_LOAD(k) do { const size_t off_ = (size_t)(row0 + ((k) >> 2) * HALF + ((k) & 3) * 16) * 2048 + col0; _Pragma("unroll") for (int bj = 0; bj < 2; ++bj) xbuf[(k) % 4][bj] = *(const u32x4*)(xb + off_ + bj * HALF); } while (0)
        ER_LOAD(0); ER_LOAD(1); ER_LOAD(2); ER_LOAD(3);
        f32x4 gv[2][2], gs[2][2];
#pragma unroll
        for (int bj = 0; bj < 2; ++bj)
#pragma unroll
            for (int n = 0; n < 2; ++n) { gv[bj][n] = *(const PG8_LAS f32x4*)(Tc + bj * HALF + n * 4);
                gs[bj][n] = xg ? *(const PG8_LAS f32x4*)(Tc + 256 + bj * HALF + n * 4) * (*(const PG8_LAS f32x4*)(Tc + 512 + bj * HALF + n * 4) + 1.0f) : (f32x4){0.f, 0.f, 0.f, 0.f}; }
        float ss[8];
#pragma unroll
        for (int k = 0; k < 8; ++k) { const int ai = k >> 2, m = k & 3, row = row0 + ai * HALF + m * 16; const size_t off = (size_t)row * 2048 + col0; float s = 0.f;
            __builtin_amdgcn_sched_barrier(0);
#pragma unroll
            for (int bj = 0; bj < 2; ++bj) { const u32x4 xw = xbuf[k % 4][bj];
                const f32x4 x0 = (f32x4){__builtin_bit_cast(float, xw.x << 16), __builtin_bit_cast(float, xw.x & 0xffff0000u), __builtin_bit_cast(float, xw.y << 16), __builtin_bit_cast(float, xw.y & 0xffff0000u)};
                const f32x4 x1 = (f32x4){__builtin_bit_cast(float, xw.z << 16), __builtin_bit_cast(float, xw.z & 0xffff0000u), __builtin_bit_cast(float, xw.w << 16), __builtin_bit_cast(float, xw.w & 0xffff0000u)};
                const f32x4 o0 = x0 + gv[bj][0] * acc[ai][bj][m][0], o1 = x1 + gv[bj][1] * acc[ai][bj][m][1];
                u32x4 w; w.x = cvt_pk_bf16(o0[0], o0[1]); w.y = cvt_pk_bf16(o0[2], o0[3]); w.z = cvt_pk_bf16(o1[0], o1[1]); w.w = cvt_pk_bf16(o1[2], o1[3]);
                if (xf) { *(f32x4*)(xf + off + bj * HALF) = o0; *(f32x4*)(xf + off + bj * HALF + 4) = o1; } else EPI_ST16(xb + off + bj * HALF, w);
                if (xg) { const f32x4 y0 = o0 * gs[bj][0], y1 = o1 * gs[bj][1]; u32x4 g; g.x = cvt_pk_bf16(y0[0], y0[1]); g.y = cvt_pk_bf16(y0[2], y0[3]); g.z = cvt_pk_bf16(y1[0], y1[1]); g.w = cvt_pk_bf16(y1[2], y1[3]);
                    EPI_ST16(xg + off + bj * HALF, g);
                    s += (o0[0] * o0[0] + o0[1] * o0[1]) + (o0[2] * o0[2] + o0[3] * o0[3]) + (o1[0] * o1[0] + o1[1] * o1[1]) + (o1[2] * o1[2] + o1[3] * o1[3]); } }
            ss[k] = s;
            __builtin_amdgcn_sched_barrier(0);
            if (k + 4 < 8) ER_LOAD(k + 4); }
#undef ER_LOAD
        if (xg) {
#pragma unroll
            for (int k = 0; k < 8; ++k) ss[k] += __shfl_xor(ss[k], 16);
#pragma unroll
            for (int k = 0; k < 8; ++k) ss[k] += __shfl_xor(ss[k], 32);
            if (fq == 0) {
#pragma unroll
                for (int k = 0; k < 8; ++k) __hip_atomic_fetch_add(rss + row0 + (k >> 2) * HALF + (k & 3) * 16, (unsigned long long)(ss[k] * 1048576.0f), __ATOMIC_RELAXED, __HIP_MEMORY_SCOPE_AGENT); } }
    }
};
struct EpiResF : EpiRes {
    float* outp; const float* gfin; unsigned long long* rssf; unsigned* pcnt;
    __device__ __forceinline__ void stage(const Unit& u, int p, int wid, int lane) const { const int b = (u.pm * BM) >> 12, c = u.pn * BM + lane * 4;
        if (wid == 0) __builtin_amdgcn_global_load_lds((const unsigned*)(gate + (size_t)b * gpitch + c), (PG8_LAS unsigned*)(T + p * 768), 16, 0, 0);
        if (wid == 1 && (xg || outp)) __builtin_amdgcn_global_load_lds((const unsigned*)((outp ? gfin : gn) + c), (PG8_LAS unsigned*)(T + p * 768 + 256), 16, 0, 0);
        if (wid == 2 && xg) __builtin_amdgcn_global_load_lds((const unsigned*)(scn + (size_t)b * gpitch + c), (PG8_LAS unsigned*)(T + p * 768 + 512), 16, 0, 0); }
    __device__ __forceinline__ void operator()(f32x4 (&acc)[2][2][4][2], const Unit& u, int p, int wr, int wc, int fr, int fq) const {
        if (!outp) { EpiRes::operator()(acc, u, p, wr, wc, fr, fq); return; }
        asm volatile("; final-norm epilogue" ::: "memory");
        const int row0 = u.pm * BM + wr * 64 + fr, col0 = u.pn * BM + wc * 32 + 8 * fq; const PG8_LAS float* Tc = T + p * 768 + wc * 32 + 8 * fq;
        u32x4 xbuf[4][2];
#define ER_LOAD(k) do { const size_t off_ = (size_t)(row0 + ((k) >> 2) * HALF + ((k) & 3) * 16) * 2048 + col0; _Pragma("unroll") for (int bj = 0; bj < 2; ++bj) xbuf[(k) % 4][bj] = *(const u32x4*)(xb + off_ + bj * HALF); } while (0)
#define ER_X(xw, g0, g1, a0, a1, o0, o1) const f32x4 o0 = (f32x4){__builtin_bit_cast(float, xw.x << 16), __builtin_bit_cast(float, xw.x & 0xffff0000u), __builtin_bit_cast(float, xw.y << 16), __builtin_bit_cast(float, xw.y & 0xffff0000u)} + g0 * a0, \
                                                            o1 = (f32x4){__builtin_bit_cast(float, xw.z << 16), __builtin_bit_cast(float, xw.z & 0xffff0000u), __builtin_bit_cast(float, xw.w << 16), __builtin_bit_cast(float, xw.w & 0xffff0000u)} + g1 * a1
        ER_LOAD(0); ER_LOAD(1); ER_LOAD(2); ER_LOAD(3);
        f32x4 gv[2][2];
#pragma unroll
        for (int bj = 0; bj < 2; ++bj)
#pragma unroll
            for (int n = 0; n < 2; ++n) gv[bj][n] = *(const PG8_LAS f32x4*)(Tc + bj * HALF + n * 4);
        float ss[8];
#pragma unroll
        for (int k = 0; k < 8; ++k) { const int ai = k >> 2, m = k & 3; float s = 0.f;
            __builtin_amdgcn_sched_barrier(0);
#pragma unroll
            for (int bj = 0; bj < 2; ++bj) { const u32x4 xw = xbuf[k % 4][bj]; ER_X(xw, gv[bj][0], gv[bj][1], acc[ai][bj][m][0], acc[ai][bj][m][1], o0, o1);
                s += (o0[0] * o0[0] + o0[1] * o0[1]) + (o0[2] * o0[2] + o0[3] * o0[3]) + (o1[0] * o1[0] + o1[1] * o1[1]) + (o1[2] * o1[2] + o1[3] * o1[3]); }
            ss[k] = s;
            __builtin_amdgcn_sched_barrier(0);
            ER_LOAD((k + 4) & 7); }
#pragma unroll
        for (int k = 0; k < 8; ++k) ss[k] += __shfl_xor(ss[k], 16);
#pragma unroll
        for (int k = 0; k < 8; ++k) ss[k] += __shfl_xor(ss[k], 32);
        unsigned long long old = 0;
        if (fq == 0) {
#pragma unroll
            for (int k = 0; k < 8; ++k) old |= __hip_atomic_fetch_add(rssf + row0 + (k >> 2) * HALF + (k & 3) * 16, (unsigned long long)(ss[k] * 1048576.0f), __ATOMIC_RELAXED, __HIP_MEMORY_SCOPE_AGENT); }
        asm volatile("" :: "v"((unsigned)old), "v"((unsigned)(old >> 32)) : "memory");
        unsigned* cnt = pcnt + u.pm * 16;
        if ((threadIdx.x & 63) == 0) { __hip_atomic_fetch_add(cnt, 1u, __ATOMIC_RELAXED, __HIP_MEMORY_SCOPE_AGENT);
            unsigned tries = 0; while (__hip_atomic_load(cnt, __ATOMIC_RELAXED, __HIP_MEMORY_SCOPE_AGENT) < 64u && ++tries < (1u << 21)) __builtin_amdgcn_s_sleep(4); }
        asm volatile("" : "+v"(gv[0][0]), "+v"(gv[0][1]), "+v"(gv[1][0]), "+v"(gv[1][1]) :: "memory");
        float rs[8];
#pragma unroll
        for (int k = 0; k < 8; ++k) rs[k] = __builtin_amdgcn_rsqf((float)__hip_atomic_load(rssf + row0 + (k >> 2) * HALF + (k & 3) * 16, __ATOMIC_RELAXED, __HIP_MEMORY_SCOPE_AGENT) * (1.0f / (1048576.0f * 2048.0f)) + 1e-6f);
        int row0b = row0; asm volatile("" : "+v"(row0b));
        f32x4 gf[2][2];
#pragma unroll
        for (int bj = 0; bj < 2; ++bj)
#pragma unroll
            for (int n = 0; n < 2; ++n) gf[bj][n] = *(const PG8_LAS f32x4*)(Tc + 256 + bj * HALF + n * 4);
#pragma unroll
        for (int k = 0; k < 8; ++k) { const int ai = k >> 2, m = k & 3; const size_t off = (size_t)(row0b + ai * HALF + m * 16) * 2048 + col0;
            __builtin_amdgcn_sched_barrier(0);
#pragma unroll
            for (int bj = 0; bj < 2; ++bj) { const u32x4 xw = xbuf[k % 4][bj]; ER_X(xw, gv[bj][0], gv[bj][1], acc[ai][bj][m][0], acc[ai][bj][m][1], o0, o1);
                *(f32x4*)(outp + off + bj * HALF) = o0 * (gf[bj][0] * rs[k]); *(f32x4*)(outp + off + bj * HALF + 4) = o1 * (gf[bj][1] * rs[k]); }
            __builtin_amdgcn_sched_barrier(0);
            if (k + 4 < 8) ER_LOAD(k + 4); }
#undef ER_X
#undef ER_LOAD
    }
};
__device__ __forceinline__ int f2i(float v) { return __builtin_bit_cast(int, v); }
__device__ __forceinline__ float i2f(int v) { return __builtin_bit_cast(float, v); }
template <int SH> __device__ __forceinline__ float dpp_ror(float v) { return i2f(__builtin_amdgcn_update_dpp(0, f2i(v), 0x120 + SH, 0xf, 0xf, true)); }
template <int SH> __device__ __forceinline__ float dpp_shr_fill(float fill, float cur) { return i2f(__builtin_amdgcn_update_dpp(f2i(fill), f2i(cur), 0x110 + SH, 0xf, 0xf, false)); }
struct EpiConv {
    static constexpr bool PERM = true, AFTER_DRAIN = false, PERMROW = true;
    bf16_t* ACT; const float* cw; const float* cb; float* HALO; PG8_LAS float* X; RowAffine ra; PG8_LAS float* TW;
    __device__ __forceinline__ void stage(const Unit& u, int p, int wid, int lane) const { ra.stage<true>(u, p, wid, lane);
        if (wid >= 3 && wid <= 6) { const int k = wid - 3, col = (lane < 32) ? (u.pn * 128 + lane * 4) : (5504 + u.pn * 128 + (lane - 32) * 4);
            __builtin_amdgcn_global_load_lds((const unsigned*)((k < 3 ? cw + (size_t)k * 11008 : cb) + col), (PG8_LAS unsigned*)(TW + p * 1024 + k * 256), 16, 0, 0); } }
    __device__ __forceinline__ void operator()(f32x4 (&acc)[2][2][4][2], const Unit& u, int p, int wr, int wc, int fr, int fq) const {
        const int tcol = wc * 32 + 8 * fq, ch0 = u.pn * 128 + tcol;
        ra.apply<true>(acc, p, wr, wc, fr, fq);
#if defined(MK_KREP) && MK_KREP > 1
#pragma unroll
        for (int ai = 0; ai < 2; ++ai)
#pragma unroll
            for (int bj = 0; bj < 2; ++bj)
#pragma unroll
                for (int m = 0; m < 4; ++m)
#pragma unroll
                    for (int n = 0; n < 2; ++n) acc[ai][bj][m][n] *= (1.0f / MK_KREP);
#endif
        if (fr == 15) {
#pragma unroll
            for (int ai = 0; ai < 2; ++ai)
#pragma unroll
                for (int mm = 0; mm < 2; ++mm)
#pragma unroll
                    for (int bj = 0; bj < 2; ++bj)
#pragma unroll
                        for (int n = 0; n < 2; ++n) *(PG8_LAS f32x4*)(X + (((ai * 2 + wr) * 2 + mm) * 256) + bj * 128 + tcol + 4 * n) = acc[ai][bj][2 + mm][n];
            if (wr == 1) {
#pragma unroll
                for (int mm = 0; mm < 2; ++mm)
#pragma unroll
                    for (int bj = 0; bj < 2; ++bj)
#pragma unroll
                        for (int n = 0; n < 2; ++n) *(f32x4*)(HALO + ((size_t)u.pm * 4 + 2 + mm) * 11008 + bj * 5504 + ch0 + 4 * n) = acc[1][bj][2 + mm][n]; }
        }
        if (fr == 0 && wr == 0) {
#pragma unroll
            for (int mm = 0; mm < 2; ++mm)
#pragma unroll
                for (int bj = 0; bj < 2; ++bj)
#pragma unroll
                    for (int n = 0; n < 2; ++n) *(f32x4*)(HALO + ((size_t)u.pm * 4 + mm) * 11008 + bj * 5504 + ch0 + 4 * n) = acc[0][bj][mm][n]; }
        asm volatile("s_waitcnt lgkmcnt(0)" ::: "memory"); __builtin_amdgcn_s_barrier(); asm volatile("" ::: "memory");
        const PG8_LAS float* Tw = TW + p * 1024 + tcol;
        const int row0 = u.pm * BM + wr * 64 + 4 * fr;
#pragma unroll
        for (int ai = 0; ai < 2; ++ai) { const int g = ai * 2 + wr;
#pragma unroll
            for (int bj = 0; bj < 2; ++bj)
#pragma unroll
                for (int n = 0; n < 2; ++n) {
                    const f32x4 w0 = *(const PG8_LAS f32x4*)(Tw + bj * 128 + 4 * n), w1 = *(const PG8_LAS f32x4*)(Tw + 256 + bj * 128 + 4 * n), w2 = *(const PG8_LAS f32x4*)(Tw + 512 + bj * 128 + 4 * n), bb = *(const PG8_LAS f32x4*)(Tw + 768 + bj * 128 + 4 * n);
                    f32x4 h62 = (f32x4){0.f, 0.f, 0.f, 0.f}, h63 = h62;
                    if (g > 0) { h62 = *(const PG8_LAS f32x4*)(X + (((g - 1) * 2 + 0) * 256) + bj * 128 + tcol + 4 * n); h63 = *(const PG8_LAS f32x4*)(X + (((g - 1) * 2 + 1) * 256) + bj * 128 + tcol + 4 * n); }
                    const f32x4 x0 = acc[ai][bj][0][n], x1 = acc[ai][bj][1][n], x2 = acc[ai][bj][2][n], x3 = acc[ai][bj][3][n];
                    f32x4 s2, s3;
#pragma unroll
                    for (int e = 0; e < 4; ++e) { s3[e] = dpp_shr_fill<1>(h63[e], x3[e]); s2[e] = dpp_shr_fill<1>(h62[e], x2[e]); }
                    f32x4 r0 = bb + w2 * x0 + w1 * s3 + w0 * s2, r1 = bb + w2 * x1 + w1 * x0 + w0 * s3, r2 = bb + w2 * x2 + w1 * x1 + w0 * x0, r3 = bb + w2 * x3 + w1 * x2 + w0 * x1;
                    asm volatile("" : "+v"(r0), "+v"(r1), "+v"(r2), "+v"(r3));
                    acc[ai][bj][0][n] = r0; acc[ai][bj][1][n] = r1; acc[ai][bj][2][n] = r2; acc[ai][bj][3][n] = r3;
                    __builtin_amdgcn_sched_barrier(0); }
#pragma unroll
            for (int m = 0; m < 4; ++m) { f32x4 o[2];
#pragma unroll
                for (int n = 0; n < 2; ++n) { const f32x4 gt = acc[ai][0][m][n], a = gt * -1.4426950408889634f, gu = gt * acc[ai][1][m][n];
                    f32x4 ex; ex.x = __builtin_amdgcn_exp2f(a.x); ex.y = __builtin_amdgcn_exp2f(a.y); ex.z = __builtin_amdgcn_exp2f(a.z); ex.w = __builtin_amdgcn_exp2f(a.w);
                    const f32x4 d = ex + 1.0f; f32x4 r; r.x = __builtin_amdgcn_rcpf(d.x); r.y = __builtin_amdgcn_rcpf(d.y); r.z = __builtin_amdgcn_rcpf(d.z); r.w = __builtin_amdgcn_rcpf(d.w);
                    o[n] = gu * r; }
                u32x4 w; w.x = cvt_pk_bf16(o[0][0], o[0][1]); w.y = cvt_pk_bf16(o[0][2], o[0][3]); w.z = cvt_pk_bf16(o[1][0], o[1][1]); w.w = cvt_pk_bf16(o[1][2], o[1][3]);
                EPI_ST16(ACT + (size_t)(row0 + ai * HALF + m) * 5504 + ch0, w); }
            __builtin_amdgcn_sched_barrier(0); }
    }
};
template <class Epi, class Sched, bool ALIGN_EPI = false, bool SP2 = false, int KREP = 1, int TP = 0>
__device__ __forceinline__ void gemm_phase(PG8_LAS unsigned char* lds, const Gemm g, const Sched& S, const Epi& E, unsigned long long* tp_out = nullptr) {
    unsigned long long tp_acc = 0, tp3 = 0;
    const int tid = ltid(), wid = __builtin_amdgcn_readfirstlane(tid >> 6), lane = tid & 63, wr = wid >> 2, wc = wid & 3, fr = lane & 15, fq = lane >> 4;
    const int K = g.K, nt = K / BK;
    unsigned voffA[2], voffB[2];
#pragma unroll
    for (int i = 0; i < 2; ++i) { int R, C; stage_rc(tid * 16 + i * 8192, R, C); const int Rb = Epi::PERM ? ((R & ~31) + perm32(R & 31)) : R;
        const int Ra = Epi::PERMROW ? ((R & ~63) + 4 * (R & 15) + ((R >> 4) & 3)) : R;
        voffA[i] = (unsigned)(Ra * K + C) * 2u; voffB[i] = (unsigned)(Rb * K + C) * 2u; }
    const size_t kstep = (size_t)(BK * 2);
    const size_t hstep = (size_t)HALF * K * 2;
    const size_t tstep = 2 * hstep;
    const unsigned ldsw = (unsigned)wid * 1024u;
    const int aoff = lds_byte(wr * 64 + fr, fq * 8), boff = lds_byte(wc * 32 + fr, fq * 8);
#define PG8_SA(b, h) (((b) * 2 + (h)) * HTB)
#define PG8_SB(b, h) ((4 + (b) * 2 + (h)) * HTB)
#define PG8_STAGE(bufoff, gbase, voff) do { _Pragma("unroll") for (int _i = 0; _i < 2; ++_i) \
        __builtin_amdgcn_global_load_lds((const unsigned*)((const char*)(gbase) + (voff)[_i]), (PG8_LAS unsigned*)(lds + (bufoff) + ldsw + _i * 8192), 16, 0, 0); } while (0)
#define PG8_LDA(dst, b, h) do { _Pragma("unroll") for (int m = 0; m < 4; ++m) _Pragma("unroll") for (int k = 0; k < 2; ++k) dst[m][k] = *(const PG8_LAS bf16x8*)(lds + PG8_SA(b, h) + aoff + m * 2048 + k * 1024); } while (0)
#define PG8_LDB(dst, b, h) do { _Pragma("unroll") for (int n = 0; n < 2; ++n) _Pragma("unroll") for (int k = 0; k < 2; ++k) dst[n][k] = *(const PG8_LAS bf16x8*)(lds + PG8_SB(b, h) + boff + n * 2048 + k * 1024); } while (0)
#define PG8_MMA(ai, bj, At, Bt) do { if (MK_SETPRIO) __builtin_amdgcn_s_setprio(MK_SETPRIO); _Pragma("unroll") for (int m = 0; m < 4; ++m) _Pragma("unroll") for (int n = 0; n < 2; ++n) _Pragma("unroll") for (int k = 0; k < 2; ++k) \
        acc[ai][bj][m][n] = __builtin_amdgcn_mfma_f32_16x16x32_bf16(Bt[n][k], At[m][k], acc[ai][bj][m][n], 0, 0, 0); if (MK_SETPRIO) __builtin_amdgcn_s_setprio(0); } while (0)
#define PG8_WAIT_V(n) asm volatile("s_waitcnt vmcnt(" #n ")" ::: "memory")
#define PG8_WAIT_L(n) asm volatile("s_waitcnt lgkmcnt(" #n ")" ::: "memory")
#define PG8_WAIT_V_SEL(sel) asm volatile("s_cmp_eq_u32 %0, 0\n\ts_cbranch_scc1 .Lw8_%=\n\ts_waitcnt vmcnt(22)\n\ts_branch .Lwd_%=\n.Lw8_%=:\n\ts_waitcnt vmcnt(8)\n.Lwd_%=:" :: "s"(sel) : "memory", "scc")
#define PG8_BAR __builtin_amdgcn_s_barrier()
#define PG8_SCHED __builtin_amdgcn_sched_barrier(0)
    Unit cur, nxt; int ui = 0;
    if (!S.next(0, cur)) return;
    E.stage(cur, 0, wid, lane);
    f32x4 acc[2][2][4][2];
#pragma unroll
    for (int a = 0; a < 2; ++a)
#pragma unroll
        for (int b = 0; b < 2; ++b)
#pragma unroll
            for (int m = 0; m < 4; ++m)
#pragma unroll
                for (int n = 0; n < 2; ++n) acc[a][b][m][n] = (f32x4){0.f, 0.f, 0.f, 0.f};
    bf16x8 At[4][2], B0[2][2], B1[2][2];
    const char* cA = (const char*)g.A + (size_t)cur.pm * tstep; const char* cB = (const char*)g.Bt + (size_t)cur.pn * tstep;
    S.a_ready(cur);
    if constexpr (SP2) {
        PG8_STAGE(PG8_SB(0, 0), cB, voffB); PG8_STAGE(PG8_SB(0, 1), cB + hstep, voffB); PG8_STAGE(PG8_SA(0, 0), cA, voffA); PG8_STAGE(PG8_SA(0, 1), cA + hstep, voffA);
        if (wr == 1) PG8_BAR;
        PG8_WAIT_V(2); PG8_BAR;
        PG8_STAGE(PG8_SB(1, 0), cB + kstep, voffB); PG8_STAGE(PG8_SA(1, 0), cA + kstep, voffA); PG8_STAGE(PG8_SB(1, 1), cB + hstep + kstep, voffB);
        PG8_WAIT_V(6); PG8_BAR;
    } else {
        PG8_STAGE(PG8_SB(0, 0), cB, voffB); PG8_STAGE(PG8_SA(0, 0), cA, voffA); PG8_STAGE(PG8_SB(0, 1), cB + hstep, voffB); PG8_STAGE(PG8_SA(0, 1), cA + hstep, voffA);
        if (wr == 1) PG8_BAR;
        PG8_WAIT_V(4); PG8_BAR;
        PG8_STAGE(PG8_SB(1, 0), cB + kstep, voffB); PG8_STAGE(PG8_SA(1, 0), cA + kstep, voffA); PG8_STAGE(PG8_SB(1, 1), cB + hstep + kstep, voffB);
        PG8_WAIT_V(6); PG8_BAR;
    }
    for (;;) {
        const bool has_next = S.next(ui + 1, nxt);
        if constexpr (TP == 3) { if (ui > 0) tp_acc += __builtin_amdgcn_s_memrealtime() - tp3; }
        const char* nA = has_next ? (const char*)g.A + (size_t)nxt.pm * tstep : cA; const char* nB = has_next ? (const char*)g.Bt + (size_t)nxt.pn * tstep : cB;
        for (int t = 0; t < nt * KREP; t += 2) {
            const bool last = (t == nt * KREP - 2);
            const int t1w = KREP > 1 ? ((t + 1) & (nt - 1)) : t + 1, t2w = KREP > 1 ? ((t + 2) & (nt - 1)) : t + 2;
            const char* a1 = cA + (size_t)t1w * kstep;
            const char* a2 = last ? nA : cA + (size_t)t2w * kstep; const char* b2 = last ? nB : cB + (size_t)t2w * kstep;
            const char* a3 = a2 + kstep; const char* b3 = b2 + kstep;
            if (last && has_next) S.a_ready(nxt);
            const int relax = __builtin_amdgcn_readfirstlane((MK_RELAXW && t == 0 && ui > 0) ? 1 : 0);
            if constexpr (SP2) {
            PG8_LDB(B0, 0, 0); PG8_LDB(B1, 0, 1); PG8_SCHED; PG8_LDA(At, 0, 0); PG8_STAGE(PG8_SA(1, 1), a1 + hstep, voffA);
            PG8_WAIT_V_SEL(relax);
            PG8_WAIT_L(0); PG8_BAR; PG8_MMA(0, 0, At, B0); PG8_MMA(0, 1, At, B1); PG8_BAR; PG8_SCHED;
            PG8_LDA(At, 0, 1); PG8_STAGE(PG8_SB(0, 0), b2, voffB); PG8_STAGE(PG8_SB(0, 1), b2 + hstep, voffB); PG8_STAGE(PG8_SA(0, 0), a2, voffA);
            PG8_WAIT_V_SEL(relax);
            PG8_WAIT_L(0); PG8_BAR; PG8_MMA(1, 0, At, B0); PG8_MMA(1, 1, At, B1); PG8_BAR; PG8_SCHED;
            PG8_LDB(B0, 1, 0); PG8_LDB(B1, 1, 1); PG8_SCHED; PG8_LDA(At, 1, 0); PG8_STAGE(PG8_SA(0, 1), a2 + hstep, voffA);
            PG8_WAIT_V(8); PG8_WAIT_L(0); PG8_BAR; PG8_MMA(0, 0, At, B0); PG8_MMA(0, 1, At, B1); PG8_BAR; PG8_SCHED;
            PG8_LDA(At, 1, 1); PG8_STAGE(PG8_SB(1, 0), b3, voffB); PG8_STAGE(PG8_SB(1, 1), b3 + hstep, voffB); PG8_STAGE(PG8_SA(1, 0), a3, voffA);
            PG8_WAIT_V(8); PG8_WAIT_L(0); PG8_BAR; PG8_MMA(1, 0, At, B0); PG8_MMA(1, 1, At, B1); PG8_BAR; PG8_SCHED;
            } else {
            PG8_LDB(B0, 0, 0); PG8_SCHED; PG8_LDA(At, 0, 0); PG8_STAGE(PG8_SA(1, 1), a1 + hstep, voffA);
            PG8_WAIT_L(8); PG8_BAR; PG8_WAIT_L(0); PG8_MMA(0, 0, At, B0); PG8_BAR; PG8_SCHED;
            PG8_LDB(B1, 0, 1); PG8_STAGE(PG8_SB(0, 0), b2, voffB);
            PG8_BAR; PG8_WAIT_L(0); PG8_MMA(0, 1, At, B1); PG8_BAR;
            PG8_LDA(At, 0, 1); PG8_STAGE(PG8_SA(0, 0), a2, voffA);
            PG8_BAR; PG8_WAIT_L(0); PG8_MMA(1, 0, At, B0); PG8_BAR; PG8_SCHED;
            PG8_STAGE(PG8_SB(0, 1), b2 + hstep, voffB);
            PG8_WAIT_V(6); PG8_BAR; PG8_MMA(1, 1, At, B1); PG8_BAR;
            PG8_LDB(B0, 1, 0); PG8_SCHED; PG8_LDA(At, 1, 0); PG8_STAGE(PG8_SA(0, 1), a2 + hstep, voffA);
            PG8_WAIT_L(8); PG8_BAR; PG8_WAIT_L(0); PG8_MMA(0, 0, At, B0); PG8_BAR; PG8_SCHED;
            PG8_LDB(B1, 1, 1); PG8_STAGE(PG8_SB(1, 0), b3, voffB);
            PG8_BAR; PG8_WAIT_L(0); PG8_MMA(0, 1, At, B1); PG8_BAR;
            PG8_LDA(At, 1, 1); PG8_STAGE(PG8_SA(1, 0), a3, voffA);
            PG8_BAR; PG8_WAIT_L(0); PG8_MMA(1, 0, At, B0); PG8_BAR; PG8_SCHED;
            PG8_STAGE(PG8_SB(1, 1), b3 + hstep, voffB);
            PG8_WAIT_V(6); PG8_BAR; PG8_MMA(1, 1, At, B1); PG8_BAR;
            }
        }
        unsigned long long tp0 = 0; if constexpr (TP == 1) tp0 = __builtin_amdgcn_s_memrealtime();
        if constexpr (ALIGN_EPI) { if (wr == 0) PG8_BAR; }
        if constexpr (TP == 2) tp0 = __builtin_amdgcn_s_memrealtime();
        if constexpr (!Epi::AFTER_DRAIN) { E(acc, cur, ui & 1, wr, wc, fr, fq); S.done(cur); }
        if constexpr (TP == 1 || TP == 2) tp_acc += __builtin_amdgcn_s_memrealtime() - tp0;
        if constexpr (TP == 3) tp3 = __builtin_amdgcn_s_memrealtime();
        if (!has_next) break;
        E.stage(nxt, (ui + 1) & 1, wid, lane);
#pragma unroll
        for (int a = 0; a < 2; ++a)
#pragma unroll
            for (int b = 0; b < 2; ++b)
#pragma unroll
                for (int m = 0; m < 4; ++m)
#pragma unroll
                    for (int n = 0; n < 2; ++n) acc[a][b][m][n] = (f32x4){0.f, 0.f, 0.f, 0.f};
        cur = nxt; cA = nA; cB = nB; ++ui;
        if constexpr (ALIGN_EPI) { if (wr == 1) PG8_BAR; }
    }
    if constexpr (TP != 0) { if (tp_out) *tp_out = tp_acc; }
    PG8_WAIT_V(0);
    if constexpr (!ALIGN_EPI) { if (wr == 0) PG8_BAR; }
    PG8_BAR;
    if constexpr (Epi::AFTER_DRAIN) { E.fused(acc, cur, wr, wc, fr, fq, lds, wid, lane); S.done(cur); }
#undef PG8_SA
#undef PG8_SB
#undef PG8_STAGE
#undef PG8_LDA
#undef PG8_LDB
#undef PG8_MMA
#undef PG8_WAIT_V
#undef PG8_WAIT_L
#undef PG8_WAIT_V_SEL
#undef PG8_BAR
#undef PG8_SCHED
}
}
#ifndef MK_ATTSKIP
#define MK_ATTSKIP 0
#endif
#ifndef MK_PPPROBE
#define MK_PPPROBE 0
#endif
#ifndef MK_YPRIO
#define MK_YPRIO 0
#endif
#ifndef MK_DMALATE
#define MK_DMALATE 0
#endif
#ifndef MK_VWPROBE
#define MK_VWPROBE 0
#endif
#ifndef MK_ATTPRIO
#define MK_ATTPRIO 0
#endif
namespace fox {
enum { ORDER_NATURAL = 0, ORDER_REVERSED = 1, ORDER_PAIRED = 2, ORDER_XCD = 4 };
constexpr int B = 8, H = 16, HKV = 16, SQ = 4096, SKV = 4096, D = 128;
constexpr int QOFF = 0;
constexpr int WINDOW = SKV;
constexpr float THR = 8.f;
constexpr bool WSKIP = false;
constexpr float SCALE = 0.08838834764831845f;
constexpr float QSCALE = SCALE * 1.4426950408889634f;
constexpr int NW = 8, QBLK = 32, KVBLK = 64, QB = NW * QBLK;
constexpr int SHM_V = KVBLK * D * 2, SHM_K = KVBLK * D * 2;
constexpr int NBUF = 3;
constexpr int LDS_FB = NBUF * SHM_V + NBUF * SHM_K;
constexpr int LDS_BYTES = LDS_FB + 2 * SKV * 4;
constexpr int OPITCH = H * D;
constexpr size_t ARENA_E = (size_t)24 << 20;
using bf16 = __hip_bfloat16;
typedef short bf16x8 __attribute__((ext_vector_type(8)));
typedef short s16x4 __attribute__((ext_vector_type(4)));
typedef float f32x16 __attribute__((ext_vector_type(16)));
typedef float f32x4 __attribute__((ext_vector_type(4)));
typedef unsigned u32x4 __attribute__((ext_vector_type(4)));
template <class A, class Bt> struct same_t { static constexpr bool v = false; };
template <class A> struct same_t<A, A> { static constexpr bool v = true; };

#define KSWZ(row, colB) ((row) * 256 + ((colB) ^ (((row) & 7) << 4)))
#define SBAR() __builtin_amdgcn_sched_barrier(0)
__device__ __forceinline__ int v_st(int k, int c) { const int kk = (k & ~0xC) | ((k & 4) << 1) | ((k & 8) >> 1); return ((kk >> 3) * 4 + (c >> 5)) * 512 + ((kk & 7) * 32 + (c & 31)) * 2; }
__device__ __forceinline__ int v_rd_base(int lane) { return ((lane & 3) << 3) | (((lane >> 2) & 3) << 6) | (((lane >> 4) & 1) << 5) | (((lane >> 5) & 1) << 8); }
constexpr int v_rd_off(int d0, int ks, int half) { return d0 * 512 + ks * 4096 + half * 2048; }
__device__ __forceinline__ int crow(int r, int hi) { return (r & 3) + 8 * (r >> 2) + 4 * hi; }
__device__ __forceinline__ unsigned cvtpk(float lo, float hi) {
    unsigned r; asm volatile("v_cvt_pk_bf16_f32 %0, %1, %2" : "=v"(r) : "v"(lo), "v"(hi)); return r;
}
__device__ __forceinline__ bf16x8 pack8(f32x4 a, f32x4 b) {
    u32x4 w = {cvtpk(a[0], a[1]), cvtpk(a[2], a[3]), cvtpk(b[0], b[1]), cvtpk(b[2], b[3])};
    return *reinterpret_cast<bf16x8*>(&w);
}
template <class T> __device__ __forceinline__ bf16x8 load8(const T* p) {
    if constexpr (same_t<T, float>::v) { return pack8(*(const f32x4*)p, *(const f32x4*)(p + 4)); }
    else { return *reinterpret_cast<const bf16x8*>(p); }
}
__device__ __forceinline__ void mask_tile(f32x16& p0, f32x16& p1, int dq, unsigned W) {
    const float NEG = -__builtin_inff();
#pragma unroll
    for (int r = 0; r < 16; ++r) {
        const int c = (r & 3) + 8 * (r >> 2);
        if ((unsigned)(dq - c) >= W) p0[r] = NEG;
        if ((unsigned)(dq - c - 32) >= W) p1[r] = NEG;
    }
}
__device__ __forceinline__ void partialSM(f32x16& p0, f32x16& p1, float& m_reg, float& mn, float& alpha) {
    float pmax = p0[0]; for (int r = 1; r < 16; ++r) pmax = fmaxf(pmax, p0[r]); for (int r = 0; r < 16; ++r) pmax = fmaxf(pmax, p1[r]);
    { auto rr = __builtin_amdgcn_permlane32_swap(__float_as_uint(pmax), __float_as_uint(pmax), false, false);
      pmax = fmaxf(__uint_as_float(rr[0]), __uint_as_float(rr[1])); }
    constexpr float THR2 = THR * 1.4426950408889634f;
    if (__builtin_expect(__all((pmax - m_reg) <= THR2), 1)) { mn = m_reg; alpha = 1.f; }
    else { mn = fmaxf(m_reg, pmax); alpha = __builtin_amdgcn_exp2f(m_reg - mn); m_reg = mn; }
    p0 = p0 - mn; p1 = p1 - mn;
    for (int r = 0; r < 16; ++r) p0[r] = __builtin_amdgcn_exp2f(p0[r]);
}
__device__ __forceinline__ void finishSM(f32x16& p0, f32x16& p1, float alpha, float& l_reg, bf16x8& pa0, bf16x8& pa1, bf16x8& pa2, bf16x8& pa3) {
    for (int r = 0; r < 16; ++r) p1[r] = __builtin_amdgcn_exp2f(p1[r]);
    typedef float f32x8_ __attribute__((ext_vector_type(8))); typedef float f32x2_ __attribute__((ext_vector_type(2)));
    const f32x16 s16 = p0 + p1; const f32x8_ s8 = s16.lo + s16.hi; const f32x4 s4 = s8.lo + s8.hi; const f32x2_ s2 = s4.lo + s4.hi; float ps = s2.x + s2.y;
    { auto rr = __builtin_amdgcn_permlane32_swap(__float_as_uint(ps), __float_as_uint(ps), false, false);
      ps = __uint_as_float(rr[0]) + __uint_as_float(rr[1]); }
    l_reg = l_reg * alpha + ps;
#define PK4(P, B_, OUT) do { unsigned a0 = cvtpk(P[B_+0], P[B_+1]), a1 = cvtpk(P[B_+2], P[B_+3]);                          \
        unsigned b0 = cvtpk(P[B_+4], P[B_+5]), b1 = cvtpk(P[B_+6], P[B_+7]);                                             \
        auto r0 = __builtin_amdgcn_permlane32_swap(a0, b0, false, false); auto r1 = __builtin_amdgcn_permlane32_swap(a1, b1, false, false); \
        u32x4 w = {r0[0], r1[0], r0[1], r1[1]}; OUT = *reinterpret_cast<bf16x8*>(&w); } while (0)
    PK4(p0, 0, pa0); PK4(p0, 8, pa1); PK4(p1, 0, pa2); PK4(p1, 8, pa3);
#undef PK4
}
template <int KB, bool SK>
__device__ __forceinline__ void qkt(f32x16& p0, f32x16& p1, const char* K_lds, int r32, int hi, const bf16x8* qr, bool act, const char* fb) {
    if (SK && !act) { const float NEG = -__builtin_inff();
#pragma unroll
        for (int r = 0; r < 16; ++r) { p0[r] = NEG; p1[r] = NEG; } return; }
#pragma unroll
    for (int q = 0; q < 4; ++q) { const f32x4 b0 = *reinterpret_cast<const f32x4*>(fb + q * 32), b1 = *reinterpret_cast<const f32x4*>(fb + 128 + q * 32);
#pragma unroll
        for (int i = 0; i < 4; ++i) { p0[4 * q + i] = b0[i]; p1[4 * q + i] = b1[i]; } }
    const char* kb[4];
#pragma unroll
    for (int dd = 0; dd < 4; ++dd) kb[dd] = K_lds + KB * SHM_K + KSWZ(r32, (dd * 16 + hi * 8) * 2);
    if (MK_ATTPRIO) __builtin_amdgcn_s_setprio(1);
#pragma unroll
    for (int d0 = 0; d0 < 8; ++d0) { const char* a = kb[d0 & 3] + (d0 >> 2) * 128;
        bf16x8 b0 = *reinterpret_cast<const bf16x8*>(a);
        bf16x8 b1 = *reinterpret_cast<const bf16x8*>(a + 32 * 256);
        p0 = __builtin_amdgcn_mfma_f32_32x32x16_bf16(b0, qr[d0], p0, 0, 0, 0);
        p1 = __builtin_amdgcn_mfma_f32_32x32x16_bf16(b1, qr[d0], p1, 0, 0, 0); }
    if (MK_ATTPRIO) __builtin_amdgcn_s_setprio(0);
}
template <bool SK>
__device__ __forceinline__ void qkt_x(f32x16& p0, f32x16& p1, const char* K_lds, int r32, int hi, const bf16x8* qr, bool act, const char* fb) {
    const int k0a = (int)(uintptr_t)K_lds + KSWZ(r32, (0 * 16 + hi * 8) * 2), k1a = (int)(uintptr_t)K_lds + KSWZ(r32, (1 * 16 + hi * 8) * 2), k2a = (int)(uintptr_t)K_lds + KSWZ(r32, (2 * 16 + hi * 8) * 2), k3a = (int)(uintptr_t)K_lds + KSWZ(r32, (3 * 16 + hi * 8) * 2);
#define KRD(dst, a, off) asm volatile("ds_read_b128 %0, %1 offset:%2" : "=&v"(dst) : "v"(a), "i"(off) : "memory")
#define K_LD(R, A0, A1, off) do { KRD(R##0, A0, off); KRD(R##1, A0, off + 8192); KRD(R##2, A1, off); KRD(R##3, A1, off + 8192); } while (0)
#define K_MM(R, d) do { p0 = __builtin_amdgcn_mfma_f32_32x32x16_bf16(R##0, qr[d + 0], p0, 0, 0, 0); p1 = __builtin_amdgcn_mfma_f32_32x32x16_bf16(R##1, qr[d + 0], p1, 0, 0, 0); \
        p0 = __builtin_amdgcn_mfma_f32_32x32x16_bf16(R##2, qr[d + 1], p0, 0, 0, 0); p1 = __builtin_amdgcn_mfma_f32_32x32x16_bf16(R##3, qr[d + 1], p1, 0, 0, 0); } while (0)
#define K_W(n, R) asm volatile("s_waitcnt lgkmcnt(" #n ")" : "+v"(R##0), "+v"(R##1), "+v"(R##2), "+v"(R##3) :: "memory")
    bf16x8 ka0, ka1, ka2, ka3, kb0, kb1, kb2, kb3;
    K_LD(ka, k0a, k1a, 0); K_LD(kb, k2a, k3a, 0);
#pragma unroll
    for (int q = 0; q < 4; ++q) { const f32x4 b0 = *reinterpret_cast<const f32x4*>(fb + q * 32), b1 = *reinterpret_cast<const f32x4*>(fb + 128 + q * 32);
#pragma unroll
        for (int i = 0; i < 4; ++i) { p0[4 * q + i] = b0[i]; p1[4 * q + i] = b1[i]; } }
    K_W(12, ka);
    K_MM(ka, 0); K_LD(ka, k0a, k1a, 128);
    K_W(4, kb); K_MM(kb, 2); K_LD(kb, k2a, k3a, 128);
    K_W(4, ka); K_MM(ka, 4);
    K_W(0, kb); K_MM(kb, 6);
#undef K_W
#undef K_MM
#undef K_LD
#undef KRD
}
template <int VB, bool SK>
__device__ __forceinline__ void pv_tile(f32x16* o, int vb0, bf16x8 pa0, bf16x8 pa1, bf16x8 pa2, bf16x8 pa3, bool act) {
    if (SK && !act) return;
#define TRRD(dst, off) asm volatile("ds_read_b64_tr_b16 %0, %1 offset:%2" : "=&v"(dst) : "v"(vb0), "i"(off) : "memory")
#define PV_D0(d0) do { s16x4 l0, l1, l2, l3, h0, h1, h2, h3; constexpr int b_ = VB * SHM_V + v_rd_off(d0, 0, 0);     \
        TRRD(l0, b_); TRRD(h0, b_ + 2048); TRRD(l1, b_ + 4096); TRRD(h1, b_ + 6144); TRRD(l2, b_ + 8192); TRRD(h2, b_ + 10240); TRRD(l3, b_ + 12288); TRRD(h3, b_ + 14336); \
        asm volatile("s_waitcnt lgkmcnt(0)" ::: "memory"); SBAR();                 \
        o[d0] = __builtin_amdgcn_mfma_f32_32x32x16_bf16((bf16x8){l0[0], l0[1], l0[2], l0[3], h0[0], h0[1], h0[2], h0[3]}, pa0, o[d0], 0, 0, 0);   \
        o[d0] = __builtin_amdgcn_mfma_f32_32x32x16_bf16((bf16x8){l1[0], l1[1], l1[2], l1[3], h1[0], h1[1], h1[2], h1[3]}, pa1, o[d0], 0, 0, 0);   \
        o[d0] = __builtin_amdgcn_mfma_f32_32x32x16_bf16((bf16x8){l2[0], l2[1], l2[2], l2[3], h2[0], h2[1], h2[2], h2[3]}, pa2, o[d0], 0, 0, 0);   \
        o[d0] = __builtin_amdgcn_mfma_f32_32x32x16_bf16((bf16x8){l3[0], l3[1], l3[2], l3[3], h3[0], h3[1], h3[2], h3[3]}, pa3, o[d0], 0, 0, 0); } while (0)
    if (MK_ATTPRIO) __builtin_amdgcn_s_setprio(1);
    PV_D0(0); PV_D0(1); PV_D0(2); PV_D0(3);
    if (MK_ATTPRIO) __builtin_amdgcn_s_setprio(0);
#undef PV_D0
#undef TRRD
}
template <bool SK>
__device__ __forceinline__ void pv_tile_x(f32x16* o, int vb, bf16x8 pa0, bf16x8 pa1, bf16x8 pa2, bf16x8 pa3, bool act) {
    if (SK && !act) return;
#define TRRD(dst, off) asm volatile("ds_read_b64_tr_b16 %0, %1 offset:%2" : "=&v"(dst) : "v"(vb), "i"(off) : "memory")
#define PV_LD(R, d0) do { constexpr int b_ = v_rd_off(d0, 0, 0); TRRD(R##0, b_); TRRD(R##1, b_ + 2048); TRRD(R##2, b_ + 4096); TRRD(R##3, b_ + 6144); TRRD(R##4, b_ + 8192); TRRD(R##5, b_ + 10240); TRRD(R##6, b_ + 12288); TRRD(R##7, b_ + 14336); } while (0)
#define PV_J(l, h) ((bf16x8){l[0], l[1], l[2], l[3], h[0], h[1], h[2], h[3]})
#define PV_MM(R, d0) do { o[d0] = __builtin_amdgcn_mfma_f32_32x32x16_bf16(PV_J(R##0, R##1), pa0, o[d0], 0, 0, 0); o[d0] = __builtin_amdgcn_mfma_f32_32x32x16_bf16(PV_J(R##2, R##3), pa1, o[d0], 0, 0, 0); \
        o[d0] = __builtin_amdgcn_mfma_f32_32x32x16_bf16(PV_J(R##4, R##5), pa2, o[d0], 0, 0, 0); o[d0] = __builtin_amdgcn_mfma_f32_32x32x16_bf16(PV_J(R##6, R##7), pa3, o[d0], 0, 0, 0); } while (0)
#define PV_W(n, R) asm volatile("s_waitcnt lgkmcnt(" #n ")" : "+v"(R##0), "+v"(R##1), "+v"(R##2), "+v"(R##3), "+v"(R##4), "+v"(R##5), "+v"(R##6), "+v"(R##7) :: "memory")
    s16x4 fa0, fa1, fa2, fa3, fa4, fa5, fa6, fa7, fb0, fb1, fb2, fb3, fb4, fb5, fb6, fb7;
    PV_LD(fa, 0); PV_LD(fb, 1);
    PV_W(8, fa); PV_MM(fa, 0); PV_LD(fa, 2);
    PV_W(8, fb); PV_MM(fb, 1); PV_LD(fb, 3);
    PV_W(8, fa); PV_MM(fa, 2);
    PV_W(0, fb); PV_MM(fb, 3);
#undef PV_W
#undef PV_MM
#undef PV_J
#undef PV_LD
#undef TRRD
}
template <class TIn, class TOut> struct BlockRef { const TIn* Q; const TIn* K; const TIn* V; TOut* O; const float* FB; int P0; };
template <class TIn> struct Seam { bf16x8 qr[8]; int b0, fp; };
#define FOX_LAS __attribute__((address_space(3)))
#define VMW() asm volatile("s_waitcnt vmcnt(0)" ::: "memory")
struct DmaMap { unsigned k0, k1, v0, v1, kl, vl; };
__device__ __forceinline__ DmaMap dma_map(char* lds, int wid, int lane) {
    DmaMap m;
#pragma unroll
    for (int j = 0; j < 2; ++j) {
        const int pk = wid * 2 + j;
        const int r = pk * 4 + (lane >> 4), p = lane & 15, c = p ^ (r & 7);
        const unsigned ko = (unsigned)(r * 256 + c * 16);
        const int s = pk * 2 + (lane >> 5), kk = (s >> 2) * 8 + ((lane & 31) >> 2), cc = (s & 3) * 32 + (lane & 3) * 8;
        const int k = (kk & ~0xC) | ((kk & 4) << 1) | ((kk & 8) >> 1);
        const unsigned vo = (unsigned)(k * 256 + cc * 2);
        if (j == 0) { m.k0 = ko; m.v0 = vo; } else { m.k1 = ko; m.v1 = vo; }
    }
    m.kl = (unsigned)(uintptr_t)(lds + NBUF * SHM_V) + (unsigned)wid * 2048u; m.vl = (unsigned)(uintptr_t)lds + (unsigned)wid * 2048u;
    return m;
}
#define DMA_TILE(Kp, Vp, kb_, buf_) do { const char* kp_ = (const char*)(Kp) + (size_t)(kb_) * (D * 2); const char* vp_ = (const char*)(Vp) + (size_t)(kb_) * (D * 2);                 \
        __builtin_amdgcn_global_load_lds((const unsigned*)(kp_ + M.k0), (FOX_LAS unsigned*)(M.kl + (unsigned)(buf_) * SHM_K), 16, 0, 0);                                           \
        __builtin_amdgcn_global_load_lds((const unsigned*)(kp_ + M.k1), (FOX_LAS unsigned*)(M.kl + (unsigned)(buf_) * SHM_K + 1024u), 16, 0, 0);                                   \
        __builtin_amdgcn_global_load_lds((const unsigned*)(vp_ + M.v0), (FOX_LAS unsigned*)(M.vl + (unsigned)(buf_) * SHM_V), 16, 0, 0);                                           \
        __builtin_amdgcn_global_load_lds((const unsigned*)(vp_ + M.v1), (FOX_LAS unsigned*)(M.vl + (unsigned)(buf_) * SHM_V + 1024u), 16, 0, 0); } while (0)
#define BIAS_DMA(FBp, nk, img) do { const int np_ = (nk) >> 8; const unsigned fl_ = (unsigned)(uintptr_t)(lds + LDS_FB) + (unsigned)(img) * (SKV * 4);                       \
        for (int pc_ = wid; pc_ < np_; pc_ += NW) __builtin_amdgcn_global_load_lds((const unsigned*)((const char*)(FBp) + pc_ * 1024 + lane * 16), (FOX_LAS unsigned*)(fl_ + (unsigned)pc_ * 1024u), 16, 0, 0); } while (0)
template <class TIn, class TOut>
__device__ __forceinline__ void causal_swa_prime(const BlockRef<TIn, TOut>& cur, int W, char* lds, Seam<TIn>& S) {
    static_assert(!same_t<TIn, float>::v, "bf16 q/k/v only");
    const int tid = ltid(), wid = __builtin_amdgcn_readfirstlane(tid >> 6), lane = tid & 63, r32 = lane & 31, hi = lane >> 5;
    const DmaMap M = dma_map(lds, wid, lane);
    DMA_TILE(cur.K, cur.V, 0, 0); S.b0 = 0; BIAS_DMA(cur.FB, cur.P0 + QB, 0); S.fp = 0;
    for (int d0 = 0; d0 < 8; ++d0) S.qr[d0] = load8<TIn>(cur.Q + (size_t)(wid * QBLK + r32) * D + d0 * 16 + hi * 8);
    VMW(); __syncthreads();
}
template <class TIn, class TOut>
__device__ __forceinline__ void causal_swa_block(const BlockRef<TIn, TOut>& cur, const BlockRef<TIn, TOut>& nxt, int skv, int W, char* lds, Seam<TIn>& S) {
    static_assert(!same_t<TIn, float>::v && !same_t<TOut, float>::v, "bf16 q/k/v/o only");
    const int tid = ltid(), wid = __builtin_amdgcn_readfirstlane(tid >> 6), lane = tid & 63, r32 = lane & 31, hi = lane >> 5;
    const int NT = (cur.P0 + QB) / KVBLK;
    const int qlo = cur.P0 + wid * QBLK, qm = qlo + r32 - 4 * hi;
    char* V_lds = lds; char* K_lds = lds + NBUF * SHM_V;
    float m_reg = -1e30f, l_reg = 0; f32x16 o[4] = {};
    float* fbuf = (float*)(lds + LDS_FB) + S.fp * SKV;
    BIAS_DMA(nxt.FB, nxt.P0 + QB, S.fp ^ 1);
    const char* fbl = (const char*)fbuf + hi * 16;
    m_reg = fbuf[cur.P0 + wid * QBLK + r32];
    const int vb0 = (int)(uintptr_t)V_lds + v_rd_base(lane);
    const DmaMap M = dma_map(lds, wid, lane);
    const TIn* Kh = cur.K; const TIn* Vh = cur.V;
#if MK_VWPROBE
    unsigned long long vwp_acc = 0, vwp_t0 = 0;
#define VWP_T0() do { if (wid == 0) vwp_t0 = __builtin_amdgcn_s_memtime(); } while (0)
#define VWP_T1() do { if (wid == 0) vwp_acc += __builtin_amdgcn_s_memtime() - vwp_t0; } while (0)
#else
#define VWP_T0() do {} while (0)
#define VWP_T1() do {} while (0)
#endif
    constexpr bool SK = MK_ATTSKIP;
#define RESC(a) do { if (__any((a) < 1.f)) { for (int d_ = 0; d_ < 4; ++d_) o[d_] = o[d_] * (a); } } while (0)
#define KBASE(t) ((t) * KVBLK)
#define ACT(t) (!SK || KBASE(t) <= qlo + QBLK - 1)
#define NXB(b) ((b) == NBUF - 1 ? 0 : (b) + 1)
#define MASKT(P0_, P1_, t) do { const int kb_ = KBASE(t); if (kb_ + KVBLK - 1 > qlo) mask_tile(P0_, P1_, qm - kb_, (unsigned)W); } while (0)
    f32x16 pA0, pA1, pB0, pB1; float mnA, mnB, alA, alB; bf16x8 pa0, pa1, pa2, pa3;
    const int b0 = S.b0; int kbt = NXB(b0);
    if (NT > 1) DMA_TILE(Kh, Vh, KBASE(1), kbt);
    SBAR(); qkt_x<SK>(pA0, pA1, K_lds + b0 * SHM_K, r32, hi, S.qr, ACT(0), fbl + KBASE(0) * 4);
    MASKT(pA0, pA1, 0); partialSM(pA0, pA1, m_reg, mnA, alA);
    VMW(); __syncthreads();
#define HALF_STEP3(PX0, PX1, mnX, alX, PY0, PY1, alY, t) do {                                                                 \
        const int bt_ = kbt, bp_ = (kbt == 0 ? NBUF - 1 : kbt - 1), bn_ = NXB(kbt);                                           \
        if (!MK_DMALATE && (t) + 1 < NT) DMA_TILE(Kh, Vh, KBASE((t) + 1), bn_);                                               \
        SBAR(); qkt_x<SK>(PX0, PX1, K_lds + bt_ * SHM_K, r32, hi, S.qr, ACT(t), fbl + KBASE(t) * 4);                         \
        if (MK_DMALATE && (t) + 1 < NT) { SBAR(); DMA_TILE(Kh, Vh, KBASE((t) + 1), bn_); SBAR(); }     \
        finishSM(PY0, PY1, alY, l_reg, pa0, pa1, pa2, pa3); SBAR();                                                           \
        pv_tile_x<SK>(o, vb0 + bp_ * SHM_V, pa0, pa1, pa2, pa3, ACT((t) - 1)); MASKT(PX0, PX1, (t)); partialSM(PX0, PX1, m_reg, mnX, alX); \
        RESC(alX); VWP_T0(); VMW(); VWP_T1(); __syncthreads(); kbt = bn_; } while (0)
    for (int t = 1; t + 1 < NT; t += 2) {
        HALF_STEP3(pB0, pB1, mnB, alB, pA0, pA1, alA, t);
        HALF_STEP3(pA0, pA1, mnA, alA, pB0, pB1, alB, t + 1);
    }
    const int bl_ = kbt, blp_ = (kbt == 0 ? NBUF - 1 : kbt - 1), bf_ = 3 - bl_ - blp_;
    const bool even = (NT & 1) == 0;
    if (even) { SBAR(); qkt_x<SK>(pB0, pB1, K_lds + bl_ * SHM_K, r32, hi, S.qr, ACT(NT - 1), fbl + KBASE(NT - 1) * 4); SBAR(); }
    DMA_TILE(nxt.K, nxt.V, 0, bf_); S.b0 = bf_; S.fp ^= 1; SBAR();
#pragma unroll
    for (int d0 = 0; d0 < 8; ++d0) S.qr[d0] = load8<TIn>(nxt.Q + (size_t)(wid * QBLK + r32) * D + d0 * 16 + hi * 8);
    SBAR();
    finishSM(pA0, pA1, alA, l_reg, pa0, pa1, pa2, pa3); SBAR();
    pv_tile_x<SK>(o, vb0 + blp_ * SHM_V, pa0, pa1, pa2, pa3, ACT(even ? NT - 2 : NT - 1));
    if (even) { MASKT(pB0, pB1, NT - 1); partialSM(pB0, pB1, m_reg, mnB, alB); RESC(alB);
        finishSM(pB0, pB1, alB, l_reg, pa0, pa1, pa2, pa3); SBAR(); pv_tile_x<SK>(o, vb0 + bl_ * SHM_V, pa0, pa1, pa2, pa3, ACT(NT - 1)); }
    SBAR();
    { const float rl = __builtin_amdgcn_rcpf(l_reg);
      TOut* Ow = cur.O + (size_t)(wid * QBLK + r32) * OPITCH + 8 * hi;
#pragma unroll
      for (int d0 = 0; d0 < 4; ++d0) { const f32x16 v = o[d0] * rl;
#pragma unroll
        for (int hf = 0; hf < 2; ++hf) { const unsigned a0 = cvtpk(v[8 * hf + 0], v[8 * hf + 1]), a1 = cvtpk(v[8 * hf + 2], v[8 * hf + 3]), b0_ = cvtpk(v[8 * hf + 4], v[8 * hf + 5]), b1_ = cvtpk(v[8 * hf + 6], v[8 * hf + 7]);
            auto r0 = __builtin_amdgcn_permlane32_swap(a0, b0_, false, false); auto r1 = __builtin_amdgcn_permlane32_swap(a1, b1_, false, false);
            u32x4 w = {r0[0], r1[0], r0[1], r1[1]};
            *(u32x4*)(Ow + d0 * 32 + 16 * hf) = w; } } }
#if MK_VWPROBE
    if (wid == 0 && lane == 0 && blockIdx.x == 0) *(volatile unsigned*)(lds + 155648 + 320 + 40 * 4) += (unsigned)(vwp_acc / 4);
#endif
    VMW(); __syncthreads();
#undef RESC
#undef KBASE
#undef ACT
#undef NXB
#undef MASKT
#undef HALF_STEP3
#undef VWP_T0
#undef VWP_T1
}
#undef VMW
#undef BIAS_DMA
#undef DMA_TILE
constexpr int NQB = SQ / QB, NXI = NQB / 2, NITEMS = NXI * B * H;
struct SwaItem { int bh, qb0, qb1; };
__device__ __forceinline__ SwaItem swa_decode(int L, bool grp) { SwaItem it; const int xcd = L & 7, k = L >> 3; it.bh = grp ? xcd * H + (k / NXI) : (k / NXI) * 8 + xcd; const int x = k % NXI; it.qb0 = x; it.qb1 = NQB - 1 - x; return it; }
template <class TIn, class TOut>
__device__ __forceinline__ BlockRef<TIn, TOut> swa_ref(const SwaItem& it, int pass, const TIn* Q, const TIn* K, const TIn* V, TOut* O, const float* FB) {
    const int qb = pass ? it.qb1 : it.qb0;
    BlockRef<TIn, TOut> r;
    const size_t ar = (size_t)(it.bh / H) * ARENA_E; const int hh = it.bh % H;
    r.Q = Q + ar + ((size_t)hh * SQ + (size_t)qb * QB) * D;
    r.O = O + ((size_t)(it.bh / H) * SQ + (size_t)qb * QB) * OPITCH + (it.bh % H) * D;
    r.K = K + ar + (size_t)hh * SKV * D; r.V = V + ar + (size_t)hh * SKV * D; r.FB = FB + (size_t)it.bh * SKV; r.P0 = qb * QB;
    return r;
}
__device__ __forceinline__ void att_phase(char* lds, const bf16* Q, const bf16* K, const bf16* V, bf16* O, const float* FB, int wg, int nwg, bool grp) {
    int L = wg; if (L >= NITEMS) return;
    SwaItem it = swa_decode(L, grp); int pass = 0;
    BlockRef<bf16, bf16> cur = swa_ref<bf16, bf16>(it, 0, Q, K, V, O, FB);
    Seam<bf16> S;
    causal_swa_prime<bf16, bf16>(cur, WINDOW, lds, S);
    for (;;) {
        const bool more_pass = pass == 0 && it.qb1 != it.qb0, more_item = L + nwg < NITEMS, last = !more_pass && !more_item;
        SwaItem itn = it; int passn = pass + 1, Ln = L;
        if (!more_pass) { passn = 0; Ln = more_item ? L + nwg : L; itn = swa_decode(Ln, grp); }
        const BlockRef<bf16, bf16> nxt = last ? cur : swa_ref<bf16, bf16>(itn, passn, Q, K, V, O, FB);
        causal_swa_block<bf16, bf16>(cur, nxt, SKV, WINDOW, lds, S);
        if (last) break;
        cur = nxt; it = itn; pass = passn; L = Ln;
    }
}
}
constexpr int DM = 2048, NBATCH = 8, SEQ = 4096, DEPTH = 4, NHEAD = 16, HDIM = 128, DFF = 5504, NFF2 = 2 * DFF, MTOK = NBATCH * SEQ;
constexpr int NQKVF = 3 * DM + NHEAD;
constexpr float EPS = 1e-6f;
constexpr int NWAVES = 8;
#ifndef MK_BARBLK
#define MK_BARBLK 0
#endif
#define BARPROBE_BLK(b) (MK_BARBLK == 0 ? true : MK_BARBLK == 1 ? ((b) < 128) : MK_BARBLK == 2 ? ((b) >= 128) : true)
#ifndef MK_PROA_SHARE
#define MK_PROA_SHARE 54
#endif
#ifndef MK_PER_PHASE
#define MK_PER_PHASE 0
#endif
constexpr size_t MiB = 1u << 20;
constexpr size_t WS_CTL = 0, CTL_ZERO_BYTES = 3 * MiB + 512 * 1024;
constexpr size_t WS_RSSF = 256 * 1024, WS_PCNT = 896 * 1024;
constexpr size_t WS_RSS = 1 * MiB;
constexpr size_t WS_VSS = 3 * MiB;
constexpr size_t WS_MOD = 3 * MiB + 512 * 1024;
constexpr size_t WS_SHT = 5 * MiB;
constexpr size_t WS_BIASV = 5 * MiB + 512 * 1024;
constexpr size_t WS_LOGF = 7 * MiB + 512 * 1024;
constexpr size_t WS_FB = 9 * MiB + 512 * 1024;
constexpr size_t WS_WQKV = 12 * MiB;
constexpr size_t WQKV_STRIDE = 25 * MiB / 2;
constexpr size_t WS_WO = 62 * MiB;
constexpr size_t WS_WGI = 78 * MiB;
constexpr size_t WS_WGO = 110 * MiB;
constexpr size_t WS_WF1 = 126 * MiB;
constexpr size_t WS_WF2 = 298 * MiB;
constexpr size_t WS_H = 384 * MiB;
constexpr size_t WS_H2 = 512 * MiB;
constexpr size_t WS_XB = 640 * MiB;
constexpr size_t WS_R = 768 * MiB;
constexpr size_t WS_ACT = WS_R + 384 * MiB;
constexpr size_t WS_END = WS_ACT + 366 * MiB;
constexpr int BV_QKVF = 0, BV_GI = 2 * 8 * NQKVF, BV_F1 = BV_GI + 2 * 8 * 4096;
constexpr int CW_TMO = 0, CW_BAR = 4096;

constexpr int RING_OFF = 0, RING_BYTES = 131072, XCH_OFF = 131072;
constexpr int CWT_OFF = 131072 + 14336;
constexpr int LDSCTL_OFF = 155648, MISC_OFF = LDSCTL_OFF + 320;
constexpr int LDS_BYTES = 159744;

#define GAS __attribute__((address_space(1)))
#define LAS __attribute__((address_space(3)))
typedef unsigned short bf16;
typedef unsigned v4u __attribute__((ext_vector_type(4)));
typedef unsigned v2u __attribute__((ext_vector_type(2)));
typedef float f32x4 __attribute__((ext_vector_type(4)));
typedef short bf16x8 __attribute__((ext_vector_type(8)));
typedef GAS unsigned gu32;
typedef unsigned long long u64;
constexpr float FIXS = 1048576.0f, FIXI = 1.0f / (1048576.0f * 2048.0f);
__device__ __forceinline__ float rstd_of(u64 v) { return __builtin_amdgcn_rsqf((float)v * FIXI + 1e-6f); }
#define RLX_AGENT __ATOMIC_RELAXED, __HIP_MEMORY_SCOPE_AGENT
#define LDS_WAIT() asm volatile("s_waitcnt lgkmcnt(0)" ::: "memory")
#define VM_WAIT() asm volatile("s_waitcnt vmcnt(0)" ::: "memory")
__device__ __forceinline__ unsigned f2bf(float f) { unsigned u = __builtin_bit_cast(unsigned, f); return (u + 0x7fffu + ((u >> 16) & 1u)) >> 16; }
__device__ __forceinline__ unsigned pk2(float lo, float hi) { return f2bf(lo) | (f2bf(hi) << 16); }
__device__ __forceinline__ float bf2f(unsigned short b) { return __builtin_bit_cast(float, (unsigned)b << 16); }
__device__ __forceinline__ float bflo(unsigned w) { return __builtin_bit_cast(float, w << 16); }
__device__ __forceinline__ float bfhi(unsigned w) { return __builtin_bit_cast(float, w & 0xffff0000u); }
#define XB_TMO      128
#define XB_XCNT(j)  (256  + 64 * (j))
#define XB_XSUB(j)  (1280 + 64 * (j))
#define XB_XGEN(j)  (2304 + 64 * (j))
#define XB_TOP      3328
#define XB_TOPGEN   3392
#define XCD_BAR_WORDS 3456
#define XB_SPIN_CAP (1u << 18)

__device__ __forceinline__ unsigned xb_ld(unsigned* p)              { return __hip_atomic_load((GAS unsigned*)p, __ATOMIC_RELAXED, __HIP_MEMORY_SCOPE_AGENT); }
__device__ __forceinline__ unsigned xb_add(unsigned* p, unsigned v) { return __hip_atomic_fetch_add((GAS unsigned*)p, v, __ATOMIC_RELAXED, __HIP_MEMORY_SCOPE_AGENT); }
__device__ __forceinline__ unsigned xb_xcc_id() { return (unsigned)__builtin_amdgcn_s_getreg((3 << 11) | 20) & 0xFu; }
#define XB_SPIN(cond, bar) do { unsigned _sp = 0; while (cond) { __builtin_amdgcn_s_sleep(1); \
    if ((++_sp & 255u) == 0u) { if (xb_ld(&(bar)[XB_TMO])) break; if (_sp > XB_SPIN_CAP) { xb_add(&(bar)[XB_TMO], 1u); break; } } } } while (0)

struct XcdBarrier {
    unsigned* bar; unsigned x, total;
    volatile LAS unsigned* st;
};

__device__ __forceinline__ XcdBarrier xcd_barrier_post(unsigned* bar, volatile LAS unsigned* st) {
    XcdBarrier b; b.bar = bar; b.x = xb_xcc_id(); b.st = st; b.total = gridDim.x * gridDim.y * gridDim.z;
    if (threadIdx.x == 0) (void)xb_add(&bar[XB_XCNT(b.x)], 1u);
    return b;
}
__device__ __forceinline__ void xcd_barrier_complete(unsigned* bar, unsigned x, unsigned G, unsigned& nloc, unsigned& nx) {
    unsigned sum, cnt, mine, sp = 0u;
    for (;;) {
        sum = 0u; cnt = 0u; mine = 0u;
#pragma unroll
        for (unsigned j = 0; j < 16; ++j) { const unsigned c = xb_ld(&bar[XB_XCNT(j)]); sum += c; cnt += (c > 0u) ? 1u : 0u; mine = (j == x) ? c : mine; }
        if (sum == G) break;
        __builtin_amdgcn_s_sleep(1);
        if ((++sp & 255u) == 0u) { if (xb_ld(&bar[XB_TMO])) break; if (sp > XB_SPIN_CAP) { xb_add(&bar[XB_TMO], 1u); break; } }
    }
    nloc = mine > 0u ? mine : 1u; nx = cnt > 0u ? cnt : 1u;
}

__device__ __forceinline__ void xcd_barrier(const XcdBarrier& b) {
#if defined(MK_BARPROBE) && MK_BARPROBE
    const unsigned long long bpt0_ = __builtin_amdgcn_s_memrealtime();
#endif
    asm volatile("s_waitcnt vmcnt(0)" ::: "memory");
    __syncthreads();
    if (threadIdx.x == 0) {
        unsigned* bar = b.bar;
        __builtin_amdgcn_s_waitcnt(0);
        unsigned nloc = b.st[0], nx = b.st[1];
        if (nloc == 0u) { xcd_barrier_complete(bar, b.x, b.total, nloc, nx); b.st[0] = nloc; b.st[1] = nx; }
        const unsigned old = xb_add(&bar[XB_XSUB(b.x)], 1u);
        const unsigned gen = old / nloc;
        if (old + 1u == (gen + 1u) * nloc) {
            __builtin_amdgcn_fence(__ATOMIC_RELEASE, "agent");
            asm volatile("s_waitcnt vmcnt(0)" ::: "memory");
            const unsigned og = xb_add(&bar[XB_TOP], 1u);
            const unsigned tg = og / nx;
            if (og + 1u == (tg + 1u) * nx) xb_add(&bar[XB_TOPGEN], 1u);
            else XB_SPIN(xb_ld(&bar[XB_TOPGEN]) == tg, bar);
            __builtin_amdgcn_fence(__ATOMIC_ACQUIRE, "agent");
            xb_add(&bar[XB_XGEN(b.x)], 1u);
            asm volatile("s_waitcnt vmcnt(0)" ::: "memory");
        } else {
            XB_SPIN(xb_ld(&bar[XB_XGEN(b.x)]) == gen, bar);
            __builtin_amdgcn_fence(__ATOMIC_ACQUIRE, "agent");
            asm volatile("s_waitcnt vmcnt(0)" ::: "memory");
        }
#if defined(MK_BARPROBE) && MK_BARPROBE
        if (b.st[33] && BARPROBE_BLK(blockIdx.x)) __hip_atomic_fetch_add((GAS unsigned long long*)(bar + 3600), __builtin_amdgcn_s_memrealtime() - bpt0_, __ATOMIC_RELAXED, __HIP_MEMORY_SCOPE_AGENT);
#endif
    }
    __syncthreads();
}
struct Frame {
    LAS unsigned char* lds; char* ldsg;
    volatile LAS unsigned* MISC;
    int tid, lane, wave, vcu, G, bid;
    const GAS float* const __attribute__((address_space(4)))* inp;
    GAS float* outg; GAS unsigned char* wsg;
    __device__ __forceinline__ const float* in(int i) const { return (const float*)inp[i]; }
};
enum { IN_X = 0, IN_C, IN_MODW, IN_MODB, IN_MIXG, IN_FFNG, IN_AWIN, IN_ABF, IN_AWO, IN_GWIN, IN_GVG, IN_GWS, IN_GBS, IN_GWO, IN_FWIN, IN_FCW, IN_FCB, IN_FWOUT, IN_FING };
enum { MW_BID = 16, MW_G, MW_VCU, MW_INP, MW_INP_HI, MW_WS, MW_WS_HI, MW_OUT, MW_OUT_HI };
__device__ __forceinline__ unsigned misc_rd(const Frame& F, int k) { return (unsigned)__builtin_amdgcn_readfirstlane((int)F.MISC[k]); }
__device__ __forceinline__ bool relaunder(Frame& F) {
    int t = (int)threadIdx.x; asm volatile("" : "+v"(t)); F.tid = t; F.lane = t & 63; F.wave = __builtin_amdgcn_readfirstlane(t >> 6);
    F.bid = (int)misc_rd(F, MW_BID); F.G = (int)misc_rd(F, MW_G); F.vcu = (int)misc_rd(F, MW_VCU);
    F.inp = (const GAS float* const __attribute__((address_space(4)))*)(((unsigned long long)misc_rd(F, MW_INP_HI) << 32) | misc_rd(F, MW_INP));
    F.wsg = (GAS unsigned char*)(((unsigned long long)misc_rd(F, MW_WS_HI) << 32) | misc_rd(F, MW_WS));
    F.outg = (GAS float*)(((unsigned long long)misc_rd(F, MW_OUT_HI) << 32) | misc_rd(F, MW_OUT));
    return true; }
__device__ __forceinline__ void stagger(const Frame& F, unsigned ticks) {
    if (ticks && ((F.bid >> 3) & 1)) { const unsigned long long t0 = __builtin_amdgcn_s_memrealtime(); while (__builtin_amdgcn_s_memrealtime() - t0 < ticks) __builtin_amdgcn_s_sleep(16); }
}
__device__ __forceinline__ float wave_sum(float v) {
#pragma unroll
    for (int o = 1; o < 64; o <<= 1) v += __shfl_xor(v, o);
    return v;
}
__device__ __forceinline__ void transpose_item(const float* W, int ldw, int K, bf16* WT, int k0, int n0, int dst_row0, int ncols, LAS float* scr, int lane) {
    const int nl = lane & 31;
    if (ncols == 32) {
        const int n4 = (lane & 7) * 4, kr = lane >> 3; f32x4 t[8];
#pragma unroll
        for (int i = 0; i < 8; ++i) t[i] = *(const GAS f32x4*)(W + (size_t)(k0 + 8 * i + kr) * ldw + n0 + n4);
#pragma unroll
        for (int i = 0; i < 8; ++i) { LAS float* d = scr + (8 * i + kr) * 33 + n4; d[0] = t[i].x; d[1] = t[i].y; d[2] = t[i].z; d[3] = t[i].w; }
    } else {
#pragma unroll 8
        for (int i = 0; i < 32; ++i) { const int kk = 2 * i + (lane >> 5); if (nl < ncols) scr[kk * 33 + nl] = W[(size_t)(k0 + kk) * ldw + n0 + nl]; } }
    LDS_WAIT(); asm volatile("" ::: "memory");
    const int c = lane & 7;
#pragma unroll
    for (int j = 0; j < 4; ++j) { const int n = (lane >> 3) + 8 * j; const LAS float* s = scr + (8 * c) * 33 + n;
        if (n < ncols) { v4u o; o.x = pk2(s[0 * 33], s[1 * 33]); o.y = pk2(s[2 * 33], s[3 * 33]); o.z = pk2(s[4 * 33], s[5 * 33]); o.w = pk2(s[6 * 33], s[7 * 33]);
            *(GAS v4u*)(WT + (size_t)(dst_row0 + n) * K + k0 + 8 * c) = o; } }
    LDS_WAIT(); asm volatile("" ::: "memory");
}
__device__ __forceinline__ void pro_a_phase(Frame& F) {
    __syncthreads();
    {
        LAS float* cact = (LAS float*)(F.lds + RING_OFF);
        LAS float* red = (LAS float*)(F.lds + RING_OFF + 65536);
        float* mod = (float*)((unsigned char*)F.wsg + WS_MOD); float* sht = (float*)((unsigned char*)F.wsg + WS_SHT);
        for (int item = F.bid; item < 192; item += F.G) {
            for (int idx = F.tid; idx < NBATCH * DM; idx += NWAVES * 64) { const int b = idx >> 11, k = idx & 2047; const float v = F.in(IN_C)[idx]; cact[k * 8 + b] = v / (1.0f + __expf(-v)); }
            __syncthreads();
            const int i = item / 48, nbase = (item % 48) * 256;
            const float* wp = F.in(IN_MODW) + ((size_t)i * DM + F.wave * 256) * 12288 + nbase + F.lane * 4;
            f32x4 acc[8];
#pragma unroll
            for (int b = 0; b < 8; ++b) acc[b] = (f32x4){0.f, 0.f, 0.f, 0.f};
#pragma unroll 8
            for (int kk = 0; kk < 256; ++kk) {
                const f32x4 w = *(const GAS f32x4*)(wp + (size_t)kk * 12288);
                const LAS f32x4* cp = (const LAS f32x4*)(cact + (F.wave * 256 + kk) * 8);
                const f32x4 c0 = cp[0], c1 = cp[1];
                acc[0] += w * c0.x; acc[1] += w * c0.y; acc[2] += w * c0.z; acc[3] += w * c0.w;
                acc[4] += w * c1.x; acc[5] += w * c1.y; acc[6] += w * c1.z; acc[7] += w * c1.w;
            }
#pragma unroll
            for (int b = 0; b < 8; ++b) *(LAS f32x4*)(red + (F.wave * 8 + b) * 256 + F.lane * 4) = acc[b];
            __syncthreads();
            for (int o = F.tid; o < 2048; o += NWAVES * 64) { const int b = o >> 8, col = o & 255, gc = nbase + col; float s = 0.f;
#pragma unroll
                for (int w = 0; w < 8; ++w) s += red[(w * 8 + b) * 256 + col];
                s += F.in(IN_MODB)[i * 12288 + gc];
                mod[((size_t)i * 8 + b) * 12288 + gc] = s;
                if (gc < DM) sht[((size_t)(2 * i) * DM + gc) * 8 + b] = s;
                else if (gc >= 3 * DM && gc < 4 * DM) sht[((size_t)(2 * i + 1) * DM + (gc - 3 * DM)) * 8 + b] = s; }
            __syncthreads();
        }
    }
    LAS float* scr = (LAS float*)(F.lds + RING_OFF + F.wave * 16384);
    const int gw = F.vcu * NWAVES + F.wave, NGW = F.G * NWAVES;
    constexpr int I_O = 32 * 64, I_GO = 32 * 64, I_F2 = 86 * 64;
    constexpr int NITEMS = 2 * (I_O + I_GO) + 4 * I_F2;
    bf16* Wo = (bf16*)((unsigned char*)F.wsg + WS_WO); bf16* Wgo = (bf16*)((unsigned char*)F.wsg + WS_WGO); bf16* Wf2 = (bf16*)((unsigned char*)F.wsg + WS_WF2);
    const int nfree = F.G > 192 ? (F.G - 192) * NWAVES : 0, nbusy = F.G * NWAVES - nfree, isfree = F.bid >= 192;
    const int n_free_items = nfree ? (int)((long)NITEMS * MK_PROA_SHARE / 100) : 0;
    const int it0 = isfree ? ((F.bid - 192) * NWAVES + F.wave) : (n_free_items + (F.bid < 192 ? F.bid : 0) * NWAVES + F.wave), its = isfree ? nfree : nbusy, itend = isfree ? n_free_items : NITEMS;
    for (int it = it0; it < itend; it += its) {
        int r = it;
        if (r < 2 * I_O) { const int j = r / I_O, q = r % I_O, kb = q / 64, nb = q % 64;
            transpose_item(F.in(IN_AWO) + (size_t)j * DM * DM, DM, DM, Wo + (size_t)j * DM * DM, 64 * kb, 32 * nb, 32 * nb, 32, scr, F.lane); continue; } r -= 2 * I_O;
        if (r < 2 * I_GO) { const int j = r / I_GO, q = r % I_GO, kb = q / 64, nb = q % 64;
            transpose_item(F.in(IN_GWO) + (size_t)j * DM * DM, DM, DM, Wgo + (size_t)j * DM * DM, 64 * kb, 32 * nb, 32 * nb, 32, scr, F.lane); continue; } r -= 2 * I_GO;
        { const int j = r / I_F2, q = r % I_F2, kb = q / 64, nb = q % 64;
            transpose_item(F.in(IN_FWOUT) + (size_t)j * DFF * DM, DM, DFF, Wf2 + (size_t)j * DM * DFF, 64 * kb, 32 * nb, 32 * nb, 32, scr, F.lane); }
    }
}
__device__ __forceinline__ void strip_item(const float* W, int ldw, bf16* WT, int n0, int dst_row0, int ncols, const float* sht, float* bias, int bpitch, LAS float* scr, int lane) {
    const int nl = lane & 31, bh = lane >> 5, c = lane & 7;
    f32x4 acc = (f32x4){0.f, 0.f, 0.f, 0.f};
    for (int kb = 0; kb < DM / 64; ++kb) { const int k0 = 64 * kb;
        const f32x4 sa = *(const GAS f32x4*)(sht + (size_t)k0 * 8 + lane * 4), sb = *(const GAS f32x4*)(sht + (size_t)k0 * 8 + 256 + lane * 4);
        if (ncols == 32) { const int n4 = (lane & 7) * 4, kr = lane >> 3; f32x4 t[8];
#pragma unroll
            for (int i = 0; i < 8; ++i) t[i] = *(const GAS f32x4*)(W + (size_t)(k0 + 8 * i + kr) * ldw + n0 + n4);
#pragma unroll
            for (int i = 0; i < 8; ++i) { LAS float* d = scr + (8 * i + kr) * 33 + n4; d[0] = t[i].x; d[1] = t[i].y; d[2] = t[i].z; d[3] = t[i].w; }
        } else {
#pragma unroll 8
            for (int i = 0; i < 32; ++i) { const int kk = 2 * i + (lane >> 5); if (nl < ncols) scr[kk * 33 + nl] = W[(size_t)(k0 + kk) * ldw + n0 + nl]; } }
        LDS_WAIT(); asm volatile("" ::: "memory");
#pragma unroll
        for (int j = 0; j < 4; ++j) { const int n = (lane >> 3) + 8 * j; const LAS float* s = scr + (8 * c) * 33 + n;
            if (n < ncols) { v4u o; o.x = pk2(s[0 * 33], s[1 * 33]); o.y = pk2(s[2 * 33], s[3 * 33]); o.z = pk2(s[4 * 33], s[5 * 33]); o.w = pk2(s[6 * 33], s[7 * 33]);
                *(GAS v4u*)(WT + (size_t)(dst_row0 + n) * DM + k0 + 8 * c) = o; } }
        LAS f32x4* sl = (LAS f32x4*)(scr + 64 * 33 + 16);
        sl[lane] = sa; sl[64 + lane] = sb;
        LDS_WAIT(); asm volatile("" ::: "memory");
#pragma unroll 8
        for (int kk = 0; kk < 64; ++kk) acc += sl[kk * 2 + bh] * scr[kk * 33 + nl];
        LDS_WAIT(); asm volatile("" ::: "memory");
    }
    if (nl < ncols) {
#pragma unroll
        for (int e = 0; e < 4; ++e) bias[(size_t)(4 * bh + e) * bpitch + n0 + nl] = acc[e]; }
}
__device__ __forceinline__ void pro_b_phase(Frame& F) {
    LAS float* scr = (LAS float*)(F.lds + RING_OFF + F.wave * 16384);
    const int gw = F.vcu * NWAVES + F.wave, NGW = F.G * NWAVES;
    constexpr int S_QKV = 193, S_GI = 128, S_F1 = 344, NSTRIPS = 2 * (S_QKV + S_GI) + 4 * S_F1;
    const float* sht = (const float*)((unsigned char*)F.wsg + WS_SHT); float* bv = (float*)((unsigned char*)F.wsg + WS_BIASV);
    bf16* Wqkv = (bf16*)((unsigned char*)F.wsg + WS_WQKV); bf16* Wgi = (bf16*)((unsigned char*)F.wsg + WS_WGI); bf16* Wf1 = (bf16*)((unsigned char*)F.wsg + WS_WF1);
    for (int it = gw; it < NSTRIPS; it += NGW) {
        int r = it;
        if (r < 2 * S_QKV) { const int j = r / S_QKV, nb = r % S_QKV;
            strip_item(F.in(IN_AWIN) + (size_t)j * DM * NQKVF, NQKVF, Wqkv + (size_t)j * WQKV_STRIDE, 32 * nb, 32 * nb, nb == 192 ? 16 : 32, sht + (size_t)(4 * j) * DM * 8, bv + BV_QKVF + (size_t)j * 8 * NQKVF, NQKVF, scr, F.lane); continue; } r -= 2 * S_QKV;
        if (r < 2 * S_GI) { const int j = r / S_GI, nb = r % S_GI;
            strip_item(F.in(IN_GWIN) + (size_t)j * DM * 4096, 4096, Wgi + (size_t)j * 4096 * DM, 32 * nb, 32 * nb, 32, sht + (size_t)(4 * j + 2) * DM * 8, bv + BV_GI + (size_t)j * 8 * 4096, 4096, scr, F.lane); continue; } r -= 2 * S_GI;
        { const int i = r / S_F1, nb = r % S_F1, n0 = 32 * nb, isup = n0 >= DFF, cch = n0 - isup * DFF;
            strip_item(F.in(IN_FWIN) + (size_t)i * DM * NFF2, NFF2, Wf1 + (size_t)i * NFF2 * DM, n0, 256 * (cch >> 7) + 128 * isup + (cch & 127), 32, sht + (size_t)(2 * i + 1) * DM * 8, bv + BV_F1 + (size_t)i * 8 * NFF2, NFF2, scr, F.lane); }
    }
}
__device__ __forceinline__ void xg0_phase(Frame& F, const float* xin, const float* g, const float* scale, bf16* XG, bf16* XB, u64* rss) {
    const int gw = F.vcu * NWAVES + F.wave, NGW = F.G * NWAVES;
    for (int rb = gw; rb < MTOK / 16; rb += NGW) {
        const int b = (rb * 16) >> 12;
        f32x4 gs[8];
#pragma unroll
        for (int j = 0; j < 8; ++j) { const int c4 = F.lane + 64 * j; gs[j] = ((const GAS f32x4*)g)[c4] * (((const GAS f32x4*)(scale + (size_t)b * 12288))[c4] + 1.0f); }
        for (int r = 0; r < 16; ++r) { const size_t row = (size_t)rb * 16 + r;
            const GAS f32x4* xr = (const GAS f32x4*)(xin + row * DM) + F.lane;
            f32x4 v[8]; float ss = 0.f;
#pragma unroll
            for (int j = 0; j < 8; ++j) { v[j] = xr[64 * j]; ss += (v[j].x * v[j].x + v[j].y * v[j].y) + (v[j].z * v[j].z + v[j].w * v[j].w); }
            ss = wave_sum(ss); if (F.lane == 0) rss[row] = (u64)(ss * FIXS);
            GAS v2u* o8 = (GAS v2u*)(XG + row * DM) + F.lane; GAS v2u* x8 = (GAS v2u*)(XB + row * DM) + F.lane;
#pragma unroll
            for (int j = 0; j < 8; ++j) { const f32x4 o = v[j] * gs[j]; v2u w; w.x = pk2(o.x, o.y); w.y = pk2(o.z, o.w); o8[64 * j] = w; v2u q; q.x = pk2(v[j].x, v[j].y); q.y = pk2(v[j].z, v[j].w); x8[64 * j] = q; } }
    }
}
__device__ __forceinline__ void normf_phase(Frame& F, float* x, const float* g) {
    const int gw = F.vcu * NWAVES + F.wave, NGW = F.G * NWAVES;
    for (int rb = gw; rb < MTOK / 16; rb += NGW) {
        f32x4 gs[8];
#pragma unroll
        for (int j = 0; j < 8; ++j) gs[j] = ((const GAS f32x4*)g)[F.lane + 64 * j];
        for (int r = 0; r < 16; ++r) { const size_t row = (size_t)rb * 16 + r;
            GAS f32x4* xr = (GAS f32x4*)(x + row * DM) + F.lane;
            f32x4 v[8]; float ss = 0.f;
#pragma unroll
            for (int j = 0; j < 8; ++j) { v[j] = xr[64 * j]; ss += (v[j].x * v[j].x + v[j].y * v[j].y) + (v[j].z * v[j].z + v[j].w * v[j].w); }
            const float rstd = 1.0f / sqrtf(wave_sum(ss) * (1.0f / DM) + EPS);
#pragma unroll
            for (int j = 0; j < 8; ++j) xr[64 * j] = v[j] * rstd * gs[j]; }
    }
}
__device__ __forceinline__ void fg_phase(Frame& F, const bf16* XG, const bf16* Wf, const float* bfv, const u64* rss, const float* biasf  , float* LOGF) {
    const int gw = F.vcu * NWAVES + F.wave, NGW = F.G * NWAVES, fr = F.lane & 15, fq = F.lane >> 4;
    for (int rb = gw; rb < MTOK / 16; rb += NGW) {
        const GAS bf16x8* ap = (const GAS bf16x8*)(XG + ((size_t)rb * 16 + fr) * DM + fq * 8);
        const GAS bf16x8* bp = (const GAS bf16x8*)(Wf + (size_t)fr * DM + fq * 8);
        f32x4 acc = (f32x4){0.f, 0.f, 0.f, 0.f};
#pragma unroll 8
        for (int ks = 0; ks < 64; ++ks) acc = __builtin_amdgcn_mfma_f32_16x16x32_bf16(bp[ks * 4], ap[ks * 4], acc, 0, 0, 0);
        const int b = (rb * 16) >> 12; const float rs = rstd_of(rss[(size_t)rb * 16 + fr]);
        const f32x4 bb = *(const GAS f32x4*)(bfv + 4 * fq) + *(const GAS f32x4*)(biasf + (size_t)b * NQKVF + 4 * fq); f32x4 o;
#pragma unroll
        for (int i = 0; i < 4; ++i) { const float z = acc[i] * rs + bb[i]; o[i] = fminf(z, 0.f) - log1pf(__expf(-fabsf(z))); }
        *(GAS f32x4*)(LOGF + ((size_t)rb * 16 + fr) * 16 + 4 * fq) = o;
    }
}
__device__ __forceinline__ void cum_phase(Frame& F, const float* LOGF, float* FB, bool grp) {
    LAS float* wt = (LAS float*)(F.lds + RING_OFF);
    for (int bh0 = grp ? (F.bid >> 3) : F.bid; bh0 < (grp ? NHEAD : NBATCH * NHEAD); bh0 += F.G) { const int bh = grp ? (F.bid & 7) * NHEAD + bh0 : bh0, b = bh >> 4, h = bh & 15;
        const float* p = LOGF + ((size_t)b * SEQ + F.tid * 8) * 16 + h;
        float v[8]; float s = 0.f;
#pragma unroll
        for (int i = 0; i < 8; ++i) { s += p[i * 16]; v[i] = s; }
        float incl = s;
#pragma unroll
        for (int o = 1; o < 64; o <<= 1) { const float t = __shfl_up(incl, o); if (F.lane >= o) incl += t; }
        if (F.lane == 63) wt[F.wave] = incl;
        __syncthreads();
        float base = incl - s;
        for (int w = 0; w < F.wave; ++w) base += wt[w];
        GAS f32x4* q = (GAS f32x4*)(FB + (size_t)bh * SEQ + F.tid * 8);
        q[0] = (f32x4){-(base + v[0]) * 1.4426950408889634f, -(base + v[1]) * 1.4426950408889634f, -(base + v[2]) * 1.4426950408889634f, -(base + v[3]) * 1.4426950408889634f};
        q[1] = (f32x4){-(base + v[4]) * 1.4426950408889634f, -(base + v[5]) * 1.4426950408889634f, -(base + v[6]) * 1.4426950408889634f, -(base + v[7]) * 1.4426950408889634f};
        __syncthreads();
    }
}
template <int VB>
__device__ __forceinline__ void gate_pv(fox::f32x16* o, int vb0, fox::bf16x8 pa0, fox::bf16x8 pa1, fox::bf16x8 pa2, fox::bf16x8 pa3) {
    using fox::s16x4; using fox::bf16x8;
#define TRRD(dst, off) asm volatile("ds_read_b64_tr_b16 %0, %1 offset:%2" : "=&v"(dst) : "v"(vb0), "i"(off) : "memory")
#define PV_D0(d0) do { s16x4 l0, l1, l2, l3, h0, h1, h2, h3; constexpr int b_ = VB * fox::SHM_V + fox::v_rd_off(d0, 0, 0); \
        TRRD(l0, b_); TRRD(h0, b_ + 2048); TRRD(l1, b_ + 4096); TRRD(h1, b_ + 6144); TRRD(l2, b_ + 8192); TRRD(h2, b_ + 10240); TRRD(l3, b_ + 12288); TRRD(h3, b_ + 14336); \
        asm volatile("s_waitcnt lgkmcnt(0)" ::: "memory"); __builtin_amdgcn_sched_barrier(0); \
        o[d0] = __builtin_amdgcn_mfma_f32_32x32x16_bf16((bf16x8){l0[0], l0[1], l0[2], l0[3], h0[0], h0[1], h0[2], h0[3]}, pa0, o[d0], 0, 0, 0);   \
        o[d0] = __builtin_amdgcn_mfma_f32_32x32x16_bf16((bf16x8){l1[0], l1[1], l1[2], l1[3], h1[0], h1[1], h1[2], h1[3]}, pa1, o[d0], 0, 0, 0);   \
        o[d0] = __builtin_amdgcn_mfma_f32_32x32x16_bf16((bf16x8){l2[0], l2[1], l2[2], l2[3], h2[0], h2[1], h2[2], h2[3]}, pa2, o[d0], 0, 0, 0);   \
        o[d0] = __builtin_amdgcn_mfma_f32_32x32x16_bf16((bf16x8){l3[0], l3[1], l3[2], l3[3], h3[0], h3[1], h3[2], h3[3]}, pa3, o[d0], 0, 0, 0); } while (0)
    PV_D0(0); PV_D0(1); PV_D0(2); PV_D0(3);
#undef PV_D0
#undef TRRD
}
__device__ __forceinline__ void gate_phase(Frame& F, const bf16* Z, const u64* VSS, const float* vg, const float* Ws, const float* bs, bf16* GT, bool grp, size_t zbump) {
    using fox::bf16x8; using fox::f32x16;
    const int r32 = F.lane & 31, hi = F.lane >> 5, c = F.wave >> 2, t0 = 32 * (F.wave & 3);
    const int vb0 = (int)(uintptr_t)(F.ldsg + RING_OFF) + c * 32768 + fox::v_rd_base(F.lane);
    constexpr int NITEM = (MTOK / 256) * 16;
#define GATE_MAP(it_) (grp ? ((((F.bid & 7) * 16 + ((it_) >> 4)) << 4) | ((it_) & 15)) : (it_))
    int itq = grp ? (F.bid >> 3) : F.bid; const int itstep = grp ? (F.G >> 3) : F.G, itend = grp ? 256 : NITEM; if (itq >= itend) return;
    int item = GATE_MAP(itq);
    bf16x8 aw[8]; int gcur = -1;
    const int srow = F.tid >> 4, c8 = (F.tid & 15) * 8;
    v4u vw[8]; u64 vs[8];
#define VO_Z() ((unsigned)((ltid() >> 4) * 4096 + (ltid() & 15) * 8) * 2u)
#define VO_S() ((unsigned)(ltid() >> 4) * 8u)
#define VO_U() ((unsigned)((c * 128 + t0 + (ltid() & 31)) * 4096 + 8 * ((ltid() >> 5) & 1)) * 2u)
#define VO_O() ((unsigned)((c * 128 + t0 + (ltid() & 31)) * DM + 8 * ((ltid() >> 5) & 1)) * 2u)
#define GATE_LOADV(it_) do { const int g_ = (it_) & 15; const size_t r_ = (size_t)((it_) >> 4) * 256;                                             \
        const unsigned vo_z = VO_Z(); _Pragma("unroll") for (int ps = 0; ps < 8; ++ps) vw[ps] = *(const GAS v4u*)((const GAS char*)(Z + (size_t)((it_) >> 8) * zbump + (r_ + 32 * ps) * 4096 + 2048 + g_ * 128) + vo_z); } while (0)
#define GATE_LOADS(it_) do { const size_t r_ = (size_t)((it_) >> 4) * 256;                                                                        \
        const unsigned vo_s = VO_S(); _Pragma("unroll") for (int ps = 0; ps < 8; ++ps) vs[ps] = *(const GAS u64*)((const GAS char*)(VSS + r_ + 32 * ps) + vo_s); } while (0)
#define GATE_RSTD() do { _Pragma("unroll") for (int ps = 0; ps < 8; ++ps) rs8[ps] = rstd_of(vs[ps]); } while (0)
    float rs8[8];
    GATE_LOADS(item); GATE_LOADV(item); GATE_RSTD();
    for (int i = 0; ; ++i) {
        const int g = item & 15, pnl = item >> 4; const size_t row0 = (size_t)pnl * 256;
        if (g != gcur) { gcur = g;
            const float* wr_ = Ws + ((size_t)g * 128 + t0 + r32) * 128 + 8 * hi;
#pragma unroll
            for (int ks = 0; ks < 8; ++ks) { const f32x4 a = *(const GAS f32x4*)(wr_ + 16 * ks), b = *(const GAS f32x4*)(wr_ + 16 * ks + 4); const int s0 = 16 * ks + 8 * hi; int t = t0 + r32; asm volatile("" : "+v"(t));
                v4u w; w.x = pk2(s0 + 0 <= t ? a.x : 0.f, s0 + 1 <= t ? a.y : 0.f); w.y = pk2(s0 + 2 <= t ? a.z : 0.f, s0 + 3 <= t ? a.w : 0.f);
                       w.z = pk2(s0 + 4 <= t ? b.x : 0.f, s0 + 5 <= t ? b.y : 0.f); w.w = pk2(s0 + 6 <= t ? b.z : 0.f, s0 + 7 <= t ? b.w : 0.f);
                aw[ks] = __builtin_bit_cast(bf16x8, w); } }
        { const f32x4 g0 = *(const GAS f32x4*)(vg + g * 128 + c8), g1 = *(const GAS f32x4*)(vg + g * 128 + c8 + 4);
#pragma unroll
          for (int ps = 0; ps < 8; ++ps) { const int row = srow + 32 * ps, s = row & 127; const v4u w = vw[ps]; const float rs = rs8[ps];
            v4u o; o.x = pk2(bflo(w.x) * rs * g0.x, bfhi(w.x) * rs * g0.y); o.y = pk2(bflo(w.y) * rs * g0.z, bfhi(w.y) * rs * g0.w);
                   o.z = pk2(bflo(w.z) * rs * g1.x, bfhi(w.z) * rs * g1.y); o.w = pk2(bflo(w.w) * rs * g1.z, bfhi(w.w) * rs * g1.w);
            *(LAS v4u*)(F.lds + RING_OFF + (i & 1) * 65536 + ((row >> 7) * 2 + (s >> 6)) * 16384 + fox::v_st(s & 63, c8)) = o; } }
        const int nxq = itq + itstep; const bool more = nxq < itend; const int nxt = GATE_MAP(nxq);
        if (more) GATE_LOADS(nxt);
        v4u uq[8];
        { const GAS v4u* up = (const GAS v4u*)((const GAS char*)(Z + (size_t)(pnl >> 4) * zbump + row0 * 4096 + g * 128) + VO_U());
#pragma unroll
          for (int j = 0; j < 8; ++j) uq[j] = up[j * 2]; }
        const float bias = bs[g * 128 + t0 + r32];
        if (more) GATE_LOADV(nxt);
        LDS_WAIT(); asm volatile("" ::: "memory"); __builtin_amdgcn_s_barrier(); asm volatile("" ::: "memory");
        if (more) GATE_RSTD();
        { const int vbi = vb0 + (i & 1) * 65536; GAS v4u* op = (GAS v4u*)((GAS char*)(GT + row0 * DM + g * 128) + VO_O());
          using fox::s16x4;
#define G_TRRD(dst, off) asm volatile("ds_read_b64_tr_b16 %0, %1 offset:%2" : "=&v"(dst) : "v"(vbi), "i"(off) : "memory")
#define G_LD(R, tile, d0) do { constexpr int b_ = (tile) * 16384 + fox::v_rd_off(d0, 0, 0); G_TRRD(R##0, b_); G_TRRD(R##1, b_ + 2048); G_TRRD(R##2, b_ + 4096); G_TRRD(R##3, b_ + 6144); G_TRRD(R##4, b_ + 8192); G_TRRD(R##5, b_ + 10240); G_TRRD(R##6, b_ + 12288); G_TRRD(R##7, b_ + 14336); } while (0)
#define G_J(l, h) ((bf16x8){l[0], l[1], l[2], l[3], h[0], h[1], h[2], h[3]})
#define G_MM(R, A) do { acc = __builtin_amdgcn_mfma_f32_32x32x16_bf16(G_J(R##0, R##1), aw[(A) + 0], acc, 0, 0, 0); acc = __builtin_amdgcn_mfma_f32_32x32x16_bf16(G_J(R##2, R##3), aw[(A) + 1], acc, 0, 0, 0); \
        acc = __builtin_amdgcn_mfma_f32_32x32x16_bf16(G_J(R##4, R##5), aw[(A) + 2], acc, 0, 0, 0); acc = __builtin_amdgcn_mfma_f32_32x32x16_bf16(G_J(R##6, R##7), aw[(A) + 3], acc, 0, 0, 0); } while (0)
#define G_W(n, R) asm volatile("s_waitcnt lgkmcnt(" #n ")" : "+v"(R##0), "+v"(R##1), "+v"(R##2), "+v"(R##3), "+v"(R##4), "+v"(R##5), "+v"(R##6), "+v"(R##7) :: "memory")
#define G_EPI(d0) do { _Pragma("unroll") for (int hf = 0; hf < 2; ++hf) { const v4u uw = uq[(d0) * 2 + hf];                                                                                          \
                auto s0 = __builtin_amdgcn_permlane32_swap(uw.x, uw.z, false, false); auto s1 = __builtin_amdgcn_permlane32_swap(uw.y, uw.w, false, false);     \
                const int j0 = 8 * hf;                                                                                                                                                            \
                const float v0 = bflo(s0[0]) * (acc[j0 + 0] + bias), v1 = bfhi(s0[0]) * (acc[j0 + 1] + bias), v2 = bflo(s1[0]) * (acc[j0 + 2] + bias), v3 = bfhi(s1[0]) * (acc[j0 + 3] + bias);      \
                const float v4 = bflo(s0[1]) * (acc[j0 + 4] + bias), v5 = bfhi(s0[1]) * (acc[j0 + 5] + bias), v6 = bflo(s1[1]) * (acc[j0 + 6] + bias), v7 = bfhi(s1[1]) * (acc[j0 + 7] + bias);      \
                const unsigned a0 = fox::cvtpk(v0, v1), a1 = fox::cvtpk(v2, v3), b0 = fox::cvtpk(v4, v5), b1 = fox::cvtpk(v6, v7);                                                                 \
                auto r0 = __builtin_amdgcn_permlane32_swap(a0, b0, false, false); auto r1 = __builtin_amdgcn_permlane32_swap(a1, b1, false, false);                                                \
                v4u w; w.x = r0[0]; w.y = r1[0]; w.z = r0[1]; w.w = r1[1];                                                                                                                         \
                op[(d0) * 4 + hf * 2] = w; } } while (0)
          s16x4 fa0, fa1, fa2, fa3, fa4, fa5, fa6, fa7, fb0, fb1, fb2, fb3, fb4, fb5, fb6, fb7; f32x16 acc;
          if (t0 >= 64) {
              G_LD(fa, 0, 0); G_LD(fb, 1, 0);
              G_W(8, fa); acc = (f32x16){}; G_MM(fa, 0); G_LD(fa, 0, 1); G_W(8, fb); G_MM(fb, 4); G_LD(fb, 1, 1); G_EPI(0);
              G_W(8, fa); acc = (f32x16){}; G_MM(fa, 0); G_LD(fa, 0, 2); G_W(8, fb); G_MM(fb, 4); G_LD(fb, 1, 2); G_EPI(1);
              G_W(8, fa); acc = (f32x16){}; G_MM(fa, 0); G_LD(fa, 0, 3); G_W(8, fb); G_MM(fb, 4); G_LD(fb, 1, 3); G_EPI(2);
              G_W(8, fa); acc = (f32x16){}; G_MM(fa, 0); G_W(0, fb); G_MM(fb, 4); G_EPI(3);
          } else {
              G_LD(fa, 0, 0); G_LD(fb, 0, 1);
              G_W(8, fa); acc = (f32x16){}; G_MM(fa, 0); G_LD(fa, 0, 2); G_EPI(0);
              G_W(8, fb); acc = (f32x16){}; G_MM(fb, 0); G_LD(fb, 0, 3); G_EPI(1);
              G_W(8, fa); acc = (f32x16){}; G_MM(fa, 0); G_EPI(2);
              G_W(0, fb); acc = (f32x16){}; G_MM(fb, 0); G_EPI(3);
          }
#undef G_EPI
#undef G_W
#undef G_MM
#undef G_J
#undef G_LD
#undef G_TRRD
        }
        if (!more) break;
        item = nxt; itq = nxq;
    }
#undef VO_O
#undef VO_U
#undef VO_S
#undef VO_Z
#undef GATE_MAP
#undef GATE_RSTD
#undef GATE_LOADS
#undef GATE_LOADV
    __syncthreads();
}
__device__ __forceinline__ float silu1(float v) { return v * __builtin_amdgcn_rcpf(1.0f + __builtin_amdgcn_exp2f(v * -1.4426950408889634f)); }
__device__ __forceinline__ void fix_phase(Frame& F, const float* HALO, const float* cw, const float* cb, bf16* ACT, int pm_lo, int pm_n, bool grp) {
    constexpr int C4 = DFF / 4;
    const int wgi = grp ? (F.bid >> 3) : F.bid, wgn = grp ? (F.G >> 3) : F.G, nit = grp ? 16 * C4 : pm_n * C4, pbase = grp ? (F.bid & 7) * 16 : pm_lo;
    for (int item = wgi * (NWAVES * 64) + F.tid; item < nit; item += wgn * NWAVES * 64) {
        const int pm = pbase + item / C4, c4 = (item % C4) * 4; if ((pm & 15) == 0) continue;
        f32x4 r0[2], r1[2];
#pragma unroll
        for (int part = 0; part < 2; ++part) { const int col = part * DFF + c4;
            const f32x4 am2 = *(const GAS f32x4*)(HALO + ((size_t)(pm - 1) * 4 + 2) * NFF2 + col), am1 = *(const GAS f32x4*)(HALO + ((size_t)(pm - 1) * 4 + 3) * NFF2 + col);
            const f32x4 a0 = *(const GAS f32x4*)(HALO + ((size_t)pm * 4 + 0) * NFF2 + col), a1 = *(const GAS f32x4*)(HALO + ((size_t)pm * 4 + 1) * NFF2 + col);
            const f32x4 w0 = *(const GAS f32x4*)(cw + col), w1 = *(const GAS f32x4*)(cw + NFF2 + col), w2 = *(const GAS f32x4*)(cw + 2 * NFF2 + col), b = *(const GAS f32x4*)(cb + col);
            r0[part] = b + w0 * am2 + w1 * am1 + w2 * a0; r1[part] = b + w0 * am1 + w1 * a0 + w2 * a1; }
        v2u o0, o1;
        o0.x = pk2(silu1(r0[0].x) * r0[1].x, silu1(r0[0].y) * r0[1].y); o0.y = pk2(silu1(r0[0].z) * r0[1].z, silu1(r0[0].w) * r0[1].w);
        o1.x = pk2(silu1(r1[0].x) * r1[1].x, silu1(r1[0].y) * r1[1].y); o1.y = pk2(silu1(r1[0].z) * r1[1].z, silu1(r1[0].w) * r1[1].w);
        *(GAS v2u*)(ACT + ((size_t)pm * 256) * DFF + c4) = o0; *(GAS v2u*)(ACT + ((size_t)pm * 256 + 1) * DFF + c4) = o1;
    }
}
constexpr int NPHASE = 96;
struct Args { const float* in[19]; float* out; unsigned char* ws; int ph_lo, ph_hi; };
static_assert(sizeof(Args) == 19 * 8 + 8 + 8 + 8, "Args has no padding bytes");
#ifndef MK_EN
#define MK_EN 0xffffffffu
#endif
#define EN(k) (((MK_EN) >> (k)) & 1u)
#ifndef MK_BARPROBE
#define MK_BARPROBE 0
#endif
#ifndef MK_BARSEL
#define MK_BARSEL 0
#endif
#define BARSEL(ph) (MK_BARSEL == 0 ? true : MK_BARSEL == 1 ? ((ph) < 2) : MK_BARSEL == 2 ? ((ph) == 2 || (ph) == 15) : MK_BARSEL == 3 ? ((ph) == 3 || (ph) == 16) : MK_BARSEL == 4 ? ((ph) == 4 || (ph) == 17) : MK_BARSEL == 5 ? ((ph) == 5 || (ph) == 18 || (ph) == 11 || (ph) == 24) : \
    MK_BARSEL == 6 ? ((ph) == 6 || (ph) == 19 || (ph) == 12 || (ph) == 25) : MK_BARSEL == 7 ? ((ph) == 7 || (ph) == 20 || (ph) == 13 || (ph) == 26) : MK_BARSEL == 8 ? ((ph) == 8 || (ph) == 21 || (ph) == 14 || (ph) == 27) : MK_BARSEL == 9 ? ((ph) == 9 || (ph) == 22) : MK_BARSEL == 10 ? ((ph) == 10 || (ph) == 23) : false)
#if MK_BARPROBE
#define BARPROBE_T0() const unsigned long long bpt0_ = __builtin_amdgcn_s_memrealtime()
#define BARPROBE_T1() do { if (threadIdx.x == 0 && ph + 2 < hi) __hip_atomic_fetch_add((unsigned long long*)((unsigned char*)F.wsg + WS_CTL + 512 * 1024), __builtin_amdgcn_s_memrealtime() - bpt0_, __ATOMIC_RELAXED, __HIP_MEMORY_SCOPE_AGENT); } while (0)
#else
#define BARPROBE_T0() do {} while (0)
#define BARPROBE_T1() do {} while (0)
#endif
#ifndef MK_TPSITE
#define MK_TPSITE 1
#endif
#ifndef MK_TPROBE
#define MK_TPROBE 0
#endif
#ifndef MK_CLKPROBE
#define MK_CLKPROBE 0
#endif
#ifndef MK_GROUPS
#define MK_GROUPS 1
#endif
#ifndef MK_FUSEFIN
#define MK_FUSEFIN 0
#endif
#ifndef MK_FFN_SPLIT
#define MK_FFN_SPLIT 1
#endif
#ifndef MK_PAD
#define MK_PAD 0
#endif
#define MK_STR2(x) #x
#define MK_STR(x) MK_STR2(x)
#define MK_PAD_STR MK_STR(MK_PAD)
#ifndef MK_DYNTAIL
#define MK_DYNTAIL 0
#endif
#ifndef MK_ALIGN
#define MK_ALIGN true
#endif
#ifndef MK_STAG_F1
#define MK_STAG_F1 0
#endif
#ifndef MK_REPBAR
#define MK_REPBAR 0
#endif
#ifndef MK_SP2
#define MK_SP2 true
#endif
#ifndef MK_BAR2
#define MK_BAR2 0
#endif
#ifndef MK_KREP
#define MK_KREP 1
#endif
#ifndef MK_REP
#define MK_REP 0u
#endif
#define REPN(k) ((((MK_REP) >> (k)) & 1u) ? 2 : 1)
#define W_MOD   ((float*)((unsigned char*)F.wsg + WS_MOD))
#define W_H     ((bf16*)((unsigned char*)F.wsg + WS_H))
#define W_Q     ((bf16*)((unsigned char*)F.wsg + WS_R))
#define W_K     ((bf16*)((unsigned char*)F.wsg + WS_R + 16 * MiB))
#define W_V     ((bf16*)((unsigned char*)F.wsg + WS_R + 32 * MiB))
#define W_Z     ((bf16*)((unsigned char*)F.wsg + WS_R))
#define W_ACT   ((bf16*)((unsigned char*)F.wsg + WS_ACT))
#define W_HALO  ((float*)((unsigned char*)F.wsg + WS_ACT + 344 * MiB))
#define W_LOGF  ((float*)((unsigned char*)F.wsg + WS_LOGF))
#define W_FB    ((float*)((unsigned char*)F.wsg + WS_FB))
#define W_VSS(n) ((u64*)((unsigned char*)F.wsg + WS_VSS) + (size_t)(n) * MTOK)
#define W_XB    ((bf16*)((unsigned char*)F.wsg + WS_XB))
#define W_H2    ((bf16*)((unsigned char*)F.wsg + WS_H2))
#define W_RSS(n) ((u64*)((unsigned char*)F.wsg + WS_RSS) + (size_t)(n) * MTOK)
#define W_BIASV ((float*)((unsigned char*)F.wsg + WS_BIASV))
#define W_MODI  (W_MOD + (size_t)i * 8 * 12288)
#define XOUT_(k) ((REPN(k) == 2 && rep_ == 0) ? W_H : W_XB)
#define XG_(k, p) ((REPN(k) == 2 && rep_ == 0) ? (bf16*)nullptr : (p))
__global__ void __launch_bounds__(NWAVES * 64, 2) mega_fwd(Args args) {
    extern __shared__ __attribute__((aligned(16))) unsigned char lds[];
    Frame F;
#if MK_PAD > 0
    asm volatile(".rept " MK_PAD_STR "\n\ts_nop 0\n\t.endr" ::: "memory");
#endif
    F.lds = (LAS unsigned char*)lds; F.ldsg = (char*)lds;
    F.MISC = (volatile LAS unsigned*)(F.lds + MISC_OFF);
    for (int u = threadIdx.x; u < (LDS_BYTES - LDSCTL_OFF) / 4; u += NWAVES * 64) ((LAS unsigned*)(F.lds + LDSCTL_OFF))[u] = 0u;
    __syncthreads();
    if (threadIdx.x == 0) {
        const int G = gridDim.x, bx = blockIdx.x; const unsigned long long kp = (unsigned long long)__builtin_amdgcn_kernarg_segment_ptr(), wp = (unsigned long long)args.ws, op = (unsigned long long)args.out;
        F.MISC[MW_BID] = (unsigned)bx; F.MISC[MW_G] = (unsigned)G; F.MISC[MW_VCU] = (unsigned)((G % 8 == 0) ? (bx % 8) * (G / 8) + bx / 8 : bx);
        F.MISC[MW_INP] = (unsigned)kp; F.MISC[MW_INP_HI] = (unsigned)(kp >> 32); F.MISC[MW_WS] = (unsigned)wp; F.MISC[MW_WS_HI] = (unsigned)(wp >> 32); F.MISC[MW_OUT] = (unsigned)op; F.MISC[MW_OUT_HI] = (unsigned)(op >> 32);
    }
    __syncthreads();
    XcdBarrier bar; bar.bar = (unsigned*)(args.ws + WS_CTL) + CW_BAR; bar.x = 0; bar.st = nullptr;
    if (!MK_PER_PHASE) bar = xcd_barrier_post((unsigned*)(args.ws + WS_CTL) + CW_BAR, F.MISC + 8);
    XcdBarrier gbar = bar; const bool grp = MK_GROUPS && !MK_PER_PHASE && gridDim.x == 256;
    if (grp) { gbar = xcd_barrier_post((unsigned*)(args.ws + WS_CTL) + CW_BAR + XCD_BAR_WORDS * (1 + (blockIdx.x & 7)), F.MISC + 10); gbar.total = 32u; }
    const int lo = args.ph_lo, hi = args.ph_hi;
    int ph = 0;
#define REPBAR(k) ((MK_REPBAR && rep_ < REPN(k)) ? (relaunder(F), bar.bar = (unsigned*)((unsigned char*)F.wsg + WS_CTL) + CW_BAR, xcd_barrier(bar), 0) : 0)
#define RUN() (lo <= ph && ph < hi && relaunder(F))
#define SEAMX(glob) do { if (!MK_PER_PHASE) { if (lo <= ph && ph + 1 < hi) { relaunder(F); if ((glob) || !grp) { bar.bar = (unsigned*)((unsigned char*)F.wsg + WS_CTL) + CW_BAR; asm volatile("" : "+s"(bar.x)); if (MK_BARPROBE && threadIdx.x == 0) F.MISC[41] = BARSEL(ph) ? 1u : 0u; xcd_barrier(bar); if (MK_BAR2) xcd_barrier(bar); } \
        else { gbar.bar = (unsigned*)((unsigned char*)F.wsg + WS_CTL) + CW_BAR + XCD_BAR_WORDS * (1 + (F.bid & 7)); asm volatile("" : "+s"(gbar.x)); if (MK_BARPROBE && threadIdx.x == 0) F.MISC[41] = BARSEL(ph) ? 1u : 0u; xcd_barrier(gbar); } } } ++ph; } while (0)
#define SEAM() SEAMX(true)
#define SEAMG() SEAMX(false)

    if (EN(0) && RUN()) for (int rep_ = 0; rep_ < REPN(0); ++rep_, REPBAR(0)) pro_a_phase(F);
    SEAM();
    if (EN(1) && RUN()) for (int rep_ = 0; rep_ < REPN(1); ++rep_, REPBAR(1)) { pro_b_phase(F); xg0_phase(F, F.in(IN_X), F.in(IN_MIXG), W_MOD + DM, W_H, W_XB, W_RSS(0)); }
    SEAM();
    for (int i = 0; i < DEPTH; ++i) {
        const int j = i >> 1;
        if ((i & 1) == 0) {
            if (EN(3) && RUN()) for (int rep_ = 0; rep_ < REPN(3); ++rep_, REPBAR(3)) {
                const bf16* wq = (const bf16*)((unsigned char*)F.wsg + WS_WQKV) + (size_t)j * WQKV_STRIDE; const float* bvq = W_BIASV + BV_QKVF + (size_t)j * 8 * NQKVF;
                fg_phase(F, W_H, wq + (size_t)6144 * DM, F.in(IN_ABF) + j * 16, W_RSS(2 * i), bvq + 6144, W_LOGF);
                pg8::Gemm g{W_H, wq, MTOK, 6144, DM}; pg8::StaticOrder S; S.init(MTOK, 6144, F.G, F.bid);
                pg8::EpiQKV E{W_Q, (size_t)(8 * MiB), (size_t)(24 * MiB), fox::QSCALE, pg8::RowAffine{W_RSS(2 * i), bvq, NQKVF, (LAS float*)(F.lds + XCH_OFF + 8192)}};
                pg8::gemm_phase<pg8::EpiQKV, pg8::StaticOrder, MK_ALIGN, MK_SP2>(F.lds + RING_OFF, g, S, E);
            }
            SEAMG();
            if (EN(4) && RUN()) for (int rep_ = 0; rep_ < REPN(4); ++rep_, REPBAR(4)) cum_phase(F, W_LOGF, W_FB, grp);
            SEAMG();
            if (EN(5) && RUN()) for (int rep_ = 0; rep_ < REPN(5); ++rep_, REPBAR(5)) fox::att_phase(F.ldsg + RING_OFF, (const fox::bf16*)W_Q, (const fox::bf16*)W_K, (const fox::bf16*)W_V, (fox::bf16*)W_H, W_FB, F.bid, F.G, grp);
            SEAMG();
            if (EN(6) && RUN()) for (int rep_ = 0; rep_ < REPN(6); ++rep_, REPBAR(6)) {
                pg8::Gemm g{W_H, (const bf16*)((unsigned char*)F.wsg + WS_WO) + (size_t)j * DM * DM, MTOK, DM, DM}; pg8::StaticOrder S; S.init(MTOK, DM, F.G, F.bid);
                pg8::EpiRes E{XOUT_(6), W_MODI + 2 * DM, 12288, XG_(6, W_H2), F.in(IN_FFNG) + i * DM, W_MODI + 4 * DM, W_RSS(2 * i + 1), (LAS float*)(F.lds + XCH_OFF), (float*)nullptr};
                pg8::gemm_phase<pg8::EpiRes, pg8::StaticOrder, MK_ALIGN, MK_SP2>(F.lds + RING_OFF, g, S, E);
            }
            SEAMG();
        } else {
            if (EN(7) && RUN()) for (int rep_ = 0; rep_ < REPN(7); ++rep_, REPBAR(7)) {
                pg8::Gemm g{W_H, (const bf16*)((unsigned char*)F.wsg + WS_WGI) + (size_t)j * 4096 * DM, MTOK, 4096, DM}; pg8::StaticOrder S; S.init(MTOK, 4096, F.G, F.bid);
                pg8::EpiStore<1> E{W_Z, 4096, pg8::RowAffine{W_RSS(2 * i), W_BIASV + BV_GI + (size_t)j * 8 * 4096, 4096, (LAS float*)(F.lds + XCH_OFF + 8192)}, W_VSS(j), (size_t)(8 * MiB)};
                pg8::gemm_phase<pg8::EpiStore<1>, pg8::StaticOrder, MK_ALIGN, MK_SP2>(F.lds + RING_OFF, g, S, E);
            }
            SEAMG();
            if (EN(9) && RUN()) for (int rep_ = 0; rep_ < REPN(9); ++rep_, REPBAR(9)) gate_phase(F, W_Z, W_VSS(j), F.in(IN_GVG) + j * DM, F.in(IN_GWS) + (size_t)j * 16 * 128 * 128, F.in(IN_GBS) + j * 16 * 128, W_H, grp, (size_t)(8 * MiB));
            SEAMG();
            if (EN(10) && RUN()) for (int rep_ = 0; rep_ < REPN(10); ++rep_, REPBAR(10)) {
                pg8::Gemm g{W_H, (const bf16*)((unsigned char*)F.wsg + WS_WGO) + (size_t)j * DM * DM, MTOK, DM, DM}; pg8::StaticOrder S; S.init(MTOK, DM, F.G, F.bid);
                pg8::EpiRes E{XOUT_(10), W_MODI + 2 * DM, 12288, XG_(10, W_H2), F.in(IN_FFNG) + i * DM, W_MODI + 4 * DM, W_RSS(2 * i + 1), (LAS float*)(F.lds + XCH_OFF), (float*)nullptr};
                pg8::gemm_phase<pg8::EpiRes, pg8::StaticOrder, MK_ALIGN, MK_SP2>(F.lds + RING_OFF, g, S, E);
            }
            SEAMG();
        }
        for (int hf_ = 0; hf_ < MK_FFN_SPLIT; ++hf_) {
        const int pmn_ = (MTOK / 256) / MK_FFN_SPLIT, pm0_ = hf_ * pmn_;
        if (EN(11) && RUN()) for (int rep_ = 0; rep_ < REPN(11); ++rep_, REPBAR(11)) {
            stagger(F, MK_STAG_F1);
#if MK_CLKPROBE
            unsigned long long pc0_ = 0, pr0_ = 0; if (i == 0 && F.bid == 0) { pc0_ = __builtin_amdgcn_s_memtime(); pr0_ = __builtin_amdgcn_s_memrealtime(); }
#endif
            pg8::Gemm g{W_H2, (const bf16*)((unsigned char*)F.wsg + WS_WF1) + (size_t)i * NFF2 * DM, MTOK, NFF2, DM}; pg8::StaticOrder S; S.init(MTOK / MK_FFN_SPLIT, NFF2, F.G, F.bid); S.pm_off = pm0_;
            pg8::EpiConv E{W_ACT, F.in(IN_FCW) + (size_t)i * 3 * NFF2, F.in(IN_FCB) + (size_t)i * NFF2, W_HALO, (LAS float*)(F.lds + XCH_OFF), pg8::RowAffine{W_RSS(2 * i + 1), W_BIASV + BV_F1 + (size_t)i * 8 * NFF2, NFF2, (LAS float*)(F.lds + XCH_OFF + 8192)}, (LAS float*)(F.lds + CWT_OFF)};
#if MK_TPROBE && MK_TPSITE == 1
            { unsigned long long tpv_ = 0; pg8::gemm_phase<pg8::EpiConv, pg8::StaticOrder, true, MK_SP2, MK_KREP, MK_TPROBE>(F.lds + RING_OFF, g, S, E, &tpv_);
              if (i == 0 && F.bid == 0 && threadIdx.x == 0) F.MISC[40] = (unsigned)(tpv_ * 10ull); }
#elif MK_DYNTAIL
            { pg8::TailClaimOrder T; T.init(MTOK, NFF2, F.G, F.bid); T.init_tail((unsigned*)((unsigned char*)F.wsg + WS_CTL + 768 * 1024) + i * 8 * 64, (volatile LAS unsigned*)(F.MISC + 42));
              pg8::gemm_phase<pg8::EpiConv, pg8::TailClaimOrder, true, MK_SP2, MK_KREP>(F.lds + RING_OFF, g, T, E); }
#else
            pg8::gemm_phase<pg8::EpiConv, pg8::StaticOrder, true, MK_SP2, MK_KREP>(F.lds + RING_OFF, g, S, E);
#endif
#if MK_CLKPROBE
            if (i == 0 && F.bid == 0) { const unsigned long long dc_ = __builtin_amdgcn_s_memtime() - pc0_, dr_ = __builtin_amdgcn_s_memrealtime() - pr0_;
                if (threadIdx.x == 0) { F.MISC[40] = (unsigned)(dc_ * 5000ull / (dr_ ? dr_ : 1ull)); } }
#endif
        }
        SEAMG();
        if (EN(12) && RUN()) for (int rep_ = 0; rep_ < REPN(12); ++rep_, REPBAR(12)) fix_phase(F, W_HALO, F.in(IN_FCW) + (size_t)i * 3 * NFF2, F.in(IN_FCB) + (size_t)i * NFF2, W_ACT, pm0_, pmn_, grp);
        SEAMG();
        if (EN(13) && RUN()) for (int rep_ = 0; rep_ < REPN(13); ++rep_, REPBAR(13)) {
            pg8::Gemm g{W_ACT, (const bf16*)((unsigned char*)F.wsg + WS_WF2) + (size_t)i * DM * DFF, MTOK, DM, DFF}; pg8::StaticOrder S; S.init(MTOK / MK_FFN_SPLIT, DM, F.G, F.bid); S.pm_off = pm0_;
            const int in_ = i < DEPTH - 1 ? i + 1 : i;
#if MK_FUSEFIN
            pg8::EpiResF E{{XOUT_(13), W_MODI + 5 * DM, 12288, XG_(13, i < DEPTH - 1 ? W_H : (bf16*)nullptr), F.in(IN_MIXG) + in_ * DM, W_MOD + (size_t)in_ * 8 * 12288 + DM, W_RSS(2 * in_), (LAS float*)(F.lds + XCH_OFF), (float*)nullptr},
                i < DEPTH - 1 ? (float*)nullptr : (float*)F.outg, F.in(IN_FING), (u64*)((unsigned char*)F.wsg + WS_RSSF), (unsigned*)((unsigned char*)F.wsg + WS_PCNT)};
#else
            pg8::EpiRes E{XOUT_(13), W_MODI + 5 * DM, 12288, XG_(13, i < DEPTH - 1 ? W_H : (bf16*)nullptr), F.in(IN_MIXG) + in_ * DM, W_MOD + (size_t)in_ * 8 * 12288 + DM, W_RSS(2 * in_), (LAS float*)(F.lds + XCH_OFF), i < DEPTH - 1 ? (float*)nullptr : (float*)F.outg};
#endif
#if MK_TPROBE && MK_TPSITE == 2
            { unsigned long long tpv_ = 0; pg8::gemm_phase<pg8::EpiRes, pg8::StaticOrder, MK_ALIGN, MK_SP2, 1, MK_TPROBE>(F.lds + RING_OFF, g, S, E, &tpv_);
              if (i == 0 && F.bid == 0 && threadIdx.x == 0) F.MISC[40] = (unsigned)(tpv_ * 10ull); }
#else
#if MK_FUSEFIN
            pg8::gemm_phase<pg8::EpiResF, pg8::StaticOrder, MK_ALIGN, MK_SP2>(F.lds + RING_OFF, g, S, E);
#else
            pg8::gemm_phase<pg8::EpiRes, pg8::StaticOrder, MK_ALIGN, MK_SP2>(F.lds + RING_OFF, g, S, E);
#endif
#endif
        }
        if (MK_FUSEFIN && i == DEPTH - 1) ++ph; else SEAMG();
        }
    }
#if MK_BARPROBE
    if (blockIdx.x == 0 && threadIdx.x == 0) F.MISC[40] = (unsigned)(__hip_atomic_load((unsigned long long*)((unsigned char*)F.wsg + WS_CTL + (CW_BAR + 3600) * 4), __ATOMIC_RELAXED, __HIP_MEMORY_SCOPE_AGENT) * 10ull / 256ull);
#endif
#if MK_CLKPROBE || MK_TPROBE || MK_BARPROBE || MK_PPPROBE || MK_VWPROBE
    if (blockIdx.x == 0) { __syncthreads(); const unsigned w_ = F.MISC[40]; const unsigned long long t0_ = __builtin_amdgcn_s_memrealtime(); while (__builtin_amdgcn_s_memrealtime() - t0_ < (unsigned long long)w_) __builtin_amdgcn_s_sleep(32); }
#endif
    if (!MK_FUSEFIN && EN(14) && RUN()) normf_phase(F, (float*)F.outg, F.in(IN_FING));
#undef RUN
#undef SEAM
}

extern "C" void kernel_launch(void* const* d_in, const int* in_sizes, int n_in, void* d_out, int out_size, void* d_ws, size_t ws_size, hipStream_t stream) {
    static int grid = 0;
    if (grid == 0) {
        if (n_in != 19 || out_size != MTOK * DM || ws_size < WS_END) { fprintf(stderr, "kernel_launch: unexpected shapes (n_in %d, out %d, ws %zu < %zu)\n", n_in, out_size, ws_size, (size_t)WS_END); grid = -1; return; }
        int dev = 0, cus = 0, per_cu = 0;
        if (hipGetDevice(&dev) != hipSuccess || hipDeviceGetAttribute(&cus, hipDeviceAttributeMultiprocessorCount, dev) != hipSuccess) { grid = -1; return; }
        if (hipFuncSetAttribute((const void*)mega_fwd, hipFuncAttributeMaxDynamicSharedMemorySize, LDS_BYTES) != hipSuccess) { fprintf(stderr, "kernel_launch: hipFuncSetAttribute failed\n"); grid = -1; return; }
        if (hipOccupancyMaxActiveBlocksPerMultiprocessor(&per_cu, (const void*)mega_fwd, NWAVES * 64, LDS_BYTES) != hipSuccess || per_cu < 1) { fprintf(stderr, "kernel_launch: occupancy query says %d\n", per_cu); }
        (void)hipGetLastError();
        grid = cus;
    }
    if (grid < 0) return;
    if (hipMemsetAsync((char*)d_ws + WS_CTL, 0, CTL_ZERO_BYTES, stream) != hipSuccess) return;
    Args a{};
    for (int i = 0; i < 19; ++i) a.in[i] = (const float*)d_in[i];
    a.out = (float*)d_out; a.ws = (unsigned char*)d_ws;
#if MK_PER_PHASE
    for (int p = 0; p < NPHASE; ++p) { a.ph_lo = p; a.ph_hi = p + 1; hipLaunchKernelGGL(mega_fwd, dim3(grid), dim3(NWAVES * 64), LDS_BYTES, stream, a); }
#else
    a.ph_lo = 0; a.ph_hi = NPHASE; hipLaunchKernelGGL(mega_fwd, dim3(grid), dim3(NWAVES * 64), LDS_BYTES, stream, a);
#endif
}
```

```cpp
#include <hip/hip_runtime.h>
#include <hip/hip_bf16.h>
#include <cstdio>
#include <cstdint>
__device__ __forceinline__ int ltid() { int t = (int)threadIdx.x; asm volatile("" : "+v"(t)); return t; }
namespace pg8 {
#define PG8_LAS __attribute__((address_space(3)))
typedef unsigned short bf16_t;
typedef short bf16x8 __attribute__((ext_vector_type(8)));
typedef float f32x4 __attribute__((ext_vector_type(4)));
typedef unsigned u32x4 __attribute__((ext_vector_type(4)));
constexpr int BM = 256, BK = 64, HALF = 128, HTB = HALF * BK * 2  , STAGE_BYTES = 8 * HTB, NXCD = 8;
#ifndef MK_SETPRIO
#define MK_SETPRIO 1
#endif
#ifndef MK_DYNGLOBAL
#define MK_DYNGLOBAL 1
#endif
#ifndef MK_RELAXW
#define MK_RELAXW 0
#endif
#ifndef MK_WGM
#define MK_WGM 4
#endif
constexpr int WGM = MK_WGM;

__host__ __device__ __forceinline__ int lds_byte(int r, int c) { const int st = (r >> 4) * 2 + (c >> 5), rr = r & 15, cc = c & 31, ob = rr * 64 + cc * 2; return st * 1024 + (ob ^ (((ob >> 9) & 1) << 5)); }
__host__ __device__ __forceinline__ void stage_rc(int b, int& R, int& C) { const int st = b / 1024, sb = b % 1024, swz = sb ^ (((sb >> 9) & 1) << 5); R = (st >> 1) * 16 + swz / 64; C = (st & 1) * 32 + (swz % 64) / 2; }
__host__ __device__ __forceinline__ int perm32(int rho) { const int n = rho >> 4, i = rho & 15; return 8 * (i >> 2) + 4 * n + (i & 3); }

struct Unit { int pm, pn; };
struct Gemm { const bf16_t* A; const bf16_t* Bt; int M, N, K; };

struct StaticOrder {
    int nM, nN, nwg, G, c, lim, pm_off;
    __host__ __device__ void init(int M, int N, int G_, int c_) { nM = M / BM; nN = N / BM; nwg = nM * nN; G = G_; c = c_; lim = nwg; pm_off = 0; }
    __host__ __device__ bool next(int i, Unit& u) const { const long L = (long)i * G + c; if (L >= lim) return false; unit_of((int)L, u); return true; }
    __host__ __device__ void unit_of(int L, Unit& u) const {
        int wgid = L; { const int q = nwg / NXCD, r = nwg % NXCD, xcd = wgid % NXCD, off = wgid / NXCD; wgid = (xcd < r ? xcd * (q + 1) : r * (q + 1) + (xcd - r) * q) + off; }
        const int nig = WGM * nN, gid = wgid / nig, fm = gid * WGM, gsz = (nM - fm) < WGM ? (nM - fm) : WGM;
        u.pm = pm_off + fm + ((wgid % nig) % gsz); u.pn = (wgid % nig) / gsz;
    }
    __device__ __forceinline__ void a_ready(const Unit&) const {}
    __device__ __forceinline__ void done(const Unit&) const {}
};
struct TailClaimOrder : StaticOrder {
    int nfull, cls, nleft; unsigned* cnt; volatile PG8_LAS unsigned* slot;
    __device__ __forceinline__ void init_tail(unsigned* counters  , volatile PG8_LAS unsigned* slot_) {
        nfull = (nwg / G) * G; cls = MK_DYNGLOBAL ? 0 : (c & 7); nleft = MK_DYNGLOBAL ? (nwg - nfull) : (nwg - nfull + 7 - cls) / 8; cnt = counters + cls * 64; slot = slot_; }
    __device__ __forceinline__ bool next(int i, Unit& u) const {
        const int L = i * G + c;
        if (L < nfull) { unit_of(L, u); return true; }
        if (i * G != nfull) return false;
        if (threadIdx.x == 0) { const unsigned k = __hip_atomic_fetch_add((__attribute__((address_space(1))) unsigned*)cnt, 1u, __ATOMIC_RELAXED, __HIP_MEMORY_SCOPE_AGENT); *slot = k; }
        asm volatile("s_waitcnt lgkmcnt(0)" ::: "memory"); __builtin_amdgcn_s_barrier(); asm volatile("" ::: "memory");
        const int k = __builtin_amdgcn_readfirstlane((int)*slot);
        if (k >= nleft) return false;
        unit_of(MK_DYNGLOBAL ? (nfull + k) : (nfull + 8 * k + cls), u); return true;
    }
};
struct OneUnit { Unit u;
    __device__ __forceinline__ bool next(int i, Unit& v) const { if (i != 0) return false; v = u; return true; }
    __device__ __forceinline__ void a_ready(const Unit&) const {}
    __device__ __forceinline__ void done(const Unit&) const {}
};
__device__ __forceinline__ unsigned cvt_pk_bf16(float lo, float hi) { unsigned r; asm volatile("v_cvt_pk_bf16_f32 %0, %1, %2" : "=v"(r) : "v"(lo), "v"(hi)); return r; }
typedef float f32x2 __attribute__((ext_vector_type(2)));
__device__ __forceinline__ f32x2 gelu_pk(f32x2 v) {
    const f32x2 av = __builtin_elementwise_abs(v), d = av * 0.2316418882f + 1.0f;
    f32x2 t; t.x = __builtin_amdgcn_rcpf(d.x); t.y = __builtin_amdgcn_rcpf(d.y);
    f32x2 q = t * 0.5307027145f + (-0.7265760135f); q = q * t + 0.7107068705f; q = q * t + (-0.142248368f); q = q * t + 0.127414796f; q = q * t;
    const f32x2 s = (v * v) * (-0.72134752044f);
    f32x2 e; e.x = __builtin_amdgcn_exp2f(s.x); e.y = __builtin_amdgcn_exp2f(s.y);
    const f32x2 m = v * (q * e), r = v - m;
    f32x2 o; o.x = v.x < 0.f ? m.x : r.x; o.y = v.y < 0.f ? m.y : r.y; return o;
}

#ifndef MK_NTST
#define MK_NTST 0
#endif
#if MK_NTST
#define EPI_ST16(p, v) __builtin_nontemporal_store((v), (u32x4*)(p))
#else
#define EPI_ST16(p, v) (*(u32x4*)(p) = (v))
#endif
struct RowAffine {
    const unsigned long long* rss; const float* biasb;
    int bpitch; PG8_LAS float* T;
    template <bool UPGATE> __device__ __forceinline__ void stage(const Unit& u, int p, int wid, int lane) const {
        if (wid == 0 || wid == 2) __builtin_amdgcn_global_load_lds((const unsigned*)(rss + (size_t)u.pm * BM + wid * 64 + lane * 2), (PG8_LAS unsigned*)(T + p * 768 + wid * 128), 16, 0, 0);
        if (wid == 1) { const int b = (u.pm * BM) >> 12;
            const int col = UPGATE ? ((lane < 32) ? (u.pn * 128 + lane * 4) : (5504 + u.pn * 128 + (lane - 32) * 4)) : (u.pn * BM + lane * 4);
            __builtin_amdgcn_global_load_lds((const unsigned*)(biasb + (size_t)b * bpitch + col), (PG8_LAS unsigned*)(T + p * 768 + 512), 16, 0, 0); }
    }
    template <bool PR = false> __device__ __forceinline__ void apply(f32x4 (&acc)[2][2][4][2], int p, int wr, int wc, int fr, int fq) const {
        const PG8_LAS unsigned long long* Tr = (const PG8_LAS unsigned long long*)(T + p * 768) + wr * 64 + (PR ? 4 * fr : fr); const PG8_LAS float* Tb = T + p * 768 + 512 + wc * 32 + 8 * fq;
        float rs[2][4];
#pragma unroll
        for (int ai = 0; ai < 2; ++ai)
#pragma unroll
            for (int m = 0; m < 4; ++m) rs[ai][m] = __builtin_amdgcn_rsqf((float)Tr[ai * HALF + (PR ? m : m * 16)] * (1.0f / (1048576.0f * 2048.0f)) + 1e-6f);
#pragma unroll
        for (int bj = 0; bj < 2; ++bj)
#pragma unroll
            for (int n = 0; n < 2; ++n) { const f32x4 bv = *(const PG8_LAS f32x4*)(Tb + bj * HALF + 4 * n);
#pragma unroll
                for (int ai = 0; ai < 2; ++ai)
#pragma unroll
                    for (int m = 0; m < 4; ++m) acc[ai][bj][m][n] = acc[ai][bj][m][n] * rs[ai][m] + bv; }
    }
};
__device__ __forceinline__ float gelu_tanh1(float v) {
    const float u = v * (0.7978845608f + 0.0356774081f * v * v);
    const float e = __builtin_amdgcn_exp2f(u * -2.8853900818f);
    return v * __builtin_amdgcn_rcpf(1.0f + e);
}
__device__ __forceinline__ f32x4 gelu_tanh4(f32x4 v) {
    const f32x4 u = v * (v * v * 0.0356774081f + 0.7978845608f);
    const f32x4 a = u * -2.8853900818f;
    f32x4 e; e.x = __builtin_amdgcn_exp2f(a.x); e.y = __builtin_amdgcn_exp2f(a.y); e.z = __builtin_amdgcn_exp2f(a.z); e.w = __builtin_amdgcn_exp2f(a.w);
    const f32x4 d = e + 1.0f;
    f32x4 r; r.x = __builtin_amdgcn_rcpf(d.x); r.y = __builtin_amdgcn_rcpf(d.y); r.z = __builtin_amdgcn_rcpf(d.z); r.w = __builtin_amdgcn_rcpf(d.w);
    return v * r;
}
template <int ACT  > struct EpiStore {
    static constexpr bool PERM = true, AFTER_DRAIN = false, PERMROW = false;
    bf16_t* O; int ldc; RowAffine ra; unsigned long long* vss; size_t obump;
    __device__ __forceinline__ void stage(const Unit& u, int p, int wid, int lane) const { ra.stage<false>(u, p, wid, lane); }
    __device__ __forceinline__ void operator()(f32x4 (&acc)[2][2][4][2], const Unit& u, int p, int wr, int wc, int fr, int fq) const {
        ra.apply(acc, p, wr, wc, fr, fq);
        const int row0 = u.pm * BM + wr * 64 + fr, col0 = u.pn * BM + wc * 32 + 8 * fq; float ssq[8];
#pragma unroll
        for (int ai = 0; ai < 2; ++ai)
#pragma unroll
            for (int m = 0; m < 4; ++m) { bf16_t* rowp = O + (size_t)((u.pm * BM) >> 12) * obump + (size_t)(row0 + ai * HALF + m * 16) * ldc + col0; float s = 0.f;
#pragma unroll
                for (int bj = 0; bj < 2; ++bj) { f32x4 v0 = acc[ai][bj][m][0], v1 = acc[ai][bj][m][1];
                    if (ACT == 1) { v0 = gelu_tanh4(v0); v1 = gelu_tanh4(v1); }
                    s += (v0[0] * v0[0] + v0[1] * v0[1]) + (v0[2] * v0[2] + v0[3] * v0[3]) + (v1[0] * v1[0] + v1[1] * v1[1]) + (v1[2] * v1[2] + v1[3] * v1[3]);
                    u32x4 w; w.x = cvt_pk_bf16(v0[0], v0[1]); w.y = cvt_pk_bf16(v0[2], v0[3]); w.z = cvt_pk_bf16(v1[0], v1[1]); w.w = cvt_pk_bf16(v1[2], v1[3]);
                    EPI_ST16(rowp + bj * HALF, w); }
                ssq[ai * 4 + m] = s; }
        if (vss && u.pn >= 8) {
#pragma unroll
            for (int k = 0; k < 8; ++k) ssq[k] += __shfl_xor(ssq[k], 16);
#pragma unroll
            for (int k = 0; k < 8; ++k) ssq[k] += __shfl_xor(ssq[k], 32);
            if (fq == 0) {
#pragma unroll
                for (int k = 0; k < 8; ++k) __hip_atomic_fetch_add(vss + row0 + (k >> 2) * HALF + (k & 3) * 16, (unsigned long long)(ssq[k] * 1048576.0f), __ATOMIC_RELAXED, __HIP_MEMORY_SCOPE_AGENT); } }
    }
};
struct EpiQKV {
    static constexpr bool PERM = true, AFTER_DRAIN = false, PERMROW = false;
    bf16_t* QKV; size_t tstride, bstride; float qscale; RowAffine ra;
    __device__ __forceinline__ void stage(const Unit& u, int p, int wid, int lane) const { ra.stage<false>(u, p, wid, lane); }
    __device__ __forceinline__ void operator()(f32x4 (&acc)[2][2][4][2], const Unit& u, int p, int wr, int wc, int fr, int fq) const {
        ra.apply(acc, p, wr, wc, fr, fq);
        const int tok0 = u.pm * BM, b = tok0 >> 12, s0 = (tok0 & 4095) + wr * 64 + fr;
        const int colt = u.pn * BM, t = colt >> 11, hd0 = (colt & 2047) >> 7;
        bf16_t* base = QKV + (size_t)b * bstride + (size_t)t * tstride; const float sc = t == 0 ? qscale : 1.0f;
#pragma unroll
        for (int bj = 0; bj < 2; ++bj) { bf16_t* hb = base + ((size_t)(hd0 + bj) * 4096 + s0) * 128 + wc * 32 + 8 * fq;
#pragma unroll
            for (int ai = 0; ai < 2; ++ai)
#pragma unroll
                for (int m = 0; m < 4; ++m) { const f32x4 v0 = acc[ai][bj][m][0] * sc, v1 = acc[ai][bj][m][1] * sc;
                    u32x4 w; w.x = cvt_pk_bf16(v0[0], v0[1]); w.y = cvt_pk_bf16(v0[2], v0[3]); w.z = cvt_pk_bf16(v1[0], v1[1]); w.w = cvt_pk_bf16(v1[2], v1[3]);
                    EPI_ST16(hb + (size_t)(ai * HALF + m * 16) * 128, w); } }
    }
};
struct EpiRes {
    static constexpr bool PERM = true, AFTER_DRAIN = false, PERMROW = false;
    bf16_t* xb; const float* gate; int gpitch; bf16_t* xg; const float* gn; const float* scn; unsigned long long* rss; PG8_LAS float* T; float* xf;
    __device__ __forceinline__ void stage(const Unit& u, int p, int wid, int lane) const { const int b = (u.pm * BM) >> 12, c = u.pn * BM + lane * 4;
        if (wid == 0) __builtin_amdgcn_global_load_lds((const unsigned*)(gate + (size_t)b * gpitch + c), (PG8_LAS unsigned*)(T + p * 768), 16, 0, 0);
        if (wid == 1 && xg) __builtin_amdgcn_global_load_lds((const unsigned*)(gn + c), (PG8_LAS unsigned*)(T + p * 768 + 256), 16, 0, 0);
        if (wid == 2 && xg) __builtin_amdgcn_global_load_lds((const unsigned*)(scn + (size_t)b * gpitch + c), (PG8_LAS unsigned*)(T + p * 768 + 512), 16, 0, 0); }
    __device__ __forceinline__ void operator()(const f32x4 (&acc)[2][2][4][2], const Unit& u, int p, int wr, int wc, int fr, int fq) const {
        const int row0 = u.pm * BM + wr * 64 + fr, col0 = u.pn * BM + wc * 32 + 8 * fq; const PG8_LAS float* Tc = T + p * 768 + wc * 32 + 8 * fq;
        u32x4 xbuf[4][2];
#define ER_LOAD(k) do { const size_t off_ = (size_t)(row0 + ((k) >> 2) * HALF + ((k) & 3) * 16) * 2048 + col0; _Pragma("unroll") for (int bj = 0; bj < 2; ++bj) xbuf[(k) % 4][bj] = *(const u32x4*)(xb + off_ + bj * HALF); } while (0)
        ER_LOAD(0); ER_LOAD(1); ER_LOAD(2); ER_LOAD(3);
        f32x4 gv[2][2], gs[2][2];
#pragma unroll
        for (int bj = 0; bj < 2; ++bj)
#pragma unroll
            for (int n = 0; n < 2; ++n) { gv[bj][n] = *(const PG8_LAS f32x4*)(Tc + bj * HALF + n * 4);
                gs[bj][n] = xg ? *(const PG8_LAS f32x4*)(Tc + 256 + bj * HALF + n * 4) * (*(const PG8_LAS f32x4*)(Tc + 512 + bj * HALF + n * 4) + 1.0f) : (f32x4){0.f, 0.f, 0.f, 0.f}; }
        float ss[8];
#pragma unroll
        for (int k = 0; k < 8; ++k) { const int ai = k >> 2, m = k & 3, row = row0 + ai * HALF + m * 16; const size_t off = (size_t)row * 2048 + col0; float s = 0.f;
            __builtin_amdgcn_sched_barrier(0);
#pragma unroll
            for (int bj = 0; bj < 2; ++bj) { const u32x4 xw = xbuf[k % 4][bj];
                const f32x4 x0 = (f32x4){__builtin_bit_cast(float, xw.x << 16), __builtin_bit_cast(float, xw.x & 0xffff0000u), __builtin_bit_cast(float, xw.y << 16), __builtin_bit_cast(float, xw.y & 0xffff0000u)};
                const f32x4 x1 = (f32x4){__builtin_bit_cast(float, xw.z << 16), __builtin_bit_cast(float, xw.z & 0xffff0000u), __builtin_bit_cast(float, xw.w << 16), __builtin_bit_cast(float, xw.w & 0xffff0000u)};
                const f32x4 o0 = x0 + gv[bj][0] * acc[ai][bj][m][0], o1 = x1 + gv[bj][1] * acc[ai][bj][m][1];
                u32x4 w; w.x = cvt_pk_bf16(o0[0], o0[1]); w.y = cvt_pk_bf16(o0[2], o0[3]); w.z = cvt_pk_bf16(o1[0], o1[1]); w.w = cvt_pk_bf16(o1[2], o1[3]);
                if (xf) { *(f32x4*)(xf + off + bj * HALF) = o0; *(f32x4*)(xf + off + bj * HALF + 4) = o1; } else EPI_ST16(xb + off + bj * HALF, w);
                if (xg) { const f32x4 y0 = o0 * gs[bj][0], y1 = o1 * gs[bj][1]; u32x4 g; g.x = cvt_pk_bf16(y0[0], y0[1]); g.y = cvt_pk_bf16(y0[2], y0[3]); g.z = cvt_pk_bf16(y1[0], y1[1]); g.w = cvt_pk_bf16(y1[2], y1[3]);
                    EPI_ST16(xg + off + bj * HALF, g);
                    s += (o0[0] * o0[0] + o0[1] * o0[1]) + (o0[2] * o0[2] + o0[3] * o0[3]) + (o1[0] * o1[0] + o1[1] * o1[1]) + (o1[2] * o1[2] + o1[3] * o1[3]); } }
            ss[k] = s;
            __builtin_amdgcn_sched_barrier(0);
            if (k + 4 < 8) ER_LOAD(k + 4); }
#undef ER_LOAD
        if (xg) {
#pragma unroll
            for (int k = 0; k < 8; ++k) ss[k] += __shfl_xor(ss[k], 16);
#pragma unroll
            for (int k = 0; k < 8; ++k) ss[k] += __shfl_xor(ss[k], 32);
            if (fq == 0) {
#pragma unroll
                for (int k = 0; k < 8; ++k) __hip_atomic_fetch_add(rss + row0 + (k >> 2) * HALF + (k & 3) * 16, (unsigned long long)(ss[k] * 1048576.0f), __ATOMIC_RELAXED, __HIP_MEMORY_SCOPE_AGENT); } }
    }
};
struct EpiResF : EpiRes {
    float* outp; const float* gfin; unsigned long long* rssf; unsigned* pcnt;
    __device__ __forceinline__ void stage(const Unit& u, int p, int wid, int lane) const { const int b = (u.pm * BM) >> 12, c = u.pn * BM + lane * 4;
        if (wid == 0) __builtin_amdgcn_global_load_lds((const unsigned*)(gate + (size_t)b * gpitch + c), (PG8_LAS unsigned*)(T + p * 768), 16, 0, 0);
        if (wid == 1 && (xg || outp)) __builtin_amdgcn_global_load_lds((const unsigned*)((outp ? gfin : gn) + c), (PG8_LAS unsigned*)(T + p * 768 + 256), 16, 0, 0);
        if (wid == 2 && xg) __builtin_amdgcn_global_load_lds((const unsigned*)(scn + (size_t)b * gpitch + c), (PG8_LAS unsigned*)(T + p * 768 + 512), 16, 0, 0); }
    __device__ __forceinline__ void operator()(f32x4 (&acc)[2][2][4][2], const Unit& u, int p, int wr, int wc, int fr, int fq) const {
        if (!outp) { EpiRes::operator()(acc, u, p, wr, wc, fr, fq); return; }
        asm volatile("; final-norm epilogue" ::: "memory");
        const int row0 = u.pm * BM + wr * 64 + fr, col0 = u.pn * BM + wc * 32 + 8 * fq; const PG8_LAS float* Tc = T + p * 768 + wc * 32 + 8 * fq;
        u32x4 xbuf[4][2];
#define ER_LOAD(k) do { const size_t off_ = (size_t)(row0 + ((k) >> 2) * HALF + ((k) & 3) * 16) * 2048 + col0; _Pragma("unroll") for (int bj = 0; bj < 2; ++bj) xbuf[(k) % 4][bj] = *(const u32x4*)(xb + off_ + bj * HALF); } while (0)
#define ER_X(xw, g0, g1, a0, a1, o0, o1) const f32x4 o0 = (f32x4){__builtin_bit_cast(float, xw.x << 16), __builtin_bit_cast(float, xw.x & 0xffff0000u), __builtin_bit_cast(float, xw.y << 16), __builtin_bit_cast(float, xw.y & 0xffff0000u)} + g0 * a0, \
                                                            o1 = (f32x4){__builtin_bit_cast(float, xw.z << 16), __builtin_bit_cast(float, xw.z & 0xffff0000u), __builtin_bit_cast(float, xw.w << 16), __builtin_bit_cast(float, xw.w & 0xffff0000u)} + g1 * a1
        ER_LOAD(0); ER_LOAD(1); ER_LOAD(2); ER_LOAD(3);
        f32x4 gv[2][2];
#pragma unroll
        for (int bj = 0; bj < 2; ++bj)
#pragma unroll
            for (int n = 0; n < 2; ++n) gv[bj][n] = *(const PG8_LAS f32x4*)(Tc + bj * HALF + n * 4);
        float ss[8];
#pragma unroll
        for (int k = 0; k < 8; ++k) { const int ai = k >> 2, m = k & 3; float s = 0.f;
            __builtin_amdgcn_sched_barrier(0);
#pragma unroll
            for (int bj = 0; bj < 2; ++bj) { const u32x4 xw = xbuf[k % 4][bj]; ER_X(xw, gv[bj][0], gv[bj][1], acc[ai][bj][m][0], acc[ai][bj][m][1], o0, o1);
                s += (o0[0] * o0[0] + o0[1] * o0[1]) + (o0[2] * o0[2] + o0[3] * o0[3]) + (o1[0] * o1[0] + o1[1] * o1[1]) + (o1[2] * o1[2] + o1[3] * o1[3]); }
            ss[k] = s;
            __builtin_amdgcn_sched_barrier(0);
            ER_LOAD((k + 4) & 7); }
#pragma unroll
        for (int k = 0; k < 8; ++k) ss[k] += __shfl_xor(ss[k], 16);
#pragma unroll
        for (int k = 0; k < 8; ++k) ss[k] += __shfl_xor(ss[k], 32);
        unsigned long long old = 0;
        if (fq == 0) {
#pragma unroll
            for (int k = 0; k < 8; ++k) old |= __hip_atomic_fetch_add(rssf + row0 + (k >> 2) * HALF + (k & 3) * 16, (unsigned long long)(ss[k] * 1048576.0f), __ATOMIC_RELAXED, __HIP_MEMORY_SCOPE_AGENT); }
        asm volatile("" :: "v"((unsigned)old), "v"((unsigned)(old >> 32)) : "memory");
        unsigned* cnt = pcnt + u.pm * 16;
        if ((threadIdx.x & 63) == 0) { __hip_atomic_fetch_add(cnt, 1u, __ATOMIC_RELAXED, __HIP_MEMORY_SCOPE_AGENT);
            unsigned tries = 0; while (__hip_atomic_load(cnt, __ATOMIC_RELAXED, __HIP_MEMORY_SCOPE_AGENT) < 64u && ++tries < (1u << 21)) __builtin_amdgcn_s_sleep(4); }
        asm volatile("" : "+v"(gv[0][0]), "+v"(gv[0][1]), "+v"(gv[1][0]), "+v"(gv[1][1]) :: "memory");
        float rs[8];
#pragma unroll
        for (int k = 0; k < 8; ++k) rs[k] = __builtin_amdgcn_rsqf((float)__hip_atomic_load(rssf + row0 + (k >> 2) * HALF + (k & 3) * 16, __ATOMIC_RELAXED, __HIP_MEMORY_SCOPE_AGENT) * (1.0f / (1048576.0f * 2048.0f)) + 1e-6f);
        int row0b = row0; asm volatile("" : "+v"(row0b));
        f32x4 gf[2][2];
#pragma unroll
        for (int bj = 0; bj < 2; ++bj)
#pragma unroll
            for (int n = 0; n < 2; ++n) gf[bj][n] = *(const PG8_LAS f32x4*)(Tc + 256 + bj * HALF + n * 4);
#pragma unroll
        for (int k = 0; k < 8; ++k) { const int ai = k >> 2, m = k & 3; const size_t off = (size_t)(row0b + ai * HALF + m * 16) * 2048 + col0;
            __builtin_amdgcn_sched_barrier(0);
#pragma unroll
            for (int bj = 0; bj < 2; ++bj) { const u32x4 xw = xbuf[k % 4][bj]; ER_X(xw, gv[bj][0], gv[bj][1], acc[ai][bj][m][0], acc[ai][bj][m][1], o0, o1);
                *(f32x4*)(outp + off + bj * HALF) = o0 * (gf[bj][0] * rs[k]); *(f32x4*)(outp + off + bj * HALF + 4) = o1 * (gf[bj][1] * rs[k]); }
            __builtin_amdgcn_sched_barrier(0);
            if (k + 4 < 8) ER_LOAD(k + 4); }
#undef ER_X
#undef ER_LOAD
    }
};
__device__ __forceinline__ int f2i(float v) { return __builtin_bit_cast(int, v); }
__device__ __forceinline__ float i2f(int v) { return __builtin_bit_cast(float, v); }
template <int SH> __device__ __forceinline__ float dpp_ror(float v) { return i2f(__builtin_amdgcn_update_dpp(0, f2i(v), 0x120 + SH, 0xf, 0xf, true)); }
template <int SH> __device__ __forceinline__ float dpp_shr_fill(float fill, float cur) { return i2f(__builtin_amdgcn_update_dpp(f2i(fill), f2i(cur), 0x110 + SH, 0xf, 0xf, false)); }
struct EpiConv {
    static constexpr bool PERM = true, AFTER_DRAIN = false, PERMROW = true;
    bf16_t* ACT; const float* cw; const float* cb; float* HALO; PG8_LAS float* X; RowAffine ra; PG8_LAS float* TW;
    __device__ __forceinline__ void stage(const Unit& u, int p, int wid, int lane) const { ra.stage<true>(u, p, wid, lane);
        if (wid >= 3 && wid <= 6) { const int k = wid - 3, col = (lane < 32) ? (u.pn * 128 + lane * 4) : (5504 + u.pn * 128 + (lane - 32) * 4);
            __builtin_amdgcn_global_load_lds((const unsigned*)((k < 3 ? cw + (size_t)k * 11008 : cb) + col), (PG8_LAS unsigned*)(TW + p * 1024 + k * 256), 16, 0, 0); } }
    __device__ __forceinline__ void operator()(f32x4 (&acc)[2][2][4][2], const Unit& u, int p, int wr, int wc, int fr, int fq) const {
        const int tcol = wc * 32 + 8 * fq, ch0 = u.pn * 128 + tcol;
        ra.apply<true>(acc, p, wr, wc, fr, fq);
#if defined(MK_KREP) && MK_KREP > 1
#pragma unroll
        for (int ai = 0; ai < 2; ++ai)
#pragma unroll
            for (int bj = 0; bj < 2; ++bj)
#pragma unroll
                for (int m = 0; m < 4; ++m)
#pragma unroll
                    for (int n = 0; n < 2; ++n) acc[ai][bj][m][n] *= (1.0f / MK_KREP);
#endif
        if (fr == 15) {
#pragma unroll
            for (int ai = 0; ai < 2; ++ai)
#pragma unroll
                for (int mm = 0; mm < 2; ++mm)
#pragma unroll
                    for (int bj = 0; bj < 2; ++bj)
#pragma unroll
                        for (int n = 0; n < 2; ++n) *(PG8_LAS f32x4*)(X + (((ai * 2 + wr) * 2 + mm) * 256) + bj * 128 + tcol + 4 * n) = acc[ai][bj][2 + mm][n];
            if (wr == 1) {
#pragma unroll
                for (int mm = 0; mm < 2; ++mm)
#pragma unroll
                    for (int bj = 0; bj < 2; ++bj)
#pragma unroll
                        for (int n = 0; n < 2; ++n) *(f32x4*)(HALO + ((size_t)u.pm * 4 + 2 + mm) * 11008 + bj * 5504 + ch0 + 4 * n) = acc[1][bj][2 + mm][n]; }
        }
        if (fr == 0 && wr == 0) {
#pragma unroll
            for (int mm = 0; mm < 2; ++mm)
#pragma unroll
                for (int bj = 0; bj < 2; ++bj)
#pragma unroll
                    for (int n = 0; n < 2; ++n) *(f32x4*)(HALO + ((size_t)u.pm * 4 + mm) * 11008 + bj * 5504 + ch0 + 4 * n) = acc[0][bj][mm][n]; }
        asm volatile("s_waitcnt lgkmcnt(0)" ::: "memory"); __builtin_amdgcn_s_barrier(); asm volatile("" ::: "memory");
        const PG8_LAS float* Tw = TW + p * 1024 + tcol;
        const int row0 = u.pm * BM + wr * 64 + 4 * fr;
#pragma unroll
        for (int ai = 0; ai < 2; ++ai) { const int g = ai * 2 + wr;
#pragma unroll
            for (int bj = 0; bj < 2; ++bj)
#pragma unroll
                for (int n = 0; n < 2; ++n) {
                    const f32x4 w0 = *(const PG8_LAS f32x4*)(Tw + bj * 128 + 4 * n), w1 = *(const PG8_LAS f32x4*)(Tw + 256 + bj * 128 + 4 * n), w2 = *(const PG8_LAS f32x4*)(Tw + 512 + bj * 128 + 4 * n), bb = *(const PG8_LAS f32x4*)(Tw + 768 + bj * 128 + 4 * n);
                    f32x4 h62 = (f32x4){0.f, 0.f, 0.f, 0.f}, h63 = h62;
                    if (g > 0) { h62 = *(const PG8_LAS f32x4*)(X + (((g - 1) * 2 + 0) * 256) + bj * 128 + tcol + 4 * n); h63 = *(const PG8_LAS f32x4*)(X + (((g - 1) * 2 + 1) * 256) + bj * 128 + tcol + 4 * n); }
                    const f32x4 x0 = acc[ai][bj][0][n], x1 = acc[ai][bj][1][n], x2 = acc[ai][bj][2][n], x3 = acc[ai][bj][3][n];
                    f32x4 s2, s3;
#pragma unroll
                    for (int e = 0; e < 4; ++e) { s3[e] = dpp_shr_fill<1>(h63[e], x3[e]); s2[e] = dpp_shr_fill<1>(h62[e], x2[e]); }
                    f32x4 r0 = bb + w2 * x0 + w1 * s3 + w0 * s2, r1 = bb + w2 * x1 + w1 * x0 + w0 * s3, r2 = bb + w2 * x2 + w1 * x1 + w0 * x0, r3 = bb + w2 * x3 + w1 * x2 + w0 * x1;
                    asm volatile("" : "+v"(r0), "+v"(r1), "+v"(r2), "+v"(r3));
                    acc[ai][bj][0][n] = r0; acc[ai][bj][1][n] = r1; acc[ai][bj][2][n] = r2; acc[ai][bj][3][n] = r3;
                    __builtin_amdgcn_sched_barrier(0); }
#pragma unroll
            for (int m = 0; m < 4; ++m) { f32x4 o[2];
#pragma unroll
                for (int n = 0; n < 2; ++n) { const f32x4 gt = acc[ai][0][m][n], a = gt * -1.4426950408889634f, gu = gt * acc[ai][1][m][n];
                    f32x4 ex; ex.x = __builtin_amdgcn_exp2f(a.x); ex.y = __builtin_amdgcn_exp2f(a.y); ex.z = __builtin_amdgcn_exp2f(a.z); ex.w = __builtin_amdgcn_exp2f(a.w);
                    const f32x4 d = ex + 1.0f; f32x4 r; r.x = __builtin_amdgcn_rcpf(d.x); r.y = __builtin_amdgcn_rcpf(d.y); r.z = __builtin_amdgcn_rcpf(d.z); r.w = __builtin_amdgcn_rcpf(d.w);
                    o[n] = gu * r; }
                u32x4 w; w.x = cvt_pk_bf16(o[0][0], o[0][1]); w.y = cvt_pk_bf16(o[0][2], o[0][3]); w.z = cvt_pk_bf16(o[1][0], o[1][1]); w.w = cvt_pk_bf16(o[1][2], o[1][3]);
                EPI_ST16(ACT + (size_t)(row0 + ai * HALF + m) * 5504 + ch0, w); }
            __builtin_amdgcn_sched_barrier(0); }
    }
};
template <class Epi, class Sched, bool ALIGN_EPI = false, bool SP2 = false, int KREP = 1, int TP = 0>
__device__ __forceinline__ void gemm_phase(PG8_LAS unsigned char* lds, const Gemm g, const Sched& S, const Epi& E, unsigned long long* tp_out = nullptr) {
    unsigned long long tp_acc = 0, tp3 = 0;
    const int tid = ltid(), wid = __builtin_amdgcn_readfirstlane(tid >> 6), lane = tid & 63, wr = wid >> 2, wc = wid & 3, fr = lane & 15, fq = lane >> 4;
    const int K = g.K, nt = K / BK;
    unsigned voffA[2], voffB[2];
#pragma unroll
    for (int i = 0; i < 2; ++i) { int R, C; stage_rc(tid * 16 + i * 8192, R, C); const int Rb = Epi::PERM ? ((R & ~31) + perm32(R & 31)) : R;
        const int Ra = Epi::PERMROW ? ((R & ~63) + 4 * (R & 15) + ((R >> 4) & 3)) : R;
        voffA[i] = (unsigned)(Ra * K + C) * 2u; voffB[i] = (unsigned)(Rb * K + C) * 2u; }
    const size_t kstep = (size_t)(BK * 2);
    const size_t hstep = (size_t)HALF * K * 2;
    const size_t tstep = 2 * hstep;
    const unsigned ldsw = (unsigned)wid * 1024u;
    const int aoff = lds_byte(wr * 64 + fr, fq * 8), boff = lds_byte(wc * 32 + fr, fq * 8);
#define PG8_SA(b, h) (((b) * 2 + (h)) * HTB)
#define PG8_SB(b, h) ((4 + (b) * 2 + (h)) * HTB)
#define PG8_STAGE(bufoff, gbase, voff) do { _Pragma("unroll") for (int _i = 0; _i < 2; ++_i) \
        __builtin_amdgcn_global_load_lds((const unsigned*)((const char*)(gbase) + (voff)[_i]), (PG8_LAS unsigned*)(lds + (bufoff) + ldsw + _i * 8192), 16, 0, 0); } while (0)
#define PG8_LDA(dst, b, h) do { _Pragma("unroll") for (int m = 0; m < 4; ++m) _Pragma("unroll") for (int k = 0; k < 2; ++k) dst[m][k] = *(const PG8_LAS bf16x8*)(lds + PG8_SA(b, h) + aoff + m * 2048 + k * 1024); } while (0)
#define PG8_LDB(dst, b, h) do { _Pragma("unroll") for (int n = 0; n < 2; ++n) _Pragma("unroll") for (int k = 0; k < 2; ++k) dst[n][k] = *(const PG8_LAS bf16x8*)(lds + PG8_SB(b, h) + boff + n * 2048 + k * 1024); } while (0)
#define PG8_MMA(ai, bj, At, Bt) do { if (MK_SETPRIO) __builtin_amdgcn_s_setprio(MK_SETPRIO); _Pragma("unroll") for (int m = 0; m < 4; ++m) _Pragma("unroll") for (int n = 0; n < 2; ++n) _Pragma("unroll") for (int k = 0; k < 2; ++k) \
        acc[ai][bj][m][n] = __builtin_amdgcn_mfma_f32_16x16x32_bf16(Bt[n][k], At[m][k], acc[ai][bj][m][n], 0, 0, 0); if (MK_SETPRIO) __builtin_amdgcn_s_setprio(0); } while (0)
#define PG8_WAIT_V(n) asm volatile("s_waitcnt vmcnt(" #n ")" ::: "memory")
#define PG8_WAIT_L(n) asm volatile("s_waitcnt lgkmcnt(" #n ")" ::: "memory")
#define PG8_WAIT_V_SEL(sel) asm volatile("s_cmp_eq_u32 %0, 0\n\ts_cbranch_scc1 .Lw8_%=\n\ts_waitcnt vmcnt(22)\n\ts_branch .Lwd_%=\n.Lw8_%=:\n\ts_waitcnt vmcnt(8)\n.Lwd_%=:" :: "s"(sel) : "memory", "scc")
#define PG8_BAR __builtin_amdgcn_s_barrier()
#define PG8_SCHED __builtin_amdgcn_sched_barrier(0)
    Unit cur, nxt; int ui = 0;
    if (!S.next(0, cur)) return;
    E.stage(cur, 0, wid, lane);
    f32x4 acc[2][2][4][2];
#pragma unroll
    for (int a = 0; a < 2; ++a)
#pragma unroll
        for (int b = 0; b < 2; ++b)
#pragma unroll
            for (int m = 0; m < 4; ++m)
#pragma unroll
                for (int n = 0; n < 2; ++n) acc[a][b][m][n] = (f32x4){0.f, 0.f, 0.f, 0.f};
    bf16x8 At[4][2], B0[2][2], B1[2][2];
    const char* cA = (const char*)g.A + (size_t)cur.pm * tstep; const char* cB = (const char*)g.Bt + (size_t)cur.pn * tstep;
    S.a_ready(cur);
    if constexpr (SP2) {
        PG8_STAGE(PG8_SB(0, 0), cB, voffB); PG8_STAGE(PG8_SB(0, 1), cB + hstep, voffB); PG8_STAGE(PG8_SA(0, 0), cA, voffA); PG8_STAGE(PG8_SA(0, 1), cA + hstep, voffA);
        if (wr == 1) PG8_BAR;
        PG8_WAIT_V(2); PG8_BAR;
        PG8_STAGE(PG8_SB(1, 0), cB + kstep, voffB); PG8_STAGE(PG8_SA(1, 0), cA + kstep, voffA); PG8_STAGE(PG8_SB(1, 1), cB + hstep + kstep, voffB);
        PG8_WAIT_V(6); PG8_BAR;
    } else {
        PG8_STAGE(PG8_SB(0, 0), cB, voffB); PG8_STAGE(PG8_SA(0, 0), cA, voffA); PG8_STAGE(PG8_SB(0, 1), cB + hstep, voffB); PG8_STAGE(PG8_SA(0, 1), cA + hstep, voffA);
        if (wr == 1) PG8_BAR;
        PG8_WAIT_V(4); PG8_BAR;
        PG8_STAGE(PG8_SB(1, 0), cB + kstep, voffB); PG8_STAGE(PG8_SA(1, 0), cA + kstep, voffA); PG8_STAGE(PG8_SB(1, 1), cB + hstep + kstep, voffB);
        PG8_WAIT_V(6); PG8_BAR;
    }
    for (;;) {
        const bool has_next = S.next(ui + 1, nxt);
        if constexpr (TP == 3) { if (ui > 0) tp_acc += __builtin_amdgcn_s_memrealtime() - tp3; }
        const char* nA = has_next ? (const char*)g.A + (size_t)nxt.pm * tstep : cA; const char* nB = has_next ? (const char*)g.Bt + (size_t)nxt.pn * tstep : cB;
        for (int t = 0; t < nt * KREP; t += 2) {
            const bool last = (t == nt * KREP - 2);
            const int t1w = KREP > 1 ? ((t + 1) & (nt - 1)) : t + 1, t2w = KREP > 1 ? ((t + 2) & (nt - 1)) : t + 2;
            const char* a1 = cA + (size_t)t1w * kstep;
            const char* a2 = last ? nA : cA + (size_t)t2w * kstep; const char* b2 = last ? nB : cB + (size_t)t2w * kstep;
            const char* a3 = a2 + kstep; const char* b3 = b2 + kstep;
            if (last && has_next) S.a_ready(nxt);
            const int relax = __builtin_amdgcn_readfirstlane((MK_RELAXW && t == 0 && ui > 0) ? 1 : 0);
            if constexpr (SP2) {
            PG8_LDB(B0, 0, 0); PG8_LDB(B1, 0, 1); PG8_SCHED; PG8_LDA(At, 0, 0); PG8_STAGE(PG8_SA(1, 1), a1 + hstep, voffA);
            PG8_WAIT_V_SEL(relax);
            PG8_WAIT_L(0); PG8_BAR; PG8_MMA(0, 0, At, B0); PG8_MMA(0, 1, At, B1); PG8_BAR; PG8_SCHED;
            PG8_LDA(At, 0, 1); PG8_STAGE(PG8_SB(0, 0), b2, voffB); PG8_STAGE(PG8_SB(0, 1), b2 + hstep, voffB); PG8_STAGE(PG8_SA(0, 0), a2, voffA);
            PG8_WAIT_V_SEL(relax);
            PG8_WAIT_L(0); PG8_BAR; PG8_MMA(1, 0, At, B0); PG8_MMA(1, 1, At, B1); PG8_BAR; PG8_SCHED;
            PG8_LDB(B0, 1, 0); PG8_LDB(B1, 1, 1); PG8_SCHED; PG8_LDA(At, 1, 0); PG8_STAGE(PG8_SA(0, 1), a2 + hstep, voffA);
            PG8_WAIT_V(8); PG8_WAIT_L(0); PG8_BAR; PG8_MMA(0, 0, At, B0); PG8_MMA(0, 1, At, B1); PG8_BAR; PG8_SCHED;
            PG8_LDA(At, 1, 1); PG8_STAGE(PG8_SB(1, 0), b3, voffB); PG8_STAGE(PG8_SB(1, 1), b3 + hstep, voffB); PG8_STAGE(PG8_SA(1, 0), a3, voffA);
            PG8_WAIT_V(8); PG8_WAIT_L(0); PG8_BAR; PG8_MMA(1, 0, At, B0); PG8_MMA(1, 1, At, B1); PG8_BAR; PG8_SCHED;
            } else {
            PG8_LDB(B0, 0, 0); PG8_SCHED; PG8_LDA(At, 0, 0); PG8_STAGE(PG8_SA(1, 1), a1 + hstep, voffA);
            PG8_WAIT_L(8); PG8_BAR; PG8_WAIT_L(0); PG8_MMA(0, 0, At, B0); PG8_BAR; PG8_SCHED;
            PG8_LDB(B1, 0, 1); PG8_STAGE(PG8_SB(0, 0), b2, voffB);
            PG8_BAR; PG8_WAIT_L(0); PG8_MMA(0, 1, At, B1); PG8_BAR;
            PG8_LDA(At, 0, 1); PG8_STAGE(PG8_SA(0, 0), a2, voffA);
            PG8_BAR; PG8_WAIT_L(0); PG8_MMA(1, 0, At, B0); PG8_BAR; PG8_SCHED;
            PG8_STAGE(PG8_SB(0, 1), b2 + hstep, voffB);
            PG8_WAIT_V(6); PG8_BAR; PG8_MMA(1, 1, At, B1); PG8_BAR;
            PG8_LDB(B0, 1, 0); PG8_SCHED; PG8_LDA(At, 1, 0); PG8_STAGE(PG8_SA(0, 1), a2 + hstep, voffA);
            PG8_WAIT_L(8); PG8_BAR; PG8_WAIT_L(0); PG8_MMA(0, 0, At, B0); PG8_BAR; PG8_SCHED;
            PG8_LDB(B1, 1, 1); PG8_STAGE(PG8_SB(1, 0), b3, voffB);
            PG8_BAR; PG8_WAIT_L(0); PG8_MMA(0, 1, At, B1); PG8_BAR;
            PG8_LDA(At, 1, 1); PG8_STAGE(PG8_SA(1, 0), a3, voffA);
            PG8_BAR; PG8_WAIT_L(0); PG8_MMA(1, 0, At, B0); PG8_BAR; PG8_SCHED;
            PG8_STAGE(PG8_SB(1, 1), b3 + hstep, voffB);
            PG8_WAIT_V(6); PG8_BAR; PG8_MMA(1, 1, At, B1); PG8_BAR;
            }
        }
        unsigned long long tp0 = 0; if constexpr (TP == 1) tp0 = __builtin_amdgcn_s_memrealtime();
        if constexpr (ALIGN_EPI) { if (wr == 0) PG8_BAR; }
        if constexpr (TP == 2) tp0 = __builtin_amdgcn_s_memrealtime();
        if constexpr (!Epi::AFTER_DRAIN) { E(acc, cur, ui & 1, wr, wc, fr, fq); S.done(cur); }
        if constexpr (TP == 1 || TP == 2) tp_acc += __builtin_amdgcn_s_memrealtime() - tp0;
        if constexpr (TP == 3) tp3 = __builtin_amdgcn_s_memrealtime();
        if (!has_next) break;
        E.stage(nxt, (ui + 1) & 1, wid, lane);
#pragma unroll
        for (int a = 0; a < 2; ++a)
#pragma unroll
            for (int b = 0; b < 2; ++b)
#pragma unroll
                for (int m = 0; m < 4; ++m)
#pragma unroll
                    for (int n = 0; n < 2; ++n) acc[a][b][m][n] = (f32x4){0.f, 0.f, 0.f, 0.f};
        cur = nxt; cA = nA; cB = nB; ++ui;
        if constexpr (ALIGN_EPI) { if (wr == 1) PG8_BAR; }
    }
    if constexpr (TP != 0) { if (tp_out) *tp_out = tp_acc; }
    PG8_WAIT_V(0);
    if constexpr (!ALIGN_EPI) { if (wr == 0) PG8_BAR; }
    PG8_BAR;
    if constexpr (Epi::AFTER_DRAIN) { E.fused(acc, cur, wr, wc, fr, fq, lds, wid, lane); S.done(cur); }
#undef PG8_SA
#undef PG8_SB
#undef PG8_STAGE
#undef PG8_LDA
#undef PG8_LDB
#undef PG8_MMA
#undef PG8_WAIT_V
#undef PG8_WAIT_L
#undef PG8_WAIT_V_SEL
#undef PG8_BAR
#undef PG8_SCHED
}
}
#ifndef MK_ATTSKIP
#define MK_ATTSKIP 0
#endif
#ifndef MK_PPPROBE
#define MK_PPPROBE 0
#endif
#ifndef MK_YPRIO
#define MK_YPRIO 0
#endif
#ifndef MK_DMALATE
#define MK_DMALATE 0
#endif
#ifndef MK_VWPROBE
#define MK_VWPROBE 0
#endif
#ifndef MK_ATTPRIO
#define MK_ATTPRIO 0
#endif
namespace fox {
enum { ORDER_NATURAL = 0, ORDER_REVERSED = 1, ORDER_PAIRED = 2, ORDER_XCD = 4 };
constexpr int B = 8, H = 16, HKV = 16, SQ = 4096, SKV = 4096, D = 128;
constexpr int QOFF = 0;
constexpr int WINDOW = SKV;
constexpr float THR = 8.f;
constexpr bool WSKIP = false;
constexpr float SCALE = 0.08838834764831845f;
constexpr float QSCALE = SCALE * 1.4426950408889634f;
constexpr int NW = 8, QBLK = 32, KVBLK = 64, QB = NW * QBLK;
constexpr int SHM_V = KVBLK * D * 2, SHM_K = KVBLK * D * 2;
constexpr int NBUF = 3;
constexpr int LDS_FB = NBUF * SHM_V + NBUF * SHM_K;
constexpr int LDS_BYTES = LDS_FB + 2 * SKV * 4;
constexpr int OPITCH = H * D;
constexpr size_t ARENA_E = (size_t)24 << 20;
using bf16 = __hip_bfloat16;
typedef short bf16x8 __attribute__((ext_vector_type(8)));
typedef short s16x4 __attribute__((ext_vector_type(4)));
typedef float f32x16 __attribute__((ext_vector_type(16)));
typedef float f32x4 __attribute__((ext_vector_type(4)));
typedef unsigned u32x4 __attribute__((ext_vector_type(4)));
template <class A, class Bt> struct same_t { static constexpr bool v = false; };
template <class A> struct same_t<A, A> { static constexpr bool v = true; };

#define KSWZ(row, colB) ((row) * 256 + ((colB) ^ (((row) & 7) << 4)))
#define SBAR() __builtin_amdgcn_sched_barrier(0)
__device__ __forceinline__ int v_st(int k, int c) { const int kk = (k & ~0xC) | ((k & 4) << 1) | ((k & 8) >> 1); return ((kk >> 3) * 4 + (c >> 5)) * 512 + ((kk & 7) * 32 + (c & 31)) * 2; }
__device__ __forceinline__ int v_rd_base(int lane) { return ((lane & 3) << 3) | (((lane >> 2) & 3) << 6) | (((lane >> 4) & 1) << 5) | (((lane >> 5) & 1) << 8); }
constexpr int v_rd_off(int d0, int ks, int half) { return d0 * 512 + ks * 4096 + half * 2048; }
__device__ __forceinline__ int crow(int r, int hi) { return (r & 3) + 8 * (r >> 2) + 4 * hi; }
__device__ __forceinline__ unsigned cvtpk(float lo, float hi) {
    unsigned r; asm volatile("v_cvt_pk_bf16_f32 %0, %1, %2" : "=v"(r) : "v"(lo), "v"(hi)); return r;
}
__device__ __forceinline__ bf16x8 pack8(f32x4 a, f32x4 b) {
    u32x4 w = {cvtpk(a[0], a[1]), cvtpk(a[2], a[3]), cvtpk(b[0], b[1]), cvtpk(b[2], b[3])};
    return *reinterpret_cast<bf16x8*>(&w);
}
template <class T> __device__ __forceinline__ bf16x8 load8(const T* p) {
    if constexpr (same_t<T, float>::v) { return pack8(*(const f32x4*)p, *(const f32x4*)(p + 4)); }
    else { return *reinterpret_cast<const bf16x8*>(p); }
}
__device__ __forceinline__ void mask_tile(f32x16& p0, f32x16& p1, int dq, unsigned W) {
    const float NEG = -__builtin_inff();
#pragma unroll
    for (int r = 0; r < 16; ++r) {
        const int c = (r & 3) + 8 * (r >> 2);
        if ((unsigned)(dq - c) >= W) p0[r] = NEG;
        if ((unsigned)(dq - c - 32) >= W) p1[r] = NEG;
    }
}
__device__ __forceinline__ void partialSM(f32x16& p0, f32x16& p1, float& m_reg, float& mn, float& alpha) {
    float pmax = p0[0]; for (int r = 1; r < 16; ++r) pmax = fmaxf(pmax, p0[r]); for (int r = 0; r < 16; ++r) pmax = fmaxf(pmax, p1[r]);
    { auto rr = __builtin_amdgcn_permlane32_swap(__float_as_uint(pmax), __float_as_uint(pmax), false, false);
      pmax = fmaxf(__uint_as_float(rr[0]), __uint_as_float(rr[1])); }
    constexpr float THR2 = THR * 1.4426950408889634f;
    if (__builtin_expect(__all((pmax - m_reg) <= THR2), 1)) { mn = m_reg; alpha = 1.f; }
    else { mn = fmaxf(m_reg, pmax); alpha = __builtin_amdgcn_exp2f(m_reg - mn); m_reg = mn; }
    p0 = p0 - mn; p1 = p1 - mn;
    for (int r = 0; r < 16; ++r) p0[r] = __builtin_amdgcn_exp2f(p0[r]);
}
__device__ __forceinline__ void finishSM(f32x16& p0, f32x16& p1, float alpha, float& l_reg, bf16x8& pa0, bf16x8& pa1, bf16x8& pa2, bf16x8& pa3) {
    for (int r = 0; r < 16; ++r) p1[r] = __builtin_amdgcn_exp2f(p1[r]);
    typedef float f32x8_ __attribute__((ext_vector_type(8))); typedef float f32x2_ __attribute__((ext_vector_type(2)));
    const f32x16 s16 = p0 + p1; const f32x8_ s8 = s16.lo + s16.hi; const f32x4 s4 = s8.lo + s8.hi; const f32x2_ s2 = s4.lo + s4.hi; float ps = s2.x + s2.y;
    { auto rr = __builtin_amdgcn_permlane32_swap(__float_as_uint(ps), __float_as_uint(ps), false, false);
      ps = __uint_as_float(rr[0]) + __uint_as_float(rr[1]); }
    l_reg = l_reg * alpha + ps;
#define PK4(P, B_, OUT) do { unsigned a0 = cvtpk(P[B_+0], P[B_+1]), a1 = cvtpk(P[B_+2], P[B_+3]);                          \
        unsigned b0 = cvtpk(P[B_+4], P[B_+5]), b1 = cvtpk(P[B_+6], P[B_+7]);                                             \
        auto r0 = __builtin_amdgcn_permlane32_swap(a0, b0, false, false); auto r1 = __builtin_amdgcn_permlane32_swap(a1, b1, false, false); \
        u32x4 w = {r0[0], r1[0], r0[1], r1[1]}; OUT = *reinterpret_cast<bf16x8*>(&w); } while (0)
    PK4(p0, 0, pa0); PK4(p0, 8, pa1); PK4(p1, 0, pa2); PK4(p1, 8, pa3);
#undef PK4
}
template <int KB, bool SK>
__device__ __forceinline__ void qkt(f32x16& p0, f32x16& p1, const char* K_lds, int r32, int hi, const bf16x8* qr, bool act, const char* fb) {
    if (SK && !act) { const float NEG = -__builtin_inff();
#pragma unroll
        for (int r = 0; r < 16; ++r) { p0[r] = NEG; p1[r] = NEG; } return; }
#pragma unroll
    for (int q = 0; q < 4; ++q) { const f32x4 b0 = *reinterpret_cast<const f32x4*>(fb + q * 32), b1 = *reinterpret_cast<const f32x4*>(fb + 128 + q * 32);
#pragma unroll
        for (int i = 0; i < 4; ++i) { p0[4 * q + i] = b0[i]; p1[4 * q + i] = b1[i]; } }
    const char* kb[4];
#pragma unroll
    for (int dd = 0; dd < 4; ++dd) kb[dd] = K_lds + KB * SHM_K + KSWZ(r32, (dd * 16 + hi * 8) * 2);
    if (MK_ATTPRIO) __builtin_amdgcn_s_setprio(1);
#pragma unroll
    for (int d0 = 0; d0 < 8; ++d0) { const char* a = kb[d0 & 3] + (d0 >> 2) * 128;
        bf16x8 b0 = *reinterpret_cast<const bf16x8*>(a);
        bf16x8 b1 = *reinterpret_cast<const bf16x8*>(a + 32 * 256);
        p0 = __builtin_amdgcn_mfma_f32_32x32x16_bf16(b0, qr[d0], p0, 0, 0, 0);
        p1 = __builtin_amdgcn_mfma_f32_32x32x16_bf16(b1, qr[d0], p1, 0, 0, 0); }
    if (MK_ATTPRIO) __builtin_amdgcn_s_setprio(0);
}
template <bool SK>
__device__ __forceinline__ void qkt_x(f32x16& p0, f32x16& p1, const char* K_lds, int r32, int hi, const bf16x8* qr, bool act, const char* fb) {
    const int k0a = (int)(uintptr_t)K_lds + KSWZ(r32, (0 * 16 + hi * 8) * 2), k1a = (int)(uintptr_t)K_lds + KSWZ(r32, (1 * 16 + hi * 8) * 2), k2a = (int)(uintptr_t)K_lds + KSWZ(r32, (2 * 16 + hi * 8) * 2), k3a = (int)(uintptr_t)K_lds + KSWZ(r32, (3 * 16 + hi * 8) * 2);
#define KRD(dst, a, off) asm volatile("ds_read_b128 %0, %1 offset:%2" : "=&v"(dst) : "v"(a), "i"(off) : "memory")
#define K_LD(R, A0, A1, off) do { KRD(R##0, A0, off); KRD(R##1, A0, off + 8192); KRD(R##2, A1, off); KRD(R##3, A1, off + 8192); } while (0)
#define K_MM(R, d) do { p0 = __builtin_amdgcn_mfma_f32_32x32x16_bf16(R##0, qr[d + 0], p0, 0, 0, 0); p1 = __builtin_amdgcn_mfma_f32_32x32x16_bf16(R##1, qr[d + 0], p1, 0, 0, 0); \
        p0 = __builtin_amdgcn_mfma_f32_32x32x16_bf16(R##2, qr[d + 1], p0, 0, 0, 0); p1 = __builtin_amdgcn_mfma_f32_32x32x16_bf16(R##3, qr[d + 1], p1, 0, 0, 0); } while (0)
#define K_W(n, R) asm volatile("s_waitcnt lgkmcnt(" #n ")" : "+v"(R##0), "+v"(R##1), "+v"(R##2), "+v"(R##3) :: "memory")
    bf16x8 ka0, ka1, ka2, ka3, kb0, kb1, kb2, kb3;
    K_LD(ka, k0a, k1a, 0); K_LD(kb, k2a, k3a, 0);
#pragma unroll
    for (int q = 0; q < 4; ++q) { const f32x4 b0 = *reinterpret_cast<const f32x4*>(fb + q * 32), b1 = *reinterpret_cast<const f32x4*>(fb + 128 + q * 32);
#pragma unroll
        for (int i = 0; i < 4; ++i) { p0[4 * q + i] = b0[i]; p1[4 * q + i] = b1[i]; } }
    K_W(12, ka);
    K_MM(ka, 0); K_LD(ka, k0a, k1a, 128);
    K_W(4, kb); K_MM(kb, 2); K_LD(kb, k2a, k3a, 128);
    K_W(4, ka); K_MM(ka, 4);
    K_W(0, kb); K_MM(kb, 6);
#undef K_W
#undef K_MM
#undef K_LD
#undef KRD
}
template <int VB, bool SK>
__device__ __forceinline__ void pv_tile(f32x16* o, int vb0, bf16x8 pa0, bf16x8 pa1, bf16x8 pa2, bf16x8 pa3, bool act) {
    if (SK && !act) return;
#define TRRD(dst, off) asm volatile("ds_read_b64_tr_b16 %0, %1 offset:%2" : "=&v"(dst) : "v"(vb0), "i"(off) : "memory")
#define PV_D0(d0) do { s16x4 l0, l1, l2, l3, h0, h1, h2, h3; constexpr int b_ = VB * SHM_V + v_rd_off(d0, 0, 0);     \
        TRRD(l0, b_); TRRD(h0, b_ + 2048); TRRD(l1, b_ + 4096); TRRD(h1, b_ + 6144); TRRD(l2, b_ + 8192); TRRD(h2, b_ + 10240); TRRD(l3, b_ + 12288); TRRD(h3, b_ + 14336); \
        asm volatile("s_waitcnt lgkmcnt(0)" ::: "memory"); SBAR();                 \
        o[d0] = __builtin_amdgcn_mfma_f32_32x32x16_bf16((bf16x8){l0[0], l0[1], l0[2], l0[3], h0[0], h0[1], h0[2], h0[3]}, pa0, o[d0], 0, 0, 0);   \
        o[d0] = __builtin_amdgcn_mfma_f32_32x32x16_bf16((bf16x8){l1[0], l1[1], l1[2], l1[3], h1[0], h1[1], h1[2], h1[3]}, pa1, o[d0], 0, 0, 0);   \
        o[d0] = __builtin_amdgcn_mfma_f32_32x32x16_bf16((bf16x8){l2[0], l2[1], l2[2], l2[3], h2[0], h2[1], h2[2], h2[3]}, pa2, o[d0], 0, 0, 0);   \
        o[d0] = __builtin_amdgcn_mfma_f32_32x32x16_bf16((bf16x8){l3[0], l3[1], l3[2], l3[3], h3[0], h3[1], h3[2], h3[3]}, pa3, o[d0], 0, 0, 0); } while (0)
    if (MK_ATTPRIO) __builtin_amdgcn_s_setprio(1);
    PV_D0(0); PV_D0(1); PV_D0(2); PV_D0(3);
    if (MK_ATTPRIO) __builtin_amdgcn_s_setprio(0);
#undef PV_D0
#undef TRRD
}
template <bool SK>
__device__ __forceinline__ void pv_tile_x(f32x16* o, int vb, bf16x8 pa0, bf16x8 pa1, bf16x8 pa2, bf16x8 pa3, bool act) {
    if (SK && !act) return;
#define TRRD(dst, off) asm volatile("ds_read_b64_tr_b16 %0, %1 offset:%2" : "=&v"(dst) : "v"(vb), "i"(off) : "memory")
#define PV_LD(R, d0) do { constexpr int b_ = v_rd_off(d0, 0, 0); TRRD(R##0, b_); TRRD(R##1, b_ + 2048); TRRD(R##2, b_ + 4096); TRRD(R##3, b_ + 6144); TRRD(R##4, b_ + 8192); TRRD(R##5, b_ + 10240); TRRD(R##6, b_ + 12288); TRRD(R##7, b_ + 14336); } while (0)
#define PV_J(l, h) ((bf16x8){l[0], l[1], l[2], l[3], h[0], h[1], h[2], h[3]})
#define PV_MM(R, d0) do { o[d0] = __builtin_amdgcn_mfma_f32_32x32x16_bf16(PV_J(R##0, R##1), pa0, o[d0], 0, 0, 0); o[d0] = __builtin_amdgcn_mfma_f32_32x32x16_bf16(PV_J(R##2, R##3), pa1, o[d0], 0, 0, 0); \
        o[d0] = __builtin_amdgcn_mfma_f32_32x32x16_bf16(PV_J(R##4, R##5), pa2, o[d0], 0, 0, 0); o[d0] = __builtin_amdgcn_mfma_f32_32x32x16_bf16(PV_J(R##6, R##7), pa3, o[d0], 0, 0, 0); } while (0)
#define PV_W(n, R) asm volatile("s_waitcnt lgkmcnt(" #n ")" : "+v"(R##0), "+v"(R##1), "+v"(R##2), "+v"(R##3), "+v"(R##4), "+v"(R##5), "+v"(R##6), "+v"(R##7) :: "memory")
    s16x4 fa0, fa1, fa2, fa3, fa4, fa5, fa6, fa7, fb0, fb1, fb2, fb3, fb4, fb5, fb6, fb7;
    PV_LD(fa, 0); PV_LD(fb, 1);
    PV_W(8, fa); PV_MM(fa, 0); PV_LD(fa, 2);
    PV_W(8, fb); PV_MM(fb, 1); PV_LD(fb, 3);
    PV_W(8, fa); PV_MM(fa, 2);
    PV_W(0, fb); PV_MM(fb, 3);
#undef PV_W
#undef PV_MM
#undef PV_J
#undef PV_LD
#undef TRRD
}
template <class TIn, class TOut> struct BlockRef { const TIn* Q; const TIn* K; const TIn* V; TOut* O; const float* FB; int P0; };
template <class TIn> struct Seam { bf16x8 qr[8]; int b0, fp; };
#define FOX_LAS __attribute__((address_space(3)))
#define VMW() asm volatile("s_waitcnt vmcnt(0)" ::: "memory")
struct DmaMap { unsigned k0, k1, v0, v1, kl, vl; };
__device__ __forceinline__ DmaMap dma_map(char* lds, int wid, int lane) {
    DmaMap m;
#pragma unroll
    for (int j = 0; j < 2; ++j) {
        const int pk = wid * 2 + j;
        const int r = pk * 4 + (lane >> 4), p = lane & 15, c = p ^ (r & 7);
        const unsigned ko = (unsigned)(r * 256 + c * 16);
        const int s = pk * 2 + (lane >> 5), kk = (s >> 2) * 8 + ((lane & 31) >> 2), cc = (s & 3) * 32 + (lane & 3) * 8;
        const int k = (kk & ~0xC) | ((kk & 4) << 1) | ((kk & 8) >> 1);
        const unsigned vo = (unsigned)(k * 256 + cc * 2);
        if (j == 0) { m.k0 = ko; m.v0 = vo; } else { m.k1 = ko; m.v1 = vo; }
    }
    m.kl = (unsigned)(uintptr_t)(lds + NBUF * SHM_V) + (unsigned)wid * 2048u; m.vl = (unsigned)(uintptr_t)lds + (unsigned)wid * 2048u;
    return m;
}
#define DMA_TILE(Kp, Vp, kb_, buf_) do { const char* kp_ = (const char*)(Kp) + (size_t)(kb_) * (D * 2); const char* vp_ = (const char*)(Vp) + (size_t)(kb_) * (D * 2);                 \
        __builtin_amdgcn_global_load_lds((const unsigned*)(kp_ + M.k0), (FOX_LAS unsigned*)(M.kl + (unsigned)(buf_) * SHM_K), 16, 0, 0);                                           \
        __builtin_amdgcn_global_load_lds((const unsigned*)(kp_ + M.k1), (FOX_LAS unsigned*)(M.kl + (unsigned)(buf_) * SHM_K + 1024u), 16, 0, 0);                                   \
        __builtin_amdgcn_global_load_lds((const unsigned*)(vp_ + M.v0), (FOX_LAS unsigned*)(M.vl + (unsigned)(buf_) * SHM_V), 16, 0, 0);                                           \
        __builtin_amdgcn_global_load_lds((const unsigned*)(vp_ + M.v1), (FOX_LAS unsigned*)(M.vl + (unsigned)(buf_) * SHM_V + 1024u), 16, 0, 0); } while (0)
#define BIAS_DMA(FBp, nk, img) do { const int np_ = (nk) >> 8; const unsigned fl_ = (unsigned)(uintptr_t)(lds + LDS_FB) + (unsigned)(img) * (SKV * 4);                       \
        for (int pc_ = wid; pc_ < np_; pc_ += NW) __builtin_amdgcn_global_load_lds((const unsigned*)((const char*)(FBp) + pc_ * 1024 + lane * 16), (FOX_LAS unsigned*)(fl_ + (unsigned)pc_ * 1024u), 16, 0, 0); } while (0)
template <class TIn, class TOut>
__device__ __forceinline__ void causal_swa_prime(const BlockRef<TIn, TOut>& cur, int W, char* lds, Seam<TIn>& S) {
    static_assert(!same_t<TIn, float>::v, "bf16 q/k/v only");
    const int tid = ltid(), wid = __builtin_amdgcn_readfirstlane(tid >> 6), lane = tid & 63, r32 = lane & 31, hi = lane >> 5;
    const DmaMap M = dma_map(lds, wid, lane);
    DMA_TILE(cur.K, cur.V, 0, 0); S.b0 = 0; BIAS_DMA(cur.FB, cur.P0 + QB, 0); S.fp = 0;
    for (int d0 = 0; d0 < 8; ++d0) S.qr[d0] = load8<TIn>(cur.Q + (size_t)(wid * QBLK + r32) * D + d0 * 16 + hi * 8);
    VMW(); __syncthreads();
}
template <class TIn, class TOut>
__device__ __forceinline__ void causal_swa_block(const BlockRef<TIn, TOut>& cur, const BlockRef<TIn, TOut>& nxt, int skv, int W, char* lds, Seam<TIn>& S) {
    static_assert(!same_t<TIn, float>::v && !same_t<TOut, float>::v, "bf16 q/k/v/o only");
    const int tid = ltid(), wid = __builtin_amdgcn_readfirstlane(tid >> 6), lane = tid & 63, r32 = lane & 31, hi = lane >> 5;
    const int NT = (cur.P0 + QB) / KVBLK;
    const int qlo = cur.P0 + wid * QBLK, qm = qlo + r32 - 4 * hi;
    char* V_lds = lds; char* K_lds = lds + NBUF * SHM_V;
    float m_reg = -1e30f, l_reg = 0; f32x16 o[4] = {};
    float* fbuf = (float*)(lds + LDS_FB) + S.fp * SKV;
    BIAS_DMA(nxt.FB, nxt.P0 + QB, S.fp ^ 1);
    const char* fbl = (const char*)fbuf + hi * 16;
    m_reg = fbuf[cur.P0 + wid * QBLK + r32];
    const int vb0 = (int)(uintptr_t)V_lds + v_rd_base(lane);
    const DmaMap M = dma_map(lds, wid, lane);
    const TIn* Kh = cur.K; const TIn* Vh = cur.V;
#if MK_VWPROBE
    unsigned long long vwp_acc = 0, vwp_t0 = 0;
#define VWP_T0() do { if (wid == 0) vwp_t0 = __builtin_amdgcn_s_memtime(); } while (0)
#define VWP_T1() do { if (wid == 0) vwp_acc += __builtin_amdgcn_s_memtime() - vwp_t0; } while (0)
#else
#define VWP_T0() do {} while (0)
#define VWP_T1() do {} while (0)
#endif
    constexpr bool SK = MK_ATTSKIP;
#define RESC(a) do { if (__any((a) < 1.f)) { for (int d_ = 0; d_ < 4; ++d_) o[d_] = o[d_] * (a); } } while (0)
#define KBASE(t) ((t) * KVBLK)
#define ACT(t) (!SK || KBASE(t) <= qlo + QBLK - 1)
#define NXB(b) ((b) == NBUF - 1 ? 0 : (b) + 1)
#define MASKT(P0_, P1_, t) do { const int kb_ = KBASE(t); if (kb_ + KVBLK - 1 > qlo) mask_tile(P0_, P1_, qm - kb_, (unsigned)W); } while (0)
    f32x16 pA0, pA1, pB0, pB1; float mnA, mnB, alA, alB; bf16x8 pa0, pa1, pa2, pa3;
    const int b0 = S.b0; int kbt = NXB(b0);
    if (NT > 1) DMA_TILE(Kh, Vh, KBASE(1), kbt);
    SBAR(); qkt_x<SK>(pA0, pA1, K_lds + b0 * SHM_K, r32, hi, S.qr, ACT(0), fbl + KBASE(0) * 4);
    MASKT(pA0, pA1, 0); partialSM(pA0, pA1, m_reg, mnA, alA);
    VMW(); __syncthreads();
#define HALF_STEP3(PX0, PX1, mnX, alX, PY0, PY1, alY, t) do {                                                                 \
        const int bt_ = kbt, bp_ = (kbt == 0 ? NBUF - 1 : kbt - 1), bn_ = NXB(kbt);                                           \
        if (!MK_DMALATE && (t) + 1 < NT) DMA_TILE(Kh, Vh, KBASE((t) + 1), bn_);                                               \
        SBAR(); qkt_x<SK>(PX0, PX1, K_lds + bt_ * SHM_K, r32, hi, S.qr, ACT(t), fbl + KBASE(t) * 4);                         \
        if (MK_DMALATE && (t) + 1 < NT) { SBAR(); DMA_TILE(Kh, Vh, KBASE((t) + 1), bn_); SBAR(); }     \
        finishSM(PY0, PY1, alY, l_reg, pa0, pa1, pa2, pa3); SBAR();                                                           \
        pv_tile_x<SK>(o, vb0 + bp_ * SHM_V, pa0, pa1, pa2, pa3, ACT((t) - 1)); MASKT(PX0, PX1, (t)); partialSM(PX0, PX1, m_reg, mnX, alX); \
        RESC(alX); VWP_T0(); VMW(); VWP_T1(); __syncthreads(); kbt = bn_; } while (0)
    for (int t = 1; t + 1 < NT; t += 2) {
        HALF_STEP3(pB0, pB1, mnB, alB, pA0, pA1, alA, t);
        HALF_STEP3(pA0, pA1, mnA, alA, pB0, pB1, alB, t + 1);
    }
    const int bl_ = kbt, blp_ = (kbt == 0 ? NBUF - 1 : kbt - 1), bf_ = 3 - bl_ - blp_;
    const bool even = (NT & 1) == 0;
    if (even) { SBAR(); qkt_x<SK>(pB0, pB1, K_lds + bl_ * SHM_K, r32, hi, S.qr, ACT(NT - 1), fbl + KBASE(NT - 1) * 4); SBAR(); }
    DMA_TILE(nxt.K, nxt.V, 0, bf_); S.b0 = bf_; S.fp ^= 1; SBAR();
#pragma unroll
    for (int d0 = 0; d0 < 8; ++d0) S.qr[d0] = load8<TIn>(nxt.Q + (size_t)(wid * QBLK + r32) * D + d0 * 16 + hi * 8);
    SBAR();
    finishSM(pA0, pA1, alA, l_reg, pa0, pa1, pa2, pa3); SBAR();
    pv_tile_x<SK>(o, vb0 + blp_ * SHM_V, pa0, pa1, pa2, pa3, ACT(even ? NT - 2 : NT - 1));
    if (even) { MASKT(pB0, pB1, NT - 1); partialSM(pB0, pB1, m_reg, mnB, alB); RESC(alB);
        finishSM(pB0, pB1, alB, l_reg, pa0, pa1, pa2, pa3); SBAR(); pv_tile_x<SK>(o, vb0 + bl_ * SHM_V, pa0, pa1, pa2, pa3, ACT(NT - 1)); }
    SBAR();
    { const float rl = __builtin_amdgcn_rcpf(l_reg);
      TOut* Ow = cur.O + (size_t)(wid * QBLK + r32) * OPITCH + 8 * hi;
#pragma unroll
      for (int d0 = 0; d0 < 4; ++d0) { const f32x16 v = o[d0] * rl;
#pragma unroll
        for (int hf = 0; hf < 2; ++hf) { const unsigned a0 = cvtpk(v[8 * hf + 0], v[8 * hf + 1]), a1 = cvtpk(v[8 * hf + 2], v[8 * hf + 3]), b0_ = cvtpk(v[8 * hf + 4], v[8 * hf + 5]), b1_ = cvtpk(v[8 * hf + 6], v[8 * hf + 7]);
            auto r0 = __builtin_amdgcn_permlane32_swap(a0, b0_, false, false); auto r1 = __builtin_amdgcn_permlane32_swap(a1, b1_, false, false);
            u32x4 w = {r0[0], r1[0], r0[1], r1[1]};
            *(u32x4*)(Ow + d0 * 32 + 16 * hf) = w; } } }
#if MK_VWPROBE
    if (wid == 0 && lane == 0 && blockIdx.x == 0) *(volatile unsigned*)(lds + 155648 + 320 + 40 * 4) += (unsigned)(vwp_acc / 4);
#endif
    VMW(); __syncthreads();
#undef RESC
#undef KBASE
#undef ACT
#undef NXB
#undef MASKT
#undef HALF_STEP3
#undef VWP_T0
#undef VWP_T1
}
#undef VMW
#undef BIAS_DMA
#undef DMA_TILE
constexpr int NQB = SQ / QB, NXI = NQB / 2, NITEMS = NXI * B * H;
struct SwaItem { int bh, qb0, qb1; };
__device__ __forceinline__ SwaItem swa_decode(int L, bool grp) { SwaItem it; const int xcd = L & 7, k = L >> 3; it.bh = grp ? xcd * H + (k / NXI) : (k / NXI) * 8 + xcd; const int x = k % NXI; it.qb0 = x; it.qb1 = NQB - 1 - x; return it; }
template <class TIn, class TOut>
__device__ __forceinline__ BlockRef<TIn, TOut> swa_ref(const SwaItem& it, int pass, const TIn* Q, const TIn* K, const TIn* V, TOut* O, const float* FB) {
    const int qb = pass ? it.qb1 : it.qb0;
    BlockRef<TIn, TOut> r;
    const size_t ar = (size_t)(it.bh / H) * ARENA_E; const int hh = it.bh % H;
    r.Q = Q + ar + ((size_t)hh * SQ + (size_t)qb * QB) * D;
    r.O = O + ((size_t)(it.bh / H) * SQ + (size_t)qb * QB) * OPITCH + (it.bh % H) * D;
    r.K = K + ar + (size_t)hh * SKV * D; r.V = V + ar + (size_t)hh * SKV * D; r.FB = FB + (size_t)it.bh * SKV; r.P0 = qb * QB;
    return r;
}
__device__ __forceinline__ void att_phase(char* lds, const bf16* Q, const bf16* K, const bf16* V, bf16* O, const float* FB, int wg, int nwg, bool grp) {
    int L = wg; if (L >= NITEMS) return;
    SwaItem it = swa_decode(L, grp); int pass = 0;
    BlockRef<bf16, bf16> cur = swa_ref<bf16, bf16>(it, 0, Q, K, V, O, FB);
    Seam<bf16> S;
    causal_swa_prime<bf16, bf16>(cur, WINDOW, lds, S);
    for (;;) {
        const bool more_pass = pass == 0 && it.qb1 != it.qb0, more_item = L + nwg < NITEMS, last = !more_pass && !more_item;
        SwaItem itn = it; int passn = pass + 1, Ln = L;
        if (!more_pass) { passn = 0; Ln = more_item ? L + nwg : L; itn = swa_decode(Ln, grp); }
        const BlockRef<bf16, bf16> nxt = last ? cur : swa_ref<bf16, bf16>(itn, passn, Q, K, V, O, FB);
        causal_swa_block<bf16, bf16>(cur, nxt, SKV, WINDOW, lds, S);
        if (last) break;
        cur = nxt; it = itn; pass = passn; L = Ln;
    }
}
}
constexpr int DM = 2048, NBATCH = 8, SEQ = 4096, DEPTH = 4, NHEAD = 16, HDIM = 128, DFF = 5504, NFF2 = 2 * DFF, MTOK = NBATCH * SEQ;
constexpr int NQKVF = 3 * DM + NHEAD;
constexpr float EPS = 1e-6f;
constexpr int NWAVES = 8;
#ifndef MK_BARBLK
#define MK_BARBLK 0
#endif
#define BARPROBE_BLK(b) (MK_BARBLK == 0 ? true : MK_BARBLK == 1 ? ((b) < 128) : MK_BARBLK == 2 ? ((b) >= 128) : true)
#ifndef MK_PROA_SHARE
#define MK_PROA_SHARE 54
#endif
#ifndef MK_PER_PHASE
#define MK_PER_PHASE 0
#endif
constexpr size_t MiB = 1u << 20;
constexpr size_t WS_CTL = 0, CTL_ZERO_BYTES = 3 * MiB + 512 * 1024;
constexpr size_t WS_RSSF = 256 * 1024, WS_PCNT = 896 * 1024;
constexpr size_t WS_RSS = 1 * MiB;
constexpr size_t WS_VSS = 3 * MiB;
constexpr size_t WS_MOD = 3 * MiB + 512 * 1024;
constexpr size_t WS_SHT = 5 * MiB;
constexpr size_t WS_BIASV = 5 * MiB + 512 * 1024;
constexpr size_t WS_LOGF = 7 * MiB + 512 * 1024;
constexpr size_t WS_FB = 9 * MiB + 512 * 1024;
constexpr size_t WS_WQKV = 12 * MiB;
constexpr size_t WQKV_STRIDE = 25 * MiB / 2;
constexpr size_t WS_WO = 62 * MiB;
constexpr size_t WS_WGI = 78 * MiB;
constexpr size_t WS_WGO = 110 * MiB;
constexpr size_t WS_WF1 = 126 * MiB;
constexpr size_t WS_WF2 = 298 * MiB;
constexpr size_t WS_H = 384 * MiB;
constexpr size_t WS_H2 = 512 * MiB;
constexpr size_t WS_XB = 640 * MiB;
constexpr size_t WS_R = 768 * MiB;
constexpr size_t WS_ACT = WS_R + 384 * MiB;
constexpr size_t WS_END = WS_ACT + 366 * MiB;
constexpr int BV_QKVF = 0, BV_GI = 2 * 8 * NQKVF, BV_F1 = BV_GI + 2 * 8 * 4096;
constexpr int CW_TMO = 0, CW_BAR = 4096;

constexpr int RING_OFF = 0, RING_BYTES = 131072, XCH_OFF = 131072;
constexpr int CWT_OFF = 131072 + 14336;
constexpr int LDSCTL_OFF = 155648, MISC_OFF = LDSCTL_OFF + 320;
constexpr int LDS_BYTES = 159744;

#define GAS __attribute__((address_space(1)))
#define LAS __attribute__((address_space(3)))
typedef unsigned short bf16;
typedef unsigned v4u __attribute__((ext_vector_type(4)));
typedef unsigned v2u __attribute__((ext_vector_type(2)));
typedef float f32x4 __attribute__((ext_vector_type(4)));
typedef short bf16x8 __attribute__((ext_vector_type(8)));
typedef GAS unsigned gu32;
typedef unsigned long long u64;
constexpr float FIXS = 1048576.0f, FIXI = 1.0f / (1048576.0f * 2048.0f);
__device__ __forceinline__ float rstd_of(u64 v) { return __builtin_amdgcn_rsqf((float)v * FIXI + 1e-6f); }
#define RLX_AGENT __ATOMIC_RELAXED, __HIP_MEMORY_SCOPE_AGENT
#define LDS_WAIT() asm volatile("s_waitcnt lgkmcnt(0)" ::: "memory")
#define VM_WAIT() asm volatile("s_waitcnt vmcnt(0)" ::: "memory")
__device__ __forceinline__ unsigned f2bf(float f) { unsigned u = __builtin_bit_cast(unsigned, f); return (u + 0x7fffu + ((u >> 16) & 1u)) >> 16; }
__device__ __forceinline__ unsigned pk2(float lo, float hi) { return f2bf(lo) | (f2bf(hi) << 16); }
__device__ __forceinline__ float bf2f(unsigned short b) { return __builtin_bit_cast(float, (unsigned)b << 16); }
__device__ __forceinline__ float bflo(unsigned w) { return __builtin_bit_cast(float, w << 16); }
__device__ __forceinline__ float bfhi(unsigned w) { return __builtin_bit_cast(float, w & 0xffff0000u); }
#define XB_TMO      128
#define XB_XCNT(j)  (256  + 64 * (j))
#define XB_XSUB(j)  (1280 + 64 * (j))
#define XB_XGEN(j)  (2304 + 64 * (j))
#define XB_TOP      3328
#define XB_TOPGEN   3392
#define XCD_BAR_WORDS 3456
#define XB_SPIN_CAP (1u << 18)

__device__ __forceinline__ unsigned xb_ld(unsigned* p)              { return __hip_atomic_load((GAS unsigned*)p, __ATOMIC_RELAXED, __HIP_MEMORY_SCOPE_AGENT); }
__device__ __forceinline__ unsigned xb_add(unsigned* p, unsigned v) { return __hip_atomic_fetch_add((GAS unsigned*)p, v, __ATOMIC_RELAXED, __HIP_MEMORY_SCOPE_AGENT); }
__device__ __forceinline__ unsigned xb_xcc_id() { return (unsigned)__builtin_amdgcn_s_getreg((3 << 11) | 20) & 0xFu; }
#define XB_SPIN(cond, bar) do { unsigned _sp = 0; while (cond) { __builtin_amdgcn_s_sleep(1); \
    if ((++_sp & 255u) == 0u) { if (xb_ld(&(bar)[XB_TMO])) break; if (_sp > XB_SPIN_CAP) { xb_add(&(bar)[XB_TMO], 1u); break; } } } } while (0)

struct XcdBarrier {
    unsigned* bar; unsigned x, total;
    volatile LAS unsigned* st;
};

__device__ __forceinline__ XcdBarrier xcd_barrier_post(unsigned* bar, volatile LAS unsigned* st) {
    XcdBarrier b; b.bar = bar; b.x = xb_xcc_id(); b.st = st; b.total = gridDim.x * gridDim.y * gridDim.z;
    if (threadIdx.x == 0) (void)xb_add(&bar[XB_XCNT(b.x)], 1u);
    return b;
}
__device__ __forceinline__ void xcd_barrier_complete(unsigned* bar, unsigned x, unsigned G, unsigned& nloc, unsigned& nx) {
    unsigned sum, cnt, mine, sp = 0u;
    for (;;) {
        sum = 0u; cnt = 0u; mine = 0u;
#pragma unroll
        for (unsigned j = 0; j < 16; ++j) { const unsigned c = xb_ld(&bar[XB_XCNT(j)]); sum += c; cnt += (c > 0u) ? 1u : 0u; mine = (j == x) ? c : mine; }
        if (sum == G) break;
        __builtin_amdgcn_s_sleep(1);
        if ((++sp & 255u) == 0u) { if (xb_ld(&bar[XB_TMO])) break; if (sp > XB_SPIN_CAP) { xb_add(&bar[XB_TMO], 1u); break; } }
    }
    nloc = mine > 0u ? mine : 1u; nx = cnt > 0u ? cnt : 1u;
}

__device__ __forceinline__ void xcd_barrier(const XcdBarrier& b) {
#if defined(MK_BARPROBE) && MK_BARPROBE
    const unsigned long long bpt0_ = __builtin_amdgcn_s_memrealtime();
#endif
    asm volatile("s_waitcnt vmcnt(0)" ::: "memory");
    __syncthreads();
    if (threadIdx.x == 0) {
        unsigned* bar = b.bar;
        __builtin_amdgcn_s_waitcnt(0);
        unsigned nloc = b.st[0], nx = b.st[1];
        if (nloc == 0u) { xcd_barrier_complete(bar, b.x, b.total, nloc, nx); b.st[0] = nloc; b.st[1] = nx; }
        const unsigned old = xb_add(&bar[XB_XSUB(b.x)], 1u);
        const unsigned gen = old / nloc;
        if (old + 1u == (gen + 1u) * nloc) {
            __builtin_amdgcn_fence(__ATOMIC_RELEASE, "agent");
            asm volatile("s_waitcnt vmcnt(0)" ::: "memory");
            if (nx > 1u) {
            const unsigned og = xb_add(&bar[XB_TOP], 1u);
            const unsigned tg = og / nx;
            if (og + 1u == (tg + 1u) * nx) xb_add(&bar[XB_TOPGEN], 1u);
            else XB_SPIN(xb_ld(&bar[XB_TOPGEN]) == tg, bar);
            }
            __builtin_amdgcn_fence(__ATOMIC_ACQUIRE, "agent");
            xb_add(&bar[XB_XGEN(b.x)], 1u);
            asm volatile("s_waitcnt vmcnt(0)" ::: "memory");
        } else {
            XB_SPIN(xb_ld(&bar[XB_XGEN(b.x)]) == gen, bar);
            __builtin_amdgcn_fence(__ATOMIC_ACQUIRE, "agent");
            asm volatile("s_waitcnt vmcnt(0)" ::: "memory");
        }
#if defined(MK_BARPROBE) && MK_BARPROBE
        if (b.st[33] && BARPROBE_BLK(blockIdx.x)) __hip_atomic_fetch_add((GAS unsigned long long*)(bar + 3600), __builtin_amdgcn_s_memrealtime() - bpt0_, __ATOMIC_RELAXED, __HIP_MEMORY_SCOPE_AGENT);
#endif
    }
    __syncthreads();
}
struct Frame {
    LAS unsigned char* lds; char* ldsg;
    volatile LAS unsigned* MISC;
    int tid, lane, wave, vcu, G, bid;
    const GAS float* const __attribute__((address_space(4)))* inp;
    GAS float* outg; GAS unsigned char* wsg;
    __device__ __forceinline__ const float* in(int i) const { return (const float*)inp[i]; }
};
enum { IN_X = 0, IN_C, IN_MODW, IN_MODB, IN_MIXG, IN_FFNG, IN_AWIN, IN_ABF, IN_AWO, IN_GWIN, IN_GVG, IN_GWS, IN_GBS, IN_GWO, IN_FWIN, IN_FCW, IN_FCB, IN_FWOUT, IN_FING };
enum { MW_BID = 16, MW_G, MW_VCU, MW_INP, MW_INP_HI, MW_WS, MW_WS_HI, MW_OUT, MW_OUT_HI };
__device__ __forceinline__ unsigned misc_rd(const Frame& F, int k) { return (unsigned)__builtin_amdgcn_readfirstlane((int)F.MISC[k]); }
__device__ __forceinline__ bool relaunder(Frame& F) {
    int t = (int)threadIdx.x; asm volatile("" : "+v"(t)); F.tid = t; F.lane = t & 63; F.wave = __builtin_amdgcn_readfirstlane(t >> 6);
    F.bid = (int)misc_rd(F, MW_BID); F.G = (int)misc_rd(F, MW_G); F.vcu = (int)misc_rd(F, MW_VCU);
    F.inp = (const GAS float* const __attribute__((address_space(4)))*)(((unsigned long long)misc_rd(F, MW_INP_HI) << 32) | misc_rd(F, MW_INP));
    F.wsg = (GAS unsigned char*)(((unsigned long long)misc_rd(F, MW_WS_HI) << 32) | misc_rd(F, MW_WS));
    F.outg = (GAS float*)(((unsigned long long)misc_rd(F, MW_OUT_HI) << 32) | misc_rd(F, MW_OUT));
    return true; }
__device__ __forceinline__ void stagger(const Frame& F, unsigned ticks) {
    if (ticks && ((F.bid >> 3) & 1)) { const unsigned long long t0 = __builtin_amdgcn_s_memrealtime(); while (__builtin_amdgcn_s_memrealtime() - t0 < ticks) __builtin_amdgcn_s_sleep(16); }
}
__device__ __forceinline__ float wave_sum(float v) {
#pragma unroll
    for (int o = 1; o < 64; o <<= 1) v += __shfl_xor(v, o);
    return v;
}
__device__ __forceinline__ void transpose_item(const float* W, int ldw, int K, bf16* WT, int k0, int n0, int dst_row0, int ncols, LAS float* scr, int lane) {
    const int nl = lane & 31;
    if (ncols == 32) {
        const int n4 = (lane & 7) * 4, kr = lane >> 3; f32x4 t[8];
#pragma unroll
        for (int i = 0; i < 8; ++i) t[i] = *(const GAS f32x4*)(W + (size_t)(k0 + 8 * i + kr) * ldw + n0 + n4);
#pragma unroll
        for (int i = 0; i < 8; ++i) { LAS float* d = scr + (8 * i + kr) * 33 + n4; d[0] = t[i].x; d[1] = t[i].y; d[2] = t[i].z; d[3] = t[i].w; }
    } else {
#pragma unroll 8
        for (int i = 0; i < 32; ++i) { const int kk = 2 * i + (lane >> 5); if (nl < ncols) scr[kk * 33 + nl] = W[(size_t)(k0 + kk) * ldw + n0 + nl]; } }
    LDS_WAIT(); asm volatile("" ::: "memory");
    const int c = lane & 7;
#pragma unroll
    for (int j = 0; j < 4; ++j) { const int n = (lane >> 3) + 8 * j; const LAS float* s = scr + (8 * c) * 33 + n;
        if (n < ncols) { v4u o; o.x = pk2(s[0 * 33], s[1 * 33]); o.y = pk2(s[2 * 33], s[3 * 33]); o.z = pk2(s[4 * 33], s[5 * 33]); o.w = pk2(s[6 * 33], s[7 * 33]);
            *(GAS v4u*)(WT + (size_t)(dst_row0 + n) * K + k0 + 8 * c) = o; } }
    LDS_WAIT(); asm volatile("" ::: "memory");
}
__device__ __forceinline__ void pro_a_phase(Frame& F) {
    __syncthreads();
    {
        LAS float* cact = (LAS float*)(F.lds + RING_OFF);
        LAS float* red = (LAS float*)(F.lds + RING_OFF + 65536);
        float* mod = (float*)((unsigned char*)F.wsg + WS_MOD); float* sht = (float*)((unsigned char*)F.wsg + WS_SHT);
        for (int item = F.bid; item < 192; item += F.G) {
            for (int idx = F.tid; idx < NBATCH * DM; idx += NWAVES * 64) { const int b = idx >> 11, k = idx & 2047; const float v = F.in(IN_C)[idx]; cact[k * 8 + b] = v / (1.0f + __expf(-v)); }
            __syncthreads();
            const int i = item / 48, nbase = (item % 48) * 256;
            const float* wp = F.in(IN_MODW) + ((size_t)i * DM + F.wave * 256) * 12288 + nbase + F.lane * 4;
            f32x4 acc[8];
#pragma unroll
            for (int b = 0; b < 8; ++b) acc[b] = (f32x4){0.f, 0.f, 0.f, 0.f};
#pragma unroll 8
            for (int kk = 0; kk < 256; ++kk) {
                const f32x4 w = *(const GAS f32x4*)(wp + (size_t)kk * 12288);
                const LAS f32x4* cp = (const LAS f32x4*)(cact + (F.wave * 256 + kk) * 8);
                const f32x4 c0 = cp[0], c1 = cp[1];
                acc[0] += w * c0.x; acc[1] += w * c0.y; acc[2] += w * c0.z; acc[3] += w * c0.w;
                acc[4] += w * c1.x; acc[5] += w * c1.y; acc[6] += w * c1.z; acc[7] += w * c1.w;
            }
#pragma unroll
            for (int b = 0; b < 8; ++b) *(LAS f32x4*)(red + (F.wave * 8 + b) * 256 + F.lane * 4) = acc[b];
            __syncthreads();
            for (int o = F.tid; o < 2048; o += NWAVES * 64) { const int b = o >> 8, col = o & 255, gc = nbase + col; float s = 0.f;
#pragma unroll
                for (int w = 0; w < 8; ++w) s += red[(w * 8 + b) * 256 + col];
                s += F.in(IN_MODB)[i * 12288 + gc];
                mod[((size_t)i * 8 + b) * 12288 + gc] = s;
                if (gc < DM) sht[((size_t)(2 * i) * DM + gc) * 8 + b] = s;
                else if (gc >= 3 * DM && gc < 4 * DM) sht[((size_t)(2 * i + 1) * DM + (gc - 3 * DM)) * 8 + b] = s; }
            __syncthreads();
        }
    }
    LAS float* scr = (LAS float*)(F.lds + RING_OFF + F.wave * 16384);
    const int gw = F.vcu * NWAVES + F.wave, NGW = F.G * NWAVES;
    constexpr int I_O = 32 * 64, I_GO = 32 * 64, I_F2 = 86 * 64;
    constexpr int NITEMS = 2 * (I_O + I_GO) + 4 * I_F2;
    bf16* Wo = (bf16*)((unsigned char*)F.wsg + WS_WO); bf16* Wgo = (bf16*)((unsigned char*)F.wsg + WS_WGO); bf16* Wf2 = (bf16*)((unsigned char*)F.wsg + WS_WF2);
    const int nfree = F.G > 192 ? (F.G - 192) * NWAVES : 0, nbusy = F.G * NWAVES - nfree, isfree = F.bid >= 192;
    const int n_free_items = nfree ? (int)((long)NITEMS * MK_PROA_SHARE / 100) : 0;
    const int it0 = isfree ? ((F.bid - 192) * NWAVES + F.wave) : (n_free_items + (F.bid < 192 ? F.bid : 0) * NWAVES + F.wave), its = isfree ? nfree : nbusy, itend = isfree ? n_free_items : NITEMS;
    for (int it = it0; it < itend; it += its) {
        int r = it;
        if (r < 2 * I_O) { const int j = r / I_O, q = r % I_O, kb = q / 64, nb = q % 64;
            transpose_item(F.in(IN_AWO) + (size_t)j * DM * DM, DM, DM, Wo + (size_t)j * DM * DM, 64 * kb, 32 * nb, 32 * nb, 32, scr, F.lane); continue; } r -= 2 * I_O;
        if (r < 2 * I_GO) { const int j = r / I_GO, q = r % I_GO, kb = q / 64, nb = q % 64;
            transpose_item(F.in(IN_GWO) + (size_t)j * DM * DM, DM, DM, Wgo + (size_t)j * DM * DM, 64 * kb, 32 * nb, 32 * nb, 32, scr, F.lane); continue; } r -= 2 * I_GO;
        { const int j = r / I_F2, q = r % I_F2, kb = q / 64, nb = q % 64;
            transpose_item(F.in(IN_FWOUT) + (size_t)j * DFF * DM, DM, DFF, Wf2 + (size_t)j * DM * DFF, 64 * kb, 32 * nb, 32 * nb, 32, scr, F.lane); }
    }
}
__device__ __forceinline__ void strip_item(const float* W, int ldw, bf16* WT, int n0, int dst_row0, int ncols, const float* sht, float* bias, int bpitch, LAS float* scr, int lane) {
    const int nl = lane & 31, bh = lane >> 5, c = lane & 7;
    f32x4 acc = (f32x4){0.f, 0.f, 0.f, 0.f};
    for (int kb = 0; kb < DM / 64; ++kb) { const int k0 = 64 * kb;
        const f32x4 sa = *(const GAS f32x4*)(sht + (size_t)k0 * 8 + lane * 4), sb = *(const GAS f32x4*)(sht + (size_t)k0 * 8 + 256 + lane * 4);
        if (ncols == 32) { const int n4 = (lane & 7) * 4, kr = lane >> 3; f32x4 t[8];
#pragma unroll
            for (int i = 0; i < 8; ++i) t[i] = *(const GAS f32x4*)(W + (size_t)(k0 + 8 * i + kr) * ldw + n0 + n4);
#pragma unroll
            for (int i = 0; i < 8; ++i) { LAS float* d = scr + (8 * i + kr) * 33 + n4; d[0] = t[i].x; d[1] = t[i].y; d[2] = t[i].z; d[3] = t[i].w; }
        } else {
#pragma unroll 8
            for (int i = 0; i < 32; ++i) { const int kk = 2 * i + (lane >> 5); if (nl < ncols) scr[kk * 33 + nl] = W[(size_t)(k0 + kk) * ldw + n0 + nl]; } }
        LDS_WAIT(); asm volatile("" ::: "memory");
#pragma unroll
        for (int j = 0; j < 4; ++j) { const int n = (lane >> 3) + 8 * j; const LAS float* s = scr + (8 * c) * 33 + n;
            if (n < ncols) { v4u o; o.x = pk2(s[0 * 33], s[1 * 33]); o.y = pk2(s[2 * 33], s[3 * 33]); o.z = pk2(s[4 * 33], s[5 * 33]); o.w = pk2(s[6 * 33], s[7 * 33]);
                *(GAS v4u*)(WT + (size_t)(dst_row0 + n) * DM + k0 + 8 * c) = o; } }
        LAS f32x4* sl = (LAS f32x4*)(scr + 64 * 33 + 16);
        sl[lane] = sa; sl[64 + lane] = sb;
        LDS_WAIT(); asm volatile("" ::: "memory");
#pragma unroll 8
        for (int kk = 0; kk < 64; ++kk) acc += sl[kk * 2 + bh] * scr[kk * 33 + nl];
        LDS_WAIT(); asm volatile("" ::: "memory");
    }
    if (nl < ncols) {
#pragma unroll
        for (int e = 0; e < 4; ++e) bias[(size_t)(4 * bh + e) * bpitch + n0 + nl] = acc[e]; }
}
__device__ __forceinline__ void pro_b_phase(Frame& F) {
    LAS float* scr = (LAS float*)(F.lds + RING_OFF + F.wave * 16384);
    const int gw = F.vcu * NWAVES + F.wave, NGW = F.G * NWAVES;
    constexpr int S_QKV = 193, S_GI = 128, S_F1 = 344, NSTRIPS = 2 * (S_QKV + S_GI) + 4 * S_F1;
    const float* sht = (const float*)((unsigned char*)F.wsg + WS_SHT); float* bv = (float*)((unsigned char*)F.wsg + WS_BIASV);
    bf16* Wqkv = (bf16*)((unsigned char*)F.wsg + WS_WQKV); bf16* Wgi = (bf16*)((unsigned char*)F.wsg + WS_WGI); bf16* Wf1 = (bf16*)((unsigned char*)F.wsg + WS_WF1);
    for (int it = gw; it < NSTRIPS; it += NGW) {
        int r = it;
        if (r < 2 * S_QKV) { const int j = r / S_QKV, nb = r % S_QKV;
            strip_item(F.in(IN_AWIN) + (size_t)j * DM * NQKVF, NQKVF, Wqkv + (size_t)j * WQKV_STRIDE, 32 * nb, 32 * nb, nb == 192 ? 16 : 32, sht + (size_t)(4 * j) * DM * 8, bv + BV_QKVF + (size_t)j * 8 * NQKVF, NQKVF, scr, F.lane); continue; } r -= 2 * S_QKV;
        if (r < 2 * S_GI) { const int j = r / S_GI, nb = r % S_GI;
            strip_item(F.in(IN_GWIN) + (size_t)j * DM * 4096, 4096, Wgi + (size_t)j * 4096 * DM, 32 * nb, 32 * nb, 32, sht + (size_t)(4 * j + 2) * DM * 8, bv + BV_GI + (size_t)j * 8 * 4096, 4096, scr, F.lane); continue; } r -= 2 * S_GI;
        { const int i = r / S_F1, nb = r % S_F1, n0 = 32 * nb, isup = n0 >= DFF, cch = n0 - isup * DFF;
            strip_item(F.in(IN_FWIN) + (size_t)i * DM * NFF2, NFF2, Wf1 + (size_t)i * NFF2 * DM, n0, 256 * (cch >> 7) + 128 * isup + (cch & 127), 32, sht + (size_t)(2 * i + 1) * DM * 8, bv + BV_F1 + (size_t)i * 8 * NFF2, NFF2, scr, F.lane); }
    }
}
__device__ __forceinline__ void xg0_phase(Frame& F, const float* xin, const float* g, const float* scale, bf16* XG, bf16* XB, u64* rss) {
    const int gw = F.vcu * NWAVES + F.wave, NGW = F.G * NWAVES;
    for (int rb = gw; rb < MTOK / 16; rb += NGW) {
        const int b = (rb * 16) >> 12;
        f32x4 gs[8];
#pragma unroll
        for (int j = 0; j < 8; ++j) { const int c4 = F.lane + 64 * j; gs[j] = ((const GAS f32x4*)g)[c4] * (((const GAS f32x4*)(scale + (size_t)b * 12288))[c4] + 1.0f); }
        for (int r = 0; r < 16; ++r) { const size_t row = (size_t)rb * 16 + r;
            const GAS f32x4* xr = (const GAS f32x4*)(xin + row * DM) + F.lane;
            f32x4 v[8]; float ss = 0.f;
#pragma unroll
            for (int j = 0; j < 8; ++j) { v[j] = xr[64 * j]; ss += (v[j].x * v[j].x + v[j].y * v[j].y) + (v[j].z * v[j].z + v[j].w * v[j].w); }
            ss = wave_sum(ss); if (F.lane == 0) rss[row] = (u64)(ss * FIXS);
            GAS v2u* o8 = (GAS v2u*)(XG + row * DM) + F.lane; GAS v2u* x8 = (GAS v2u*)(XB + row * DM) + F.lane;
#pragma unroll
            for (int j = 0; j < 8; ++j) { const f32x4 o = v[j] * gs[j]; v2u w; w.x = pk2(o.x, o.y); w.y = pk2(o.z, o.w); o8[64 * j] = w; v2u q; q.x = pk2(v[j].x, v[j].y); q.y = pk2(v[j].z, v[j].w); x8[64 * j] = q; } }
    }
}
__device__ __forceinline__ void normf_phase(Frame& F, float* x, const float* g) {
    const int gw = F.vcu * NWAVES + F.wave, NGW = F.G * NWAVES;
    for (int rb = gw; rb < MTOK / 16; rb += NGW) {
        f32x4 gs[8];
#pragma unroll
        for (int j = 0; j < 8; ++j) gs[j] = ((const GAS f32x4*)g)[F.lane + 64 * j];
        for (int r = 0; r < 16; ++r) { const size_t row = (size_t)rb * 16 + r;
            GAS f32x4* xr = (GAS f32x4*)(x + row * DM) + F.lane;
            f32x4 v[8]; float ss = 0.f;
#pragma unroll
            for (int j = 0; j < 8; ++j) { v[j] = xr[64 * j]; ss += (v[j].x * v[j].x + v[j].y * v[j].y) + (v[j].z * v[j].z + v[j].w * v[j].w); }
            const float rstd = 1.0f / sqrtf(wave_sum(ss) * (1.0f / DM) + EPS);
#pragma unroll
            for (int j = 0; j < 8; ++j) xr[64 * j] = v[j] * rstd * gs[j]; }
    }
}
__device__ __forceinline__ void fg_phase(Frame& F, const bf16* XG, const bf16* Wf, const float* bfv, const u64* rss, const float* biasf  , float* LOGF) {
    const int gw = F.vcu * NWAVES + F.wave, NGW = F.G * NWAVES, fr = F.lane & 15, fq = F.lane >> 4;
    for (int rb = gw; rb < MTOK / 16; rb += NGW) {
        const GAS bf16x8* ap = (const GAS bf16x8*)(XG + ((size_t)rb * 16 + fr) * DM + fq * 8);
        const GAS bf16x8* bp = (const GAS bf16x8*)(Wf + (size_t)fr * DM + fq * 8);
        f32x4 acc = (f32x4){0.f, 0.f, 0.f, 0.f};
#pragma unroll 8
        for (int ks = 0; ks < 64; ++ks) acc = __builtin_amdgcn_mfma_f32_16x16x32_bf16(bp[ks * 4], ap[ks * 4], acc, 0, 0, 0);
        const int b = (rb * 16) >> 12; const float rs = rstd_of(rss[(size_t)rb * 16 + fr]);
        const f32x4 bb = *(const GAS f32x4*)(bfv + 4 * fq) + *(const GAS f32x4*)(biasf + (size_t)b * NQKVF + 4 * fq); f32x4 o;
#pragma unroll
        for (int i = 0; i < 4; ++i) { const float z = acc[i] * rs + bb[i]; o[i] = fminf(z, 0.f) - log1pf(__expf(-fabsf(z))); }
        *(GAS f32x4*)(LOGF + ((size_t)rb * 16 + fr) * 16 + 4 * fq) = o;
    }
}
__device__ __forceinline__ void cum_phase(Frame& F, const float* LOGF, float* FB, bool grp) {
    LAS float* wt = (LAS float*)(F.lds + RING_OFF);
    for (int bh0 = grp ? (F.bid >> 3) : F.bid; bh0 < (grp ? NHEAD : NBATCH * NHEAD); bh0 += F.G) { const int bh = grp ? (F.bid & 7) * NHEAD + bh0 : bh0, b = bh >> 4, h = bh & 15;
        const float* p = LOGF + ((size_t)b * SEQ + F.tid * 8) * 16 + h;
        float v[8]; float s = 0.f;
#pragma unroll
        for (int i = 0; i < 8; ++i) { s += p[i * 16]; v[i] = s; }
        float incl = s;
#pragma unroll
        for (int o = 1; o < 64; o <<= 1) { const float t = __shfl_up(incl, o); if (F.lane >= o) incl += t; }
        if (F.lane == 63) wt[F.wave] = incl;
        __syncthreads();
        float base = incl - s;
        for (int w = 0; w < F.wave; ++w) base += wt[w];
        GAS f32x4* q = (GAS f32x4*)(FB + (size_t)bh * SEQ + F.tid * 8);
        q[0] = (f32x4){-(base + v[0]) * 1.4426950408889634f, -(base + v[1]) * 1.4426950408889634f, -(base + v[2]) * 1.4426950408889634f, -(base + v[3]) * 1.4426950408889634f};
        q[1] = (f32x4){-(base + v[4]) * 1.4426950408889634f, -(base + v[5]) * 1.4426950408889634f, -(base + v[6]) * 1.4426950408889634f, -(base + v[7]) * 1.4426950408889634f};
        __syncthreads();
    }
}
template <int VB>
__device__ __forceinline__ void gate_pv(fox::f32x16* o, int vb0, fox::bf16x8 pa0, fox::bf16x8 pa1, fox::bf16x8 pa2, fox::bf16x8 pa3) {
    using fox::s16x4; using fox::bf16x8;
#define TRRD(dst, off) asm volatile("ds_read_b64_tr_b16 %0, %1 offset:%2" : "=&v"(dst) : "v"(vb0), "i"(off) : "memory")
#define PV_D0(d0) do { s16x4 l0, l1, l2, l3, h0, h1, h2, h3; constexpr int b_ = VB * fox::SHM_V + fox::v_rd_off(d0, 0, 0); \
        TRRD(l0, b_); TRRD(h0, b_ + 2048); TRRD(l1, b_ + 4096); TRRD(h1, b_ + 6144); TRRD(l2, b_ + 8192); TRRD(h2, b_ + 10240); TRRD(l3, b_ + 12288); TRRD(h3, b_ + 14336); \
        asm volatile("s_waitcnt lgkmcnt(0)" ::: "memory"); __builtin_amdgcn_sched_barrier(0); \
        o[d0] = __builtin_amdgcn_mfma_f32_32x32x16_bf16((bf16x8){l0[0], l0[1], l0[2], l0[3], h0[0], h0[1], h0[2], h0[3]}, pa0, o[d0], 0, 0, 0);   \
        o[d0] = __builtin_amdgcn_mfma_f32_32x32x16_bf16((bf16x8){l1[0], l1[1], l1[2], l1[3], h1[0], h1[1], h1[2], h1[3]}, pa1, o[d0], 0, 0, 0);   \
        o[d0] = __builtin_amdgcn_mfma_f32_32x32x16_bf16((bf16x8){l2[0], l2[1], l2[2], l2[3], h2[0], h2[1], h2[2], h2[3]}, pa2, o[d0], 0, 0, 0);   \
        o[d0] = __builtin_amdgcn_mfma_f32_32x32x16_bf16((bf16x8){l3[0], l3[1], l3[2], l3[3], h3[0], h3[1], h3[2], h3[3]}, pa3, o[d0], 0, 0, 0); } while (0)
    PV_D0(0); PV_D0(1); PV_D0(2); PV_D0(3);
#undef PV_D0
#undef TRRD
}
__device__ __forceinline__ void gate_phase(Frame& F, const bf16* Z, const u64* VSS, const float* vg, const float* Ws, const float* bs, bf16* GT, bool grp, size_t zbump) {
    using fox::bf16x8; using fox::f32x16;
    const int r32 = F.lane & 31, hi = F.lane >> 5, c = F.wave >> 2, t0 = 32 * (F.wave & 3);
    const int vb0 = (int)(uintptr_t)(F.ldsg + RING_OFF) + c * 32768 + fox::v_rd_base(F.lane);
    constexpr int NITEM = (MTOK / 256) * 16;
#define GATE_MAP(it_) (grp ? ((((F.bid & 7) * 16 + ((it_) >> 4)) << 4) | ((it_) & 15)) : (it_))
    int itq = grp ? (F.bid >> 3) : F.bid; const int itstep = grp ? (F.G >> 3) : F.G, itend = grp ? 256 : NITEM; if (itq >= itend) return;
    int item = GATE_MAP(itq);
    bf16x8 aw[8]; int gcur = -1;
    const int srow = F.tid >> 4, c8 = (F.tid & 15) * 8;
    v4u vw[8]; u64 vs[8];
#define VO_Z() ((unsigned)((ltid() >> 4) * 4096 + (ltid() & 15) * 8) * 2u)
#define VO_S() ((unsigned)(ltid() >> 4) * 8u)
#define VO_U() ((unsigned)((c * 128 + t0 + (ltid() & 31)) * 4096 + 8 * ((ltid() >> 5) & 1)) * 2u)
#define VO_O() ((unsigned)((c * 128 + t0 + (ltid() & 31)) * DM + 8 * ((ltid() >> 5) & 1)) * 2u)
#define GATE_LOADV(it_) do { const int g_ = (it_) & 15; const size_t r_ = (size_t)((it_) >> 4) * 256;                                             \
        const unsigned vo_z = VO_Z(); _Pragma("unroll") for (int ps = 0; ps < 8; ++ps) vw[ps] = *(const GAS v4u*)((const GAS char*)(Z + (size_t)((it_) >> 8) * zbump + (r_ + 32 * ps) * 4096 + 2048 + g_ * 128) + vo_z); } while (0)
#define GATE_LOADS(it_) do { const size_t r_ = (size_t)((it_) >> 4) * 256;                                                                        \
        const unsigned vo_s = VO_S(); _Pragma("unroll") for (int ps = 0; ps < 8; ++ps) vs[ps] = *(const GAS u64*)((const GAS char*)(VSS + r_ + 32 * ps) + vo_s); } while (0)
#define GATE_RSTD() do { _Pragma("unroll") for (int ps = 0; ps < 8; ++ps) rs8[ps] = rstd_of(vs[ps]); } while (0)
    float rs8[8];
    GATE_LOADS(item); GATE_LOADV(item); GATE_RSTD();
    for (int i = 0; ; ++i) {
        const int g = item & 15, pnl = item >> 4; const size_t row0 = (size_t)pnl * 256;
        if (g != gcur) { gcur = g;
            const float* wr_ = Ws + ((size_t)g * 128 + t0 + r32) * 128 + 8 * hi;
#pragma unroll
            for (int ks = 0; ks < 8; ++ks) { const f32x4 a = *(const GAS f32x4*)(wr_ + 16 * ks), b = *(const GAS f32x4*)(wr_ + 16 * ks + 4); const int s0 = 16 * ks + 8 * hi; int t = t0 + r32; asm volatile("" : "+v"(t));
                v4u w; w.x = pk2(s0 + 0 <= t ? a.x : 0.f, s0 + 1 <= t ? a.y : 0.f); w.y = pk2(s0 + 2 <= t ? a.z : 0.f, s0 + 3 <= t ? a.w : 0.f);
                       w.z = pk2(s0 + 4 <= t ? b.x : 0.f, s0 + 5 <= t ? b.y : 0.f); w.w = pk2(s0 + 6 <= t ? b.z : 0.f, s0 + 7 <= t ? b.w : 0.f);
                aw[ks] = __builtin_bit_cast(bf16x8, w); } }
        { const f32x4 g0 = *(const GAS f32x4*)(vg + g * 128 + c8), g1 = *(const GAS f32x4*)(vg + g * 128 + c8 + 4);
#pragma unroll
          for (int ps = 0; ps < 8; ++ps) { const int row = srow + 32 * ps, s = row & 127; const v4u w = vw[ps]; const float rs = rs8[ps];
            v4u o; o.x = pk2(bflo(w.x) * rs * g0.x, bfhi(w.x) * rs * g0.y); o.y = pk2(bflo(w.y) * rs * g0.z, bfhi(w.y) * rs * g0.w);
                   o.z = pk2(bflo(w.z) * rs * g1.x, bfhi(w.z) * rs * g1.y); o.w = pk2(bflo(w.w) * rs * g1.z, bfhi(w.w) * rs * g1.w);
            *(LAS v4u*)(F.lds + RING_OFF + (i & 1) * 65536 + ((row >> 7) * 2 + (s >> 6)) * 16384 + fox::v_st(s & 63, c8)) = o; } }
        const int nxq = itq + itstep; const bool more = nxq < itend; const int nxt = GATE_MAP(nxq);
        if (more) GATE_LOADS(nxt);
        v4u uq[8];
        { const GAS v4u* up = (const GAS v4u*)((const GAS char*)(Z + (size_t)(pnl >> 4) * zbump + row0 * 4096 + g * 128) + VO_U());
#pragma unroll
          for (int j = 0; j < 8; ++j) uq[j] = up[j * 2]; }
        const float bias = bs[g * 128 + t0 + r32];
        if (more) GATE_LOADV(nxt);
        LDS_WAIT(); asm volatile("" ::: "memory"); __builtin_amdgcn_s_barrier(); asm volatile("" ::: "memory");
        if (more) GATE_RSTD();
        { const int vbi = vb0 + (i & 1) * 65536; GAS v4u* op = (GAS v4u*)((GAS char*)(GT + row0 * DM + g * 128) + VO_O());
          using fox::s16x4;
#define G_TRRD(dst, off) asm volatile("ds_read_b64_tr_b16 %0, %1 offset:%2" : "=&v"(dst) : "v"(vbi), "i"(off) : "memory")
#define G_LD(R, tile, d0) do { constexpr int b_ = (tile) * 16384 + fox::v_rd_off(d0, 0, 0); G_TRRD(R##0, b_); G_TRRD(R##1, b_ + 2048); G_TRRD(R##2, b_ + 4096); G_TRRD(R##3, b_ + 6144); G_TRRD(R##4, b_ + 8192); G_TRRD(R##5, b_ + 10240); G_TRRD(R##6, b_ + 12288); G_TRRD(R##7, b_ + 14336); } while (0)
#define G_J(l, h) ((bf16x8){l[0], l[1], l[2], l[3], h[0], h[1], h[2], h[3]})
#define G_MM(R, A) do { acc = __builtin_amdgcn_mfma_f32_32x32x16_bf16(G_J(R##0, R##1), aw[(A) + 0], acc, 0, 0, 0); acc = __builtin_amdgcn_mfma_f32_32x32x16_bf16(G_J(R##2, R##3), aw[(A) + 1], acc, 0, 0, 0); \
        acc = __builtin_amdgcn_mfma_f32_32x32x16_bf16(G_J(R##4, R##5), aw[(A) + 2], acc, 0, 0, 0); acc = __builtin_amdgcn_mfma_f32_32x32x16_bf16(G_J(R##6, R##7), aw[(A) + 3], acc, 0, 0, 0); } while (0)
#define G_W(n, R) asm volatile("s_waitcnt lgkmcnt(" #n ")" : "+v"(R##0), "+v"(R##1), "+v"(R##2), "+v"(R##3), "+v"(R##4), "+v"(R##5), "+v"(R##6), "+v"(R##7) :: "memory")
#define G_EPI(d0) do { _Pragma("unroll") for (int hf = 0; hf < 2; ++hf) { const v4u uw = uq[(d0) * 2 + hf];                                                                                          \
                auto s0 = __builtin_amdgcn_permlane32_swap(uw.x, uw.z, false, false); auto s1 = __builtin_amdgcn_permlane32_swap(uw.y, uw.w, false, false);     \
                const int j0 = 8 * hf;                                                                                                                                                            \
                const float v0 = bflo(s0[0]) * (acc[j0 + 0] + bias), v1 = bfhi(s0[0]) * (acc[j0 + 1] + bias), v2 = bflo(s1[0]) * (acc[j0 + 2] + bias), v3 = bfhi(s1[0]) * (acc[j0 + 3] + bias);      \
                const float v4 = bflo(s0[1]) * (acc[j0 + 4] + bias), v5 = bfhi(s0[1]) * (acc[j0 + 5] + bias), v6 = bflo(s1[1]) * (acc[j0 + 6] + bias), v7 = bfhi(s1[1]) * (acc[j0 + 7] + bias);      \
                const unsigned a0 = fox::cvtpk(v0, v1), a1 = fox::cvtpk(v2, v3), b0 = fox::cvtpk(v4, v5), b1 = fox::cvtpk(v6, v7);                                                                 \
                auto r0 = __builtin_amdgcn_permlane32_swap(a0, b0, false, false); auto r1 = __builtin_amdgcn_permlane32_swap(a1, b1, false, false);                                                \
                v4u w; w.x = r0[0]; w.y = r1[0]; w.z = r0[1]; w.w = r1[1];                                                                                                                         \
                op[(d0) * 4 + hf * 2] = w; } } while (0)
          s16x4 fa0, fa1, fa2, fa3, fa4, fa5, fa6, fa7, fb0, fb1, fb2, fb3, fb4, fb5, fb6, fb7; f32x16 acc;
          if (t0 >= 64) {
              G_LD(fa, 0, 0); G_LD(fb, 1, 0);
              G_W(8, fa); acc = (f32x16){}; G_MM(fa, 0); G_LD(fa, 0, 1); G_W(8, fb); G_MM(fb, 4); G_LD(fb, 1, 1); G_EPI(0);
              G_W(8, fa); acc = (f32x16){}; G_MM(fa, 0); G_LD(fa, 0, 2); G_W(8, fb); G_MM(fb, 4); G_LD(fb, 1, 2); G_EPI(1);
              G_W(8, fa); acc = (f32x16){}; G_MM(fa, 0); G_LD(fa, 0, 3); G_W(8, fb); G_MM(fb, 4); G_LD(fb, 1, 3); G_EPI(2);
              G_W(8, fa); acc = (f32x16){}; G_MM(fa, 0); G_W(0, fb); G_MM(fb, 4); G_EPI(3);
          } else {
              G_LD(fa, 0, 0); G_LD(fb, 0, 1);
              G_W(8, fa); acc = (f32x16){}; G_MM(fa, 0); G_LD(fa, 0, 2); G_EPI(0);
              G_W(8, fb); acc = (f32x16){}; G_MM(fb, 0); G_LD(fb, 0, 3); G_EPI(1);
              G_W(8, fa); acc = (f32x16){}; G_MM(fa, 0); G_EPI(2);
              G_W(0, fb); acc = (f32x16){}; G_MM(fb, 0); G_EPI(3);
          }
#undef G_EPI
#undef G_W
#undef G_MM
#undef G_J
#undef G_LD
#undef G_TRRD
        }
        if (!more) break;
        item = nxt; itq = nxq;
    }
#undef VO_O
#undef VO_U
#undef VO_S
#undef VO_Z
#undef GATE_MAP
#undef GATE_RSTD
#undef GATE_LOADS
#undef GATE_LOADV
    __syncthreads();
}
__device__ __forceinline__ float silu1(float v) { return v * __builtin_amdgcn_rcpf(1.0f + __builtin_amdgcn_exp2f(v * -1.4426950408889634f)); }
__device__ __forceinline__ void fix_phase(Frame& F, const float* HALO, const float* cw, const float* cb, bf16* ACT, int pm_lo, int pm_n, bool grp) {
    constexpr int C4 = DFF / 4;
    const int wgi = grp ? (F.bid >> 3) : F.bid, wgn = grp ? (F.G >> 3) : F.G, nit = grp ? 16 * C4 : pm_n * C4, pbase = grp ? (F.bid & 7) * 16 : pm_lo;
    for (int item = wgi * (NWAVES * 64) + F.tid; item < nit; item += wgn * NWAVES * 64) {
        const int pm = pbase + item / C4, c4 = (item % C4) * 4; if ((pm & 15) == 0) continue;
        f32x4 r0[2], r1[2];
#pragma unroll
        for (int part = 0; part < 2; ++part) { const int col = part * DFF + c4;
            const f32x4 am2 = *(const GAS f32x4*)(HALO + ((size_t)(pm - 1) * 4 + 2) * NFF2 + col), am1 = *(const GAS f32x4*)(HALO + ((size_t)(pm - 1) * 4 + 3) * NFF2 + col);
            const f32x4 a0 = *(const GAS f32x4*)(HALO + ((size_t)pm * 4 + 0) * NFF2 + col), a1 = *(const GAS f32x4*)(HALO + ((size_t)pm * 4 + 1) * NFF2 + col);
            const f32x4 w0 = *(const GAS f32x4*)(cw + col), w1 = *(const GAS f32x4*)(cw + NFF2 + col), w2 = *(const GAS f32x4*)(cw + 2 * NFF2 + col), b = *(const GAS f32x4*)(cb + col);
            r0[part] = b + w0 * am2 + w1 * am1 + w2 * a0; r1[part] = b + w0 * am1 + w1 * a0 + w2 * a1; }
        v2u o0, o1;
        o0.x = pk2(silu1(r0[0].x) * r0[1].x, silu1(r0[0].y) * r0[1].y); o0.y = pk2(silu1(r0[0].z) * r0[1].z, silu1(r0[0].w) * r0[1].w);
        o1.x = pk2(silu1(r1[0].x) * r1[1].x, silu1(r1[0].y) * r1[1].y); o1.y = pk2(silu1(r1[0].z) * r1[1].z, silu1(r1[0].w) * r1[1].w);
        *(GAS v2u*)(ACT + ((size_t)pm * 256) * DFF + c4) = o0; *(GAS v2u*)(ACT + ((size_t)pm * 256 + 1) * DFF + c4) = o1;
    }
}
constexpr int NPHASE = 96;
struct Args { const float* in[19]; float* out; unsigned char* ws; int ph_lo, ph_hi; };
static_assert(sizeof(Args) == 19 * 8 + 8 + 8 + 8, "Args has no padding bytes");
#ifndef MK_EN
#define MK_EN 0xffffffffu
#endif
#define EN(k) (((MK_EN) >> (k)) & 1u)
#ifndef MK_BARPROBE
#define MK_BARPROBE 0
#endif
#ifndef MK_BARSEL
#define MK_BARSEL 0
#endif
#define BARSEL(ph) (MK_BARSEL == 0 ? true : MK_BARSEL == 1 ? ((ph) < 2) : MK_BARSEL == 2 ? ((ph) == 2 || (ph) == 15) : MK_BARSEL == 3 ? ((ph) == 3 || (ph) == 16) : MK_BARSEL == 4 ? ((ph) == 4 || (ph) == 17) : MK_BARSEL == 5 ? ((ph) == 5 || (ph) == 18 || (ph) == 11 || (ph) == 24) : \
    MK_BARSEL == 6 ? ((ph) == 6 || (ph) == 19 || (ph) == 12 || (ph) == 25) : MK_BARSEL == 7 ? ((ph) == 7 || (ph) == 20 || (ph) == 13 || (ph) == 26) : MK_BARSEL == 8 ? ((ph) == 8 || (ph) == 21 || (ph) == 14 || (ph) == 27) : MK_BARSEL == 9 ? ((ph) == 9 || (ph) == 22) : MK_BARSEL == 10 ? ((ph) == 10 || (ph) == 23) : false)
#if MK_BARPROBE
#define BARPROBE_T0() const unsigned long long bpt0_ = __builtin_amdgcn_s_memrealtime()
#define BARPROBE_T1() do { if (threadIdx.x == 0 && ph + 2 < hi) __hip_atomic_fetch_add((unsigned long long*)((unsigned char*)F.wsg + WS_CTL + 512 * 1024), __builtin_amdgcn_s_memrealtime() - bpt0_, __ATOMIC_RELAXED, __HIP_MEMORY_SCOPE_AGENT); } while (0)
#else
#define BARPROBE_T0() do {} while (0)
#define BARPROBE_T1() do {} while (0)
#endif
#ifndef MK_TPSITE
#define MK_TPSITE 1
#endif
#ifndef MK_TPROBE
#define MK_TPROBE 0
#endif
#ifndef MK_CLKPROBE
#define MK_CLKPROBE 0
#endif
#ifndef MK_GROUPS
#define MK_GROUPS 1
#endif
#ifndef MK_FUSEFIN
#define MK_FUSEFIN 0
#endif
#ifndef MK_FFN_SPLIT
#define MK_FFN_SPLIT 1
#endif
#ifndef MK_PAD
#define MK_PAD 0
#endif
#define MK_STR2(x) #x
#define MK_STR(x) MK_STR2(x)
#define MK_PAD_STR MK_STR(MK_PAD)
#ifndef MK_DYNTAIL
#define MK_DYNTAIL 0
#endif
#ifndef MK_ALIGN
#define MK_ALIGN true
#endif
#ifndef MK_STAG_F1
#define MK_STAG_F1 0
#endif
#ifndef MK_REPBAR
#define MK_REPBAR 0
#endif
#ifndef MK_SP2
#define MK_SP2 true
#endif
#ifndef MK_BAR2
#define MK_BAR2 0
#endif
#ifndef MK_KREP
#define MK_KREP 1
#endif
#ifndef MK_REP
#define MK_REP 0u
#endif
#define REPN(k) ((((MK_REP) >> (k)) & 1u) ? 2 : 1)
#define W_MOD   ((float*)((unsigned char*)F.wsg + WS_MOD))
#define W_H     ((bf16*)((unsigned char*)F.wsg + WS_H))
#define W_Q     ((bf16*)((unsigned char*)F.wsg + WS_R))
#define W_K     ((bf16*)((unsigned char*)F.wsg + WS_R + 16 * MiB))
#define W_V     ((bf16*)((unsigned char*)F.wsg + WS_R + 32 * MiB))
#define W_Z     ((bf16*)((unsigned char*)F.wsg + WS_R))
#define W_ACT   ((bf16*)((unsigned char*)F.wsg + WS_ACT))
#define W_HALO  ((float*)((unsigned char*)F.wsg + WS_ACT + 344 * MiB))
#define W_LOGF  ((float*)((unsigned char*)F.wsg + WS_LOGF))
#define W_FB    ((float*)((unsigned char*)F.wsg + WS_FB))
#define W_VSS(n) ((u64*)((unsigned char*)F.wsg + WS_VSS) + (size_t)(n) * MTOK)
#define W_XB    ((bf16*)((unsigned char*)F.wsg + WS_XB))
#define W_H2    ((bf16*)((unsigned char*)F.wsg + WS_H2))
#define W_RSS(n) ((u64*)((unsigned char*)F.wsg + WS_RSS) + (size_t)(n) * MTOK)
#define W_BIASV ((float*)((unsigned char*)F.wsg + WS_BIASV))
#define W_MODI  (W_MOD + (size_t)i * 8 * 12288)
#define XOUT_(k) ((REPN(k) == 2 && rep_ == 0) ? W_H : W_XB)
#define XG_(k, p) ((REPN(k) == 2 && rep_ == 0) ? (bf16*)nullptr : (p))
__global__ void __launch_bounds__(NWAVES * 64, 2) mega_fwd(Args args) {
    extern __shared__ __attribute__((aligned(16))) unsigned char lds[];
    Frame F;
#if MK_PAD > 0
    asm volatile(".rept " MK_PAD_STR "\n\ts_nop 0\n\t.endr" ::: "memory");
#endif
    F.lds = (LAS unsigned char*)lds; F.ldsg = (char*)lds;
    F.MISC = (volatile LAS unsigned*)(F.lds + MISC_OFF);
    for (int u = threadIdx.x; u < (LDS_BYTES - LDSCTL_OFF) / 4; u += NWAVES * 64) ((LAS unsigned*)(F.lds + LDSCTL_OFF))[u] = 0u;
    __syncthreads();
    if (threadIdx.x == 0) {
        const int G = gridDim.x, bx = blockIdx.x; const unsigned long long kp = (unsigned long long)__builtin_amdgcn_kernarg_segment_ptr(), wp = (unsigned long long)args.ws, op = (unsigned long long)args.out;
        F.MISC[MW_BID] = (unsigned)bx; F.MISC[MW_G] = (unsigned)G; F.MISC[MW_VCU] = (unsigned)((G % 8 == 0) ? (bx % 8) * (G / 8) + bx / 8 : bx);
        F.MISC[MW_INP] = (unsigned)kp; F.MISC[MW_INP_HI] = (unsigned)(kp >> 32); F.MISC[MW_WS] = (unsigned)wp; F.MISC[MW_WS_HI] = (unsigned)(wp >> 32); F.MISC[MW_OUT] = (unsigned)op; F.MISC[MW_OUT_HI] = (unsigned)(op >> 32);
    }
    __syncthreads();
    XcdBarrier bar; bar.bar = (unsigned*)(args.ws + WS_CTL) + CW_BAR; bar.x = 0; bar.st = nullptr;
    if (!MK_PER_PHASE) bar = xcd_barrier_post((unsigned*)(args.ws + WS_CTL) + CW_BAR, F.MISC + 8);
    XcdBarrier gbar = bar; const bool grp = MK_GROUPS && !MK_PER_PHASE && gridDim.x == 256;
    if (grp) { gbar = xcd_barrier_post((unsigned*)(args.ws + WS_CTL) + CW_BAR + XCD_BAR_WORDS * (1 + (blockIdx.x & 7)), F.MISC + 10); gbar.total = 32u; }
    const int lo = args.ph_lo, hi = args.ph_hi;
    int ph = 0;
#define REPBAR(k) ((MK_REPBAR && rep_ < REPN(k)) ? (relaunder(F), bar.bar = (unsigned*)((unsigned char*)F.wsg + WS_CTL) + CW_BAR, xcd_barrier(bar), 0) : 0)
#define RUN() (lo <= ph && ph < hi && relaunder(F))
#define SEAMX(glob) do { if (!MK_PER_PHASE) { if (lo <= ph && ph + 1 < hi) { relaunder(F); if ((glob) || !grp) { bar.bar = (unsigned*)((unsigned char*)F.wsg + WS_CTL) + CW_BAR; asm volatile("" : "+s"(bar.x)); if (MK_BARPROBE && threadIdx.x == 0) F.MISC[41] = BARSEL(ph) ? 1u : 0u; xcd_barrier(bar); if (MK_BAR2) xcd_barrier(bar); } \
        else { gbar.bar = (unsigned*)((unsigned char*)F.wsg + WS_CTL) + CW_BAR + XCD_BAR_WORDS * (1 + (F.bid & 7)); asm volatile("" : "+s"(gbar.x)); if (MK_BARPROBE && threadIdx.x == 0) F.MISC[41] = BARSEL(ph) ? 1u : 0u; xcd_barrier(gbar); } } } ++ph; } while (0)
#define SEAM() SEAMX(true)
#define SEAMG() SEAMX(false)

    if (EN(0) && RUN()) for (int rep_ = 0; rep_ < REPN(0); ++rep_, REPBAR(0)) pro_a_phase(F);
    SEAM();
    if (EN(1) && RUN()) for (int rep_ = 0; rep_ < REPN(1); ++rep_, REPBAR(1)) { pro_b_phase(F); xg0_phase(F, F.in(IN_X), F.in(IN_MIXG), W_MOD + DM, W_H, W_XB, W_RSS(0)); }
    SEAM();
    for (int i = 0; i < DEPTH; ++i) {
        const int j = i >> 1;
        if ((i & 1) == 0) {
            if (EN(3) && RUN()) for (int rep_ = 0; rep_ < REPN(3); ++rep_, REPBAR(3)) {
                const bf16* wq = (const bf16*)((unsigned char*)F.wsg + WS_WQKV) + (size_t)j * WQKV_STRIDE; const float* bvq = W_BIASV + BV_QKVF + (size_t)j * 8 * NQKVF;
                fg_phase(F, W_H, wq + (size_t)6144 * DM, F.in(IN_ABF) + j * 16, W_RSS(2 * i), bvq + 6144, W_LOGF);
                pg8::Gemm g{W_H, wq, MTOK, 6144, DM}; pg8::StaticOrder S; S.init(MTOK, 6144, F.G, F.bid);
                pg8::EpiQKV E{W_Q, (size_t)(8 * MiB), (size_t)(24 * MiB), fox::QSCALE, pg8::RowAffine{W_RSS(2 * i), bvq, NQKVF, (LAS float*)(F.lds + XCH_OFF + 8192)}};
                pg8::gemm_phase<pg8::EpiQKV, pg8::StaticOrder, MK_ALIGN, MK_SP2>(F.lds + RING_OFF, g, S, E);
            }
            SEAMG();
            if (EN(4) && RUN()) for (int rep_ = 0; rep_ < REPN(4); ++rep_, REPBAR(4)) cum_phase(F, W_LOGF, W_FB, grp);
            SEAMG();
            if (EN(5) && RUN()) for (int rep_ = 0; rep_ < REPN(5); ++rep_, REPBAR(5)) fox::att_phase(F.ldsg + RING_OFF, (const fox::bf16*)W_Q, (const fox::bf16*)W_K, (const fox::bf16*)W_V, (fox::bf16*)W_H, W_FB, F.bid, F.G, grp);
            SEAMG();
            if (EN(6) && RUN()) for (int rep_ = 0; rep_ < REPN(6); ++rep_, REPBAR(6)) {
                pg8::Gemm g{W_H, (const bf16*)((unsigned char*)F.wsg + WS_WO) + (size_t)j * DM * DM, MTOK, DM, DM}; pg8::StaticOrder S; S.init(MTOK, DM, F.G, F.bid);
                pg8::EpiRes E{XOUT_(6), W_MODI + 2 * DM, 12288, XG_(6, W_H2), F.in(IN_FFNG) + i * DM, W_MODI + 4 * DM, W_RSS(2 * i + 1), (LAS float*)(F.lds + XCH_OFF), (float*)nullptr};
                pg8::gemm_phase<pg8::EpiRes, pg8::StaticOrder, MK_ALIGN, MK_SP2>(F.lds + RING_OFF, g, S, E);
            }
            SEAMG();
        } else {
            if (EN(7) && RUN()) for (int rep_ = 0; rep_ < REPN(7); ++rep_, REPBAR(7)) {
                pg8::Gemm g{W_H, (const bf16*)((unsigned char*)F.wsg + WS_WGI) + (size_t)j * 4096 * DM, MTOK, 4096, DM}; pg8::StaticOrder S; S.init(MTOK, 4096, F.G, F.bid);
                pg8::EpiStore<1> E{W_Z, 4096, pg8::RowAffine{W_RSS(2 * i), W_BIASV + BV_GI + (size_t)j * 8 * 4096, 4096, (LAS float*)(F.lds + XCH_OFF + 8192)}, W_VSS(j), (size_t)(8 * MiB)};
                pg8::gemm_phase<pg8::EpiStore<1>, pg8::StaticOrder, MK_ALIGN, MK_SP2>(F.lds + RING_OFF, g, S, E);
            }
            SEAMG();
            if (EN(9) && RUN()) for (int rep_ = 0; rep_ < REPN(9); ++rep_, REPBAR(9)) gate_phase(F, W_Z, W_VSS(j), F.in(IN_GVG) + j * DM, F.in(IN_GWS) + (size_t)j * 16 * 128 * 128, F.in(IN_GBS) + j * 16 * 128, W_H, grp, (size_t)(8 * MiB));
            SEAMG();
            if (EN(10) && RUN()) for (int rep_ = 0; rep_ < REPN(10); ++rep_, REPBAR(10)) {
                pg8::Gemm g{W_H, (const bf16*)((unsigned char*)F.wsg + WS_WGO) + (size_t)j * DM * DM, MTOK, DM, DM}; pg8::StaticOrder S; S.init(MTOK, DM, F.G, F.bid);
                pg8::EpiRes E{XOUT_(10), W_MODI + 2 * DM, 12288, XG_(10, W_H2), F.in(IN_FFNG) + i * DM, W_MODI + 4 * DM, W_RSS(2 * i + 1), (LAS float*)(F.lds + XCH_OFF), (float*)nullptr};
                pg8::gemm_phase<pg8::EpiRes, pg8::StaticOrder, MK_ALIGN, MK_SP2>(F.lds + RING_OFF, g, S, E);
            }
            SEAMG();
        }
        for (int hf_ = 0; hf_ < MK_FFN_SPLIT; ++hf_) {
        const int pmn_ = (MTOK / 256) / MK_FFN_SPLIT, pm0_ = hf_ * pmn_;
        if (EN(11) && RUN()) for (int rep_ = 0; rep_ < REPN(11); ++rep_, REPBAR(11)) {
            stagger(F, MK_STAG_F1);
#if MK_CLKPROBE
            unsigned long long pc0_ = 0, pr0_ = 0; if (i == 0 && F.bid == 0) { pc0_ = __builtin_amdgcn_s_memtime(); pr0_ = __builtin_amdgcn_s_memrealtime(); }
#endif
            pg8::Gemm g{W_H2, (const bf16*)((unsigned char*)F.wsg + WS_WF1) + (size_t)i * NFF2 * DM, MTOK, NFF2, DM}; pg8::StaticOrder S; S.init(MTOK / MK_FFN_SPLIT, NFF2, F.G, F.bid); S.pm_off = pm0_;
            pg8::EpiConv E{W_ACT, F.in(IN_FCW) + (size_t)i * 3 * NFF2, F.in(IN_FCB) + (size_t)i * NFF2, W_HALO, (LAS float*)(F.lds + XCH_OFF), pg8::RowAffine{W_RSS(2 * i + 1), W_BIASV + BV_F1 + (size_t)i * 8 * NFF2, NFF2, (LAS float*)(F.lds + XCH_OFF + 8192)}, (LAS float*)(F.lds + CWT_OFF)};
#if MK_TPROBE && MK_TPSITE == 1
            { unsigned long long tpv_ = 0; pg8::gemm_phase<pg8::EpiConv, pg8::StaticOrder, true, MK_SP2, MK_KREP, MK_TPROBE>(F.lds + RING_OFF, g, S, E, &tpv_);
              if (i == 0 && F.bid == 0 && threadIdx.x == 0) F.MISC[40] = (unsigned)(tpv_ * 10ull); }
#elif MK_DYNTAIL
            { pg8::TailClaimOrder T; T.init(MTOK, NFF2, F.G, F.bid); T.init_tail((unsigned*)((unsigned char*)F.wsg + WS_CTL + 768 * 1024) + i * 8 * 64, (volatile LAS unsigned*)(F.MISC + 42));
              pg8::gemm_phase<pg8::EpiConv, pg8::TailClaimOrder, true, MK_SP2, MK_KREP>(F.lds + RING_OFF, g, T, E); }
#else
            pg8::gemm_phase<pg8::EpiConv, pg8::StaticOrder, true, MK_SP2, MK_KREP>(F.lds + RING_OFF, g, S, E);
#endif
#if MK_CLKPROBE
            if (i == 0 && F.bid == 0) { const unsigned long long dc_ = __builtin_amdgcn_s_memtime() - pc0_, dr_ = __builtin_amdgcn_s_memrealtime() - pr0_;
                if (threadIdx.x == 0) { F.MISC[40] = (unsigned)(dc_ * 5000ull / (dr_ ? dr_ : 1ull)); } }
#endif
        }
        SEAMG();
        if (EN(12) && RUN()) for (int rep_ = 0; rep_ < REPN(12); ++rep_, REPBAR(12)) fix_phase(F, W_HALO, F.in(IN_FCW) + (size_t)i * 3 * NFF2, F.in(IN_FCB) + (size_t)i * NFF2, W_ACT, pm0_, pmn_, grp);
        SEAMG();
        if (EN(13) && RUN()) for (int rep_ = 0; rep_ < REPN(13); ++rep_, REPBAR(13)) {
            pg8::Gemm g{W_ACT, (const bf16*)((unsigned char*)F.wsg + WS_WF2) + (size_t)i * DM * DFF, MTOK, DM, DFF}; pg8::StaticOrder S; S.init(MTOK / MK_FFN_SPLIT, DM, F.G, F.bid); S.pm_off = pm0_;
            const int in_ = i < DEPTH - 1 ? i + 1 : i;
#if MK_FUSEFIN
            pg8::EpiResF E{{XOUT_(13), W_MODI + 5 * DM, 12288, XG_(13, i < DEPTH - 1 ? W_H : (bf16*)nullptr), F.in(IN_MIXG) + in_ * DM, W_MOD + (size_t)in_ * 8 * 12288 + DM, W_RSS(2 * in_), (LAS float*)(F.lds + XCH_OFF), (float*)nullptr},
                i < DEPTH - 1 ? (float*)nullptr : (float*)F.outg, F.in(IN_FING), (u64*)((unsigned char*)F.wsg + WS_RSSF), (unsigned*)((unsigned char*)F.wsg + WS_PCNT)};
#else
            pg8::EpiRes E{XOUT_(13), W_MODI + 5 * DM, 12288, XG_(13, i < DEPTH - 1 ? W_H : (bf16*)nullptr), F.in(IN_MIXG) + in_ * DM, W_MOD + (size_t)in_ * 8 * 12288 + DM, W_RSS(2 * in_), (LAS float*)(F.lds + XCH_OFF), i < DEPTH - 1 ? (float*)nullptr : (float*)F.outg};
#endif
#if MK_TPROBE && MK_TPSITE == 2
            { unsigned long long tpv_ = 0; pg8::gemm_phase<pg8::EpiRes, pg8::StaticOrder, MK_ALIGN, MK_SP2, 1, MK_TPROBE>(F.lds + RING_OFF, g, S, E, &tpv_);
              if (i == 0 && F.bid == 0 && threadIdx.x == 0) F.MISC[40] = (unsigned)(tpv_ * 10ull); }
#else
#if MK_FUSEFIN
            pg8::gemm_phase<pg8::EpiResF, pg8::StaticOrder, MK_ALIGN, MK_SP2>(F.lds + RING_OFF, g, S, E);
#else
            pg8::gemm_phase<pg8::EpiRes, pg8::StaticOrder, MK_ALIGN, MK_SP2>(F.lds + RING_OFF, g, S, E);
#endif
#endif
        }
        if (MK_FUSEFIN && i == DEPTH - 1) ++ph; else SEAMG();
        }
    }
#if MK_BARPROBE
    if (blockIdx.x == 0 && threadIdx.x == 0) F.MISC[40] = (unsigned)(__hip_atomic_load((unsigned long long*)((unsigned char*)F.wsg + WS_CTL + (CW_BAR + 3600) * 4), __ATOMIC_RELAXED, __HIP_MEMORY_SCOPE_AGENT) * 10ull / 256ull);
#endif
#if MK_CLKPROBE || MK_TPROBE || MK_BARPROBE || MK_PPPROBE || MK_VWPROBE
    if (blockIdx.x == 0) { __syncthreads(); const unsigned w_ = F.MISC[40]; const unsigned long long t0_ = __builtin_amdgcn_s_memrealtime(); while (__builtin_amdgcn_s_memrealtime() - t0_ < (unsigned long long)w_) __builtin_amdgcn_s_sleep(32); }
#endif
    if (!MK_FUSEFIN && EN(14) && RUN()) normf_phase(F, (float*)F.outg, F.in(IN_FING));
#undef RUN
#undef SEAM
}

extern "C" void kernel_launch(void* const* d_in, const int* in_sizes, int n_in, void* d_out, int out_size, void* d_ws, size_t ws_size, hipStream_t stream) {
    static int grid = 0;
    if (grid == 0) {
        if (n_in != 19 || out_size != MTOK * DM || ws_size < WS_END) { fprintf(stderr, "kernel_launch: unexpected shapes (n_in %d, out %d, ws %zu < %zu)\n", n_in, out_size, ws_size, (size_t)WS_END); grid = -1; return; }
        int dev = 0, cus = 0, per_cu = 0;
        if (hipGetDevice(&dev) != hipSuccess || hipDeviceGetAttribute(&cus, hipDeviceAttributeMultiprocessorCount, dev) != hipSuccess) { grid = -1; return; }
        if (hipFuncSetAttribute((const void*)mega_fwd, hipFuncAttributeMaxDynamicSharedMemorySize, LDS_BYTES) != hipSuccess) { fprintf(stderr, "kernel_launch: hipFuncSetAttribute failed\n"); grid = -1; return; }
        if (hipOccupancyMaxActiveBlocksPerMultiprocessor(&per_cu, (const void*)mega_fwd, NWAVES * 64, LDS_BYTES) != hipSuccess || per_cu < 1) { fprintf(stderr, "kernel_launch: occupancy query says %d\n", per_cu); }
        (void)hipGetLastError();
        grid = cus;
    }
    if (grid < 0) return;
    if (hipMemsetAsync((char*)d_ws + WS_CTL, 0, CTL_ZERO_BYTES, stream) != hipSuccess) return;
    Args a{};
    for (int i = 0; i < 19; ++i) a.in[i] = (const float*)d_in[i];
    a.out = (float*)d_out; a.ws = (unsigned char*)d_ws;
#if MK_PER_PHASE
    for (int p = 0; p < NPHASE; ++p) { a.ph_lo = p; a.ph_hi = p + 1; hipLaunchKernelGGL(mega_fwd, dim3(grid), dim3(NWAVES * 64), LDS_BYTES, stream, a); }
#else
    a.ph_lo = 0; a.ph_hi = NPHASE; hipLaunchKernelGGL(mega_fwd, dim3(grid), dim3(NWAVES * 64), LDS_BYTES, stream, a);
#endif
}
```
